# Optimizing an MI355X kernel written in HIP

```python
import functools
import jax, jax.numpy as jnp
from jax import lax
import numpy as np

D_MODEL = 1024
BATCH = 2
SEQ = 16384
DEPTH = 4
DEC_BATCH = 16
DEC_SEQ = 32
PAST_LEN = 2048

CHUNK = 64
Q_BLOCK = 128
MIX_WIDTH = D_MODEL
SB_WIDTH = MIX_WIDTH // 2
RET_WIDTH = MIX_WIDTH - SB_WIDTH
SB_HEAD_DIM = 64
SB_HEADS = SB_WIDTH // SB_HEAD_DIM
RET_HEAD_DIM = 128
RET_HEADS = RET_WIDTH // RET_HEAD_DIM
IN_SPLITS = (SB_WIDTH, 2 * SB_WIDTH, 3 * SB_WIDTH, 3 * SB_WIDTH + RET_WIDTH,
             3 * SB_WIDTH + 2 * RET_WIDTH, 3 * SB_WIDTH + 3 * RET_WIDTH)
IN_WIDTH = 3 * SB_WIDTH + 4 * RET_WIDTH
D_FF = ((8 * D_MODEL + 3 * 256 - 1) // (3 * 256)) * 256
N_MOD = 6
ROPE_BASE = 10000.0
EPS = 1e-6

kernel_name = 'stickbreak_retention_hybrid_stream_step'


def rms_norm(x, g):
    xf = x.astype(jnp.float32)
    y = xf * lax.rsqrt(jnp.mean(xf * xf, axis=-1, keepdims=True) + EPS)
    return (y * g.astype(jnp.float32)).astype(x.dtype)


def rotary(x, pos):
    half = x.shape[-1] // 2
    inv = ROPE_BASE ** (-jnp.arange(half, dtype=jnp.float32) / half)
    ang = pos.astype(jnp.float32)[:, None] * inv[None, :]
    cos, sin = jnp.cos(ang)[:, None, :], jnp.sin(ang)[:, None, :]
    xf = x.astype(jnp.float32)
    x1, x2 = xf[..., :half], xf[..., half:]
    return jnp.concatenate([x1 * cos - x2 * sin, x1 * sin + x2 * cos], axis=-1).astype(x.dtype)


def retention_log_decay():
    return jnp.log1p(-jnp.exp2(-5.0 - jnp.arange(RET_HEADS, dtype=jnp.float32)))


def modulation(c, w_ada, b_ada):
    mod = jax.nn.silu(c) @ w_ada + b_ada
    return tuple(m[:, None, :] for m in jnp.split(mod, N_MOD, axis=-1))


def project_heads(h, w_in, pos):
    B, T, _ = h.shape
    q_sb, k_sb, v_sb, q_r, k_r, v_r, gate = jnp.split(h @ w_in, IN_SPLITS, axis=-1)
    q_sb = q_sb.reshape(B, T, SB_HEADS, SB_HEAD_DIM)
    k_sb = k_sb.reshape(B, T, SB_HEADS, SB_HEAD_DIM)
    v_sb = v_sb.reshape(B, T, SB_HEADS, SB_HEAD_DIM)
    q_r = rotary(q_r.reshape(B, T, RET_HEADS, RET_HEAD_DIM), pos)
    k_r = rotary(k_r.reshape(B, T, RET_HEADS, RET_HEAD_DIM), pos) * (RET_HEAD_DIM ** -0.5)
    v_r = v_r.reshape(B, T, RET_HEADS, RET_HEAD_DIM)
    return q_sb, k_sb, v_sb, q_r, k_r, v_r, gate


def stick_breaking_weights(z, mask, cum):
    log_1m = jnp.where(mask, jax.nn.log_sigmoid(-z), 0.0)
    between = lax.cumsum(log_1m, axis=3, reverse=True) - log_1m + cum[..., None]
    w = jnp.where(mask, jnp.exp(jax.nn.log_sigmoid(z) + between), 0.0)
    return w, jnp.sum(log_1m, axis=3)


def stick_breaking_prompt(q, k, v):
    B, S, H, d = q.shape
    scale = d ** -0.5
    local = jnp.arange(Q_BLOCK)
    diag_mask = local[None, :] < local[:, None]

    def query_block(i):
        qi = lax.dynamic_slice_in_dim(q, i * Q_BLOCK, Q_BLOCK, axis=1)

        def cond(carry):
            return carry[0] >= 0

        def body(carry):
            j, acc, cum = carry
            kj = lax.dynamic_slice_in_dim(k, j * Q_BLOCK, Q_BLOCK, axis=1)
            vj = lax.dynamic_slice_in_dim(v, j * Q_BLOCK, Q_BLOCK, axis=1)
            z = jnp.einsum('bqhd,bkhd->bhqk', qi, kj, preferred_element_type=jnp.float32) * scale
            mask = jnp.logical_or(j < i, diag_mask)
            w, block_sum = stick_breaking_weights(z, mask, cum)
            acc = acc + jnp.einsum('bhqk,bkhd->bqhd', w, vj.astype(jnp.float32))
            return j - 1, acc, cum + block_sum

        init = (i, jnp.zeros((B, Q_BLOCK, H, d), jnp.float32),
                jnp.zeros((B, H, Q_BLOCK), jnp.float32))
        _, acc, _ = lax.while_loop(cond, body, init)
        return acc.astype(q.dtype)

    blocks = lax.map(query_block, jnp.arange(S // Q_BLOCK, dtype=jnp.int32))
    return blocks.transpose(1, 0, 2, 3, 4).reshape(B, S, H, d)


def stick_breaking_dense(q, k, v, q_pos, k_pos):
    z = jnp.einsum('bqhd,bkhd->bhqk', q, k, preferred_element_type=jnp.float32) * (q.shape[-1] ** -0.5)
    mask = k_pos[None, :] < q_pos[:, None]
    w, _ = stick_breaking_weights(z, mask, jnp.zeros(z.shape[:3], jnp.float32))
    return jnp.einsum('bhqk,bkhd->bqhd', w, v.astype(jnp.float32)).astype(q.dtype)


def retention_chunk(q, k, v, state, log_gamma):
    L = q.shape[1]
    q, k, v = (a.astype(jnp.float32) for a in (q, k, v))
    idx = jnp.arange(L, dtype=jnp.float32)
    diff = idx[:, None] - idx[None, :]
    decay = jnp.where(diff >= 0, jnp.exp(jnp.maximum(diff, 0.0)[None] * log_gamma[:, None, None]), 0.0)
    scores = jnp.einsum('blhd,bmhd->bhlm', q, k) * decay[None]
    inner = jnp.einsum('bhlm,bmhe->blhe', scores, v)
    q_decay = jnp.exp((idx + 1.0)[:, None] * log_gamma[None, :])
    cross = jnp.einsum('blhd,bhde->blhe', q, state) * q_decay[None, :, :, None]
    k_decay = jnp.exp((L - 1.0 - idx)[:, None] * log_gamma[None, :])
    new_state = (jnp.exp(L * log_gamma)[None, :, None, None] * state
                 + jnp.einsum('blhd,blhe->bhde', k * k_decay[None, :, :, None], v))
    return inner + cross, new_state


def retention_prompt(q, k, v):
    B, S, H, dk = q.shape
    dv = v.shape[-1]
    n_chunks = S // CHUNK
    log_gamma = retention_log_decay()

    def chunks(a):
        return a.reshape(B, n_chunks, CHUNK, H, a.shape[-1]).swapaxes(0, 1)

    def body(state, xs):
        o, state = retention_chunk(xs[0], xs[1], xs[2], state, log_gamma)
        return state, o

    state, o = lax.scan(body, jnp.zeros((B, H, dk, dv), jnp.float32), (chunks(q), chunks(k), chunks(v)))
    return o.swapaxes(0, 1).reshape(B, S, H, dv), state


def core_prompt(q_sb, k_sb, v_sb, q_r, k_r, v_r):
    o_sb = stick_breaking_prompt(q_sb, k_sb, v_sb)
    o_r, st = retention_prompt(q_r, k_r, v_r)
    return o_sb, o_r.astype(q_sb.dtype), (k_sb, v_sb, st.astype(q_sb.dtype))


def core_sample(cache_k, cache_v, state, q_sb, k_sb, v_sb, q_r, k_r, v_r):
    T = q_sb.shape[1]
    past = cache_k.shape[1]
    k_all = jnp.concatenate([cache_k.astype(k_sb.dtype), k_sb], axis=1)
    v_all = jnp.concatenate([cache_v.astype(v_sb.dtype), v_sb], axis=1)
    q_pos = past + jnp.arange(T)
    k_pos = jnp.arange(past + T)
    o_sb = stick_breaking_dense(q_sb, k_all, v_all, q_pos, k_pos)
    o_r, st = retention_chunk(q_r, k_r, v_r, state.astype(jnp.float32), retention_log_decay())
    return o_sb, o_r.astype(q_sb.dtype), (k_sb, v_sb, st.astype(q_sb.dtype))


def merge_heads(o_sb, o_ret, gate, g_sb, g_ret, w_out):
    B, T = o_sb.shape[:2]
    o_sb = rms_norm(o_sb.reshape(B, T, SB_WIDTH), g_sb)
    o_ret = rms_norm(o_ret, g_ret).reshape(B, T, RET_WIDTH) * jax.nn.silu(gate)
    return jnp.concatenate([o_sb, o_ret], axis=-1) @ w_out


def swiglu(h, w_ff_in, w_ff_out):
    g, u = jnp.split(h @ w_ff_in, 2, axis=-1)
    return (jax.nn.silu(g) * u) @ w_ff_out


def trunk_layer(x, c, pos, core, g_mix, g_ffn, w_ada, b_ada, w_in, g_sb, g_ret, w_out, w_ff_in, w_ff_out):
    sh1, sc1, gt1, sh2, sc2, gt2 = modulation(c, w_ada, b_ada)
    h = rms_norm(x, g_mix) * (1 + sc1) + sh1
    q_sb, k_sb, v_sb, q_r, k_r, v_r, gate = project_heads(h, w_in, pos)
    o_sb, o_ret, new_state = core(q_sb, k_sb, v_sb, q_r, k_r, v_r)
    x = x + gt1 * merge_heads(o_sb, o_ret, gate, g_sb, g_ret, w_out)
    h = rms_norm(x, g_ffn) * (1 + sc2) + sh2
    x = x + gt2 * swiglu(h, w_ff_in, w_ff_out)
    return x, new_state


def setup_inputs(seed: int = 0) -> dict:
    key = jax.random.key(seed)
    ks = jax.random.split(key, 18)

    def nrm(k, shape, s=1.0):
        return s * jax.random.normal(k, shape, jnp.float32)

    return {
        'x_prompt': nrm(ks[0], (BATCH, SEQ, D_MODEL)),
        'x_sample': nrm(ks[1], (DEC_BATCH, DEC_SEQ, D_MODEL)),
        'cache_sb_k': nrm(ks[2], (DEPTH, DEC_BATCH, PAST_LEN, SB_HEADS, SB_HEAD_DIM)),
        'cache_sb_v': nrm(ks[3], (DEPTH, DEC_BATCH, PAST_LEN, SB_HEADS, SB_HEAD_DIM)),
        'state_ret': nrm(ks[4], (DEPTH, DEC_BATCH, RET_HEADS, RET_HEAD_DIM, RET_HEAD_DIM), 0.5),
        'c_prompt': nrm(ks[5], (BATCH, D_MODEL)),
        'c_sample': nrm(ks[6], (DEC_BATCH, D_MODEL)),
        'g_norm_mix': 1.0 + nrm(ks[7], (DEPTH, D_MODEL), 0.02),
        'g_norm_ffn': 1.0 + nrm(ks[8], (DEPTH, D_MODEL), 0.02),
        'w_ada': nrm(ks[9], (DEPTH, D_MODEL, N_MOD * D_MODEL), 0.5 * D_MODEL ** -0.5),
        'b_ada': nrm(ks[10], (DEPTH, N_MOD * D_MODEL), 0.02),
        'w_in': nrm(ks[11], (DEPTH, D_MODEL, IN_WIDTH), D_MODEL ** -0.5),
        'g_sb_out': 1.0 + nrm(ks[12], (DEPTH, SB_WIDTH), 0.02),
        'g_ret_out': 1.0 + nrm(ks[13], (DEPTH, RET_HEADS, RET_HEAD_DIM), 0.02),
        'w_out': nrm(ks[14], (DEPTH, MIX_WIDTH, D_MODEL), MIX_WIDTH ** -0.5),
        'w_ff_in': nrm(ks[15], (DEPTH, D_MODEL, 2 * D_FF), D_MODEL ** -0.5),
        'w_ff_out': nrm(ks[16], (DEPTH, D_FF, D_MODEL), D_FF ** -0.5),
        'g_final': 1.0 + nrm(ks[17], (D_MODEL,), 0.02),
    }


def reference(x_prompt, x_sample, cache_sb_k, cache_sb_v, state_ret, c_prompt, c_sample,
              g_norm_mix, g_norm_ffn, w_ada, b_ada, w_in, g_sb_out, g_ret_out, w_out,
              w_ff_in, w_ff_out, g_final):
    pos_p = jnp.arange(x_prompt.shape[1])
    pos_s = cache_sb_k.shape[2] + jnp.arange(x_sample.shape[1])
    xp, xs = x_prompt, x_sample
    kp, vp, rp, ksm, vsm, rsm = [], [], [], [], [], []
    for l in range(DEPTH):
        weights = (g_norm_mix[l], g_norm_ffn[l], w_ada[l], b_ada[l], w_in[l], g_sb_out[l],
                   g_ret_out[l], w_out[l], w_ff_in[l], w_ff_out[l])
        xp, (k_new, v_new, r_new) = trunk_layer(xp, c_prompt, pos_p, core_prompt, *weights)
        kp.append(k_new)
        vp.append(v_new)
        rp.append(r_new)
        core_s = functools.partial(core_sample, cache_sb_k[l], cache_sb_v[l], state_ret[l])
        xs, (k_new, v_new, r_new) = trunk_layer(xs, c_sample, pos_s, core_s, *weights)
        ksm.append(k_new)
        vsm.append(v_new)
        rsm.append(r_new)
    y_prompt = rms_norm(xp, g_final)
    y_sample = rms_norm(xs, g_final)
    return (y_prompt, y_sample, jnp.stack(kp), jnp.stack(vp), jnp.stack(rp),
            jnp.stack(ksm), jnp.stack(vsm), jnp.stack(rsm))
```

```cpp
#include <hip/hip_runtime.h>
#include <hip/hip_cooperative_groups.h>
#include <cstdio>
#include <cstdint>
namespace cg = cooperative_groups;
namespace pg8 {
#define PG8_LAS __attribute__((address_space(3)))
typedef unsigned short bf16_t;
typedef short bf16x8 __attribute__((ext_vector_type(8)));
typedef float f32x4 __attribute__((ext_vector_type(4)));
typedef unsigned u32x4 __attribute__((ext_vector_type(4)));
constexpr int BM = 256, BK = 64, HALF = 128, HTB = HALF * BK * 2  , STAGE_BYTES = 8 * HTB, NXCD = 8, WGM = 8;

__host__ __device__ __forceinline__ int lds_byte(int r, int c) { const int st = (r >> 4) * 2 + (c >> 5), rr = r & 15, cc = c & 31, ob = rr * 64 + cc * 2; return st * 1024 + (ob ^ (((ob >> 9) & 1) << 5)); }
__host__ __device__ __forceinline__ void stage_rc(int b, int& R, int& C) { const int st = b / 1024, sb = b % 1024, swz = sb ^ (((sb >> 9) & 1) << 5); R = (st >> 1) * 16 + swz / 64; C = (st & 1) * 32 + (swz % 64) / 2; }
__host__ __device__ __forceinline__ int perm32(int rho) { const int n = rho >> 4, i = rho & 15; return 8 * (i >> 2) + 4 * n + (i & 3); }

struct Unit { int pm, pn; };
struct Gemm { const bf16_t* A; const bf16_t* Bt; int M, N, K; };

struct StaticOrder {
    int nM, nN, nwg, G, c;
    __host__ __device__ void init(int M, int N, int G_, int c_) { nM = M / BM; nN = N / BM; nwg = nM * nN; G = G_; c = c_; }
    __host__ __device__ bool next(int i, Unit& u) const {
        const long L = (long)i * G + c; if (L >= nwg) return false;
        int wgid = (int)L; { const int q = nwg / NXCD, r = nwg % NXCD, xcd = wgid % NXCD, off = wgid / NXCD; wgid = (xcd < r ? xcd * (q + 1) : r * (q + 1) + (xcd - r) * q) + off; }
        const int nig = WGM * nN, gid = wgid / nig, fm = gid * WGM, gsz = (nM - fm) < WGM ? (nM - fm) : WGM;
        u.pm = fm + ((wgid % nig) % gsz); u.pn = (wgid % nig) / gsz; return true;
    }
    __device__ __forceinline__ void a_ready(const Unit&) const {}
    __device__ __forceinline__ void done(const Unit&) const {}
};

__device__ __forceinline__ unsigned cvt_pk_bf16(float lo, float hi) { unsigned r; asm volatile("v_cvt_pk_bf16_f32 %0, %1, %2" : "=v"(r) : "v"(lo), "v"(hi)); return r; }
typedef float f32x2 __attribute__((ext_vector_type(2)));
__device__ __forceinline__ f32x2 gelu_pk(f32x2 v) {
    const f32x2 av = __builtin_elementwise_abs(v), d = av * 0.2316418882f + 1.0f;
    f32x2 t; t.x = __builtin_amdgcn_rcpf(d.x); t.y = __builtin_amdgcn_rcpf(d.y);
    f32x2 q = t * 0.5307027145f + (-0.7265760135f); q = q * t + 0.7107068705f; q = q * t + (-0.142248368f); q = q * t + 0.127414796f; q = q * t;
    const f32x2 s = (v * v) * (-0.72134752044f);
    f32x2 e; e.x = __builtin_amdgcn_exp2f(s.x); e.y = __builtin_amdgcn_exp2f(s.y);
    const f32x2 m = v * (q * e), r = v - m;
    f32x2 o; o.x = v.x < 0.f ? m.x : r.x; o.y = v.y < 0.f ? m.y : r.y; return o;
}

template <int ACT  > struct EpiBf16 {
    static constexpr bool PERM = true, AFTER_DRAIN = false; static_assert(ACT == 0 || ACT == 1, "EpiBf16: ACT is 0 (none) or 1 (gelu_pk)");
    bf16_t* O; int ldc; const float* bias; int split_cols; size_t split_stride; float scale0;
    __device__ __forceinline__ void operator()(const f32x4 (&acc)[2][2][4][2], const Unit& u, int wr, int wc, int fr, int fq) const {
        const int row0 = u.pm * BM + wr * 64 + fr; int colt = u.pn * BM; bf16_t* base = O;
        float sc = 1.f; if (split_cols) { const int t = colt / split_cols; base += (size_t)t * split_stride; colt -= t * split_cols; if (t == 0) sc = scale0; }
        const int col0 = colt + wc * 32 + 8 * fq, bcol0 = u.pn * BM + wc * 32 + 8 * fq;
        f32x4 bv[2][2];
#pragma unroll
        for (int bj = 0; bj < 2; ++bj)
#pragma unroll
            for (int n = 0; n < 2; ++n) bv[bj][n] = bias ? *(const f32x4*)(bias + bcol0 + bj * HALF + 4 * n) : (f32x4){0.f, 0.f, 0.f, 0.f};
#pragma unroll
        for (int ai = 0; ai < 2; ++ai)
#pragma unroll
            for (int m = 0; m < 4; ++m) { bf16_t* rowp = base + (size_t)(row0 + ai * HALF + m * 16) * ldc + col0;
#pragma unroll
                for (int bj = 0; bj < 2; ++bj) { f32x4 v0 = acc[ai][bj][m][0] + bv[bj][0], v1 = acc[ai][bj][m][1] + bv[bj][1];
                    if (ACT == 1) { f32x2 a = gelu_pk((f32x2){v0[0], v0[1]}), b = gelu_pk((f32x2){v0[2], v0[3]}), c = gelu_pk((f32x2){v1[0], v1[1]}), d = gelu_pk((f32x2){v1[2], v1[3]});
                        v0 = (f32x4){a.x, a.y, b.x, b.y}; v1 = (f32x4){c.x, c.y, d.x, d.y}; }
                    v0 = v0 * sc; v1 = v1 * sc; u32x4 w; w.x = cvt_pk_bf16(v0[0], v0[1]); w.y = cvt_pk_bf16(v0[2], v0[3]); w.z = cvt_pk_bf16(v1[0], v1[1]); w.w = cvt_pk_bf16(v1[2], v1[3]);
                    *(u32x4*)(rowp + bj * HALF) = w; } }
    }
};
template <class Epi, class Sched, bool ALIGN_EPI = false, bool SP2 = false>
__device__ __forceinline__ void gemm_phase(PG8_LAS unsigned char* lds, const Gemm g, const Sched& S, const Epi& E) {
    int tid_o = threadIdx.x; asm volatile("" : "+v"(tid_o));
    const int tid = tid_o, wid = __builtin_amdgcn_readfirstlane(tid >> 6), lane = tid & 63, wr = wid >> 2, wc = wid & 3, fr = lane & 15, fq = lane >> 4;
    const int K = g.K, nt = K / BK;
    unsigned voffA[2], voffB[2];
#pragma unroll
    for (int i = 0; i < 2; ++i) { int R, C; stage_rc(tid * 16 + i * 8192, R, C); const int Rb = Epi::PERM ? ((R & ~31) + perm32(R & 31)) : R;
        voffA[i] = (unsigned)(R * K + C) * 2u; voffB[i] = (unsigned)(Rb * K + C) * 2u; }
    const size_t kstep = (size_t)(BK * 2);
    const size_t hstep = (size_t)HALF * K * 2;
    const size_t tstep = 2 * hstep;
    const unsigned ldsw = (unsigned)wid * 1024u;
    const int aoff = lds_byte(wr * 64 + fr, fq * 8), boff = lds_byte(wc * 32 + fr, fq * 8);
#define PG8_SA(b, h) (((b) * 2 + (h)) * HTB)
#define PG8_SB(b, h) ((4 + (b) * 2 + (h)) * HTB)
#define PG8_STAGE(bufoff, gbase, voff) do { _Pragma("unroll") for (int _i = 0; _i < 2; ++_i) \
        __builtin_amdgcn_global_load_lds((const unsigned*)((const char*)(gbase) + (voff)[_i]), (PG8_LAS unsigned*)(lds + (bufoff) + ldsw + _i * 8192), 16, 0, 0); } while (0)
#define PG8_LDA(dst, b, h) do { _Pragma("unroll") for (int m = 0; m < 4; ++m) _Pragma("unroll") for (int k = 0; k < 2; ++k) dst[m][k] = *(const PG8_LAS bf16x8*)(lds + PG8_SA(b, h) + aoff + m * 2048 + k * 1024); } while (0)
#define PG8_LDB(dst, b, h) do { _Pragma("unroll") for (int n = 0; n < 2; ++n) _Pragma("unroll") for (int k = 0; k < 2; ++k) dst[n][k] = *(const PG8_LAS bf16x8*)(lds + PG8_SB(b, h) + boff + n * 2048 + k * 1024); } while (0)
#define PG8_MMA(ai, bj, At, Bt) do { __builtin_amdgcn_s_setprio(1); _Pragma("unroll") for (int m = 0; m < 4; ++m) _Pragma("unroll") for (int n = 0; n < 2; ++n) _Pragma("unroll") for (int k = 0; k < 2; ++k) \
        acc[ai][bj][m][n] = __builtin_amdgcn_mfma_f32_16x16x32_bf16(Bt[n][k], At[m][k], acc[ai][bj][m][n], 0, 0, 0); __builtin_amdgcn_s_setprio(0); } while (0)
#define PG8_WAIT_V(n) asm volatile("s_waitcnt vmcnt(" #n ")" ::: "memory")
#define PG8_WAIT_L(n) asm volatile("s_waitcnt lgkmcnt(" #n ")" ::: "memory")
#define PG8_BAR __builtin_amdgcn_s_barrier()
#define PG8_SCHED __builtin_amdgcn_sched_barrier(0)
    Unit cur, nxt; int ui = 0;
    if (!S.next(0, cur)) return;
    f32x4 acc[2][2][4][2];
#pragma unroll
    for (int a = 0; a < 2; ++a)
#pragma unroll
        for (int b = 0; b < 2; ++b)
#pragma unroll
            for (int m = 0; m < 4; ++m)
#pragma unroll
                for (int n = 0; n < 2; ++n) acc[a][b][m][n] = (f32x4){0.f, 0.f, 0.f, 0.f};
    bf16x8 At[4][2], B0[2][2], B1[2][2];
    const char* cA = (const char*)g.A + (size_t)cur.pm * tstep; const char* cB = (const char*)g.Bt + (size_t)cur.pn * tstep;
    S.a_ready(cur);
    if constexpr (SP2) {
        PG8_STAGE(PG8_SB(0, 0), cB, voffB); PG8_STAGE(PG8_SB(0, 1), cB + hstep, voffB); PG8_STAGE(PG8_SA(0, 0), cA, voffA); PG8_STAGE(PG8_SA(0, 1), cA + hstep, voffA);
        if (wr == 1) PG8_BAR;
        PG8_WAIT_V(2); PG8_BAR;
        PG8_STAGE(PG8_SB(1, 0), cB + kstep, voffB); PG8_STAGE(PG8_SA(1, 0), cA + kstep, voffA); PG8_STAGE(PG8_SB(1, 1), cB + hstep + kstep, voffB);
        PG8_WAIT_V(6); PG8_BAR;
    } else {
        PG8_STAGE(PG8_SB(0, 0), cB, voffB); PG8_STAGE(PG8_SA(0, 0), cA, voffA); PG8_STAGE(PG8_SB(0, 1), cB + hstep, voffB); PG8_STAGE(PG8_SA(0, 1), cA + hstep, voffA);
        if (wr == 1) PG8_BAR;
        PG8_WAIT_V(4); PG8_BAR;
        PG8_STAGE(PG8_SB(1, 0), cB + kstep, voffB); PG8_STAGE(PG8_SA(1, 0), cA + kstep, voffA); PG8_STAGE(PG8_SB(1, 1), cB + hstep + kstep, voffB);
        PG8_WAIT_V(6); PG8_BAR;
    }
    for (;;) {
        const bool has_next = S.next(ui + 1, nxt);
        const char* nA = has_next ? (const char*)g.A + (size_t)nxt.pm * tstep : cA; const char* nB = has_next ? (const char*)g.Bt + (size_t)nxt.pn * tstep : cB;
        for (int t = 0; t < nt; t += 2) {
            const bool last = (t == nt - 2);
            const char* a1 = cA + (size_t)(t + 1) * kstep;
            const char* a2 = last ? nA : cA + (size_t)(t + 2) * kstep; const char* b2 = last ? nB : cB + (size_t)(t + 2) * kstep;
            const char* a3 = a2 + kstep; const char* b3 = b2 + kstep;
            if (last && has_next) S.a_ready(nxt);
            if constexpr (SP2) {
            PG8_LDB(B0, 0, 0); PG8_LDB(B1, 0, 1); PG8_SCHED; PG8_LDA(At, 0, 0); PG8_STAGE(PG8_SA(1, 1), a1 + hstep, voffA);
            PG8_WAIT_V(8); PG8_WAIT_L(0); PG8_BAR; PG8_MMA(0, 0, At, B0); PG8_MMA(0, 1, At, B1); PG8_BAR; PG8_SCHED;
            PG8_LDA(At, 0, 1); PG8_STAGE(PG8_SB(0, 0), b2, voffB); PG8_STAGE(PG8_SB(0, 1), b2 + hstep, voffB); PG8_STAGE(PG8_SA(0, 0), a2, voffA);
            PG8_WAIT_V(8); PG8_WAIT_L(0); PG8_BAR; PG8_MMA(1, 0, At, B0); PG8_MMA(1, 1, At, B1); PG8_BAR; PG8_SCHED;
            PG8_LDB(B0, 1, 0); PG8_LDB(B1, 1, 1); PG8_SCHED; PG8_LDA(At, 1, 0); PG8_STAGE(PG8_SA(0, 1), a2 + hstep, voffA);
            PG8_WAIT_V(8); PG8_WAIT_L(0); PG8_BAR; PG8_MMA(0, 0, At, B0); PG8_MMA(0, 1, At, B1); PG8_BAR; PG8_SCHED;
            PG8_LDA(At, 1, 1); PG8_STAGE(PG8_SB(1, 0), b3, voffB); PG8_STAGE(PG8_SB(1, 1), b3 + hstep, voffB); PG8_STAGE(PG8_SA(1, 0), a3, voffA);
            PG8_WAIT_V(8); PG8_WAIT_L(0); PG8_BAR; PG8_MMA(1, 0, At, B0); PG8_MMA(1, 1, At, B1); PG8_BAR; PG8_SCHED;
            } else {
            PG8_LDB(B0, 0, 0); PG8_SCHED; PG8_LDA(At, 0, 0); PG8_STAGE(PG8_SA(1, 1), a1 + hstep, voffA);
            PG8_WAIT_L(8); PG8_BAR; PG8_WAIT_L(0); PG8_MMA(0, 0, At, B0); PG8_BAR; PG8_SCHED;
            PG8_LDB(B1, 0, 1); PG8_STAGE(PG8_SB(0, 0), b2, voffB);
            PG8_BAR; PG8_WAIT_L(0); PG8_MMA(0, 1, At, B1); PG8_BAR;
            PG8_LDA(At, 0, 1); PG8_STAGE(PG8_SA(0, 0), a2, voffA);
            PG8_BAR; PG8_WAIT_L(0); PG8_MMA(1, 0, At, B0); PG8_BAR; PG8_SCHED;
            PG8_STAGE(PG8_SB(0, 1), b2 + hstep, voffB);
            PG8_WAIT_V(6); PG8_BAR; PG8_MMA(1, 1, At, B1); PG8_BAR;
            PG8_LDB(B0, 1, 0); PG8_SCHED; PG8_LDA(At, 1, 0); PG8_STAGE(PG8_SA(0, 1), a2 + hstep, voffA);
            PG8_WAIT_L(8); PG8_BAR; PG8_WAIT_L(0); PG8_MMA(0, 0, At, B0); PG8_BAR; PG8_SCHED;
            PG8_LDB(B1, 1, 1); PG8_STAGE(PG8_SB(1, 0), b3, voffB);
            PG8_BAR; PG8_WAIT_L(0); PG8_MMA(0, 1, At, B1); PG8_BAR;
            PG8_LDA(At, 1, 1); PG8_STAGE(PG8_SA(1, 0), a3, voffA);
            PG8_BAR; PG8_WAIT_L(0); PG8_MMA(1, 0, At, B0); PG8_BAR; PG8_SCHED;
            PG8_STAGE(PG8_SB(1, 1), b3 + hstep, voffB);
            PG8_WAIT_V(6); PG8_BAR; PG8_MMA(1, 1, At, B1); PG8_BAR;
            }
        }
        if constexpr (ALIGN_EPI) { if (wr == 0) PG8_BAR; }
        if constexpr (!Epi::AFTER_DRAIN) { E(acc, cur, wr, wc, fr, fq); S.done(cur); }
        if (!has_next) break;
#pragma unroll
        for (int a = 0; a < 2; ++a)
#pragma unroll
            for (int b = 0; b < 2; ++b)
#pragma unroll
                for (int m = 0; m < 4; ++m)
#pragma unroll
                    for (int n = 0; n < 2; ++n) acc[a][b][m][n] = (f32x4){0.f, 0.f, 0.f, 0.f};
        cur = nxt; cA = nA; cB = nB; ++ui;
        if constexpr (ALIGN_EPI) { if (wr == 1) PG8_BAR; }
    }
    PG8_WAIT_V(0);
    if constexpr (!ALIGN_EPI) { if (wr == 0) PG8_BAR; }
    PG8_BAR;
    if constexpr (Epi::AFTER_DRAIN) { E.fused(acc, cur, wr, wc, fr, fq, lds, wid, lane); S.done(cur); }
#undef PG8_SA
#undef PG8_SB
#undef PG8_STAGE
#undef PG8_LDA
#undef PG8_LDB
#undef PG8_MMA
#undef PG8_WAIT_V
#undef PG8_WAIT_L
#undef PG8_BAR
#undef PG8_SCHED
}
}

#define LAS __attribute__((address_space(3)))
typedef unsigned short bf16_t;
typedef short bf16x8 __attribute__((ext_vector_type(8)));
typedef float f32x4 __attribute__((ext_vector_type(4)));
typedef float f32x2 __attribute__((ext_vector_type(2)));
typedef float f32x16 __attribute__((ext_vector_type(16)));
typedef unsigned u32x4 __attribute__((ext_vector_type(4)));
typedef unsigned u32x2 __attribute__((ext_vector_type(2)));
#define MFMA32(a, b, c) __builtin_amdgcn_mfma_f32_32x32x16_bf16((a), (b), (c), 0, 0, 0)

constexpr int DM = 1024, SEQ = 16384, NBP = 2, DEPTH = 4, DB = 16, DS = 32, PAST = 2048;
constexpr int MP = NBP * SEQ, MS = DB * DS, MT = MP + MS;
constexpr int INW = 3584, DFF = 2816, NMOD = 6144, NBI = 18;
constexpr float EPS = 1e-6f;
constexpr size_t OFF_YP = 0, OFF_YS = 33554432, OFF_KP = 34078720, OFF_VP = 101187584, OFF_RP = 168296448,
                 OFF_KS = 168820736, OFF_VS = 169869312, OFF_RS = 170917888;
constexpr size_t MiB = 1u << 20;
constexpr size_t WS_MOD = 0, MOD_BYTES = 2 * MiB;
constexpr size_t WS_ROPE = 2 * MiB;
constexpr size_t WS_WIN = 10 * MiB, WS_WOUT = 38 * MiB, WS_WFI = 46 * MiB, WS_WFO = 90 * MiB;
constexpr size_t WS_X = 112 * MiB;
constexpr size_t WS_H = 242 * MiB;
constexpr size_t WS_O = 307 * MiB;
constexpr size_t WS_QKV = 372 * MiB;
constexpr size_t WS_U = 600 * MiB;
constexpr size_t WS_END = 616 * MiB;
constexpr int LDS_BYTES = 147456;

struct Params { const float* in[18]; float* out; unsigned char* ws; };

__device__ __forceinline__ unsigned f2bf(float f) { unsigned u = __builtin_bit_cast(unsigned, f); return (u + 0x7fffu + ((u >> 16) & 1u)) >> 16; }
__device__ __forceinline__ unsigned pk2(float lo, float hi) { return f2bf(lo) | (f2bf(hi) << 16); }
__device__ __forceinline__ float bf2f(unsigned h) { return __builtin_bit_cast(float, h << 16); }
__device__ __forceinline__ bf16x8 pack8(f32x4 a, f32x4 b) { u32x4 p; p.x = pk2(a.x, a.y); p.y = pk2(a.z, a.w); p.z = pk2(b.x, b.y); p.w = pk2(b.z, b.w); return __builtin_bit_cast(bf16x8, p); }
__device__ __forceinline__ float wave_sum(float v) {
#pragma unroll
    for (int o = 1; o < 64; o <<= 1) v += __shfl_xor(v, o);
    return v;
}
__device__ __forceinline__ float silu_f(float x) { return x * __builtin_amdgcn_rcpf(1.f + __expf(-x)); }
__device__ __forceinline__ int batch_of(int row) { return row < MP ? (row >> 14) : 2 + ((row - MP) >> 5); }

struct EpiQKV {
    static constexpr bool PERM = true, AFTER_DRAIN = false;
    bf16_t* QKV; float* out; int layer;
    __device__ __forceinline__ void operator()(const pg8::f32x4 (&acc)[2][2][4][2], const pg8::Unit& u, int wr, int wc, int fr, int fq) const {
        const int row0 = u.pm * 256 + wr * 64 + fr, col0 = u.pn * 256 + wc * 32 + 8 * fq;
        const bool kv = (u.pn >= 2 && u.pn < 6);
        const size_t vsel = (u.pn >= 4) ? 1 : 0;
        const size_t obase = (u.pm < 128) ? OFF_KP + vsel * (OFF_VP - OFF_KP) + (size_t)layer * MP * 512 + (size_t)row0 * 512
                                          : OFF_KS + vsel * (OFF_VS - OFF_KS) + (size_t)layer * MS * 512 + (size_t)(row0 - MP) * 512;
#pragma unroll
        for (int ai = 0; ai < 2; ++ai)
#pragma unroll
            for (int m = 0; m < 4; ++m) {
                const int row = row0 + ai * 128 + m * 16;
#pragma unroll
                for (int bj = 0; bj < 2; ++bj) {
                    const int col = col0 + bj * 128;
                    const pg8::f32x4 v0 = acc[ai][bj][m][0], v1 = acc[ai][bj][m][1];
                    u32x4 w; w.x = pg8::cvt_pk_bf16(v0[0], v0[1]); w.y = pg8::cvt_pk_bf16(v0[2], v0[3]); w.z = pg8::cvt_pk_bf16(v1[0], v1[1]); w.w = pg8::cvt_pk_bf16(v1[2], v1[3]);
                    *(u32x4*)(QKV + (size_t)row * INW + col) = w;
                    if (kv) {
                        const int c = col & 511;
                        float* dst = out + obase + (size_t)(ai * 128 + m * 16) * 512 + c;
                        *(pg8::f32x4*)dst = v0; *(pg8::f32x4*)(dst + 4) = v1;
                    }
                }
                asm volatile("" ::: "memory");
            }
    }
};
struct EpiResid {
    static constexpr bool PERM = false, AFTER_DRAIN = false;
    const float* base_p; const float* base_s;
    float* X; const float* gate;
    __device__ __forceinline__ void operator()(const pg8::f32x4 (&acc)[2][2][4][2], const pg8::Unit& u, int wr, int wc, int fr, int fq) const {
        const int col0 = u.pn * 256 + wc * 32 + 4 * fq;
#pragma unroll
        for (int ai = 0; ai < 2; ++ai)
#pragma unroll
            for (int m = 0; m < 4; ++m) {
                const int row = u.pm * 256 + ai * 128 + wr * 64 + m * 16 + fr;
                const float* br = base_p ? (row < MP ? base_p + (size_t)row * DM : base_s + (size_t)(row - MP) * DM) : X + (size_t)row * DM;
                const float* gr = gate + (size_t)batch_of(row) * NMOD; float* xr = X + (size_t)row * DM;
#pragma unroll
                for (int bj = 0; bj < 2; ++bj)
#pragma unroll
                    for (int n = 0; n < 2; ++n) { const int c = col0 + bj * 128 + n * 16;
                        const pg8::f32x4 b = *(const pg8::f32x4*)(br + c), g = *(const pg8::f32x4*)(gr + c);
                        *(pg8::f32x4*)(xr + c) = b + g * acc[ai][bj][m][n]; }
                asm volatile("" ::: "memory");
            }
    }
};
struct EpiSwiGLU {
    static constexpr bool PERM = true, AFTER_DRAIN = false;
    bf16_t* ACT;
    __device__ __forceinline__ void operator()(const pg8::f32x4 (&acc)[2][2][4][2], const pg8::Unit& u, int wr, int wc, int fr, int fq) const {
        const int col0 = u.pn * 128 + wc * 32 + 8 * fq;
#pragma unroll
        for (int ai = 0; ai < 2; ++ai)
#pragma unroll
            for (int m = 0; m < 4; ++m) {
                const int row = u.pm * 256 + ai * 128 + wr * 64 + m * 16 + fr;
                const pg8::f32x4 g0 = acc[ai][0][m][0], g1 = acc[ai][0][m][1], u0 = acc[ai][1][m][0], u1 = acc[ai][1][m][1];
                float r[8];
#pragma unroll
                for (int j = 0; j < 4; ++j) { r[j] = silu_f(g0[j]) * u0[j]; r[4 + j] = silu_f(g1[j]) * u1[j]; }
                u32x4 w; w.x = pg8::cvt_pk_bf16(r[0], r[1]); w.y = pg8::cvt_pk_bf16(r[2], r[3]); w.z = pg8::cvt_pk_bf16(r[4], r[5]); w.w = pg8::cvt_pk_bf16(r[6], r[7]);
                *(u32x4*)(ACT + (size_t)row * DFF + col0) = w;
                asm volatile("" ::: "memory");
            }
    }
};

__device__ __forceinline__ void transpose_item(const float* W, int K, int N, bf16_t* WT, LAS float* scr, int item, int lane, bool perm) {
    const int nblk = N / 32, kb = item / nblk, nb = item % nblk, k0 = 64 * kb, n0 = 32 * nb;
    int p0 = n0;
    if (perm) { if (n0 < DFF) p0 = (n0 >> 7) * 256 + (n0 & 127); else { const int n1 = n0 - DFF; p0 = (n1 >> 7) * 256 + 128 + (n1 & 127); } }
#pragma unroll 8
    for (int i = 0; i < 32; ++i) { const int kk = 2 * i + (lane >> 5); scr[kk * 33 + (lane & 31)] = W[(size_t)(k0 + kk) * N + n0 + (lane & 31)]; }
    asm volatile("s_waitcnt lgkmcnt(0)" ::: "memory"); __builtin_amdgcn_wave_barrier();
    const int c = lane & 7;
#pragma unroll
    for (int j = 0; j < 4; ++j) { const int n = (lane >> 3) + 8 * j; const LAS float* s = scr + (8 * c) * 33 + n;
        u32x4 o; o.x = pk2(s[0 * 33], s[1 * 33]); o.y = pk2(s[2 * 33], s[3 * 33]); o.z = pk2(s[4 * 33], s[5 * 33]); o.w = pk2(s[6 * 33], s[7 * 33]);
        *(u32x4*)(WT + (size_t)(p0 + n) * K + k0 + 8 * c) = o; }
    asm volatile("s_waitcnt lgkmcnt(0)" ::: "memory"); __builtin_amdgcn_wave_barrier();
}

__device__ __forceinline__ void p0_phase(const Params& P, LAS unsigned char* lds, int tid, int lane, int wave) {
    LAS float* sc = (LAS float*)lds;
    for (int i = tid; i < NBI * DM; i += 512) { const int b = i >> 10, k = i & 1023; const float c = b < 2 ? P.in[5][b * DM + k] : P.in[6][(b - 2) * DM + k]; sc[i] = silu_f(c); }
    __syncthreads();
    const int gw = blockIdx.x * 8 + wave, NGW = gridDim.x * 8;
    float* MOD = (float*)(P.ws + WS_MOD);
    for (int it = gw; it < 768; it += NGW) {
        const int l = it / 192, r = it % 192, cb = r >> 3, kc = r & 7;
        f32x4 acc[NBI];
#pragma unroll
        for (int b = 0; b < NBI; ++b) acc[b] = (f32x4){0.f, 0.f, 0.f, 0.f};
        const float* wp = P.in[9] + ((size_t)l * DM + kc * 128) * NMOD + cb * 256 + lane * 4;
        const LAS float* scp = sc + kc * 128;
#pragma unroll 4
        for (int k = 0; k < 128; ++k) { const f32x4 w = *(const f32x4*)(wp + (size_t)k * NMOD);
#pragma unroll
            for (int b = 0; b < NBI; ++b) acc[b] += scp[b * DM + k] * w; }
        if (kc == 0) { const f32x4 bv = *(const f32x4*)(P.in[10] + (size_t)l * NMOD + cb * 256 + lane * 4);
#pragma unroll
            for (int b = 0; b < NBI; ++b) acc[b] += bv; }
        float* mp = MOD + (size_t)l * NBI * NMOD + cb * 256 + lane * 4;
#pragma unroll
        for (int b = 0; b < NBI; ++b) { atomicAdd(mp + b * NMOD + 0, acc[b].x); atomicAdd(mp + b * NMOD + 1, acc[b].y); atomicAdd(mp + b * NMOD + 2, acc[b].z); atomicAdd(mp + b * NMOD + 3, acc[b].w); }
    }
    LAS float* scr = (LAS float*)(lds + 73728 + wave * 8448);
    constexpr int I_IN = 16 * 112, I_OUT = 16 * 32, I_FI = 16 * 176, I_FO = 44 * 32, I_L = I_IN + I_OUT + I_FI + I_FO;
    for (int it = gw; it < DEPTH * I_L; it += NGW) {
        const int l = it / I_L; int r = it % I_L;
        if (r < I_IN) { transpose_item(P.in[11] + (size_t)l * DM * INW, DM, INW, (bf16_t*)(P.ws + WS_WIN) + (size_t)l * INW * DM, scr, r, lane, false); continue; } r -= I_IN;
        if (r < I_OUT) { transpose_item(P.in[14] + (size_t)l * DM * DM, DM, DM, (bf16_t*)(P.ws + WS_WOUT) + (size_t)l * DM * DM, scr, r, lane, false); continue; } r -= I_OUT;
        if (r < I_FI) { transpose_item(P.in[15] + (size_t)l * DM * 2 * DFF, DM, 2 * DFF, (bf16_t*)(P.ws + WS_WFI) + (size_t)l * 2 * DFF * DM, scr, r, lane, true); continue; } r -= I_FI;
        transpose_item(P.in[16] + (size_t)l * DFF * DM, DFF, DM, (bf16_t*)(P.ws + WS_WFO) + (size_t)l * DM * DFF, scr, r, lane, false);
    }
    f32x2* ROPE = (f32x2*)(P.ws + WS_ROPE);
    for (int idx = blockIdx.x * 512 + tid; idx < SEQ * 64; idx += gridDim.x * 512) {
        const int pos = idx >> 6, i = idx & 63;
        const float inv = exp2f(-(float)i * (13.287712379549449f / 64.f));
        const float ang = (float)pos * inv;
        double rev = (double)ang * 0.15915494309189535; rev -= floor(rev);
        const float rf = (float)rev;
        ROPE[idx] = (f32x2){__builtin_amdgcn_cosf(rf), __builtin_amdgcn_sinf(rf)};
    }
}

template <bool FINAL>
__device__ __forceinline__ void norm_phase(const Params& P, int l, bool from_input, const float* gain, int sh_off, int sc_off, int lane, int wave) {
    const int gw = blockIdx.x * 8 + wave, NGW = gridDim.x * 8;
    const float* MOD = (const float*)(P.ws + WS_MOD) + (size_t)l * NBI * NMOD;
    const float* X = (const float*)(P.ws + WS_X); bf16_t* H = (bf16_t*)(P.ws + WS_H);
    f32x4 g[4];
#pragma unroll
    for (int j = 0; j < 4; ++j) g[j] = *(const f32x4*)(gain + 4 * lane + 256 * j);
    for (int m = gw; m < MT; m += NGW) {
        const float* xr = (!FINAL && from_input) ? (m < MP ? P.in[0] + (size_t)m * DM : P.in[1] + (size_t)(m - MP) * DM) : X + (size_t)m * DM;
        f32x4 v[4]; float ss = 0.f;
#pragma unroll
        for (int j = 0; j < 4; ++j) { v[j] = *(const f32x4*)(xr + 4 * lane + 256 * j); ss += (v[j].x * v[j].x + v[j].y * v[j].y) + (v[j].z * v[j].z + v[j].w * v[j].w); }
        const float rstd = rsqrtf(wave_sum(ss) * (1.f / DM) + EPS);
        if (FINAL) {
            float* o = P.out + (size_t)m * DM;
#pragma unroll
            for (int j = 0; j < 4; ++j) *(f32x4*)(o + 4 * lane + 256 * j) = v[j] * rstd * g[j];
        } else {
            const float* mr = MOD + (size_t)batch_of(m) * NMOD;
#pragma unroll
            for (int j = 0; j < 4; ++j) { const int c = 4 * lane + 256 * j;
                const f32x4 sc = *(const f32x4*)(mr + sc_off + c), sh = *(const f32x4*)(mr + sh_off + c);
                const f32x4 hh = v[j] * rstd * g[j] * (1.f + sc) + sh;
                u32x2 w; w.x = pk2(hh.x, hh.y); w.y = pk2(hh.z, hh.w);
                *(u32x2*)(H + (size_t)m * DM + c) = w; }
        }
    }
}

__device__ __forceinline__ void sb_unit(const Params& P, int l, int u, LAS unsigned char* lds, int tid, int lane, int wave) {
    const bf16_t* QKV = (const bf16_t*)(P.ws + WS_QKV);
    const int h = wave, l32 = lane & 31, hf = lane >> 5;
    const bool samp = u >= 1024;
    int qrow0, nsteps; const float* ck = nullptr; const float* cv = nullptr;
    if (!samp) { const int b = u >> 9, qb = u & 511; qrow0 = b * SEQ + qb * 32; nsteps = qb + 1; }
    else { const int bs = u - 1024; qrow0 = MP + bs * 32; nsteps = 65; ck = P.in[2] + (size_t)(l * DB + bs) * PAST * 512; cv = P.in[3] + (size_t)(l * DB + bs) * PAST * 512; }
    bf16x8 qf[4];
#pragma unroll
    for (int ks = 0; ks < 4; ++ks) qf[ks] = *(const bf16x8*)(QKV + (size_t)(qrow0 + l32) * INW + h * 64 + ks * 16 + hf * 8);
    f32x16 O0, O1;
#pragma unroll
    for (int r = 0; r < 16; ++r) { O0[r] = 0.f; O1[r] = 0.f; }
    float cum = 0.f;
    LAS unsigned char* vt = lds + 66048 + wave * 4608;
    for (int s = 0; s < nsteps; ++s) {
        bf16x8 kf[4];
        if (!samp || s == 0) {
            const int krow0 = samp ? qrow0 : qrow0 - s * 32;
#pragma unroll
            for (int ks = 0; ks < 4; ++ks) kf[ks] = *(const bf16x8*)(QKV + (size_t)(krow0 + l32) * INW + 512 + h * 64 + ks * 16 + hf * 8);
#pragma unroll
            for (int it = 0; it < 4; ++it) { const int id = it * 64 + lane, key = id >> 3, ch = id & 7;
                const bf16x8 v = *(const bf16x8*)(QKV + (size_t)(krow0 + key) * INW + 1024 + h * 64 + ch * 8);
                *(LAS bf16x8*)(vt + key * 144 + ch * 16) = v; }
        } else {
            const int kpos0 = (64 - s) * 32;
#pragma unroll
            for (int ks = 0; ks < 4; ++ks) { const float* p = ck + (size_t)(kpos0 + l32) * 512 + h * 64 + ks * 16 + hf * 8; kf[ks] = pack8(*(const f32x4*)p, *(const f32x4*)(p + 4)); }
#pragma unroll
            for (int it = 0; it < 4; ++it) { const int id = it * 64 + lane, key = id >> 3, ch = id & 7;
                const float* p = cv + (size_t)(kpos0 + key) * 512 + h * 64 + ch * 8;
                *(LAS bf16x8*)(vt + key * 144 + ch * 16) = pack8(*(const f32x4*)p, *(const f32x4*)(p + 4)); }
        }
        asm volatile("s_waitcnt lgkmcnt(0)" ::: "memory"); __builtin_amdgcn_wave_barrier();
        f32x16 S;
#pragma unroll
        for (int r = 0; r < 16; ++r) S[r] = 0.f;
#pragma unroll
        for (int ks = 0; ks < 4; ++ks) S = MFMA32(kf[ks], qf[ks], S);
        float L[16], lb[16]; bool valid[16];
#pragma unroll
        for (int r = 0; r < 16; ++r) {
            const float z = S[r] * 0.125f;
            const float sp = fmaxf(z, 0.f) + __logf(1.f + __expf(-fabsf(z)));
            const int key = (r >> 2) * 8 + hf * 4 + (r & 3);
            valid[r] = (s != 0) || (key < l32);
            L[r] = valid[r] ? -sp : 0.f; lb[r] = z - sp;
        }
        float T[4], Pp[4];
#pragma unroll
        for (int g = 0; g < 4; ++g) { T[g] = (L[4 * g] + L[4 * g + 1]) + (L[4 * g + 2] + L[4 * g + 3]); Pp[g] = __shfl_xor(T[g], 32); }
        float later[4]; float tot = 0.f;
#pragma unroll
        for (int g = 3; g >= 0; --g) { later[g] = tot; tot += T[g] + Pp[g]; }
        float w[16];
#pragma unroll
        for (int g = 0; g < 4; ++g) {
            const float s3 = cum + later[g] + (hf == 0 ? Pp[g] : 0.f);
            const float s2 = s3 + L[4 * g + 3], s1 = s2 + L[4 * g + 2], s0 = s1 + L[4 * g + 1];
            w[4 * g + 3] = valid[4 * g + 3] ? __expf(lb[4 * g + 3] + s3) : 0.f;
            w[4 * g + 2] = valid[4 * g + 2] ? __expf(lb[4 * g + 2] + s2) : 0.f;
            w[4 * g + 1] = valid[4 * g + 1] ? __expf(lb[4 * g + 1] + s1) : 0.f;
            w[4 * g + 0] = valid[4 * g + 0] ? __expf(lb[4 * g + 0] + s0) : 0.f;
        }
        cum += tot;
#pragma unroll
        for (int c = 0; c < 2; ++c) {
            u32x4 pw; pw.x = pk2(w[8 * c], w[8 * c + 1]); pw.y = pk2(w[8 * c + 2], w[8 * c + 3]); pw.z = pk2(w[8 * c + 4], w[8 * c + 5]); pw.w = pk2(w[8 * c + 6], w[8 * c + 7]);
            const bf16x8 pa = __builtin_bit_cast(bf16x8, pw);
#pragma unroll
            for (int dt = 0; dt < 2; ++dt) {
                bf16x8 vb;
#pragma unroll
                for (int i = 0; i < 8; ++i) { const int key = 16 * c + 8 * (i >> 2) + 4 * hf + (i & 3); vb[i] = *(const LAS short*)(vt + key * 144 + (l32 + 32 * dt) * 2); }
                if (dt == 0) O0 = MFMA32(pa, vb, O0); else O1 = MFMA32(pa, vb, O1);
            }
        }
        asm volatile("" ::: "memory");
        if (__all(cum < -110.f)) break;
    }
    LAS float* oa = (LAS float*)lds;
#pragma unroll
    for (int r = 0; r < 16; ++r) { const int q = (r >> 2) * 8 + hf * 4 + (r & 3); oa[q * 516 + h * 64 + l32] = O0[r]; oa[q * 516 + h * 64 + 32 + l32] = O1[r]; }
    __syncthreads();
    bf16_t* Ob = (bf16_t*)(P.ws + WS_O);
    const float* gsb = P.in[12] + (size_t)l * 512;
#pragma unroll
    for (int rr = 0; rr < 4; ++rr) {
        const int q = wave * 4 + rr;
        const f32x4 a = *(const LAS f32x4*)(oa + q * 516 + 4 * lane), b = *(const LAS f32x4*)(oa + q * 516 + 256 + 4 * lane);
        float ss = (a.x * a.x + a.y * a.y) + (a.z * a.z + a.w * a.w) + (b.x * b.x + b.y * b.y) + (b.z * b.z + b.w * b.w);
        const float rstd = rsqrtf(wave_sum(ss) * (1.f / 512.f) + EPS);
        const f32x4 ga = *(const f32x4*)(gsb + 4 * lane), gb = *(const f32x4*)(gsb + 256 + 4 * lane);
        const f32x4 ya = a * rstd * ga, yb = b * rstd * gb;
        u32x2 wa, wb; wa.x = pk2(ya.x, ya.y); wa.y = pk2(ya.z, ya.w); wb.x = pk2(yb.x, yb.y); wb.y = pk2(yb.z, yb.w);
        *(u32x2*)(Ob + (size_t)(qrow0 + q) * DM + 4 * lane) = wa; *(u32x2*)(Ob + (size_t)(qrow0 + q) * DM + 256 + 4 * lane) = wb;
    }
    __syncthreads();
}

__device__ __forceinline__ void ret_unit(const Params& P, int l, LAS unsigned char* lds, int tid, int lane, int wave,
                                         int row0, int pos0, int nchunks, int L, int h, const float* init, float* outst, bool state_only) {
    const bf16_t* QKV = (const bf16_t*)(P.ws + WS_QKV); bf16_t* Ob = (bf16_t*)(P.ws + WS_O);
    const f32x2* ROPE = (const f32x2*)(P.ws + WS_ROPE);
    const float lg2 = log2f(1.f - exp2f(-5.f - (float)h));
    LAS unsigned char *Qn = lds, *Kn = lds + 17408, *KdT = lds + 34816, *VT = lds + 53248, *SbT = lds + 71680, *Pm = lds + 106496;
    LAS float* of = (LAS float*)lds;
    const int l32 = lane & 31, hf = lane >> 5;
    const int sdt = wave >> 1, set0 = (wave & 1) * 2;
    f32x16 S0, S1;
#pragma unroll
    for (int r = 0; r < 16; ++r) { S0[r] = 0.f; S1[r] = 0.f; }
    if (init) {
        const float* ip = init + (sdt * 32 + hf * 4) * 128 + set0 * 32 + l32;
#pragma unroll
        for (int r = 0; r < 16; ++r) { S0[r] = ip[((r >> 2) * 8 + (r & 3)) * 128]; S1[r] = ip[((r >> 2) * 8 + (r & 3)) * 128 + 32]; if ((r & 3) == 3) asm volatile("" ::: "memory"); }
    }
    if (!state_only) {
#pragma unroll
        for (int g = 0; g < 4; ++g) { const int d0 = sdt * 32 + g * 8 + hf * 4;
            u32x2 a, b; a.x = pk2(S0[4 * g], S0[4 * g + 1]); a.y = pk2(S0[4 * g + 2], S0[4 * g + 3]); b.x = pk2(S1[4 * g], S1[4 * g + 1]); b.y = pk2(S1[4 * g + 2], S1[4 * g + 3]);
            *(LAS u32x2*)(SbT + (set0 * 32 + l32) * 272 + d0 * 2) = a; *(LAS u32x2*)(SbT + ((set0 + 1) * 32 + l32) * 272 + d0 * 2) = b; }
    }
    const float gL = exp2f((float)L * lg2);
    const int lt = wave >> 2, et = wave & 3;
    const int l32_0 = l32, hf_0 = hf, tid_0 = tid; const float lg2_0 = lg2;
#pragma unroll 1
    for (int c = 0; c < nchunks; ++c) {
        int l32 = l32_0, hf = hf_0, tid = tid_0; float lg2 = lg2_0;
        asm volatile("" : "+v"(l32), "+v"(hf), "+v"(tid), "+v"(lg2));
        {
            const int t = tid >> 3, i0 = (tid & 7) * 8; const bool ok = t < L;
            const size_t row = (size_t)(row0 + c * 64 + t);
            const float kd = ok ? exp2f((float)(L - 1 - t) * lg2) : 0.f;
            f32x2 cs[8];
#pragma unroll
            for (int i = 0; i < 8; ++i) cs[i] = ok ? ROPE[(size_t)(pos0 + c * 64 + t) * 64 + i0 + i] : (f32x2){0.f, 0.f};
            {
                bf16x8 k1 = {0, 0, 0, 0, 0, 0, 0, 0}, k2 = {0, 0, 0, 0, 0, 0, 0, 0};
                if (ok) { k1 = *(const bf16x8*)(QKV + row * INW + 2048 + h * 128 + i0); k2 = *(const bf16x8*)(QKV + row * INW + 2048 + h * 128 + 64 + i0); }
                float o1[8], o2[8];
#pragma unroll
                for (int i = 0; i < 8; ++i) { const float x1 = bf2f((unsigned short)k1[i]), x2 = bf2f((unsigned short)k2[i]);
                    o1[i] = (x1 * cs[i].x - x2 * cs[i].y) * 0.08838834764831845f; o2[i] = (x1 * cs[i].y + x2 * cs[i].x) * 0.08838834764831845f; }
                if (!state_only) {
                    u32x4 a, b; a.x = pk2(o1[0], o1[1]); a.y = pk2(o1[2], o1[3]); a.z = pk2(o1[4], o1[5]); a.w = pk2(o1[6], o1[7]);
                    b.x = pk2(o2[0], o2[1]); b.y = pk2(o2[2], o2[3]); b.z = pk2(o2[4], o2[5]); b.w = pk2(o2[6], o2[7]);
                    *(LAS u32x4*)(Kn + t * 272 + i0 * 2) = a; *(LAS u32x4*)(Kn + t * 272 + (64 + i0) * 2) = b;
                }
#pragma unroll
                for (int i = 0; i < 8; ++i) { *(LAS unsigned short*)(KdT + (i0 + i) * 144 + t * 2) = (unsigned short)f2bf(o1[i] * kd); *(LAS unsigned short*)(KdT + (64 + i0 + i) * 144 + t * 2) = (unsigned short)f2bf(o2[i] * kd); }
            }
            if (!state_only) {
                bf16x8 q1 = {0, 0, 0, 0, 0, 0, 0, 0}, q2 = {0, 0, 0, 0, 0, 0, 0, 0};
                if (ok) { q1 = *(const bf16x8*)(QKV + row * INW + 1536 + h * 128 + i0); q2 = *(const bf16x8*)(QKV + row * INW + 1536 + h * 128 + 64 + i0); }
                float o1[8], o2[8];
#pragma unroll
                for (int i = 0; i < 8; ++i) { const float x1 = bf2f((unsigned short)q1[i]), x2 = bf2f((unsigned short)q2[i]);
                    o1[i] = x1 * cs[i].x - x2 * cs[i].y; o2[i] = x1 * cs[i].y + x2 * cs[i].x; }
                u32x4 a, b; a.x = pk2(o1[0], o1[1]); a.y = pk2(o1[2], o1[3]); a.z = pk2(o1[4], o1[5]); a.w = pk2(o1[6], o1[7]);
                b.x = pk2(o2[0], o2[1]); b.y = pk2(o2[2], o2[3]); b.z = pk2(o2[4], o2[5]); b.w = pk2(o2[6], o2[7]);
                *(LAS u32x4*)(Qn + t * 272 + i0 * 2) = a; *(LAS u32x4*)(Qn + t * 272 + (64 + i0) * 2) = b;
            }
#pragma unroll
            for (int it = 0; it < 2; ++it) { const int id = tid + 512 * it, t2 = id >> 4, ch = id & 15;
                bf16x8 v = {0, 0, 0, 0, 0, 0, 0, 0};
                if (t2 < L) v = *(const bf16x8*)(QKV + (size_t)(row0 + c * 64 + t2) * INW + 2560 + h * 128 + ch * 8);
#pragma unroll
                for (int i = 0; i < 8; ++i) *(LAS short*)(VT + (ch * 8 + i) * 144 + t2 * 2) = v[i]; }
        }
        __syncthreads();
        f32x16 acc;
        if (!state_only) {
#pragma unroll
            for (int r = 0; r < 16; ++r) acc[r] = 0.f;
#pragma unroll
            for (int ks = 0; ks < 8; ++ks) { const bf16x8 a = *(const LAS bf16x8*)(Qn + (lt * 32 + l32) * 272 + (ks * 16 + hf * 8) * 2), b = *(const LAS bf16x8*)(SbT + (et * 32 + l32) * 272 + (ks * 16 + hf * 8) * 2); acc = MFMA32(a, b, acc); }
#pragma unroll
            for (int r = 0; r < 16; ++r) { const int tl = lt * 32 + (r >> 2) * 8 + hf * 4 + (r & 3); acc[r] *= exp2f((float)(tl + 1) * lg2); }
            if (wave < 4) {
                const int slt = wave >> 1, smt = wave & 1;
                f32x16 sc;
#pragma unroll
                for (int r = 0; r < 16; ++r) sc[r] = 0.f;
                if (slt >= smt) {
#pragma unroll
                    for (int ks = 0; ks < 8; ++ks) { const bf16x8 a = *(const LAS bf16x8*)(Qn + (slt * 32 + l32) * 272 + (ks * 16 + hf * 8) * 2), b = *(const LAS bf16x8*)(Kn + (smt * 32 + l32) * 272 + (ks * 16 + hf * 8) * 2); sc = MFMA32(a, b, sc); }
                }
                const int tm = smt * 32 + l32;
#pragma unroll
                for (int r = 0; r < 16; ++r) { const int tl = slt * 32 + (r >> 2) * 8 + hf * 4 + (r & 3);
                    const float p = tl >= tm ? sc[r] * exp2f((float)(tl - tm) * lg2) : 0.f;
                    *(LAS unsigned short*)(Pm + tl * 144 + tm * 2) = (unsigned short)f2bf(p); }
            }
            __syncthreads();
#pragma unroll
            for (int ms = 0; ms < 4; ++ms) { const bf16x8 a = *(const LAS bf16x8*)(Pm + (lt * 32 + l32) * 144 + (ms * 16 + hf * 8) * 2), b = *(const LAS bf16x8*)(VT + (et * 32 + l32) * 144 + (ms * 16 + hf * 8) * 2); acc = MFMA32(a, b, acc); }
#pragma unroll
            for (int r = 0; r < 16; ++r) { const int tl = lt * 32 + (r >> 2) * 8 + hf * 4 + (r & 3); of[tl * 132 + et * 32 + l32] = acc[r]; }
        }
#pragma unroll
        for (int r = 0; r < 16; ++r) { S0[r] *= gL; S1[r] *= gL; }
#pragma unroll
        for (int ts = 0; ts < 4; ++ts) {
            const bf16x8 a = *(const LAS bf16x8*)(KdT + (sdt * 32 + l32) * 144 + (ts * 16 + hf * 8) * 2);
            const bf16x8 b0 = *(const LAS bf16x8*)(VT + (set0 * 32 + l32) * 144 + (ts * 16 + hf * 8) * 2), b1 = *(const LAS bf16x8*)(VT + ((set0 + 1) * 32 + l32) * 144 + (ts * 16 + hf * 8) * 2);
            S0 = MFMA32(a, b0, S0); S1 = MFMA32(a, b1, S1);
        }
        if (!state_only) {
#pragma unroll
            for (int g = 0; g < 4; ++g) { const int d0 = sdt * 32 + g * 8 + hf * 4;
                u32x2 a, b; a.x = pk2(S0[4 * g], S0[4 * g + 1]); a.y = pk2(S0[4 * g + 2], S0[4 * g + 3]); b.x = pk2(S1[4 * g], S1[4 * g + 1]); b.y = pk2(S1[4 * g + 2], S1[4 * g + 3]);
                *(LAS u32x2*)(SbT + (set0 * 32 + l32) * 272 + d0 * 2) = a; *(LAS u32x2*)(SbT + ((set0 + 1) * 32 + l32) * 272 + d0 * 2) = b; }
            __syncthreads();
            const f32x2 gr = *(const f32x2*)(P.in[13] + (size_t)(l * 4 + h) * 128 + lane * 2);
#pragma unroll
            for (int rr = 0; rr < 8; ++rr) {
                const int t = wave * 8 + rr;
                if (t < L) {
                    const f32x2 v = *(const LAS f32x2*)(of + t * 132 + lane * 2);
                    const float rstd = rsqrtf(wave_sum(v.x * v.x + v.y * v.y) * (1.f / 128.f) + EPS);
                    const size_t row = (size_t)(row0 + c * 64 + t);
                    const unsigned gg = *(const unsigned*)(QKV + row * INW + 3072 + h * 128 + lane * 2);
                    const float y0 = v.x * rstd * gr.x * silu_f(bf2f(gg & 0xffffu)), y1 = v.y * rstd * gr.y * silu_f(bf2f(gg >> 16));
                    *(unsigned*)(Ob + row * DM + 512 + h * 128 + lane * 2) = pk2(y0, y1);
                }
            }
        }
        __syncthreads();
    }
    if (outst) {
        float* op = outst + (sdt * 32 + hf * 4) * 128 + set0 * 32 + l32;
#pragma unroll
        for (int r = 0; r < 16; ++r) { op[((r >> 2) * 8 + (r & 3)) * 128] = S0[r]; op[((r >> 2) * 8 + (r & 3)) * 128 + 32] = S1[r]; if ((r & 3) == 3) asm volatile("" ::: "memory"); }
    }
}

__global__ void __launch_bounds__(512, 2) fwd_megakernel(Params P) {
    extern __shared__ __attribute__((aligned(16))) unsigned char lds_raw[];
    LAS unsigned char* lds = (LAS unsigned char*)lds_raw;
    cg::grid_group grid = cg::this_grid();
    int tid = threadIdx.x, lane = tid & 63, wave = __builtin_amdgcn_readfirstlane(tid >> 6);
#define REFRESH() do { tid = threadIdx.x; asm volatile("" : "+v"(tid)); lane = tid & 63; wave = __builtin_amdgcn_readfirstlane(tid >> 6); } while (0)
    const int G = gridDim.x, bx = blockIdx.x;
    bf16_t* H = (bf16_t*)(P.ws + WS_H); bf16_t* Ob = (bf16_t*)(P.ws + WS_O); bf16_t* QKV = (bf16_t*)(P.ws + WS_QKV); bf16_t* ACT = QKV;
    float* X = (float*)(P.ws + WS_X); float* U = (float*)(P.ws + WS_U);
    const float* MOD = (const float*)(P.ws + WS_MOD);

#ifndef SK_P0
    p0_phase(P, lds, tid, lane, wave);
#endif
    grid.sync(); REFRESH();
#pragma unroll 1
    for (int l = 0; l < DEPTH; ++l) {
        norm_phase<false>(P, l, l == 0, P.in[7] + (size_t)l * DM, 0, 1024, lane, wave);
        grid.sync(); REFRESH();
#ifndef SK_G1
        {
            pg8::Gemm g{H, (const bf16_t*)(P.ws + WS_WIN) + (size_t)l * INW * DM, MT, INW, DM}; pg8::StaticOrder S; S.init(MT, INW, G, bx);
            EpiQKV E{QKV, P.out, l};
            pg8::gemm_phase<EpiQKV, pg8::StaticOrder, true, true>(lds, g, S, E);
        }
#endif
        grid.sync(); REFRESH();
        for (int u = bx; u < 1360; u += G) {
#ifndef SK_R1
            if (u < 256) { const int bh = u >> 5, seg = u & 31, b = bh >> 2, h = bh & 3;
                ret_unit(P, l, lds, tid, lane, wave, b * SEQ + seg * 512, seg * 512, 8, 64, h, nullptr, U + (size_t)(bh * 32 + seg) * 16384, true); }
            else
#endif
#ifndef SK_RS
            if (u < 320) { const int idx = u - 256, bs = idx >> 2, h = idx & 3; const size_t so = ((size_t)(l * DB + bs) * 4 + h) * 16384;
                ret_unit(P, l, lds, tid, lane, wave, MP + bs * 32, PAST, 1, 32, h, P.in[4] + so, P.out + OFF_RS + so, false); }
            else
#endif
            {}
#ifndef SK_SB
            if (u >= 320) sb_unit(P, l, u - 320, lds, tid, lane, wave);
#endif
        }
        grid.sync(); REFRESH();
        for (int idx = bx * 512 + tid; idx < 8 * 16384; idx += G * 512) {
            const int bh = idx >> 14, within = idx & 16383, h = bh & 3;
            const float g512 = exp2f(512.f * log2f(1.f - exp2f(-5.f - (float)h)));
            float* up = U + (size_t)bh * 32 * 16384 + within; float s = 0.f;
            for (int seg = 0; seg < 32; ++seg) { const float uu = up[(size_t)seg * 16384]; up[(size_t)seg * 16384] = s; s = g512 * s + uu; }
            P.out[OFF_RP + ((size_t)l * 8 + bh) * 16384 + within] = s;
        }
        grid.sync(); REFRESH();
#ifndef SK_R3
        for (int u = bx; u < 256; u += G) { const int bh = u >> 5, seg = u & 31, b = bh >> 2, h = bh & 3;
            ret_unit(P, l, lds, tid, lane, wave, b * SEQ + seg * 512, seg * 512, 8, 64, h, U + (size_t)(bh * 32 + seg) * 16384, nullptr, false); }
#endif
        grid.sync(); REFRESH();
#ifndef SK_G2
        {
            pg8::Gemm g{Ob, (const bf16_t*)(P.ws + WS_WOUT) + (size_t)l * DM * DM, MT, DM, DM}; pg8::StaticOrder S; S.init(MT, DM, G, bx);
            EpiResid E{l == 0 ? P.in[0] : nullptr, l == 0 ? P.in[1] : nullptr, X, MOD + (size_t)l * NBI * NMOD + 2048};
            pg8::gemm_phase<EpiResid, pg8::StaticOrder, true, true>(lds, g, S, E);
        }
#endif
        grid.sync(); REFRESH();
        norm_phase<false>(P, l, false, P.in[8] + (size_t)l * DM, 3072, 4096, lane, wave);
        grid.sync(); REFRESH();
#ifndef SK_G3
        {
            pg8::Gemm g{H, (const bf16_t*)(P.ws + WS_WFI) + (size_t)l * 2 * DFF * DM, MT, 2 * DFF, DM}; pg8::StaticOrder S; S.init(MT, 2 * DFF, G, bx);
            EpiSwiGLU E{ACT};
            pg8::gemm_phase<EpiSwiGLU, pg8::StaticOrder, true, true>(lds, g, S, E);
        }
#endif
        grid.sync(); REFRESH();
#ifndef SK_G4
        {
            pg8::Gemm g{ACT, (const bf16_t*)(P.ws + WS_WFO) + (size_t)l * DM * DFF, MT, DM, DFF}; pg8::StaticOrder S; S.init(MT, DM, G, bx);
            EpiResid E{nullptr, nullptr, X, MOD + (size_t)l * NBI * NMOD + 5120};
            pg8::gemm_phase<EpiResid, pg8::StaticOrder, true, true>(lds, g, S, E);
        }
#endif
        grid.sync(); REFRESH();
    }
    norm_phase<true>(P, 0, false, P.in[17], 0, 0, lane, wave);
}

extern "C" void kernel_launch(void* const* d_in, const int* in_sizes, int n_in, void* d_out, int out_size, void* d_ws, size_t ws_size, hipStream_t stream) {
    static int grid = 0;
    if (grid == 0) {
        if (n_in != 18 || ws_size < WS_END) { fprintf(stderr, "kernel_launch: unexpected n_in %d / ws_size %zu\n", n_in, ws_size); grid = -1; return; }
        int dev = 0, cus = 0, per_cu = 0;
        (void)hipGetDevice(&dev); (void)hipDeviceGetAttribute(&cus, hipDeviceAttributeMultiprocessorCount, dev);
        if (hipFuncSetAttribute((const void*)fwd_megakernel, hipFuncAttributeMaxDynamicSharedMemorySize, LDS_BYTES) != hipSuccess) { fprintf(stderr, "kernel_launch: hipFuncSetAttribute failed\n"); grid = -1; return; }
        (void)hipOccupancyMaxActiveBlocksPerMultiprocessor(&per_cu, (const void*)fwd_megakernel, 512, LDS_BYTES);
        (void)hipGetLastError();
        if (per_cu < 1) { fprintf(stderr, "kernel_launch: occupancy query says %d blocks per CU\n", per_cu); per_cu = 1; }
        grid = cus;
    }
    if (grid < 0) return;
    (void)hipMemsetAsync((char*)d_ws + WS_MOD, 0, MOD_BYTES, stream);
    Params p{};
    for (int i = 0; i < 18; ++i) p.in[i] = (const float*)d_in[i];
    p.out = (float*)d_out; p.ws = (unsigned char*)d_ws;
    void* args[] = {&p};
    hipError_t e = hipLaunchCooperativeKernel((const void*)fwd_megakernel, dim3(grid), dim3(512), args, LDS_BYTES, stream);
    if (e != hipSuccess) fprintf(stderr, "cooperative launch failed: %s (grid %d)\n", hipGetErrorString(e), grid);
}
```

```cpp
#include <hip/hip_runtime.h>
#include <hip/hip_cooperative_groups.h>
#include <cstdio>
#include <cstdint>
namespace cg = cooperative_groups;
namespace pg8 {
#define PG8_LAS __attribute__((address_space(3)))
typedef unsigned short bf16_t;
typedef short bf16x8 __attribute__((ext_vector_type(8)));
typedef float f32x4 __attribute__((ext_vector_type(4)));
typedef unsigned u32x4 __attribute__((ext_vector_type(4)));
constexpr int BM = 256, BK = 64, HALF = 128, HTB = HALF * BK * 2  , STAGE_BYTES = 8 * HTB, NXCD = 8, WGM = 8;

__host__ __device__ __forceinline__ int lds_byte(int r, int c) { const int st = (r >> 4) * 2 + (c >> 5), rr = r & 15, cc = c & 31, ob = rr * 64 + cc * 2; return st * 1024 + (ob ^ (((ob >> 9) & 1) << 5)); }
__host__ __device__ __forceinline__ void stage_rc(int b, int& R, int& C) { const int st = b / 1024, sb = b % 1024, swz = sb ^ (((sb >> 9) & 1) << 5); R = (st >> 1) * 16 + swz / 64; C = (st & 1) * 32 + (swz % 64) / 2; }
__host__ __device__ __forceinline__ int perm32(int rho) { const int n = rho >> 4, i = rho & 15; return 8 * (i >> 2) + 4 * n + (i & 3); }

struct Unit { int pm, pn; };
struct Gemm { const bf16_t* A; const bf16_t* Bt; int M, N, K; };

struct StaticOrder {
    int nM, nN, nwg, G, c;
    __host__ __device__ void init(int M, int N, int G_, int c_) { nM = M / BM; nN = N / BM; nwg = nM * nN; G = G_; c = c_; }
    __host__ __device__ bool next(int i, Unit& u) const {
        const long L = (long)i * G + c; if (L >= nwg) return false;
        int wgid = (int)L; { const int q = nwg / NXCD, r = nwg % NXCD, xcd = wgid % NXCD, off = wgid / NXCD; wgid = (xcd < r ? xcd * (q + 1) : r * (q + 1) + (xcd - r) * q) + off; }
        const int nig = WGM * nN, gid = wgid / nig, fm = gid * WGM, gsz = (nM - fm) < WGM ? (nM - fm) : WGM;
        u.pm = fm + ((wgid % nig) % gsz); u.pn = (wgid % nig) / gsz; return true;
    }
    __device__ __forceinline__ void a_ready(const Unit&) const {}
    __device__ __forceinline__ void done(const Unit&) const {}
};

__device__ __forceinline__ unsigned cvt_pk_bf16(float lo, float hi) { unsigned r; asm volatile("v_cvt_pk_bf16_f32 %0, %1, %2" : "=v"(r) : "v"(lo), "v"(hi)); return r; }
typedef float f32x2 __attribute__((ext_vector_type(2)));
__device__ __forceinline__ f32x2 gelu_pk(f32x2 v) {
    const f32x2 av = __builtin_elementwise_abs(v), d = av * 0.2316418882f + 1.0f;
    f32x2 t; t.x = __builtin_amdgcn_rcpf(d.x); t.y = __builtin_amdgcn_rcpf(d.y);
    f32x2 q = t * 0.5307027145f + (-0.7265760135f); q = q * t + 0.7107068705f; q = q * t + (-0.142248368f); q = q * t + 0.127414796f; q = q * t;
    const f32x2 s = (v * v) * (-0.72134752044f);
    f32x2 e; e.x = __builtin_amdgcn_exp2f(s.x); e.y = __builtin_amdgcn_exp2f(s.y);
    const f32x2 m = v * (q * e), r = v - m;
    f32x2 o; o.x = v.x < 0.f ? m.x : r.x; o.y = v.y < 0.f ? m.y : r.y; return o;
}

template <int ACT  > struct EpiBf16 {
    static constexpr bool PERM = true, AFTER_DRAIN = false; static_assert(ACT == 0 || ACT == 1, "EpiBf16: ACT is 0 (none) or 1 (gelu_pk)");
    bf16_t* O; int ldc; const float* bias; int split_cols; size_t split_stride; float scale0;
    __device__ __forceinline__ void operator()(const f32x4 (&acc)[2][2][4][2], const Unit& u, int wr, int wc, int fr, int fq) const {
        const int row0 = u.pm * BM + wr * 64 + fr; int colt = u.pn * BM; bf16_t* base = O;
        float sc = 1.f; if (split_cols) { const int t = colt / split_cols; base += (size_t)t * split_stride; colt -= t * split_cols; if (t == 0) sc = scale0; }
        const int col0 = colt + wc * 32 + 8 * fq, bcol0 = u.pn * BM + wc * 32 + 8 * fq;
        f32x4 bv[2][2];
#pragma unroll
        for (int bj = 0; bj < 2; ++bj)
#pragma unroll
            for (int n = 0; n < 2; ++n) bv[bj][n] = bias ? *(const f32x4*)(bias + bcol0 + bj * HALF + 4 * n) : (f32x4){0.f, 0.f, 0.f, 0.f};
#pragma unroll
        for (int ai = 0; ai < 2; ++ai)
#pragma unroll
            for (int m = 0; m < 4; ++m) { bf16_t* rowp = base + (size_t)(row0 + ai * HALF + m * 16) * ldc + col0;
#pragma unroll
                for (int bj = 0; bj < 2; ++bj) { f32x4 v0 = acc[ai][bj][m][0] + bv[bj][0], v1 = acc[ai][bj][m][1] + bv[bj][1];
                    if (ACT == 1) { f32x2 a = gelu_pk((f32x2){v0[0], v0[1]}), b = gelu_pk((f32x2){v0[2], v0[3]}), c = gelu_pk((f32x2){v1[0], v1[1]}), d = gelu_pk((f32x2){v1[2], v1[3]});
                        v0 = (f32x4){a.x, a.y, b.x, b.y}; v1 = (f32x4){c.x, c.y, d.x, d.y}; }
                    v0 = v0 * sc; v1 = v1 * sc; u32x4 w; w.x = cvt_pk_bf16(v0[0], v0[1]); w.y = cvt_pk_bf16(v0[2], v0[3]); w.z = cvt_pk_bf16(v1[0], v1[1]); w.w = cvt_pk_bf16(v1[2], v1[3]);
                    *(u32x4*)(rowp + bj * HALF) = w; } }
    }
};
template <class Epi, class Sched, bool ALIGN_EPI = false, bool SP2 = false>
__device__ __forceinline__ void gemm_phase(PG8_LAS unsigned char* lds, const Gemm g, const Sched& S, const Epi& E) {
    int tid_o = threadIdx.x; asm volatile("" : "+v"(tid_o));
    const int tid = tid_o, wid = __builtin_amdgcn_readfirstlane(tid >> 6), lane = tid & 63, wr = wid >> 2, wc = wid & 3, fr = lane & 15, fq = lane >> 4;
    const int K = g.K, nt = K / BK;
    unsigned voffA[2], voffB[2];
#pragma unroll
    for (int i = 0; i < 2; ++i) { int R, C; stage_rc(tid * 16 + i * 8192, R, C); const int Rb = Epi::PERM ? ((R & ~31) + perm32(R & 31)) : R;
        voffA[i] = (unsigned)(R * K + C) * 2u; voffB[i] = (unsigned)(Rb * K + C) * 2u; }
    const size_t kstep = (size_t)(BK * 2);
    const size_t hstep = (size_t)HALF * K * 2;
    const size_t tstep = 2 * hstep;
    const unsigned ldsw = (unsigned)wid * 1024u;
    const int aoff = lds_byte(wr * 64 + fr, fq * 8), boff = lds_byte(wc * 32 + fr, fq * 8);
#define PG8_SA(b, h) (((b) * 2 + (h)) * HTB)
#define PG8_SB(b, h) ((4 + (b) * 2 + (h)) * HTB)
#define PG8_STAGE(bufoff, gbase, voff) do { _Pragma("unroll") for (int _i = 0; _i < 2; ++_i) \
        __builtin_amdgcn_global_load_lds((const unsigned*)((const char*)(gbase) + (voff)[_i]), (PG8_LAS unsigned*)(lds + (bufoff) + ldsw + _i * 8192), 16, 0, 0); } while (0)
#define PG8_LDA(dst, b, h) do { _Pragma("unroll") for (int m = 0; m < 4; ++m) _Pragma("unroll") for (int k = 0; k < 2; ++k) dst[m][k] = *(const PG8_LAS bf16x8*)(lds + PG8_SA(b, h) + aoff + m * 2048 + k * 1024); } while (0)
#define PG8_LDB(dst, b, h) do { _Pragma("unroll") for (int n = 0; n < 2; ++n) _Pragma("unroll") for (int k = 0; k < 2; ++k) dst[n][k] = *(const PG8_LAS bf16x8*)(lds + PG8_SB(b, h) + boff + n * 2048 + k * 1024); } while (0)
#define PG8_MMA(ai, bj, At, Bt) do { __builtin_amdgcn_s_setprio(1); _Pragma("unroll") for (int m = 0; m < 4; ++m) _Pragma("unroll") for (int n = 0; n < 2; ++n) _Pragma("unroll") for (int k = 0; k < 2; ++k) \
        acc[ai][bj][m][n] = __builtin_amdgcn_mfma_f32_16x16x32_bf16(Bt[n][k], At[m][k], acc[ai][bj][m][n], 0, 0, 0); __builtin_amdgcn_s_setprio(0); } while (0)
#define PG8_WAIT_V(n) asm volatile("s_waitcnt vmcnt(" #n ")" ::: "memory")
#define PG8_WAIT_L(n) asm volatile("s_waitcnt lgkmcnt(" #n ")" ::: "memory")
#define PG8_BAR __builtin_amdgcn_s_barrier()
#define PG8_SCHED __builtin_amdgcn_sched_barrier(0)
    Unit cur, nxt; int ui = 0;
    if (!S.next(0, cur)) return;
    f32x4 acc[2][2][4][2];
#pragma unroll
    for (int a = 0; a < 2; ++a)
#pragma unroll
        for (int b = 0; b < 2; ++b)
#pragma unroll
            for (int m = 0; m < 4; ++m)
#pragma unroll
                for (int n = 0; n < 2; ++n) acc[a][b][m][n] = (f32x4){0.f, 0.f, 0.f, 0.f};
    bf16x8 At[4][2], B0[2][2], B1[2][2];
    const char* cA = (const char*)g.A + (size_t)cur.pm * tstep; const char* cB = (const char*)g.Bt + (size_t)cur.pn * tstep;
    S.a_ready(cur);
    if constexpr (SP2) {
        PG8_STAGE(PG8_SB(0, 0), cB, voffB); PG8_STAGE(PG8_SB(0, 1), cB + hstep, voffB); PG8_STAGE(PG8_SA(0, 0), cA, voffA); PG8_STAGE(PG8_SA(0, 1), cA + hstep, voffA);
        if (wr == 1) PG8_BAR;
        PG8_WAIT_V(2); PG8_BAR;
        PG8_STAGE(PG8_SB(1, 0), cB + kstep, voffB); PG8_STAGE(PG8_SA(1, 0), cA + kstep, voffA); PG8_STAGE(PG8_SB(1, 1), cB + hstep + kstep, voffB);
        PG8_WAIT_V(6); PG8_BAR;
    } else {
        PG8_STAGE(PG8_SB(0, 0), cB, voffB); PG8_STAGE(PG8_SA(0, 0), cA, voffA); PG8_STAGE(PG8_SB(0, 1), cB + hstep, voffB); PG8_STAGE(PG8_SA(0, 1), cA + hstep, voffA);
        if (wr == 1) PG8_BAR;
        PG8_WAIT_V(4); PG8_BAR;
        PG8_STAGE(PG8_SB(1, 0), cB + kstep, voffB); PG8_STAGE(PG8_SA(1, 0), cA + kstep, voffA); PG8_STAGE(PG8_SB(1, 1), cB + hstep + kstep, voffB);
        PG8_WAIT_V(6); PG8_BAR;
    }
    for (;;) {
        const bool has_next = S.next(ui + 1, nxt);
        const char* nA = has_next ? (const char*)g.A + (size_t)nxt.pm * tstep : cA; const char* nB = has_next ? (const char*)g.Bt + (size_t)nxt.pn * tstep : cB;
        for (int t = 0; t < nt; t += 2) {
            const bool last = (t == nt - 2);
            const char* a1 = cA + (size_t)(t + 1) * kstep;
            const char* a2 = last ? nA : cA + (size_t)(t + 2) * kstep; const char* b2 = last ? nB : cB + (size_t)(t + 2) * kstep;
            const char* a3 = a2 + kstep; const char* b3 = b2 + kstep;
            if (last && has_next) S.a_ready(nxt);
            if constexpr (SP2) {
            PG8_LDB(B0, 0, 0); PG8_LDB(B1, 0, 1); PG8_SCHED; PG8_LDA(At, 0, 0); PG8_STAGE(PG8_SA(1, 1), a1 + hstep, voffA);
            PG8_WAIT_V(8); PG8_WAIT_L(0); PG8_BAR; PG8_MMA(0, 0, At, B0); PG8_MMA(0, 1, At, B1); PG8_BAR; PG8_SCHED;
            PG8_LDA(At, 0, 1); PG8_STAGE(PG8_SB(0, 0), b2, voffB); PG8_STAGE(PG8_SB(0, 1), b2 + hstep, voffB); PG8_STAGE(PG8_SA(0, 0), a2, voffA);
            PG8_WAIT_V(8); PG8_WAIT_L(0); PG8_BAR; PG8_MMA(1, 0, At, B0); PG8_MMA(1, 1, At, B1); PG8_BAR; PG8_SCHED;
            PG8_LDB(B0, 1, 0); PG8_LDB(B1, 1, 1); PG8_SCHED; PG8_LDA(At, 1, 0); PG8_STAGE(PG8_SA(0, 1), a2 + hstep, voffA);
            PG8_WAIT_V(8); PG8_WAIT_L(0); PG8_BAR; PG8_MMA(0, 0, At, B0); PG8_MMA(0, 1, At, B1); PG8_BAR; PG8_SCHED;
            PG8_LDA(At, 1, 1); PG8_STAGE(PG8_SB(1, 0), b3, voffB); PG8_STAGE(PG8_SB(1, 1), b3 + hstep, voffB); PG8_STAGE(PG8_SA(1, 0), a3, voffA);
            PG8_WAIT_V(8); PG8_WAIT_L(0); PG8_BAR; PG8_MMA(1, 0, At, B0); PG8_MMA(1, 1, At, B1); PG8_BAR; PG8_SCHED;
            } else {
            PG8_LDB(B0, 0, 0); PG8_SCHED; PG8_LDA(At, 0, 0); PG8_STAGE(PG8_SA(1, 1), a1 + hstep, voffA);
            PG8_WAIT_L(8); PG8_BAR; PG8_WAIT_L(0); PG8_MMA(0, 0, At, B0); PG8_BAR; PG8_SCHED;
            PG8_LDB(B1, 0, 1); PG8_STAGE(PG8_SB(0, 0), b2, voffB);
            PG8_BAR; PG8_WAIT_L(0); PG8_MMA(0, 1, At, B1); PG8_BAR;
            PG8_LDA(At, 0, 1); PG8_STAGE(PG8_SA(0, 0), a2, voffA);
            PG8_BAR; PG8_WAIT_L(0); PG8_MMA(1, 0, At, B0); PG8_BAR; PG8_SCHED;
            PG8_STAGE(PG8_SB(0, 1), b2 + hstep, voffB);
            PG8_WAIT_V(6); PG8_BAR; PG8_MMA(1, 1, At, B1); PG8_BAR;
            PG8_LDB(B0, 1, 0); PG8_SCHED; PG8_LDA(At, 1, 0); PG8_STAGE(PG8_SA(0, 1), a2 + hstep, voffA);
            PG8_WAIT_L(8); PG8_BAR; PG8_WAIT_L(0); PG8_MMA(0, 0, At, B0); PG8_BAR; PG8_SCHED;
            PG8_LDB(B1, 1, 1); PG8_STAGE(PG8_SB(1, 0), b3, voffB);
            PG8_BAR; PG8_WAIT_L(0); PG8_MMA(0, 1, At, B1); PG8_BAR;
            PG8_LDA(At, 1, 1); PG8_STAGE(PG8_SA(1, 0), a3, voffA);
            PG8_BAR; PG8_WAIT_L(0); PG8_MMA(1, 0, At, B0); PG8_BAR; PG8_SCHED;
            PG8_STAGE(PG8_SB(1, 1), b3 + hstep, voffB);
            PG8_WAIT_V(6); PG8_BAR; PG8_MMA(1, 1, At, B1); PG8_BAR;
            }
        }
        if constexpr (ALIGN_EPI) { if (wr == 0) PG8_BAR; }
        if constexpr (!Epi::AFTER_DRAIN) { E(acc, cur, wr, wc, fr, fq); S.done(cur); }
        if (!has_next) break;
#pragma unroll
        for (int a = 0; a < 2; ++a)
#pragma unroll
            for (int b = 0; b < 2; ++b)
#pragma unroll
                for (int m = 0; m < 4; ++m)
#pragma unroll
                    for (int n = 0; n < 2; ++n) acc[a][b][m][n] = (f32x4){0.f, 0.f, 0.f, 0.f};
        cur = nxt; cA = nA; cB = nB; ++ui;
        if constexpr (ALIGN_EPI) { if (wr == 1) PG8_BAR; }
    }
    PG8_WAIT_V(0);
    if constexpr (!ALIGN_EPI) { if (wr == 0) PG8_BAR; }
    PG8_BAR;
    if constexpr (Epi::AFTER_DRAIN) { E.fused(acc, cur, wr, wc, fr, fq, lds, wid, lane); S.done(cur); }
#undef PG8_SA
#undef PG8_SB
#undef PG8_STAGE
#undef PG8_LDA
#undef PG8_LDB
#undef PG8_MMA
#undef PG8_WAIT_V
#undef PG8_WAIT_L
#undef PG8_BAR
#undef PG8_SCHED
}
}

#define LAS __attribute__((address_space(3)))
typedef unsigned short bf16_t;
typedef short bf16x8 __attribute__((ext_vector_type(8)));
typedef float f32x4 __attribute__((ext_vector_type(4)));
typedef float f32x2 __attribute__((ext_vector_type(2)));
typedef float f32x16 __attribute__((ext_vector_type(16)));
typedef unsigned u32x4 __attribute__((ext_vector_type(4)));
typedef unsigned u32x2 __attribute__((ext_vector_type(2)));
#define MFMA32(a, b, c) __builtin_amdgcn_mfma_f32_32x32x16_bf16((a), (b), (c), 0, 0, 0)

constexpr int DM = 1024, SEQ = 16384, NBP = 2, DEPTH = 4, DB = 16, DS = 32, PAST = 2048;
constexpr int MP = NBP * SEQ, MS = DB * DS, MT = MP + MS;
constexpr int INW = 3584, DFF = 2816, NMOD = 6144, NBI = 18;
constexpr float EPS = 1e-6f;
constexpr size_t OFF_YP = 0, OFF_YS = 33554432, OFF_KP = 34078720, OFF_VP = 101187584, OFF_RP = 168296448,
                 OFF_KS = 168820736, OFF_VS = 169869312, OFF_RS = 170917888;
constexpr size_t MiB = 1u << 20;
constexpr size_t WS_MOD = 0, MOD_BYTES = 2 * MiB;
constexpr size_t WS_ROPE = 2 * MiB;
constexpr size_t WS_WIN = 10 * MiB, WS_WOUT = 38 * MiB, WS_WFI = 46 * MiB, WS_WFO = 90 * MiB;
constexpr size_t WS_X = 112 * MiB;
constexpr size_t WS_H = 242 * MiB;
constexpr size_t WS_O = 307 * MiB;
constexpr size_t WS_QKV = 372 * MiB;
constexpr size_t WS_U = 600 * MiB;
constexpr size_t WS_END = 616 * MiB;
constexpr int LDS_BYTES = 147456;

struct Params { const float* in[18]; float* out; unsigned char* ws; };

__device__ __forceinline__ unsigned f2bf(float f) { unsigned u = __builtin_bit_cast(unsigned, f); return (u + 0x7fffu + ((u >> 16) & 1u)) >> 16; }
__device__ __forceinline__ unsigned pk2(float lo, float hi) { return f2bf(lo) | (f2bf(hi) << 16); }
__device__ __forceinline__ float bf2f(unsigned h) { return __builtin_bit_cast(float, h << 16); }
__device__ __forceinline__ bf16x8 pack8(f32x4 a, f32x4 b) { u32x4 p; p.x = pk2(a.x, a.y); p.y = pk2(a.z, a.w); p.z = pk2(b.x, b.y); p.w = pk2(b.z, b.w); return __builtin_bit_cast(bf16x8, p); }
__device__ __forceinline__ float wave_sum(float v) {
#pragma unroll
    for (int o = 1; o < 64; o <<= 1) v += __shfl_xor(v, o);
    return v;
}
__device__ __forceinline__ float silu_f(float x) { return x * __builtin_amdgcn_rcpf(1.f + __expf(-x)); }
__device__ __forceinline__ int batch_of(int row) { return row < MP ? (row >> 14) : 2 + ((row - MP) >> 5); }

struct EpiQKV {
    static constexpr bool PERM = true, AFTER_DRAIN = false;
    bf16_t* QKV; float* out; int layer;
    __device__ __forceinline__ void operator()(const pg8::f32x4 (&acc)[2][2][4][2], const pg8::Unit& u, int wr, int wc, int fr, int fq) const {
        const int row0 = u.pm * 256 + wr * 64 + fr, col0 = u.pn * 256 + wc * 32 + 8 * fq;
        const bool kv = (u.pn >= 2 && u.pn < 6);
        const size_t vsel = (u.pn >= 4) ? 1 : 0;
        const size_t obase = (u.pm < 128) ? OFF_KP + vsel * (OFF_VP - OFF_KP) + (size_t)layer * MP * 512 + (size_t)row0 * 512
                                          : OFF_KS + vsel * (OFF_VS - OFF_KS) + (size_t)layer * MS * 512 + (size_t)(row0 - MP) * 512;
#pragma unroll
        for (int ai = 0; ai < 2; ++ai)
#pragma unroll
            for (int m = 0; m < 4; ++m) {
                const int row = row0 + ai * 128 + m * 16;
#pragma unroll
                for (int bj = 0; bj < 2; ++bj) {
                    const int col = col0 + bj * 128;
                    const pg8::f32x4 v0 = acc[ai][bj][m][0], v1 = acc[ai][bj][m][1];
                    u32x4 w; w.x = pg8::cvt_pk_bf16(v0[0], v0[1]); w.y = pg8::cvt_pk_bf16(v0[2], v0[3]); w.z = pg8::cvt_pk_bf16(v1[0], v1[1]); w.w = pg8::cvt_pk_bf16(v1[2], v1[3]);
                    *(u32x4*)(QKV + (size_t)row * INW + col) = w;
                    if (kv) {
                        const int c = col & 511;
                        float* dst = out + obase + (size_t)(ai * 128 + m * 16) * 512 + c;
                        *(pg8::f32x4*)dst = v0; *(pg8::f32x4*)(dst + 4) = v1;
                    }
                }
                asm volatile("" ::: "memory");
            }
    }
};
struct EpiResid {
    static constexpr bool PERM = false, AFTER_DRAIN = false;
    const float* base_p; const float* base_s;
    float* X; const float* gate;
    __device__ __forceinline__ void operator()(const pg8::f32x4 (&acc)[2][2][4][2], const pg8::Unit& u, int wr, int wc, int fr, int fq) const {
        const int col0 = u.pn * 256 + wc * 32 + 4 * fq;
#pragma unroll
        for (int ai = 0; ai < 2; ++ai)
#pragma unroll
            for (int m = 0; m < 4; ++m) {
                const int row = u.pm * 256 + ai * 128 + wr * 64 + m * 16 + fr;
                const float* br = base_p ? (row < MP ? base_p + (size_t)row * DM : base_s + (size_t)(row - MP) * DM) : X + (size_t)row * DM;
                const float* gr = gate + (size_t)batch_of(row) * NMOD; float* xr = X + (size_t)row * DM;
#pragma unroll
                for (int bj = 0; bj < 2; ++bj)
#pragma unroll
                    for (int n = 0; n < 2; ++n) { const int c = col0 + bj * 128 + n * 16;
                        const pg8::f32x4 b = *(const pg8::f32x4*)(br + c), g = *(const pg8::f32x4*)(gr + c);
                        *(pg8::f32x4*)(xr + c) = b + g * acc[ai][bj][m][n]; }
                asm volatile("" ::: "memory");
            }
    }
};
struct EpiSwiGLU {
    static constexpr bool PERM = true, AFTER_DRAIN = false;
    bf16_t* ACT;
    __device__ __forceinline__ void operator()(const pg8::f32x4 (&acc)[2][2][4][2], const pg8::Unit& u, int wr, int wc, int fr, int fq) const {
        const int col0 = u.pn * 128 + wc * 32 + 8 * fq;
#pragma unroll
        for (int ai = 0; ai < 2; ++ai)
#pragma unroll
            for (int m = 0; m < 4; ++m) {
                const int row = u.pm * 256 + ai * 128 + wr * 64 + m * 16 + fr;
                const pg8::f32x4 g0 = acc[ai][0][m][0], g1 = acc[ai][0][m][1], u0 = acc[ai][1][m][0], u1 = acc[ai][1][m][1];
                float r[8];
#pragma unroll
                for (int j = 0; j < 4; ++j) { r[j] = silu_f(g0[j]) * u0[j]; r[4 + j] = silu_f(g1[j]) * u1[j]; }
                u32x4 w; w.x = pg8::cvt_pk_bf16(r[0], r[1]); w.y = pg8::cvt_pk_bf16(r[2], r[3]); w.z = pg8::cvt_pk_bf16(r[4], r[5]); w.w = pg8::cvt_pk_bf16(r[6], r[7]);
                *(u32x4*)(ACT + (size_t)row * DFF + col0) = w;
                asm volatile("" ::: "memory");
            }
    }
};

__device__ __forceinline__ void transpose_item(const float* W, int K, int N, bf16_t* WT, LAS float* scr, int item, int lane, bool perm) {
    const int nblk = N / 32, kb = item / nblk, nb = item % nblk, k0 = 64 * kb, n0 = 32 * nb;
    int p0 = n0;
    if (perm) { if (n0 < DFF) p0 = (n0 >> 7) * 256 + (n0 & 127); else { const int n1 = n0 - DFF; p0 = (n1 >> 7) * 256 + 128 + (n1 & 127); } }
#pragma unroll 8
    for (int i = 0; i < 32; ++i) { const int kk = 2 * i + (lane >> 5); scr[kk * 33 + (lane & 31)] = W[(size_t)(k0 + kk) * N + n0 + (lane & 31)]; }
    asm volatile("s_waitcnt lgkmcnt(0)" ::: "memory"); __builtin_amdgcn_wave_barrier();
    const int c = lane & 7;
#pragma unroll
    for (int j = 0; j < 4; ++j) { const int n = (lane >> 3) + 8 * j; const LAS float* s = scr + (8 * c) * 33 + n;
        u32x4 o; o.x = pk2(s[0 * 33], s[1 * 33]); o.y = pk2(s[2 * 33], s[3 * 33]); o.z = pk2(s[4 * 33], s[5 * 33]); o.w = pk2(s[6 * 33], s[7 * 33]);
        *(u32x4*)(WT + (size_t)(p0 + n) * K + k0 + 8 * c) = o; }
    asm volatile("s_waitcnt lgkmcnt(0)" ::: "memory"); __builtin_amdgcn_wave_barrier();
}

__device__ __forceinline__ void p0_phase(const Params& P, LAS unsigned char* lds, int tid, int lane, int wave) {
    LAS float* sc = (LAS float*)lds;
    for (int i = tid; i < NBI * DM; i += 512) { const int b = i >> 10, k = i & 1023; const float c = b < 2 ? P.in[5][b * DM + k] : P.in[6][(b - 2) * DM + k]; sc[i] = silu_f(c); }
    __syncthreads();
    const int gw = blockIdx.x * 8 + wave, NGW = gridDim.x * 8;
    float* MOD = (float*)(P.ws + WS_MOD);
    for (int it = gw; it < 768; it += NGW) {
        const int l = it / 192, r = it % 192, cb = r >> 3, kc = r & 7;
        f32x4 acc[NBI];
#pragma unroll
        for (int b = 0; b < NBI; ++b) acc[b] = (f32x4){0.f, 0.f, 0.f, 0.f};
        const float* wp = P.in[9] + ((size_t)l * DM + kc * 128) * NMOD + cb * 256 + lane * 4;
        const LAS float* scp = sc + kc * 128;
#pragma unroll 4
        for (int k = 0; k < 128; ++k) { const f32x4 w = *(const f32x4*)(wp + (size_t)k * NMOD);
#pragma unroll
            for (int b = 0; b < NBI; ++b) acc[b] += scp[b * DM + k] * w; }
        if (kc == 0) { const f32x4 bv = *(const f32x4*)(P.in[10] + (size_t)l * NMOD + cb * 256 + lane * 4);
#pragma unroll
            for (int b = 0; b < NBI; ++b) acc[b] += bv; }
        float* mp = MOD + (size_t)l * NBI * NMOD + cb * 256 + lane * 4;
#pragma unroll
        for (int b = 0; b < NBI; ++b) { atomicAdd(mp + b * NMOD + 0, acc[b].x); atomicAdd(mp + b * NMOD + 1, acc[b].y); atomicAdd(mp + b * NMOD + 2, acc[b].z); atomicAdd(mp + b * NMOD + 3, acc[b].w); }
    }
    LAS float* scr = (LAS float*)(lds + 73728 + wave * 8448);
    constexpr int I_IN = 16 * 112, I_OUT = 16 * 32, I_FI = 16 * 176, I_FO = 44 * 32, I_L = I_IN + I_OUT + I_FI + I_FO;
    for (int it = gw; it < DEPTH * I_L; it += NGW) {
        const int l = it / I_L; int r = it % I_L;
        if (r < I_IN) { transpose_item(P.in[11] + (size_t)l * DM * INW, DM, INW, (bf16_t*)(P.ws + WS_WIN) + (size_t)l * INW * DM, scr, r, lane, false); continue; } r -= I_IN;
        if (r < I_OUT) { transpose_item(P.in[14] + (size_t)l * DM * DM, DM, DM, (bf16_t*)(P.ws + WS_WOUT) + (size_t)l * DM * DM, scr, r, lane, false); continue; } r -= I_OUT;
        if (r < I_FI) { transpose_item(P.in[15] + (size_t)l * DM * 2 * DFF, DM, 2 * DFF, (bf16_t*)(P.ws + WS_WFI) + (size_t)l * 2 * DFF * DM, scr, r, lane, true); continue; } r -= I_FI;
        transpose_item(P.in[16] + (size_t)l * DFF * DM, DFF, DM, (bf16_t*)(P.ws + WS_WFO) + (size_t)l * DM * DFF, scr, r, lane, false);
    }
    f32x2* ROPE = (f32x2*)(P.ws + WS_ROPE);
    for (int idx = blockIdx.x * 512 + tid; idx < SEQ * 64; idx += gridDim.x * 512) {
        const int pos = idx >> 6, i = idx & 63;
        const float inv = exp2f(-(float)i * (13.287712379549449f / 64.f));
        const float ang = (float)pos * inv;
        double rev = (double)ang * 0.15915494309189535; rev -= floor(rev);
        const float rf = (float)rev;
        ROPE[idx] = (f32x2){__builtin_amdgcn_cosf(rf), __builtin_amdgcn_sinf(rf)};
    }
}

template <bool FINAL>
__device__ __forceinline__ void norm_phase(const Params& P, int l, bool from_input, const float* gain, int sh_off, int sc_off, int lane, int wave) {
    const int gw = blockIdx.x * 8 + wave, NGW = gridDim.x * 8;
    const float* MOD = (const float*)(P.ws + WS_MOD) + (size_t)l * NBI * NMOD;
    const float* X = (const float*)(P.ws + WS_X); bf16_t* H = (bf16_t*)(P.ws + WS_H);
    f32x4 g[4];
#pragma unroll
    for (int j = 0; j < 4; ++j) g[j] = *(const f32x4*)(gain + 4 * lane + 256 * j);
    for (int m = gw; m < MT; m += NGW) {
        const float* xr = (!FINAL && from_input) ? (m < MP ? P.in[0] + (size_t)m * DM : P.in[1] + (size_t)(m - MP) * DM) : X + (size_t)m * DM;
        f32x4 v[4]; float ss = 0.f;
#pragma unroll
        for (int j = 0; j < 4; ++j) { v[j] = *(const f32x4*)(xr + 4 * lane + 256 * j); ss += (v[j].x * v[j].x + v[j].y * v[j].y) + (v[j].z * v[j].z + v[j].w * v[j].w); }
        const float rstd = rsqrtf(wave_sum(ss) * (1.f / DM) + EPS);
        if (FINAL) {
            float* o = P.out + (size_t)m * DM;
#pragma unroll
            for (int j = 0; j < 4; ++j) *(f32x4*)(o + 4 * lane + 256 * j) = v[j] * rstd * g[j];
        } else {
            const float* mr = MOD + (size_t)batch_of(m) * NMOD;
#pragma unroll
            for (int j = 0; j < 4; ++j) { const int c = 4 * lane + 256 * j;
                const f32x4 sc = *(const f32x4*)(mr + sc_off + c), sh = *(const f32x4*)(mr + sh_off + c);
                const f32x4 hh = v[j] * rstd * g[j] * (1.f + sc) + sh;
                u32x2 w; w.x = pk2(hh.x, hh.y); w.y = pk2(hh.z, hh.w);
                *(u32x2*)(H + (size_t)m * DM + c) = w; }
        }
    }
}

__device__ __forceinline__ void sb_unit(const Params& P, int l, int u, LAS unsigned char* lds, int tid, int lane, int wave) {
    const bf16_t* QKV = (const bf16_t*)(P.ws + WS_QKV);
    const int h = wave, l32 = lane & 31, hf = lane >> 5;
    const bool samp = u >= 1024;
    int qrow0, nsteps; const float* ck = nullptr; const float* cv = nullptr;
    if (!samp) { const int b = u >> 9, qb = u & 511; qrow0 = b * SEQ + qb * 32; nsteps = qb + 1; }
    else { const int bs = u - 1024; qrow0 = MP + bs * 32; nsteps = 65; ck = P.in[2] + (size_t)(l * DB + bs) * PAST * 512; cv = P.in[3] + (size_t)(l * DB + bs) * PAST * 512; }
    bf16x8 qf[4];
#pragma unroll
    for (int ks = 0; ks < 4; ++ks) qf[ks] = *(const bf16x8*)(QKV + (size_t)(qrow0 + l32) * INW + h * 64 + ks * 16 + hf * 8);
    f32x16 O0, O1;
#pragma unroll
    for (int r = 0; r < 16; ++r) { O0[r] = 0.f; O1[r] = 0.f; }
    float cum = 0.f;
    LAS unsigned char* vt = lds + 66048 + wave * 4608;
    auto issue = [&](int s, bf16x8 (&k)[4], bf16x8 (&v)[4]) {
        if (!samp || s == 0) {
            const int krow0 = samp ? qrow0 : qrow0 - s * 32;
#pragma unroll
            for (int ks = 0; ks < 4; ++ks) k[ks] = *(const bf16x8*)(QKV + (size_t)(krow0 + l32) * INW + 512 + h * 64 + ks * 16 + hf * 8);
#pragma unroll
            for (int it = 0; it < 4; ++it) { const int id = it * 64 + lane, key = id >> 3, ch = id & 7;
                v[it] = *(const bf16x8*)(QKV + (size_t)(krow0 + key) * INW + 1024 + h * 64 + ch * 8); }
        } else {
            const int kpos0 = (64 - s) * 32;
#pragma unroll
            for (int ks = 0; ks < 4; ++ks) { const float* p = ck + (size_t)(kpos0 + l32) * 512 + h * 64 + ks * 16 + hf * 8; k[ks] = pack8(*(const f32x4*)p, *(const f32x4*)(p + 4)); }
#pragma unroll
            for (int it = 0; it < 4; ++it) { const int id = it * 64 + lane, key = id >> 3, ch = id & 7;
                const float* p = cv + (size_t)(kpos0 + key) * 512 + h * 64 + ch * 8;
                v[it] = pack8(*(const f32x4*)p, *(const f32x4*)(p + 4)); }
        }
    };
    bf16x8 kf[4], vr[4];
    issue(0, kf, vr);
    for (int s = 0; s < nsteps; ++s) {
#pragma unroll
        for (int it = 0; it < 4; ++it) { const int id = it * 64 + lane, key = id >> 3, ch = id & 7; *(LAS bf16x8*)(vt + key * 144 + ch * 16) = vr[it]; }
        bf16x8 kn[4];
#pragma unroll
        for (int ks = 0; ks < 4; ++ks) kn[ks] = kf[ks];
        if (s + 1 < nsteps) issue(s + 1, kn, vr);
        asm volatile("s_waitcnt lgkmcnt(0)" ::: "memory"); __builtin_amdgcn_wave_barrier();
        f32x16 S;
#pragma unroll
        for (int r = 0; r < 16; ++r) S[r] = 0.f;
#pragma unroll
        for (int ks = 0; ks < 4; ++ks) S = MFMA32(kf[ks], qf[ks], S);
        float L[16], lb[16]; bool valid[16];
#pragma unroll
        for (int r = 0; r < 16; ++r) {
            const float z = S[r] * 0.125f;
            const float sp = fmaxf(z, 0.f) + __logf(1.f + __expf(-fabsf(z)));
            const int key = (r >> 2) * 8 + hf * 4 + (r & 3);
            valid[r] = (s != 0) || (key < l32);
            L[r] = valid[r] ? -sp : 0.f; lb[r] = z - sp;
        }
        float T[4], Pp[4];
#pragma unroll
        for (int g = 0; g < 4; ++g) { T[g] = (L[4 * g] + L[4 * g + 1]) + (L[4 * g + 2] + L[4 * g + 3]); Pp[g] = __shfl_xor(T[g], 32); }
        float later[4]; float tot = 0.f;
#pragma unroll
        for (int g = 3; g >= 0; --g) { later[g] = tot; tot += T[g] + Pp[g]; }
        float w[16];
#pragma unroll
        for (int g = 0; g < 4; ++g) {
            const float s3 = cum + later[g] + (hf == 0 ? Pp[g] : 0.f);
            const float s2 = s3 + L[4 * g + 3], s1 = s2 + L[4 * g + 2], s0 = s1 + L[4 * g + 1];
            w[4 * g + 3] = valid[4 * g + 3] ? __expf(lb[4 * g + 3] + s3) : 0.f;
            w[4 * g + 2] = valid[4 * g + 2] ? __expf(lb[4 * g + 2] + s2) : 0.f;
            w[4 * g + 1] = valid[4 * g + 1] ? __expf(lb[4 * g + 1] + s1) : 0.f;
            w[4 * g + 0] = valid[4 * g + 0] ? __expf(lb[4 * g + 0] + s0) : 0.f;
        }
        cum += tot;
#pragma unroll
        for (int c = 0; c < 2; ++c) {
            u32x4 pw; pw.x = pk2(w[8 * c], w[8 * c + 1]); pw.y = pk2(w[8 * c + 2], w[8 * c + 3]); pw.z = pk2(w[8 * c + 4], w[8 * c + 5]); pw.w = pk2(w[8 * c + 6], w[8 * c + 7]);
            const bf16x8 pa = __builtin_bit_cast(bf16x8, pw);
#pragma unroll
            for (int dt = 0; dt < 2; ++dt) {
                bf16x8 vb;
#pragma unroll
                for (int i = 0; i < 8; ++i) { const int key = 16 * c + 8 * (i >> 2) + 4 * hf + (i & 3); vb[i] = *(const LAS short*)(vt + key * 144 + (l32 + 32 * dt) * 2); }
                if (dt == 0) O0 = MFMA32(pa, vb, O0); else O1 = MFMA32(pa, vb, O1);
            }
        }
        asm volatile("" ::: "memory");
        if (__all(cum < -110.f)) break;
#pragma unroll
        for (int ks = 0; ks < 4; ++ks) kf[ks] = kn[ks];
    }
    LAS float* oa = (LAS float*)lds;
#pragma unroll
    for (int r = 0; r < 16; ++r) { const int q = (r >> 2) * 8 + hf * 4 + (r & 3); oa[q * 516 + h * 64 + l32] = O0[r]; oa[q * 516 + h * 64 + 32 + l32] = O1[r]; }
    __syncthreads();
    bf16_t* Ob = (bf16_t*)(P.ws + WS_O);
    const float* gsb = P.in[12] + (size_t)l * 512;
#pragma unroll
    for (int rr = 0; rr < 4; ++rr) {
        const int q = wave * 4 + rr;
        const f32x4 a = *(const LAS f32x4*)(oa + q * 516 + 4 * lane), b = *(const LAS f32x4*)(oa + q * 516 + 256 + 4 * lane);
        float ss = (a.x * a.x + a.y * a.y) + (a.z * a.z + a.w * a.w) + (b.x * b.x + b.y * b.y) + (b.z * b.z + b.w * b.w);
        const float rstd = rsqrtf(wave_sum(ss) * (1.f / 512.f) + EPS);
        const f32x4 ga = *(const f32x4*)(gsb + 4 * lane), gb = *(const f32x4*)(gsb + 256 + 4 * lane);
        const f32x4 ya = a * rstd * ga, yb = b * rstd * gb;
        u32x2 wa, wb; wa.x = pk2(ya.x, ya.y); wa.y = pk2(ya.z, ya.w); wb.x = pk2(yb.x, yb.y); wb.y = pk2(yb.z, yb.w);
        *(u32x2*)(Ob + (size_t)(qrow0 + q) * DM + 4 * lane) = wa; *(u32x2*)(Ob + (size_t)(qrow0 + q) * DM + 256 + 4 * lane) = wb;
    }
    __syncthreads();
}

__device__ __forceinline__ void ret_unit(const Params& P, int l, LAS unsigned char* lds, int tid, int lane, int wave,
                                         int row0, int pos0, int nchunks, int L, int h, const float* init, float* outst, bool state_only) {
    const bf16_t* QKV = (const bf16_t*)(P.ws + WS_QKV); bf16_t* Ob = (bf16_t*)(P.ws + WS_O);
    const f32x2* ROPE = (const f32x2*)(P.ws + WS_ROPE);
    const float lg2 = log2f(1.f - exp2f(-5.f - (float)h));
    LAS unsigned char *Qn = lds, *Kn = lds + 17408, *KdT = lds + 34816, *VT = lds + 53248, *SbT = lds + 71680, *Pm = lds + 106496;
    LAS float* of = (LAS float*)lds;
    const int l32 = lane & 31, hf = lane >> 5;
    const int sdt = wave >> 1, set0 = (wave & 1) * 2;
    f32x16 S0, S1;
#pragma unroll
    for (int r = 0; r < 16; ++r) { S0[r] = 0.f; S1[r] = 0.f; }
    if (init) {
        const float* ip = init + (sdt * 32 + hf * 4) * 128 + set0 * 32 + l32;
#pragma unroll
        for (int r = 0; r < 16; ++r) { S0[r] = ip[((r >> 2) * 8 + (r & 3)) * 128]; S1[r] = ip[((r >> 2) * 8 + (r & 3)) * 128 + 32]; if ((r & 3) == 3) asm volatile("" ::: "memory"); }
    }
    if (!state_only) {
#pragma unroll
        for (int g = 0; g < 4; ++g) { const int d0 = sdt * 32 + g * 8 + hf * 4;
            u32x2 a, b; a.x = pk2(S0[4 * g], S0[4 * g + 1]); a.y = pk2(S0[4 * g + 2], S0[4 * g + 3]); b.x = pk2(S1[4 * g], S1[4 * g + 1]); b.y = pk2(S1[4 * g + 2], S1[4 * g + 3]);
            *(LAS u32x2*)(SbT + (set0 * 32 + l32) * 272 + d0 * 2) = a; *(LAS u32x2*)(SbT + ((set0 + 1) * 32 + l32) * 272 + d0 * 2) = b; }
    }
    const float gL = exp2f((float)L * lg2);
    const int lt = wave >> 2, et = wave & 3;
    bf16x8 rk1, rk2, rq1, rq2, rv0, rv1; f32x4 rcs[4];
    const bf16x8 z8 = {0, 0, 0, 0, 0, 0, 0, 0};
    auto issue = [&](int c) {
        const int t = tid >> 3, i0 = (tid & 7) * 8; const bool ok = t < L;
        const size_t row = (size_t)(row0 + c * 64 + t);
        rk1 = z8; rk2 = z8; rq1 = z8; rq2 = z8;
#pragma unroll
        for (int i = 0; i < 4; ++i) rcs[i] = (f32x4){0.f, 0.f, 0.f, 0.f};
        if (ok) {
            rk1 = *(const bf16x8*)(QKV + row * INW + 2048 + h * 128 + i0); rk2 = *(const bf16x8*)(QKV + row * INW + 2048 + h * 128 + 64 + i0);
            if (!state_only) { rq1 = *(const bf16x8*)(QKV + row * INW + 1536 + h * 128 + i0); rq2 = *(const bf16x8*)(QKV + row * INW + 1536 + h * 128 + 64 + i0); }
            const f32x4* rp = (const f32x4*)(ROPE + (size_t)(pos0 + c * 64 + t) * 64 + i0);
#pragma unroll
            for (int i = 0; i < 4; ++i) rcs[i] = rp[i];
        }
        const int t0 = tid >> 4, ch = tid & 15;
        rv0 = z8; rv1 = z8;
        if (t0 < L) rv0 = *(const bf16x8*)(QKV + (size_t)(row0 + c * 64 + t0) * INW + 2560 + h * 128 + ch * 8);
        if (t0 + 32 < L) rv1 = *(const bf16x8*)(QKV + (size_t)(row0 + c * 64 + t0 + 32) * INW + 2560 + h * 128 + ch * 8);
    };
    issue(0);
    const int l32_0 = l32, hf_0 = hf, tid_0 = tid; const float lg2_0 = lg2;
#pragma unroll 1
    for (int c = 0; c < nchunks; ++c) {
        int l32 = l32_0, hf = hf_0, tid = tid_0; float lg2 = lg2_0;
        asm volatile("" : "+v"(l32), "+v"(hf), "+v"(tid), "+v"(lg2));
        {
            const int t = tid >> 3, pc = tid & 7, i0 = pc * 8; const bool ok = t < L;
            const float kd = ok ? __builtin_amdgcn_exp2f((float)(L - 1 - t) * lg2) : 0.f;
            const int tsw = (((t >> 3) ^ pc) << 4) + (t & 7) * 2;
            float cs_c[8], cs_s[8];
#pragma unroll
            for (int i = 0; i < 4; ++i) { cs_c[2 * i] = rcs[i].x; cs_s[2 * i] = rcs[i].y; cs_c[2 * i + 1] = rcs[i].z; cs_s[2 * i + 1] = rcs[i].w; }
            {
                float o1[8], o2[8];
#pragma unroll
                for (int i = 0; i < 8; ++i) { const float x1 = bf2f((unsigned short)rk1[i]), x2 = bf2f((unsigned short)rk2[i]);
                    o1[i] = (x1 * cs_c[i] - x2 * cs_s[i]) * 0.08838834764831845f; o2[i] = (x1 * cs_s[i] + x2 * cs_c[i]) * 0.08838834764831845f; }
                if (!state_only) {
                    u32x4 a, b; a.x = pk2(o1[0], o1[1]); a.y = pk2(o1[2], o1[3]); a.z = pk2(o1[4], o1[5]); a.w = pk2(o1[6], o1[7]);
                    b.x = pk2(o2[0], o2[1]); b.y = pk2(o2[2], o2[3]); b.z = pk2(o2[4], o2[5]); b.w = pk2(o2[6], o2[7]);
                    *(LAS u32x4*)(Kn + t * 272 + i0 * 2) = a; *(LAS u32x4*)(Kn + t * 272 + (64 + i0) * 2) = b;
                }
#pragma unroll
                for (int i = 0; i < 8; ++i) { *(LAS unsigned short*)(KdT + (i0 + i) * 144 + tsw) = (unsigned short)f2bf(o1[i] * kd); *(LAS unsigned short*)(KdT + (64 + i0 + i) * 144 + tsw) = (unsigned short)f2bf(o2[i] * kd); }
            }
            if (!state_only) {
                float o1[8], o2[8];
#pragma unroll
                for (int i = 0; i < 8; ++i) { const float x1 = bf2f((unsigned short)rq1[i]), x2 = bf2f((unsigned short)rq2[i]);
                    o1[i] = x1 * cs_c[i] - x2 * cs_s[i]; o2[i] = x1 * cs_s[i] + x2 * cs_c[i]; }
                u32x4 a, b; a.x = pk2(o1[0], o1[1]); a.y = pk2(o1[2], o1[3]); a.z = pk2(o1[4], o1[5]); a.w = pk2(o1[6], o1[7]);
                b.x = pk2(o2[0], o2[1]); b.y = pk2(o2[2], o2[3]); b.z = pk2(o2[4], o2[5]); b.w = pk2(o2[6], o2[7]);
                *(LAS u32x4*)(Qn + t * 272 + i0 * 2) = a; *(LAS u32x4*)(Qn + t * 272 + (64 + i0) * 2) = b;
            }
            {
                const int t0 = tid >> 4, ch = tid & 15, sw = ch & 7;
                const int o0 = (((t0 >> 3) ^ sw) << 4) + (t0 & 7) * 2, o1b = ((((t0 + 32) >> 3) ^ sw) << 4) + (t0 & 7) * 2;
#pragma unroll
                for (int i = 0; i < 8; ++i) { *(LAS short*)(VT + (ch * 8 + i) * 144 + o0) = rv0[i]; *(LAS short*)(VT + (ch * 8 + i) * 144 + o1b) = rv1[i]; }
            }
        }
        if (c + 1 < nchunks) issue(c + 1);
        __syncthreads();
        f32x16 acc;
        if (!state_only) {
#pragma unroll
            for (int r = 0; r < 16; ++r) acc[r] = 0.f;
#pragma unroll
            for (int ks = 0; ks < 8; ++ks) { const bf16x8 a = *(const LAS bf16x8*)(Qn + (lt * 32 + l32) * 272 + (ks * 16 + hf * 8) * 2), b = *(const LAS bf16x8*)(SbT + (et * 32 + l32) * 272 + (ks * 16 + hf * 8) * 2); acc = MFMA32(a, b, acc); }
#pragma unroll
            for (int r = 0; r < 16; ++r) { const int tl = lt * 32 + (r >> 2) * 8 + hf * 4 + (r & 3); acc[r] *= __builtin_amdgcn_exp2f((float)(tl + 1) * lg2); }
            if (wave < 4) {
                const int slt = wave >> 1, smt = wave & 1;
                f32x16 sc;
#pragma unroll
                for (int r = 0; r < 16; ++r) sc[r] = 0.f;
                if (slt >= smt) {
#pragma unroll
                    for (int ks = 0; ks < 8; ++ks) { const bf16x8 a = *(const LAS bf16x8*)(Qn + (slt * 32 + l32) * 272 + (ks * 16 + hf * 8) * 2), b = *(const LAS bf16x8*)(Kn + (smt * 32 + l32) * 272 + (ks * 16 + hf * 8) * 2); sc = MFMA32(a, b, sc); }
                }
                const int tm = smt * 32 + l32;
#pragma unroll
                for (int r = 0; r < 16; ++r) { const int tl = slt * 32 + (r >> 2) * 8 + hf * 4 + (r & 3);
                    const float p = tl >= tm ? sc[r] * __builtin_amdgcn_exp2f((float)(tl - tm) * lg2) : 0.f;
                    *(LAS unsigned short*)(Pm + tl * 144 + tm * 2) = (unsigned short)f2bf(p); }
            }
            __syncthreads();
#pragma unroll
            for (int ms = 0; ms < 4; ++ms) { const bf16x8 a = *(const LAS bf16x8*)(Pm + (lt * 32 + l32) * 144 + (ms * 16 + hf * 8) * 2), b = *(const LAS bf16x8*)(VT + (et * 32 + l32) * 144 + (((ms * 2 + hf) ^ ((et * 4 + (l32 >> 3)) & 7)) << 4)); acc = MFMA32(a, b, acc); }
#pragma unroll
            for (int r = 0; r < 16; ++r) { const int tl = lt * 32 + (r >> 2) * 8 + hf * 4 + (r & 3); of[tl * 132 + et * 32 + l32] = acc[r]; }
        }
#pragma unroll
        for (int r = 0; r < 16; ++r) { S0[r] *= gL; S1[r] *= gL; }
#pragma unroll
        for (int ts = 0; ts < 4; ++ts) {
            const int cc = ts * 2 + hf, rs = l32 >> 3;
            const bf16x8 a = *(const LAS bf16x8*)(KdT + (sdt * 32 + l32) * 144 + ((cc ^ ((sdt * 4 + rs) & 7)) << 4));
            const bf16x8 b0 = *(const LAS bf16x8*)(VT + (set0 * 32 + l32) * 144 + ((cc ^ ((set0 * 4 + rs) & 7)) << 4)), b1 = *(const LAS bf16x8*)(VT + ((set0 + 1) * 32 + l32) * 144 + ((cc ^ (((set0 + 1) * 4 + rs) & 7)) << 4));
            S0 = MFMA32(a, b0, S0); S1 = MFMA32(a, b1, S1);
        }
        if (!state_only) {
#pragma unroll
            for (int g = 0; g < 4; ++g) { const int d0 = sdt * 32 + g * 8 + hf * 4;
                u32x2 a, b; a.x = pk2(S0[4 * g], S0[4 * g + 1]); a.y = pk2(S0[4 * g + 2], S0[4 * g + 3]); b.x = pk2(S1[4 * g], S1[4 * g + 1]); b.y = pk2(S1[4 * g + 2], S1[4 * g + 3]);
                *(LAS u32x2*)(SbT + (set0 * 32 + l32) * 272 + d0 * 2) = a; *(LAS u32x2*)(SbT + ((set0 + 1) * 32 + l32) * 272 + d0 * 2) = b; }
            __syncthreads();
            const f32x2 gr = *(const f32x2*)(P.in[13] + (size_t)(l * 4 + h) * 128 + lane * 2);
#pragma unroll
            for (int rr = 0; rr < 8; ++rr) {
                const int t = wave * 8 + rr;
                if (t < L) {
                    const f32x2 v = *(const LAS f32x2*)(of + t * 132 + lane * 2);
                    const float rstd = rsqrtf(wave_sum(v.x * v.x + v.y * v.y) * (1.f / 128.f) + EPS);
                    const size_t row = (size_t)(row0 + c * 64 + t);
                    const unsigned gg = *(const unsigned*)(QKV + row * INW + 3072 + h * 128 + lane * 2);
                    const float y0 = v.x * rstd * gr.x * silu_f(bf2f(gg & 0xffffu)), y1 = v.y * rstd * gr.y * silu_f(bf2f(gg >> 16));
                    *(unsigned*)(Ob + row * DM + 512 + h * 128 + lane * 2) = pk2(y0, y1);
                }
            }
        }
        __syncthreads();
    }
    if (outst) {
        float* op = outst + (sdt * 32 + hf * 4) * 128 + set0 * 32 + l32;
#pragma unroll
        for (int r = 0; r < 16; ++r) { op[((r >> 2) * 8 + (r & 3)) * 128] = S0[r]; op[((r >> 2) * 8 + (r & 3)) * 128 + 32] = S1[r]; if ((r & 3) == 3) asm volatile("" ::: "memory"); }
    }
}

__global__ void __launch_bounds__(512, 2) fwd_megakernel(Params P) {
    extern __shared__ __attribute__((aligned(16))) unsigned char lds_raw[];
    LAS unsigned char* lds = (LAS unsigned char*)lds_raw;
    cg::grid_group grid = cg::this_grid();
    int tid = threadIdx.x, lane = tid & 63, wave = __builtin_amdgcn_readfirstlane(tid >> 6);
#define REFRESH() do { tid = threadIdx.x; asm volatile("" : "+v"(tid)); lane = tid & 63; wave = __builtin_amdgcn_readfirstlane(tid >> 6); } while (0)
    const int G = gridDim.x, bx = blockIdx.x;
    bf16_t* H = (bf16_t*)(P.ws + WS_H); bf16_t* Ob = (bf16_t*)(P.ws + WS_O); bf16_t* QKV = (bf16_t*)(P.ws + WS_QKV); bf16_t* ACT = QKV;
    float* X = (float*)(P.ws + WS_X); float* U = (float*)(P.ws + WS_U);
    const float* MOD = (const float*)(P.ws + WS_MOD);

#ifndef SK_P0
    p0_phase(P, lds, tid, lane, wave);
#endif
    grid.sync(); REFRESH();
#pragma unroll 1
    for (int l = 0; l < DEPTH; ++l) {
        norm_phase<false>(P, l, l == 0, P.in[7] + (size_t)l * DM, 0, 1024, lane, wave);
        grid.sync(); REFRESH();
#ifndef SK_G1
        {
            pg8::Gemm g{H, (const bf16_t*)(P.ws + WS_WIN) + (size_t)l * INW * DM, MT, INW, DM}; pg8::StaticOrder S; S.init(MT, INW, G, bx);
            EpiQKV E{QKV, P.out, l};
            pg8::gemm_phase<EpiQKV, pg8::StaticOrder, true, true>(lds, g, S, E);
        }
#endif
        grid.sync(); REFRESH();
        for (int u = bx; u < 1360; u += G) {
#ifndef SK_R1
            if (u < 256) { const int bh = u >> 5, seg = u & 31, b = bh >> 2, h = bh & 3;
                ret_unit(P, l, lds, tid, lane, wave, b * SEQ + seg * 512, seg * 512, 8, 64, h, nullptr, U + (size_t)(bh * 32 + seg) * 16384, true); }
            else
#endif
#ifndef SK_RS
            if (u < 320) { const int idx = u - 256, bs = idx >> 2, h = idx & 3; const size_t so = ((size_t)(l * DB + bs) * 4 + h) * 16384;
                ret_unit(P, l, lds, tid, lane, wave, MP + bs * 32, PAST, 1, 32, h, P.in[4] + so, P.out + OFF_RS + so, false); }
            else
#endif
            {}
#ifndef SK_SB
            if (u >= 320) sb_unit(P, l, u - 320, lds, tid, lane, wave);
#endif
        }
        grid.sync(); REFRESH();
        for (int idx = bx * 512 + tid; idx < 8 * 16384; idx += G * 512) {
            const int bh = idx >> 14, within = idx & 16383, h = bh & 3;
            const float g512 = exp2f(512.f * log2f(1.f - exp2f(-5.f - (float)h)));
            float* up = U + (size_t)bh * 32 * 16384 + within; float s = 0.f;
            for (int seg = 0; seg < 32; ++seg) { const float uu = up[(size_t)seg * 16384]; up[(size_t)seg * 16384] = s; s = g512 * s + uu; }
            P.out[OFF_RP + ((size_t)l * 8 + bh) * 16384 + within] = s;
        }
        grid.sync(); REFRESH();
#ifndef SK_R3
        for (int u = bx; u < 256; u += G) { const int bh = u >> 5, seg = u & 31, b = bh >> 2, h = bh & 3;
            ret_unit(P, l, lds, tid, lane, wave, b * SEQ + seg * 512, seg * 512, 8, 64, h, U + (size_t)(bh * 32 + seg) * 16384, nullptr, false); }
#endif
        grid.sync(); REFRESH();
#ifndef SK_G2
        {
            pg8::Gemm g{Ob, (const bf16_t*)(P.ws + WS_WOUT) + (size_t)l * DM * DM, MT, DM, DM}; pg8::StaticOrder S; S.init(MT, DM, G, bx);
            EpiResid E{l == 0 ? P.in[0] : nullptr, l == 0 ? P.in[1] : nullptr, X, MOD + (size_t)l * NBI * NMOD + 2048};
            pg8::gemm_phase<EpiResid, pg8::StaticOrder, true, true>(lds, g, S, E);
        }
#endif
        grid.sync(); REFRESH();
        norm_phase<false>(P, l, false, P.in[8] + (size_t)l * DM, 3072, 4096, lane, wave);
        grid.sync(); REFRESH();
#ifndef SK_G3
        {
            pg8::Gemm g{H, (const bf16_t*)(P.ws + WS_WFI) + (size_t)l * 2 * DFF * DM, MT, 2 * DFF, DM}; pg8::StaticOrder S; S.init(MT, 2 * DFF, G, bx);
            EpiSwiGLU E{ACT};
            pg8::gemm_phase<EpiSwiGLU, pg8::StaticOrder, true, true>(lds, g, S, E);
        }
#endif
        grid.sync(); REFRESH();
#ifndef SK_G4
        {
            pg8::Gemm g{ACT, (const bf16_t*)(P.ws + WS_WFO) + (size_t)l * DM * DFF, MT, DM, DFF}; pg8::StaticOrder S; S.init(MT, DM, G, bx);
            EpiResid E{nullptr, nullptr, X, MOD + (size_t)l * NBI * NMOD + 5120};
            pg8::gemm_phase<EpiResid, pg8::StaticOrder, true, true>(lds, g, S, E);
        }
#endif
        grid.sync(); REFRESH();
    }
    norm_phase<true>(P, 0, false, P.in[17], 0, 0, lane, wave);
}

extern "C" void kernel_launch(void* const* d_in, const int* in_sizes, int n_in, void* d_out, int out_size, void* d_ws, size_t ws_size, hipStream_t stream) {
    static int grid = 0;
    if (grid == 0) {
        if (n_in != 18 || ws_size < WS_END) { fprintf(stderr, "kernel_launch: unexpected n_in %d / ws_size %zu\n", n_in, ws_size); grid = -1; return; }
        int dev = 0, cus = 0, per_cu = 0;
        (void)hipGetDevice(&dev); (void)hipDeviceGetAttribute(&cus, hipDeviceAttributeMultiprocessorCount, dev);
        if (hipFuncSetAttribute((const void*)fwd_megakernel, hipFuncAttributeMaxDynamicSharedMemorySize, LDS_BYTES) != hipSuccess) { fprintf(stderr, "kernel_launch: hipFuncSetAttribute failed\n"); grid = -1; return; }
        (void)hipOccupancyMaxActiveBlocksPerMultiprocessor(&per_cu, (const void*)fwd_megakernel, 512, LDS_BYTES);
        (void)hipGetLastError();
        if (per_cu < 1) { fprintf(stderr, "kernel_launch: occupancy query says %d blocks per CU\n", per_cu); per_cu = 1; }
        grid = cus;
    }
    if (grid < 0) return;
    (void)hipMemsetAsync((char*)d_ws + WS_MOD, 0, MOD_BYTES, stream);
    Params p{};
    for (int i = 0; i < 18; ++i) p.in[i] = (const float*)d_in[i];
    p.out = (float*)d_out; p.ws = (unsigned char*)d_ws;
    void* args[] = {&p};
    hipError_t e = hipLaunchCooperativeKernel((const void*)fwd_megakernel, dim3(grid), dim3(512), args, LDS_BYTES, stream);
    if (e != hipSuccess) fprintf(stderr, "cooperative launch failed: %s (grid %d)\n", hipGetErrorString(e), grid);
}
```

```cpp
#include <hip/hip_runtime.h>
#include <hip/hip_cooperative_groups.h>
#include <cstdio>
#include <cstdint>
namespace cg = cooperative_groups;
namespace pg8 {
#define PG8_LAS __attribute__((address_space(3)))
typedef unsigned short bf16_t;
typedef short bf16x8 __attribute__((ext_vector_type(8)));
typedef float f32x4 __attribute__((ext_vector_type(4)));
typedef unsigned u32x4 __attribute__((ext_vector_type(4)));
constexpr int BM = 256, BK = 64, HALF = 128, HTB = HALF * BK * 2  , STAGE_BYTES = 8 * HTB, NXCD = 8, WGM = 8;

__host__ __device__ __forceinline__ int lds_byte(int r, int c) { const int st = (r >> 4) * 2 + (c >> 5), rr = r & 15, cc = c & 31, ob = rr * 64 + cc * 2; return st * 1024 + (ob ^ (((ob >> 9) & 1) << 5)); }
__host__ __device__ __forceinline__ void stage_rc(int b, int& R, int& C) { const int st = b / 1024, sb = b % 1024, swz = sb ^ (((sb >> 9) & 1) << 5); R = (st >> 1) * 16 + swz / 64; C = (st & 1) * 32 + (swz % 64) / 2; }
__host__ __device__ __forceinline__ int perm32(int rho) { const int n = rho >> 4, i = rho & 15; return 8 * (i >> 2) + 4 * n + (i & 3); }

struct Unit { int pm, pn; };
struct Gemm { const bf16_t* A; const bf16_t* Bt; int M, N, K; };

struct StaticOrder {
    int nM, nN, nwg, G, c;
    __host__ __device__ void init(int M, int N, int G_, int c_) { nM = M / BM; nN = N / BM; nwg = nM * nN; G = G_; c = c_; }
    __host__ __device__ bool next(int i, Unit& u) const {
        const long L = (long)i * G + c; if (L >= nwg) return false;
        int wgid = (int)L; { const int q = nwg / NXCD, r = nwg % NXCD, xcd = wgid % NXCD, off = wgid / NXCD; wgid = (xcd < r ? xcd * (q + 1) : r * (q + 1) + (xcd - r) * q) + off; }
        const int nig = WGM * nN, gid = wgid / nig, fm = gid * WGM, gsz = (nM - fm) < WGM ? (nM - fm) : WGM;
        u.pm = fm + ((wgid % nig) % gsz); u.pn = (wgid % nig) / gsz; return true;
    }
    __device__ __forceinline__ void a_ready(const Unit&) const {}
    __device__ __forceinline__ void done(const Unit&) const {}
};

__device__ __forceinline__ unsigned cvt_pk_bf16(float lo, float hi) { unsigned r; asm volatile("v_cvt_pk_bf16_f32 %0, %1, %2" : "=v"(r) : "v"(lo), "v"(hi)); return r; }
typedef float f32x2 __attribute__((ext_vector_type(2)));
__device__ __forceinline__ f32x2 gelu_pk(f32x2 v) {
    const f32x2 av = __builtin_elementwise_abs(v), d = av * 0.2316418882f + 1.0f;
    f32x2 t; t.x = __builtin_amdgcn_rcpf(d.x); t.y = __builtin_amdgcn_rcpf(d.y);
    f32x2 q = t * 0.5307027145f + (-0.7265760135f); q = q * t + 0.7107068705f; q = q * t + (-0.142248368f); q = q * t + 0.127414796f; q = q * t;
    const f32x2 s = (v * v) * (-0.72134752044f);
    f32x2 e; e.x = __builtin_amdgcn_exp2f(s.x); e.y = __builtin_amdgcn_exp2f(s.y);
    const f32x2 m = v * (q * e), r = v - m;
    f32x2 o; o.x = v.x < 0.f ? m.x : r.x; o.y = v.y < 0.f ? m.y : r.y; return o;
}

template <int ACT  > struct EpiBf16 {
    static constexpr bool PERM = true, AFTER_DRAIN = false; static_assert(ACT == 0 || ACT == 1, "EpiBf16: ACT is 0 (none) or 1 (gelu_pk)");
    bf16_t* O; int ldc; const float* bias; int split_cols; size_t split_stride; float scale0;
    __device__ __forceinline__ void operator()(const f32x4 (&acc)[2][2][4][2], const Unit& u, int wr, int wc, int fr, int fq) const {
        const int row0 = u.pm * BM + wr * 64 + fr; int colt = u.pn * BM; bf16_t* base = O;
        float sc = 1.f; if (split_cols) { const int t = colt / split_cols; base += (size_t)t * split_stride; colt -= t * split_cols; if (t == 0) sc = scale0; }
        const int col0 = colt + wc * 32 + 8 * fq, bcol0 = u.pn * BM + wc * 32 + 8 * fq;
        f32x4 bv[2][2];
#pragma unroll
        for (int bj = 0; bj < 2; ++bj)
#pragma unroll
            for (int n = 0; n < 2; ++n) bv[bj][n] = bias ? *(const f32x4*)(bias + bcol0 + bj * HALF + 4 * n) : (f32x4){0.f, 0.f, 0.f, 0.f};
#pragma unroll
        for (int ai = 0; ai < 2; ++ai)
#pragma unroll
            for (int m = 0; m < 4; ++m) { bf16_t* rowp = base + (size_t)(row0 + ai * HALF + m * 16) * ldc + col0;
#pragma unroll
                for (int bj = 0; bj < 2; ++bj) { f32x4 v0 = acc[ai][bj][m][0] + bv[bj][0], v1 = acc[ai][bj][m][1] + bv[bj][1];
                    if (ACT == 1) { f32x2 a = gelu_pk((f32x2){v0[0], v0[1]}), b = gelu_pk((f32x2){v0[2], v0[3]}), c = gelu_pk((f32x2){v1[0], v1[1]}), d = gelu_pk((f32x2){v1[2], v1[3]});
                        v0 = (f32x4){a.x, a.y, b.x, b.y}; v1 = (f32x4){c.x, c.y, d.x, d.y}; }
                    v0 = v0 * sc; v1 = v1 * sc; u32x4 w; w.x = cvt_pk_bf16(v0[0], v0[1]); w.y = cvt_pk_bf16(v0[2], v0[3]); w.z = cvt_pk_bf16(v1[0], v1[1]); w.w = cvt_pk_bf16(v1[2], v1[3]);
                    *(u32x4*)(rowp + bj * HALF) = w; } }
    }
};
template <class Epi, class Sched, bool ALIGN_EPI = false, bool SP2 = false>
__device__ __forceinline__ void gemm_phase(PG8_LAS unsigned char* lds, const Gemm g, const Sched& S, const Epi& E) {
    int tid_o = threadIdx.x; asm volatile("" : "+v"(tid_o));
    const int tid = tid_o, wid = __builtin_amdgcn_readfirstlane(tid >> 6), lane = tid & 63, wr = wid >> 2, wc = wid & 3, fr = lane & 15, fq = lane >> 4;
    const int K = g.K, nt = K / BK;
    unsigned voffA[2], voffB[2];
#pragma unroll
    for (int i = 0; i < 2; ++i) { int R, C; stage_rc(tid * 16 + i * 8192, R, C); const int Rb = Epi::PERM ? ((R & ~31) + perm32(R & 31)) : R;
        voffA[i] = (unsigned)(R * K + C) * 2u; voffB[i] = (unsigned)(Rb * K + C) * 2u; }
    const size_t kstep = (size_t)(BK * 2);
    const size_t hstep = (size_t)HALF * K * 2;
    const size_t tstep = 2 * hstep;
    const unsigned ldsw = (unsigned)wid * 1024u;
    const int aoff = lds_byte(wr * 64 + fr, fq * 8), boff = lds_byte(wc * 32 + fr, fq * 8);
#define PG8_SA(b, h) (((b) * 2 + (h)) * HTB)
#define PG8_SB(b, h) ((4 + (b) * 2 + (h)) * HTB)
#define PG8_STAGE(bufoff, gbase, voff) do { _Pragma("unroll") for (int _i = 0; _i < 2; ++_i) \
        __builtin_amdgcn_global_load_lds((const unsigned*)((const char*)(gbase) + (voff)[_i]), (PG8_LAS unsigned*)(lds + (bufoff) + ldsw + _i * 8192), 16, 0, 0); } while (0)
#define PG8_LDA(dst, b, h) do { _Pragma("unroll") for (int m = 0; m < 4; ++m) _Pragma("unroll") for (int k = 0; k < 2; ++k) dst[m][k] = *(const PG8_LAS bf16x8*)(lds + PG8_SA(b, h) + aoff + m * 2048 + k * 1024); } while (0)
#define PG8_LDB(dst, b, h) do { _Pragma("unroll") for (int n = 0; n < 2; ++n) _Pragma("unroll") for (int k = 0; k < 2; ++k) dst[n][k] = *(const PG8_LAS bf16x8*)(lds + PG8_SB(b, h) + boff + n * 2048 + k * 1024); } while (0)
#define PG8_MMA(ai, bj, At, Bt) do { __builtin_amdgcn_s_setprio(1); _Pragma("unroll") for (int m = 0; m < 4; ++m) _Pragma("unroll") for (int n = 0; n < 2; ++n) _Pragma("unroll") for (int k = 0; k < 2; ++k) \
        acc[ai][bj][m][n] = __builtin_amdgcn_mfma_f32_16x16x32_bf16(Bt[n][k], At[m][k], acc[ai][bj][m][n], 0, 0, 0); __builtin_amdgcn_s_setprio(0); } while (0)
#define PG8_WAIT_V(n) asm volatile("s_waitcnt vmcnt(" #n ")" ::: "memory")
#define PG8_WAIT_L(n) asm volatile("s_waitcnt lgkmcnt(" #n ")" ::: "memory")
#define PG8_BAR __builtin_amdgcn_s_barrier()
#define PG8_SCHED __builtin_amdgcn_sched_barrier(0)
    Unit cur, nxt; int ui = 0;
    if (!S.next(0, cur)) return;
    f32x4 acc[2][2][4][2];
#pragma unroll
    for (int a = 0; a < 2; ++a)
#pragma unroll
        for (int b = 0; b < 2; ++b)
#pragma unroll
            for (int m = 0; m < 4; ++m)
#pragma unroll
                for (int n = 0; n < 2; ++n) acc[a][b][m][n] = (f32x4){0.f, 0.f, 0.f, 0.f};
    bf16x8 At[4][2], B0[2][2], B1[2][2];
    const char* cA = (const char*)g.A + (size_t)cur.pm * tstep; const char* cB = (const char*)g.Bt + (size_t)cur.pn * tstep;
    S.a_ready(cur);
    if constexpr (SP2) {
        PG8_STAGE(PG8_SB(0, 0), cB, voffB); PG8_STAGE(PG8_SB(0, 1), cB + hstep, voffB); PG8_STAGE(PG8_SA(0, 0), cA, voffA); PG8_STAGE(PG8_SA(0, 1), cA + hstep, voffA);
        if (wr == 1) PG8_BAR;
        PG8_WAIT_V(2); PG8_BAR;
        PG8_STAGE(PG8_SB(1, 0), cB + kstep, voffB); PG8_STAGE(PG8_SA(1, 0), cA + kstep, voffA); PG8_STAGE(PG8_SB(1, 1), cB + hstep + kstep, voffB);
        PG8_WAIT_V(6); PG8_BAR;
    } else {
        PG8_STAGE(PG8_SB(0, 0), cB, voffB); PG8_STAGE(PG8_SA(0, 0), cA, voffA); PG8_STAGE(PG8_SB(0, 1), cB + hstep, voffB); PG8_STAGE(PG8_SA(0, 1), cA + hstep, voffA);
        if (wr == 1) PG8_BAR;
        PG8_WAIT_V(4); PG8_BAR;
        PG8_STAGE(PG8_SB(1, 0), cB + kstep, voffB); PG8_STAGE(PG8_SA(1, 0), cA + kstep, voffA); PG8_STAGE(PG8_SB(1, 1), cB + hstep + kstep, voffB);
        PG8_WAIT_V(6); PG8_BAR;
    }
    for (;;) {
        const bool has_next = S.next(ui + 1, nxt);
        const char* nA = has_next ? (const char*)g.A + (size_t)nxt.pm * tstep : cA; const char* nB = has_next ? (const char*)g.Bt + (size_t)nxt.pn * tstep : cB;
        for (int t = 0; t < nt; t += 2) {
            const bool last = (t == nt - 2);
            const char* a1 = cA + (size_t)(t + 1) * kstep;
            const char* a2 = last ? nA : cA + (size_t)(t + 2) * kstep; const char* b2 = last ? nB : cB + (size_t)(t + 2) * kstep;
            const char* a3 = a2 + kstep; const char* b3 = b2 + kstep;
            if (last && has_next) S.a_ready(nxt);
            if constexpr (SP2) {
            PG8_LDB(B0, 0, 0); PG8_LDB(B1, 0, 1); PG8_SCHED; PG8_LDA(At, 0, 0); PG8_STAGE(PG8_SA(1, 1), a1 + hstep, voffA);
            PG8_WAIT_V(8); PG8_WAIT_L(0); PG8_BAR; PG8_MMA(0, 0, At, B0); PG8_MMA(0, 1, At, B1); PG8_BAR; PG8_SCHED;
            PG8_LDA(At, 0, 1); PG8_STAGE(PG8_SB(0, 0), b2, voffB); PG8_STAGE(PG8_SB(0, 1), b2 + hstep, voffB); PG8_STAGE(PG8_SA(0, 0), a2, voffA);
            PG8_WAIT_V(8); PG8_WAIT_L(0); PG8_BAR; PG8_MMA(1, 0, At, B0); PG8_MMA(1, 1, At, B1); PG8_BAR; PG8_SCHED;
            PG8_LDB(B0, 1, 0); PG8_LDB(B1, 1, 1); PG8_SCHED; PG8_LDA(At, 1, 0); PG8_STAGE(PG8_SA(0, 1), a2 + hstep, voffA);
            PG8_WAIT_V(8); PG8_WAIT_L(0); PG8_BAR; PG8_MMA(0, 0, At, B0); PG8_MMA(0, 1, At, B1); PG8_BAR; PG8_SCHED;
            PG8_LDA(At, 1, 1); PG8_STAGE(PG8_SB(1, 0), b3, voffB); PG8_STAGE(PG8_SB(1, 1), b3 + hstep, voffB); PG8_STAGE(PG8_SA(1, 0), a3, voffA);
            PG8_WAIT_V(8); PG8_WAIT_L(0); PG8_BAR; PG8_MMA(1, 0, At, B0); PG8_MMA(1, 1, At, B1); PG8_BAR; PG8_SCHED;
            } else {
            PG8_LDB(B0, 0, 0); PG8_SCHED; PG8_LDA(At, 0, 0); PG8_STAGE(PG8_SA(1, 1), a1 + hstep, voffA);
            PG8_WAIT_L(8); PG8_BAR; PG8_WAIT_L(0); PG8_MMA(0, 0, At, B0); PG8_BAR; PG8_SCHED;
            PG8_LDB(B1, 0, 1); PG8_STAGE(PG8_SB(0, 0), b2, voffB);
            PG8_BAR; PG8_WAIT_L(0); PG8_MMA(0, 1, At, B1); PG8_BAR;
            PG8_LDA(At, 0, 1); PG8_STAGE(PG8_SA(0, 0), a2, voffA);
            PG8_BAR; PG8_WAIT_L(0); PG8_MMA(1, 0, At, B0); PG8_BAR; PG8_SCHED;
            PG8_STAGE(PG8_SB(0, 1), b2 + hstep, voffB);
            PG8_WAIT_V(6); PG8_BAR; PG8_MMA(1, 1, At, B1); PG8_BAR;
            PG8_LDB(B0, 1, 0); PG8_SCHED; PG8_LDA(At, 1, 0); PG8_STAGE(PG8_SA(0, 1), a2 + hstep, voffA);
            PG8_WAIT_L(8); PG8_BAR; PG8_WAIT_L(0); PG8_MMA(0, 0, At, B0); PG8_BAR; PG8_SCHED;
            PG8_LDB(B1, 1, 1); PG8_STAGE(PG8_SB(1, 0), b3, voffB);
            PG8_BAR; PG8_WAIT_L(0); PG8_MMA(0, 1, At, B1); PG8_BAR;
            PG8_LDA(At, 1, 1); PG8_STAGE(PG8_SA(1, 0), a3, voffA);
            PG8_BAR; PG8_WAIT_L(0); PG8_MMA(1, 0, At, B0); PG8_BAR; PG8_SCHED;
            PG8_STAGE(PG8_SB(1, 1), b3 + hstep, voffB);
            PG8_WAIT_V(6); PG8_BAR; PG8_MMA(1, 1, At, B1); PG8_BAR;
            }
        }
        if constexpr (ALIGN_EPI) { if (wr == 0) PG8_BAR; }
        if constexpr (!Epi::AFTER_DRAIN) { E(acc, cur, wr, wc, fr, fq); S.done(cur); }
        if (!has_next) break;
#pragma unroll
        for (int a = 0; a < 2; ++a)
#pragma unroll
            for (int b = 0; b < 2; ++b)
#pragma unroll
                for (int m = 0; m < 4; ++m)
#pragma unroll
                    for (int n = 0; n < 2; ++n) acc[a][b][m][n] = (f32x4){0.f, 0.f, 0.f, 0.f};
        cur = nxt; cA = nA; cB = nB; ++ui;
        if constexpr (ALIGN_EPI) { if (wr == 1) PG8_BAR; }
    }
    PG8_WAIT_V(0);
    if constexpr (!ALIGN_EPI) { if (wr == 0) PG8_BAR; }
    PG8_BAR;
    if constexpr (Epi::AFTER_DRAIN) { E.fused(acc, cur, wr, wc, fr, fq, lds, wid, lane); S.done(cur); }
#undef PG8_SA
#undef PG8_SB
#undef PG8_STAGE
#undef PG8_LDA
#undef PG8_LDB
#undef PG8_MMA
#undef PG8_WAIT_V
#undef PG8_WAIT_L
#undef PG8_BAR
#undef PG8_SCHED
}
}

#define LAS __attribute__((address_space(3)))
typedef unsigned short bf16_t;
typedef short bf16x8 __attribute__((ext_vector_type(8)));
typedef float f32x4 __attribute__((ext_vector_type(4)));
typedef float f32x2 __attribute__((ext_vector_type(2)));
typedef float f32x16 __attribute__((ext_vector_type(16)));
typedef unsigned u32x4 __attribute__((ext_vector_type(4)));
typedef unsigned u32x2 __attribute__((ext_vector_type(2)));
#define MFMA32(a, b, c) __builtin_amdgcn_mfma_f32_32x32x16_bf16((a), (b), (c), 0, 0, 0)

constexpr int DM = 1024, SEQ = 16384, NBP = 2, DEPTH = 4, DB = 16, DS = 32, PAST = 2048;
constexpr int MP = NBP * SEQ, MS = DB * DS, MT = MP + MS;
constexpr int INW = 3584, DFF = 2816, NMOD = 6144, NBI = 18;
constexpr float EPS = 1e-6f;
constexpr size_t OFF_YP = 0, OFF_YS = 33554432, OFF_KP = 34078720, OFF_VP = 101187584, OFF_RP = 168296448,
                 OFF_KS = 168820736, OFF_VS = 169869312, OFF_RS = 170917888;
constexpr size_t MiB = 1u << 20;
constexpr size_t WS_MOD = 0, MOD_BYTES = 2 * MiB; constexpr size_t WS_BAR = 1802240;
constexpr size_t WS_ROPE = 2 * MiB;
constexpr size_t WS_WIN = 10 * MiB, WS_WOUT = 38 * MiB, WS_WFI = 46 * MiB, WS_WFO = 90 * MiB;
constexpr size_t WS_X = 112 * MiB;
constexpr size_t WS_H = 242 * MiB;
constexpr size_t WS_O = 307 * MiB;
constexpr size_t WS_QKV = 372 * MiB;
constexpr size_t WS_U = 600 * MiB;
constexpr size_t WS_END = 616 * MiB;
constexpr int LDS_BYTES = 147456;

struct Params { const float* in[18]; float* out; unsigned char* ws; };

__device__ __forceinline__ unsigned f2bf(float f) { unsigned u = __builtin_bit_cast(unsigned, f); return (u + 0x7fffu + ((u >> 16) & 1u)) >> 16; }
__device__ __forceinline__ unsigned pk2(float lo, float hi) { return f2bf(lo) | (f2bf(hi) << 16); }
__device__ __forceinline__ float bf2f(unsigned h) { return __builtin_bit_cast(float, h << 16); }
__device__ __forceinline__ bf16x8 pack8(f32x4 a, f32x4 b) { u32x4 p; p.x = pk2(a.x, a.y); p.y = pk2(a.z, a.w); p.z = pk2(b.x, b.y); p.w = pk2(b.z, b.w); return __builtin_bit_cast(bf16x8, p); }
__device__ __forceinline__ float wave_sum(float v) {
#pragma unroll
    for (int o = 1; o < 64; o <<= 1) v += __shfl_xor(v, o);
    return v;
}
__device__ __forceinline__ float silu_f(float x) { return x * __builtin_amdgcn_rcpf(1.f + __expf(-x)); }
__device__ __forceinline__ int batch_of(int row) { return row < MP ? (row >> 14) : 2 + ((row - MP) >> 5); }

struct EpiQKV {
    static constexpr bool PERM = true, AFTER_DRAIN = false;
    bf16_t* QKV; float* out; int layer;
    __device__ __forceinline__ void operator()(const pg8::f32x4 (&acc)[2][2][4][2], const pg8::Unit& u, int wr, int wc, int fr, int fq) const {
        const int row0 = u.pm * 256 + wr * 64 + fr, col0 = u.pn * 256 + wc * 32 + 8 * fq;
        const bool kv = (u.pn >= 2 && u.pn < 6);
        const size_t vsel = (u.pn >= 4) ? 1 : 0;
        const size_t obase = (u.pm < 128) ? OFF_KP + vsel * (OFF_VP - OFF_KP) + (size_t)layer * MP * 512 + (size_t)row0 * 512
                                          : OFF_KS + vsel * (OFF_VS - OFF_KS) + (size_t)layer * MS * 512 + (size_t)(row0 - MP) * 512;
#pragma unroll
        for (int ai = 0; ai < 2; ++ai)
#pragma unroll
            for (int m = 0; m < 4; ++m) {
                const int row = row0 + ai * 128 + m * 16;
#pragma unroll
                for (int bj = 0; bj < 2; ++bj) {
                    const int col = col0 + bj * 128;
                    const pg8::f32x4 v0 = acc[ai][bj][m][0], v1 = acc[ai][bj][m][1];
                    u32x4 w; w.x = pg8::cvt_pk_bf16(v0[0], v0[1]); w.y = pg8::cvt_pk_bf16(v0[2], v0[3]); w.z = pg8::cvt_pk_bf16(v1[0], v1[1]); w.w = pg8::cvt_pk_bf16(v1[2], v1[3]);
                    *(u32x4*)(QKV + (size_t)row * INW + col) = w;
                    if (kv) {
                        const int c = col & 511;
                        float* dst = out + obase + (size_t)(ai * 128 + m * 16) * 512 + c;
                        *(pg8::f32x4*)dst = v0; *(pg8::f32x4*)(dst + 4) = v1;
                    }
                }
                asm volatile("" ::: "memory");
            }
    }
};
struct EpiResid {
    static constexpr bool PERM = false, AFTER_DRAIN = false;
    const float* base_p; const float* base_s;
    float* X; const float* gate;
    __device__ __forceinline__ void operator()(const pg8::f32x4 (&acc)[2][2][4][2], const pg8::Unit& u, int wr, int wc, int fr, int fq) const {
        const int col0 = u.pn * 256 + wc * 32 + 4 * fq;
#pragma unroll
        for (int ai = 0; ai < 2; ++ai)
#pragma unroll
            for (int m = 0; m < 4; ++m) {
                const int row = u.pm * 256 + ai * 128 + wr * 64 + m * 16 + fr;
                const float* br = base_p ? (row < MP ? base_p + (size_t)row * DM : base_s + (size_t)(row - MP) * DM) : X + (size_t)row * DM;
                const float* gr = gate + (size_t)batch_of(row) * NMOD; float* xr = X + (size_t)row * DM;
#pragma unroll
                for (int bj = 0; bj < 2; ++bj)
#pragma unroll
                    for (int n = 0; n < 2; ++n) { const int c = col0 + bj * 128 + n * 16;
                        const pg8::f32x4 b = *(const pg8::f32x4*)(br + c), g = *(const pg8::f32x4*)(gr + c);
                        *(pg8::f32x4*)(xr + c) = b + g * acc[ai][bj][m][n]; }
                asm volatile("" ::: "memory");
            }
    }
};
struct EpiSwiGLU {
    static constexpr bool PERM = true, AFTER_DRAIN = false;
    bf16_t* ACT;
    __device__ __forceinline__ void operator()(const pg8::f32x4 (&acc)[2][2][4][2], const pg8::Unit& u, int wr, int wc, int fr, int fq) const {
        const int col0 = u.pn * 128 + wc * 32 + 8 * fq;
#pragma unroll
        for (int ai = 0; ai < 2; ++ai)
#pragma unroll
            for (int m = 0; m < 4; ++m) {
                const int row = u.pm * 256 + ai * 128 + wr * 64 + m * 16 + fr;
                const pg8::f32x4 g0 = acc[ai][0][m][0], g1 = acc[ai][0][m][1], u0 = acc[ai][1][m][0], u1 = acc[ai][1][m][1];
                float r[8];
#pragma unroll
                for (int j = 0; j < 4; ++j) { r[j] = silu_f(g0[j]) * u0[j]; r[4 + j] = silu_f(g1[j]) * u1[j]; }
                u32x4 w; w.x = pg8::cvt_pk_bf16(r[0], r[1]); w.y = pg8::cvt_pk_bf16(r[2], r[3]); w.z = pg8::cvt_pk_bf16(r[4], r[5]); w.w = pg8::cvt_pk_bf16(r[6], r[7]);
                *(u32x4*)(ACT + (size_t)row * DFF + col0) = w;
                asm volatile("" ::: "memory");
            }
    }
};

__device__ __forceinline__ void transpose_item(const float* W, int K, int N, bf16_t* WT, LAS float* scr, int item, int lane, bool perm) {
    const int nblk = N / 32, kb = item / nblk, nb = item % nblk, k0 = 64 * kb, n0 = 32 * nb;
    int p0 = n0;
    if (perm) { if (n0 < DFF) p0 = (n0 >> 7) * 256 + (n0 & 127); else { const int n1 = n0 - DFF; p0 = (n1 >> 7) * 256 + 128 + (n1 & 127); } }
#pragma unroll 8
    for (int i = 0; i < 32; ++i) { const int kk = 2 * i + (lane >> 5); scr[kk * 33 + (lane & 31)] = W[(size_t)(k0 + kk) * N + n0 + (lane & 31)]; }
    asm volatile("s_waitcnt lgkmcnt(0)" ::: "memory"); __builtin_amdgcn_wave_barrier();
    const int c = lane & 7;
#pragma unroll
    for (int j = 0; j < 4; ++j) { const int n = (lane >> 3) + 8 * j; const LAS float* s = scr + (8 * c) * 33 + n;
        u32x4 o; o.x = pk2(s[0 * 33], s[1 * 33]); o.y = pk2(s[2 * 33], s[3 * 33]); o.z = pk2(s[4 * 33], s[5 * 33]); o.w = pk2(s[6 * 33], s[7 * 33]);
        *(u32x4*)(WT + (size_t)(p0 + n) * K + k0 + 8 * c) = o; }
    asm volatile("s_waitcnt lgkmcnt(0)" ::: "memory"); __builtin_amdgcn_wave_barrier();
}

__device__ __forceinline__ void p0_phase(const Params& P, LAS unsigned char* lds, int tid, int lane, int wave) {
    LAS float* sc = (LAS float*)lds;
    for (int i = tid; i < NBI * DM; i += 512) { const int b = i >> 10, k = i & 1023; const float c = b < 2 ? P.in[5][b * DM + k] : P.in[6][(b - 2) * DM + k]; sc[i] = silu_f(c); }
    __syncthreads();
    const int gw = blockIdx.x * 8 + wave, NGW = gridDim.x * 8;
    float* MOD = (float*)(P.ws + WS_MOD);
    for (int it = gw; it < 768; it += NGW) {
        const int l = it / 192, r = it % 192, cb = r >> 3, kc = r & 7;
        f32x4 acc[NBI];
#pragma unroll
        for (int b = 0; b < NBI; ++b) acc[b] = (f32x4){0.f, 0.f, 0.f, 0.f};
        const float* wp = P.in[9] + ((size_t)l * DM + kc * 128) * NMOD + cb * 256 + lane * 4;
        const LAS float* scp = sc + kc * 128;
#pragma unroll 4
        for (int k = 0; k < 128; ++k) { const f32x4 w = *(const f32x4*)(wp + (size_t)k * NMOD);
#pragma unroll
            for (int b = 0; b < NBI; ++b) acc[b] += scp[b * DM + k] * w; }
        if (kc == 0) { const f32x4 bv = *(const f32x4*)(P.in[10] + (size_t)l * NMOD + cb * 256 + lane * 4);
#pragma unroll
            for (int b = 0; b < NBI; ++b) acc[b] += bv; }
        float* mp = MOD + (size_t)l * NBI * NMOD + cb * 256 + lane * 4;
#pragma unroll
        for (int b = 0; b < NBI; ++b) { atomicAdd(mp + b * NMOD + 0, acc[b].x); atomicAdd(mp + b * NMOD + 1, acc[b].y); atomicAdd(mp + b * NMOD + 2, acc[b].z); atomicAdd(mp + b * NMOD + 3, acc[b].w); }
    }
    LAS float* scr = (LAS float*)(lds + 73728 + wave * 8448);
    constexpr int I_IN = 16 * 112, I_OUT = 16 * 32, I_FI = 16 * 176, I_FO = 44 * 32, I_L = I_IN + I_OUT + I_FI + I_FO;
    for (int it = gw; it < DEPTH * I_L; it += NGW) {
        const int l = it / I_L; int r = it % I_L;
        if (r < I_IN) { transpose_item(P.in[11] + (size_t)l * DM * INW, DM, INW, (bf16_t*)(P.ws + WS_WIN) + (size_t)l * INW * DM, scr, r, lane, false); continue; } r -= I_IN;
        if (r < I_OUT) { transpose_item(P.in[14] + (size_t)l * DM * DM, DM, DM, (bf16_t*)(P.ws + WS_WOUT) + (size_t)l * DM * DM, scr, r, lane, false); continue; } r -= I_OUT;
        if (r < I_FI) { transpose_item(P.in[15] + (size_t)l * DM * 2 * DFF, DM, 2 * DFF, (bf16_t*)(P.ws + WS_WFI) + (size_t)l * 2 * DFF * DM, scr, r, lane, true); continue; } r -= I_FI;
        transpose_item(P.in[16] + (size_t)l * DFF * DM, DFF, DM, (bf16_t*)(P.ws + WS_WFO) + (size_t)l * DM * DFF, scr, r, lane, false);
    }
    f32x2* ROPE = (f32x2*)(P.ws + WS_ROPE);
    for (int idx = blockIdx.x * 512 + tid; idx < SEQ * 64; idx += gridDim.x * 512) {
        const int pos = idx >> 6, i = idx & 63;
        const float inv = exp2f(-(float)i * (13.287712379549449f / 64.f));
        const float ang = (float)pos * inv;
        double rev = (double)ang * 0.15915494309189535; rev -= floor(rev);
        const float rf = (float)rev;
        ROPE[idx] = (f32x2){__builtin_amdgcn_cosf(rf), __builtin_amdgcn_sinf(rf)};
    }
}

template <bool FINAL>
__device__ __forceinline__ void norm_phase(const Params& P, int l, bool from_input, const float* gain, int sh_off, int sc_off, int lane, int wave) {
    const int gw = blockIdx.x * 8 + wave, NGW = gridDim.x * 8;
    const float* MOD = (const float*)(P.ws + WS_MOD) + (size_t)l * NBI * NMOD;
    const float* X = (const float*)(P.ws + WS_X); bf16_t* H = (bf16_t*)(P.ws + WS_H);
    f32x4 g[4];
#pragma unroll
    for (int j = 0; j < 4; ++j) g[j] = *(const f32x4*)(gain + 4 * lane + 256 * j);
    for (int m = gw; m < MT; m += NGW) {
        const float* xr = (!FINAL && from_input) ? (m < MP ? P.in[0] + (size_t)m * DM : P.in[1] + (size_t)(m - MP) * DM) : X + (size_t)m * DM;
        f32x4 v[4]; float ss = 0.f;
#pragma unroll
        for (int j = 0; j < 4; ++j) { v[j] = *(const f32x4*)(xr + 4 * lane + 256 * j); ss += (v[j].x * v[j].x + v[j].y * v[j].y) + (v[j].z * v[j].z + v[j].w * v[j].w); }
        const float rstd = rsqrtf(wave_sum(ss) * (1.f / DM) + EPS);
        if (FINAL) {
            float* o = P.out + (size_t)m * DM;
#pragma unroll
            for (int j = 0; j < 4; ++j) *(f32x4*)(o + 4 * lane + 256 * j) = v[j] * rstd * g[j];
        } else {
            const float* mr = MOD + (size_t)batch_of(m) * NMOD;
#pragma unroll
            for (int j = 0; j < 4; ++j) { const int c = 4 * lane + 256 * j;
                const f32x4 sc = *(const f32x4*)(mr + sc_off + c), sh = *(const f32x4*)(mr + sh_off + c);
                const f32x4 hh = v[j] * rstd * g[j] * (1.f + sc) + sh;
                u32x2 w; w.x = pk2(hh.x, hh.y); w.y = pk2(hh.z, hh.w);
                *(u32x2*)(H + (size_t)m * DM + c) = w; }
        }
    }
}

__device__ __forceinline__ void sb_unit(const Params& P, int l, int u, LAS unsigned char* lds, int tid, int lane, int wave) {
    const bf16_t* QKV = (const bf16_t*)(P.ws + WS_QKV);
    const int h = wave, l32 = lane & 31, hf = lane >> 5;
    const bool samp = u >= 1024;
    int qrow0, nsteps; const float* ck = nullptr; const float* cv = nullptr;
    if (!samp) { const int b = u >> 9, qb = u & 511; qrow0 = b * SEQ + qb * 32; nsteps = qb + 1; }
    else { const int bs = u - 1024; qrow0 = MP + bs * 32; nsteps = 65; ck = P.in[2] + (size_t)(l * DB + bs) * PAST * 512; cv = P.in[3] + (size_t)(l * DB + bs) * PAST * 512; }
    bf16x8 qf[4];
#pragma unroll
    for (int ks = 0; ks < 4; ++ks) qf[ks] = *(const bf16x8*)(QKV + (size_t)(qrow0 + l32) * INW + h * 64 + ks * 16 + hf * 8);
    f32x16 O0, O1;
#pragma unroll
    for (int r = 0; r < 16; ++r) { O0[r] = 0.f; O1[r] = 0.f; }
    float cum = 0.f;
    LAS unsigned char* vt = lds + 66048 + wave * 4608;
    auto issue = [&](int s, bf16x8 (&k)[4], bf16x8 (&v)[4]) {
        if (!samp || s == 0) {
            const int krow0 = samp ? qrow0 : qrow0 - s * 32;
#pragma unroll
            for (int ks = 0; ks < 4; ++ks) k[ks] = *(const bf16x8*)(QKV + (size_t)(krow0 + l32) * INW + 512 + h * 64 + ks * 16 + hf * 8);
#pragma unroll
            for (int it = 0; it < 4; ++it) { const int id = it * 64 + lane, key = id >> 3, ch = id & 7;
                v[it] = *(const bf16x8*)(QKV + (size_t)(krow0 + key) * INW + 1024 + h * 64 + ch * 8); }
        } else {
            const int kpos0 = (64 - s) * 32;
#pragma unroll
            for (int ks = 0; ks < 4; ++ks) { const float* p = ck + (size_t)(kpos0 + l32) * 512 + h * 64 + ks * 16 + hf * 8; k[ks] = pack8(*(const f32x4*)p, *(const f32x4*)(p + 4)); }
#pragma unroll
            for (int it = 0; it < 4; ++it) { const int id = it * 64 + lane, key = id >> 3, ch = id & 7;
                const float* p = cv + (size_t)(kpos0 + key) * 512 + h * 64 + ch * 8;
                v[it] = pack8(*(const f32x4*)p, *(const f32x4*)(p + 4)); }
        }
    };
    bf16x8 kf[4], vr[4];
    issue(0, kf, vr);
    for (int s = 0; s < nsteps; ++s) {
#pragma unroll
        for (int it = 0; it < 4; ++it) { const int id = it * 64 + lane, key = id >> 3, ch = id & 7; *(LAS bf16x8*)(vt + key * 144 + ch * 16) = vr[it]; }
        bf16x8 kn[4];
#pragma unroll
        for (int ks = 0; ks < 4; ++ks) kn[ks] = kf[ks];
        if (s + 1 < nsteps) issue(s + 1, kn, vr);
        asm volatile("s_waitcnt lgkmcnt(0)" ::: "memory"); __builtin_amdgcn_wave_barrier();
        f32x16 S;
#pragma unroll
        for (int r = 0; r < 16; ++r) S[r] = 0.f;
#pragma unroll
        for (int ks = 0; ks < 4; ++ks) S = MFMA32(kf[ks], qf[ks], S);
        float L[16], lb[16]; bool valid[16];
#pragma unroll
        for (int r = 0; r < 16; ++r) {
            const float z = S[r] * 0.125f;
            const float sp = fmaxf(z, 0.f) + __logf(1.f + __expf(-fabsf(z)));
            const int key = (r >> 2) * 8 + hf * 4 + (r & 3);
            valid[r] = (s != 0) || (key < l32);
            L[r] = valid[r] ? -sp : 0.f; lb[r] = z - sp;
        }
        float T[4], Pp[4];
#pragma unroll
        for (int g = 0; g < 4; ++g) { T[g] = (L[4 * g] + L[4 * g + 1]) + (L[4 * g + 2] + L[4 * g + 3]); Pp[g] = __shfl_xor(T[g], 32); }
        float later[4]; float tot = 0.f;
#pragma unroll
        for (int g = 3; g >= 0; --g) { later[g] = tot; tot += T[g] + Pp[g]; }
        float w[16];
#pragma unroll
        for (int g = 0; g < 4; ++g) {
            const float s3 = cum + later[g] + (hf == 0 ? Pp[g] : 0.f);
            const float s2 = s3 + L[4 * g + 3], s1 = s2 + L[4 * g + 2], s0 = s1 + L[4 * g + 1];
            w[4 * g + 3] = valid[4 * g + 3] ? __expf(lb[4 * g + 3] + s3) : 0.f;
            w[4 * g + 2] = valid[4 * g + 2] ? __expf(lb[4 * g + 2] + s2) : 0.f;
            w[4 * g + 1] = valid[4 * g + 1] ? __expf(lb[4 * g + 1] + s1) : 0.f;
            w[4 * g + 0] = valid[4 * g + 0] ? __expf(lb[4 * g + 0] + s0) : 0.f;
        }
        cum += tot;
#pragma unroll
        for (int c = 0; c < 2; ++c) {
            u32x4 pw; pw.x = pk2(w[8 * c], w[8 * c + 1]); pw.y = pk2(w[8 * c + 2], w[8 * c + 3]); pw.z = pk2(w[8 * c + 4], w[8 * c + 5]); pw.w = pk2(w[8 * c + 6], w[8 * c + 7]);
            const bf16x8 pa = __builtin_bit_cast(bf16x8, pw);
#pragma unroll
            for (int dt = 0; dt < 2; ++dt) {
                bf16x8 vb;
#pragma unroll
                for (int i = 0; i < 8; ++i) { const int key = 16 * c + 8 * (i >> 2) + 4 * hf + (i & 3); vb[i] = *(const LAS short*)(vt + key * 144 + (l32 + 32 * dt) * 2); }
                if (dt == 0) O0 = MFMA32(pa, vb, O0); else O1 = MFMA32(pa, vb, O1);
            }
        }
        asm volatile("" ::: "memory");
        if (__all(cum < -110.f)) break;
#pragma unroll
        for (int ks = 0; ks < 4; ++ks) kf[ks] = kn[ks];
    }
    LAS float* oa = (LAS float*)lds;
#pragma unroll
    for (int r = 0; r < 16; ++r) { const int q = (r >> 2) * 8 + hf * 4 + (r & 3); oa[q * 516 + h * 64 + l32] = O0[r]; oa[q * 516 + h * 64 + 32 + l32] = O1[r]; }
    __syncthreads();
    bf16_t* Ob = (bf16_t*)(P.ws + WS_O);
    const float* gsb = P.in[12] + (size_t)l * 512;
#pragma unroll
    for (int rr = 0; rr < 4; ++rr) {
        const int q = wave * 4 + rr;
        const f32x4 a = *(const LAS f32x4*)(oa + q * 516 + 4 * lane), b = *(const LAS f32x4*)(oa + q * 516 + 256 + 4 * lane);
        float ss = (a.x * a.x + a.y * a.y) + (a.z * a.z + a.w * a.w) + (b.x * b.x + b.y * b.y) + (b.z * b.z + b.w * b.w);
        const float rstd = rsqrtf(wave_sum(ss) * (1.f / 512.f) + EPS);
        const f32x4 ga = *(const f32x4*)(gsb + 4 * lane), gb = *(const f32x4*)(gsb + 256 + 4 * lane);
        const f32x4 ya = a * rstd * ga, yb = b * rstd * gb;
        u32x2 wa, wb; wa.x = pk2(ya.x, ya.y); wa.y = pk2(ya.z, ya.w); wb.x = pk2(yb.x, yb.y); wb.y = pk2(yb.z, yb.w);
        *(u32x2*)(Ob + (size_t)(qrow0 + q) * DM + 4 * lane) = wa; *(u32x2*)(Ob + (size_t)(qrow0 + q) * DM + 256 + 4 * lane) = wb;
    }
    __syncthreads();
}

__device__ __forceinline__ void ret_unit(const Params& P, int l, LAS unsigned char* lds, int tid, int lane, int wave,
                                         int row0, int pos0, int nchunks, int L, int h, const float* init, float* outst, bool state_only) {
    const bf16_t* QKV = (const bf16_t*)(P.ws + WS_QKV); bf16_t* Ob = (bf16_t*)(P.ws + WS_O);
    const f32x2* ROPE = (const f32x2*)(P.ws + WS_ROPE);
    const float lg2 = log2f(1.f - exp2f(-5.f - (float)h));
    LAS unsigned char *Qn = lds, *Kn = lds + 17408, *KdT = lds + 34816, *VT = lds + 53248, *SbT = lds + 71680, *Pm = lds + 106496;
    LAS float* of = (LAS float*)lds;
    const int l32 = lane & 31, hf = lane >> 5;
    const int sdt = wave >> 1, set0 = (wave & 1) * 2;
    f32x16 S0, S1;
#pragma unroll
    for (int r = 0; r < 16; ++r) { S0[r] = 0.f; S1[r] = 0.f; }
    if (init) {
        const float* ip = init + (sdt * 32 + hf * 4) * 128 + set0 * 32 + l32;
#pragma unroll
        for (int r = 0; r < 16; ++r) { S0[r] = ip[((r >> 2) * 8 + (r & 3)) * 128]; S1[r] = ip[((r >> 2) * 8 + (r & 3)) * 128 + 32]; if ((r & 3) == 3) asm volatile("" ::: "memory"); }
    }
    if (!state_only) {
#pragma unroll
        for (int g = 0; g < 4; ++g) { const int d0 = sdt * 32 + g * 8 + hf * 4;
            u32x2 a, b; a.x = pk2(S0[4 * g], S0[4 * g + 1]); a.y = pk2(S0[4 * g + 2], S0[4 * g + 3]); b.x = pk2(S1[4 * g], S1[4 * g + 1]); b.y = pk2(S1[4 * g + 2], S1[4 * g + 3]);
            *(LAS u32x2*)(SbT + (set0 * 32 + l32) * 272 + d0 * 2) = a; *(LAS u32x2*)(SbT + ((set0 + 1) * 32 + l32) * 272 + d0 * 2) = b; }
    }
    const float gL = exp2f((float)L * lg2);
    const int lt = wave >> 2, et = wave & 3;
    bf16x8 rk1, rk2, rq1, rq2, rv0, rv1; f32x4 rcs[4];
    const bf16x8 z8 = {0, 0, 0, 0, 0, 0, 0, 0};
    auto issue = [&](int c) {
        const int t = tid >> 3, i0 = (tid & 7) * 8; const bool ok = t < L;
        const size_t row = (size_t)(row0 + c * 64 + t);
        rk1 = z8; rk2 = z8; rq1 = z8; rq2 = z8;
#pragma unroll
        for (int i = 0; i < 4; ++i) rcs[i] = (f32x4){0.f, 0.f, 0.f, 0.f};
        if (ok) {
            rk1 = *(const bf16x8*)(QKV + row * INW + 2048 + h * 128 + i0); rk2 = *(const bf16x8*)(QKV + row * INW + 2048 + h * 128 + 64 + i0);
            if (!state_only) { rq1 = *(const bf16x8*)(QKV + row * INW + 1536 + h * 128 + i0); rq2 = *(const bf16x8*)(QKV + row * INW + 1536 + h * 128 + 64 + i0); }
            const f32x4* rp = (const f32x4*)(ROPE + (size_t)(pos0 + c * 64 + t) * 64 + i0);
#pragma unroll
            for (int i = 0; i < 4; ++i) rcs[i] = rp[i];
        }
        const int t0 = tid >> 4, ch = tid & 15;
        rv0 = z8; rv1 = z8;
        if (t0 < L) rv0 = *(const bf16x8*)(QKV + (size_t)(row0 + c * 64 + t0) * INW + 2560 + h * 128 + ch * 8);
        if (t0 + 32 < L) rv1 = *(const bf16x8*)(QKV + (size_t)(row0 + c * 64 + t0 + 32) * INW + 2560 + h * 128 + ch * 8);
    };
    issue(0);
    const int l32_0 = l32, hf_0 = hf, tid_0 = tid; const float lg2_0 = lg2;
#pragma unroll 1
    for (int c = 0; c < nchunks; ++c) {
        int l32 = l32_0, hf = hf_0, tid = tid_0; float lg2 = lg2_0;
        asm volatile("" : "+v"(l32), "+v"(hf), "+v"(tid), "+v"(lg2));
        {
            const int t = tid >> 3, pc = tid & 7, i0 = pc * 8; const bool ok = t < L;
            const float kd = ok ? __builtin_amdgcn_exp2f((float)(L - 1 - t) * lg2) : 0.f;
            const int tsw = (((t >> 3) ^ pc) << 4) + (t & 7) * 2;
            float cs_c[8], cs_s[8];
#pragma unroll
            for (int i = 0; i < 4; ++i) { cs_c[2 * i] = rcs[i].x; cs_s[2 * i] = rcs[i].y; cs_c[2 * i + 1] = rcs[i].z; cs_s[2 * i + 1] = rcs[i].w; }
            {
                float o1[8], o2[8];
#pragma unroll
                for (int i = 0; i < 8; ++i) { const float x1 = bf2f((unsigned short)rk1[i]), x2 = bf2f((unsigned short)rk2[i]);
                    o1[i] = (x1 * cs_c[i] - x2 * cs_s[i]) * 0.08838834764831845f; o2[i] = (x1 * cs_s[i] + x2 * cs_c[i]) * 0.08838834764831845f; }
                if (!state_only) {
                    u32x4 a, b; a.x = pk2(o1[0], o1[1]); a.y = pk2(o1[2], o1[3]); a.z = pk2(o1[4], o1[5]); a.w = pk2(o1[6], o1[7]);
                    b.x = pk2(o2[0], o2[1]); b.y = pk2(o2[2], o2[3]); b.z = pk2(o2[4], o2[5]); b.w = pk2(o2[6], o2[7]);
                    *(LAS u32x4*)(Kn + t * 272 + i0 * 2) = a; *(LAS u32x4*)(Kn + t * 272 + (64 + i0) * 2) = b;
                }
#pragma unroll
                for (int i = 0; i < 8; ++i) { *(LAS unsigned short*)(KdT + (i0 + i) * 144 + tsw) = (unsigned short)f2bf(o1[i] * kd); *(LAS unsigned short*)(KdT + (64 + i0 + i) * 144 + tsw) = (unsigned short)f2bf(o2[i] * kd); }
            }
            if (!state_only) {
                float o1[8], o2[8];
#pragma unroll
                for (int i = 0; i < 8; ++i) { const float x1 = bf2f((unsigned short)rq1[i]), x2 = bf2f((unsigned short)rq2[i]);
                    o1[i] = x1 * cs_c[i] - x2 * cs_s[i]; o2[i] = x1 * cs_s[i] + x2 * cs_c[i]; }
                u32x4 a, b; a.x = pk2(o1[0], o1[1]); a.y = pk2(o1[2], o1[3]); a.z = pk2(o1[4], o1[5]); a.w = pk2(o1[6], o1[7]);
                b.x = pk2(o2[0], o2[1]); b.y = pk2(o2[2], o2[3]); b.z = pk2(o2[4], o2[5]); b.w = pk2(o2[6], o2[7]);
                *(LAS u32x4*)(Qn + t * 272 + i0 * 2) = a; *(LAS u32x4*)(Qn + t * 272 + (64 + i0) * 2) = b;
            }
            {
                const int t0 = tid >> 4, ch = tid & 15, sw = ch & 7;
                const int o0 = (((t0 >> 3) ^ sw) << 4) + (t0 & 7) * 2, o1b = ((((t0 + 32) >> 3) ^ sw) << 4) + (t0 & 7) * 2;
#pragma unroll
                for (int i = 0; i < 8; ++i) { *(LAS short*)(VT + (ch * 8 + i) * 144 + o0) = rv0[i]; *(LAS short*)(VT + (ch * 8 + i) * 144 + o1b) = rv1[i]; }
            }
        }
        if (c + 1 < nchunks) issue(c + 1);
        __syncthreads();
        f32x16 acc;
        if (!state_only) {
#pragma unroll
            for (int r = 0; r < 16; ++r) acc[r] = 0.f;
#pragma unroll
            for (int ks = 0; ks < 8; ++ks) { const bf16x8 a = *(const LAS bf16x8*)(Qn + (lt * 32 + l32) * 272 + (ks * 16 + hf * 8) * 2), b = *(const LAS bf16x8*)(SbT + (et * 32 + l32) * 272 + (ks * 16 + hf * 8) * 2); acc = MFMA32(a, b, acc); }
#pragma unroll
            for (int r = 0; r < 16; ++r) { const int tl = lt * 32 + (r >> 2) * 8 + hf * 4 + (r & 3); acc[r] *= __builtin_amdgcn_exp2f((float)(tl + 1) * lg2); }
            if (wave < 4) {
                const int slt = wave >> 1, smt = wave & 1;
                f32x16 sc;
#pragma unroll
                for (int r = 0; r < 16; ++r) sc[r] = 0.f;
                if (slt >= smt) {
#pragma unroll
                    for (int ks = 0; ks < 8; ++ks) { const bf16x8 a = *(const LAS bf16x8*)(Qn + (slt * 32 + l32) * 272 + (ks * 16 + hf * 8) * 2), b = *(const LAS bf16x8*)(Kn + (smt * 32 + l32) * 272 + (ks * 16 + hf * 8) * 2); sc = MFMA32(a, b, sc); }
                }
                const int tm = smt * 32 + l32;
#pragma unroll
                for (int r = 0; r < 16; ++r) { const int tl = slt * 32 + (r >> 2) * 8 + hf * 4 + (r & 3);
                    const float p = tl >= tm ? sc[r] * __builtin_amdgcn_exp2f((float)(tl - tm) * lg2) : 0.f;
                    *(LAS unsigned short*)(Pm + tl * 144 + tm * 2) = (unsigned short)f2bf(p); }
            }
            __syncthreads();
#pragma unroll
            for (int ms = 0; ms < 4; ++ms) { const bf16x8 a = *(const LAS bf16x8*)(Pm + (lt * 32 + l32) * 144 + (ms * 16 + hf * 8) * 2), b = *(const LAS bf16x8*)(VT + (et * 32 + l32) * 144 + (((ms * 2 + hf) ^ ((et * 4 + (l32 >> 3)) & 7)) << 4)); acc = MFMA32(a, b, acc); }
#pragma unroll
            for (int r = 0; r < 16; ++r) { const int tl = lt * 32 + (r >> 2) * 8 + hf * 4 + (r & 3); of[tl * 132 + et * 32 + l32] = acc[r]; }
        }
#pragma unroll
        for (int r = 0; r < 16; ++r) { S0[r] *= gL; S1[r] *= gL; }
#pragma unroll
        for (int ts = 0; ts < 4; ++ts) {
            const int cc = ts * 2 + hf, rs = l32 >> 3;
            const bf16x8 a = *(const LAS bf16x8*)(KdT + (sdt * 32 + l32) * 144 + ((cc ^ ((sdt * 4 + rs) & 7)) << 4));
            const bf16x8 b0 = *(const LAS bf16x8*)(VT + (set0 * 32 + l32) * 144 + ((cc ^ ((set0 * 4 + rs) & 7)) << 4)), b1 = *(const LAS bf16x8*)(VT + ((set0 + 1) * 32 + l32) * 144 + ((cc ^ (((set0 + 1) * 4 + rs) & 7)) << 4));
            S0 = MFMA32(a, b0, S0); S1 = MFMA32(a, b1, S1);
        }
        if (!state_only) {
#pragma unroll
            for (int g = 0; g < 4; ++g) { const int d0 = sdt * 32 + g * 8 + hf * 4;
                u32x2 a, b; a.x = pk2(S0[4 * g], S0[4 * g + 1]); a.y = pk2(S0[4 * g + 2], S0[4 * g + 3]); b.x = pk2(S1[4 * g], S1[4 * g + 1]); b.y = pk2(S1[4 * g + 2], S1[4 * g + 3]);
                *(LAS u32x2*)(SbT + (set0 * 32 + l32) * 272 + d0 * 2) = a; *(LAS u32x2*)(SbT + ((set0 + 1) * 32 + l32) * 272 + d0 * 2) = b; }
            __syncthreads();
            const f32x2 gr = *(const f32x2*)(P.in[13] + (size_t)(l * 4 + h) * 128 + lane * 2);
#pragma unroll
            for (int rr = 0; rr < 8; ++rr) {
                const int t = wave * 8 + rr;
                if (t < L) {
                    const f32x2 v = *(const LAS f32x2*)(of + t * 132 + lane * 2);
                    const float rstd = rsqrtf(wave_sum(v.x * v.x + v.y * v.y) * (1.f / 128.f) + EPS);
                    const size_t row = (size_t)(row0 + c * 64 + t);
                    const unsigned gg = *(const unsigned*)(QKV + row * INW + 3072 + h * 128 + lane * 2);
                    const float y0 = v.x * rstd * gr.x * silu_f(bf2f(gg & 0xffffu)), y1 = v.y * rstd * gr.y * silu_f(bf2f(gg >> 16));
                    *(unsigned*)(Ob + row * DM + 512 + h * 128 + lane * 2) = pk2(y0, y1);
                }
            }
        }
        __syncthreads();
    }
    if (outst) {
        float* op = outst + (sdt * 32 + hf * 4) * 128 + set0 * 32 + l32;
#pragma unroll
        for (int r = 0; r < 16; ++r) { op[((r >> 2) * 8 + (r & 3)) * 128] = S0[r]; op[((r >> 2) * 8 + (r & 3)) * 128 + 32] = S1[r]; if ((r & 3) == 3) asm volatile("" ::: "memory"); }
    }
}


#define XB_TMO      128
#define XB_XCNT(j)  (256  + 64 * (j))
#define XB_XSUB(j)  (1280 + 64 * (j))
#define XB_XGEN(j)  (2304 + 64 * (j))
#define XB_TOP      3328
#define XB_TOPGEN   3392
#define XCD_BAR_WORDS 3456
#define XB_SPIN_CAP (1u << 18)

__device__ __forceinline__ unsigned xb_ld(unsigned* p)              { return __hip_atomic_load(p, __ATOMIC_RELAXED, __HIP_MEMORY_SCOPE_AGENT); }
__device__ __forceinline__ unsigned xb_add(unsigned* p, unsigned v) { return __hip_atomic_fetch_add(p, v, __ATOMIC_RELAXED, __HIP_MEMORY_SCOPE_AGENT); }
__device__ __forceinline__ unsigned xb_xcc_id() { return (unsigned)__builtin_amdgcn_s_getreg((3 << 11) | 20) & 0xFu; }
#define XB_SPIN(cond, bar) do { unsigned _sp = 0; while (cond) { __builtin_amdgcn_s_sleep(1); \
    if ((++_sp & 255u) == 0u) { if (xb_ld(&(bar)[XB_TMO])) break; if (_sp > XB_SPIN_CAP) { atomicAdd(&(bar)[XB_TMO], 1u); break; } } } } while (0)

struct XcdBarrier {
    unsigned* bar; unsigned x;
    volatile LAS unsigned* st;
};

__device__ __forceinline__ XcdBarrier xcd_barrier_post(unsigned* bar, volatile LAS unsigned* st) {
    XcdBarrier b; b.bar = bar; b.x = xb_xcc_id(); b.st = st;
    if (threadIdx.x == 0) (void)xb_add(&bar[XB_XCNT(b.x)], 1u);
    return b;
}
__device__ __forceinline__ void xcd_barrier_complete(unsigned* bar, unsigned x, unsigned& nloc, unsigned& nx) {
    const unsigned G = gridDim.x * gridDim.y * gridDim.z;
    unsigned sum, cnt, mine, sp = 0u;
    for (;;) {
        sum = 0u; cnt = 0u; mine = 0u;
#pragma unroll
        for (unsigned j = 0; j < 16; ++j) { const unsigned c = xb_ld(&bar[XB_XCNT(j)]); sum += c; cnt += (c > 0u) ? 1u : 0u; mine = (j == x) ? c : mine; }
        if (sum == G) break;
        __builtin_amdgcn_s_sleep(1);
        if ((++sp & 255u) == 0u) { if (xb_ld(&bar[XB_TMO])) break; if (sp > XB_SPIN_CAP) { atomicAdd(&bar[XB_TMO], 1u); break; } }
    }
    nloc = mine > 0u ? mine : 1u; nx = cnt > 0u ? cnt : 1u;
}

__device__ __forceinline__ void xcd_barrier(const XcdBarrier& b) {
    asm volatile("s_waitcnt vmcnt(0)" ::: "memory");
    __syncthreads();
    if (threadIdx.x == 0) {
        unsigned* bar = b.bar;
        __builtin_amdgcn_s_waitcnt(0);
        unsigned nloc = b.st[0], nx = b.st[1];
        if (nloc == 0u) { xcd_barrier_complete(bar, b.x, nloc, nx); b.st[0] = nloc; b.st[1] = nx; }
        const unsigned old = xb_add(&bar[XB_XSUB(b.x)], 1u);
        const unsigned gen = old / nloc;
        if (old + 1u == (gen + 1u) * nloc) {
            __builtin_amdgcn_fence(__ATOMIC_RELEASE, "agent");
            asm volatile("s_waitcnt vmcnt(0)" ::: "memory");
            const unsigned og = xb_add(&bar[XB_TOP], 1u);
            const unsigned tg = og / nx;
            if (og + 1u == (tg + 1u) * nx) xb_add(&bar[XB_TOPGEN], 1u);
            else XB_SPIN(xb_ld(&bar[XB_TOPGEN]) == tg, bar);
            __builtin_amdgcn_fence(__ATOMIC_ACQUIRE, "agent");
            xb_add(&bar[XB_XGEN(b.x)], 1u);
            asm volatile("s_waitcnt vmcnt(0)" ::: "memory");
        } else {
            XB_SPIN(xb_ld(&bar[XB_XGEN(b.x)]) == gen, bar);
            __builtin_amdgcn_fence(__ATOMIC_ACQUIRE, "agent");
            asm volatile("s_waitcnt vmcnt(0)" ::: "memory");
        }
    }
    __syncthreads();
}
__global__ void __launch_bounds__(512, 2) fwd_megakernel(Params P) {
    extern __shared__ __attribute__((aligned(16))) unsigned char lds_raw[];
    LAS unsigned char* lds = (LAS unsigned char*)lds_raw;
    cg::grid_group grid = cg::this_grid();
    int tid = threadIdx.x, lane = tid & 63, wave = __builtin_amdgcn_readfirstlane(tid >> 6);
#define REFRESH() do { tid = threadIdx.x; asm volatile("" : "+v"(tid)); lane = tid & 63; wave = __builtin_amdgcn_readfirstlane(tid >> 6); } while (0)
    const int G = gridDim.x, bx = blockIdx.x;
    bf16_t* H = (bf16_t*)(P.ws + WS_H); bf16_t* Ob = (bf16_t*)(P.ws + WS_O); bf16_t* QKV = (bf16_t*)(P.ws + WS_QKV); bf16_t* ACT = QKV;
    float* X = (float*)(P.ws + WS_X); float* U = (float*)(P.ws + WS_U);
    const float* MOD = (const float*)(P.ws + WS_MOD);

    volatile LAS unsigned* bst = (volatile LAS unsigned*)(lds + LDS_BYTES - 64);
    if (tid == 0) { bst[0] = 0u; bst[1] = 0u; }
    __syncthreads();
    const XcdBarrier xbar = xcd_barrier_post((unsigned*)(P.ws + WS_BAR), bst);
#ifndef SK_P0
    p0_phase(P, lds, tid, lane, wave);
#endif
    grid.sync(); REFRESH();
#pragma unroll 1
    for (int l = 0; l < DEPTH; ++l) {
        norm_phase<false>(P, l, l == 0, P.in[7] + (size_t)l * DM, 0, 1024, lane, wave);
        xcd_barrier(xbar); REFRESH();
#ifndef SK_G1
        {
            pg8::Gemm g{H, (const bf16_t*)(P.ws + WS_WIN) + (size_t)l * INW * DM, MT, INW, DM}; pg8::StaticOrder S; S.init(MT, INW, G, bx);
            EpiQKV E{QKV, P.out, l};
            pg8::gemm_phase<EpiQKV, pg8::StaticOrder, true, true>(lds, g, S, E);
        }
#endif
        xcd_barrier(xbar); REFRESH();
        for (int u = bx; u < 1360; u += G) {
#ifndef SK_R1
            if (u < 256) { const int bh = u >> 5, seg = u & 31, b = bh >> 2, h = bh & 3;
                ret_unit(P, l, lds, tid, lane, wave, b * SEQ + seg * 512, seg * 512, 8, 64, h, nullptr, U + (size_t)(bh * 32 + seg) * 16384, true); }
            else
#endif
#ifndef SK_RS
            if (u < 320) { const int idx = u - 256, bs = idx >> 2, h = idx & 3; const size_t so = ((size_t)(l * DB + bs) * 4 + h) * 16384;
                ret_unit(P, l, lds, tid, lane, wave, MP + bs * 32, PAST, 1, 32, h, P.in[4] + so, P.out + OFF_RS + so, false); }
            else
#endif
            {}
#ifndef SK_SB
            if (u >= 320) sb_unit(P, l, u - 320, lds, tid, lane, wave);
#endif
        }
        xcd_barrier(xbar); REFRESH();
        for (int idx = bx * 512 + tid; idx < 8 * 16384; idx += G * 512) {
            const int bh = idx >> 14, within = idx & 16383, h = bh & 3;
            const float g512 = exp2f(512.f * log2f(1.f - exp2f(-5.f - (float)h)));
            float* up = U + (size_t)bh * 32 * 16384 + within; float s = 0.f;
            for (int seg = 0; seg < 32; ++seg) { const float uu = up[(size_t)seg * 16384]; up[(size_t)seg * 16384] = s; s = g512 * s + uu; }
            P.out[OFF_RP + ((size_t)l * 8 + bh) * 16384 + within] = s;
        }
        xcd_barrier(xbar); REFRESH();
#ifndef SK_R3
        for (int u = bx; u < 256; u += G) { const int bh = u >> 5, seg = u & 31, b = bh >> 2, h = bh & 3;
            ret_unit(P, l, lds, tid, lane, wave, b * SEQ + seg * 512, seg * 512, 8, 64, h, U + (size_t)(bh * 32 + seg) * 16384, nullptr, false); }
#endif
        xcd_barrier(xbar); REFRESH();
#ifndef SK_G2
        {
            pg8::Gemm g{Ob, (const bf16_t*)(P.ws + WS_WOUT) + (size_t)l * DM * DM, MT, DM, DM}; pg8::StaticOrder S; S.init(MT, DM, G, bx);
            EpiResid E{l == 0 ? P.in[0] : nullptr, l == 0 ? P.in[1] : nullptr, X, MOD + (size_t)l * NBI * NMOD + 2048};
            pg8::gemm_phase<EpiResid, pg8::StaticOrder, true, true>(lds, g, S, E);
        }
#endif
        xcd_barrier(xbar); REFRESH();
        norm_phase<false>(P, l, false, P.in[8] + (size_t)l * DM, 3072, 4096, lane, wave);
        xcd_barrier(xbar); REFRESH();
#ifndef SK_G3
        {
            pg8::Gemm g{H, (const bf16_t*)(P.ws + WS_WFI) + (size_t)l * 2 * DFF * DM, MT, 2 * DFF, DM}; pg8::StaticOrder S; S.init(MT, 2 * DFF, G, bx);
            EpiSwiGLU E{ACT};
            pg8::gemm_phase<EpiSwiGLU, pg8::StaticOrder, true, true>(lds, g, S, E);
        }
#endif
        xcd_barrier(xbar); REFRESH();
#ifndef SK_G4
        {
            pg8::Gemm g{ACT, (const bf16_t*)(P.ws + WS_WFO) + (size_t)l * DM * DFF, MT, DM, DFF}; pg8::StaticOrder S; S.init(MT, DM, G, bx);
            EpiResid E{nullptr, nullptr, X, MOD + (size_t)l * NBI * NMOD + 5120};
            pg8::gemm_phase<EpiResid, pg8::StaticOrder, true, true>(lds, g, S, E);
        }
#endif
        xcd_barrier(xbar); REFRESH();
    }
    norm_phase<true>(P, 0, false, P.in[17], 0, 0, lane, wave);
}

extern "C" void kernel_launch(void* const* d_in, const int* in_sizes, int n_in, void* d_out, int out_size, void* d_ws, size_t ws_size, hipStream_t stream) {
    static int grid = 0;
    if (grid == 0) {
        if (n_in != 18 || ws_size < WS_END) { fprintf(stderr, "kernel_launch: unexpected n_in %d / ws_size %zu\n", n_in, ws_size); grid = -1; return; }
        int dev = 0, cus = 0, per_cu = 0;
        (void)hipGetDevice(&dev); (void)hipDeviceGetAttribute(&cus, hipDeviceAttributeMultiprocessorCount, dev);
        if (hipFuncSetAttribute((const void*)fwd_megakernel, hipFuncAttributeMaxDynamicSharedMemorySize, LDS_BYTES) != hipSuccess) { fprintf(stderr, "kernel_launch: hipFuncSetAttribute failed\n"); grid = -1; return; }
        (void)hipOccupancyMaxActiveBlocksPerMultiprocessor(&per_cu, (const void*)fwd_megakernel, 512, LDS_BYTES);
        (void)hipGetLastError();
        if (per_cu < 1) { fprintf(stderr, "kernel_launch: occupancy query says %d blocks per CU\n", per_cu); per_cu = 1; }
        grid = cus;
    }
    if (grid < 0) return;
    (void)hipMemsetAsync((char*)d_ws + WS_MOD, 0, MOD_BYTES, stream);
    Params p{};
    for (int i = 0; i < 18; ++i) p.in[i] = (const float*)d_in[i];
    p.out = (float*)d_out; p.ws = (unsigned char*)d_ws;
    void* args[] = {&p};
    hipError_t e = hipLaunchCooperativeKernel((const void*)fwd_megakernel, dim3(grid), dim3(512), args, LDS_BYTES, stream);
    if (e != hipSuccess) fprintf(stderr, "cooperative launch failed: %s (grid %d)\n", hipGetErrorString(e), grid);
}
```

```cpp
#include <hip/hip_runtime.h>
#include <hip/hip_cooperative_groups.h>
#include <cstdio>
#include <cstdint>
namespace cg = cooperative_groups;
namespace pg8 {
#define PG8_LAS __attribute__((address_space(3)))
typedef unsigned short bf16_t;
typedef short bf16x8 __attribute__((ext_vector_type(8)));
typedef float f32x4 __attribute__((ext_vector_type(4)));
typedef unsigned u32x4 __attribute__((ext_vector_type(4)));
constexpr int BM = 256, BK = 64, HALF = 128, HTB = HALF * BK * 2  , STAGE_BYTES = 8 * HTB, NXCD = 8, WGM = 8;

__host__ __device__ __forceinline__ int lds_byte(int r, int c) { const int st = (r >> 4) * 2 + (c >> 5), rr = r & 15, cc = c & 31, ob = rr * 64 + cc * 2; return st * 1024 + (ob ^ (((ob >> 9) & 1) << 5)); }
__host__ __device__ __forceinline__ void stage_rc(int b, int& R, int& C) { const int st = b / 1024, sb = b % 1024, swz = sb ^ (((sb >> 9) & 1) << 5); R = (st >> 1) * 16 + swz / 64; C = (st & 1) * 32 + (swz % 64) / 2; }
__host__ __device__ __forceinline__ int perm32(int rho) { const int n = rho >> 4, i = rho & 15; return 8 * (i >> 2) + 4 * n + (i & 3); }

struct Unit { int pm, pn; };
struct Gemm { const bf16_t* A; const bf16_t* Bt; int M, N, K; };

struct StaticOrder {
    int nM, nN, nwg, G, c;
    __host__ __device__ void init(int M, int N, int G_, int c_) { nM = M / BM; nN = N / BM; nwg = nM * nN; G = G_; c = c_; }
    __host__ __device__ bool next(int i, Unit& u) const {
        const long L = (long)i * G + c; if (L >= nwg) return false;
        int wgid = (int)L; { const int q = nwg / NXCD, r = nwg % NXCD, xcd = wgid % NXCD, off = wgid / NXCD; wgid = (xcd < r ? xcd * (q + 1) : r * (q + 1) + (xcd - r) * q) + off; }
        const int nig = WGM * nN, gid = wgid / nig, fm = gid * WGM, gsz = (nM - fm) < WGM ? (nM - fm) : WGM;
        u.pm = fm + ((wgid % nig) % gsz); u.pn = (wgid % nig) / gsz; return true;
    }
    __device__ __forceinline__ void a_ready(const Unit&) const {}
    __device__ __forceinline__ void done(const Unit&) const {}
};

__device__ __forceinline__ unsigned cvt_pk_bf16(float lo, float hi) { unsigned r; asm volatile("v_cvt_pk_bf16_f32 %0, %1, %2" : "=v"(r) : "v"(lo), "v"(hi)); return r; }
typedef float f32x2 __attribute__((ext_vector_type(2)));
__device__ __forceinline__ f32x2 gelu_pk(f32x2 v) {
    const f32x2 av = __builtin_elementwise_abs(v), d = av * 0.2316418882f + 1.0f;
    f32x2 t; t.x = __builtin_amdgcn_rcpf(d.x); t.y = __builtin_amdgcn_rcpf(d.y);
    f32x2 q = t * 0.5307027145f + (-0.7265760135f); q = q * t + 0.7107068705f; q = q * t + (-0.142248368f); q = q * t + 0.127414796f; q = q * t;
    const f32x2 s = (v * v) * (-0.72134752044f);
    f32x2 e; e.x = __builtin_amdgcn_exp2f(s.x); e.y = __builtin_amdgcn_exp2f(s.y);
    const f32x2 m = v * (q * e), r = v - m;
    f32x2 o; o.x = v.x < 0.f ? m.x : r.x; o.y = v.y < 0.f ? m.y : r.y; return o;
}

template <int ACT  > struct EpiBf16 {
    static constexpr bool PERM = true, AFTER_DRAIN = false; static_assert(ACT == 0 || ACT == 1, "EpiBf16: ACT is 0 (none) or 1 (gelu_pk)");
    bf16_t* O; int ldc; const float* bias; int split_cols; size_t split_stride; float scale0;
    __device__ __forceinline__ void operator()(const f32x4 (&acc)[2][2][4][2], const Unit& u, int wr, int wc, int fr, int fq) const {
        const int row0 = u.pm * BM + wr * 64 + fr; int colt = u.pn * BM; bf16_t* base = O;
        float sc = 1.f; if (split_cols) { const int t = colt / split_cols; base += (size_t)t * split_stride; colt -= t * split_cols; if (t == 0) sc = scale0; }
        const int col0 = colt + wc * 32 + 8 * fq, bcol0 = u.pn * BM + wc * 32 + 8 * fq;
        f32x4 bv[2][2];
#pragma unroll
        for (int bj = 0; bj < 2; ++bj)
#pragma unroll
            for (int n = 0; n < 2; ++n) bv[bj][n] = bias ? *(const f32x4*)(bias + bcol0 + bj * HALF + 4 * n) : (f32x4){0.f, 0.f, 0.f, 0.f};
#pragma unroll
        for (int ai = 0; ai < 2; ++ai)
#pragma unroll
            for (int m = 0; m < 4; ++m) { bf16_t* rowp = base + (size_t)(row0 + ai * HALF + m * 16) * ldc + col0;
#pragma unroll
                for (int bj = 0; bj < 2; ++bj) { f32x4 v0 = acc[ai][bj][m][0] + bv[bj][0], v1 = acc[ai][bj][m][1] + bv[bj][1];
                    if (ACT == 1) { f32x2 a = gelu_pk((f32x2){v0[0], v0[1]}), b = gelu_pk((f32x2){v0[2], v0[3]}), c = gelu_pk((f32x2){v1[0], v1[1]}), d = gelu_pk((f32x2){v1[2], v1[3]});
                        v0 = (f32x4){a.x, a.y, b.x, b.y}; v1 = (f32x4){c.x, c.y, d.x, d.y}; }
                    v0 = v0 * sc; v1 = v1 * sc; u32x4 w; w.x = cvt_pk_bf16(v0[0], v0[1]); w.y = cvt_pk_bf16(v0[2], v0[3]); w.z = cvt_pk_bf16(v1[0], v1[1]); w.w = cvt_pk_bf16(v1[2], v1[3]);
                    *(u32x4*)(rowp + bj * HALF) = w; } }
    }
};
template <class Epi, class Sched, bool ALIGN_EPI = false, bool SP2 = false>
__device__ __forceinline__ void gemm_phase(PG8_LAS unsigned char* lds, const Gemm g, const Sched& S, const Epi& E) {
    int tid_o = threadIdx.x; asm volatile("" : "+v"(tid_o));
    const int tid = tid_o, wid = __builtin_amdgcn_readfirstlane(tid >> 6), lane = tid & 63, wr = wid >> 2, wc = wid & 3, fr = lane & 15, fq = lane >> 4;
    const int K = g.K, nt = K / BK;
    unsigned voffA[2], voffB[2];
#pragma unroll
    for (int i = 0; i < 2; ++i) { int R, C; stage_rc(tid * 16 + i * 8192, R, C); const int Rb = Epi::PERM ? ((R & ~31) + perm32(R & 31)) : R;
        voffA[i] = (unsigned)(R * K + C) * 2u; voffB[i] = (unsigned)(Rb * K + C) * 2u; }
    const size_t kstep = (size_t)(BK * 2);
    const size_t hstep = (size_t)HALF * K * 2;
    const size_t tstep = 2 * hstep;
    const unsigned ldsw = (unsigned)wid * 1024u;
    const int aoff = lds_byte(wr * 64 + fr, fq * 8), boff = lds_byte(wc * 32 + fr, fq * 8);
#define PG8_SA(b, h) (((b) * 2 + (h)) * HTB)
#define PG8_SB(b, h) ((4 + (b) * 2 + (h)) * HTB)
#define PG8_STAGE(bufoff, gbase, voff) do { _Pragma("unroll") for (int _i = 0; _i < 2; ++_i) \
        __builtin_amdgcn_global_load_lds((const unsigned*)((const char*)(gbase) + (voff)[_i]), (PG8_LAS unsigned*)(lds + (bufoff) + ldsw + _i * 8192), 16, 0, 0); } while (0)
#define PG8_LDA(dst, b, h) do { _Pragma("unroll") for (int m = 0; m < 4; ++m) _Pragma("unroll") for (int k = 0; k < 2; ++k) dst[m][k] = *(const PG8_LAS bf16x8*)(lds + PG8_SA(b, h) + aoff + m * 2048 + k * 1024); } while (0)
#define PG8_LDB(dst, b, h) do { _Pragma("unroll") for (int n = 0; n < 2; ++n) _Pragma("unroll") for (int k = 0; k < 2; ++k) dst[n][k] = *(const PG8_LAS bf16x8*)(lds + PG8_SB(b, h) + boff + n * 2048 + k * 1024); } while (0)
#define PG8_MMA(ai, bj, At, Bt) do { __builtin_amdgcn_s_setprio(1); _Pragma("unroll") for (int m = 0; m < 4; ++m) _Pragma("unroll") for (int n = 0; n < 2; ++n) _Pragma("unroll") for (int k = 0; k < 2; ++k) \
        acc[ai][bj][m][n] = __builtin_amdgcn_mfma_f32_16x16x32_bf16(Bt[n][k], At[m][k], acc[ai][bj][m][n], 0, 0, 0); __builtin_amdgcn_s_setprio(0); } while (0)
#define PG8_WAIT_V(n) asm volatile("s_waitcnt vmcnt(" #n ")" ::: "memory")
#define PG8_WAIT_L(n) asm volatile("s_waitcnt lgkmcnt(" #n ")" ::: "memory")
#define PG8_BAR __builtin_amdgcn_s_barrier()
#define PG8_SCHED __builtin_amdgcn_sched_barrier(0)
    Unit cur, nxt; int ui = 0;
    if (!S.next(0, cur)) return;
    f32x4 acc[2][2][4][2];
#pragma unroll
    for (int a = 0; a < 2; ++a)
#pragma unroll
        for (int b = 0; b < 2; ++b)
#pragma unroll
            for (int m = 0; m < 4; ++m)
#pragma unroll
                for (int n = 0; n < 2; ++n) acc[a][b][m][n] = (f32x4){0.f, 0.f, 0.f, 0.f};
    bf16x8 At[4][2], B0[2][2], B1[2][2];
    const char* cA = (const char*)g.A + (size_t)cur.pm * tstep; const char* cB = (const char*)g.Bt + (size_t)cur.pn * tstep;
    S.a_ready(cur);
    if constexpr (SP2) {
        PG8_STAGE(PG8_SB(0, 0), cB, voffB); PG8_STAGE(PG8_SB(0, 1), cB + hstep, voffB); PG8_STAGE(PG8_SA(0, 0), cA, voffA); PG8_STAGE(PG8_SA(0, 1), cA + hstep, voffA);
        if (wr == 1) PG8_BAR;
        PG8_WAIT_V(2); PG8_BAR;
        PG8_STAGE(PG8_SB(1, 0), cB + kstep, voffB); PG8_STAGE(PG8_SA(1, 0), cA + kstep, voffA); PG8_STAGE(PG8_SB(1, 1), cB + hstep + kstep, voffB);
        PG8_WAIT_V(6); PG8_BAR;
    } else {
        PG8_STAGE(PG8_SB(0, 0), cB, voffB); PG8_STAGE(PG8_SA(0, 0), cA, voffA); PG8_STAGE(PG8_SB(0, 1), cB + hstep, voffB); PG8_STAGE(PG8_SA(0, 1), cA + hstep, voffA);
        if (wr == 1) PG8_BAR;
        PG8_WAIT_V(4); PG8_BAR;
        PG8_STAGE(PG8_SB(1, 0), cB + kstep, voffB); PG8_STAGE(PG8_SA(1, 0), cA + kstep, voffA); PG8_STAGE(PG8_SB(1, 1), cB + hstep + kstep, voffB);
        PG8_WAIT_V(6); PG8_BAR;
    }
    for (;;) {
        const bool has_next = S.next(ui + 1, nxt);
        const char* nA = has_next ? (const char*)g.A + (size_t)nxt.pm * tstep : cA; const char* nB = has_next ? (const char*)g.Bt + (size_t)nxt.pn * tstep : cB;
        for (int t = 0; t < nt; t += 2) {
            const bool last = (t == nt - 2);
            const char* a1 = cA + (size_t)(t + 1) * kstep;
            const char* a2 = last ? nA : cA + (size_t)(t + 2) * kstep; const char* b2 = last ? nB : cB + (size_t)(t + 2) * kstep;
            const char* a3 = a2 + kstep; const char* b3 = b2 + kstep;
            if (last && has_next) S.a_ready(nxt);
            if constexpr (SP2) {
            PG8_LDB(B0, 0, 0); PG8_LDB(B1, 0, 1); PG8_SCHED; PG8_LDA(At, 0, 0); PG8_STAGE(PG8_SA(1, 1), a1 + hstep, voffA);
            PG8_WAIT_V(8); PG8_WAIT_L(0); PG8_BAR; PG8_MMA(0, 0, At, B0); PG8_MMA(0, 1, At, B1); PG8_BAR; PG8_SCHED;
            PG8_LDA(At, 0, 1); PG8_STAGE(PG8_SB(0, 0), b2, voffB); PG8_STAGE(PG8_SB(0, 1), b2 + hstep, voffB); PG8_STAGE(PG8_SA(0, 0), a2, voffA);
            PG8_WAIT_V(8); PG8_WAIT_L(0); PG8_BAR; PG8_MMA(1, 0, At, B0); PG8_MMA(1, 1, At, B1); PG8_BAR; PG8_SCHED;
            PG8_LDB(B0, 1, 0); PG8_LDB(B1, 1, 1); PG8_SCHED; PG8_LDA(At, 1, 0); PG8_STAGE(PG8_SA(0, 1), a2 + hstep, voffA);
            PG8_WAIT_V(8); PG8_WAIT_L(0); PG8_BAR; PG8_MMA(0, 0, At, B0); PG8_MMA(0, 1, At, B1); PG8_BAR; PG8_SCHED;
            PG8_LDA(At, 1, 1); PG8_STAGE(PG8_SB(1, 0), b3, voffB); PG8_STAGE(PG8_SB(1, 1), b3 + hstep, voffB); PG8_STAGE(PG8_SA(1, 0), a3, voffA);
            PG8_WAIT_V(8); PG8_WAIT_L(0); PG8_BAR; PG8_MMA(1, 0, At, B0); PG8_MMA(1, 1, At, B1); PG8_BAR; PG8_SCHED;
            } else {
            PG8_LDB(B0, 0, 0); PG8_SCHED; PG8_LDA(At, 0, 0); PG8_STAGE(PG8_SA(1, 1), a1 + hstep, voffA);
            PG8_WAIT_L(8); PG8_BAR; PG8_WAIT_L(0); PG8_MMA(0, 0, At, B0); PG8_BAR; PG8_SCHED;
            PG8_LDB(B1, 0, 1); PG8_STAGE(PG8_SB(0, 0), b2, voffB);
            PG8_BAR; PG8_WAIT_L(0); PG8_MMA(0, 1, At, B1); PG8_BAR;
            PG8_LDA(At, 0, 1); PG8_STAGE(PG8_SA(0, 0), a2, voffA);
            PG8_BAR; PG8_WAIT_L(0); PG8_MMA(1, 0, At, B0); PG8_BAR; PG8_SCHED;
            PG8_STAGE(PG8_SB(0, 1), b2 + hstep, voffB);
            PG8_WAIT_V(6); PG8_BAR; PG8_MMA(1, 1, At, B1); PG8_BAR;
            PG8_LDB(B0, 1, 0); PG8_SCHED; PG8_LDA(At, 1, 0); PG8_STAGE(PG8_SA(0, 1), a2 + hstep, voffA);
            PG8_WAIT_L(8); PG8_BAR; PG8_WAIT_L(0); PG8_MMA(0, 0, At, B0); PG8_BAR; PG8_SCHED;
            PG8_LDB(B1, 1, 1); PG8_STAGE(PG8_SB(1, 0), b3, voffB);
            PG8_BAR; PG8_WAIT_L(0); PG8_MMA(0, 1, At, B1); PG8_BAR;
            PG8_LDA(At, 1, 1); PG8_STAGE(PG8_SA(1, 0), a3, voffA);
            PG8_BAR; PG8_WAIT_L(0); PG8_MMA(1, 0, At, B0); PG8_BAR; PG8_SCHED;
            PG8_STAGE(PG8_SB(1, 1), b3 + hstep, voffB);
            PG8_WAIT_V(6); PG8_BAR; PG8_MMA(1, 1, At, B1); PG8_BAR;
            }
        }
        if constexpr (ALIGN_EPI) { if (wr == 0) PG8_BAR; }
        if constexpr (!Epi::AFTER_DRAIN) { E(acc, cur, wr, wc, fr, fq); S.done(cur); }
        if (!has_next) break;
#pragma unroll
        for (int a = 0; a < 2; ++a)
#pragma unroll
            for (int b = 0; b < 2; ++b)
#pragma unroll
                for (int m = 0; m < 4; ++m)
#pragma unroll
                    for (int n = 0; n < 2; ++n) acc[a][b][m][n] = (f32x4){0.f, 0.f, 0.f, 0.f};
        cur = nxt; cA = nA; cB = nB; ++ui;
        if constexpr (ALIGN_EPI) { if (wr == 1) PG8_BAR; }
    }
    PG8_WAIT_V(0);
    if constexpr (!ALIGN_EPI) { if (wr == 0) PG8_BAR; }
    PG8_BAR;
    if constexpr (Epi::AFTER_DRAIN) { E.fused(acc, cur, wr, wc, fr, fq, lds, wid, lane); S.done(cur); }
#undef PG8_SA
#undef PG8_SB
#undef PG8_STAGE
#undef PG8_LDA
#undef PG8_LDB
#undef PG8_MMA
#undef PG8_WAIT_V
#undef PG8_WAIT_L
#undef PG8_BAR
#undef PG8_SCHED
}
}

#define LAS __attribute__((address_space(3)))
typedef unsigned short bf16_t;
typedef short bf16x8 __attribute__((ext_vector_type(8)));
typedef float f32x4 __attribute__((ext_vector_type(4)));
typedef float f32x2 __attribute__((ext_vector_type(2)));
typedef float f32x16 __attribute__((ext_vector_type(16)));
typedef unsigned u32x4 __attribute__((ext_vector_type(4)));
typedef unsigned u32x2 __attribute__((ext_vector_type(2)));
#define MFMA32(a, b, c) __builtin_amdgcn_mfma_f32_32x32x16_bf16((a), (b), (c), 0, 0, 0)

constexpr int DM = 1024, SEQ = 16384, NBP = 2, DEPTH = 4, DB = 16, DS = 32, PAST = 2048;
constexpr int MP = NBP * SEQ, MS = DB * DS, MT = MP + MS;
constexpr int INW = 3584, DFF = 2816, NMOD = 6144, NBI = 18;
constexpr float EPS = 1e-6f;
constexpr size_t OFF_YP = 0, OFF_YS = 33554432, OFF_KP = 34078720, OFF_VP = 101187584, OFF_RP = 168296448,
                 OFF_KS = 168820736, OFF_VS = 169869312, OFF_RS = 170917888;
constexpr size_t MiB = 1u << 20;
constexpr size_t WS_MOD = 0, MOD_BYTES = 2 * MiB; constexpr size_t WS_BAR = 1802240;
constexpr size_t WS_ROPE = 2 * MiB;
constexpr size_t WS_WIN = 10 * MiB, WS_WOUT = 38 * MiB, WS_WFI = 46 * MiB, WS_WFO = 90 * MiB;
constexpr size_t WS_X = 112 * MiB;
constexpr size_t WS_H = 242 * MiB;
constexpr size_t WS_O = 307 * MiB;
constexpr size_t WS_QKV = 372 * MiB;
constexpr size_t WS_U = 600 * MiB;
constexpr size_t WS_END = 616 * MiB;
constexpr int LDS_BYTES = 147456;

struct Params { const float* in[18]; float* out; unsigned char* ws; };

__device__ __forceinline__ unsigned f2bf(float f) { unsigned u = __builtin_bit_cast(unsigned, f); return (u + 0x7fffu + ((u >> 16) & 1u)) >> 16; }
__device__ __forceinline__ unsigned pk2(float lo, float hi) { return f2bf(lo) | (f2bf(hi) << 16); }
__device__ __forceinline__ float bf2f(unsigned h) { return __builtin_bit_cast(float, h << 16); }
__device__ __forceinline__ bf16x8 pack8(f32x4 a, f32x4 b) { u32x4 p; p.x = pk2(a.x, a.y); p.y = pk2(a.z, a.w); p.z = pk2(b.x, b.y); p.w = pk2(b.z, b.w); return __builtin_bit_cast(bf16x8, p); }
__device__ __forceinline__ float wave_sum(float v) {
#pragma unroll
    for (int o = 1; o < 64; o <<= 1) v += __shfl_xor(v, o);
    return v;
}
__device__ __forceinline__ float silu_f(float x) { return x * __builtin_amdgcn_rcpf(1.f + __expf(-x)); }
__device__ __forceinline__ int batch_of(int row) { return row < MP ? (row >> 14) : 2 + ((row - MP) >> 5); }

struct EpiQKV {
    static constexpr bool PERM = true, AFTER_DRAIN = false;
    bf16_t* QKV; float* out; int layer;
    __device__ __forceinline__ void operator()(const pg8::f32x4 (&acc)[2][2][4][2], const pg8::Unit& u, int wr, int wc, int fr, int fq) const {
        const int row0 = u.pm * 256 + wr * 64 + fr, col0 = u.pn * 256 + wc * 32 + 8 * fq;
        const bool kv = (u.pn >= 2 && u.pn < 6);
        const size_t vsel = (u.pn >= 4) ? 1 : 0;
        const size_t obase = (u.pm < 128) ? OFF_KP + vsel * (OFF_VP - OFF_KP) + (size_t)layer * MP * 512 + (size_t)row0 * 512
                                          : OFF_KS + vsel * (OFF_VS - OFF_KS) + (size_t)layer * MS * 512 + (size_t)(row0 - MP) * 512;
#pragma unroll
        for (int ai = 0; ai < 2; ++ai)
#pragma unroll
            for (int m = 0; m < 4; ++m) {
                const int row = row0 + ai * 128 + m * 16;
#pragma unroll
                for (int bj = 0; bj < 2; ++bj) {
                    const int col = col0 + bj * 128;
                    const pg8::f32x4 v0 = acc[ai][bj][m][0], v1 = acc[ai][bj][m][1];
                    u32x4 w; w.x = pg8::cvt_pk_bf16(v0[0], v0[1]); w.y = pg8::cvt_pk_bf16(v0[2], v0[3]); w.z = pg8::cvt_pk_bf16(v1[0], v1[1]); w.w = pg8::cvt_pk_bf16(v1[2], v1[3]);
                    *(u32x4*)(QKV + (size_t)row * INW + col) = w;
                    if (kv) {
                        const int c = col & 511;
                        float* dst = out + obase + (size_t)(ai * 128 + m * 16) * 512 + c;
                        *(pg8::f32x4*)dst = v0; *(pg8::f32x4*)(dst + 4) = v1;
                    }
                }
                asm volatile("" ::: "memory");
            }
    }
};
struct EpiResid {
    static constexpr bool PERM = false, AFTER_DRAIN = false;
    const float* base_p; const float* base_s;
    float* X; const float* gate;
    __device__ __forceinline__ void operator()(const pg8::f32x4 (&acc)[2][2][4][2], const pg8::Unit& u, int wr, int wc, int fr, int fq) const {
        const int col0 = u.pn * 256 + wc * 32 + 4 * fq;
        const bool uni = u.pm < 128;
        pg8::f32x4 gv[4];
        { const float* gr = gate + (size_t)batch_of(u.pm * 256 + wr * 64 + fr) * NMOD;
#pragma unroll
          for (int q = 0; q < 4; ++q) gv[q] = *(const pg8::f32x4*)(gr + col0 + (q >> 1) * 128 + (q & 1) * 16); }
#pragma unroll
        for (int grp = 0; grp < 4; ++grp) {
            const int ai = grp >> 1, m0 = (grp & 1) * 2;
            pg8::f32x4 bv[2][4];
#pragma unroll
            for (int mm = 0; mm < 2; ++mm) {
                const int row = u.pm * 256 + ai * 128 + wr * 64 + (m0 + mm) * 16 + fr;
                const float* br = base_p ? (row < MP ? base_p + (size_t)row * DM : base_s + (size_t)(row - MP) * DM) : X + (size_t)row * DM;
#pragma unroll
                for (int q = 0; q < 4; ++q) bv[mm][q] = *(const pg8::f32x4*)(br + col0 + (q >> 1) * 128 + (q & 1) * 16);
            }
#pragma unroll
            for (int mm = 0; mm < 2; ++mm) {
                const int m = m0 + mm, row = u.pm * 256 + ai * 128 + wr * 64 + m * 16 + fr;
                if (!uni) { const float* gr = gate + (size_t)batch_of(row) * NMOD;
#pragma unroll
                    for (int q = 0; q < 4; ++q) gv[q] = *(const pg8::f32x4*)(gr + col0 + (q >> 1) * 128 + (q & 1) * 16); }
                float* xr = X + (size_t)row * DM;
#pragma unroll
                for (int q = 0; q < 4; ++q) { const int bj = q >> 1, n = q & 1;
                    *(pg8::f32x4*)(xr + col0 + bj * 128 + n * 16) = bv[mm][q] + gv[q] * acc[ai][bj][m][n]; }
            }
            asm volatile("" ::: "memory");
        }
    }
};
struct EpiSwiGLU {
    static constexpr bool PERM = true, AFTER_DRAIN = false;
    bf16_t* ACT;
    __device__ __forceinline__ void operator()(const pg8::f32x4 (&acc)[2][2][4][2], const pg8::Unit& u, int wr, int wc, int fr, int fq) const {
        const int col0 = u.pn * 128 + wc * 32 + 8 * fq;
#pragma unroll
        for (int ai = 0; ai < 2; ++ai)
#pragma unroll
            for (int m = 0; m < 4; ++m) {
                const int row = u.pm * 256 + ai * 128 + wr * 64 + m * 16 + fr;
                const pg8::f32x4 g0 = acc[ai][0][m][0], g1 = acc[ai][0][m][1], u0 = acc[ai][1][m][0], u1 = acc[ai][1][m][1];
                float r[8];
#pragma unroll
                for (int j = 0; j < 4; ++j) { r[j] = silu_f(g0[j]) * u0[j]; r[4 + j] = silu_f(g1[j]) * u1[j]; }
                u32x4 w; w.x = pg8::cvt_pk_bf16(r[0], r[1]); w.y = pg8::cvt_pk_bf16(r[2], r[3]); w.z = pg8::cvt_pk_bf16(r[4], r[5]); w.w = pg8::cvt_pk_bf16(r[6], r[7]);
                *(u32x4*)(ACT + (size_t)row * DFF + col0) = w;
                asm volatile("" ::: "memory");
            }
    }
};

__device__ __forceinline__ void transpose_item(const float* W, int K, int N, bf16_t* WT, LAS float* scr, int item, int lane, bool perm) {
    const int nblk = N / 32, kb = item / nblk, nb = item % nblk, k0 = 64 * kb, n0 = 32 * nb;
    int p0 = n0;
    if (perm) { if (n0 < DFF) p0 = (n0 >> 7) * 256 + (n0 & 127); else { const int n1 = n0 - DFF; p0 = (n1 >> 7) * 256 + 128 + (n1 & 127); } }
#pragma unroll 8
    for (int i = 0; i < 32; ++i) { const int kk = 2 * i + (lane >> 5); scr[kk * 33 + (lane & 31)] = W[(size_t)(k0 + kk) * N + n0 + (lane & 31)]; }
    asm volatile("s_waitcnt lgkmcnt(0)" ::: "memory"); __builtin_amdgcn_wave_barrier();
    const int c = lane & 7;
#pragma unroll
    for (int j = 0; j < 4; ++j) { const int n = (lane >> 3) + 8 * j; const LAS float* s = scr + (8 * c) * 33 + n;
        u32x4 o; o.x = pk2(s[0 * 33], s[1 * 33]); o.y = pk2(s[2 * 33], s[3 * 33]); o.z = pk2(s[4 * 33], s[5 * 33]); o.w = pk2(s[6 * 33], s[7 * 33]);
        *(u32x4*)(WT + (size_t)(p0 + n) * K + k0 + 8 * c) = o; }
    asm volatile("s_waitcnt lgkmcnt(0)" ::: "memory"); __builtin_amdgcn_wave_barrier();
}

__device__ __forceinline__ void p0_phase(const Params& P, LAS unsigned char* lds, int tid, int lane, int wave) {
    LAS float* sc = (LAS float*)lds;
    for (int i = tid; i < NBI * DM; i += 512) { const int b = i >> 10, k = i & 1023; const float c = b < 2 ? P.in[5][b * DM + k] : P.in[6][(b - 2) * DM + k]; sc[i] = silu_f(c); }
    __syncthreads();
    const int gw = blockIdx.x * 8 + wave, NGW = gridDim.x * 8;
    float* MOD = (float*)(P.ws + WS_MOD);
    for (int it = gw; it < 768; it += NGW) {
        const int l = it / 192, r = it % 192, cb = r >> 3, kc = r & 7;
        f32x4 acc[NBI];
#pragma unroll
        for (int b = 0; b < NBI; ++b) acc[b] = (f32x4){0.f, 0.f, 0.f, 0.f};
        const float* wp = P.in[9] + ((size_t)l * DM + kc * 128) * NMOD + cb * 256 + lane * 4;
        const LAS float* scp = sc + kc * 128;
#pragma unroll 4
        for (int k = 0; k < 128; ++k) { const f32x4 w = *(const f32x4*)(wp + (size_t)k * NMOD);
#pragma unroll
            for (int b = 0; b < NBI; ++b) acc[b] += scp[b * DM + k] * w; }
        if (kc == 0) { const f32x4 bv = *(const f32x4*)(P.in[10] + (size_t)l * NMOD + cb * 256 + lane * 4);
#pragma unroll
            for (int b = 0; b < NBI; ++b) acc[b] += bv; }
        float* mp = MOD + (size_t)l * NBI * NMOD + cb * 256 + lane * 4;
#pragma unroll
        for (int b = 0; b < NBI; ++b) { atomicAdd(mp + b * NMOD + 0, acc[b].x); atomicAdd(mp + b * NMOD + 1, acc[b].y); atomicAdd(mp + b * NMOD + 2, acc[b].z); atomicAdd(mp + b * NMOD + 3, acc[b].w); }
    }
    LAS float* scr = (LAS float*)(lds + 73728 + wave * 8448);
    constexpr int I_IN = 16 * 112, I_OUT = 16 * 32, I_FI = 16 * 176, I_FO = 44 * 32, I_L = I_IN + I_OUT + I_FI + I_FO;
    for (int it = gw; it < DEPTH * I_L; it += NGW) {
        const int l = it / I_L; int r = it % I_L;
        if (r < I_IN) { transpose_item(P.in[11] + (size_t)l * DM * INW, DM, INW, (bf16_t*)(P.ws + WS_WIN) + (size_t)l * INW * DM, scr, r, lane, false); continue; } r -= I_IN;
        if (r < I_OUT) { transpose_item(P.in[14] + (size_t)l * DM * DM, DM, DM, (bf16_t*)(P.ws + WS_WOUT) + (size_t)l * DM * DM, scr, r, lane, false); continue; } r -= I_OUT;
        if (r < I_FI) { transpose_item(P.in[15] + (size_t)l * DM * 2 * DFF, DM, 2 * DFF, (bf16_t*)(P.ws + WS_WFI) + (size_t)l * 2 * DFF * DM, scr, r, lane, true); continue; } r -= I_FI;
        transpose_item(P.in[16] + (size_t)l * DFF * DM, DFF, DM, (bf16_t*)(P.ws + WS_WFO) + (size_t)l * DM * DFF, scr, r, lane, false);
    }
    f32x2* ROPE = (f32x2*)(P.ws + WS_ROPE);
    for (int idx = blockIdx.x * 512 + tid; idx < SEQ * 64; idx += gridDim.x * 512) {
        const int pos = idx >> 6, i = idx & 63;
        const float inv = exp2f(-(float)i * (13.287712379549449f / 64.f));
        const float ang = (float)pos * inv;
        double rev = (double)ang * 0.15915494309189535; rev -= floor(rev);
        const float rf = (float)rev;
        ROPE[idx] = (f32x2){__builtin_amdgcn_cosf(rf), __builtin_amdgcn_sinf(rf)};
    }
}

template <bool FINAL>
__device__ __forceinline__ void norm_phase(const Params& P, int l, bool from_input, const float* gain, int sh_off, int sc_off, int lane, int wave) {
    const int gw = blockIdx.x * 8 + wave, NGW = gridDim.x * 8;
    const float* MOD = (const float*)(P.ws + WS_MOD) + (size_t)l * NBI * NMOD;
    const float* X = (const float*)(P.ws + WS_X); bf16_t* H = (bf16_t*)(P.ws + WS_H);
    f32x4 g[4];
#pragma unroll
    for (int j = 0; j < 4; ++j) g[j] = *(const f32x4*)(gain + 4 * lane + 256 * j);
    for (int m = gw; m < MT; m += NGW) {
        const float* xr = (!FINAL && from_input) ? (m < MP ? P.in[0] + (size_t)m * DM : P.in[1] + (size_t)(m - MP) * DM) : X + (size_t)m * DM;
        f32x4 v[4]; float ss = 0.f;
#pragma unroll
        for (int j = 0; j < 4; ++j) { v[j] = *(const f32x4*)(xr + 4 * lane + 256 * j); ss += (v[j].x * v[j].x + v[j].y * v[j].y) + (v[j].z * v[j].z + v[j].w * v[j].w); }
        const float rstd = rsqrtf(wave_sum(ss) * (1.f / DM) + EPS);
        if (FINAL) {
            float* o = P.out + (size_t)m * DM;
#pragma unroll
            for (int j = 0; j < 4; ++j) *(f32x4*)(o + 4 * lane + 256 * j) = v[j] * rstd * g[j];
        } else {
            const float* mr = MOD + (size_t)batch_of(m) * NMOD;
#pragma unroll
            for (int j = 0; j < 4; ++j) { const int c = 4 * lane + 256 * j;
                const f32x4 sc = *(const f32x4*)(mr + sc_off + c), sh = *(const f32x4*)(mr + sh_off + c);
                const f32x4 hh = v[j] * rstd * g[j] * (1.f + sc) + sh;
                u32x2 w; w.x = pk2(hh.x, hh.y); w.y = pk2(hh.z, hh.w);
                *(u32x2*)(H + (size_t)m * DM + c) = w; }
        }
    }
}

__device__ __forceinline__ void sb_unit(const Params& P, int l, int u, LAS unsigned char* lds, int tid, int lane, int wave) {
    const bf16_t* QKV = (const bf16_t*)(P.ws + WS_QKV);
    const int h = wave, l32 = lane & 31, hf = lane >> 5;
    const bool samp = u >= 1024;
    int qrow0, nsteps; const float* ck = nullptr; const float* cv = nullptr;
    if (!samp) { const int b = u >> 9, qb = u & 511; qrow0 = b * SEQ + qb * 32; nsteps = qb + 1; }
    else { const int bs = u - 1024; qrow0 = MP + bs * 32; nsteps = 65; ck = P.in[2] + (size_t)(l * DB + bs) * PAST * 512; cv = P.in[3] + (size_t)(l * DB + bs) * PAST * 512; }
    bf16x8 qf[4];
#pragma unroll
    for (int ks = 0; ks < 4; ++ks) qf[ks] = *(const bf16x8*)(QKV + (size_t)(qrow0 + l32) * INW + h * 64 + ks * 16 + hf * 8);
    f32x16 O0, O1;
#pragma unroll
    for (int r = 0; r < 16; ++r) { O0[r] = 0.f; O1[r] = 0.f; }
    float cum = 0.f;
    LAS unsigned char* vt = lds + 66048 + wave * 4608;
    auto issue = [&](int s, bf16x8 (&k)[4], bf16x8 (&v)[4]) {
        if (!samp || s == 0) {
            const int krow0 = samp ? qrow0 : qrow0 - s * 32;
#pragma unroll
            for (int ks = 0; ks < 4; ++ks) k[ks] = *(const bf16x8*)(QKV + (size_t)(krow0 + l32) * INW + 512 + h * 64 + ks * 16 + hf * 8);
#pragma unroll
            for (int it = 0; it < 4; ++it) { const int id = it * 64 + lane, key = id >> 3, ch = id & 7;
                v[it] = *(const bf16x8*)(QKV + (size_t)(krow0 + key) * INW + 1024 + h * 64 + ch * 8); }
        } else {
            const int kpos0 = (64 - s) * 32;
#pragma unroll
            for (int ks = 0; ks < 4; ++ks) { const float* p = ck + (size_t)(kpos0 + l32) * 512 + h * 64 + ks * 16 + hf * 8; k[ks] = pack8(*(const f32x4*)p, *(const f32x4*)(p + 4)); }
#pragma unroll
            for (int it = 0; it < 4; ++it) { const int id = it * 64 + lane, key = id >> 3, ch = id & 7;
                const float* p = cv + (size_t)(kpos0 + key) * 512 + h * 64 + ch * 8;
                v[it] = pack8(*(const f32x4*)p, *(const f32x4*)(p + 4)); }
        }
    };
    bf16x8 kf[4], vr[4];
    issue(0, kf, vr);
    for (int s = 0; s < nsteps; ++s) {
#pragma unroll
        for (int it = 0; it < 4; ++it) { const int id = it * 64 + lane, key = id >> 3, ch = id & 7; *(LAS bf16x8*)(vt + key * 144 + ch * 16) = vr[it]; }
        bf16x8 kn[4];
#pragma unroll
        for (int ks = 0; ks < 4; ++ks) kn[ks] = kf[ks];
        if (s + 1 < nsteps) issue(s + 1, kn, vr);
        asm volatile("s_waitcnt lgkmcnt(0)" ::: "memory"); __builtin_amdgcn_wave_barrier();
        f32x16 S;
#pragma unroll
        for (int r = 0; r < 16; ++r) S[r] = 0.f;
#pragma unroll
        for (int ks = 0; ks < 4; ++ks) S = MFMA32(kf[ks], qf[ks], S);
        float L[16], lb[16]; bool valid[16];
#pragma unroll
        for (int r = 0; r < 16; ++r) {
            const float z = S[r] * 0.125f;
            const float sp = fmaxf(z, 0.f) + __logf(1.f + __expf(-fabsf(z)));
            const int key = (r >> 2) * 8 + hf * 4 + (r & 3);
            valid[r] = (s != 0) || (key < l32);
            L[r] = valid[r] ? -sp : 0.f; lb[r] = z - sp;
        }
        float T[4], Pp[4];
#pragma unroll
        for (int g = 0; g < 4; ++g) { T[g] = (L[4 * g] + L[4 * g + 1]) + (L[4 * g + 2] + L[4 * g + 3]); Pp[g] = __shfl_xor(T[g], 32); }
        float later[4]; float tot = 0.f;
#pragma unroll
        for (int g = 3; g >= 0; --g) { later[g] = tot; tot += T[g] + Pp[g]; }
        float w[16];
#pragma unroll
        for (int g = 0; g < 4; ++g) {
            const float s3 = cum + later[g] + (hf == 0 ? Pp[g] : 0.f);
            const float s2 = s3 + L[4 * g + 3], s1 = s2 + L[4 * g + 2], s0 = s1 + L[4 * g + 1];
            w[4 * g + 3] = valid[4 * g + 3] ? __expf(lb[4 * g + 3] + s3) : 0.f;
            w[4 * g + 2] = valid[4 * g + 2] ? __expf(lb[4 * g + 2] + s2) : 0.f;
            w[4 * g + 1] = valid[4 * g + 1] ? __expf(lb[4 * g + 1] + s1) : 0.f;
            w[4 * g + 0] = valid[4 * g + 0] ? __expf(lb[4 * g + 0] + s0) : 0.f;
        }
        cum += tot;
#pragma unroll
        for (int c = 0; c < 2; ++c) {
            u32x4 pw; pw.x = pk2(w[8 * c], w[8 * c + 1]); pw.y = pk2(w[8 * c + 2], w[8 * c + 3]); pw.z = pk2(w[8 * c + 4], w[8 * c + 5]); pw.w = pk2(w[8 * c + 6], w[8 * c + 7]);
            const bf16x8 pa = __builtin_bit_cast(bf16x8, pw);
#pragma unroll
            for (int dt = 0; dt < 2; ++dt) {
                bf16x8 vb;
#pragma unroll
                for (int i = 0; i < 8; ++i) { const int key = 16 * c + 8 * (i >> 2) + 4 * hf + (i & 3); vb[i] = *(const LAS short*)(vt + key * 144 + (l32 + 32 * dt) * 2); }
                if (dt == 0) O0 = MFMA32(pa, vb, O0); else O1 = MFMA32(pa, vb, O1);
            }
        }
        asm volatile("" ::: "memory");
        if (__all(cum < -110.f)) break;
#pragma unroll
        for (int ks = 0; ks < 4; ++ks) kf[ks] = kn[ks];
    }
    LAS float* oa = (LAS float*)lds;
#pragma unroll
    for (int r = 0; r < 16; ++r) { const int q = (r >> 2) * 8 + hf * 4 + (r & 3); oa[q * 516 + h * 64 + l32] = O0[r]; oa[q * 516 + h * 64 + 32 + l32] = O1[r]; }
    __syncthreads();
    bf16_t* Ob = (bf16_t*)(P.ws + WS_O);
    const float* gsb = P.in[12] + (size_t)l * 512;
#pragma unroll
    for (int rr = 0; rr < 4; ++rr) {
        const int q = wave * 4 + rr;
        const f32x4 a = *(const LAS f32x4*)(oa + q * 516 + 4 * lane), b = *(const LAS f32x4*)(oa + q * 516 + 256 + 4 * lane);
        float ss = (a.x * a.x + a.y * a.y) + (a.z * a.z + a.w * a.w) + (b.x * b.x + b.y * b.y) + (b.z * b.z + b.w * b.w);
        const float rstd = rsqrtf(wave_sum(ss) * (1.f / 512.f) + EPS);
        const f32x4 ga = *(const f32x4*)(gsb + 4 * lane), gb = *(const f32x4*)(gsb + 256 + 4 * lane);
        const f32x4 ya = a * rstd * ga, yb = b * rstd * gb;
        u32x2 wa, wb; wa.x = pk2(ya.x, ya.y); wa.y = pk2(ya.z, ya.w); wb.x = pk2(yb.x, yb.y); wb.y = pk2(yb.z, yb.w);
        *(u32x2*)(Ob + (size_t)(qrow0 + q) * DM + 4 * lane) = wa; *(u32x2*)(Ob + (size_t)(qrow0 + q) * DM + 256 + 4 * lane) = wb;
    }
    __syncthreads();
}

__device__ __forceinline__ void ret_unit(const Params& P, int l, LAS unsigned char* lds, int tid, int lane, int wave,
                                         int row0, int pos0, int nchunks, int L, int h, const float* init, float* outst, bool state_only) {
    const bf16_t* QKV = (const bf16_t*)(P.ws + WS_QKV); bf16_t* Ob = (bf16_t*)(P.ws + WS_O);
    const f32x2* ROPE = (const f32x2*)(P.ws + WS_ROPE);
    const float lg2 = log2f(1.f - exp2f(-5.f - (float)h));
    LAS unsigned char *Qn = lds, *Kn = lds + 17408, *KdT = lds + 34816, *VT = lds + 53248, *SbT = lds + 71680, *Pm = lds + 106496;
    LAS float* of = (LAS float*)lds;
    const int l32 = lane & 31, hf = lane >> 5;
    const int sdt = wave >> 1, set0 = (wave & 1) * 2;
    f32x16 S0, S1;
#pragma unroll
    for (int r = 0; r < 16; ++r) { S0[r] = 0.f; S1[r] = 0.f; }
    if (init) {
        const float* ip = init + (sdt * 32 + hf * 4) * 128 + set0 * 32 + l32;
#pragma unroll
        for (int r = 0; r < 16; ++r) { S0[r] = ip[((r >> 2) * 8 + (r & 3)) * 128]; S1[r] = ip[((r >> 2) * 8 + (r & 3)) * 128 + 32]; if ((r & 3) == 3) asm volatile("" ::: "memory"); }
    }
    if (!state_only) {
#pragma unroll
        for (int g = 0; g < 4; ++g) { const int d0 = sdt * 32 + g * 8 + hf * 4;
            u32x2 a, b; a.x = pk2(S0[4 * g], S0[4 * g + 1]); a.y = pk2(S0[4 * g + 2], S0[4 * g + 3]); b.x = pk2(S1[4 * g], S1[4 * g + 1]); b.y = pk2(S1[4 * g + 2], S1[4 * g + 3]);
            *(LAS u32x2*)(SbT + (set0 * 32 + l32) * 272 + d0 * 2) = a; *(LAS u32x2*)(SbT + ((set0 + 1) * 32 + l32) * 272 + d0 * 2) = b; }
    }
    const float gL = exp2f((float)L * lg2);
    const int lt = wave >> 2, et = wave & 3;
    bf16x8 rk1, rk2, rq1, rq2, rv0, rv1; f32x4 rcs[4];
    const bf16x8 z8 = {0, 0, 0, 0, 0, 0, 0, 0};
    auto issue = [&](int c) {
        const int t = tid >> 3, i0 = (tid & 7) * 8; const bool ok = t < L;
        const size_t row = (size_t)(row0 + c * 64 + t);
        rk1 = z8; rk2 = z8; rq1 = z8; rq2 = z8;
#pragma unroll
        for (int i = 0; i < 4; ++i) rcs[i] = (f32x4){0.f, 0.f, 0.f, 0.f};
        if (ok) {
            rk1 = *(const bf16x8*)(QKV + row * INW + 2048 + h * 128 + i0); rk2 = *(const bf16x8*)(QKV + row * INW + 2048 + h * 128 + 64 + i0);
            if (!state_only) { rq1 = *(const bf16x8*)(QKV + row * INW + 1536 + h * 128 + i0); rq2 = *(const bf16x8*)(QKV + row * INW + 1536 + h * 128 + 64 + i0); }
            const f32x4* rp = (const f32x4*)(ROPE + (size_t)(pos0 + c * 64 + t) * 64 + i0);
#pragma unroll
            for (int i = 0; i < 4; ++i) rcs[i] = rp[i];
        }
        const int t0 = tid >> 4, ch = tid & 15;
        rv0 = z8; rv1 = z8;
        if (t0 < L) rv0 = *(const bf16x8*)(QKV + (size_t)(row0 + c * 64 + t0) * INW + 2560 + h * 128 + ch * 8);
        if (t0 + 32 < L) rv1 = *(const bf16x8*)(QKV + (size_t)(row0 + c * 64 + t0 + 32) * INW + 2560 + h * 128 + ch * 8);
    };
    issue(0);
    const int l32_0 = l32, hf_0 = hf, tid_0 = tid; const float lg2_0 = lg2;
#pragma unroll 1
    for (int c = 0; c < nchunks; ++c) {
        int l32 = l32_0, hf = hf_0, tid = tid_0; float lg2 = lg2_0;
        asm volatile("" : "+v"(l32), "+v"(hf), "+v"(tid), "+v"(lg2));
        {
            const int t = tid >> 3, pc = tid & 7, i0 = pc * 8; const bool ok = t < L;
            const float kd = ok ? __builtin_amdgcn_exp2f((float)(L - 1 - t) * lg2) : 0.f;
            const int tsw = (((t >> 3) ^ pc) << 4) + (t & 7) * 2;
            float cs_c[8], cs_s[8];
#pragma unroll
            for (int i = 0; i < 4; ++i) { cs_c[2 * i] = rcs[i].x; cs_s[2 * i] = rcs[i].y; cs_c[2 * i + 1] = rcs[i].z; cs_s[2 * i + 1] = rcs[i].w; }
            {
                float o1[8], o2[8];
#pragma unroll
                for (int i = 0; i < 8; ++i) { const float x1 = bf2f((unsigned short)rk1[i]), x2 = bf2f((unsigned short)rk2[i]);
                    o1[i] = (x1 * cs_c[i] - x2 * cs_s[i]) * 0.08838834764831845f; o2[i] = (x1 * cs_s[i] + x2 * cs_c[i]) * 0.08838834764831845f; }
                if (!state_only) {
                    u32x4 a, b; a.x = pk2(o1[0], o1[1]); a.y = pk2(o1[2], o1[3]); a.z = pk2(o1[4], o1[5]); a.w = pk2(o1[6], o1[7]);
                    b.x = pk2(o2[0], o2[1]); b.y = pk2(o2[2], o2[3]); b.z = pk2(o2[4], o2[5]); b.w = pk2(o2[6], o2[7]);
                    *(LAS u32x4*)(Kn + t * 272 + i0 * 2) = a; *(LAS u32x4*)(Kn + t * 272 + (64 + i0) * 2) = b;
                }
#pragma unroll
                for (int i = 0; i < 8; ++i) { *(LAS unsigned short*)(KdT + (i0 + i) * 144 + tsw) = (unsigned short)f2bf(o1[i] * kd); *(LAS unsigned short*)(KdT + (64 + i0 + i) * 144 + tsw) = (unsigned short)f2bf(o2[i] * kd); }
            }
            if (!state_only) {
                float o1[8], o2[8];
#pragma unroll
                for (int i = 0; i < 8; ++i) { const float x1 = bf2f((unsigned short)rq1[i]), x2 = bf2f((unsigned short)rq2[i]);
                    o1[i] = x1 * cs_c[i] - x2 * cs_s[i]; o2[i] = x1 * cs_s[i] + x2 * cs_c[i]; }
                u32x4 a, b; a.x = pk2(o1[0], o1[1]); a.y = pk2(o1[2], o1[3]); a.z = pk2(o1[4], o1[5]); a.w = pk2(o1[6], o1[7]);
                b.x = pk2(o2[0], o2[1]); b.y = pk2(o2[2], o2[3]); b.z = pk2(o2[4], o2[5]); b.w = pk2(o2[6], o2[7]);
                *(LAS u32x4*)(Qn + t * 272 + i0 * 2) = a; *(LAS u32x4*)(Qn + t * 272 + (64 + i0) * 2) = b;
            }
            {
                const int t0 = tid >> 4, ch = tid & 15, sw = ch & 7;
                const int o0 = (((t0 >> 3) ^ sw) << 4) + (t0 & 7) * 2, o1b = ((((t0 + 32) >> 3) ^ sw) << 4) + (t0 & 7) * 2;
#pragma unroll
                for (int i = 0; i < 8; ++i) { *(LAS short*)(VT + (ch * 8 + i) * 144 + o0) = rv0[i]; *(LAS short*)(VT + (ch * 8 + i) * 144 + o1b) = rv1[i]; }
            }
        }
        if (c + 1 < nchunks) issue(c + 1);
        __syncthreads();
        f32x16 acc;
        if (!state_only) {
#pragma unroll
            for (int r = 0; r < 16; ++r) acc[r] = 0.f;
#pragma unroll
            for (int ks = 0; ks < 8; ++ks) { const bf16x8 a = *(const LAS bf16x8*)(Qn + (lt * 32 + l32) * 272 + (ks * 16 + hf * 8) * 2), b = *(const LAS bf16x8*)(SbT + (et * 32 + l32) * 272 + (ks * 16 + hf * 8) * 2); acc = MFMA32(a, b, acc); }
#pragma unroll
            for (int r = 0; r < 16; ++r) { const int tl = lt * 32 + (r >> 2) * 8 + hf * 4 + (r & 3); acc[r] *= __builtin_amdgcn_exp2f((float)(tl + 1) * lg2); }
            if (wave < 4) {
                const int slt = wave >> 1, smt = wave & 1;
                f32x16 sc;
#pragma unroll
                for (int r = 0; r < 16; ++r) sc[r] = 0.f;
                if (slt >= smt) {
#pragma unroll
                    for (int ks = 0; ks < 8; ++ks) { const bf16x8 a = *(const LAS bf16x8*)(Qn + (slt * 32 + l32) * 272 + (ks * 16 + hf * 8) * 2), b = *(const LAS bf16x8*)(Kn + (smt * 32 + l32) * 272 + (ks * 16 + hf * 8) * 2); sc = MFMA32(a, b, sc); }
                }
                const int tm = smt * 32 + l32;
#pragma unroll
                for (int r = 0; r < 16; ++r) { const int tl = slt * 32 + (r >> 2) * 8 + hf * 4 + (r & 3);
                    const float p = tl >= tm ? sc[r] * __builtin_amdgcn_exp2f((float)(tl - tm) * lg2) : 0.f;
                    *(LAS unsigned short*)(Pm + tl * 144 + tm * 2) = (unsigned short)f2bf(p); }
            }
            __syncthreads();
#pragma unroll
            for (int ms = 0; ms < 4; ++ms) { const bf16x8 a = *(const LAS bf16x8*)(Pm + (lt * 32 + l32) * 144 + (ms * 16 + hf * 8) * 2), b = *(const LAS bf16x8*)(VT + (et * 32 + l32) * 144 + (((ms * 2 + hf) ^ ((et * 4 + (l32 >> 3)) & 7)) << 4)); acc = MFMA32(a, b, acc); }
#pragma unroll
            for (int r = 0; r < 16; ++r) { const int tl = lt * 32 + (r >> 2) * 8 + hf * 4 + (r & 3); of[tl * 132 + et * 32 + l32] = acc[r]; }
        }
#pragma unroll
        for (int r = 0; r < 16; ++r) { S0[r] *= gL; S1[r] *= gL; }
#pragma unroll
        for (int ts = 0; ts < 4; ++ts) {
            const int cc = ts * 2 + hf, rs = l32 >> 3;
            const bf16x8 a = *(const LAS bf16x8*)(KdT + (sdt * 32 + l32) * 144 + ((cc ^ ((sdt * 4 + rs) & 7)) << 4));
            const bf16x8 b0 = *(const LAS bf16x8*)(VT + (set0 * 32 + l32) * 144 + ((cc ^ ((set0 * 4 + rs) & 7)) << 4)), b1 = *(const LAS bf16x8*)(VT + ((set0 + 1) * 32 + l32) * 144 + ((cc ^ (((set0 + 1) * 4 + rs) & 7)) << 4));
            S0 = MFMA32(a, b0, S0); S1 = MFMA32(a, b1, S1);
        }
        if (!state_only) {
#pragma unroll
            for (int g = 0; g < 4; ++g) { const int d0 = sdt * 32 + g * 8 + hf * 4;
                u32x2 a, b; a.x = pk2(S0[4 * g], S0[4 * g + 1]); a.y = pk2(S0[4 * g + 2], S0[4 * g + 3]); b.x = pk2(S1[4 * g], S1[4 * g + 1]); b.y = pk2(S1[4 * g + 2], S1[4 * g + 3]);
                *(LAS u32x2*)(SbT + (set0 * 32 + l32) * 272 + d0 * 2) = a; *(LAS u32x2*)(SbT + ((set0 + 1) * 32 + l32) * 272 + d0 * 2) = b; }
            __syncthreads();
            const f32x2 gr = *(const f32x2*)(P.in[13] + (size_t)(l * 4 + h) * 128 + lane * 2);
#pragma unroll
            for (int rr = 0; rr < 8; ++rr) {
                const int t = wave * 8 + rr;
                if (t < L) {
                    const f32x2 v = *(const LAS f32x2*)(of + t * 132 + lane * 2);
                    const float rstd = rsqrtf(wave_sum(v.x * v.x + v.y * v.y) * (1.f / 128.f) + EPS);
                    const size_t row = (size_t)(row0 + c * 64 + t);
                    const unsigned gg = *(const unsigned*)(QKV + row * INW + 3072 + h * 128 + lane * 2);
                    const float y0 = v.x * rstd * gr.x * silu_f(bf2f(gg & 0xffffu)), y1 = v.y * rstd * gr.y * silu_f(bf2f(gg >> 16));
                    *(unsigned*)(Ob + row * DM + 512 + h * 128 + lane * 2) = pk2(y0, y1);
                }
            }
        }
        __syncthreads();
    }
    if (outst) {
        float* op = outst + (sdt * 32 + hf * 4) * 128 + set0 * 32 + l32;
#pragma unroll
        for (int r = 0; r < 16; ++r) { op[((r >> 2) * 8 + (r & 3)) * 128] = S0[r]; op[((r >> 2) * 8 + (r & 3)) * 128 + 32] = S1[r]; if ((r & 3) == 3) asm volatile("" ::: "memory"); }
    }
}


#define XB_TMO      128
#define XB_XCNT(j)  (256  + 64 * (j))
#define XB_XSUB(j)  (1280 + 64 * (j))
#define XB_XGEN(j)  (2304 + 64 * (j))
#define XB_TOP      3328
#define XB_TOPGEN   3392
#define XCD_BAR_WORDS 3456
#define XB_SPIN_CAP (1u << 18)

__device__ __forceinline__ unsigned xb_ld(unsigned* p)              { return __hip_atomic_load(p, __ATOMIC_RELAXED, __HIP_MEMORY_SCOPE_AGENT); }
__device__ __forceinline__ unsigned xb_add(unsigned* p, unsigned v) { return __hip_atomic_fetch_add(p, v, __ATOMIC_RELAXED, __HIP_MEMORY_SCOPE_AGENT); }
__device__ __forceinline__ unsigned xb_xcc_id() { return (unsigned)__builtin_amdgcn_s_getreg((3 << 11) | 20) & 0xFu; }
#define XB_SPIN(cond, bar) do { unsigned _sp = 0; while (cond) { __builtin_amdgcn_s_sleep(1); \
    if ((++_sp & 255u) == 0u) { if (xb_ld(&(bar)[XB_TMO])) break; if (_sp > XB_SPIN_CAP) { atomicAdd(&(bar)[XB_TMO], 1u); break; } } } } while (0)

struct XcdBarrier {
    unsigned* bar; unsigned x;
    volatile LAS unsigned* st;
};

__device__ __forceinline__ XcdBarrier xcd_barrier_post(unsigned* bar, volatile LAS unsigned* st) {
    XcdBarrier b; b.bar = bar; b.x = xb_xcc_id(); b.st = st;
    if (threadIdx.x == 0) (void)xb_add(&bar[XB_XCNT(b.x)], 1u);
    return b;
}
__device__ __forceinline__ void xcd_barrier_complete(unsigned* bar, unsigned x, unsigned& nloc, unsigned& nx) {
    const unsigned G = gridDim.x * gridDim.y * gridDim.z;
    unsigned sum, cnt, mine, sp = 0u;
    for (;;) {
        sum = 0u; cnt = 0u; mine = 0u;
#pragma unroll
        for (unsigned j = 0; j < 16; ++j) { const unsigned c = xb_ld(&bar[XB_XCNT(j)]); sum += c; cnt += (c > 0u) ? 1u : 0u; mine = (j == x) ? c : mine; }
        if (sum == G) break;
        __builtin_amdgcn_s_sleep(1);
        if ((++sp & 255u) == 0u) { if (xb_ld(&bar[XB_TMO])) break; if (sp > XB_SPIN_CAP) { atomicAdd(&bar[XB_TMO], 1u); break; } }
    }
    nloc = mine > 0u ? mine : 1u; nx = cnt > 0u ? cnt : 1u;
}

__device__ __forceinline__ void xcd_barrier(const XcdBarrier& b) {
    asm volatile("s_waitcnt vmcnt(0)" ::: "memory");
    __syncthreads();
    if (threadIdx.x == 0) {
        unsigned* bar = b.bar;
        __builtin_amdgcn_s_waitcnt(0);
        unsigned nloc = b.st[0], nx = b.st[1];
        if (nloc == 0u) { xcd_barrier_complete(bar, b.x, nloc, nx); b.st[0] = nloc; b.st[1] = nx; }
        const unsigned old = xb_add(&bar[XB_XSUB(b.x)], 1u);
        const unsigned gen = old / nloc;
        if (old + 1u == (gen + 1u) * nloc) {
            __builtin_amdgcn_fence(__ATOMIC_RELEASE, "agent");
            asm volatile("s_waitcnt vmcnt(0)" ::: "memory");
            const unsigned og = xb_add(&bar[XB_TOP], 1u);
            const unsigned tg = og / nx;
            if (og + 1u == (tg + 1u) * nx) xb_add(&bar[XB_TOPGEN], 1u);
            else XB_SPIN(xb_ld(&bar[XB_TOPGEN]) == tg, bar);
            __builtin_amdgcn_fence(__ATOMIC_ACQUIRE, "agent");
            xb_add(&bar[XB_XGEN(b.x)], 1u);
            asm volatile("s_waitcnt vmcnt(0)" ::: "memory");
        } else {
            XB_SPIN(xb_ld(&bar[XB_XGEN(b.x)]) == gen, bar);
            __builtin_amdgcn_fence(__ATOMIC_ACQUIRE, "agent");
            asm volatile("s_waitcnt vmcnt(0)" ::: "memory");
        }
    }
    __syncthreads();
}
__global__ void __launch_bounds__(512, 2) fwd_megakernel(Params P) {
    extern __shared__ __attribute__((aligned(16))) unsigned char lds_raw[];
    LAS unsigned char* lds = (LAS unsigned char*)lds_raw;
    cg::grid_group grid = cg::this_grid();
    int tid = threadIdx.x, lane = tid & 63, wave = __builtin_amdgcn_readfirstlane(tid >> 6);
#define REFRESH() do { tid = threadIdx.x; asm volatile("" : "+v"(tid)); lane = tid & 63; wave = __builtin_amdgcn_readfirstlane(tid >> 6); } while (0)
    const int G = gridDim.x, bx = blockIdx.x;
    bf16_t* H = (bf16_t*)(P.ws + WS_H); bf16_t* Ob = (bf16_t*)(P.ws + WS_O); bf16_t* QKV = (bf16_t*)(P.ws + WS_QKV); bf16_t* ACT = QKV;
    float* X = (float*)(P.ws + WS_X); float* U = (float*)(P.ws + WS_U);
    const float* MOD = (const float*)(P.ws + WS_MOD);

    volatile LAS unsigned* bst = (volatile LAS unsigned*)(lds + LDS_BYTES - 64);
    if (tid == 0) { bst[0] = 0u; bst[1] = 0u; }
    __syncthreads();
    const XcdBarrier xbar = xcd_barrier_post((unsigned*)(P.ws + WS_BAR), bst);
#ifndef SK_P0
    p0_phase(P, lds, tid, lane, wave);
#endif
    grid.sync(); REFRESH();
#pragma unroll 1
    for (int l = 0; l < DEPTH; ++l) {
        norm_phase<false>(P, l, l == 0, P.in[7] + (size_t)l * DM, 0, 1024, lane, wave);
        xcd_barrier(xbar); REFRESH();
#ifndef SK_G1
        {
            pg8::Gemm g{H, (const bf16_t*)(P.ws + WS_WIN) + (size_t)l * INW * DM, MT, INW, DM}; pg8::StaticOrder S; S.init(MT, INW, G, bx);
            EpiQKV E{QKV, P.out, l};
            pg8::gemm_phase<EpiQKV, pg8::StaticOrder, true, true>(lds, g, S, E);
        }
#endif
        xcd_barrier(xbar); REFRESH();
        for (int u = bx; u < 1360; u += G) {
#ifndef SK_R1
            if (u < 256) { const int bh = u >> 5, seg = u & 31, b = bh >> 2, h = bh & 3;
                ret_unit(P, l, lds, tid, lane, wave, b * SEQ + seg * 512, seg * 512, 8, 64, h, nullptr, U + (size_t)(bh * 32 + seg) * 16384, true); }
            else
#endif
#ifndef SK_RS
            if (u < 320) { const int idx = u - 256, bs = idx >> 2, h = idx & 3; const size_t so = ((size_t)(l * DB + bs) * 4 + h) * 16384;
                ret_unit(P, l, lds, tid, lane, wave, MP + bs * 32, PAST, 1, 32, h, P.in[4] + so, P.out + OFF_RS + so, false); }
            else
#endif
            {}
#ifndef SK_SB
            if (u >= 320) sb_unit(P, l, u - 320, lds, tid, lane, wave);
#endif
        }
        xcd_barrier(xbar); REFRESH();
        for (int idx = bx * 512 + tid; idx < 8 * 16384; idx += G * 512) {
            const int bh = idx >> 14, within = idx & 16383, h = bh & 3;
            const float g512 = exp2f(512.f * log2f(1.f - exp2f(-5.f - (float)h)));
            float* up = U + (size_t)bh * 32 * 16384 + within; float s = 0.f;
            for (int seg = 0; seg < 32; ++seg) { const float uu = up[(size_t)seg * 16384]; up[(size_t)seg * 16384] = s; s = g512 * s + uu; }
            P.out[OFF_RP + ((size_t)l * 8 + bh) * 16384 + within] = s;
        }
        xcd_barrier(xbar); REFRESH();
#ifndef SK_R3
        for (int u = bx; u < 256; u += G) { const int bh = u >> 5, seg = u & 31, b = bh >> 2, h = bh & 3;
            ret_unit(P, l, lds, tid, lane, wave, b * SEQ + seg * 512, seg * 512, 8, 64, h, U + (size_t)(bh * 32 + seg) * 16384, nullptr, false); }
#endif
        xcd_barrier(xbar); REFRESH();
#ifndef SK_G2
        {
            pg8::Gemm g{Ob, (const bf16_t*)(P.ws + WS_WOUT) + (size_t)l * DM * DM, MT, DM, DM}; pg8::StaticOrder S; S.init(MT, DM, G, bx);
            EpiResid E{l == 0 ? P.in[0] : nullptr, l == 0 ? P.in[1] : nullptr, X, MOD + (size_t)l * NBI * NMOD + 2048};
            pg8::gemm_phase<EpiResid, pg8::StaticOrder, true, true>(lds, g, S, E);
        }
#endif
        xcd_barrier(xbar); REFRESH();
        norm_phase<false>(P, l, false, P.in[8] + (size_t)l * DM, 3072, 4096, lane, wave);
        xcd_barrier(xbar); REFRESH();
#ifndef SK_G3
        {
            pg8::Gemm g{H, (const bf16_t*)(P.ws + WS_WFI) + (size_t)l * 2 * DFF * DM, MT, 2 * DFF, DM}; pg8::StaticOrder S; S.init(MT, 2 * DFF, G, bx);
            EpiSwiGLU E{ACT};
            pg8::gemm_phase<EpiSwiGLU, pg8::StaticOrder, true, true>(lds, g, S, E);
        }
#endif
        xcd_barrier(xbar); REFRESH();
#ifndef SK_G4
        {
            pg8::Gemm g{ACT, (const bf16_t*)(P.ws + WS_WFO) + (size_t)l * DM * DFF, MT, DM, DFF}; pg8::StaticOrder S; S.init(MT, DM, G, bx);
            EpiResid E{nullptr, nullptr, X, MOD + (size_t)l * NBI * NMOD + 5120};
            pg8::gemm_phase<EpiResid, pg8::StaticOrder, true, true>(lds, g, S, E);
        }
#endif
        xcd_barrier(xbar); REFRESH();
    }
    norm_phase<true>(P, 0, false, P.in[17], 0, 0, lane, wave);
}

extern "C" void kernel_launch(void* const* d_in, const int* in_sizes, int n_in, void* d_out, int out_size, void* d_ws, size_t ws_size, hipStream_t stream) {
    static int grid = 0;
    if (grid == 0) {
        if (n_in != 18 || ws_size < WS_END) { fprintf(stderr, "kernel_launch: unexpected n_in %d / ws_size %zu\n", n_in, ws_size); grid = -1; return; }
        int dev = 0, cus = 0, per_cu = 0;
        (void)hipGetDevice(&dev); (void)hipDeviceGetAttribute(&cus, hipDeviceAttributeMultiprocessorCount, dev);
        if (hipFuncSetAttribute((const void*)fwd_megakernel, hipFuncAttributeMaxDynamicSharedMemorySize, LDS_BYTES) != hipSuccess) { fprintf(stderr, "kernel_launch: hipFuncSetAttribute failed\n"); grid = -1; return; }
        (void)hipOccupancyMaxActiveBlocksPerMultiprocessor(&per_cu, (const void*)fwd_megakernel, 512, LDS_BYTES);
        (void)hipGetLastError();
        if (per_cu < 1) { fprintf(stderr, "kernel_launch: occupancy query says %d blocks per CU\n", per_cu); per_cu = 1; }
        grid = cus;
    }
    if (grid < 0) return;
    (void)hipMemsetAsync((char*)d_ws + WS_MOD, 0, MOD_BYTES, stream);
    Params p{};
    for (int i = 0; i < 18; ++i) p.in[i] = (const float*)d_in[i];
    p.out = (float*)d_out; p.ws = (unsigned char*)d_ws;
    void* args[] = {&p};
    hipError_t e = hipLaunchCooperativeKernel((const void*)fwd_megakernel, dim3(grid), dim3(512), args, LDS_BYTES, stream);
    if (e != hipSuccess) fprintf(stderr, "cooperative launch failed: %s (grid %d)\n", hipGetErrorString(e), grid);
}
```

```cpp
#include <hip/hip_runtime.h>
#include <hip/hip_cooperative_groups.h>
#include <cstdio>
#include <cstdint>
namespace cg = cooperative_groups;
namespace pg8 {
#define PG8_LAS __attribute__((address_space(3)))
typedef unsigned short bf16_t;
typedef short bf16x8 __attribute__((ext_vector_type(8)));
typedef float f32x4 __attribute__((ext_vector_type(4)));
typedef unsigned u32x4 __attribute__((ext_vector_type(4)));
constexpr int BM = 256, BK = 64, HALF = 128, HTB = HALF * BK * 2  , STAGE_BYTES = 8 * HTB, NXCD = 8, WGM = 8;

__host__ __device__ __forceinline__ int lds_byte(int r, int c) { const int st = (r >> 4) * 2 + (c >> 5), rr = r & 15, cc = c & 31, ob = rr * 64 + cc * 2; return st * 1024 + (ob ^ (((ob >> 9) & 1) << 5)); }
__host__ __device__ __forceinline__ void stage_rc(int b, int& R, int& C) { const int st = b / 1024, sb = b % 1024, swz = sb ^ (((sb >> 9) & 1) << 5); R = (st >> 1) * 16 + swz / 64; C = (st & 1) * 32 + (swz % 64) / 2; }
__host__ __device__ __forceinline__ int perm32(int rho) { const int n = rho >> 4, i = rho & 15; return 8 * (i >> 2) + 4 * n + (i & 3); }

struct Unit { int pm, pn; };
struct Gemm { const bf16_t* A; const bf16_t* Bt; int M, N, K; };

struct StaticOrder {
    int nM, nN, nwg, G, c;
    __host__ __device__ void init(int M, int N, int G_, int c_) { nM = M / BM; nN = N / BM; nwg = nM * nN; G = G_; c = c_; }
    __host__ __device__ bool next(int i, Unit& u) const {
        const long L = (long)i * G + c; if (L >= nwg) return false;
        int wgid = (int)L; { const int q = nwg / NXCD, r = nwg % NXCD, xcd = wgid % NXCD, off = wgid / NXCD; wgid = (xcd < r ? xcd * (q + 1) : r * (q + 1) + (xcd - r) * q) + off; }
        const int nig = WGM * nN, gid = wgid / nig, fm = gid * WGM, gsz = (nM - fm) < WGM ? (nM - fm) : WGM;
        u.pm = fm + ((wgid % nig) % gsz); u.pn = (wgid % nig) / gsz; return true;
    }
    __device__ __forceinline__ void a_ready(const Unit&) const {}
    __device__ __forceinline__ void done(const Unit&) const {}
};

__device__ __forceinline__ unsigned cvt_pk_bf16(float lo, float hi) { unsigned r; asm volatile("v_cvt_pk_bf16_f32 %0, %1, %2" : "=v"(r) : "v"(lo), "v"(hi)); return r; }
typedef float f32x2 __attribute__((ext_vector_type(2)));
__device__ __forceinline__ f32x2 gelu_pk(f32x2 v) {
    const f32x2 av = __builtin_elementwise_abs(v), d = av * 0.2316418882f + 1.0f;
    f32x2 t; t.x = __builtin_amdgcn_rcpf(d.x); t.y = __builtin_amdgcn_rcpf(d.y);
    f32x2 q = t * 0.5307027145f + (-0.7265760135f); q = q * t + 0.7107068705f; q = q * t + (-0.142248368f); q = q * t + 0.127414796f; q = q * t;
    const f32x2 s = (v * v) * (-0.72134752044f);
    f32x2 e; e.x = __builtin_amdgcn_exp2f(s.x); e.y = __builtin_amdgcn_exp2f(s.y);
    const f32x2 m = v * (q * e), r = v - m;
    f32x2 o; o.x = v.x < 0.f ? m.x : r.x; o.y = v.y < 0.f ? m.y : r.y; return o;
}

template <int ACT  > struct EpiBf16 {
    static constexpr bool PERM = true, AFTER_DRAIN = false; static_assert(ACT == 0 || ACT == 1, "EpiBf16: ACT is 0 (none) or 1 (gelu_pk)");
    bf16_t* O; int ldc; const float* bias; int split_cols; size_t split_stride; float scale0;
    __device__ __forceinline__ void operator()(const f32x4 (&acc)[2][2][4][2], const Unit& u, int wr, int wc, int fr, int fq) const {
        const int row0 = u.pm * BM + wr * 64 + fr; int colt = u.pn * BM; bf16_t* base = O;
        float sc = 1.f; if (split_cols) { const int t = colt / split_cols; base += (size_t)t * split_stride; colt -= t * split_cols; if (t == 0) sc = scale0; }
        const int col0 = colt + wc * 32 + 8 * fq, bcol0 = u.pn * BM + wc * 32 + 8 * fq;
        f32x4 bv[2][2];
#pragma unroll
        for (int bj = 0; bj < 2; ++bj)
#pragma unroll
            for (int n = 0; n < 2; ++n) bv[bj][n] = bias ? *(const f32x4*)(bias + bcol0 + bj * HALF + 4 * n) : (f32x4){0.f, 0.f, 0.f, 0.f};
#pragma unroll
        for (int ai = 0; ai < 2; ++ai)
#pragma unroll
            for (int m = 0; m < 4; ++m) { bf16_t* rowp = base + (size_t)(row0 + ai * HALF + m * 16) * ldc + col0;
#pragma unroll
                for (int bj = 0; bj < 2; ++bj) { f32x4 v0 = acc[ai][bj][m][0] + bv[bj][0], v1 = acc[ai][bj][m][1] + bv[bj][1];
                    if (ACT == 1) { f32x2 a = gelu_pk((f32x2){v0[0], v0[1]}), b = gelu_pk((f32x2){v0[2], v0[3]}), c = gelu_pk((f32x2){v1[0], v1[1]}), d = gelu_pk((f32x2){v1[2], v1[3]});
                        v0 = (f32x4){a.x, a.y, b.x, b.y}; v1 = (f32x4){c.x, c.y, d.x, d.y}; }
                    v0 = v0 * sc; v1 = v1 * sc; u32x4 w; w.x = cvt_pk_bf16(v0[0], v0[1]); w.y = cvt_pk_bf16(v0[2], v0[3]); w.z = cvt_pk_bf16(v1[0], v1[1]); w.w = cvt_pk_bf16(v1[2], v1[3]);
                    *(u32x4*)(rowp + bj * HALF) = w; } }
    }
};
template <class Epi, class Sched, bool ALIGN_EPI = false, bool SP2 = false>
__device__ __forceinline__ void gemm_phase(PG8_LAS unsigned char* lds, const Gemm g, const Sched& S, const Epi& E) {
    int tid_o = threadIdx.x; asm volatile("" : "+v"(tid_o));
    const int tid = tid_o, wid = __builtin_amdgcn_readfirstlane(tid >> 6), lane = tid & 63, wr = wid >> 2, wc = wid & 3, fr = lane & 15, fq = lane >> 4;
    const int K = g.K, nt = K / BK;
    unsigned voffA[2], voffB[2];
#pragma unroll
    for (int i = 0; i < 2; ++i) { int R, C; stage_rc(tid * 16 + i * 8192, R, C); const int Rb = Epi::PERM ? ((R & ~31) + perm32(R & 31)) : R;
        voffA[i] = (unsigned)(R * K + C) * 2u; voffB[i] = (unsigned)(Rb * K + C) * 2u; }
    const size_t kstep = (size_t)(BK * 2);
    const size_t hstep = (size_t)HALF * K * 2;
    const size_t tstep = 2 * hstep;
    const unsigned ldsw = (unsigned)wid * 1024u;
    const int aoff = lds_byte(wr * 64 + fr, fq * 8), boff = lds_byte(wc * 32 + fr, fq * 8);
#define PG8_SA(b, h) (((b) * 2 + (h)) * HTB)
#define PG8_SB(b, h) ((4 + (b) * 2 + (h)) * HTB)
#define PG8_STAGE(bufoff, gbase, voff) do { _Pragma("unroll") for (int _i = 0; _i < 2; ++_i) \
        __builtin_amdgcn_global_load_lds((const unsigned*)((const char*)(gbase) + (voff)[_i]), (PG8_LAS unsigned*)(lds + (bufoff) + ldsw + _i * 8192), 16, 0, 0); } while (0)
#define PG8_LDA(dst, b, h) do { _Pragma("unroll") for (int m = 0; m < 4; ++m) _Pragma("unroll") for (int k = 0; k < 2; ++k) dst[m][k] = *(const PG8_LAS bf16x8*)(lds + PG8_SA(b, h) + aoff + m * 2048 + k * 1024); } while (0)
#define PG8_LDB(dst, b, h) do { _Pragma("unroll") for (int n = 0; n < 2; ++n) _Pragma("unroll") for (int k = 0; k < 2; ++k) dst[n][k] = *(const PG8_LAS bf16x8*)(lds + PG8_SB(b, h) + boff + n * 2048 + k * 1024); } while (0)
#define PG8_MMA(ai, bj, At, Bt) do { __builtin_amdgcn_s_setprio(1); _Pragma("unroll") for (int m = 0; m < 4; ++m) _Pragma("unroll") for (int n = 0; n < 2; ++n) _Pragma("unroll") for (int k = 0; k < 2; ++k) \
        acc[ai][bj][m][n] = __builtin_amdgcn_mfma_f32_16x16x32_bf16(Bt[n][k], At[m][k], acc[ai][bj][m][n], 0, 0, 0); __builtin_amdgcn_s_setprio(0); } while (0)
#define PG8_WAIT_V(n) asm volatile("s_waitcnt vmcnt(" #n ")" ::: "memory")
#define PG8_WAIT_L(n) asm volatile("s_waitcnt lgkmcnt(" #n ")" ::: "memory")
#define PG8_BAR __builtin_amdgcn_s_barrier()
#define PG8_SCHED __builtin_amdgcn_sched_barrier(0)
    Unit cur, nxt; int ui = 0;
    if (!S.next(0, cur)) return;
    f32x4 acc[2][2][4][2];
#pragma unroll
    for (int a = 0; a < 2; ++a)
#pragma unroll
        for (int b = 0; b < 2; ++b)
#pragma unroll
            for (int m = 0; m < 4; ++m)
#pragma unroll
                for (int n = 0; n < 2; ++n) acc[a][b][m][n] = (f32x4){0.f, 0.f, 0.f, 0.f};
    bf16x8 At[4][2], B0[2][2], B1[2][2];
    const char* cA = (const char*)g.A + (size_t)cur.pm * tstep; const char* cB = (const char*)g.Bt + (size_t)cur.pn * tstep;
    S.a_ready(cur);
    if constexpr (SP2) {
        PG8_STAGE(PG8_SB(0, 0), cB, voffB); PG8_STAGE(PG8_SB(0, 1), cB + hstep, voffB); PG8_STAGE(PG8_SA(0, 0), cA, voffA); PG8_STAGE(PG8_SA(0, 1), cA + hstep, voffA);
        if (wr == 1) PG8_BAR;
        PG8_WAIT_V(2); PG8_BAR;
        PG8_STAGE(PG8_SB(1, 0), cB + kstep, voffB); PG8_STAGE(PG8_SA(1, 0), cA + kstep, voffA); PG8_STAGE(PG8_SB(1, 1), cB + hstep + kstep, voffB);
        PG8_WAIT_V(6); PG8_BAR;
    } else {
        PG8_STAGE(PG8_SB(0, 0), cB, voffB); PG8_STAGE(PG8_SA(0, 0), cA, voffA); PG8_STAGE(PG8_SB(0, 1), cB + hstep, voffB); PG8_STAGE(PG8_SA(0, 1), cA + hstep, voffA);
        if (wr == 1) PG8_BAR;
        PG8_WAIT_V(4); PG8_BAR;
        PG8_STAGE(PG8_SB(1, 0), cB + kstep, voffB); PG8_STAGE(PG8_SA(1, 0), cA + kstep, voffA); PG8_STAGE(PG8_SB(1, 1), cB + hstep + kstep, voffB);
        PG8_WAIT_V(6); PG8_BAR;
    }
    for (;;) {
        const bool has_next = S.next(ui + 1, nxt);
        const char* nA = has_next ? (const char*)g.A + (size_t)nxt.pm * tstep : cA; const char* nB = has_next ? (const char*)g.Bt + (size_t)nxt.pn * tstep : cB;
        for (int t = 0; t < nt; t += 2) {
            const bool last = (t == nt - 2);
            const char* a1 = cA + (size_t)(t + 1) * kstep;
            const char* a2 = last ? nA : cA + (size_t)(t + 2) * kstep; const char* b2 = last ? nB : cB + (size_t)(t + 2) * kstep;
            const char* a3 = a2 + kstep; const char* b3 = b2 + kstep;
            if (last && has_next) S.a_ready(nxt);
            if constexpr (SP2) {
            PG8_LDB(B0, 0, 0); PG8_LDB(B1, 0, 1); PG8_SCHED; PG8_LDA(At, 0, 0); PG8_STAGE(PG8_SA(1, 1), a1 + hstep, voffA);
            PG8_WAIT_V(8); PG8_WAIT_L(0); PG8_BAR; PG8_MMA(0, 0, At, B0); PG8_MMA(0, 1, At, B1); PG8_BAR; PG8_SCHED;
            PG8_LDA(At, 0, 1); PG8_STAGE(PG8_SB(0, 0), b2, voffB); PG8_STAGE(PG8_SB(0, 1), b2 + hstep, voffB); PG8_STAGE(PG8_SA(0, 0), a2, voffA);
            PG8_WAIT_V(8); PG8_WAIT_L(0); PG8_BAR; PG8_MMA(1, 0, At, B0); PG8_MMA(1, 1, At, B1); PG8_BAR; PG8_SCHED;
            PG8_LDB(B0, 1, 0); PG8_LDB(B1, 1, 1); PG8_SCHED; PG8_LDA(At, 1, 0); PG8_STAGE(PG8_SA(0, 1), a2 + hstep, voffA);
            PG8_WAIT_V(8); PG8_WAIT_L(0); PG8_BAR; PG8_MMA(0, 0, At, B0); PG8_MMA(0, 1, At, B1); PG8_BAR; PG8_SCHED;
            PG8_LDA(At, 1, 1); PG8_STAGE(PG8_SB(1, 0), b3, voffB); PG8_STAGE(PG8_SB(1, 1), b3 + hstep, voffB); PG8_STAGE(PG8_SA(1, 0), a3, voffA);
            PG8_WAIT_V(8); PG8_WAIT_L(0); PG8_BAR; PG8_MMA(1, 0, At, B0); PG8_MMA(1, 1, At, B1); PG8_BAR; PG8_SCHED;
            } else {
            PG8_LDB(B0, 0, 0); PG8_SCHED; PG8_LDA(At, 0, 0); PG8_STAGE(PG8_SA(1, 1), a1 + hstep, voffA);
            PG8_WAIT_L(8); PG8_BAR; PG8_WAIT_L(0); PG8_MMA(0, 0, At, B0); PG8_BAR; PG8_SCHED;
            PG8_LDB(B1, 0, 1); PG8_STAGE(PG8_SB(0, 0), b2, voffB);
            PG8_BAR; PG8_WAIT_L(0); PG8_MMA(0, 1, At, B1); PG8_BAR;
            PG8_LDA(At, 0, 1); PG8_STAGE(PG8_SA(0, 0), a2, voffA);
            PG8_BAR; PG8_WAIT_L(0); PG8_MMA(1, 0, At, B0); PG8_BAR; PG8_SCHED;
            PG8_STAGE(PG8_SB(0, 1), b2 + hstep, voffB);
            PG8_WAIT_V(6); PG8_BAR; PG8_MMA(1, 1, At, B1); PG8_BAR;
            PG8_LDB(B0, 1, 0); PG8_SCHED; PG8_LDA(At, 1, 0); PG8_STAGE(PG8_SA(0, 1), a2 + hstep, voffA);
            PG8_WAIT_L(8); PG8_BAR; PG8_WAIT_L(0); PG8_MMA(0, 0, At, B0); PG8_BAR; PG8_SCHED;
            PG8_LDB(B1, 1, 1); PG8_STAGE(PG8_SB(1, 0), b3, voffB);
            PG8_BAR; PG8_WAIT_L(0); PG8_MMA(0, 1, At, B1); PG8_BAR;
            PG8_LDA(At, 1, 1); PG8_STAGE(PG8_SA(1, 0), a3, voffA);
            PG8_BAR; PG8_WAIT_L(0); PG8_MMA(1, 0, At, B0); PG8_BAR; PG8_SCHED;
            PG8_STAGE(PG8_SB(1, 1), b3 + hstep, voffB);
            PG8_WAIT_V(6); PG8_BAR; PG8_MMA(1, 1, At, B1); PG8_BAR;
            }
        }
        if constexpr (ALIGN_EPI) { if (wr == 0) PG8_BAR; }
        if constexpr (!Epi::AFTER_DRAIN) { E(acc, cur, wr, wc, fr, fq); S.done(cur); }
        if (!has_next) break;
#pragma unroll
        for (int a = 0; a < 2; ++a)
#pragma unroll
            for (int b = 0; b < 2; ++b)
#pragma unroll
                for (int m = 0; m < 4; ++m)
#pragma unroll
                    for (int n = 0; n < 2; ++n) acc[a][b][m][n] = (f32x4){0.f, 0.f, 0.f, 0.f};
        cur = nxt; cA = nA; cB = nB; ++ui;
        if constexpr (ALIGN_EPI) { if (wr == 1) PG8_BAR; }
    }
    PG8_WAIT_V(0);
    if constexpr (!ALIGN_EPI) { if (wr == 0) PG8_BAR; }
    PG8_BAR;
    if constexpr (Epi::AFTER_DRAIN) { E.fused(acc, cur, wr, wc, fr, fq, lds, wid, lane); S.done(cur); }
#undef PG8_SA
#undef PG8_SB
#undef PG8_STAGE
#undef PG8_LDA
#undef PG8_LDB
#undef PG8_MMA
#undef PG8_WAIT_V
#undef PG8_WAIT_L
#undef PG8_BAR
#undef PG8_SCHED
}
}

#define LAS __attribute__((address_space(3)))
typedef unsigned short bf16_t;
typedef short bf16x8 __attribute__((ext_vector_type(8)));
typedef float f32x4 __attribute__((ext_vector_type(4)));
typedef float f32x2 __attribute__((ext_vector_type(2)));
typedef float f32x16 __attribute__((ext_vector_type(16)));
typedef unsigned u32x4 __attribute__((ext_vector_type(4)));
typedef unsigned u32x2 __attribute__((ext_vector_type(2)));
#define MFMA32(a, b, c) __builtin_amdgcn_mfma_f32_32x32x16_bf16((a), (b), (c), 0, 0, 0)

constexpr int DM = 1024, SEQ = 16384, NBP = 2, DEPTH = 4, DB = 16, DS = 32, PAST = 2048;
constexpr int MP = NBP * SEQ, MS = DB * DS, MT = MP + MS;
constexpr int INW = 3584, DFF = 2816, NMOD = 6144, NBI = 18;
constexpr float EPS = 1e-6f;
constexpr size_t OFF_YP = 0, OFF_YS = 33554432, OFF_KP = 34078720, OFF_VP = 101187584, OFF_RP = 168296448,
                 OFF_KS = 168820736, OFF_VS = 169869312, OFF_RS = 170917888;
constexpr size_t MiB = 1u << 20;
constexpr size_t WS_MOD = 0, MOD_BYTES = 2 * MiB; constexpr size_t WS_BAR = 1802240;
constexpr size_t WS_ROPE = 2 * MiB;
constexpr size_t WS_WIN = 10 * MiB, WS_WOUT = 38 * MiB, WS_WFI = 46 * MiB, WS_WFO = 90 * MiB;
constexpr size_t WS_X = 112 * MiB;
constexpr size_t WS_H = 242 * MiB;
constexpr size_t WS_O = 307 * MiB;
constexpr size_t WS_QKV = 372 * MiB;
constexpr size_t WS_U = 600 * MiB;
constexpr size_t WS_END = 616 * MiB;
constexpr int LDS_BYTES = 147456;

struct Params { const float* in[18]; float* out; unsigned char* ws; };

__device__ __forceinline__ unsigned f2bf(float f) { unsigned u = __builtin_bit_cast(unsigned, f); return (u + 0x7fffu + ((u >> 16) & 1u)) >> 16; }
__device__ __forceinline__ unsigned pk2(float lo, float hi) { return f2bf(lo) | (f2bf(hi) << 16); }
__device__ __forceinline__ float bf2f(unsigned h) { return __builtin_bit_cast(float, h << 16); }
__device__ __forceinline__ bf16x8 pack8(f32x4 a, f32x4 b) { u32x4 p; p.x = pk2(a.x, a.y); p.y = pk2(a.z, a.w); p.z = pk2(b.x, b.y); p.w = pk2(b.z, b.w); return __builtin_bit_cast(bf16x8, p); }
__device__ __forceinline__ float wave_sum(float v) {
#pragma unroll
    for (int o = 1; o < 64; o <<= 1) v += __shfl_xor(v, o);
    return v;
}
__device__ __forceinline__ float silu_f(float x) { return x * __builtin_amdgcn_rcpf(1.f + __expf(-x)); }
__device__ __forceinline__ int batch_of(int row) { return row < MP ? (row >> 14) : 2 + ((row - MP) >> 5); }

struct EpiQKV {
    static constexpr bool PERM = true, AFTER_DRAIN = false;
    bf16_t* QKV; float* out; int layer;
    __device__ __forceinline__ void operator()(const pg8::f32x4 (&acc)[2][2][4][2], const pg8::Unit& u, int wr, int wc, int fr, int fq) const {
        const int row0 = u.pm * 256 + wr * 64 + fr, col0 = u.pn * 256 + wc * 32 + 8 * fq;
        const bool kv = (u.pn >= 2 && u.pn < 6);
        const size_t vsel = (u.pn >= 4) ? 1 : 0;
        const size_t obase = (u.pm < 128) ? OFF_KP + vsel * (OFF_VP - OFF_KP) + (size_t)layer * MP * 512 + (size_t)row0 * 512
                                          : OFF_KS + vsel * (OFF_VS - OFF_KS) + (size_t)layer * MS * 512 + (size_t)(row0 - MP) * 512;
#pragma unroll
        for (int ai = 0; ai < 2; ++ai)
#pragma unroll
            for (int m = 0; m < 4; ++m) {
                const int row = row0 + ai * 128 + m * 16;
#pragma unroll
                for (int bj = 0; bj < 2; ++bj) {
                    const int col = col0 + bj * 128;
                    const pg8::f32x4 v0 = acc[ai][bj][m][0], v1 = acc[ai][bj][m][1];
                    u32x4 w; w.x = pg8::cvt_pk_bf16(v0[0], v0[1]); w.y = pg8::cvt_pk_bf16(v0[2], v0[3]); w.z = pg8::cvt_pk_bf16(v1[0], v1[1]); w.w = pg8::cvt_pk_bf16(v1[2], v1[3]);
                    *(u32x4*)(QKV + (size_t)row * INW + col) = w;
                    if (kv) {
                        const int c = col & 511;
                        float* dst = out + obase + (size_t)(ai * 128 + m * 16) * 512 + c;
                        *(pg8::f32x4*)dst = v0; *(pg8::f32x4*)(dst + 4) = v1;
                    }
                }
                asm volatile("" ::: "memory");
            }
    }
};
struct EpiResid {
    static constexpr bool PERM = false, AFTER_DRAIN = false;
    const float* base_p; const float* base_s;
    float* X; const float* gate;
    __device__ __forceinline__ void operator()(const pg8::f32x4 (&acc)[2][2][4][2], const pg8::Unit& u, int wr, int wc, int fr, int fq) const {
        const int col0 = u.pn * 256 + wc * 32 + 4 * fq;
        const bool uni = u.pm < 128;
        pg8::f32x4 gv[4];
        { const float* gr = gate + (size_t)batch_of(u.pm * 256 + wr * 64 + fr) * NMOD;
#pragma unroll
          for (int q = 0; q < 4; ++q) gv[q] = *(const pg8::f32x4*)(gr + col0 + (q >> 1) * 128 + (q & 1) * 16); }
#pragma unroll
        for (int grp = 0; grp < 4; ++grp) {
            const int ai = grp >> 1, m0 = (grp & 1) * 2;
            pg8::f32x4 bv[2][4];
#pragma unroll
            for (int mm = 0; mm < 2; ++mm) {
                const int row = u.pm * 256 + ai * 128 + wr * 64 + (m0 + mm) * 16 + fr;
                const float* br = base_p ? (row < MP ? base_p + (size_t)row * DM : base_s + (size_t)(row - MP) * DM) : X + (size_t)row * DM;
#pragma unroll
                for (int q = 0; q < 4; ++q) bv[mm][q] = *(const pg8::f32x4*)(br + col0 + (q >> 1) * 128 + (q & 1) * 16);
            }
#pragma unroll
            for (int mm = 0; mm < 2; ++mm) {
                const int m = m0 + mm, row = u.pm * 256 + ai * 128 + wr * 64 + m * 16 + fr;
                if (!uni) { const float* gr = gate + (size_t)batch_of(row) * NMOD;
#pragma unroll
                    for (int q = 0; q < 4; ++q) gv[q] = *(const pg8::f32x4*)(gr + col0 + (q >> 1) * 128 + (q & 1) * 16); }
                float* xr = X + (size_t)row * DM;
#pragma unroll
                for (int q = 0; q < 4; ++q) { const int bj = q >> 1, n = q & 1;
                    *(pg8::f32x4*)(xr + col0 + bj * 128 + n * 16) = bv[mm][q] + gv[q] * acc[ai][bj][m][n]; }
            }
            asm volatile("" ::: "memory");
        }
    }
};
struct EpiSwiGLU {
    static constexpr bool PERM = true, AFTER_DRAIN = false;
    bf16_t* ACT;
    __device__ __forceinline__ void operator()(const pg8::f32x4 (&acc)[2][2][4][2], const pg8::Unit& u, int wr, int wc, int fr, int fq) const {
        const int col0 = u.pn * 128 + wc * 32 + 8 * fq;
#pragma unroll
        for (int ai = 0; ai < 2; ++ai)
#pragma unroll
            for (int m = 0; m < 4; ++m) {
                const int row = u.pm * 256 + ai * 128 + wr * 64 + m * 16 + fr;
                const pg8::f32x4 g0 = acc[ai][0][m][0], g1 = acc[ai][0][m][1], u0 = acc[ai][1][m][0], u1 = acc[ai][1][m][1];
                float r[8];
#pragma unroll
                for (int j = 0; j < 4; ++j) { r[j] = silu_f(g0[j]) * u0[j]; r[4 + j] = silu_f(g1[j]) * u1[j]; }
                u32x4 w; w.x = pg8::cvt_pk_bf16(r[0], r[1]); w.y = pg8::cvt_pk_bf16(r[2], r[3]); w.z = pg8::cvt_pk_bf16(r[4], r[5]); w.w = pg8::cvt_pk_bf16(r[6], r[7]);
                *(u32x4*)(ACT + (size_t)row * DFF + col0) = w;
                asm volatile("" ::: "memory");
            }
    }
};


template <int NKS  , int UNR, class Epi>
__device__ __forceinline__ void sgemm_phase(LAS unsigned char* lds, const bf16_t* A  , int lda, const bf16_t* Bt, int K, int ncb,
                                            int tid, int lane, int wave, const Epi& E) {
    const int l32 = lane & 31, hf = lane >> 5;
    LAS float* red = (LAS float*)lds;
    const int kw0 = wave * NKS * 16 + hf * 8;
    for (int it = blockIdx.x; it < 16 * ncb; it += gridDim.x) {
        const int rb = it & 15, cb = it >> 4;
        int n0, n1; E.cols(cb, n0, n1);
        const bf16_t* ap = A + (size_t)(rb * 32 + l32) * lda + kw0;
        const bf16_t* b0p = Bt + (size_t)(n0 + l32) * K + kw0;
        const bf16_t* b1p = Bt + (size_t)(n1 + l32) * K + kw0;
        f32x16 c0, c1;
#pragma unroll
        for (int r = 0; r < 16; ++r) { c0[r] = 0.f; c1[r] = 0.f; }
#pragma unroll 1
        for (int kb = 0; kb < NKS; kb += UNR) {
            bf16x8 a[UNR], b0[UNR], b1[UNR];
#pragma unroll
            for (int j = 0; j < UNR; ++j) { a[j] = *(const bf16x8*)(ap + (kb + j) * 16); b0[j] = *(const bf16x8*)(b0p + (kb + j) * 16); b1[j] = *(const bf16x8*)(b1p + (kb + j) * 16); }
#pragma unroll
            for (int j = 0; j < UNR; ++j) { c0 = MFMA32(a[j], b0[j], c0); c1 = MFMA32(a[j], b1[j], c1); }
        }
        LAS float* rw = red + wave * 2176;
#pragma unroll
        for (int r = 0; r < 16; ++r) { const int row = (r >> 2) * 8 + hf * 4 + (r & 3); rw[row * 34 + l32] = c0[r]; rw[1088 + row * 34 + l32] = c1[r]; }
        __syncthreads();
        {
            const int row = tid >> 4, cc = (tid & 15) * 2;
            f32x2 g = {0.f, 0.f}, u = {0.f, 0.f};
#pragma unroll
            for (int w = 0; w < 8; ++w) { g += *(const LAS f32x2*)(red + w * 2176 + row * 34 + cc); u += *(const LAS f32x2*)(red + w * 2176 + 1088 + row * 34 + cc); }
            E(rb * 32 + row, n0 + cc, n1 + cc, g, u);
        }
        __syncthreads();
    }
}
struct SEpiQKV {
    bf16_t* QKV; float* out; int layer;
    __device__ __forceinline__ void cols(int cb, int& n0, int& n1) const { n0 = cb * 64; n1 = n0 + 32; }
    __device__ __forceinline__ void emit(int r, int c, f32x2 v) const {
        *(unsigned*)(QKV + (size_t)(MP + r) * INW + c) = pk2(v.x, v.y);
        if (c >= 512 && c < 1536) { const size_t off = (c < 1024 ? OFF_KS : OFF_VS) + ((size_t)layer * MS + r) * 512 + (c & 511); *(f32x2*)(out + off) = v; }
    }
    __device__ __forceinline__ void operator()(int r, int c0, int c1, f32x2 g, f32x2 u) const { emit(r, c0, g); emit(r, c1, u); }
};
struct SEpiResid {
    const float* base; float* Xs; const float* gate;
    __device__ __forceinline__ void cols(int cb, int& n0, int& n1) const { n0 = cb * 64; n1 = n0 + 32; }
    __device__ __forceinline__ void operator()(int r, int c0, int c1, f32x2 g, f32x2 u) const {
        const float* gp = gate + (size_t)(2 + (r >> 5)) * NMOD; const float* bp = base + (size_t)r * DM; float* xp = Xs + (size_t)r * DM;
        const f32x2 x0 = *(const f32x2*)(bp + c0) + *(const f32x2*)(gp + c0) * g, x1 = *(const f32x2*)(bp + c1) + *(const f32x2*)(gp + c1) * u;
        *(f32x2*)(xp + c0) = x0; *(f32x2*)(xp + c1) = x1;
    }
};
struct SEpiSwiGLU {
    bf16_t* ACT;
    __device__ __forceinline__ void cols(int cb, int& n0, int& n1) const { n0 = (cb >> 2) * 256 + (cb & 3) * 32; n1 = n0 + 128; }
    __device__ __forceinline__ void operator()(int r, int c0, int c1, f32x2 g, f32x2 u) const {
        const int col = (c0 >> 8) * 128 + (c0 & 127);
        *(unsigned*)(ACT + (size_t)(MP + r) * DFF + col) = pk2(silu_f(g.x) * u.x, silu_f(g.y) * u.y);
    }
};

__device__ __forceinline__ void transpose_item(const float* W, int K, int N, bf16_t* WT, LAS float* scr, int item, int lane, bool perm) {
    const int nblk = N / 32, kb = item / nblk, nb = item % nblk, k0 = 64 * kb, n0 = 32 * nb;
    int p0 = n0;
    if (perm) { if (n0 < DFF) p0 = (n0 >> 7) * 256 + (n0 & 127); else { const int n1 = n0 - DFF; p0 = (n1 >> 7) * 256 + 128 + (n1 & 127); } }
#pragma unroll 8
    for (int i = 0; i < 32; ++i) { const int kk = 2 * i + (lane >> 5); scr[kk * 33 + (lane & 31)] = W[(size_t)(k0 + kk) * N + n0 + (lane & 31)]; }
    asm volatile("s_waitcnt lgkmcnt(0)" ::: "memory"); __builtin_amdgcn_wave_barrier();
    const int c = lane & 7;
#pragma unroll
    for (int j = 0; j < 4; ++j) { const int n = (lane >> 3) + 8 * j; const LAS float* s = scr + (8 * c) * 33 + n;
        u32x4 o; o.x = pk2(s[0 * 33], s[1 * 33]); o.y = pk2(s[2 * 33], s[3 * 33]); o.z = pk2(s[4 * 33], s[5 * 33]); o.w = pk2(s[6 * 33], s[7 * 33]);
        *(u32x4*)(WT + (size_t)(p0 + n) * K + k0 + 8 * c) = o; }
    asm volatile("s_waitcnt lgkmcnt(0)" ::: "memory"); __builtin_amdgcn_wave_barrier();
}

__device__ __forceinline__ void p0_phase(const Params& P, LAS unsigned char* lds, int tid, int lane, int wave) {
    LAS float* sc = (LAS float*)lds;
    for (int i = tid; i < NBI * DM; i += 512) { const int b = i >> 10, k = i & 1023; const float c = b < 2 ? P.in[5][b * DM + k] : P.in[6][(b - 2) * DM + k]; sc[i] = silu_f(c); }
    __syncthreads();
    const int gw = blockIdx.x * 8 + wave, NGW = gridDim.x * 8;
    float* MOD = (float*)(P.ws + WS_MOD);
    for (int it = gw; it < 768; it += NGW) {
        const int l = it / 192, r = it % 192, cb = r >> 3, kc = r & 7;
        f32x4 acc[NBI];
#pragma unroll
        for (int b = 0; b < NBI; ++b) acc[b] = (f32x4){0.f, 0.f, 0.f, 0.f};
        const float* wp = P.in[9] + ((size_t)l * DM + kc * 128) * NMOD + cb * 256 + lane * 4;
        const LAS float* scp = sc + kc * 128;
#pragma unroll 4
        for (int k = 0; k < 128; ++k) { const f32x4 w = *(const f32x4*)(wp + (size_t)k * NMOD);
#pragma unroll
            for (int b = 0; b < NBI; ++b) acc[b] += scp[b * DM + k] * w; }
        if (kc == 0) { const f32x4 bv = *(const f32x4*)(P.in[10] + (size_t)l * NMOD + cb * 256 + lane * 4);
#pragma unroll
            for (int b = 0; b < NBI; ++b) acc[b] += bv; }
        float* mp = MOD + (size_t)l * NBI * NMOD + cb * 256 + lane * 4;
#pragma unroll
        for (int b = 0; b < NBI; ++b) { atomicAdd(mp + b * NMOD + 0, acc[b].x); atomicAdd(mp + b * NMOD + 1, acc[b].y); atomicAdd(mp + b * NMOD + 2, acc[b].z); atomicAdd(mp + b * NMOD + 3, acc[b].w); }
    }
    LAS float* scr = (LAS float*)(lds + 73728 + wave * 8448);
    constexpr int I_IN = 16 * 112, I_OUT = 16 * 32, I_FI = 16 * 176, I_FO = 44 * 32, I_L = I_IN + I_OUT + I_FI + I_FO;
    for (int it = gw; it < DEPTH * I_L; it += NGW) {
        const int l = it / I_L; int r = it % I_L;
        if (r < I_IN) { transpose_item(P.in[11] + (size_t)l * DM * INW, DM, INW, (bf16_t*)(P.ws + WS_WIN) + (size_t)l * INW * DM, scr, r, lane, false); continue; } r -= I_IN;
        if (r < I_OUT) { transpose_item(P.in[14] + (size_t)l * DM * DM, DM, DM, (bf16_t*)(P.ws + WS_WOUT) + (size_t)l * DM * DM, scr, r, lane, false); continue; } r -= I_OUT;
        if (r < I_FI) { transpose_item(P.in[15] + (size_t)l * DM * 2 * DFF, DM, 2 * DFF, (bf16_t*)(P.ws + WS_WFI) + (size_t)l * 2 * DFF * DM, scr, r, lane, true); continue; } r -= I_FI;
        transpose_item(P.in[16] + (size_t)l * DFF * DM, DFF, DM, (bf16_t*)(P.ws + WS_WFO) + (size_t)l * DM * DFF, scr, r, lane, false);
    }
    f32x2* ROPE = (f32x2*)(P.ws + WS_ROPE);
    for (int idx = blockIdx.x * 512 + tid; idx < SEQ * 64; idx += gridDim.x * 512) {
        const int pos = idx >> 6, i = idx & 63;
        const float inv = exp2f(-(float)i * (13.287712379549449f / 64.f));
        const float ang = (float)pos * inv;
        double rev = (double)ang * 0.15915494309189535; rev -= floor(rev);
        const float rf = (float)rev;
        ROPE[idx] = (f32x2){__builtin_amdgcn_cosf(rf), __builtin_amdgcn_sinf(rf)};
    }
}

template <bool FINAL>
__device__ __forceinline__ void norm_phase(const Params& P, int l, bool from_input, const float* gain, int sh_off, int sc_off, int lane, int wave) {
    const int gw = blockIdx.x * 8 + wave, NGW = gridDim.x * 8;
    const float* MOD = (const float*)(P.ws + WS_MOD) + (size_t)l * NBI * NMOD;
    const float* X = (const float*)(P.ws + WS_X); bf16_t* H = (bf16_t*)(P.ws + WS_H);
    f32x4 g[4];
#pragma unroll
    for (int j = 0; j < 4; ++j) g[j] = *(const f32x4*)(gain + 4 * lane + 256 * j);
    for (int m = gw; m < MT; m += NGW) {
        const float* xr = (!FINAL && from_input) ? (m < MP ? P.in[0] + (size_t)m * DM : P.in[1] + (size_t)(m - MP) * DM) : X + (size_t)m * DM;
        f32x4 v[4]; float ss = 0.f;
#pragma unroll
        for (int j = 0; j < 4; ++j) { v[j] = *(const f32x4*)(xr + 4 * lane + 256 * j); ss += (v[j].x * v[j].x + v[j].y * v[j].y) + (v[j].z * v[j].z + v[j].w * v[j].w); }
        const float rstd = rsqrtf(wave_sum(ss) * (1.f / DM) + EPS);
        if (FINAL) {
            float* o = P.out + (size_t)m * DM;
#pragma unroll
            for (int j = 0; j < 4; ++j) *(f32x4*)(o + 4 * lane + 256 * j) = v[j] * rstd * g[j];
        } else {
            const float* mr = MOD + (size_t)batch_of(m) * NMOD;
#pragma unroll
            for (int j = 0; j < 4; ++j) { const int c = 4 * lane + 256 * j;
                const f32x4 sc = *(const f32x4*)(mr + sc_off + c), sh = *(const f32x4*)(mr + sh_off + c);
                const f32x4 hh = v[j] * rstd * g[j] * (1.f + sc) + sh;
                u32x2 w; w.x = pk2(hh.x, hh.y); w.y = pk2(hh.z, hh.w);
                *(u32x2*)(H + (size_t)m * DM + c) = w; }
        }
    }
}

__device__ __forceinline__ void sb_unit(const Params& P, int l, int u, LAS unsigned char* lds, int tid, int lane, int wave) {
    const bf16_t* QKV = (const bf16_t*)(P.ws + WS_QKV);
    const int h = wave, l32 = lane & 31, hf = lane >> 5;
    const bool samp = u >= 1024;
    int qrow0, nsteps; const float* ck = nullptr; const float* cv = nullptr;
    if (!samp) { const int b = u >> 9, qb = u & 511; qrow0 = b * SEQ + qb * 32; nsteps = qb + 1; }
    else { const int bs = u - 1024; qrow0 = MP + bs * 32; nsteps = 65; ck = P.in[2] + (size_t)(l * DB + bs) * PAST * 512; cv = P.in[3] + (size_t)(l * DB + bs) * PAST * 512; }
    bf16x8 qf[4];
#pragma unroll
    for (int ks = 0; ks < 4; ++ks) qf[ks] = *(const bf16x8*)(QKV + (size_t)(qrow0 + l32) * INW + h * 64 + ks * 16 + hf * 8);
    f32x16 O0, O1;
#pragma unroll
    for (int r = 0; r < 16; ++r) { O0[r] = 0.f; O1[r] = 0.f; }
    float cum = 0.f;
    LAS unsigned char* vt = lds + 66048 + wave * 4608;
    auto issue = [&](int s, bf16x8 (&k)[4], bf16x8 (&v)[4]) {
        if (!samp || s == 0) {
            const int krow0 = samp ? qrow0 : qrow0 - s * 32;
#pragma unroll
            for (int ks = 0; ks < 4; ++ks) k[ks] = *(const bf16x8*)(QKV + (size_t)(krow0 + l32) * INW + 512 + h * 64 + ks * 16 + hf * 8);
#pragma unroll
            for (int it = 0; it < 4; ++it) { const int id = it * 64 + lane, key = id >> 3, ch = id & 7;
                v[it] = *(const bf16x8*)(QKV + (size_t)(krow0 + key) * INW + 1024 + h * 64 + ch * 8); }
        } else {
            const int kpos0 = (64 - s) * 32;
#pragma unroll
            for (int ks = 0; ks < 4; ++ks) { const float* p = ck + (size_t)(kpos0 + l32) * 512 + h * 64 + ks * 16 + hf * 8; k[ks] = pack8(*(const f32x4*)p, *(const f32x4*)(p + 4)); }
#pragma unroll
            for (int it = 0; it < 4; ++it) { const int id = it * 64 + lane, key = id >> 3, ch = id & 7;
                const float* p = cv + (size_t)(kpos0 + key) * 512 + h * 64 + ch * 8;
                v[it] = pack8(*(const f32x4*)p, *(const f32x4*)(p + 4)); }
        }
    };
    bf16x8 kf[4], vr[4];
    issue(0, kf, vr);
    for (int s = 0; s < nsteps; ++s) {
#pragma unroll
        for (int it = 0; it < 4; ++it) { const int id = it * 64 + lane, key = id >> 3, ch = id & 7; *(LAS bf16x8*)(vt + key * 144 + ch * 16) = vr[it]; }
        bf16x8 kn[4];
#pragma unroll
        for (int ks = 0; ks < 4; ++ks) kn[ks] = kf[ks];
        if (s + 1 < nsteps) issue(s + 1, kn, vr);
        asm volatile("s_waitcnt lgkmcnt(0)" ::: "memory"); __builtin_amdgcn_wave_barrier();
        f32x16 S;
#pragma unroll
        for (int r = 0; r < 16; ++r) S[r] = 0.f;
#pragma unroll
        for (int ks = 0; ks < 4; ++ks) S = MFMA32(kf[ks], qf[ks], S);
        float L[16], lb[16]; bool valid[16];
#pragma unroll
        for (int r = 0; r < 16; ++r) {
            const float z = S[r] * 0.125f;
            const float sp = fmaxf(z, 0.f) + __logf(1.f + __expf(-fabsf(z)));
            const int key = (r >> 2) * 8 + hf * 4 + (r & 3);
            valid[r] = (s != 0) || (key < l32);
            L[r] = valid[r] ? -sp : 0.f; lb[r] = z - sp;
        }
        float T[4], Pp[4];
#pragma unroll
        for (int g = 0; g < 4; ++g) { T[g] = (L[4 * g] + L[4 * g + 1]) + (L[4 * g + 2] + L[4 * g + 3]); Pp[g] = __shfl_xor(T[g], 32); }
        float later[4]; float tot = 0.f;
#pragma unroll
        for (int g = 3; g >= 0; --g) { later[g] = tot; tot += T[g] + Pp[g]; }
        float w[16];
#pragma unroll
        for (int g = 0; g < 4; ++g) {
            const float s3 = cum + later[g] + (hf == 0 ? Pp[g] : 0.f);
            const float s2 = s3 + L[4 * g + 3], s1 = s2 + L[4 * g + 2], s0 = s1 + L[4 * g + 1];
            w[4 * g + 3] = valid[4 * g + 3] ? __expf(lb[4 * g + 3] + s3) : 0.f;
            w[4 * g + 2] = valid[4 * g + 2] ? __expf(lb[4 * g + 2] + s2) : 0.f;
            w[4 * g + 1] = valid[4 * g + 1] ? __expf(lb[4 * g + 1] + s1) : 0.f;
            w[4 * g + 0] = valid[4 * g + 0] ? __expf(lb[4 * g + 0] + s0) : 0.f;
        }
        cum += tot;
#pragma unroll
        for (int c = 0; c < 2; ++c) {
            u32x4 pw; pw.x = pk2(w[8 * c], w[8 * c + 1]); pw.y = pk2(w[8 * c + 2], w[8 * c + 3]); pw.z = pk2(w[8 * c + 4], w[8 * c + 5]); pw.w = pk2(w[8 * c + 6], w[8 * c + 7]);
            const bf16x8 pa = __builtin_bit_cast(bf16x8, pw);
#pragma unroll
            for (int dt = 0; dt < 2; ++dt) {
                bf16x8 vb;
#pragma unroll
                for (int i = 0; i < 8; ++i) { const int key = 16 * c + 8 * (i >> 2) + 4 * hf + (i & 3); vb[i] = *(const LAS short*)(vt + key * 144 + (l32 + 32 * dt) * 2); }
                if (dt == 0) O0 = MFMA32(pa, vb, O0); else O1 = MFMA32(pa, vb, O1);
            }
        }
        asm volatile("" ::: "memory");
        if (__all(cum < -110.f)) break;
#pragma unroll
        for (int ks = 0; ks < 4; ++ks) kf[ks] = kn[ks];
    }
    LAS float* oa = (LAS float*)lds;
#pragma unroll
    for (int r = 0; r < 16; ++r) { const int q = (r >> 2) * 8 + hf * 4 + (r & 3); oa[q * 516 + h * 64 + l32] = O0[r]; oa[q * 516 + h * 64 + 32 + l32] = O1[r]; }
    __syncthreads();
    bf16_t* Ob = (bf16_t*)(P.ws + WS_O);
    const float* gsb = P.in[12] + (size_t)l * 512;
#pragma unroll
    for (int rr = 0; rr < 4; ++rr) {
        const int q = wave * 4 + rr;
        const f32x4 a = *(const LAS f32x4*)(oa + q * 516 + 4 * lane), b = *(const LAS f32x4*)(oa + q * 516 + 256 + 4 * lane);
        float ss = (a.x * a.x + a.y * a.y) + (a.z * a.z + a.w * a.w) + (b.x * b.x + b.y * b.y) + (b.z * b.z + b.w * b.w);
        const float rstd = rsqrtf(wave_sum(ss) * (1.f / 512.f) + EPS);
        const f32x4 ga = *(const f32x4*)(gsb + 4 * lane), gb = *(const f32x4*)(gsb + 256 + 4 * lane);
        const f32x4 ya = a * rstd * ga, yb = b * rstd * gb;
        u32x2 wa, wb; wa.x = pk2(ya.x, ya.y); wa.y = pk2(ya.z, ya.w); wb.x = pk2(yb.x, yb.y); wb.y = pk2(yb.z, yb.w);
        *(u32x2*)(Ob + (size_t)(qrow0 + q) * DM + 4 * lane) = wa; *(u32x2*)(Ob + (size_t)(qrow0 + q) * DM + 256 + 4 * lane) = wb;
    }
    __syncthreads();
}

__device__ __forceinline__ void ret_unit(const Params& P, int l, LAS unsigned char* lds, int tid, int lane, int wave,
                                         int row0, int pos0, int nchunks, int L, int h, const float* init, float* outst, bool state_only) {
    const bf16_t* QKV = (const bf16_t*)(P.ws + WS_QKV); bf16_t* Ob = (bf16_t*)(P.ws + WS_O);
    const f32x2* ROPE = (const f32x2*)(P.ws + WS_ROPE);
    const float lg2 = log2f(1.f - exp2f(-5.f - (float)h));
    LAS unsigned char *Qn = lds, *Kn = lds + 17408, *KdT = lds + 34816, *VT = lds + 53248, *SbT = lds + 71680, *Pm = lds + 106496;
    LAS float* of = (LAS float*)lds;
    const int l32 = lane & 31, hf = lane >> 5;
    const int sdt = wave >> 1, set0 = (wave & 1) * 2;
    f32x16 S0, S1;
#pragma unroll
    for (int r = 0; r < 16; ++r) { S0[r] = 0.f; S1[r] = 0.f; }
    if (init) {
        const float* ip = init + (sdt * 32 + hf * 4) * 128 + set0 * 32 + l32;
#pragma unroll
        for (int r = 0; r < 16; ++r) { S0[r] = ip[((r >> 2) * 8 + (r & 3)) * 128]; S1[r] = ip[((r >> 2) * 8 + (r & 3)) * 128 + 32]; if ((r & 3) == 3) asm volatile("" ::: "memory"); }
    }
    if (!state_only) {
#pragma unroll
        for (int g = 0; g < 4; ++g) { const int d0 = sdt * 32 + g * 8 + hf * 4;
            u32x2 a, b; a.x = pk2(S0[4 * g], S0[4 * g + 1]); a.y = pk2(S0[4 * g + 2], S0[4 * g + 3]); b.x = pk2(S1[4 * g], S1[4 * g + 1]); b.y = pk2(S1[4 * g + 2], S1[4 * g + 3]);
            *(LAS u32x2*)(SbT + (set0 * 32 + l32) * 272 + d0 * 2) = a; *(LAS u32x2*)(SbT + ((set0 + 1) * 32 + l32) * 272 + d0 * 2) = b; }
    }
    const float gL = exp2f((float)L * lg2);
    const int lt = wave >> 2, et = wave & 3;
    bf16x8 rk1, rk2, rq1, rq2, rv0, rv1; f32x4 rcs[4];
    const bf16x8 z8 = {0, 0, 0, 0, 0, 0, 0, 0};
    auto issue = [&](int c) {
        const int t = tid >> 3, i0 = (tid & 7) * 8; const bool ok = t < L;
        const size_t row = (size_t)(row0 + c * 64 + t);
        rk1 = z8; rk2 = z8; rq1 = z8; rq2 = z8;
#pragma unroll
        for (int i = 0; i < 4; ++i) rcs[i] = (f32x4){0.f, 0.f, 0.f, 0.f};
        if (ok) {
            rk1 = *(const bf16x8*)(QKV + row * INW + 2048 + h * 128 + i0); rk2 = *(const bf16x8*)(QKV + row * INW + 2048 + h * 128 + 64 + i0);
            if (!state_only) { rq1 = *(const bf16x8*)(QKV + row * INW + 1536 + h * 128 + i0); rq2 = *(const bf16x8*)(QKV + row * INW + 1536 + h * 128 + 64 + i0); }
            const f32x4* rp = (const f32x4*)(ROPE + (size_t)(pos0 + c * 64 + t) * 64 + i0);
#pragma unroll
            for (int i = 0; i < 4; ++i) rcs[i] = rp[i];
        }
        const int t0 = tid >> 4, ch = tid & 15;
        rv0 = z8; rv1 = z8;
        if (t0 < L) rv0 = *(const bf16x8*)(QKV + (size_t)(row0 + c * 64 + t0) * INW + 2560 + h * 128 + ch * 8);
        if (t0 + 32 < L) rv1 = *(const bf16x8*)(QKV + (size_t)(row0 + c * 64 + t0 + 32) * INW + 2560 + h * 128 + ch * 8);
    };
    issue(0);
    const int l32_0 = l32, hf_0 = hf, tid_0 = tid; const float lg2_0 = lg2;
#pragma unroll 1
    for (int c = 0; c < nchunks; ++c) {
        int l32 = l32_0, hf = hf_0, tid = tid_0; float lg2 = lg2_0;
        asm volatile("" : "+v"(l32), "+v"(hf), "+v"(tid), "+v"(lg2));
        {
            const int t = tid >> 3, pc = tid & 7, i0 = pc * 8; const bool ok = t < L;
            const float kd = ok ? __builtin_amdgcn_exp2f((float)(L - 1 - t) * lg2) : 0.f;
            const int tsw = (((t >> 3) ^ pc) << 4) + (t & 7) * 2;
            float cs_c[8], cs_s[8];
#pragma unroll
            for (int i = 0; i < 4; ++i) { cs_c[2 * i] = rcs[i].x; cs_s[2 * i] = rcs[i].y; cs_c[2 * i + 1] = rcs[i].z; cs_s[2 * i + 1] = rcs[i].w; }
            {
                float o1[8], o2[8];
#pragma unroll
                for (int i = 0; i < 8; ++i) { const float x1 = bf2f((unsigned short)rk1[i]), x2 = bf2f((unsigned short)rk2[i]);
                    o1[i] = (x1 * cs_c[i] - x2 * cs_s[i]) * 0.08838834764831845f; o2[i] = (x1 * cs_s[i] + x2 * cs_c[i]) * 0.08838834764831845f; }
                if (!state_only) {
                    u32x4 a, b; a.x = pk2(o1[0], o1[1]); a.y = pk2(o1[2], o1[3]); a.z = pk2(o1[4], o1[5]); a.w = pk2(o1[6], o1[7]);
                    b.x = pk2(o2[0], o2[1]); b.y = pk2(o2[2], o2[3]); b.z = pk2(o2[4], o2[5]); b.w = pk2(o2[6], o2[7]);
                    *(LAS u32x4*)(Kn + t * 272 + i0 * 2) = a; *(LAS u32x4*)(Kn + t * 272 + (64 + i0) * 2) = b;
                }
#pragma unroll
                for (int i = 0; i < 8; ++i) { *(LAS unsigned short*)(KdT + (i0 + i) * 144 + tsw) = (unsigned short)f2bf(o1[i] * kd); *(LAS unsigned short*)(KdT + (64 + i0 + i) * 144 + tsw) = (unsigned short)f2bf(o2[i] * kd); }
            }
            if (!state_only) {
                float o1[8], o2[8];
#pragma unroll
                for (int i = 0; i < 8; ++i) { const float x1 = bf2f((unsigned short)rq1[i]), x2 = bf2f((unsigned short)rq2[i]);
                    o1[i] = x1 * cs_c[i] - x2 * cs_s[i]; o2[i] = x1 * cs_s[i] + x2 * cs_c[i]; }
                u32x4 a, b; a.x = pk2(o1[0], o1[1]); a.y = pk2(o1[2], o1[3]); a.z = pk2(o1[4], o1[5]); a.w = pk2(o1[6], o1[7]);
                b.x = pk2(o2[0], o2[1]); b.y = pk2(o2[2], o2[3]); b.z = pk2(o2[4], o2[5]); b.w = pk2(o2[6], o2[7]);
                *(LAS u32x4*)(Qn + t * 272 + i0 * 2) = a; *(LAS u32x4*)(Qn + t * 272 + (64 + i0) * 2) = b;
            }
            {
                const int t0 = tid >> 4, ch = tid & 15, sw = ch & 7;
                const int o0 = (((t0 >> 3) ^ sw) << 4) + (t0 & 7) * 2, o1b = ((((t0 + 32) >> 3) ^ sw) << 4) + (t0 & 7) * 2;
#pragma unroll
                for (int i = 0; i < 8; ++i) { *(LAS short*)(VT + (ch * 8 + i) * 144 + o0) = rv0[i]; *(LAS short*)(VT + (ch * 8 + i) * 144 + o1b) = rv1[i]; }
            }
        }
        if (c + 1 < nchunks) issue(c + 1);
        __syncthreads();
        f32x16 acc;
        if (!state_only) {
#pragma unroll
            for (int r = 0; r < 16; ++r) acc[r] = 0.f;
#pragma unroll
            for (int ks = 0; ks < 8; ++ks) { const bf16x8 a = *(const LAS bf16x8*)(Qn + (lt * 32 + l32) * 272 + (ks * 16 + hf * 8) * 2), b = *(const LAS bf16x8*)(SbT + (et * 32 + l32) * 272 + (ks * 16 + hf * 8) * 2); acc = MFMA32(a, b, acc); }
#pragma unroll
            for (int r = 0; r < 16; ++r) { const int tl = lt * 32 + (r >> 2) * 8 + hf * 4 + (r & 3); acc[r] *= __builtin_amdgcn_exp2f((float)(tl + 1) * lg2); }
            if (wave < 4) {
                const int slt = wave >> 1, smt = wave & 1;
                f32x16 sc;
#pragma unroll
                for (int r = 0; r < 16; ++r) sc[r] = 0.f;
                if (slt >= smt) {
#pragma unroll
                    for (int ks = 0; ks < 8; ++ks) { const bf16x8 a = *(const LAS bf16x8*)(Qn + (slt * 32 + l32) * 272 + (ks * 16 + hf * 8) * 2), b = *(const LAS bf16x8*)(Kn + (smt * 32 + l32) * 272 + (ks * 16 + hf * 8) * 2); sc = MFMA32(a, b, sc); }
                }
                const int tm = smt * 32 + l32;
#pragma unroll
                for (int r = 0; r < 16; ++r) { const int tl = slt * 32 + (r >> 2) * 8 + hf * 4 + (r & 3);
                    const float p = tl >= tm ? sc[r] * __builtin_amdgcn_exp2f((float)(tl - tm) * lg2) : 0.f;
                    *(LAS unsigned short*)(Pm + tl * 144 + tm * 2) = (unsigned short)f2bf(p); }
            }
            __syncthreads();
#pragma unroll
            for (int ms = 0; ms < 4; ++ms) { const bf16x8 a = *(const LAS bf16x8*)(Pm + (lt * 32 + l32) * 144 + (ms * 16 + hf * 8) * 2), b = *(const LAS bf16x8*)(VT + (et * 32 + l32) * 144 + (((ms * 2 + hf) ^ ((et * 4 + (l32 >> 3)) & 7)) << 4)); acc = MFMA32(a, b, acc); }
#pragma unroll
            for (int r = 0; r < 16; ++r) { const int tl = lt * 32 + (r >> 2) * 8 + hf * 4 + (r & 3); of[tl * 132 + et * 32 + l32] = acc[r]; }
        }
#pragma unroll
        for (int r = 0; r < 16; ++r) { S0[r] *= gL; S1[r] *= gL; }
#pragma unroll
        for (int ts = 0; ts < 4; ++ts) {
            const int cc = ts * 2 + hf, rs = l32 >> 3;
            const bf16x8 a = *(const LAS bf16x8*)(KdT + (sdt * 32 + l32) * 144 + ((cc ^ ((sdt * 4 + rs) & 7)) << 4));
            const bf16x8 b0 = *(const LAS bf16x8*)(VT + (set0 * 32 + l32) * 144 + ((cc ^ ((set0 * 4 + rs) & 7)) << 4)), b1 = *(const LAS bf16x8*)(VT + ((set0 + 1) * 32 + l32) * 144 + ((cc ^ (((set0 + 1) * 4 + rs) & 7)) << 4));
            S0 = MFMA32(a, b0, S0); S1 = MFMA32(a, b1, S1);
        }
        if (!state_only) {
#pragma unroll
            for (int g = 0; g < 4; ++g) { const int d0 = sdt * 32 + g * 8 + hf * 4;
                u32x2 a, b; a.x = pk2(S0[4 * g], S0[4 * g + 1]); a.y = pk2(S0[4 * g + 2], S0[4 * g + 3]); b.x = pk2(S1[4 * g], S1[4 * g + 1]); b.y = pk2(S1[4 * g + 2], S1[4 * g + 3]);
                *(LAS u32x2*)(SbT + (set0 * 32 + l32) * 272 + d0 * 2) = a; *(LAS u32x2*)(SbT + ((set0 + 1) * 32 + l32) * 272 + d0 * 2) = b; }
            __syncthreads();
            const f32x2 gr = *(const f32x2*)(P.in[13] + (size_t)(l * 4 + h) * 128 + lane * 2);
#pragma unroll
            for (int rr = 0; rr < 8; ++rr) {
                const int t = wave * 8 + rr;
                if (t < L) {
                    const f32x2 v = *(const LAS f32x2*)(of + t * 132 + lane * 2);
                    const float rstd = rsqrtf(wave_sum(v.x * v.x + v.y * v.y) * (1.f / 128.f) + EPS);
                    const size_t row = (size_t)(row0 + c * 64 + t);
                    const unsigned gg = *(const unsigned*)(QKV + row * INW + 3072 + h * 128 + lane * 2);
                    const float y0 = v.x * rstd * gr.x * silu_f(bf2f(gg & 0xffffu)), y1 = v.y * rstd * gr.y * silu_f(bf2f(gg >> 16));
                    *(unsigned*)(Ob + row * DM + 512 + h * 128 + lane * 2) = pk2(y0, y1);
                }
            }
        }
        __syncthreads();
    }
    if (outst) {
        float* op = outst + (sdt * 32 + hf * 4) * 128 + set0 * 32 + l32;
#pragma unroll
        for (int r = 0; r < 16; ++r) { op[((r >> 2) * 8 + (r & 3)) * 128] = S0[r]; op[((r >> 2) * 8 + (r & 3)) * 128 + 32] = S1[r]; if ((r & 3) == 3) asm volatile("" ::: "memory"); }
    }
}


#define XB_TMO      128
#define XB_XCNT(j)  (256  + 64 * (j))
#define XB_XSUB(j)  (1280 + 64 * (j))
#define XB_XGEN(j)  (2304 + 64 * (j))
#define XB_TOP      3328
#define XB_TOPGEN   3392
#define XCD_BAR_WORDS 3456
#define XB_SPIN_CAP (1u << 18)

__device__ __forceinline__ unsigned xb_ld(unsigned* p)              { return __hip_atomic_load(p, __ATOMIC_RELAXED, __HIP_MEMORY_SCOPE_AGENT); }
__device__ __forceinline__ unsigned xb_add(unsigned* p, unsigned v) { return __hip_atomic_fetch_add(p, v, __ATOMIC_RELAXED, __HIP_MEMORY_SCOPE_AGENT); }
__device__ __forceinline__ unsigned xb_xcc_id() { return (unsigned)__builtin_amdgcn_s_getreg((3 << 11) | 20) & 0xFu; }
#define XB_SPIN(cond, bar) do { unsigned _sp = 0; while (cond) { __builtin_amdgcn_s_sleep(1); \
    if ((++_sp & 255u) == 0u) { if (xb_ld(&(bar)[XB_TMO])) break; if (_sp > XB_SPIN_CAP) { atomicAdd(&(bar)[XB_TMO], 1u); break; } } } } while (0)

struct XcdBarrier {
    unsigned* bar; unsigned x;
    volatile LAS unsigned* st;
};

__device__ __forceinline__ XcdBarrier xcd_barrier_post(unsigned* bar, volatile LAS unsigned* st) {
    XcdBarrier b; b.bar = bar; b.x = xb_xcc_id(); b.st = st;
    if (threadIdx.x == 0) (void)xb_add(&bar[XB_XCNT(b.x)], 1u);
    return b;
}
__device__ __forceinline__ void xcd_barrier_complete(unsigned* bar, unsigned x, unsigned& nloc, unsigned& nx) {
    const unsigned G = gridDim.x * gridDim.y * gridDim.z;
    unsigned sum, cnt, mine, sp = 0u;
    for (;;) {
        sum = 0u; cnt = 0u; mine = 0u;
#pragma unroll
        for (unsigned j = 0; j < 16; ++j) { const unsigned c = xb_ld(&bar[XB_XCNT(j)]); sum += c; cnt += (c > 0u) ? 1u : 0u; mine = (j == x) ? c : mine; }
        if (sum == G) break;
        __builtin_amdgcn_s_sleep(1);
        if ((++sp & 255u) == 0u) { if (xb_ld(&bar[XB_TMO])) break; if (sp > XB_SPIN_CAP) { atomicAdd(&bar[XB_TMO], 1u); break; } }
    }
    nloc = mine > 0u ? mine : 1u; nx = cnt > 0u ? cnt : 1u;
}

__device__ __forceinline__ void xcd_barrier(const XcdBarrier& b) {
    asm volatile("s_waitcnt vmcnt(0)" ::: "memory");
    __syncthreads();
    if (threadIdx.x == 0) {
        unsigned* bar = b.bar;
        __builtin_amdgcn_s_waitcnt(0);
        unsigned nloc = b.st[0], nx = b.st[1];
        if (nloc == 0u) { xcd_barrier_complete(bar, b.x, nloc, nx); b.st[0] = nloc; b.st[1] = nx; }
        const unsigned old = xb_add(&bar[XB_XSUB(b.x)], 1u);
        const unsigned gen = old / nloc;
        if (old + 1u == (gen + 1u) * nloc) {
            __builtin_amdgcn_fence(__ATOMIC_RELEASE, "agent");
            asm volatile("s_waitcnt vmcnt(0)" ::: "memory");
            const unsigned og = xb_add(&bar[XB_TOP], 1u);
            const unsigned tg = og / nx;
            if (og + 1u == (tg + 1u) * nx) xb_add(&bar[XB_TOPGEN], 1u);
            else XB_SPIN(xb_ld(&bar[XB_TOPGEN]) == tg, bar);
            __builtin_amdgcn_fence(__ATOMIC_ACQUIRE, "agent");
            xb_add(&bar[XB_XGEN(b.x)], 1u);
            asm volatile("s_waitcnt vmcnt(0)" ::: "memory");
        } else {
            XB_SPIN(xb_ld(&bar[XB_XGEN(b.x)]) == gen, bar);
            __builtin_amdgcn_fence(__ATOMIC_ACQUIRE, "agent");
            asm volatile("s_waitcnt vmcnt(0)" ::: "memory");
        }
    }
    __syncthreads();
}
__global__ void __launch_bounds__(512, 2) fwd_megakernel(Params P) {
    extern __shared__ __attribute__((aligned(16))) unsigned char lds_raw[];
    LAS unsigned char* lds = (LAS unsigned char*)lds_raw;
    cg::grid_group grid = cg::this_grid();
    int tid = threadIdx.x, lane = tid & 63, wave = __builtin_amdgcn_readfirstlane(tid >> 6);
#define REFRESH() do { tid = threadIdx.x; asm volatile("" : "+v"(tid)); lane = tid & 63; wave = __builtin_amdgcn_readfirstlane(tid >> 6); } while (0)
    const int G = gridDim.x, bx = blockIdx.x;
    bf16_t* H = (bf16_t*)(P.ws + WS_H); bf16_t* Ob = (bf16_t*)(P.ws + WS_O); bf16_t* QKV = (bf16_t*)(P.ws + WS_QKV); bf16_t* ACT = QKV;
    float* X = (float*)(P.ws + WS_X); float* U = (float*)(P.ws + WS_U);
    const float* MOD = (const float*)(P.ws + WS_MOD);

    volatile LAS unsigned* bst = (volatile LAS unsigned*)(lds + LDS_BYTES - 64);
    if (tid == 0) { bst[0] = 0u; bst[1] = 0u; }
    __syncthreads();
    const XcdBarrier xbar = xcd_barrier_post((unsigned*)(P.ws + WS_BAR), bst);
#ifndef SK_P0
    p0_phase(P, lds, tid, lane, wave);
#endif
    grid.sync(); REFRESH();
#pragma unroll 1
    for (int l = 0; l < DEPTH; ++l) {
        norm_phase<false>(P, l, l == 0, P.in[7] + (size_t)l * DM, 0, 1024, lane, wave);
        xcd_barrier(xbar); REFRESH();
#ifndef SK_G1
        {
            pg8::Gemm g{H, (const bf16_t*)(P.ws + WS_WIN) + (size_t)l * INW * DM, MP, INW, DM}; pg8::StaticOrder S; S.init(MP, INW, G, bx);
            EpiQKV E{QKV, P.out, l};
            pg8::gemm_phase<EpiQKV, pg8::StaticOrder, true, true>(lds, g, S, E);
            SEpiQKV SE{QKV, P.out, l};
            sgemm_phase<8, 8, SEpiQKV>(lds, H + (size_t)MP * DM, DM, g.Bt, DM, INW / 64, tid, lane, wave, SE);
        }
#endif
        xcd_barrier(xbar); REFRESH();
        for (int u = bx; u < 1360; u += G) {
#ifndef SK_R1
            if (u < 256) { const int bh = u >> 5, seg = u & 31, b = bh >> 2, h = bh & 3;
                ret_unit(P, l, lds, tid, lane, wave, b * SEQ + seg * 512, seg * 512, 8, 64, h, nullptr, U + (size_t)(bh * 32 + seg) * 16384, true); }
            else
#endif
#ifndef SK_RS
            if (u < 320) { const int idx = u - 256, bs = idx >> 2, h = idx & 3; const size_t so = ((size_t)(l * DB + bs) * 4 + h) * 16384;
                ret_unit(P, l, lds, tid, lane, wave, MP + bs * 32, PAST, 1, 32, h, P.in[4] + so, P.out + OFF_RS + so, false); }
            else
#endif
            {}
#ifndef SK_SB
            if (u >= 320) sb_unit(P, l, u - 320, lds, tid, lane, wave);
#endif
        }
        xcd_barrier(xbar); REFRESH();
        for (int idx = bx * 512 + tid; idx < 8 * 16384; idx += G * 512) {
            const int bh = idx >> 14, within = idx & 16383, h = bh & 3;
            const float g512 = exp2f(512.f * log2f(1.f - exp2f(-5.f - (float)h)));
            float* up = U + (size_t)bh * 32 * 16384 + within; float s = 0.f;
            for (int seg = 0; seg < 32; ++seg) { const float uu = up[(size_t)seg * 16384]; up[(size_t)seg * 16384] = s; s = g512 * s + uu; }
            P.out[OFF_RP + ((size_t)l * 8 + bh) * 16384 + within] = s;
        }
        xcd_barrier(xbar); REFRESH();
#ifndef SK_R3
        for (int u = bx; u < 256; u += G) { const int bh = u >> 5, seg = u & 31, b = bh >> 2, h = bh & 3;
            ret_unit(P, l, lds, tid, lane, wave, b * SEQ + seg * 512, seg * 512, 8, 64, h, U + (size_t)(bh * 32 + seg) * 16384, nullptr, false); }
#endif
        xcd_barrier(xbar); REFRESH();
#ifndef SK_G2
        {
            pg8::Gemm g{Ob, (const bf16_t*)(P.ws + WS_WOUT) + (size_t)l * DM * DM, MP, DM, DM}; pg8::StaticOrder S; S.init(MP, DM, G, bx);
            EpiResid E{l == 0 ? P.in[0] : nullptr, l == 0 ? P.in[1] : nullptr, X, MOD + (size_t)l * NBI * NMOD + 2048};
            pg8::gemm_phase<EpiResid, pg8::StaticOrder, true, true>(lds, g, S, E);
            SEpiResid SE{l == 0 ? P.in[1] : X + (size_t)MP * DM, X + (size_t)MP * DM, MOD + (size_t)l * NBI * NMOD + 2048};
            sgemm_phase<8, 8, SEpiResid>(lds, Ob + (size_t)MP * DM, DM, g.Bt, DM, DM / 64, tid, lane, wave, SE);
        }
#endif
        xcd_barrier(xbar); REFRESH();
        norm_phase<false>(P, l, false, P.in[8] + (size_t)l * DM, 3072, 4096, lane, wave);
        xcd_barrier(xbar); REFRESH();
#ifndef SK_G3
        {
            pg8::Gemm g{H, (const bf16_t*)(P.ws + WS_WFI) + (size_t)l * 2 * DFF * DM, MP, 2 * DFF, DM}; pg8::StaticOrder S; S.init(MP, 2 * DFF, G, bx);
            EpiSwiGLU E{ACT};
            pg8::gemm_phase<EpiSwiGLU, pg8::StaticOrder, true, true>(lds, g, S, E);
            SEpiSwiGLU SE{ACT};
            sgemm_phase<8, 8, SEpiSwiGLU>(lds, H + (size_t)MP * DM, DM, g.Bt, DM, (2 * DFF / 256) * 4, tid, lane, wave, SE);
        }
#endif
        xcd_barrier(xbar); REFRESH();
#ifndef SK_G4
        {
            pg8::Gemm g{ACT, (const bf16_t*)(P.ws + WS_WFO) + (size_t)l * DM * DFF, MP, DM, DFF}; pg8::StaticOrder S; S.init(MP, DM, G, bx);
            EpiResid E{nullptr, nullptr, X, MOD + (size_t)l * NBI * NMOD + 5120};
            pg8::gemm_phase<EpiResid, pg8::StaticOrder, true, true>(lds, g, S, E);
            SEpiResid SE{X + (size_t)MP * DM, X + (size_t)MP * DM, MOD + (size_t)l * NBI * NMOD + 5120};
            sgemm_phase<22, 11, SEpiResid>(lds, ACT + (size_t)MP * DFF, DFF, g.Bt, DFF, DM / 64, tid, lane, wave, SE);
        }
#endif
        xcd_barrier(xbar); REFRESH();
    }
    norm_phase<true>(P, 0, false, P.in[17], 0, 0, lane, wave);
}

extern "C" void kernel_launch(void* const* d_in, const int* in_sizes, int n_in, void* d_out, int out_size, void* d_ws, size_t ws_size, hipStream_t stream) {
    static int grid = 0;
    if (grid == 0) {
        if (n_in != 18 || ws_size < WS_END) { fprintf(stderr, "kernel_launch: unexpected n_in %d / ws_size %zu\n", n_in, ws_size); grid = -1; return; }
        int dev = 0, cus = 0, per_cu = 0;
        (void)hipGetDevice(&dev); (void)hipDeviceGetAttribute(&cus, hipDeviceAttributeMultiprocessorCount, dev);
        if (hipFuncSetAttribute((const void*)fwd_megakernel, hipFuncAttributeMaxDynamicSharedMemorySize, LDS_BYTES) != hipSuccess) { fprintf(stderr, "kernel_launch: hipFuncSetAttribute failed\n"); grid = -1; return; }
        (void)hipOccupancyMaxActiveBlocksPerMultiprocessor(&per_cu, (const void*)fwd_megakernel, 512, LDS_BYTES);
        (void)hipGetLastError();
        if (per_cu < 1) { fprintf(stderr, "kernel_launch: occupancy query says %d blocks per CU\n", per_cu); per_cu = 1; }
        grid = cus;
    }
    if (grid < 0) return;
    (void)hipMemsetAsync((char*)d_ws + WS_MOD, 0, MOD_BYTES, stream);
    Params p{};
    for (int i = 0; i < 18; ++i) p.in[i] = (const float*)d_in[i];
    p.out = (float*)d_out; p.ws = (unsigned char*)d_ws;
    void* args[] = {&p};
    hipError_t e = hipLaunchCooperativeKernel((const void*)fwd_megakernel, dim3(grid), dim3(512), args, LDS_BYTES, stream);
    if (e != hipSuccess) fprintf(stderr, "cooperative launch failed: %s (grid %d)\n", hipGetErrorString(e), grid);
}
```

```cpp
#include <hip/hip_runtime.h>
#include <hip/hip_cooperative_groups.h>
#include <cstdio>
#include <cstdint>
namespace cg = cooperative_groups;
namespace pg8 {
#define PG8_LAS __attribute__((address_space(3)))
typedef unsigned short bf16_t;
typedef short bf16x8 __attribute__((ext_vector_type(8)));
typedef float f32x4 __attribute__((ext_vector_type(4)));
typedef unsigned u32x4 __attribute__((ext_vector_type(4)));
constexpr int BM = 256, BK = 64, HALF = 128, HTB = HALF * BK * 2  , STAGE_BYTES = 8 * HTB, NXCD = 8, WGM = 8;

__host__ __device__ __forceinline__ int lds_byte(int r, int c) { const int st = (r >> 4) * 2 + (c >> 5), rr = r & 15, cc = c & 31, ob = rr * 64 + cc * 2; return st * 1024 + (ob ^ (((ob >> 9) & 1) << 5)); }
__host__ __device__ __forceinline__ void stage_rc(int b, int& R, int& C) { const int st = b / 1024, sb = b % 1024, swz = sb ^ (((sb >> 9) & 1) << 5); R = (st >> 1) * 16 + swz / 64; C = (st & 1) * 32 + (swz % 64) / 2; }
__host__ __device__ __forceinline__ int perm32(int rho) { const int n = rho >> 4, i = rho & 15; return 8 * (i >> 2) + 4 * n + (i & 3); }

struct Unit { int pm, pn; };
struct Gemm { const bf16_t* A; const bf16_t* Bt; int M, N, K; };

struct StaticOrder {
    int nM, nN, nwg, G, c;
    __host__ __device__ void init(int M, int N, int G_, int c_) { nM = M / BM; nN = N / BM; nwg = nM * nN; G = G_; c = c_; }
    __host__ __device__ bool next(int i, Unit& u) const {
        const long L = (long)i * G + c; if (L >= nwg) return false;
        int wgid = (int)L; { const int q = nwg / NXCD, r = nwg % NXCD, xcd = wgid % NXCD, off = wgid / NXCD; wgid = (xcd < r ? xcd * (q + 1) : r * (q + 1) + (xcd - r) * q) + off; }
        const int nig = WGM * nN, gid = wgid / nig, fm = gid * WGM, gsz = (nM - fm) < WGM ? (nM - fm) : WGM;
        u.pm = fm + ((wgid % nig) % gsz); u.pn = (wgid % nig) / gsz; return true;
    }
    __device__ __forceinline__ void a_ready(const Unit&) const {}
    __device__ __forceinline__ void done(const Unit&) const {}
};

__device__ __forceinline__ unsigned cvt_pk_bf16(float lo, float hi) { unsigned r; asm volatile("v_cvt_pk_bf16_f32 %0, %1, %2" : "=v"(r) : "v"(lo), "v"(hi)); return r; }
typedef float f32x2 __attribute__((ext_vector_type(2)));
__device__ __forceinline__ f32x2 gelu_pk(f32x2 v) {
    const f32x2 av = __builtin_elementwise_abs(v), d = av * 0.2316418882f + 1.0f;
    f32x2 t; t.x = __builtin_amdgcn_rcpf(d.x); t.y = __builtin_amdgcn_rcpf(d.y);
    f32x2 q = t * 0.5307027145f + (-0.7265760135f); q = q * t + 0.7107068705f; q = q * t + (-0.142248368f); q = q * t + 0.127414796f; q = q * t;
    const f32x2 s = (v * v) * (-0.72134752044f);
    f32x2 e; e.x = __builtin_amdgcn_exp2f(s.x); e.y = __builtin_amdgcn_exp2f(s.y);
    const f32x2 m = v * (q * e), r = v - m;
    f32x2 o; o.x = v.x < 0.f ? m.x : r.x; o.y = v.y < 0.f ? m.y : r.y; return o;
}

template <int ACT  > struct EpiBf16 {
    static constexpr bool PERM = true, AFTER_DRAIN = false; static_assert(ACT == 0 || ACT == 1, "EpiBf16: ACT is 0 (none) or 1 (gelu_pk)");
    bf16_t* O; int ldc; const float* bias; int split_cols; size_t split_stride; float scale0;
    __device__ __forceinline__ void operator()(const f32x4 (&acc)[2][2][4][2], const Unit& u, int wr, int wc, int fr, int fq) const {
        const int row0 = u.pm * BM + wr * 64 + fr; int colt = u.pn * BM; bf16_t* base = O;
        float sc = 1.f; if (split_cols) { const int t = colt / split_cols; base += (size_t)t * split_stride; colt -= t * split_cols; if (t == 0) sc = scale0; }
        const int col0 = colt + wc * 32 + 8 * fq, bcol0 = u.pn * BM + wc * 32 + 8 * fq;
        f32x4 bv[2][2];
#pragma unroll
        for (int bj = 0; bj < 2; ++bj)
#pragma unroll
            for (int n = 0; n < 2; ++n) bv[bj][n] = bias ? *(const f32x4*)(bias + bcol0 + bj * HALF + 4 * n) : (f32x4){0.f, 0.f, 0.f, 0.f};
#pragma unroll
        for (int ai = 0; ai < 2; ++ai)
#pragma unroll
            for (int m = 0; m < 4; ++m) { bf16_t* rowp = base + (size_t)(row0 + ai * HALF + m * 16) * ldc + col0;
#pragma unroll
                for (int bj = 0; bj < 2; ++bj) { f32x4 v0 = acc[ai][bj][m][0] + bv[bj][0], v1 = acc[ai][bj][m][1] + bv[bj][1];
                    if (ACT == 1) { f32x2 a = gelu_pk((f32x2){v0[0], v0[1]}), b = gelu_pk((f32x2){v0[2], v0[3]}), c = gelu_pk((f32x2){v1[0], v1[1]}), d = gelu_pk((f32x2){v1[2], v1[3]});
                        v0 = (f32x4){a.x, a.y, b.x, b.y}; v1 = (f32x4){c.x, c.y, d.x, d.y}; }
                    v0 = v0 * sc; v1 = v1 * sc; u32x4 w; w.x = cvt_pk_bf16(v0[0], v0[1]); w.y = cvt_pk_bf16(v0[2], v0[3]); w.z = cvt_pk_bf16(v1[0], v1[1]); w.w = cvt_pk_bf16(v1[2], v1[3]);
                    *(u32x4*)(rowp + bj * HALF) = w; } }
    }
};
template <class Epi, class Sched, bool ALIGN_EPI = false, bool SP2 = false>
__device__ __forceinline__ void gemm_phase(PG8_LAS unsigned char* lds, const Gemm g, const Sched& S, const Epi& E) {
    int tid_o = threadIdx.x; asm volatile("" : "+v"(tid_o));
    const int tid = tid_o, wid = __builtin_amdgcn_readfirstlane(tid >> 6), lane = tid & 63, wr = wid >> 2, wc = wid & 3, fr = lane & 15, fq = lane >> 4;
    const int K = g.K, nt = K / BK;
    unsigned voffA[2], voffB[2];
#pragma unroll
    for (int i = 0; i < 2; ++i) { int R, C; stage_rc(tid * 16 + i * 8192, R, C); const int Rb = Epi::PERM ? ((R & ~31) + perm32(R & 31)) : R;
        voffA[i] = (unsigned)(R * K + C) * 2u; voffB[i] = (unsigned)(Rb * K + C) * 2u; }
    const size_t kstep = (size_t)(BK * 2);
    const size_t hstep = (size_t)HALF * K * 2;
    const size_t tstep = 2 * hstep;
    const unsigned ldsw = (unsigned)wid * 1024u;
    const int aoff = lds_byte(wr * 64 + fr, fq * 8), boff = lds_byte(wc * 32 + fr, fq * 8);
#define PG8_SA(b, h) (((b) * 2 + (h)) * HTB)
#define PG8_SB(b, h) ((4 + (b) * 2 + (h)) * HTB)
#define PG8_STAGE(bufoff, gbase, voff) do { _Pragma("unroll") for (int _i = 0; _i < 2; ++_i) \
        __builtin_amdgcn_global_load_lds((const unsigned*)((const char*)(gbase) + (voff)[_i]), (PG8_LAS unsigned*)(lds + (bufoff) + ldsw + _i * 8192), 16, 0, 0); } while (0)
#define PG8_LDA(dst, b, h) do { _Pragma("unroll") for (int m = 0; m < 4; ++m) _Pragma("unroll") for (int k = 0; k < 2; ++k) dst[m][k] = *(const PG8_LAS bf16x8*)(lds + PG8_SA(b, h) + aoff + m * 2048 + k * 1024); } while (0)
#define PG8_LDB(dst, b, h) do { _Pragma("unroll") for (int n = 0; n < 2; ++n) _Pragma("unroll") for (int k = 0; k < 2; ++k) dst[n][k] = *(const PG8_LAS bf16x8*)(lds + PG8_SB(b, h) + boff + n * 2048 + k * 1024); } while (0)
#define PG8_MMA(ai, bj, At, Bt) do { __builtin_amdgcn_s_setprio(1); _Pragma("unroll") for (int m = 0; m < 4; ++m) _Pragma("unroll") for (int n = 0; n < 2; ++n) _Pragma("unroll") for (int k = 0; k < 2; ++k) \
        acc[ai][bj][m][n] = __builtin_amdgcn_mfma_f32_16x16x32_bf16(Bt[n][k], At[m][k], acc[ai][bj][m][n], 0, 0, 0); __builtin_amdgcn_s_setprio(0); } while (0)
#define PG8_WAIT_V(n) asm volatile("s_waitcnt vmcnt(" #n ")" ::: "memory")
#define PG8_WAIT_L(n) asm volatile("s_waitcnt lgkmcnt(" #n ")" ::: "memory")
#define PG8_BAR __builtin_amdgcn_s_barrier()
#define PG8_SCHED __builtin_amdgcn_sched_barrier(0)
    Unit cur, nxt; int ui = 0;
    if (!S.next(0, cur)) return;
    f32x4 acc[2][2][4][2];
#pragma unroll
    for (int a = 0; a < 2; ++a)
#pragma unroll
        for (int b = 0; b < 2; ++b)
#pragma unroll
            for (int m = 0; m < 4; ++m)
#pragma unroll
                for (int n = 0; n < 2; ++n) acc[a][b][m][n] = (f32x4){0.f, 0.f, 0.f, 0.f};
    bf16x8 At[4][2], B0[2][2], B1[2][2];
    const char* cA = (const char*)g.A + (size_t)cur.pm * tstep; const char* cB = (const char*)g.Bt + (size_t)cur.pn * tstep;
    S.a_ready(cur);
    if constexpr (SP2) {
        PG8_STAGE(PG8_SB(0, 0), cB, voffB); PG8_STAGE(PG8_SB(0, 1), cB + hstep, voffB); PG8_STAGE(PG8_SA(0, 0), cA, voffA); PG8_STAGE(PG8_SA(0, 1), cA + hstep, voffA);
        if (wr == 1) PG8_BAR;
        PG8_WAIT_V(2); PG8_BAR;
        PG8_STAGE(PG8_SB(1, 0), cB + kstep, voffB); PG8_STAGE(PG8_SA(1, 0), cA + kstep, voffA); PG8_STAGE(PG8_SB(1, 1), cB + hstep + kstep, voffB);
        PG8_WAIT_V(6); PG8_BAR;
    } else {
        PG8_STAGE(PG8_SB(0, 0), cB, voffB); PG8_STAGE(PG8_SA(0, 0), cA, voffA); PG8_STAGE(PG8_SB(0, 1), cB + hstep, voffB); PG8_STAGE(PG8_SA(0, 1), cA + hstep, voffA);
        if (wr == 1) PG8_BAR;
        PG8_WAIT_V(4); PG8_BAR;
        PG8_STAGE(PG8_SB(1, 0), cB + kstep, voffB); PG8_STAGE(PG8_SA(1, 0), cA + kstep, voffA); PG8_STAGE(PG8_SB(1, 1), cB + hstep + kstep, voffB);
        PG8_WAIT_V(6); PG8_BAR;
    }
    for (;;) {
        const bool has_next = S.next(ui + 1, nxt);
        const char* nA = has_next ? (const char*)g.A + (size_t)nxt.pm * tstep : cA; const char* nB = has_next ? (const char*)g.Bt + (size_t)nxt.pn * tstep : cB;
        for (int t = 0; t < nt; t += 2) {
            const bool last = (t == nt - 2);
            const char* a1 = cA + (size_t)(t + 1) * kstep;
            const char* a2 = last ? nA : cA + (size_t)(t + 2) * kstep; const char* b2 = last ? nB : cB + (size_t)(t + 2) * kstep;
            const char* a3 = a2 + kstep; const char* b3 = b2 + kstep;
            if (last && has_next) S.a_ready(nxt);
            if constexpr (SP2) {
            PG8_LDB(B0, 0, 0); PG8_LDB(B1, 0, 1); PG8_SCHED; PG8_LDA(At, 0, 0); PG8_STAGE(PG8_SA(1, 1), a1 + hstep, voffA);
            PG8_WAIT_V(8); PG8_WAIT_L(0); PG8_BAR; PG8_MMA(0, 0, At, B0); PG8_MMA(0, 1, At, B1); PG8_BAR; PG8_SCHED;
            PG8_LDA(At, 0, 1); PG8_STAGE(PG8_SB(0, 0), b2, voffB); PG8_STAGE(PG8_SB(0, 1), b2 + hstep, voffB); PG8_STAGE(PG8_SA(0, 0), a2, voffA);
            PG8_WAIT_V(8); PG8_WAIT_L(0); PG8_BAR; PG8_MMA(1, 0, At, B0); PG8_MMA(1, 1, At, B1); PG8_BAR; PG8_SCHED;
            PG8_LDB(B0, 1, 0); PG8_LDB(B1, 1, 1); PG8_SCHED; PG8_LDA(At, 1, 0); PG8_STAGE(PG8_SA(0, 1), a2 + hstep, voffA);
            PG8_WAIT_V(8); PG8_WAIT_L(0); PG8_BAR; PG8_MMA(0, 0, At, B0); PG8_MMA(0, 1, At, B1); PG8_BAR; PG8_SCHED;
            PG8_LDA(At, 1, 1); PG8_STAGE(PG8_SB(1, 0), b3, voffB); PG8_STAGE(PG8_SB(1, 1), b3 + hstep, voffB); PG8_STAGE(PG8_SA(1, 0), a3, voffA);
            PG8_WAIT_V(8); PG8_WAIT_L(0); PG8_BAR; PG8_MMA(1, 0, At, B0); PG8_MMA(1, 1, At, B1); PG8_BAR; PG8_SCHED;
            } else {
            PG8_LDB(B0, 0, 0); PG8_SCHED; PG8_LDA(At, 0, 0); PG8_STAGE(PG8_SA(1, 1), a1 + hstep, voffA);
            PG8_WAIT_L(8); PG8_BAR; PG8_WAIT_L(0); PG8_MMA(0, 0, At, B0); PG8_BAR; PG8_SCHED;
            PG8_LDB(B1, 0, 1); PG8_STAGE(PG8_SB(0, 0), b2, voffB);
            PG8_BAR; PG8_WAIT_L(0); PG8_MMA(0, 1, At, B1); PG8_BAR;
            PG8_LDA(At, 0, 1); PG8_STAGE(PG8_SA(0, 0), a2, voffA);
            PG8_BAR; PG8_WAIT_L(0); PG8_MMA(1, 0, At, B0); PG8_BAR; PG8_SCHED;
            PG8_STAGE(PG8_SB(0, 1), b2 + hstep, voffB);
            PG8_WAIT_V(6); PG8_BAR; PG8_MMA(1, 1, At, B1); PG8_BAR;
            PG8_LDB(B0, 1, 0); PG8_SCHED; PG8_LDA(At, 1, 0); PG8_STAGE(PG8_SA(0, 1), a2 + hstep, voffA);
            PG8_WAIT_L(8); PG8_BAR; PG8_WAIT_L(0); PG8_MMA(0, 0, At, B0); PG8_BAR; PG8_SCHED;
            PG8_LDB(B1, 1, 1); PG8_STAGE(PG8_SB(1, 0), b3, voffB);
            PG8_BAR; PG8_WAIT_L(0); PG8_MMA(0, 1, At, B1); PG8_BAR;
            PG8_LDA(At, 1, 1); PG8_STAGE(PG8_SA(1, 0), a3, voffA);
            PG8_BAR; PG8_WAIT_L(0); PG8_MMA(1, 0, At, B0); PG8_BAR; PG8_SCHED;
            PG8_STAGE(PG8_SB(1, 1), b3 + hstep, voffB);
            PG8_WAIT_V(6); PG8_BAR; PG8_MMA(1, 1, At, B1); PG8_BAR;
            }
        }
        if constexpr (ALIGN_EPI) { if (wr == 0) PG8_BAR; }
        if constexpr (!Epi::AFTER_DRAIN) { E(acc, cur, wr, wc, fr, fq); S.done(cur); }
        if (!has_next) break;
#pragma unroll
        for (int a = 0; a < 2; ++a)
#pragma unroll
            for (int b = 0; b < 2; ++b)
#pragma unroll
                for (int m = 0; m < 4; ++m)
#pragma unroll
                    for (int n = 0; n < 2; ++n) acc[a][b][m][n] = (f32x4){0.f, 0.f, 0.f, 0.f};
        cur = nxt; cA = nA; cB = nB; ++ui;
        if constexpr (ALIGN_EPI) { if (wr == 1) PG8_BAR; }
    }
    PG8_WAIT_V(0);
    if constexpr (!ALIGN_EPI) { if (wr == 0) PG8_BAR; }
    PG8_BAR;
    if constexpr (Epi::AFTER_DRAIN) { E.fused(acc, cur, wr, wc, fr, fq, lds, wid, lane); S.done(cur); }
#undef PG8_SA
#undef PG8_SB
#undef PG8_STAGE
#undef PG8_LDA
#undef PG8_LDB
#undef PG8_MMA
#undef PG8_WAIT_V
#undef PG8_WAIT_L
#undef PG8_BAR
#undef PG8_SCHED
}
}

#define LAS __attribute__((address_space(3)))
typedef unsigned short bf16_t;
typedef short bf16x8 __attribute__((ext_vector_type(8)));
typedef float f32x4 __attribute__((ext_vector_type(4)));
typedef float f32x2 __attribute__((ext_vector_type(2)));
typedef float f32x16 __attribute__((ext_vector_type(16)));
typedef unsigned u32x4 __attribute__((ext_vector_type(4)));
typedef unsigned u32x2 __attribute__((ext_vector_type(2)));
#define MFMA32(a, b, c) __builtin_amdgcn_mfma_f32_32x32x16_bf16((a), (b), (c), 0, 0, 0)

constexpr int DM = 1024, SEQ = 16384, NBP = 2, DEPTH = 4, DB = 16, DS = 32, PAST = 2048;
constexpr int MP = NBP * SEQ, MS = DB * DS, MT = MP + MS;
constexpr int INW = 3584, DFF = 2816, NMOD = 6144, NBI = 18;
constexpr float EPS = 1e-6f;
constexpr size_t OFF_YP = 0, OFF_YS = 33554432, OFF_KP = 34078720, OFF_VP = 101187584, OFF_RP = 168296448,
                 OFF_KS = 168820736, OFF_VS = 169869312, OFF_RS = 170917888;
constexpr size_t MiB = 1u << 20;
constexpr size_t WS_MOD = 0, MOD_BYTES = 2 * MiB; constexpr size_t WS_BAR = 1802240;
constexpr size_t WS_ROPE = 2 * MiB;
constexpr size_t WS_WIN = 10 * MiB, WS_WOUT = 38 * MiB, WS_WFI = 46 * MiB, WS_WFO = 90 * MiB;
constexpr size_t WS_X = 112 * MiB;
constexpr size_t WS_H = 242 * MiB;
constexpr size_t WS_O = 307 * MiB;
constexpr size_t WS_QKV = 372 * MiB;
constexpr size_t WS_U = 600 * MiB;
constexpr size_t WS_END = 616 * MiB;
constexpr int LDS_BYTES = 147456;

struct Params { const float* in[18]; float* out; unsigned char* ws; };

typedef __bf16 bf16x2_t __attribute__((ext_vector_type(2)));
__device__ __forceinline__ unsigned pk2(float lo, float hi) { const f32x2 v = {lo, hi}; return __builtin_bit_cast(unsigned, __builtin_convertvector(v, bf16x2_t)); }
__device__ __forceinline__ unsigned f2bf(float f) { return pk2(f, 0.f) & 0xffffu; }
__device__ __forceinline__ float bf2f(unsigned h) { return __builtin_bit_cast(float, h << 16); }
__device__ __forceinline__ bf16x8 pack8(f32x4 a, f32x4 b) { u32x4 p; p.x = pk2(a.x, a.y); p.y = pk2(a.z, a.w); p.z = pk2(b.x, b.y); p.w = pk2(b.z, b.w); return __builtin_bit_cast(bf16x8, p); }
__device__ __forceinline__ float wave_sum(float v) {
#pragma unroll
    for (int o = 1; o < 64; o <<= 1) v += __shfl_xor(v, o);
    return v;
}
__device__ __forceinline__ float silu_f(float x) { return x * __builtin_amdgcn_rcpf(1.f + __expf(-x)); }
__device__ __forceinline__ int batch_of(int row) { return row < MP ? (row >> 14) : 2 + ((row - MP) >> 5); }

struct EpiQKV {
    static constexpr bool PERM = true, AFTER_DRAIN = false;
    bf16_t* QKV; float* out; int layer;
    __device__ __forceinline__ void operator()(const pg8::f32x4 (&acc)[2][2][4][2], const pg8::Unit& u, int wr, int wc, int fr, int fq) const {
        const int row0 = u.pm * 256 + wr * 64 + fr, col0 = u.pn * 256 + wc * 32 + 8 * fq;
        const bool kv = (u.pn >= 2 && u.pn < 6);
        const size_t vsel = (u.pn >= 4) ? 1 : 0;
        const size_t obase = (u.pm < 128) ? OFF_KP + vsel * (OFF_VP - OFF_KP) + (size_t)layer * MP * 512 + (size_t)row0 * 512
                                          : OFF_KS + vsel * (OFF_VS - OFF_KS) + (size_t)layer * MS * 512 + (size_t)(row0 - MP) * 512;
#pragma unroll
        for (int ai = 0; ai < 2; ++ai)
#pragma unroll
            for (int m = 0; m < 4; ++m) {
                const int row = row0 + ai * 128 + m * 16;
#pragma unroll
                for (int bj = 0; bj < 2; ++bj) {
                    const int col = col0 + bj * 128;
                    const pg8::f32x4 v0 = acc[ai][bj][m][0], v1 = acc[ai][bj][m][1];
                    u32x4 w; w.x = pg8::cvt_pk_bf16(v0[0], v0[1]); w.y = pg8::cvt_pk_bf16(v0[2], v0[3]); w.z = pg8::cvt_pk_bf16(v1[0], v1[1]); w.w = pg8::cvt_pk_bf16(v1[2], v1[3]);
                    *(u32x4*)(QKV + (size_t)row * INW + col) = w;
                    if (kv) {
                        const int c = col & 511;
                        float* dst = out + obase + (size_t)(ai * 128 + m * 16) * 512 + c;
                        *(pg8::f32x4*)dst = v0; *(pg8::f32x4*)(dst + 4) = v1;
                    }
                }
                asm volatile("" ::: "memory");
            }
    }
};
struct EpiResid {
    static constexpr bool PERM = false, AFTER_DRAIN = false;
    const float* base_p; const float* base_s;
    float* X; const float* gate;
    __device__ __forceinline__ void operator()(const pg8::f32x4 (&acc)[2][2][4][2], const pg8::Unit& u, int wr, int wc, int fr, int fq) const {
        const int col0 = u.pn * 256 + wc * 32 + 4 * fq;
        const bool uni = u.pm < 128;
        pg8::f32x4 gv[4];
        { const float* gr = gate + (size_t)batch_of(u.pm * 256 + wr * 64 + fr) * NMOD;
#pragma unroll
          for (int q = 0; q < 4; ++q) gv[q] = *(const pg8::f32x4*)(gr + col0 + (q >> 1) * 128 + (q & 1) * 16); }
#pragma unroll
        for (int grp = 0; grp < 4; ++grp) {
            const int ai = grp >> 1, m0 = (grp & 1) * 2;
            pg8::f32x4 bv[2][4];
#pragma unroll
            for (int mm = 0; mm < 2; ++mm) {
                const int row = u.pm * 256 + ai * 128 + wr * 64 + (m0 + mm) * 16 + fr;
                const float* br = base_p ? (row < MP ? base_p + (size_t)row * DM : base_s + (size_t)(row - MP) * DM) : X + (size_t)row * DM;
#pragma unroll
                for (int q = 0; q < 4; ++q) bv[mm][q] = *(const pg8::f32x4*)(br + col0 + (q >> 1) * 128 + (q & 1) * 16);
            }
#pragma unroll
            for (int mm = 0; mm < 2; ++mm) {
                const int m = m0 + mm, row = u.pm * 256 + ai * 128 + wr * 64 + m * 16 + fr;
                if (!uni) { const float* gr = gate + (size_t)batch_of(row) * NMOD;
#pragma unroll
                    for (int q = 0; q < 4; ++q) gv[q] = *(const pg8::f32x4*)(gr + col0 + (q >> 1) * 128 + (q & 1) * 16); }
                float* xr = X + (size_t)row * DM;
#pragma unroll
                for (int q = 0; q < 4; ++q) { const int bj = q >> 1, n = q & 1;
                    *(pg8::f32x4*)(xr + col0 + bj * 128 + n * 16) = bv[mm][q] + gv[q] * acc[ai][bj][m][n]; }
            }
            asm volatile("" ::: "memory");
        }
    }
};
struct EpiSwiGLU {
    static constexpr bool PERM = true, AFTER_DRAIN = false;
    bf16_t* ACT;
    __device__ __forceinline__ void operator()(const pg8::f32x4 (&acc)[2][2][4][2], const pg8::Unit& u, int wr, int wc, int fr, int fq) const {
        const int col0 = u.pn * 128 + wc * 32 + 8 * fq;
#pragma unroll
        for (int ai = 0; ai < 2; ++ai)
#pragma unroll
            for (int m = 0; m < 4; ++m) {
                const int row = u.pm * 256 + ai * 128 + wr * 64 + m * 16 + fr;
                const pg8::f32x4 g0 = acc[ai][0][m][0], g1 = acc[ai][0][m][1], u0 = acc[ai][1][m][0], u1 = acc[ai][1][m][1];
                float r[8];
#pragma unroll
                for (int j = 0; j < 4; ++j) { r[j] = silu_f(g0[j]) * u0[j]; r[4 + j] = silu_f(g1[j]) * u1[j]; }
                u32x4 w; w.x = pg8::cvt_pk_bf16(r[0], r[1]); w.y = pg8::cvt_pk_bf16(r[2], r[3]); w.z = pg8::cvt_pk_bf16(r[4], r[5]); w.w = pg8::cvt_pk_bf16(r[6], r[7]);
                *(u32x4*)(ACT + (size_t)row * DFF + col0) = w;
                asm volatile("" ::: "memory");
            }
    }
};


template <int NKS  , int UNR, class Epi>
__device__ __forceinline__ void sgemm_phase(LAS unsigned char* lds, const bf16_t* A  , int lda, const bf16_t* Bt, int K, int ncb,
                                            int tid, int lane, int wave, const Epi& E) {
    const int l32 = lane & 31, hf = lane >> 5;
    LAS float* red = (LAS float*)lds;
    const int kw0 = wave * NKS * 16 + hf * 8;
    for (int it = blockIdx.x; it < 16 * ncb; it += gridDim.x) {
        const int rb = it & 15, cb = it >> 4;
        int n0, n1; E.cols(cb, n0, n1);
        const bf16_t* ap = A + (size_t)(rb * 32 + l32) * lda + kw0;
        const bf16_t* b0p = Bt + (size_t)(n0 + l32) * K + kw0;
        const bf16_t* b1p = Bt + (size_t)(n1 + l32) * K + kw0;
        f32x16 c0, c1;
#pragma unroll
        for (int r = 0; r < 16; ++r) { c0[r] = 0.f; c1[r] = 0.f; }
#pragma unroll 1
        for (int kb = 0; kb < NKS; kb += UNR) {
            bf16x8 a[UNR], b0[UNR], b1[UNR];
#pragma unroll
            for (int j = 0; j < UNR; ++j) { a[j] = *(const bf16x8*)(ap + (kb + j) * 16); b0[j] = *(const bf16x8*)(b0p + (kb + j) * 16); b1[j] = *(const bf16x8*)(b1p + (kb + j) * 16); }
#pragma unroll
            for (int j = 0; j < UNR; ++j) { c0 = MFMA32(a[j], b0[j], c0); c1 = MFMA32(a[j], b1[j], c1); }
        }
        LAS float* rw = red + wave * 2176;
#pragma unroll
        for (int r = 0; r < 16; ++r) { const int row = (r >> 2) * 8 + hf * 4 + (r & 3); rw[row * 34 + l32] = c0[r]; rw[1088 + row * 34 + l32] = c1[r]; }
        __syncthreads();
        {
            const int row = tid >> 4, cc = (tid & 15) * 2;
            f32x2 g = {0.f, 0.f}, u = {0.f, 0.f};
#pragma unroll
            for (int w = 0; w < 8; ++w) { g += *(const LAS f32x2*)(red + w * 2176 + row * 34 + cc); u += *(const LAS f32x2*)(red + w * 2176 + 1088 + row * 34 + cc); }
            E(rb * 32 + row, n0 + cc, n1 + cc, g, u);
        }
        __syncthreads();
    }
}
struct SEpiQKV {
    bf16_t* QKV; float* out; int layer;
    __device__ __forceinline__ void cols(int cb, int& n0, int& n1) const { n0 = cb * 64; n1 = n0 + 32; }
    __device__ __forceinline__ void emit(int r, int c, f32x2 v) const {
        *(unsigned*)(QKV + (size_t)(MP + r) * INW + c) = pk2(v.x, v.y);
        if (c >= 512 && c < 1536) { const size_t off = (c < 1024 ? OFF_KS : OFF_VS) + ((size_t)layer * MS + r) * 512 + (c & 511); *(f32x2*)(out + off) = v; }
    }
    __device__ __forceinline__ void operator()(int r, int c0, int c1, f32x2 g, f32x2 u) const { emit(r, c0, g); emit(r, c1, u); }
};
struct SEpiResid {
    const float* base; float* Xs; const float* gate;
    __device__ __forceinline__ void cols(int cb, int& n0, int& n1) const { n0 = cb * 64; n1 = n0 + 32; }
    __device__ __forceinline__ void operator()(int r, int c0, int c1, f32x2 g, f32x2 u) const {
        const float* gp = gate + (size_t)(2 + (r >> 5)) * NMOD; const float* bp = base + (size_t)r * DM; float* xp = Xs + (size_t)r * DM;
        const f32x2 x0 = *(const f32x2*)(bp + c0) + *(const f32x2*)(gp + c0) * g, x1 = *(const f32x2*)(bp + c1) + *(const f32x2*)(gp + c1) * u;
        *(f32x2*)(xp + c0) = x0; *(f32x2*)(xp + c1) = x1;
    }
};
struct SEpiSwiGLU {
    bf16_t* ACT;
    __device__ __forceinline__ void cols(int cb, int& n0, int& n1) const { n0 = (cb >> 2) * 256 + (cb & 3) * 32; n1 = n0 + 128; }
    __device__ __forceinline__ void operator()(int r, int c0, int c1, f32x2 g, f32x2 u) const {
        const int col = (c0 >> 8) * 128 + (c0 & 127);
        *(unsigned*)(ACT + (size_t)(MP + r) * DFF + col) = pk2(silu_f(g.x) * u.x, silu_f(g.y) * u.y);
    }
};

__device__ __forceinline__ void transpose_item(const float* W, int K, int N, bf16_t* WT, LAS float* scr, int item, int lane, bool perm) {
    const int nblk = N / 32, kb = item / nblk, nb = item % nblk, k0 = 64 * kb, n0 = 32 * nb;
    int p0 = n0;
    if (perm) { if (n0 < DFF) p0 = (n0 >> 7) * 256 + (n0 & 127); else { const int n1 = n0 - DFF; p0 = (n1 >> 7) * 256 + 128 + (n1 & 127); } }
#pragma unroll 8
    for (int i = 0; i < 32; ++i) { const int kk = 2 * i + (lane >> 5); scr[kk * 33 + (lane & 31)] = W[(size_t)(k0 + kk) * N + n0 + (lane & 31)]; }
    asm volatile("s_waitcnt lgkmcnt(0)" ::: "memory"); __builtin_amdgcn_wave_barrier();
    const int c = lane & 7;
#pragma unroll
    for (int j = 0; j < 4; ++j) { const int n = (lane >> 3) + 8 * j; const LAS float* s = scr + (8 * c) * 33 + n;
        u32x4 o; o.x = pk2(s[0 * 33], s[1 * 33]); o.y = pk2(s[2 * 33], s[3 * 33]); o.z = pk2(s[4 * 33], s[5 * 33]); o.w = pk2(s[6 * 33], s[7 * 33]);
        *(u32x4*)(WT + (size_t)(p0 + n) * K + k0 + 8 * c) = o; }
    asm volatile("s_waitcnt lgkmcnt(0)" ::: "memory"); __builtin_amdgcn_wave_barrier();
}

__device__ __forceinline__ void p0_phase(const Params& P, LAS unsigned char* lds, int tid, int lane, int wave) {
    LAS float* sc = (LAS float*)lds;
    for (int i = tid; i < NBI * DM; i += 512) { const int b = i >> 10, k = i & 1023; const float c = b < 2 ? P.in[5][b * DM + k] : P.in[6][(b - 2) * DM + k]; sc[i] = silu_f(c); }
    __syncthreads();
    const int gw = blockIdx.x * 8 + wave, NGW = gridDim.x * 8;
    float* MOD = (float*)(P.ws + WS_MOD);
    for (int it = gw; it < 768; it += NGW) {
        const int l = it / 192, r = it % 192, cb = r >> 3, kc = r & 7;
        f32x4 acc[NBI];
#pragma unroll
        for (int b = 0; b < NBI; ++b) acc[b] = (f32x4){0.f, 0.f, 0.f, 0.f};
        const float* wp = P.in[9] + ((size_t)l * DM + kc * 128) * NMOD + cb * 256 + lane * 4;
        const LAS float* scp = sc + kc * 128;
#pragma unroll 4
        for (int k = 0; k < 128; ++k) { const f32x4 w = *(const f32x4*)(wp + (size_t)k * NMOD);
#pragma unroll
            for (int b = 0; b < NBI; ++b) acc[b] += scp[b * DM + k] * w; }
        if (kc == 0) { const f32x4 bv = *(const f32x4*)(P.in[10] + (size_t)l * NMOD + cb * 256 + lane * 4);
#pragma unroll
            for (int b = 0; b < NBI; ++b) acc[b] += bv; }
        float* mp = MOD + (size_t)l * NBI * NMOD + cb * 256 + lane * 4;
#pragma unroll
        for (int b = 0; b < NBI; ++b) { atomicAdd(mp + b * NMOD + 0, acc[b].x); atomicAdd(mp + b * NMOD + 1, acc[b].y); atomicAdd(mp + b * NMOD + 2, acc[b].z); atomicAdd(mp + b * NMOD + 3, acc[b].w); }
    }
    LAS float* scr = (LAS float*)(lds + 73728 + wave * 8448);
    constexpr int I_IN = 16 * 112, I_OUT = 16 * 32, I_FI = 16 * 176, I_FO = 44 * 32, I_L = I_IN + I_OUT + I_FI + I_FO;
    for (int it = gw; it < DEPTH * I_L; it += NGW) {
        const int l = it / I_L; int r = it % I_L;
        if (r < I_IN) { transpose_item(P.in[11] + (size_t)l * DM * INW, DM, INW, (bf16_t*)(P.ws + WS_WIN) + (size_t)l * INW * DM, scr, r, lane, false); continue; } r -= I_IN;
        if (r < I_OUT) { transpose_item(P.in[14] + (size_t)l * DM * DM, DM, DM, (bf16_t*)(P.ws + WS_WOUT) + (size_t)l * DM * DM, scr, r, lane, false); continue; } r -= I_OUT;
        if (r < I_FI) { transpose_item(P.in[15] + (size_t)l * DM * 2 * DFF, DM, 2 * DFF, (bf16_t*)(P.ws + WS_WFI) + (size_t)l * 2 * DFF * DM, scr, r, lane, true); continue; } r -= I_FI;
        transpose_item(P.in[16] + (size_t)l * DFF * DM, DFF, DM, (bf16_t*)(P.ws + WS_WFO) + (size_t)l * DM * DFF, scr, r, lane, false);
    }
    f32x2* ROPE = (f32x2*)(P.ws + WS_ROPE);
    for (int idx = blockIdx.x * 512 + tid; idx < SEQ * 64; idx += gridDim.x * 512) {
        const int pos = idx >> 6, i = idx & 63;
        const float inv = exp2f(-(float)i * (13.287712379549449f / 64.f));
        const float ang = (float)pos * inv;
        double rev = (double)ang * 0.15915494309189535; rev -= floor(rev);
        const float rf = (float)rev;
        ROPE[idx] = (f32x2){__builtin_amdgcn_cosf(rf), __builtin_amdgcn_sinf(rf)};
    }
}

template <bool FINAL>
__device__ __forceinline__ void norm_phase(const Params& P, int l, bool from_input, const float* gain, int sh_off, int sc_off, int lane, int wave) {
    const int gw = blockIdx.x * 8 + wave, NGW = gridDim.x * 8;
    const float* MOD = (const float*)(P.ws + WS_MOD) + (size_t)l * NBI * NMOD;
    const float* X = (const float*)(P.ws + WS_X); bf16_t* H = (bf16_t*)(P.ws + WS_H);
    f32x4 g[4];
#pragma unroll
    for (int j = 0; j < 4; ++j) g[j] = *(const f32x4*)(gain + 4 * lane + 256 * j);
    for (int m = gw; m < MT; m += NGW) {
        const float* xr = (!FINAL && from_input) ? (m < MP ? P.in[0] + (size_t)m * DM : P.in[1] + (size_t)(m - MP) * DM) : X + (size_t)m * DM;
        f32x4 v[4]; float ss = 0.f;
#pragma unroll
        for (int j = 0; j < 4; ++j) { v[j] = *(const f32x4*)(xr + 4 * lane + 256 * j); ss += (v[j].x * v[j].x + v[j].y * v[j].y) + (v[j].z * v[j].z + v[j].w * v[j].w); }
        const float rstd = rsqrtf(wave_sum(ss) * (1.f / DM) + EPS);
        if (FINAL) {
            float* o = P.out + (size_t)m * DM;
#pragma unroll
            for (int j = 0; j < 4; ++j) *(f32x4*)(o + 4 * lane + 256 * j) = v[j] * rstd * g[j];
        } else {
            const float* mr = MOD + (size_t)batch_of(m) * NMOD;
#pragma unroll
            for (int j = 0; j < 4; ++j) { const int c = 4 * lane + 256 * j;
                const f32x4 sc = *(const f32x4*)(mr + sc_off + c), sh = *(const f32x4*)(mr + sh_off + c);
                const f32x4 hh = v[j] * rstd * g[j] * (1.f + sc) + sh;
                u32x2 w; w.x = pk2(hh.x, hh.y); w.y = pk2(hh.z, hh.w);
                *(u32x2*)(H + (size_t)m * DM + c) = w; }
        }
    }
}

__device__ __forceinline__ void sb_unit(const Params& P, int l, int u, LAS unsigned char* lds, int tid, int lane, int wave) {
    const bf16_t* QKV = (const bf16_t*)(P.ws + WS_QKV);
    const int h = wave, l32 = lane & 31, hf = lane >> 5;
    const bool samp = u >= 1024;
    int qrow0, nsteps; const float* ck = nullptr; const float* cv = nullptr;
    if (!samp) { const int b = u >> 9, qb = u & 511; qrow0 = b * SEQ + qb * 32; nsteps = qb + 1; }
    else { const int bs = u - 1024; qrow0 = MP + bs * 32; nsteps = 65; ck = P.in[2] + (size_t)(l * DB + bs) * PAST * 512; cv = P.in[3] + (size_t)(l * DB + bs) * PAST * 512; }
    bf16x8 qf[4];
#pragma unroll
    for (int ks = 0; ks < 4; ++ks) qf[ks] = *(const bf16x8*)(QKV + (size_t)(qrow0 + l32) * INW + h * 64 + ks * 16 + hf * 8);
    f32x16 O0, O1;
#pragma unroll
    for (int r = 0; r < 16; ++r) { O0[r] = 0.f; O1[r] = 0.f; }
    float cum = 0.f;
    LAS unsigned char* vt = lds + 66048 + wave * 4608;
    auto issue = [&](int s, bf16x8 (&k)[4], bf16x8 (&v)[4]) {
        if (!samp || s == 0) {
            const int krow0 = samp ? qrow0 : qrow0 - s * 32;
#pragma unroll
            for (int ks = 0; ks < 4; ++ks) k[ks] = *(const bf16x8*)(QKV + (size_t)(krow0 + l32) * INW + 512 + h * 64 + ks * 16 + hf * 8);
#pragma unroll
            for (int it = 0; it < 4; ++it) { const int id = it * 64 + lane, key = id >> 3, ch = id & 7;
                v[it] = *(const bf16x8*)(QKV + (size_t)(krow0 + key) * INW + 1024 + h * 64 + ch * 8); }
        } else {
            const int kpos0 = (64 - s) * 32;
#pragma unroll
            for (int ks = 0; ks < 4; ++ks) { const float* p = ck + (size_t)(kpos0 + l32) * 512 + h * 64 + ks * 16 + hf * 8; k[ks] = pack8(*(const f32x4*)p, *(const f32x4*)(p + 4)); }
#pragma unroll
            for (int it = 0; it < 4; ++it) { const int id = it * 64 + lane, key = id >> 3, ch = id & 7;
                const float* p = cv + (size_t)(kpos0 + key) * 512 + h * 64 + ch * 8;
                v[it] = pack8(*(const f32x4*)p, *(const f32x4*)(p + 4)); }
        }
    };
    bf16x8 kf[4], vr[4];
    issue(0, kf, vr);
    for (int s = 0; s < nsteps; ++s) {
#pragma unroll
        for (int it = 0; it < 4; ++it) { const int id = it * 64 + lane, key = id >> 3, ch = id & 7; *(LAS bf16x8*)(vt + key * 144 + ch * 16) = vr[it]; }
        bf16x8 kn[4];
#pragma unroll
        for (int ks = 0; ks < 4; ++ks) kn[ks] = kf[ks];
        if (s + 1 < nsteps) issue(s + 1, kn, vr);
        asm volatile("s_waitcnt lgkmcnt(0)" ::: "memory"); __builtin_amdgcn_wave_barrier();
        f32x16 S;
#pragma unroll
        for (int r = 0; r < 16; ++r) S[r] = 0.f;
#pragma unroll
        for (int ks = 0; ks < 4; ++ks) S = MFMA32(kf[ks], qf[ks], S);
        float L[16], lb[16]; bool valid[16];
#pragma unroll
        for (int r = 0; r < 16; ++r) {
            const float z = S[r] * 0.125f;
            const float sp = fmaxf(z, 0.f) + __logf(1.f + __expf(-fabsf(z)));
            const int key = (r >> 2) * 8 + hf * 4 + (r & 3);
            valid[r] = (s != 0) || (key < l32);
            L[r] = valid[r] ? -sp : 0.f; lb[r] = z - sp;
        }
        float T[4], Pp[4];
#pragma unroll
        for (int g = 0; g < 4; ++g) { T[g] = (L[4 * g] + L[4 * g + 1]) + (L[4 * g + 2] + L[4 * g + 3]); Pp[g] = __shfl_xor(T[g], 32); }
        float later[4]; float tot = 0.f;
#pragma unroll
        for (int g = 3; g >= 0; --g) { later[g] = tot; tot += T[g] + Pp[g]; }
        float w[16];
#pragma unroll
        for (int g = 0; g < 4; ++g) {
            const float s3 = cum + later[g] + (hf == 0 ? Pp[g] : 0.f);
            const float s2 = s3 + L[4 * g + 3], s1 = s2 + L[4 * g + 2], s0 = s1 + L[4 * g + 1];
            w[4 * g + 3] = valid[4 * g + 3] ? __expf(lb[4 * g + 3] + s3) : 0.f;
            w[4 * g + 2] = valid[4 * g + 2] ? __expf(lb[4 * g + 2] + s2) : 0.f;
            w[4 * g + 1] = valid[4 * g + 1] ? __expf(lb[4 * g + 1] + s1) : 0.f;
            w[4 * g + 0] = valid[4 * g + 0] ? __expf(lb[4 * g + 0] + s0) : 0.f;
        }
        cum += tot;
#pragma unroll
        for (int c = 0; c < 2; ++c) {
            u32x4 pw; pw.x = pk2(w[8 * c], w[8 * c + 1]); pw.y = pk2(w[8 * c + 2], w[8 * c + 3]); pw.z = pk2(w[8 * c + 4], w[8 * c + 5]); pw.w = pk2(w[8 * c + 6], w[8 * c + 7]);
            const bf16x8 pa = __builtin_bit_cast(bf16x8, pw);
#pragma unroll
            for (int dt = 0; dt < 2; ++dt) {
                bf16x8 vb;
#pragma unroll
                for (int i = 0; i < 8; ++i) { const int key = 16 * c + 8 * (i >> 2) + 4 * hf + (i & 3); vb[i] = *(const LAS short*)(vt + key * 144 + (l32 + 32 * dt) * 2); }
                if (dt == 0) O0 = MFMA32(pa, vb, O0); else O1 = MFMA32(pa, vb, O1);
            }
        }
        asm volatile("" ::: "memory");
        if (__all(cum < -110.f)) break;
#pragma unroll
        for (int ks = 0; ks < 4; ++ks) kf[ks] = kn[ks];
    }
    LAS float* oa = (LAS float*)lds;
#pragma unroll
    for (int r = 0; r < 16; ++r) { const int q = (r >> 2) * 8 + hf * 4 + (r & 3); oa[q * 516 + h * 64 + l32] = O0[r]; oa[q * 516 + h * 64 + 32 + l32] = O1[r]; }
    __syncthreads();
    bf16_t* Ob = (bf16_t*)(P.ws + WS_O);
    const float* gsb = P.in[12] + (size_t)l * 512;
    {
        f32x4 ra[4], rb[4]; float sq[4];
#pragma unroll
        for (int rr = 0; rr < 4; ++rr) { const int q = wave * 4 + rr;
            ra[rr] = *(const LAS f32x4*)(oa + q * 516 + 4 * lane); rb[rr] = *(const LAS f32x4*)(oa + q * 516 + 256 + 4 * lane);
            const f32x4 a = ra[rr], b = rb[rr];
            sq[rr] = (a.x * a.x + a.y * a.y) + (a.z * a.z + a.w * a.w) + (b.x * b.x + b.y * b.y) + (b.z * b.z + b.w * b.w); }
#pragma unroll
        for (int o = 1; o < 64; o <<= 1) {
#pragma unroll
            for (int rr = 0; rr < 4; ++rr) sq[rr] += __shfl_xor(sq[rr], o);
        }
        const f32x4 ga = *(const f32x4*)(gsb + 4 * lane), gb = *(const f32x4*)(gsb + 256 + 4 * lane);
#pragma unroll
        for (int rr = 0; rr < 4; ++rr) { const int q = wave * 4 + rr;
            const float rstd = rsqrtf(sq[rr] * (1.f / 512.f) + EPS);
            const f32x4 ya = ra[rr] * rstd * ga, yb = rb[rr] * rstd * gb;
            u32x2 wa, wb; wa.x = pk2(ya.x, ya.y); wa.y = pk2(ya.z, ya.w); wb.x = pk2(yb.x, yb.y); wb.y = pk2(yb.z, yb.w);
            *(u32x2*)(Ob + (size_t)(qrow0 + q) * DM + 4 * lane) = wa; *(u32x2*)(Ob + (size_t)(qrow0 + q) * DM + 256 + 4 * lane) = wb; }
    }
    __syncthreads();
}

__device__ __forceinline__ void ret_unit(const Params& P, int l, LAS unsigned char* lds, int tid, int lane, int wave,
                                         int row0, int pos0, int nchunks, int L, int h, const float* init, float* outst, bool state_only) {
    const bf16_t* QKV = (const bf16_t*)(P.ws + WS_QKV); bf16_t* Ob = (bf16_t*)(P.ws + WS_O);
    const f32x2* ROPE = (const f32x2*)(P.ws + WS_ROPE);
    const float lg2 = log2f(1.f - exp2f(-5.f - (float)h));
    LAS unsigned char *Qn = lds, *Kn = lds + 17408, *KdT = lds + 34816, *VT = lds + 53248, *SbT = lds + 71680, *Pm = lds + 106496;
    LAS float* of = (LAS float*)lds;
    const int l32 = lane & 31, hf = lane >> 5;
    const int sdt = wave >> 1, set0 = (wave & 1) * 2;
    f32x16 S0, S1;
#pragma unroll
    for (int r = 0; r < 16; ++r) { S0[r] = 0.f; S1[r] = 0.f; }
    if (init) {
        const float* ip = init + (sdt * 32 + hf * 4) * 128 + set0 * 32 + l32;
#pragma unroll
        for (int r = 0; r < 16; ++r) { S0[r] = ip[((r >> 2) * 8 + (r & 3)) * 128]; S1[r] = ip[((r >> 2) * 8 + (r & 3)) * 128 + 32]; if ((r & 3) == 3) asm volatile("" ::: "memory"); }
    }
    if (!state_only) {
#pragma unroll
        for (int g = 0; g < 4; ++g) { const int d0 = sdt * 32 + g * 8 + hf * 4;
            u32x2 a, b; a.x = pk2(S0[4 * g], S0[4 * g + 1]); a.y = pk2(S0[4 * g + 2], S0[4 * g + 3]); b.x = pk2(S1[4 * g], S1[4 * g + 1]); b.y = pk2(S1[4 * g + 2], S1[4 * g + 3]);
            *(LAS u32x2*)(SbT + (set0 * 32 + l32) * 272 + d0 * 2) = a; *(LAS u32x2*)(SbT + ((set0 + 1) * 32 + l32) * 272 + d0 * 2) = b; }
    }
    const float gL = exp2f((float)L * lg2);
    const int lt = wave >> 2, et = wave & 3;
    bf16x8 rk1, rk2, rq1, rq2, rv0, rv1; f32x4 rcs[4];
    const bf16x8 z8 = {0, 0, 0, 0, 0, 0, 0, 0};
    auto issue = [&](int c) {
        const int t = tid >> 3, i0 = (tid & 7) * 8; const bool ok = t < L;
        const size_t row = (size_t)(row0 + c * 64 + t);
        rk1 = z8; rk2 = z8; rq1 = z8; rq2 = z8;
#pragma unroll
        for (int i = 0; i < 4; ++i) rcs[i] = (f32x4){0.f, 0.f, 0.f, 0.f};
        if (ok) {
            rk1 = *(const bf16x8*)(QKV + row * INW + 2048 + h * 128 + i0); rk2 = *(const bf16x8*)(QKV + row * INW + 2048 + h * 128 + 64 + i0);
            if (!state_only) { rq1 = *(const bf16x8*)(QKV + row * INW + 1536 + h * 128 + i0); rq2 = *(const bf16x8*)(QKV + row * INW + 1536 + h * 128 + 64 + i0); }
            const f32x4* rp = (const f32x4*)(ROPE + (size_t)(pos0 + c * 64 + t) * 64 + i0);
#pragma unroll
            for (int i = 0; i < 4; ++i) rcs[i] = rp[i];
        }
        const int t0 = tid >> 4, ch = tid & 15;
        rv0 = z8; rv1 = z8;
        if (t0 < L) rv0 = *(const bf16x8*)(QKV + (size_t)(row0 + c * 64 + t0) * INW + 2560 + h * 128 + ch * 8);
        if (t0 + 32 < L) rv1 = *(const bf16x8*)(QKV + (size_t)(row0 + c * 64 + t0 + 32) * INW + 2560 + h * 128 + ch * 8);
    };
    issue(0);
    const int l32_0 = l32, hf_0 = hf, tid_0 = tid; const float lg2_0 = lg2;
#pragma unroll 1
    for (int c = 0; c < nchunks; ++c) {
        int l32 = l32_0, hf = hf_0, tid = tid_0; float lg2 = lg2_0;
        asm volatile("" : "+v"(l32), "+v"(hf), "+v"(tid), "+v"(lg2));
        {
            const int t = tid >> 3, pc = tid & 7, i0 = pc * 8; const bool ok = t < L;
            const float kd = ok ? __builtin_amdgcn_exp2f((float)(L - 1 - t) * lg2) : 0.f;
            const int tsw = (((t >> 3) ^ pc) << 4) + (t & 7) * 2;
            float cs_c[8], cs_s[8];
#pragma unroll
            for (int i = 0; i < 4; ++i) { cs_c[2 * i] = rcs[i].x; cs_s[2 * i] = rcs[i].y; cs_c[2 * i + 1] = rcs[i].z; cs_s[2 * i + 1] = rcs[i].w; }
            {
                float o1[8], o2[8];
#pragma unroll
                for (int i = 0; i < 8; ++i) { const float x1 = bf2f((unsigned short)rk1[i]), x2 = bf2f((unsigned short)rk2[i]);
                    o1[i] = (x1 * cs_c[i] - x2 * cs_s[i]) * 0.08838834764831845f; o2[i] = (x1 * cs_s[i] + x2 * cs_c[i]) * 0.08838834764831845f; }
                if (!state_only) {
                    u32x4 a, b; a.x = pk2(o1[0], o1[1]); a.y = pk2(o1[2], o1[3]); a.z = pk2(o1[4], o1[5]); a.w = pk2(o1[6], o1[7]);
                    b.x = pk2(o2[0], o2[1]); b.y = pk2(o2[2], o2[3]); b.z = pk2(o2[4], o2[5]); b.w = pk2(o2[6], o2[7]);
                    *(LAS u32x4*)(Kn + t * 272 + i0 * 2) = a; *(LAS u32x4*)(Kn + t * 272 + (64 + i0) * 2) = b;
                }
#pragma unroll
                for (int i = 0; i < 8; ++i) { *(LAS unsigned short*)(KdT + (i0 + i) * 144 + tsw) = (unsigned short)f2bf(o1[i] * kd); *(LAS unsigned short*)(KdT + (64 + i0 + i) * 144 + tsw) = (unsigned short)f2bf(o2[i] * kd); }
            }
            if (!state_only) {
                float o1[8], o2[8];
#pragma unroll
                for (int i = 0; i < 8; ++i) { const float x1 = bf2f((unsigned short)rq1[i]), x2 = bf2f((unsigned short)rq2[i]);
                    o1[i] = x1 * cs_c[i] - x2 * cs_s[i]; o2[i] = x1 * cs_s[i] + x2 * cs_c[i]; }
                u32x4 a, b; a.x = pk2(o1[0], o1[1]); a.y = pk2(o1[2], o1[3]); a.z = pk2(o1[4], o1[5]); a.w = pk2(o1[6], o1[7]);
                b.x = pk2(o2[0], o2[1]); b.y = pk2(o2[2], o2[3]); b.z = pk2(o2[4], o2[5]); b.w = pk2(o2[6], o2[7]);
                *(LAS u32x4*)(Qn + t * 272 + i0 * 2) = a; *(LAS u32x4*)(Qn + t * 272 + (64 + i0) * 2) = b;
            }
            {
                const int t0 = tid >> 4, ch = tid & 15, sw = ch & 7;
                const int o0 = (((t0 >> 3) ^ sw) << 4) + (t0 & 7) * 2, o1b = ((((t0 + 32) >> 3) ^ sw) << 4) + (t0 & 7) * 2;
#pragma unroll
                for (int i = 0; i < 8; ++i) { *(LAS short*)(VT + (ch * 8 + i) * 144 + o0) = rv0[i]; *(LAS short*)(VT + (ch * 8 + i) * 144 + o1b) = rv1[i]; }
            }
        }
        if (c + 1 < nchunks) issue(c + 1);
        unsigned gpre[8];
#pragma unroll
        for (int rr = 0; rr < 8; ++rr) { const int t = wave * 8 + rr; gpre[rr] = (!state_only && t < L) ? *(const unsigned*)(QKV + (size_t)(row0 + c * 64 + t) * INW + 3072 + h * 128 + lane * 2) : 0u; }
        __syncthreads();
        f32x16 acc;
        if (!state_only) {
#pragma unroll
            for (int r = 0; r < 16; ++r) acc[r] = 0.f;
#pragma unroll
            for (int ks = 0; ks < 8; ++ks) { const bf16x8 a = *(const LAS bf16x8*)(Qn + (lt * 32 + l32) * 272 + (ks * 16 + hf * 8) * 2), b = *(const LAS bf16x8*)(SbT + (et * 32 + l32) * 272 + (ks * 16 + hf * 8) * 2); acc = MFMA32(a, b, acc); }
#pragma unroll
            for (int r = 0; r < 16; ++r) { const int tl = lt * 32 + (r >> 2) * 8 + hf * 4 + (r & 3); acc[r] *= __builtin_amdgcn_exp2f((float)(tl + 1) * lg2); }
            if (wave < 4) {
                const int slt = wave >> 1, smt = wave & 1;
                f32x16 sc;
#pragma unroll
                for (int r = 0; r < 16; ++r) sc[r] = 0.f;
                if (slt >= smt) {
#pragma unroll
                    for (int ks = 0; ks < 8; ++ks) { const bf16x8 a = *(const LAS bf16x8*)(Qn + (slt * 32 + l32) * 272 + (ks * 16 + hf * 8) * 2), b = *(const LAS bf16x8*)(Kn + (smt * 32 + l32) * 272 + (ks * 16 + hf * 8) * 2); sc = MFMA32(a, b, sc); }
                }
                const int tm = smt * 32 + l32;
#pragma unroll
                for (int r = 0; r < 16; ++r) { const int tl = slt * 32 + (r >> 2) * 8 + hf * 4 + (r & 3);
                    const float p = tl >= tm ? sc[r] * __builtin_amdgcn_exp2f((float)(tl - tm) * lg2) : 0.f;
                    *(LAS unsigned short*)(Pm + tl * 144 + tm * 2) = (unsigned short)f2bf(p); }
            }
            __syncthreads();
#pragma unroll
            for (int ms = 0; ms < 4; ++ms) { const bf16x8 a = *(const LAS bf16x8*)(Pm + (lt * 32 + l32) * 144 + (ms * 16 + hf * 8) * 2), b = *(const LAS bf16x8*)(VT + (et * 32 + l32) * 144 + (((ms * 2 + hf) ^ ((et * 4 + (l32 >> 3)) & 7)) << 4)); acc = MFMA32(a, b, acc); }
#pragma unroll
            for (int r = 0; r < 16; ++r) { const int tl = lt * 32 + (r >> 2) * 8 + hf * 4 + (r & 3); of[tl * 132 + et * 32 + l32] = acc[r]; }
        }
#pragma unroll
        for (int r = 0; r < 16; ++r) { S0[r] *= gL; S1[r] *= gL; }
#pragma unroll
        for (int ts = 0; ts < 4; ++ts) {
            const int cc = ts * 2 + hf, rs = l32 >> 3;
            const bf16x8 a = *(const LAS bf16x8*)(KdT + (sdt * 32 + l32) * 144 + ((cc ^ ((sdt * 4 + rs) & 7)) << 4));
            const bf16x8 b0 = *(const LAS bf16x8*)(VT + (set0 * 32 + l32) * 144 + ((cc ^ ((set0 * 4 + rs) & 7)) << 4)), b1 = *(const LAS bf16x8*)(VT + ((set0 + 1) * 32 + l32) * 144 + ((cc ^ (((set0 + 1) * 4 + rs) & 7)) << 4));
            S0 = MFMA32(a, b0, S0); S1 = MFMA32(a, b1, S1);
        }
        if (!state_only) {
#pragma unroll
            for (int g = 0; g < 4; ++g) { const int d0 = sdt * 32 + g * 8 + hf * 4;
                u32x2 a, b; a.x = pk2(S0[4 * g], S0[4 * g + 1]); a.y = pk2(S0[4 * g + 2], S0[4 * g + 3]); b.x = pk2(S1[4 * g], S1[4 * g + 1]); b.y = pk2(S1[4 * g + 2], S1[4 * g + 3]);
                *(LAS u32x2*)(SbT + (set0 * 32 + l32) * 272 + d0 * 2) = a; *(LAS u32x2*)(SbT + ((set0 + 1) * 32 + l32) * 272 + d0 * 2) = b; }
            __syncthreads();
            const f32x2 gr = *(const f32x2*)(P.in[13] + (size_t)(l * 4 + h) * 128 + lane * 2);
            f32x2 ov[8]; float sq[8];
#pragma unroll
            for (int rr = 0; rr < 8; ++rr) { ov[rr] = *(const LAS f32x2*)(of + (wave * 8 + rr) * 132 + lane * 2); sq[rr] = ov[rr].x * ov[rr].x + ov[rr].y * ov[rr].y; }
#pragma unroll
            for (int o = 1; o < 64; o <<= 1) {
#pragma unroll
                for (int rr = 0; rr < 8; ++rr) sq[rr] += __shfl_xor(sq[rr], o);
            }
#pragma unroll
            for (int rr = 0; rr < 8; ++rr) {
                const int t = wave * 8 + rr;
                if (t < L) {
                    const float rstd = rsqrtf(sq[rr] * (1.f / 128.f) + EPS);
                    const size_t row = (size_t)(row0 + c * 64 + t);
                    const unsigned gg = gpre[rr];
                    const float y0 = ov[rr].x * rstd * gr.x * silu_f(bf2f(gg & 0xffffu)), y1 = ov[rr].y * rstd * gr.y * silu_f(bf2f(gg >> 16));
                    *(unsigned*)(Ob + row * DM + 512 + h * 128 + lane * 2) = pk2(y0, y1);
                }
            }
        }
        __syncthreads();
    }
    if (outst) {
        float* op = outst + (sdt * 32 + hf * 4) * 128 + set0 * 32 + l32;
#pragma unroll
        for (int r = 0; r < 16; ++r) { op[((r >> 2) * 8 + (r & 3)) * 128] = S0[r]; op[((r >> 2) * 8 + (r & 3)) * 128 + 32] = S1[r]; if ((r & 3) == 3) asm volatile("" ::: "memory"); }
    }
}


#define XB_TMO      128
#define XB_XCNT(j)  (256  + 64 * (j))
#define XB_XSUB(j)  (1280 + 64 * (j))
#define XB_XGEN(j)  (2304 + 64 * (j))
#define XB_TOP      3328
#define XB_TOPGEN   3392
#define XCD_BAR_WORDS 3456
#define XB_SPIN_CAP (1u << 18)

__device__ __forceinline__ unsigned xb_ld(unsigned* p)              { return __hip_atomic_load(p, __ATOMIC_RELAXED, __HIP_MEMORY_SCOPE_AGENT); }
__device__ __forceinline__ unsigned xb_add(unsigned* p, unsigned v) { return __hip_atomic_fetch_add(p, v, __ATOMIC_RELAXED, __HIP_MEMORY_SCOPE_AGENT); }
__device__ __forceinline__ unsigned xb_xcc_id() { return (unsigned)__builtin_amdgcn_s_getreg((3 << 11) | 20) & 0xFu; }
#define XB_SPIN(cond, bar) do { unsigned _sp = 0; while (cond) { __builtin_amdgcn_s_sleep(1); \
    if ((++_sp & 255u) == 0u) { if (xb_ld(&(bar)[XB_TMO])) break; if (_sp > XB_SPIN_CAP) { atomicAdd(&(bar)[XB_TMO], 1u); break; } } } } while (0)

struct XcdBarrier {
    unsigned* bar; unsigned x;
    volatile LAS unsigned* st;
};

__device__ __forceinline__ XcdBarrier xcd_barrier_post(unsigned* bar, volatile LAS unsigned* st) {
    XcdBarrier b; b.bar = bar; b.x = xb_xcc_id(); b.st = st;
    if (threadIdx.x == 0) (void)xb_add(&bar[XB_XCNT(b.x)], 1u);
    return b;
}
__device__ __forceinline__ void xcd_barrier_complete(unsigned* bar, unsigned x, unsigned& nloc, unsigned& nx) {
    const unsigned G = gridDim.x * gridDim.y * gridDim.z;
    unsigned sum, cnt, mine, sp = 0u;
    for (;;) {
        sum = 0u; cnt = 0u; mine = 0u;
#pragma unroll
        for (unsigned j = 0; j < 16; ++j) { const unsigned c = xb_ld(&bar[XB_XCNT(j)]); sum += c; cnt += (c > 0u) ? 1u : 0u; mine = (j == x) ? c : mine; }
        if (sum == G) break;
        __builtin_amdgcn_s_sleep(1);
        if ((++sp & 255u) == 0u) { if (xb_ld(&bar[XB_TMO])) break; if (sp > XB_SPIN_CAP) { atomicAdd(&bar[XB_TMO], 1u); break; } }
    }
    nloc = mine > 0u ? mine : 1u; nx = cnt > 0u ? cnt : 1u;
}

__device__ __forceinline__ void xcd_barrier(const XcdBarrier& b) {
    asm volatile("s_waitcnt vmcnt(0)" ::: "memory");
    __syncthreads();
    if (threadIdx.x == 0) {
        unsigned* bar = b.bar;
        __builtin_amdgcn_s_waitcnt(0);
        unsigned nloc = b.st[0], nx = b.st[1];
        if (nloc == 0u) { xcd_barrier_complete(bar, b.x, nloc, nx); b.st[0] = nloc; b.st[1] = nx; }
        const unsigned old = xb_add(&bar[XB_XSUB(b.x)], 1u);
        const unsigned gen = old / nloc;
        if (old + 1u == (gen + 1u) * nloc) {
            __builtin_amdgcn_fence(__ATOMIC_RELEASE, "agent");
            asm volatile("s_waitcnt vmcnt(0)" ::: "memory");
            const unsigned og = xb_add(&bar[XB_TOP], 1u);
            const unsigned tg = og / nx;
            if (og + 1u == (tg + 1u) * nx) xb_add(&bar[XB_TOPGEN], 1u);
            else XB_SPIN(xb_ld(&bar[XB_TOPGEN]) == tg, bar);
            __builtin_amdgcn_fence(__ATOMIC_ACQUIRE, "agent");
            xb_add(&bar[XB_XGEN(b.x)], 1u);
            asm volatile("s_waitcnt vmcnt(0)" ::: "memory");
        } else {
            XB_SPIN(xb_ld(&bar[XB_XGEN(b.x)]) == gen, bar);
            __builtin_amdgcn_fence(__ATOMIC_ACQUIRE, "agent");
            asm volatile("s_waitcnt vmcnt(0)" ::: "memory");
        }
    }
    __syncthreads();
}
__global__ void __launch_bounds__(512, 2) fwd_megakernel(Params P) {
    extern __shared__ __attribute__((aligned(16))) unsigned char lds_raw[];
    LAS unsigned char* lds = (LAS unsigned char*)lds_raw;
    cg::grid_group grid = cg::this_grid();
    int tid = threadIdx.x, lane = tid & 63, wave = __builtin_amdgcn_readfirstlane(tid >> 6);
#define REFRESH() do { tid = threadIdx.x; asm volatile("" : "+v"(tid)); lane = tid & 63; wave = __builtin_amdgcn_readfirstlane(tid >> 6); } while (0)
    const int G = gridDim.x, bx = blockIdx.x;
    bf16_t* H = (bf16_t*)(P.ws + WS_H); bf16_t* Ob = (bf16_t*)(P.ws + WS_O); bf16_t* QKV = (bf16_t*)(P.ws + WS_QKV); bf16_t* ACT = QKV;
    float* X = (float*)(P.ws + WS_X); float* U = (float*)(P.ws + WS_U);
    const float* MOD = (const float*)(P.ws + WS_MOD);

    volatile LAS unsigned* bst = (volatile LAS unsigned*)(lds + LDS_BYTES - 64);
    if (tid == 0) { bst[0] = 0u; bst[1] = 0u; }
    __syncthreads();
    const XcdBarrier xbar = xcd_barrier_post((unsigned*)(P.ws + WS_BAR), bst);
#ifndef SK_P0
    p0_phase(P, lds, tid, lane, wave);
#endif
    grid.sync(); REFRESH();
#pragma unroll 1
    for (int l = 0; l < DEPTH; ++l) {
        norm_phase<false>(P, l, l == 0, P.in[7] + (size_t)l * DM, 0, 1024, lane, wave);
        xcd_barrier(xbar); REFRESH();
#ifndef SK_G1
        {
            pg8::Gemm g{H, (const bf16_t*)(P.ws + WS_WIN) + (size_t)l * INW * DM, MP, INW, DM}; pg8::StaticOrder S; S.init(MP, INW, G, bx);
            EpiQKV E{QKV, P.out, l};
            pg8::gemm_phase<EpiQKV, pg8::StaticOrder, true, true>(lds, g, S, E);
            SEpiQKV SE{QKV, P.out, l};
            sgemm_phase<8, 8, SEpiQKV>(lds, H + (size_t)MP * DM, DM, g.Bt, DM, INW / 64, tid, lane, wave, SE);
        }
#endif
        xcd_barrier(xbar); REFRESH();
        for (int u = bx; u < 1360; u += G) {
#ifndef SK_R1
            if (u < 256) { const int bh = u >> 5, seg = u & 31, b = bh >> 2, h = bh & 3;
                ret_unit(P, l, lds, tid, lane, wave, b * SEQ + seg * 512, seg * 512, 8, 64, h, nullptr, U + (size_t)(bh * 32 + seg) * 16384, true); }
            else
#endif
#ifndef SK_RS
            if (u < 320) { const int idx = u - 256, bs = idx >> 2, h = idx & 3; const size_t so = ((size_t)(l * DB + bs) * 4 + h) * 16384;
                ret_unit(P, l, lds, tid, lane, wave, MP + bs * 32, PAST, 1, 32, h, P.in[4] + so, P.out + OFF_RS + so, false); }
            else
#endif
            {}
#ifndef SK_SB
            if (u >= 320) sb_unit(P, l, u - 320, lds, tid, lane, wave);
#endif
        }
        xcd_barrier(xbar); REFRESH();
        for (int idx = bx * 512 + tid; idx < 8 * 16384; idx += G * 512) {
            const int bh = idx >> 14, within = idx & 16383, h = bh & 3;
            const float g512 = exp2f(512.f * log2f(1.f - exp2f(-5.f - (float)h)));
            float* up = U + (size_t)bh * 32 * 16384 + within; float s = 0.f;
            for (int seg = 0; seg < 32; ++seg) { const float uu = up[(size_t)seg * 16384]; up[(size_t)seg * 16384] = s; s = g512 * s + uu; }
            P.out[OFF_RP + ((size_t)l * 8 + bh) * 16384 + within] = s;
        }
        xcd_barrier(xbar); REFRESH();
#ifndef SK_R3
        for (int u = bx; u < 256; u += G) { const int bh = u >> 5, seg = u & 31, b = bh >> 2, h = bh & 3;
            ret_unit(P, l, lds, tid, lane, wave, b * SEQ + seg * 512, seg * 512, 8, 64, h, U + (size_t)(bh * 32 + seg) * 16384, nullptr, false); }
#endif
        xcd_barrier(xbar); REFRESH();
#ifndef SK_G2
        {
            pg8::Gemm g{Ob, (const bf16_t*)(P.ws + WS_WOUT) + (size_t)l * DM * DM, MP, DM, DM}; pg8::StaticOrder S; S.init(MP, DM, G, bx);
            EpiResid E{l == 0 ? P.in[0] : nullptr, l == 0 ? P.in[1] : nullptr, X, MOD + (size_t)l * NBI * NMOD + 2048};
            pg8::gemm_phase<EpiResid, pg8::StaticOrder, true, true>(lds, g, S, E);
            SEpiResid SE{l == 0 ? P.in[1] : X + (size_t)MP * DM, X + (size_t)MP * DM, MOD + (size_t)l * NBI * NMOD + 2048};
            sgemm_phase<8, 8, SEpiResid>(lds, Ob + (size_t)MP * DM, DM, g.Bt, DM, DM / 64, tid, lane, wave, SE);
        }
#endif
        xcd_barrier(xbar); REFRESH();
        norm_phase<false>(P, l, false, P.in[8] + (size_t)l * DM, 3072, 4096, lane, wave);
        xcd_barrier(xbar); REFRESH();
#ifndef SK_G3
        {
            pg8::Gemm g{H, (const bf16_t*)(P.ws + WS_WFI) + (size_t)l * 2 * DFF * DM, MP, 2 * DFF, DM}; pg8::StaticOrder S; S.init(MP, 2 * DFF, G, bx);
            EpiSwiGLU E{ACT};
            pg8::gemm_phase<EpiSwiGLU, pg8::StaticOrder, true, true>(lds, g, S, E);
            SEpiSwiGLU SE{ACT};
            sgemm_phase<8, 8, SEpiSwiGLU>(lds, H + (size_t)MP * DM, DM, g.Bt, DM, (2 * DFF / 256) * 4, tid, lane, wave, SE);
        }
#endif
        xcd_barrier(xbar); REFRESH();
#ifndef SK_G4
        {
            pg8::Gemm g{ACT, (const bf16_t*)(P.ws + WS_WFO) + (size_t)l * DM * DFF, MP, DM, DFF}; pg8::StaticOrder S; S.init(MP, DM, G, bx);
            EpiResid E{nullptr, nullptr, X, MOD + (size_t)l * NBI * NMOD + 5120};
            pg8::gemm_phase<EpiResid, pg8::StaticOrder, true, true>(lds, g, S, E);
            SEpiResid SE{X + (size_t)MP * DM, X + (size_t)MP * DM, MOD + (size_t)l * NBI * NMOD + 5120};
            sgemm_phase<22, 11, SEpiResid>(lds, ACT + (size_t)MP * DFF, DFF, g.Bt, DFF, DM / 64, tid, lane, wave, SE);
        }
#endif
        xcd_barrier(xbar); REFRESH();
    }
    norm_phase<true>(P, 0, false, P.in[17], 0, 0, lane, wave);
}

extern "C" void kernel_launch(void* const* d_in, const int* in_sizes, int n_in, void* d_out, int out_size, void* d_ws, size_t ws_size, hipStream_t stream) {
    static int grid = 0;
    if (grid == 0) {
        if (n_in != 18 || ws_size < WS_END) { fprintf(stderr, "kernel_launch: unexpected n_in %d / ws_size %zu\n", n_in, ws_size); grid = -1; return; }
        int dev = 0, cus = 0, per_cu = 0;
        (void)hipGetDevice(&dev); (void)hipDeviceGetAttribute(&cus, hipDeviceAttributeMultiprocessorCount, dev);
        if (hipFuncSetAttribute((const void*)fwd_megakernel, hipFuncAttributeMaxDynamicSharedMemorySize, LDS_BYTES) != hipSuccess) { fprintf(stderr, "kernel_launch: hipFuncSetAttribute failed\n"); grid = -1; return; }
        (void)hipOccupancyMaxActiveBlocksPerMultiprocessor(&per_cu, (const void*)fwd_megakernel, 512, LDS_BYTES);
        (void)hipGetLastError();
        if (per_cu < 1) { fprintf(stderr, "kernel_launch: occupancy query says %d blocks per CU\n", per_cu); per_cu = 1; }
        grid = cus;
    }
    if (grid < 0) return;
    (void)hipMemsetAsync((char*)d_ws + WS_MOD, 0, MOD_BYTES, stream);
    Params p{};
    for (int i = 0; i < 18; ++i) p.in[i] = (const float*)d_in[i];
    p.out = (float*)d_out; p.ws = (unsigned char*)d_ws;
    void* args[] = {&p};
    hipError_t e = hipLaunchCooperativeKernel((const void*)fwd_megakernel, dim3(grid), dim3(512), args, LDS_BYTES, stream);
    if (e != hipSuccess) fprintf(stderr, "cooperative launch failed: %s (grid %d)\n", hipGetErrorString(e), grid);
}
```

```cpp
#include <hip/hip_runtime.h>
#include <hip/hip_cooperative_groups.h>
#include <cstdio>
#include <cstdint>
namespace cg = cooperative_groups;
namespace pg8 {
#define PG8_LAS __attribute__((address_space(3)))
typedef unsigned short bf16_t;
typedef short bf16x8 __attribute__((ext_vector_type(8)));
typedef float f32x4 __attribute__((ext_vector_type(4)));
typedef unsigned u32x4 __attribute__((ext_vector_type(4)));
constexpr int BM = 256, BK = 64, HALF = 128, HTB = HALF * BK * 2  , STAGE_BYTES = 8 * HTB, NXCD = 8, WGM = 8;

__host__ __device__ __forceinline__ int lds_byte(int r, int c) { const int st = (r >> 4) * 2 + (c >> 5), rr = r & 15, cc = c & 31, ob = rr * 64 + cc * 2; return st * 1024 + (ob ^ (((ob >> 9) & 1) << 5)); }
__host__ __device__ __forceinline__ void stage_rc(int b, int& R, int& C) { const int st = b / 1024, sb = b % 1024, swz = sb ^ (((sb >> 9) & 1) << 5); R = (st >> 1) * 16 + swz / 64; C = (st & 1) * 32 + (swz % 64) / 2; }
__host__ __device__ __forceinline__ int perm32(int rho) { const int n = rho >> 4, i = rho & 15; return 8 * (i >> 2) + 4 * n + (i & 3); }

struct Unit { int pm, pn; };
struct Gemm { const bf16_t* A; const bf16_t* Bt; int M, N, K; };

struct StaticOrder {
    int nM, nN, nwg, G, c;
    __host__ __device__ void init(int M, int N, int G_, int c_) { nM = M / BM; nN = N / BM; nwg = nM * nN; G = G_; c = c_; }
    __host__ __device__ bool next(int i, Unit& u) const {
        const long L = (long)i * G + c; if (L >= nwg) return false;
        int wgid = (int)L; { const int q = nwg / NXCD, r = nwg % NXCD, xcd = wgid % NXCD, off = wgid / NXCD; wgid = (xcd < r ? xcd * (q + 1) : r * (q + 1) + (xcd - r) * q) + off; }
        const int nig = WGM * nN, gid = wgid / nig, fm = gid * WGM, gsz = (nM - fm) < WGM ? (nM - fm) : WGM;
        u.pm = fm + ((wgid % nig) % gsz); u.pn = (wgid % nig) / gsz; return true;
    }
    __device__ __forceinline__ void a_ready(const Unit&) const {}
    __device__ __forceinline__ void done(const Unit&) const {}
};

__device__ __forceinline__ unsigned cvt_pk_bf16(float lo, float hi) { unsigned r; asm volatile("v_cvt_pk_bf16_f32 %0, %1, %2" : "=v"(r) : "v"(lo), "v"(hi)); return r; }
typedef float f32x2 __attribute__((ext_vector_type(2)));
__device__ __forceinline__ f32x2 gelu_pk(f32x2 v) {
    const f32x2 av = __builtin_elementwise_abs(v), d = av * 0.2316418882f + 1.0f;
    f32x2 t; t.x = __builtin_amdgcn_rcpf(d.x); t.y = __builtin_amdgcn_rcpf(d.y);
    f32x2 q = t * 0.5307027145f + (-0.7265760135f); q = q * t + 0.7107068705f; q = q * t + (-0.142248368f); q = q * t + 0.127414796f; q = q * t;
    const f32x2 s = (v * v) * (-0.72134752044f);
    f32x2 e; e.x = __builtin_amdgcn_exp2f(s.x); e.y = __builtin_amdgcn_exp2f(s.y);
    const f32x2 m = v * (q * e), r = v - m;
    f32x2 o; o.x = v.x < 0.f ? m.x : r.x; o.y = v.y < 0.f ? m.y : r.y; return o;
}

template <int ACT  > struct EpiBf16 {
    static constexpr bool PERM = true, AFTER_DRAIN = false; static_assert(ACT == 0 || ACT == 1, "EpiBf16: ACT is 0 (none) or 1 (gelu_pk)");
    bf16_t* O; int ldc; const float* bias; int split_cols; size_t split_stride; float scale0;
    __device__ __forceinline__ void operator()(const f32x4 (&acc)[2][2][4][2], const Unit& u, int wr, int wc, int fr, int fq) const {
        const int row0 = u.pm * BM + wr * 64 + fr; int colt = u.pn * BM; bf16_t* base = O;
        float sc = 1.f; if (split_cols) { const int t = colt / split_cols; base += (size_t)t * split_stride; colt -= t * split_cols; if (t == 0) sc = scale0; }
        const int col0 = colt + wc * 32 + 8 * fq, bcol0 = u.pn * BM + wc * 32 + 8 * fq;
        f32x4 bv[2][2];
#pragma unroll
        for (int bj = 0; bj < 2; ++bj)
#pragma unroll
            for (int n = 0; n < 2; ++n) bv[bj][n] = bias ? *(const f32x4*)(bias + bcol0 + bj * HALF + 4 * n) : (f32x4){0.f, 0.f, 0.f, 0.f};
#pragma unroll
        for (int ai = 0; ai < 2; ++ai)
#pragma unroll
            for (int m = 0; m < 4; ++m) { bf16_t* rowp = base + (size_t)(row0 + ai * HALF + m * 16) * ldc + col0;
#pragma unroll
                for (int bj = 0; bj < 2; ++bj) { f32x4 v0 = acc[ai][bj][m][0] + bv[bj][0], v1 = acc[ai][bj][m][1] + bv[bj][1];
                    if (ACT == 1) { f32x2 a = gelu_pk((f32x2){v0[0], v0[1]}), b = gelu_pk((f32x2){v0[2], v0[3]}), c = gelu_pk((f32x2){v1[0], v1[1]}), d = gelu_pk((f32x2){v1[2], v1[3]});
                        v0 = (f32x4){a.x, a.y, b.x, b.y}; v1 = (f32x4){c.x, c.y, d.x, d.y}; }
                    v0 = v0 * sc; v1 = v1 * sc; u32x4 w; w.x = cvt_pk_bf16(v0[0], v0[1]); w.y = cvt_pk_bf16(v0[2], v0[3]); w.z = cvt_pk_bf16(v1[0], v1[1]); w.w = cvt_pk_bf16(v1[2], v1[3]);
                    *(u32x4*)(rowp + bj * HALF) = w; } }
    }
};
template <class Epi, class Sched, bool ALIGN_EPI = false, bool SP2 = false>
__device__ __forceinline__ void gemm_phase(PG8_LAS unsigned char* lds, const Gemm g, const Sched& S, const Epi& E) {
    int tid_o = threadIdx.x; asm volatile("" : "+v"(tid_o));
    const int tid = tid_o, wid = __builtin_amdgcn_readfirstlane(tid >> 6), lane = tid & 63, wr = wid >> 2, wc = wid & 3, fr = lane & 15, fq = lane >> 4;
    const int K = g.K, nt = K / BK;
    unsigned voffA[2], voffB[2];
#pragma unroll
    for (int i = 0; i < 2; ++i) { int R, C; stage_rc(tid * 16 + i * 8192, R, C); const int Rb = Epi::PERM ? ((R & ~31) + perm32(R & 31)) : R;
        voffA[i] = (unsigned)(R * K + C) * 2u; voffB[i] = (unsigned)(Rb * K + C) * 2u; }
    const size_t kstep = (size_t)(BK * 2);
    const size_t hstep = (size_t)HALF * K * 2;
    const size_t tstep = 2 * hstep;
    const unsigned ldsw = (unsigned)wid * 1024u;
    const int aoff = lds_byte(wr * 64 + fr, fq * 8), boff = lds_byte(wc * 32 + fr, fq * 8);
#define PG8_SA(b, h) (((b) * 2 + (h)) * HTB)
#define PG8_SB(b, h) ((4 + (b) * 2 + (h)) * HTB)
#define PG8_STAGE(bufoff, gbase, voff) do { _Pragma("unroll") for (int _i = 0; _i < 2; ++_i) \
        __builtin_amdgcn_global_load_lds((const unsigned*)((const char*)(gbase) + (voff)[_i]), (PG8_LAS unsigned*)(lds + (bufoff) + ldsw + _i * 8192), 16, 0, 0); } while (0)
#define PG8_LDA(dst, b, h) do { _Pragma("unroll") for (int m = 0; m < 4; ++m) _Pragma("unroll") for (int k = 0; k < 2; ++k) dst[m][k] = *(const PG8_LAS bf16x8*)(lds + PG8_SA(b, h) + aoff + m * 2048 + k * 1024); } while (0)
#define PG8_LDB(dst, b, h) do { _Pragma("unroll") for (int n = 0; n < 2; ++n) _Pragma("unroll") for (int k = 0; k < 2; ++k) dst[n][k] = *(const PG8_LAS bf16x8*)(lds + PG8_SB(b, h) + boff + n * 2048 + k * 1024); } while (0)
#define PG8_MMA(ai, bj, At, Bt) do { __builtin_amdgcn_s_setprio(1); _Pragma("unroll") for (int m = 0; m < 4; ++m) _Pragma("unroll") for (int n = 0; n < 2; ++n) _Pragma("unroll") for (int k = 0; k < 2; ++k) \
        acc[ai][bj][m][n] = __builtin_amdgcn_mfma_f32_16x16x32_bf16(Bt[n][k], At[m][k], acc[ai][bj][m][n], 0, 0, 0); __builtin_amdgcn_s_setprio(0); } while (0)
#define PG8_WAIT_V(n) asm volatile("s_waitcnt vmcnt(" #n ")" ::: "memory")
#define PG8_WAIT_L(n) asm volatile("s_waitcnt lgkmcnt(" #n ")" ::: "memory")
#define PG8_BAR __builtin_amdgcn_s_barrier()
#define PG8_SCHED __builtin_amdgcn_sched_barrier(0)
    Unit cur, nxt; int ui = 0;
    if (!S.next(0, cur)) return;
    f32x4 acc[2][2][4][2];
#pragma unroll
    for (int a = 0; a < 2; ++a)
#pragma unroll
        for (int b = 0; b < 2; ++b)
#pragma unroll
            for (int m = 0; m < 4; ++m)
#pragma unroll
                for (int n = 0; n < 2; ++n) acc[a][b][m][n] = (f32x4){0.f, 0.f, 0.f, 0.f};
    bf16x8 At[4][2], B0[2][2], B1[2][2];
    const char* cA = (const char*)g.A + (size_t)cur.pm * tstep; const char* cB = (const char*)g.Bt + (size_t)cur.pn * tstep;
    S.a_ready(cur);
    if constexpr (SP2) {
        PG8_STAGE(PG8_SB(0, 0), cB, voffB); PG8_STAGE(PG8_SB(0, 1), cB + hstep, voffB); PG8_STAGE(PG8_SA(0, 0), cA, voffA); PG8_STAGE(PG8_SA(0, 1), cA + hstep, voffA);
        if (wr == 1) PG8_BAR;
        PG8_WAIT_V(2); PG8_BAR;
        PG8_STAGE(PG8_SB(1, 0), cB + kstep, voffB); PG8_STAGE(PG8_SA(1, 0), cA + kstep, voffA); PG8_STAGE(PG8_SB(1, 1), cB + hstep + kstep, voffB);
        PG8_WAIT_V(6); PG8_BAR;
    } else {
        PG8_STAGE(PG8_SB(0, 0), cB, voffB); PG8_STAGE(PG8_SA(0, 0), cA, voffA); PG8_STAGE(PG8_SB(0, 1), cB + hstep, voffB); PG8_STAGE(PG8_SA(0, 1), cA + hstep, voffA);
        if (wr == 1) PG8_BAR;
        PG8_WAIT_V(4); PG8_BAR;
        PG8_STAGE(PG8_SB(1, 0), cB + kstep, voffB); PG8_STAGE(PG8_SA(1, 0), cA + kstep, voffA); PG8_STAGE(PG8_SB(1, 1), cB + hstep + kstep, voffB);
        PG8_WAIT_V(6); PG8_BAR;
    }
    for (;;) {
        const bool has_next = S.next(ui + 1, nxt);
        const char* nA = has_next ? (const char*)g.A + (size_t)nxt.pm * tstep : cA; const char* nB = has_next ? (const char*)g.Bt + (size_t)nxt.pn * tstep : cB;
        for (int t = 0; t < nt; t += 2) {
            const bool last = (t == nt - 2);
            const char* a1 = cA + (size_t)(t + 1) * kstep;
            const char* a2 = last ? nA : cA + (size_t)(t + 2) * kstep; const char* b2 = last ? nB : cB + (size_t)(t + 2) * kstep;
            const char* a3 = a2 + kstep; const char* b3 = b2 + kstep;
            if (last && has_next) S.a_ready(nxt);
            if constexpr (SP2) {
            PG8_LDB(B0, 0, 0); PG8_LDB(B1, 0, 1); PG8_SCHED; PG8_LDA(At, 0, 0); PG8_STAGE(PG8_SA(1, 1), a1 + hstep, voffA);
            PG8_WAIT_V(8); PG8_WAIT_L(0); PG8_BAR; PG8_MMA(0, 0, At, B0); PG8_MMA(0, 1, At, B1); PG8_BAR; PG8_SCHED;
            PG8_LDA(At, 0, 1); PG8_STAGE(PG8_SB(0, 0), b2, voffB); PG8_STAGE(PG8_SB(0, 1), b2 + hstep, voffB); PG8_STAGE(PG8_SA(0, 0), a2, voffA);
            PG8_WAIT_V(8); PG8_WAIT_L(0); PG8_BAR; PG8_MMA(1, 0, At, B0); PG8_MMA(1, 1, At, B1); PG8_BAR; PG8_SCHED;
            PG8_LDB(B0, 1, 0); PG8_LDB(B1, 1, 1); PG8_SCHED; PG8_LDA(At, 1, 0); PG8_STAGE(PG8_SA(0, 1), a2 + hstep, voffA);
            PG8_WAIT_V(8); PG8_WAIT_L(0); PG8_BAR; PG8_MMA(0, 0, At, B0); PG8_MMA(0, 1, At, B1); PG8_BAR; PG8_SCHED;
            PG8_LDA(At, 1, 1); PG8_STAGE(PG8_SB(1, 0), b3, voffB); PG8_STAGE(PG8_SB(1, 1), b3 + hstep, voffB); PG8_STAGE(PG8_SA(1, 0), a3, voffA);
            PG8_WAIT_V(8); PG8_WAIT_L(0); PG8_BAR; PG8_MMA(1, 0, At, B0); PG8_MMA(1, 1, At, B1); PG8_BAR; PG8_SCHED;
            } else {
            PG8_LDB(B0, 0, 0); PG8_SCHED; PG8_LDA(At, 0, 0); PG8_STAGE(PG8_SA(1, 1), a1 + hstep, voffA);
            PG8_WAIT_L(8); PG8_BAR; PG8_WAIT_L(0); PG8_MMA(0, 0, At, B0); PG8_BAR; PG8_SCHED;
            PG8_LDB(B1, 0, 1); PG8_STAGE(PG8_SB(0, 0), b2, voffB);
            PG8_BAR; PG8_WAIT_L(0); PG8_MMA(0, 1, At, B1); PG8_BAR;
            PG8_LDA(At, 0, 1); PG8_STAGE(PG8_SA(0, 0), a2, voffA);
            PG8_BAR; PG8_WAIT_L(0); PG8_MMA(1, 0, At, B0); PG8_BAR; PG8_SCHED;
            PG8_STAGE(PG8_SB(0, 1), b2 + hstep, voffB);
            PG8_WAIT_V(6); PG8_BAR; PG8_MMA(1, 1, At, B1); PG8_BAR;
            PG8_LDB(B0, 1, 0); PG8_SCHED; PG8_LDA(At, 1, 0); PG8_STAGE(PG8_SA(0, 1), a2 + hstep, voffA);
            PG8_WAIT_L(8); PG8_BAR; PG8_WAIT_L(0); PG8_MMA(0, 0, At, B0); PG8_BAR; PG8_SCHED;
            PG8_LDB(B1, 1, 1); PG8_STAGE(PG8_SB(1, 0), b3, voffB);
            PG8_BAR; PG8_WAIT_L(0); PG8_MMA(0, 1, At, B1); PG8_BAR;
            PG8_LDA(At, 1, 1); PG8_STAGE(PG8_SA(1, 0), a3, voffA);
            PG8_BAR; PG8_WAIT_L(0); PG8_MMA(1, 0, At, B0); PG8_BAR; PG8_SCHED;
            PG8_STAGE(PG8_SB(1, 1), b3 + hstep, voffB);
            PG8_WAIT_V(6); PG8_BAR; PG8_MMA(1, 1, At, B1); PG8_BAR;
            }
        }
        if constexpr (ALIGN_EPI) { if (wr == 0) PG8_BAR; }
        if constexpr (!Epi::AFTER_DRAIN) { E(acc, cur, wr, wc, fr, fq); S.done(cur); }
        if (!has_next) break;
#pragma unroll
        for (int a = 0; a < 2; ++a)
#pragma unroll
            for (int b = 0; b < 2; ++b)
#pragma unroll
                for (int m = 0; m < 4; ++m)
#pragma unroll
                    for (int n = 0; n < 2; ++n) acc[a][b][m][n] = (f32x4){0.f, 0.f, 0.f, 0.f};
        cur = nxt; cA = nA; cB = nB; ++ui;
        if constexpr (ALIGN_EPI) { if (wr == 1) PG8_BAR; }
    }
    PG8_WAIT_V(0);
    if constexpr (!ALIGN_EPI) { if (wr == 0) PG8_BAR; }
    PG8_BAR;
    if constexpr (Epi::AFTER_DRAIN) { E.fused(acc, cur, wr, wc, fr, fq, lds, wid, lane); S.done(cur); }
#undef PG8_SA
#undef PG8_SB
#undef PG8_STAGE
#undef PG8_LDA
#undef PG8_LDB
#undef PG8_MMA
#undef PG8_WAIT_V
#undef PG8_WAIT_L
#undef PG8_BAR
#undef PG8_SCHED
}
}

#define LAS __attribute__((address_space(3)))
typedef unsigned short bf16_t;
typedef short bf16x8 __attribute__((ext_vector_type(8)));
typedef float f32x4 __attribute__((ext_vector_type(4)));
typedef float f32x2 __attribute__((ext_vector_type(2)));
typedef float f32x16 __attribute__((ext_vector_type(16)));
typedef unsigned u32x4 __attribute__((ext_vector_type(4)));
typedef unsigned u32x2 __attribute__((ext_vector_type(2)));
#define MFMA32(a, b, c) __builtin_amdgcn_mfma_f32_32x32x16_bf16((a), (b), (c), 0, 0, 0)

constexpr int DM = 1024, SEQ = 16384, NBP = 2, DEPTH = 4, DB = 16, DS = 32, PAST = 2048;
constexpr int MP = NBP * SEQ, MS = DB * DS, MT = MP + MS;
constexpr int INW = 3584, DFF = 2816, NMOD = 6144, NBI = 18;
constexpr float EPS = 1e-6f;
constexpr size_t OFF_YP = 0, OFF_YS = 33554432, OFF_KP = 34078720, OFF_VP = 101187584, OFF_RP = 168296448,
                 OFF_KS = 168820736, OFF_VS = 169869312, OFF_RS = 170917888;
constexpr size_t MiB = 1u << 20;
constexpr size_t WS_MOD = 0, MOD_BYTES = 2 * MiB; constexpr size_t WS_CTR = 1820160;
constexpr size_t WS_BAR = 1802240;
constexpr size_t WS_ROPE = 2 * MiB;
constexpr size_t WS_WIN = 10 * MiB, WS_WOUT = 38 * MiB, WS_WFI = 46 * MiB, WS_WFO = 90 * MiB;
constexpr size_t WS_X = 112 * MiB;
constexpr size_t WS_H = 242 * MiB;
constexpr size_t WS_O = 307 * MiB;
constexpr size_t WS_QKV = 372 * MiB;
constexpr size_t WS_U = 600 * MiB;
constexpr size_t WS_END = 616 * MiB;
constexpr int LDS_BYTES = 147456;

struct Params { const float* in[18]; float* out; unsigned char* ws; };

typedef __bf16 bf16x2_t __attribute__((ext_vector_type(2)));
__device__ __forceinline__ unsigned pk2(float lo, float hi) { const f32x2 v = {lo, hi}; return __builtin_bit_cast(unsigned, __builtin_convertvector(v, bf16x2_t)); }
__device__ __forceinline__ unsigned f2bf(float f) { return pk2(f, 0.f) & 0xffffu; }
__device__ __forceinline__ float bf2f(unsigned h) { return __builtin_bit_cast(float, h << 16); }
__device__ __forceinline__ bf16x8 pack8(f32x4 a, f32x4 b) { u32x4 p; p.x = pk2(a.x, a.y); p.y = pk2(a.z, a.w); p.z = pk2(b.x, b.y); p.w = pk2(b.z, b.w); return __builtin_bit_cast(bf16x8, p); }
__device__ __forceinline__ float wave_sum(float v) {
#pragma unroll
    for (int o = 1; o < 64; o <<= 1) v += __shfl_xor(v, o);
    return v;
}
__device__ __forceinline__ float silu_f(float x) { return x * __builtin_amdgcn_rcpf(1.f + __expf(-x)); }
__device__ __forceinline__ int batch_of(int row) { return row < MP ? (row >> 14) : 2 + ((row - MP) >> 5); }

struct EpiQKV {
    static constexpr bool PERM = true, AFTER_DRAIN = false;
    bf16_t* QKV; float* out; int layer;
    __device__ __forceinline__ void operator()(const pg8::f32x4 (&acc)[2][2][4][2], const pg8::Unit& u, int wr, int wc, int fr, int fq) const {
        const int row0 = u.pm * 256 + wr * 64 + fr, col0 = u.pn * 256 + wc * 32 + 8 * fq;
        const bool kv = (u.pn >= 2 && u.pn < 6);
        const size_t vsel = (u.pn >= 4) ? 1 : 0;
        const size_t obase = (u.pm < 128) ? OFF_KP + vsel * (OFF_VP - OFF_KP) + (size_t)layer * MP * 512 + (size_t)row0 * 512
                                          : OFF_KS + vsel * (OFF_VS - OFF_KS) + (size_t)layer * MS * 512 + (size_t)(row0 - MP) * 512;
#pragma unroll
        for (int ai = 0; ai < 2; ++ai)
#pragma unroll
            for (int m = 0; m < 4; ++m) {
                const int row = row0 + ai * 128 + m * 16;
#pragma unroll
                for (int bj = 0; bj < 2; ++bj) {
                    const int col = col0 + bj * 128;
                    const pg8::f32x4 v0 = acc[ai][bj][m][0], v1 = acc[ai][bj][m][1];
                    u32x4 w; w.x = pg8::cvt_pk_bf16(v0[0], v0[1]); w.y = pg8::cvt_pk_bf16(v0[2], v0[3]); w.z = pg8::cvt_pk_bf16(v1[0], v1[1]); w.w = pg8::cvt_pk_bf16(v1[2], v1[3]);
                    *(u32x4*)(QKV + (size_t)row * INW + col) = w;
                    if (kv) {
                        const int c = col & 511;
                        float* dst = out + obase + (size_t)(ai * 128 + m * 16) * 512 + c;
                        *(pg8::f32x4*)dst = v0; *(pg8::f32x4*)(dst + 4) = v1;
                    }
                }
                asm volatile("" ::: "memory");
            }
    }
};
struct EpiResid {
    static constexpr bool PERM = false, AFTER_DRAIN = false;
    const float* base_p; const float* base_s;
    float* X; const float* gate;
    __device__ __forceinline__ void operator()(const pg8::f32x4 (&acc)[2][2][4][2], const pg8::Unit& u, int wr, int wc, int fr, int fq) const {
        const int col0 = u.pn * 256 + wc * 32 + 4 * fq;
        const bool uni = u.pm < 128;
        pg8::f32x4 gv[4];
        { const float* gr = gate + (size_t)batch_of(u.pm * 256 + wr * 64 + fr) * NMOD;
#pragma unroll
          for (int q = 0; q < 4; ++q) gv[q] = *(const pg8::f32x4*)(gr + col0 + (q >> 1) * 128 + (q & 1) * 16); }
#pragma unroll
        for (int grp = 0; grp < 4; ++grp) {
            const int ai = grp >> 1, m0 = (grp & 1) * 2;
            pg8::f32x4 bv[2][4];
#pragma unroll
            for (int mm = 0; mm < 2; ++mm) {
                const int row = u.pm * 256 + ai * 128 + wr * 64 + (m0 + mm) * 16 + fr;
                const float* br = base_p ? (row < MP ? base_p + (size_t)row * DM : base_s + (size_t)(row - MP) * DM) : X + (size_t)row * DM;
#pragma unroll
                for (int q = 0; q < 4; ++q) bv[mm][q] = *(const pg8::f32x4*)(br + col0 + (q >> 1) * 128 + (q & 1) * 16);
            }
#pragma unroll
            for (int mm = 0; mm < 2; ++mm) {
                const int m = m0 + mm, row = u.pm * 256 + ai * 128 + wr * 64 + m * 16 + fr;
                if (!uni) { const float* gr = gate + (size_t)batch_of(row) * NMOD;
#pragma unroll
                    for (int q = 0; q < 4; ++q) gv[q] = *(const pg8::f32x4*)(gr + col0 + (q >> 1) * 128 + (q & 1) * 16); }
                float* xr = X + (size_t)row * DM;
#pragma unroll
                for (int q = 0; q < 4; ++q) { const int bj = q >> 1, n = q & 1;
                    *(pg8::f32x4*)(xr + col0 + bj * 128 + n * 16) = bv[mm][q] + gv[q] * acc[ai][bj][m][n]; }
            }
            asm volatile("" ::: "memory");
        }
    }
};
struct EpiSwiGLU {
    static constexpr bool PERM = true, AFTER_DRAIN = false;
    bf16_t* ACT;
    __device__ __forceinline__ void operator()(const pg8::f32x4 (&acc)[2][2][4][2], const pg8::Unit& u, int wr, int wc, int fr, int fq) const {
        const int col0 = u.pn * 128 + wc * 32 + 8 * fq;
#pragma unroll
        for (int ai = 0; ai < 2; ++ai)
#pragma unroll
            for (int m = 0; m < 4; ++m) {
                const int row = u.pm * 256 + ai * 128 + wr * 64 + m * 16 + fr;
                const pg8::f32x4 g0 = acc[ai][0][m][0], g1 = acc[ai][0][m][1], u0 = acc[ai][1][m][0], u1 = acc[ai][1][m][1];
                float r[8];
#pragma unroll
                for (int j = 0; j < 4; ++j) { r[j] = silu_f(g0[j]) * u0[j]; r[4 + j] = silu_f(g1[j]) * u1[j]; }
                u32x4 w; w.x = pg8::cvt_pk_bf16(r[0], r[1]); w.y = pg8::cvt_pk_bf16(r[2], r[3]); w.z = pg8::cvt_pk_bf16(r[4], r[5]); w.w = pg8::cvt_pk_bf16(r[6], r[7]);
                *(u32x4*)(ACT + (size_t)row * DFF + col0) = w;
                asm volatile("" ::: "memory");
            }
    }
};


template <int NKS  , int UNR, class Epi>
__device__ __forceinline__ void sgemm_phase(LAS unsigned char* lds, const bf16_t* A  , int lda, const bf16_t* Bt, int K, int ncb,
                                            int tid, int lane, int wave, const Epi& E) {
    const int l32 = lane & 31, hf = lane >> 5;
    LAS float* red = (LAS float*)lds;
    const int kw0 = wave * NKS * 16 + hf * 8;
    for (int it = blockIdx.x; it < 16 * ncb; it += gridDim.x) {
        const int rb = it & 15, cb = it >> 4;
        int n0, n1; E.cols(cb, n0, n1);
        const bf16_t* ap = A + (size_t)(rb * 32 + l32) * lda + kw0;
        const bf16_t* b0p = Bt + (size_t)(n0 + l32) * K + kw0;
        const bf16_t* b1p = Bt + (size_t)(n1 + l32) * K + kw0;
        f32x16 c0, c1;
#pragma unroll
        for (int r = 0; r < 16; ++r) { c0[r] = 0.f; c1[r] = 0.f; }
#pragma unroll 1
        for (int kb = 0; kb < NKS; kb += UNR) {
            bf16x8 a[UNR], b0[UNR], b1[UNR];
#pragma unroll
            for (int j = 0; j < UNR; ++j) { a[j] = *(const bf16x8*)(ap + (kb + j) * 16); b0[j] = *(const bf16x8*)(b0p + (kb + j) * 16); b1[j] = *(const bf16x8*)(b1p + (kb + j) * 16); }
#pragma unroll
            for (int j = 0; j < UNR; ++j) { c0 = MFMA32(a[j], b0[j], c0); c1 = MFMA32(a[j], b1[j], c1); }
        }
        LAS float* rw = red + wave * 2176;
#pragma unroll
        for (int r = 0; r < 16; ++r) { const int row = (r >> 2) * 8 + hf * 4 + (r & 3); rw[row * 34 + l32] = c0[r]; rw[1088 + row * 34 + l32] = c1[r]; }
        __syncthreads();
        {
            const int row = tid >> 4, cc = (tid & 15) * 2;
            f32x2 g = {0.f, 0.f}, u = {0.f, 0.f};
#pragma unroll
            for (int w = 0; w < 8; ++w) { g += *(const LAS f32x2*)(red + w * 2176 + row * 34 + cc); u += *(const LAS f32x2*)(red + w * 2176 + 1088 + row * 34 + cc); }
            E(rb * 32 + row, n0 + cc, n1 + cc, g, u);
        }
        __syncthreads();
    }
}
struct SEpiQKV {
    bf16_t* QKV; float* out; int layer;
    __device__ __forceinline__ void cols(int cb, int& n0, int& n1) const { n0 = cb * 64; n1 = n0 + 32; }
    __device__ __forceinline__ void emit(int r, int c, f32x2 v) const {
        *(unsigned*)(QKV + (size_t)(MP + r) * INW + c) = pk2(v.x, v.y);
        if (c >= 512 && c < 1536) { const size_t off = (c < 1024 ? OFF_KS : OFF_VS) + ((size_t)layer * MS + r) * 512 + (c & 511); *(f32x2*)(out + off) = v; }
    }
    __device__ __forceinline__ void operator()(int r, int c0, int c1, f32x2 g, f32x2 u) const { emit(r, c0, g); emit(r, c1, u); }
};
struct SEpiResid {
    const float* base; float* Xs; const float* gate;
    __device__ __forceinline__ void cols(int cb, int& n0, int& n1) const { n0 = cb * 64; n1 = n0 + 32; }
    __device__ __forceinline__ void operator()(int r, int c0, int c1, f32x2 g, f32x2 u) const {
        const float* gp = gate + (size_t)(2 + (r >> 5)) * NMOD; const float* bp = base + (size_t)r * DM; float* xp = Xs + (size_t)r * DM;
        const f32x2 x0 = *(const f32x2*)(bp + c0) + *(const f32x2*)(gp + c0) * g, x1 = *(const f32x2*)(bp + c1) + *(const f32x2*)(gp + c1) * u;
        *(f32x2*)(xp + c0) = x0; *(f32x2*)(xp + c1) = x1;
    }
};
struct SEpiSwiGLU {
    bf16_t* ACT;
    __device__ __forceinline__ void cols(int cb, int& n0, int& n1) const { n0 = (cb >> 2) * 256 + (cb & 3) * 32; n1 = n0 + 128; }
    __device__ __forceinline__ void operator()(int r, int c0, int c1, f32x2 g, f32x2 u) const {
        const int col = (c0 >> 8) * 128 + (c0 & 127);
        *(unsigned*)(ACT + (size_t)(MP + r) * DFF + col) = pk2(silu_f(g.x) * u.x, silu_f(g.y) * u.y);
    }
};

__device__ __forceinline__ void transpose_item(const float* W, int K, int N, bf16_t* WT, LAS float* scr, int item, int lane, bool perm) {
    const int nblk = N / 32, kb = item / nblk, nb = item % nblk, k0 = 64 * kb, n0 = 32 * nb;
    int p0 = n0;
    if (perm) { if (n0 < DFF) p0 = (n0 >> 7) * 256 + (n0 & 127); else { const int n1 = n0 - DFF; p0 = (n1 >> 7) * 256 + 128 + (n1 & 127); } }
#pragma unroll 8
    for (int i = 0; i < 32; ++i) { const int kk = 2 * i + (lane >> 5); scr[kk * 33 + (lane & 31)] = W[(size_t)(k0 + kk) * N + n0 + (lane & 31)]; }
    asm volatile("s_waitcnt lgkmcnt(0)" ::: "memory"); __builtin_amdgcn_wave_barrier();
    const int c = lane & 7;
#pragma unroll
    for (int j = 0; j < 4; ++j) { const int n = (lane >> 3) + 8 * j; const LAS float* s = scr + (8 * c) * 33 + n;
        u32x4 o; o.x = pk2(s[0 * 33], s[1 * 33]); o.y = pk2(s[2 * 33], s[3 * 33]); o.z = pk2(s[4 * 33], s[5 * 33]); o.w = pk2(s[6 * 33], s[7 * 33]);
        *(u32x4*)(WT + (size_t)(p0 + n) * K + k0 + 8 * c) = o; }
    asm volatile("s_waitcnt lgkmcnt(0)" ::: "memory"); __builtin_amdgcn_wave_barrier();
}

__device__ __forceinline__ void p0_phase(const Params& P, LAS unsigned char* lds, int tid, int lane, int wave) {
    LAS float* sc = (LAS float*)lds;
    for (int i = tid; i < NBI * DM; i += 512) { const int b = i >> 10, k = i & 1023; const float c = b < 2 ? P.in[5][b * DM + k] : P.in[6][(b - 2) * DM + k]; sc[i] = silu_f(c); }
    __syncthreads();
    const int gw = blockIdx.x * 8 + wave, NGW = gridDim.x * 8;
    float* MOD = (float*)(P.ws + WS_MOD);
    for (int it = gw; it < 768; it += NGW) {
        const int l = it / 192, r = it % 192, cb = r >> 3, kc = r & 7;
        f32x4 acc[NBI];
#pragma unroll
        for (int b = 0; b < NBI; ++b) acc[b] = (f32x4){0.f, 0.f, 0.f, 0.f};
        const float* wp = P.in[9] + ((size_t)l * DM + kc * 128) * NMOD + cb * 256 + lane * 4;
        const LAS float* scp = sc + kc * 128;
#pragma unroll 4
        for (int k = 0; k < 128; ++k) { const f32x4 w = *(const f32x4*)(wp + (size_t)k * NMOD);
#pragma unroll
            for (int b = 0; b < NBI; ++b) acc[b] += scp[b * DM + k] * w; }
        if (kc == 0) { const f32x4 bv = *(const f32x4*)(P.in[10] + (size_t)l * NMOD + cb * 256 + lane * 4);
#pragma unroll
            for (int b = 0; b < NBI; ++b) acc[b] += bv; }
        float* mp = MOD + (size_t)l * NBI * NMOD + cb * 256 + lane * 4;
#pragma unroll
        for (int b = 0; b < NBI; ++b) { atomicAdd(mp + b * NMOD + 0, acc[b].x); atomicAdd(mp + b * NMOD + 1, acc[b].y); atomicAdd(mp + b * NMOD + 2, acc[b].z); atomicAdd(mp + b * NMOD + 3, acc[b].w); }
    }
    LAS float* scr = (LAS float*)(lds + 73728 + wave * 8448);
    constexpr int I_IN = 16 * 112, I_OUT = 16 * 32, I_FI = 16 * 176, I_FO = 44 * 32, I_L = I_IN + I_OUT + I_FI + I_FO;
    for (int it = gw; it < DEPTH * I_L; it += NGW) {
        const int l = it / I_L; int r = it % I_L;
        if (r < I_IN) { transpose_item(P.in[11] + (size_t)l * DM * INW, DM, INW, (bf16_t*)(P.ws + WS_WIN) + (size_t)l * INW * DM, scr, r, lane, false); continue; } r -= I_IN;
        if (r < I_OUT) { transpose_item(P.in[14] + (size_t)l * DM * DM, DM, DM, (bf16_t*)(P.ws + WS_WOUT) + (size_t)l * DM * DM, scr, r, lane, false); continue; } r -= I_OUT;
        if (r < I_FI) { transpose_item(P.in[15] + (size_t)l * DM * 2 * DFF, DM, 2 * DFF, (bf16_t*)(P.ws + WS_WFI) + (size_t)l * 2 * DFF * DM, scr, r, lane, true); continue; } r -= I_FI;
        transpose_item(P.in[16] + (size_t)l * DFF * DM, DFF, DM, (bf16_t*)(P.ws + WS_WFO) + (size_t)l * DM * DFF, scr, r, lane, false);
    }
    f32x2* ROPE = (f32x2*)(P.ws + WS_ROPE);
    for (int idx = blockIdx.x * 512 + tid; idx < SEQ * 64; idx += gridDim.x * 512) {
        const int pos = idx >> 6, i = idx & 63;
        const float inv = exp2f(-(float)i * (13.287712379549449f / 64.f));
        const float ang = (float)pos * inv;
        double rev = (double)ang * 0.15915494309189535; rev -= floor(rev);
        const float rf = (float)rev;
        ROPE[idx] = (f32x2){__builtin_amdgcn_cosf(rf), __builtin_amdgcn_sinf(rf)};
    }
}

template <bool FINAL>
__device__ __forceinline__ void norm_phase(const Params& P, int l, bool from_input, const float* gain, int sh_off, int sc_off, int lane, int wave) {
    const int gw = blockIdx.x * 8 + wave, NGW = gridDim.x * 8;
    const float* MOD = (const float*)(P.ws + WS_MOD) + (size_t)l * NBI * NMOD;
    const float* X = (const float*)(P.ws + WS_X); bf16_t* H = (bf16_t*)(P.ws + WS_H);
    f32x4 g[4];
#pragma unroll
    for (int j = 0; j < 4; ++j) g[j] = *(const f32x4*)(gain + 4 * lane + 256 * j);
    for (int m = gw; m < MT; m += NGW) {
        const float* xr = (!FINAL && from_input) ? (m < MP ? P.in[0] + (size_t)m * DM : P.in[1] + (size_t)(m - MP) * DM) : X + (size_t)m * DM;
        f32x4 v[4]; float ss = 0.f;
#pragma unroll
        for (int j = 0; j < 4; ++j) { v[j] = *(const f32x4*)(xr + 4 * lane + 256 * j); ss += (v[j].x * v[j].x + v[j].y * v[j].y) + (v[j].z * v[j].z + v[j].w * v[j].w); }
        const float rstd = rsqrtf(wave_sum(ss) * (1.f / DM) + EPS);
        if (FINAL) {
            float* o = P.out + (size_t)m * DM;
#pragma unroll
            for (int j = 0; j < 4; ++j) *(f32x4*)(o + 4 * lane + 256 * j) = v[j] * rstd * g[j];
        } else {
            const float* mr = MOD + (size_t)batch_of(m) * NMOD;
#pragma unroll
            for (int j = 0; j < 4; ++j) { const int c = 4 * lane + 256 * j;
                const f32x4 sc = *(const f32x4*)(mr + sc_off + c), sh = *(const f32x4*)(mr + sh_off + c);
                const f32x4 hh = v[j] * rstd * g[j] * (1.f + sc) + sh;
                u32x2 w; w.x = pk2(hh.x, hh.y); w.y = pk2(hh.z, hh.w);
                *(u32x2*)(H + (size_t)m * DM + c) = w; }
        }
    }
}

__device__ __forceinline__ void sb_unit(const Params& P, int l, int u, LAS unsigned char* lds, int tid, int lane, int wave) {
    const bf16_t* QKV = (const bf16_t*)(P.ws + WS_QKV);
    const int h = wave, l32 = lane & 31, hf = lane >> 5;
    const bool samp = u >= 1024;
    int qrow0, nsteps; const float* ck = nullptr; const float* cv = nullptr;
    if (!samp) { const int b = u >> 9, qb = u & 511; qrow0 = b * SEQ + qb * 32; nsteps = qb + 1; }
    else { const int bs = u - 1024; qrow0 = MP + bs * 32; nsteps = 65; ck = P.in[2] + (size_t)(l * DB + bs) * PAST * 512; cv = P.in[3] + (size_t)(l * DB + bs) * PAST * 512; }
    bf16x8 qf[4];
#pragma unroll
    for (int ks = 0; ks < 4; ++ks) qf[ks] = *(const bf16x8*)(QKV + (size_t)(qrow0 + l32) * INW + h * 64 + ks * 16 + hf * 8);
    f32x16 O0, O1;
#pragma unroll
    for (int r = 0; r < 16; ++r) { O0[r] = 0.f; O1[r] = 0.f; }
    float cum = 0.f;
    LAS unsigned char* vt = lds + 66048 + wave * 4608;
    auto issue = [&](int s, bf16x8 (&k)[4], bf16x8 (&v)[4]) {
        if (!samp || s == 0) {
            const int krow0 = samp ? qrow0 : qrow0 - s * 32;
#pragma unroll
            for (int ks = 0; ks < 4; ++ks) k[ks] = *(const bf16x8*)(QKV + (size_t)(krow0 + l32) * INW + 512 + h * 64 + ks * 16 + hf * 8);
#pragma unroll
            for (int it = 0; it < 4; ++it) { const int id = it * 64 + lane, key = id >> 3, ch = id & 7;
                v[it] = *(const bf16x8*)(QKV + (size_t)(krow0 + key) * INW + 1024 + h * 64 + ch * 8); }
        } else {
            const int kpos0 = (64 - s) * 32;
#pragma unroll
            for (int ks = 0; ks < 4; ++ks) { const float* p = ck + (size_t)(kpos0 + l32) * 512 + h * 64 + ks * 16 + hf * 8; k[ks] = pack8(*(const f32x4*)p, *(const f32x4*)(p + 4)); }
#pragma unroll
            for (int it = 0; it < 4; ++it) { const int id = it * 64 + lane, key = id >> 3, ch = id & 7;
                const float* p = cv + (size_t)(kpos0 + key) * 512 + h * 64 + ch * 8;
                v[it] = pack8(*(const f32x4*)p, *(const f32x4*)(p + 4)); }
        }
    };
    bf16x8 kf[4], vr[4];
    issue(0, kf, vr);
    for (int s = 0; s < nsteps; ++s) {
#pragma unroll
        for (int it = 0; it < 4; ++it) { const int id = it * 64 + lane, key = id >> 3, ch = id & 7; *(LAS bf16x8*)(vt + key * 144 + ch * 16) = vr[it]; }
        bf16x8 kn[4];
#pragma unroll
        for (int ks = 0; ks < 4; ++ks) kn[ks] = kf[ks];
        if (s + 1 < nsteps) issue(s + 1, kn, vr);
        asm volatile("s_waitcnt lgkmcnt(0)" ::: "memory"); __builtin_amdgcn_wave_barrier();
        f32x16 S;
#pragma unroll
        for (int r = 0; r < 16; ++r) S[r] = 0.f;
#pragma unroll
        for (int ks = 0; ks < 4; ++ks) S = MFMA32(kf[ks], qf[ks], S);
        float L[16], lb[16]; bool valid[16];
#pragma unroll
        for (int r = 0; r < 16; ++r) {
            const float z = S[r] * 0.125f;
            const float sp = fmaxf(z, 0.f) + __logf(1.f + __expf(-fabsf(z)));
            const int key = (r >> 2) * 8 + hf * 4 + (r & 3);
            valid[r] = (s != 0) || (key < l32);
            L[r] = valid[r] ? -sp : 0.f; lb[r] = z - sp;
        }
        float T[4], Pp[4];
#pragma unroll
        for (int g = 0; g < 4; ++g) { T[g] = (L[4 * g] + L[4 * g + 1]) + (L[4 * g + 2] + L[4 * g + 3]); Pp[g] = __shfl_xor(T[g], 32); }
        float later[4]; float tot = 0.f;
#pragma unroll
        for (int g = 3; g >= 0; --g) { later[g] = tot; tot += T[g] + Pp[g]; }
        float w[16];
#pragma unroll
        for (int g = 0; g < 4; ++g) {
            const float s3 = cum + later[g] + (hf == 0 ? Pp[g] : 0.f);
            const float s2 = s3 + L[4 * g + 3], s1 = s2 + L[4 * g + 2], s0 = s1 + L[4 * g + 1];
            w[4 * g + 3] = valid[4 * g + 3] ? __expf(lb[4 * g + 3] + s3) : 0.f;
            w[4 * g + 2] = valid[4 * g + 2] ? __expf(lb[4 * g + 2] + s2) : 0.f;
            w[4 * g + 1] = valid[4 * g + 1] ? __expf(lb[4 * g + 1] + s1) : 0.f;
            w[4 * g + 0] = valid[4 * g + 0] ? __expf(lb[4 * g + 0] + s0) : 0.f;
        }
        cum += tot;
#pragma unroll
        for (int c = 0; c < 2; ++c) {
            u32x4 pw; pw.x = pk2(w[8 * c], w[8 * c + 1]); pw.y = pk2(w[8 * c + 2], w[8 * c + 3]); pw.z = pk2(w[8 * c + 4], w[8 * c + 5]); pw.w = pk2(w[8 * c + 6], w[8 * c + 7]);
            const bf16x8 pa = __builtin_bit_cast(bf16x8, pw);
#pragma unroll
            for (int dt = 0; dt < 2; ++dt) {
                bf16x8 vb;
#pragma unroll
                for (int i = 0; i < 8; ++i) { const int key = 16 * c + 8 * (i >> 2) + 4 * hf + (i & 3); vb[i] = *(const LAS short*)(vt + key * 144 + (l32 + 32 * dt) * 2); }
                if (dt == 0) O0 = MFMA32(pa, vb, O0); else O1 = MFMA32(pa, vb, O1);
            }
        }
        asm volatile("" ::: "memory");
        if (__all(cum < -110.f)) break;
#pragma unroll
        for (int ks = 0; ks < 4; ++ks) kf[ks] = kn[ks];
    }
    LAS float* oa = (LAS float*)lds;
#pragma unroll
    for (int r = 0; r < 16; ++r) { const int q = (r >> 2) * 8 + hf * 4 + (r & 3); oa[q * 516 + h * 64 + l32] = O0[r]; oa[q * 516 + h * 64 + 32 + l32] = O1[r]; }
    __syncthreads();
    bf16_t* Ob = (bf16_t*)(P.ws + WS_O);
    const float* gsb = P.in[12] + (size_t)l * 512;
    {
        f32x4 ra[4], rb[4]; float sq[4];
#pragma unroll
        for (int rr = 0; rr < 4; ++rr) { const int q = wave * 4 + rr;
            ra[rr] = *(const LAS f32x4*)(oa + q * 516 + 4 * lane); rb[rr] = *(const LAS f32x4*)(oa + q * 516 + 256 + 4 * lane);
            const f32x4 a = ra[rr], b = rb[rr];
            sq[rr] = (a.x * a.x + a.y * a.y) + (a.z * a.z + a.w * a.w) + (b.x * b.x + b.y * b.y) + (b.z * b.z + b.w * b.w); }
#pragma unroll
        for (int o = 1; o < 64; o <<= 1) {
#pragma unroll
            for (int rr = 0; rr < 4; ++rr) sq[rr] += __shfl_xor(sq[rr], o);
        }
        const f32x4 ga = *(const f32x4*)(gsb + 4 * lane), gb = *(const f32x4*)(gsb + 256 + 4 * lane);
#pragma unroll
        for (int rr = 0; rr < 4; ++rr) { const int q = wave * 4 + rr;
            const float rstd = rsqrtf(sq[rr] * (1.f / 512.f) + EPS);
            const f32x4 ya = ra[rr] * rstd * ga, yb = rb[rr] * rstd * gb;
            u32x2 wa, wb; wa.x = pk2(ya.x, ya.y); wa.y = pk2(ya.z, ya.w); wb.x = pk2(yb.x, yb.y); wb.y = pk2(yb.z, yb.w);
            *(u32x2*)(Ob + (size_t)(qrow0 + q) * DM + 4 * lane) = wa; *(u32x2*)(Ob + (size_t)(qrow0 + q) * DM + 256 + 4 * lane) = wb; }
    }
    __syncthreads();
}

__device__ __forceinline__ void ret_unit(const Params& P, int l, LAS unsigned char* lds, int tid, int lane, int wave,
                                         int row0, int pos0, int nchunks, int L, int h, const float* init, float* outst, bool state_only) {
    const bf16_t* QKV = (const bf16_t*)(P.ws + WS_QKV); bf16_t* Ob = (bf16_t*)(P.ws + WS_O);
    const f32x2* ROPE = (const f32x2*)(P.ws + WS_ROPE);
    const float lg2 = log2f(1.f - exp2f(-5.f - (float)h));
    LAS unsigned char *Qn = lds, *Kn = lds + 17408, *KdT = lds + 34816, *VT = lds + 53248, *SbT = lds + 71680, *Pm = lds + 106496;
    LAS float* of = (LAS float*)lds;
    const int l32 = lane & 31, hf = lane >> 5;
    const int sdt = wave >> 1, set0 = (wave & 1) * 2;
    f32x16 S0, S1;
#pragma unroll
    for (int r = 0; r < 16; ++r) { S0[r] = 0.f; S1[r] = 0.f; }
    if (init) {
        const float* ip = init + (sdt * 32 + hf * 4) * 128 + set0 * 32 + l32;
#pragma unroll
        for (int r = 0; r < 16; ++r) { S0[r] = ip[((r >> 2) * 8 + (r & 3)) * 128]; S1[r] = ip[((r >> 2) * 8 + (r & 3)) * 128 + 32]; if ((r & 3) == 3) asm volatile("" ::: "memory"); }
    }
    if (!state_only) {
#pragma unroll
        for (int g = 0; g < 4; ++g) { const int d0 = sdt * 32 + g * 8 + hf * 4;
            u32x2 a, b; a.x = pk2(S0[4 * g], S0[4 * g + 1]); a.y = pk2(S0[4 * g + 2], S0[4 * g + 3]); b.x = pk2(S1[4 * g], S1[4 * g + 1]); b.y = pk2(S1[4 * g + 2], S1[4 * g + 3]);
            *(LAS u32x2*)(SbT + (set0 * 32 + l32) * 272 + d0 * 2) = a; *(LAS u32x2*)(SbT + ((set0 + 1) * 32 + l32) * 272 + d0 * 2) = b; }
    }
    const float gL = exp2f((float)L * lg2);
    const int lt = wave >> 2, et = wave & 3;
    bf16x8 rk1, rk2, rq1, rq2, rv0, rv1; f32x4 rcs[4];
    const bf16x8 z8 = {0, 0, 0, 0, 0, 0, 0, 0};
    auto issue = [&](int c) {
        const int t = tid >> 3, i0 = (tid & 7) * 8; const bool ok = t < L;
        const size_t row = (size_t)(row0 + c * 64 + t);
        rk1 = z8; rk2 = z8; rq1 = z8; rq2 = z8;
#pragma unroll
        for (int i = 0; i < 4; ++i) rcs[i] = (f32x4){0.f, 0.f, 0.f, 0.f};
        if (ok) {
            rk1 = *(const bf16x8*)(QKV + row * INW + 2048 + h * 128 + i0); rk2 = *(const bf16x8*)(QKV + row * INW + 2048 + h * 128 + 64 + i0);
            if (!state_only) { rq1 = *(const bf16x8*)(QKV + row * INW + 1536 + h * 128 + i0); rq2 = *(const bf16x8*)(QKV + row * INW + 1536 + h * 128 + 64 + i0); }
            const f32x4* rp = (const f32x4*)(ROPE + (size_t)(pos0 + c * 64 + t) * 64 + i0);
#pragma unroll
            for (int i = 0; i < 4; ++i) rcs[i] = rp[i];
        }
        const int t0 = tid >> 4, ch = tid & 15;
        rv0 = z8; rv1 = z8;
        if (t0 < L) rv0 = *(const bf16x8*)(QKV + (size_t)(row0 + c * 64 + t0) * INW + 2560 + h * 128 + ch * 8);
        if (t0 + 32 < L) rv1 = *(const bf16x8*)(QKV + (size_t)(row0 + c * 64 + t0 + 32) * INW + 2560 + h * 128 + ch * 8);
    };
    issue(0);
    const int l32_0 = l32, hf_0 = hf, tid_0 = tid; const float lg2_0 = lg2;
#pragma unroll 1
    for (int c = 0; c < nchunks; ++c) {
        int l32 = l32_0, hf = hf_0, tid = tid_0; float lg2 = lg2_0;
        asm volatile("" : "+v"(l32), "+v"(hf), "+v"(tid), "+v"(lg2));
        {
            const int t = tid >> 3, pc = tid & 7, i0 = pc * 8; const bool ok = t < L;
            const float kd = ok ? __builtin_amdgcn_exp2f((float)(L - 1 - t) * lg2) : 0.f;
            const int tsw = (((t >> 3) ^ pc) << 4) + (t & 7) * 2;
            float cs_c[8], cs_s[8];
#pragma unroll
            for (int i = 0; i < 4; ++i) { cs_c[2 * i] = rcs[i].x; cs_s[2 * i] = rcs[i].y; cs_c[2 * i + 1] = rcs[i].z; cs_s[2 * i + 1] = rcs[i].w; }
            {
                float o1[8], o2[8];
#pragma unroll
                for (int i = 0; i < 8; ++i) { const float x1 = bf2f((unsigned short)rk1[i]), x2 = bf2f((unsigned short)rk2[i]);
                    o1[i] = (x1 * cs_c[i] - x2 * cs_s[i]) * 0.08838834764831845f; o2[i] = (x1 * cs_s[i] + x2 * cs_c[i]) * 0.08838834764831845f; }
                if (!state_only) {
                    u32x4 a, b; a.x = pk2(o1[0], o1[1]); a.y = pk2(o1[2], o1[3]); a.z = pk2(o1[4], o1[5]); a.w = pk2(o1[6], o1[7]);
                    b.x = pk2(o2[0], o2[1]); b.y = pk2(o2[2], o2[3]); b.z = pk2(o2[4], o2[5]); b.w = pk2(o2[6], o2[7]);
                    *(LAS u32x4*)(Kn + t * 272 + i0 * 2) = a; *(LAS u32x4*)(Kn + t * 272 + (64 + i0) * 2) = b;
                }
#pragma unroll
                for (int i = 0; i < 8; ++i) { *(LAS unsigned short*)(KdT + (i0 + i) * 144 + tsw) = (unsigned short)f2bf(o1[i] * kd); *(LAS unsigned short*)(KdT + (64 + i0 + i) * 144 + tsw) = (unsigned short)f2bf(o2[i] * kd); }
            }
            if (!state_only) {
                float o1[8], o2[8];
#pragma unroll
                for (int i = 0; i < 8; ++i) { const float x1 = bf2f((unsigned short)rq1[i]), x2 = bf2f((unsigned short)rq2[i]);
                    o1[i] = x1 * cs_c[i] - x2 * cs_s[i]; o2[i] = x1 * cs_s[i] + x2 * cs_c[i]; }
                u32x4 a, b; a.x = pk2(o1[0], o1[1]); a.y = pk2(o1[2], o1[3]); a.z = pk2(o1[4], o1[5]); a.w = pk2(o1[6], o1[7]);
                b.x = pk2(o2[0], o2[1]); b.y = pk2(o2[2], o2[3]); b.z = pk2(o2[4], o2[5]); b.w = pk2(o2[6], o2[7]);
                *(LAS u32x4*)(Qn + t * 272 + i0 * 2) = a; *(LAS u32x4*)(Qn + t * 272 + (64 + i0) * 2) = b;
            }
            {
                const int t0 = tid >> 4, ch = tid & 15, sw = ch & 7;
                const int o0 = (((t0 >> 3) ^ sw) << 4) + (t0 & 7) * 2, o1b = ((((t0 + 32) >> 3) ^ sw) << 4) + (t0 & 7) * 2;
#pragma unroll
                for (int i = 0; i < 8; ++i) { *(LAS short*)(VT + (ch * 8 + i) * 144 + o0) = rv0[i]; *(LAS short*)(VT + (ch * 8 + i) * 144 + o1b) = rv1[i]; }
            }
        }
        if (c + 1 < nchunks) issue(c + 1);
        unsigned gpre[8];
#pragma unroll
        for (int rr = 0; rr < 8; ++rr) { const int t = wave * 8 + rr; gpre[rr] = (!state_only && t < L) ? *(const unsigned*)(QKV + (size_t)(row0 + c * 64 + t) * INW + 3072 + h * 128 + lane * 2) : 0u; }
        __syncthreads();
        f32x16 acc;
        if (!state_only) {
#pragma unroll
            for (int r = 0; r < 16; ++r) acc[r] = 0.f;
#pragma unroll
            for (int ks = 0; ks < 8; ++ks) { const bf16x8 a = *(const LAS bf16x8*)(Qn + (lt * 32 + l32) * 272 + (ks * 16 + hf * 8) * 2), b = *(const LAS bf16x8*)(SbT + (et * 32 + l32) * 272 + (ks * 16 + hf * 8) * 2); acc = MFMA32(a, b, acc); }
#pragma unroll
            for (int r = 0; r < 16; ++r) { const int tl = lt * 32 + (r >> 2) * 8 + hf * 4 + (r & 3); acc[r] *= __builtin_amdgcn_exp2f((float)(tl + 1) * lg2); }
            if (wave < 4) {
                const int slt = wave >> 1, smt = wave & 1;
                f32x16 sc;
#pragma unroll
                for (int r = 0; r < 16; ++r) sc[r] = 0.f;
                if (slt >= smt) {
#pragma unroll
                    for (int ks = 0; ks < 8; ++ks) { const bf16x8 a = *(const LAS bf16x8*)(Qn + (slt * 32 + l32) * 272 + (ks * 16 + hf * 8) * 2), b = *(const LAS bf16x8*)(Kn + (smt * 32 + l32) * 272 + (ks * 16 + hf * 8) * 2); sc = MFMA32(a, b, sc); }
                }
                const int tm = smt * 32 + l32;
#pragma unroll
                for (int r = 0; r < 16; ++r) { const int tl = slt * 32 + (r >> 2) * 8 + hf * 4 + (r & 3);
                    const float p = tl >= tm ? sc[r] * __builtin_amdgcn_exp2f((float)(tl - tm) * lg2) : 0.f;
                    *(LAS unsigned short*)(Pm + tl * 144 + tm * 2) = (unsigned short)f2bf(p); }
            }
            __syncthreads();
#pragma unroll
            for (int ms = 0; ms < 4; ++ms) { const bf16x8 a = *(const LAS bf16x8*)(Pm + (lt * 32 + l32) * 144 + (ms * 16 + hf * 8) * 2), b = *(const LAS bf16x8*)(VT + (et * 32 + l32) * 144 + (((ms * 2 + hf) ^ ((et * 4 + (l32 >> 3)) & 7)) << 4)); acc = MFMA32(a, b, acc); }
#pragma unroll
            for (int r = 0; r < 16; ++r) { const int tl = lt * 32 + (r >> 2) * 8 + hf * 4 + (r & 3); of[tl * 132 + et * 32 + l32] = acc[r]; }
        }
#pragma unroll
        for (int r = 0; r < 16; ++r) { S0[r] *= gL; S1[r] *= gL; }
#pragma unroll
        for (int ts = 0; ts < 4; ++ts) {
            const int cc = ts * 2 + hf, rs = l32 >> 3;
            const bf16x8 a = *(const LAS bf16x8*)(KdT + (sdt * 32 + l32) * 144 + ((cc ^ ((sdt * 4 + rs) & 7)) << 4));
            const bf16x8 b0 = *(const LAS bf16x8*)(VT + (set0 * 32 + l32) * 144 + ((cc ^ ((set0 * 4 + rs) & 7)) << 4)), b1 = *(const LAS bf16x8*)(VT + ((set0 + 1) * 32 + l32) * 144 + ((cc ^ (((set0 + 1) * 4 + rs) & 7)) << 4));
            S0 = MFMA32(a, b0, S0); S1 = MFMA32(a, b1, S1);
        }
        if (!state_only) {
#pragma unroll
            for (int g = 0; g < 4; ++g) { const int d0 = sdt * 32 + g * 8 + hf * 4;
                u32x2 a, b; a.x = pk2(S0[4 * g], S0[4 * g + 1]); a.y = pk2(S0[4 * g + 2], S0[4 * g + 3]); b.x = pk2(S1[4 * g], S1[4 * g + 1]); b.y = pk2(S1[4 * g + 2], S1[4 * g + 3]);
                *(LAS u32x2*)(SbT + (set0 * 32 + l32) * 272 + d0 * 2) = a; *(LAS u32x2*)(SbT + ((set0 + 1) * 32 + l32) * 272 + d0 * 2) = b; }
            __syncthreads();
            const f32x2 gr = *(const f32x2*)(P.in[13] + (size_t)(l * 4 + h) * 128 + lane * 2);
            f32x2 ov[8]; float sq[8];
#pragma unroll
            for (int rr = 0; rr < 8; ++rr) { ov[rr] = *(const LAS f32x2*)(of + (wave * 8 + rr) * 132 + lane * 2); sq[rr] = ov[rr].x * ov[rr].x + ov[rr].y * ov[rr].y; }
#pragma unroll
            for (int o = 1; o < 64; o <<= 1) {
#pragma unroll
                for (int rr = 0; rr < 8; ++rr) sq[rr] += __shfl_xor(sq[rr], o);
            }
#pragma unroll
            for (int rr = 0; rr < 8; ++rr) {
                const int t = wave * 8 + rr;
                if (t < L) {
                    const float rstd = rsqrtf(sq[rr] * (1.f / 128.f) + EPS);
                    const size_t row = (size_t)(row0 + c * 64 + t);
                    const unsigned gg = gpre[rr];
                    const float y0 = ov[rr].x * rstd * gr.x * silu_f(bf2f(gg & 0xffffu)), y1 = ov[rr].y * rstd * gr.y * silu_f(bf2f(gg >> 16));
                    *(unsigned*)(Ob + row * DM + 512 + h * 128 + lane * 2) = pk2(y0, y1);
                }
            }
        }
        __syncthreads();
    }
    if (outst) {
        float* op = outst + (sdt * 32 + hf * 4) * 128 + set0 * 32 + l32;
#pragma unroll
        for (int r = 0; r < 16; ++r) { op[((r >> 2) * 8 + (r & 3)) * 128] = S0[r]; op[((r >> 2) * 8 + (r & 3)) * 128 + 32] = S1[r]; if ((r & 3) == 3) asm volatile("" ::: "memory"); }
    }
}


#define XB_TMO      128
#define XB_XCNT(j)  (256  + 64 * (j))
#define XB_XSUB(j)  (1280 + 64 * (j))
#define XB_XGEN(j)  (2304 + 64 * (j))
#define XB_TOP      3328
#define XB_TOPGEN   3392
#define XCD_BAR_WORDS 3456
#define XB_SPIN_CAP (1u << 18)

__device__ __forceinline__ unsigned xb_ld(unsigned* p)              { return __hip_atomic_load(p, __ATOMIC_RELAXED, __HIP_MEMORY_SCOPE_AGENT); }
__device__ __forceinline__ unsigned xb_add(unsigned* p, unsigned v) { return __hip_atomic_fetch_add(p, v, __ATOMIC_RELAXED, __HIP_MEMORY_SCOPE_AGENT); }
__device__ __forceinline__ unsigned xb_xcc_id() { return (unsigned)__builtin_amdgcn_s_getreg((3 << 11) | 20) & 0xFu; }
#define XB_SPIN(cond, bar) do { unsigned _sp = 0; while (cond) { __builtin_amdgcn_s_sleep(1); \
    if ((++_sp & 255u) == 0u) { if (xb_ld(&(bar)[XB_TMO])) break; if (_sp > XB_SPIN_CAP) { atomicAdd(&(bar)[XB_TMO], 1u); break; } } } } while (0)

struct XcdBarrier {
    unsigned* bar; unsigned x;
    volatile LAS unsigned* st;
};

__device__ __forceinline__ XcdBarrier xcd_barrier_post(unsigned* bar, volatile LAS unsigned* st) {
    XcdBarrier b; b.bar = bar; b.x = xb_xcc_id(); b.st = st;
    if (threadIdx.x == 0) (void)xb_add(&bar[XB_XCNT(b.x)], 1u);
    return b;
}
__device__ __forceinline__ void xcd_barrier_complete(unsigned* bar, unsigned x, unsigned& nloc, unsigned& nx) {
    const unsigned G = gridDim.x * gridDim.y * gridDim.z;
    unsigned sum, cnt, mine, sp = 0u;
    for (;;) {
        sum = 0u; cnt = 0u; mine = 0u;
#pragma unroll
        for (unsigned j = 0; j < 16; ++j) { const unsigned c = xb_ld(&bar[XB_XCNT(j)]); sum += c; cnt += (c > 0u) ? 1u : 0u; mine = (j == x) ? c : mine; }
        if (sum == G) break;
        __builtin_amdgcn_s_sleep(1);
        if ((++sp & 255u) == 0u) { if (xb_ld(&bar[XB_TMO])) break; if (sp > XB_SPIN_CAP) { atomicAdd(&bar[XB_TMO], 1u); break; } }
    }
    nloc = mine > 0u ? mine : 1u; nx = cnt > 0u ? cnt : 1u;
}

__device__ __forceinline__ void xcd_barrier(const XcdBarrier& b) {
    asm volatile("s_waitcnt vmcnt(0)" ::: "memory");
    __syncthreads();
    if (threadIdx.x == 0) {
        unsigned* bar = b.bar;
        __builtin_amdgcn_s_waitcnt(0);
        unsigned nloc = b.st[0], nx = b.st[1];
        if (nloc == 0u) { xcd_barrier_complete(bar, b.x, nloc, nx); b.st[0] = nloc; b.st[1] = nx; }
        const unsigned old = xb_add(&bar[XB_XSUB(b.x)], 1u);
        const unsigned gen = old / nloc;
        if (old + 1u == (gen + 1u) * nloc) {
            __builtin_amdgcn_fence(__ATOMIC_RELEASE, "agent");
            asm volatile("s_waitcnt vmcnt(0)" ::: "memory");
            const unsigned og = xb_add(&bar[XB_TOP], 1u);
            const unsigned tg = og / nx;
            if (og + 1u == (tg + 1u) * nx) xb_add(&bar[XB_TOPGEN], 1u);
            else XB_SPIN(xb_ld(&bar[XB_TOPGEN]) == tg, bar);
            __builtin_amdgcn_fence(__ATOMIC_ACQUIRE, "agent");
            xb_add(&bar[XB_XGEN(b.x)], 1u);
            asm volatile("s_waitcnt vmcnt(0)" ::: "memory");
        } else {
            XB_SPIN(xb_ld(&bar[XB_XGEN(b.x)]) == gen, bar);
            __builtin_amdgcn_fence(__ATOMIC_ACQUIRE, "agent");
            asm volatile("s_waitcnt vmcnt(0)" ::: "memory");
        }
    }
    __syncthreads();
}
__global__ void __launch_bounds__(512, 2) fwd_megakernel(Params P) {
    extern __shared__ __attribute__((aligned(16))) unsigned char lds_raw[];
    LAS unsigned char* lds = (LAS unsigned char*)lds_raw;
    cg::grid_group grid = cg::this_grid();
    int tid = threadIdx.x, lane = tid & 63, wave = __builtin_amdgcn_readfirstlane(tid >> 6);
#define REFRESH() do { tid = threadIdx.x; asm volatile("" : "+v"(tid)); lane = tid & 63; wave = __builtin_amdgcn_readfirstlane(tid >> 6); } while (0)
    const int G = gridDim.x, bx = blockIdx.x;
    bf16_t* H = (bf16_t*)(P.ws + WS_H); bf16_t* Ob = (bf16_t*)(P.ws + WS_O); bf16_t* QKV = (bf16_t*)(P.ws + WS_QKV); bf16_t* ACT = QKV;
    float* X = (float*)(P.ws + WS_X); float* U = (float*)(P.ws + WS_U);
    const float* MOD = (const float*)(P.ws + WS_MOD);

    volatile LAS unsigned* bst = (volatile LAS unsigned*)(lds + LDS_BYTES - 64);
    if (tid == 0) { bst[0] = 0u; bst[1] = 0u; }
    __syncthreads();
    const XcdBarrier xbar = xcd_barrier_post((unsigned*)(P.ws + WS_BAR), bst);
#ifndef SK_P0
    p0_phase(P, lds, tid, lane, wave);
#endif
    grid.sync(); REFRESH();
#pragma unroll 1
    for (int l = 0; l < DEPTH; ++l) {
        norm_phase<false>(P, l, l == 0, P.in[7] + (size_t)l * DM, 0, 1024, lane, wave);
        xcd_barrier(xbar); REFRESH();
#ifndef SK_G1
        {
            pg8::Gemm g{H, (const bf16_t*)(P.ws + WS_WIN) + (size_t)l * INW * DM, MP, INW, DM}; pg8::StaticOrder S; S.init(MP, INW, G, bx);
            EpiQKV E{QKV, P.out, l};
            pg8::gemm_phase<EpiQKV, pg8::StaticOrder, true, true>(lds, g, S, E);
            SEpiQKV SE{QKV, P.out, l};
            sgemm_phase<8, 8, SEpiQKV>(lds, H + (size_t)MP * DM, DM, g.Bt, DM, INW / 64, tid, lane, wave, SE);
        }
#endif
        xcd_barrier(xbar); REFRESH();
        {
            unsigned* qhead = (unsigned*)(P.ws + WS_CTR) + l * 64;
            volatile LAS unsigned* qslot = (volatile LAS unsigned*)(lds + LDS_BYTES - 128);
            for (;;) {
                if (tid == 0) *qslot = __hip_atomic_fetch_add(qhead, 1u, __ATOMIC_RELAXED, __HIP_MEMORY_SCOPE_AGENT);
                __syncthreads();
                const int u = (int)*qslot;
                __syncthreads();
                if (u >= 1360) break;
                if (u < 256) { const int bh = u >> 5, seg = u & 31, b = bh >> 2, h = bh & 3;
                    ret_unit(P, l, lds, tid, lane, wave, b * SEQ + seg * 512, seg * 512, 8, 64, h, nullptr, U + (size_t)(bh * 32 + seg) * 16384, true); }
                else if (u < 272) sb_unit(P, l, 1024 + (u - 256), lds, tid, lane, wave);
                else if (u < 1296) { const int v = u - 272; sb_unit(P, l, (v & 1) * 512 + (511 - (v >> 1)), lds, tid, lane, wave); }
                else { const int idx = u - 1296, bs = idx >> 2, h = idx & 3; const size_t so = ((size_t)(l * DB + bs) * 4 + h) * 16384;
                    ret_unit(P, l, lds, tid, lane, wave, MP + bs * 32, PAST, 1, 32, h, P.in[4] + so, P.out + OFF_RS + so, false); }
            }
        }
        xcd_barrier(xbar); REFRESH();
        for (int idx = bx * 512 + tid; idx < 8 * 16384; idx += G * 512) {
            const int bh = idx >> 14, within = idx & 16383, h = bh & 3;
            const float g512 = exp2f(512.f * log2f(1.f - exp2f(-5.f - (float)h)));
            float* up = U + (size_t)bh * 32 * 16384 + within; float s = 0.f;
            for (int seg = 0; seg < 32; ++seg) { const float uu = up[(size_t)seg * 16384]; up[(size_t)seg * 16384] = s; s = g512 * s + uu; }
            P.out[OFF_RP + ((size_t)l * 8 + bh) * 16384 + within] = s;
        }
        xcd_barrier(xbar); REFRESH();
#ifndef SK_R3
        for (int u = bx; u < 256; u += G) { const int bh = u >> 5, seg = u & 31, b = bh >> 2, h = bh & 3;
            ret_unit(P, l, lds, tid, lane, wave, b * SEQ + seg * 512, seg * 512, 8, 64, h, U + (size_t)(bh * 32 + seg) * 16384, nullptr, false); }
#endif
        xcd_barrier(xbar); REFRESH();
#ifndef SK_G2
        {
            pg8::Gemm g{Ob, (const bf16_t*)(P.ws + WS_WOUT) + (size_t)l * DM * DM, MP, DM, DM}; pg8::StaticOrder S; S.init(MP, DM, G, bx);
            EpiResid E{l == 0 ? P.in[0] : nullptr, l == 0 ? P.in[1] : nullptr, X, MOD + (size_t)l * NBI * NMOD + 2048};
            pg8::gemm_phase<EpiResid, pg8::StaticOrder, true, true>(lds, g, S, E);
            SEpiResid SE{l == 0 ? P.in[1] : X + (size_t)MP * DM, X + (size_t)MP * DM, MOD + (size_t)l * NBI * NMOD + 2048};
            sgemm_phase<8, 8, SEpiResid>(lds, Ob + (size_t)MP * DM, DM, g.Bt, DM, DM / 64, tid, lane, wave, SE);
        }
#endif
        xcd_barrier(xbar); REFRESH();
        norm_phase<false>(P, l, false, P.in[8] + (size_t)l * DM, 3072, 4096, lane, wave);
        xcd_barrier(xbar); REFRESH();
#ifndef SK_G3
        {
            pg8::Gemm g{H, (const bf16_t*)(P.ws + WS_WFI) + (size_t)l * 2 * DFF * DM, MP, 2 * DFF, DM}; pg8::StaticOrder S; S.init(MP, 2 * DFF, G, bx);
            EpiSwiGLU E{ACT};
            pg8::gemm_phase<EpiSwiGLU, pg8::StaticOrder, true, true>(lds, g, S, E);
            SEpiSwiGLU SE{ACT};
            sgemm_phase<8, 8, SEpiSwiGLU>(lds, H + (size_t)MP * DM, DM, g.Bt, DM, (2 * DFF / 256) * 4, tid, lane, wave, SE);
        }
#endif
        xcd_barrier(xbar); REFRESH();
#ifndef SK_G4
        {
            pg8::Gemm g{ACT, (const bf16_t*)(P.ws + WS_WFO) + (size_t)l * DM * DFF, MP, DM, DFF}; pg8::StaticOrder S; S.init(MP, DM, G, bx);
            EpiResid E{nullptr, nullptr, X, MOD + (size_t)l * NBI * NMOD + 5120};
            pg8::gemm_phase<EpiResid, pg8::StaticOrder, true, true>(lds, g, S, E);
            SEpiResid SE{X + (size_t)MP * DM, X + (size_t)MP * DM, MOD + (size_t)l * NBI * NMOD + 5120};
            sgemm_phase<22, 11, SEpiResid>(lds, ACT + (size_t)MP * DFF, DFF, g.Bt, DFF, DM / 64, tid, lane, wave, SE);
        }
#endif
        xcd_barrier(xbar); REFRESH();
    }
    norm_phase<true>(P, 0, false, P.in[17], 0, 0, lane, wave);
}

extern "C" void kernel_launch(void* const* d_in, const int* in_sizes, int n_in, void* d_out, int out_size, void* d_ws, size_t ws_size, hipStream_t stream) {
    static int grid = 0;
    if (grid == 0) {
        if (n_in != 18 || ws_size < WS_END) { fprintf(stderr, "kernel_launch: unexpected n_in %d / ws_size %zu\n", n_in, ws_size); grid = -1; return; }
        int dev = 0, cus = 0, per_cu = 0;
        (void)hipGetDevice(&dev); (void)hipDeviceGetAttribute(&cus, hipDeviceAttributeMultiprocessorCount, dev);
        if (hipFuncSetAttribute((const void*)fwd_megakernel, hipFuncAttributeMaxDynamicSharedMemorySize, LDS_BYTES) != hipSuccess) { fprintf(stderr, "kernel_launch: hipFuncSetAttribute failed\n"); grid = -1; return; }
        (void)hipOccupancyMaxActiveBlocksPerMultiprocessor(&per_cu, (const void*)fwd_megakernel, 512, LDS_BYTES);
        (void)hipGetLastError();
        if (per_cu < 1) { fprintf(stderr, "kernel_launch: occupancy query says %d blocks per CU\n", per_cu); per_cu = 1; }
        grid = cus;
    }
    if (grid < 0) return;
    (void)hipMemsetAsync((char*)d_ws + WS_MOD, 0, MOD_BYTES, stream);
    Params p{};
    for (int i = 0; i < 18; ++i) p.in[i] = (const float*)d_in[i];
    p.out = (float*)d_out; p.ws = (unsigned char*)d_ws;
    void* args[] = {&p};
    hipError_t e = hipLaunchCooperativeKernel((const void*)fwd_megakernel, dim3(grid), dim3(512), args, LDS_BYTES, stream);
    if (e != hipSuccess) fprintf(stderr, "cooperative launch failed: %s (grid %d)\n", hipGetErrorString(e), grid);
}
```

```cpp
#include <hip/hip_runtime.h>
#include <hip/hip_cooperative_groups.h>
#include <cstdio>
#include <cstdint>
namespace cg = cooperative_groups;
namespace pg8 {
#define PG8_LAS __attribute__((address_space(3)))
typedef unsigned short bf16_t;
typedef short bf16x8 __attribute__((ext_vector_type(8)));
typedef float f32x4 __attribute__((ext_vector_type(4)));
typedef unsigned u32x4 __attribute__((ext_vector_type(4)));
constexpr int BM = 256, BK = 64, HALF = 128, HTB = HALF * BK * 2  , STAGE_BYTES = 8 * HTB, NXCD = 8, WGM = 8;

__host__ __device__ __forceinline__ int lds_byte(int r, int c) { const int st = (r >> 4) * 2 + (c >> 5), rr = r & 15, cc = c & 31, ob = rr * 64 + cc * 2; return st * 1024 + (ob ^ (((ob >> 9) & 1) << 5)); }
__host__ __device__ __forceinline__ void stage_rc(int b, int& R, int& C) { const int st = b / 1024, sb = b % 1024, swz = sb ^ (((sb >> 9) & 1) << 5); R = (st >> 1) * 16 + swz / 64; C = (st & 1) * 32 + (swz % 64) / 2; }
__host__ __device__ __forceinline__ int perm32(int rho) { const int n = rho >> 4, i = rho & 15; return 8 * (i >> 2) + 4 * n + (i & 3); }

struct Unit { int pm, pn; };
struct Gemm { const bf16_t* A; const bf16_t* Bt; int M, N, K; };

struct StaticOrder {
    int nM, nN, nwg, G, c;
    __host__ __device__ void init(int M, int N, int G_, int c_) { nM = M / BM; nN = N / BM; nwg = nM * nN; G = G_; c = c_; }
    __host__ __device__ bool next(int i, Unit& u) const {
        const long L = (long)i * G + c; if (L >= nwg) return false;
        int wgid = (int)L; { const int q = nwg / NXCD, r = nwg % NXCD, xcd = wgid % NXCD, off = wgid / NXCD; wgid = (xcd < r ? xcd * (q + 1) : r * (q + 1) + (xcd - r) * q) + off; }
        const int nig = WGM * nN, gid = wgid / nig, fm = gid * WGM, gsz = (nM - fm) < WGM ? (nM - fm) : WGM;
        u.pm = fm + ((wgid % nig) % gsz); u.pn = (wgid % nig) / gsz; return true;
    }
    __device__ __forceinline__ void a_ready(const Unit&) const {}
    __device__ __forceinline__ void done(const Unit&) const {}
};

__device__ __forceinline__ unsigned cvt_pk_bf16(float lo, float hi) { unsigned r; asm volatile("v_cvt_pk_bf16_f32 %0, %1, %2" : "=v"(r) : "v"(lo), "v"(hi)); return r; }
typedef float f32x2 __attribute__((ext_vector_type(2)));
__device__ __forceinline__ f32x2 gelu_pk(f32x2 v) {
    const f32x2 av = __builtin_elementwise_abs(v), d = av * 0.2316418882f + 1.0f;
    f32x2 t; t.x = __builtin_amdgcn_rcpf(d.x); t.y = __builtin_amdgcn_rcpf(d.y);
    f32x2 q = t * 0.5307027145f + (-0.7265760135f); q = q * t + 0.7107068705f; q = q * t + (-0.142248368f); q = q * t + 0.127414796f; q = q * t;
    const f32x2 s = (v * v) * (-0.72134752044f);
    f32x2 e; e.x = __builtin_amdgcn_exp2f(s.x); e.y = __builtin_amdgcn_exp2f(s.y);
    const f32x2 m = v * (q * e), r = v - m;
    f32x2 o; o.x = v.x < 0.f ? m.x : r.x; o.y = v.y < 0.f ? m.y : r.y; return o;
}

template <int ACT  > struct EpiBf16 {
    static constexpr bool PERM = true, AFTER_DRAIN = false; static_assert(ACT == 0 || ACT == 1, "EpiBf16: ACT is 0 (none) or 1 (gelu_pk)");
    bf16_t* O; int ldc; const float* bias; int split_cols; size_t split_stride; float scale0;
    __device__ __forceinline__ void operator()(const f32x4 (&acc)[2][2][4][2], const Unit& u, int wr, int wc, int fr, int fq) const {
        const int row0 = u.pm * BM + wr * 64 + fr; int colt = u.pn * BM; bf16_t* base = O;
        float sc = 1.f; if (split_cols) { const int t = colt / split_cols; base += (size_t)t * split_stride; colt -= t * split_cols; if (t == 0) sc = scale0; }
        const int col0 = colt + wc * 32 + 8 * fq, bcol0 = u.pn * BM + wc * 32 + 8 * fq;
        f32x4 bv[2][2];
#pragma unroll
        for (int bj = 0; bj < 2; ++bj)
#pragma unroll
            for (int n = 0; n < 2; ++n) bv[bj][n] = bias ? *(const f32x4*)(bias + bcol0 + bj * HALF + 4 * n) : (f32x4){0.f, 0.f, 0.f, 0.f};
#pragma unroll
        for (int ai = 0; ai < 2; ++ai)
#pragma unroll
            for (int m = 0; m < 4; ++m) { bf16_t* rowp = base + (size_t)(row0 + ai * HALF + m * 16) * ldc + col0;
#pragma unroll
                for (int bj = 0; bj < 2; ++bj) { f32x4 v0 = acc[ai][bj][m][0] + bv[bj][0], v1 = acc[ai][bj][m][1] + bv[bj][1];
                    if (ACT == 1) { f32x2 a = gelu_pk((f32x2){v0[0], v0[1]}), b = gelu_pk((f32x2){v0[2], v0[3]}), c = gelu_pk((f32x2){v1[0], v1[1]}), d = gelu_pk((f32x2){v1[2], v1[3]});
                        v0 = (f32x4){a.x, a.y, b.x, b.y}; v1 = (f32x4){c.x, c.y, d.x, d.y}; }
                    v0 = v0 * sc; v1 = v1 * sc; u32x4 w; w.x = cvt_pk_bf16(v0[0], v0[1]); w.y = cvt_pk_bf16(v0[2], v0[3]); w.z = cvt_pk_bf16(v1[0], v1[1]); w.w = cvt_pk_bf16(v1[2], v1[3]);
                    *(u32x4*)(rowp + bj * HALF) = w; } }
    }
};
template <class Epi, class Sched, bool ALIGN_EPI = false, bool SP2 = false>
__device__ __forceinline__ void gemm_phase(PG8_LAS unsigned char* lds, const Gemm g, const Sched& S, const Epi& E) {
    int tid_o = threadIdx.x; asm volatile("" : "+v"(tid_o));
    const int tid = tid_o, wid = __builtin_amdgcn_readfirstlane(tid >> 6), lane = tid & 63, wr = wid >> 2, wc = wid & 3, fr = lane & 15, fq = lane >> 4;
    const int K = g.K, nt = K / BK;
    unsigned voffA[2], voffB[2];
#pragma unroll
    for (int i = 0; i < 2; ++i) { int R, C; stage_rc(tid * 16 + i * 8192, R, C); const int Rb = Epi::PERM ? ((R & ~31) + perm32(R & 31)) : R;
        voffA[i] = (unsigned)(R * K + C) * 2u; voffB[i] = (unsigned)(Rb * K + C) * 2u; }
    const size_t kstep = (size_t)(BK * 2);
    const size_t hstep = (size_t)HALF * K * 2;
    const size_t tstep = 2 * hstep;
    const unsigned ldsw = (unsigned)wid * 1024u;
    const int aoff = lds_byte(wr * 64 + fr, fq * 8), boff = lds_byte(wc * 32 + fr, fq * 8);
#define PG8_SA(b, h) (((b) * 2 + (h)) * HTB)
#define PG8_SB(b, h) ((4 + (b) * 2 + (h)) * HTB)
#define PG8_STAGE(bufoff, gbase, voff) do { _Pragma("unroll") for (int _i = 0; _i < 2; ++_i) \
        __builtin_amdgcn_global_load_lds((const unsigned*)((const char*)(gbase) + (voff)[_i]), (PG8_LAS unsigned*)(lds + (bufoff) + ldsw + _i * 8192), 16, 0, 0); } while (0)
#define PG8_LDA(dst, b, h) do { _Pragma("unroll") for (int m = 0; m < 4; ++m) _Pragma("unroll") for (int k = 0; k < 2; ++k) dst[m][k] = *(const PG8_LAS bf16x8*)(lds + PG8_SA(b, h) + aoff + m * 2048 + k * 1024); } while (0)
#define PG8_LDB(dst, b, h) do { _Pragma("unroll") for (int n = 0; n < 2; ++n) _Pragma("unroll") for (int k = 0; k < 2; ++k) dst[n][k] = *(const PG8_LAS bf16x8*)(lds + PG8_SB(b, h) + boff + n * 2048 + k * 1024); } while (0)
#define PG8_MMA(ai, bj, At, Bt) do { __builtin_amdgcn_s_setprio(1); _Pragma("unroll") for (int m = 0; m < 4; ++m) _Pragma("unroll") for (int n = 0; n < 2; ++n) _Pragma("unroll") for (int k = 0; k < 2; ++k) \
        acc[ai][bj][m][n] = __builtin_amdgcn_mfma_f32_16x16x32_bf16(Bt[n][k], At[m][k], acc[ai][bj][m][n], 0, 0, 0); __builtin_amdgcn_s_setprio(0); } while (0)
#define PG8_WAIT_V(n) asm volatile("s_waitcnt vmcnt(" #n ")" ::: "memory")
#define PG8_WAIT_L(n) asm volatile("s_waitcnt lgkmcnt(" #n ")" ::: "memory")
#define PG8_BAR __builtin_amdgcn_s_barrier()
#define PG8_SCHED __builtin_amdgcn_sched_barrier(0)
    Unit cur, nxt; int ui = 0;
    if (!S.next(0, cur)) return;
    f32x4 acc[2][2][4][2];
#pragma unroll
    for (int a = 0; a < 2; ++a)
#pragma unroll
        for (int b = 0; b < 2; ++b)
#pragma unroll
            for (int m = 0; m < 4; ++m)
#pragma unroll
                for (int n = 0; n < 2; ++n) acc[a][b][m][n] = (f32x4){0.f, 0.f, 0.f, 0.f};
    bf16x8 At[4][2], B0[2][2], B1[2][2];
    const char* cA = (const char*)g.A + (size_t)cur.pm * tstep; const char* cB = (const char*)g.Bt + (size_t)cur.pn * tstep;
    S.a_ready(cur);
    if constexpr (SP2) {
        PG8_STAGE(PG8_SB(0, 0), cB, voffB); PG8_STAGE(PG8_SB(0, 1), cB + hstep, voffB); PG8_STAGE(PG8_SA(0, 0), cA, voffA); PG8_STAGE(PG8_SA(0, 1), cA + hstep, voffA);
        if (wr == 1) PG8_BAR;
        PG8_WAIT_V(2); PG8_BAR;
        PG8_STAGE(PG8_SB(1, 0), cB + kstep, voffB); PG8_STAGE(PG8_SA(1, 0), cA + kstep, voffA); PG8_STAGE(PG8_SB(1, 1), cB + hstep + kstep, voffB);
        PG8_WAIT_V(6); PG8_BAR;
    } else {
        PG8_STAGE(PG8_SB(0, 0), cB, voffB); PG8_STAGE(PG8_SA(0, 0), cA, voffA); PG8_STAGE(PG8_SB(0, 1), cB + hstep, voffB); PG8_STAGE(PG8_SA(0, 1), cA + hstep, voffA);
        if (wr == 1) PG8_BAR;
        PG8_WAIT_V(4); PG8_BAR;
        PG8_STAGE(PG8_SB(1, 0), cB + kstep, voffB); PG8_STAGE(PG8_SA(1, 0), cA + kstep, voffA); PG8_STAGE(PG8_SB(1, 1), cB + hstep + kstep, voffB);
        PG8_WAIT_V(6); PG8_BAR;
    }
    for (;;) {
        const bool has_next = S.next(ui + 1, nxt);
        const char* nA = has_next ? (const char*)g.A + (size_t)nxt.pm * tstep : cA; const char* nB = has_next ? (const char*)g.Bt + (size_t)nxt.pn * tstep : cB;
        for (int t = 0; t < nt; t += 2) {
            const bool last = (t == nt - 2);
            const char* a1 = cA + (size_t)(t + 1) * kstep;
            const char* a2 = last ? nA : cA + (size_t)(t + 2) * kstep; const char* b2 = last ? nB : cB + (size_t)(t + 2) * kstep;
            const char* a3 = a2 + kstep; const char* b3 = b2 + kstep;
            if (last && has_next) S.a_ready(nxt);
            if constexpr (SP2) {
            PG8_LDB(B0, 0, 0); PG8_LDB(B1, 0, 1); PG8_SCHED; PG8_LDA(At, 0, 0); PG8_STAGE(PG8_SA(1, 1), a1 + hstep, voffA);
            PG8_WAIT_V(8); PG8_WAIT_L(0); PG8_BAR; PG8_MMA(0, 0, At, B0); PG8_MMA(0, 1, At, B1); PG8_BAR; PG8_SCHED;
            PG8_LDA(At, 0, 1); PG8_STAGE(PG8_SB(0, 0), b2, voffB); PG8_STAGE(PG8_SB(0, 1), b2 + hstep, voffB); PG8_STAGE(PG8_SA(0, 0), a2, voffA);
            PG8_WAIT_V(8); PG8_WAIT_L(0); PG8_BAR; PG8_MMA(1, 0, At, B0); PG8_MMA(1, 1, At, B1); PG8_BAR; PG8_SCHED;
            PG8_LDB(B0, 1, 0); PG8_LDB(B1, 1, 1); PG8_SCHED; PG8_LDA(At, 1, 0); PG8_STAGE(PG8_SA(0, 1), a2 + hstep, voffA);
            PG8_WAIT_V(8); PG8_WAIT_L(0); PG8_BAR; PG8_MMA(0, 0, At, B0); PG8_MMA(0, 1, At, B1); PG8_BAR; PG8_SCHED;
            PG8_LDA(At, 1, 1); PG8_STAGE(PG8_SB(1, 0), b3, voffB); PG8_STAGE(PG8_SB(1, 1), b3 + hstep, voffB); PG8_STAGE(PG8_SA(1, 0), a3, voffA);
            PG8_WAIT_V(8); PG8_WAIT_L(0); PG8_BAR; PG8_MMA(1, 0, At, B0); PG8_MMA(1, 1, At, B1); PG8_BAR; PG8_SCHED;
            } else {
            PG8_LDB(B0, 0, 0); PG8_SCHED; PG8_LDA(At, 0, 0); PG8_STAGE(PG8_SA(1, 1), a1 + hstep, voffA);
            PG8_WAIT_L(8); PG8_BAR; PG8_WAIT_L(0); PG8_MMA(0, 0, At, B0); PG8_BAR; PG8_SCHED;
            PG8_LDB(B1, 0, 1); PG8_STAGE(PG8_SB(0, 0), b2, voffB);
            PG8_BAR; PG8_WAIT_L(0); PG8_MMA(0, 1, At, B1); PG8_BAR;
            PG8_LDA(At, 0, 1); PG8_STAGE(PG8_SA(0, 0), a2, voffA);
            PG8_BAR; PG8_WAIT_L(0); PG8_MMA(1, 0, At, B0); PG8_BAR; PG8_SCHED;
            PG8_STAGE(PG8_SB(0, 1), b2 + hstep, voffB);
            PG8_WAIT_V(6); PG8_BAR; PG8_MMA(1, 1, At, B1); PG8_BAR;
            PG8_LDB(B0, 1, 0); PG8_SCHED; PG8_LDA(At, 1, 0); PG8_STAGE(PG8_SA(0, 1), a2 + hstep, voffA);
            PG8_WAIT_L(8); PG8_BAR; PG8_WAIT_L(0); PG8_MMA(0, 0, At, B0); PG8_BAR; PG8_SCHED;
            PG8_LDB(B1, 1, 1); PG8_STAGE(PG8_SB(1, 0), b3, voffB);
            PG8_BAR; PG8_WAIT_L(0); PG8_MMA(0, 1, At, B1); PG8_BAR;
            PG8_LDA(At, 1, 1); PG8_STAGE(PG8_SA(1, 0), a3, voffA);
            PG8_BAR; PG8_WAIT_L(0); PG8_MMA(1, 0, At, B0); PG8_BAR; PG8_SCHED;
            PG8_STAGE(PG8_SB(1, 1), b3 + hstep, voffB);
            PG8_WAIT_V(6); PG8_BAR; PG8_MMA(1, 1, At, B1); PG8_BAR;
            }
        }
        if constexpr (ALIGN_EPI) { if (wr == 0) PG8_BAR; }
        if constexpr (!Epi::AFTER_DRAIN) { E(acc, cur, wr, wc, fr, fq); S.done(cur); }
        if (!has_next) break;
#pragma unroll
        for (int a = 0; a < 2; ++a)
#pragma unroll
            for (int b = 0; b < 2; ++b)
#pragma unroll
                for (int m = 0; m < 4; ++m)
#pragma unroll
                    for (int n = 0; n < 2; ++n) acc[a][b][m][n] = (f32x4){0.f, 0.f, 0.f, 0.f};
        cur = nxt; cA = nA; cB = nB; ++ui;
        if constexpr (ALIGN_EPI) { if (wr == 1) PG8_BAR; }
    }
    PG8_WAIT_V(0);
    if constexpr (!ALIGN_EPI) { if (wr == 0) PG8_BAR; }
    PG8_BAR;
    if constexpr (Epi::AFTER_DRAIN) { E.fused(acc, cur, wr, wc, fr, fq, lds, wid, lane); S.done(cur); }
#undef PG8_SA
#undef PG8_SB
#undef PG8_STAGE
#undef PG8_LDA
#undef PG8_LDB
#undef PG8_MMA
#undef PG8_WAIT_V
#undef PG8_WAIT_L
#undef PG8_BAR
#undef PG8_SCHED
}
}

#define LAS __attribute__((address_space(3)))
typedef unsigned short bf16_t;
typedef short bf16x8 __attribute__((ext_vector_type(8)));
typedef float f32x4 __attribute__((ext_vector_type(4)));
typedef float f32x2 __attribute__((ext_vector_type(2)));
typedef float f32x16 __attribute__((ext_vector_type(16)));
typedef unsigned u32x4 __attribute__((ext_vector_type(4)));
typedef unsigned u32x2 __attribute__((ext_vector_type(2)));
#define MFMA32(a, b, c) __builtin_amdgcn_mfma_f32_32x32x16_bf16((a), (b), (c), 0, 0, 0)

constexpr int DM = 1024, SEQ = 16384, NBP = 2, DEPTH = 4, DB = 16, DS = 32, PAST = 2048;
constexpr int MP = NBP * SEQ, MS = DB * DS, MT = MP + MS;
constexpr int INW = 3584, DFF = 2816, NMOD = 6144, NBI = 18;
constexpr float EPS = 1e-6f;
constexpr size_t OFF_YP = 0, OFF_YS = 33554432, OFF_KP = 34078720, OFF_VP = 101187584, OFF_RP = 168296448,
                 OFF_KS = 168820736, OFF_VS = 169869312, OFF_RS = 170917888;
constexpr size_t MiB = 1u << 20;
constexpr size_t WS_MOD = 0, MOD_BYTES = 2 * MiB; constexpr size_t WS_CTR = 1820160;
constexpr size_t WS_BAR = 1802240;
constexpr size_t WS_ROPE = 2 * MiB;
constexpr size_t WS_WIN = 10 * MiB, WS_WOUT = 38 * MiB, WS_WFI = 46 * MiB, WS_WFO = 90 * MiB;
constexpr size_t WS_X = 112 * MiB;
constexpr size_t WS_H = 242 * MiB;
constexpr size_t WS_O = 307 * MiB;
constexpr size_t WS_QKV = 372 * MiB;
constexpr size_t WS_U = 600 * MiB;
constexpr size_t WS_END = 616 * MiB;
constexpr int LDS_BYTES = 147456;

struct Params { const float* in[18]; float* out; unsigned char* ws; };

typedef __bf16 bf16x2_t __attribute__((ext_vector_type(2)));
__device__ __forceinline__ unsigned pk2(float lo, float hi) { const f32x2 v = {lo, hi}; return __builtin_bit_cast(unsigned, __builtin_convertvector(v, bf16x2_t)); }
__device__ __forceinline__ unsigned f2bf(float f) { return pk2(f, 0.f) & 0xffffu; }
__device__ __forceinline__ float bf2f(unsigned h) { return __builtin_bit_cast(float, h << 16); }
__device__ __forceinline__ bf16x8 pack8(f32x4 a, f32x4 b) { u32x4 p; p.x = pk2(a.x, a.y); p.y = pk2(a.z, a.w); p.z = pk2(b.x, b.y); p.w = pk2(b.z, b.w); return __builtin_bit_cast(bf16x8, p); }
__device__ __forceinline__ float wave_sum(float v) {
#pragma unroll
    for (int o = 1; o < 64; o <<= 1) v += __shfl_xor(v, o);
    return v;
}
__device__ __forceinline__ float silu_f(float x) { return x * __builtin_amdgcn_rcpf(1.f + __expf(-x)); }
__device__ __forceinline__ int batch_of(int row) { return row < MP ? (row >> 14) : 2 + ((row - MP) >> 5); }

struct EpiQKV {
    static constexpr bool PERM = true, AFTER_DRAIN = false;
    bf16_t* QKV; float* out; int layer;
    __device__ __forceinline__ void operator()(const pg8::f32x4 (&acc)[2][2][4][2], const pg8::Unit& u, int wr, int wc, int fr, int fq) const {
        const int row0 = u.pm * 256 + wr * 64 + fr, col0 = u.pn * 256 + wc * 32 + 8 * fq;
        const bool kv = (u.pn >= 2 && u.pn < 6);
        const size_t vsel = (u.pn >= 4) ? 1 : 0;
        const size_t obase = (u.pm < 128) ? OFF_KP + vsel * (OFF_VP - OFF_KP) + (size_t)layer * MP * 512 + (size_t)row0 * 512
                                          : OFF_KS + vsel * (OFF_VS - OFF_KS) + (size_t)layer * MS * 512 + (size_t)(row0 - MP) * 512;
#pragma unroll
        for (int ai = 0; ai < 2; ++ai)
#pragma unroll
            for (int m = 0; m < 4; ++m) {
                const int row = row0 + ai * 128 + m * 16;
#pragma unroll
                for (int bj = 0; bj < 2; ++bj) {
                    const int col = col0 + bj * 128;
                    const pg8::f32x4 v0 = acc[ai][bj][m][0], v1 = acc[ai][bj][m][1];
                    u32x4 w; w.x = pg8::cvt_pk_bf16(v0[0], v0[1]); w.y = pg8::cvt_pk_bf16(v0[2], v0[3]); w.z = pg8::cvt_pk_bf16(v1[0], v1[1]); w.w = pg8::cvt_pk_bf16(v1[2], v1[3]);
                    *(u32x4*)(QKV + (size_t)row * INW + col) = w;
                    if (kv) {
                        const int c = col & 511;
                        float* dst = out + obase + (size_t)(ai * 128 + m * 16) * 512 + c;
                        *(pg8::f32x4*)dst = v0; *(pg8::f32x4*)(dst + 4) = v1;
                    }
                }
                asm volatile("" ::: "memory");
            }
    }
};
struct EpiResid {
    static constexpr bool PERM = false, AFTER_DRAIN = false;
    const float* base_p; const float* base_s;
    float* X; const float* gate;
    __device__ __forceinline__ void operator()(const pg8::f32x4 (&acc)[2][2][4][2], const pg8::Unit& u, int wr, int wc, int fr, int fq) const {
        const int col0 = u.pn * 256 + wc * 32 + 4 * fq;
        const bool uni = u.pm < 128;
        pg8::f32x4 gv[4];
        { const float* gr = gate + (size_t)batch_of(u.pm * 256 + wr * 64 + fr) * NMOD;
#pragma unroll
          for (int q = 0; q < 4; ++q) gv[q] = *(const pg8::f32x4*)(gr + col0 + (q >> 1) * 128 + (q & 1) * 16); }
#pragma unroll
        for (int grp = 0; grp < 4; ++grp) {
            const int ai = grp >> 1, m0 = (grp & 1) * 2;
            pg8::f32x4 bv[2][4];
#pragma unroll
            for (int mm = 0; mm < 2; ++mm) {
                const int row = u.pm * 256 + ai * 128 + wr * 64 + (m0 + mm) * 16 + fr;
                const float* br = base_p ? (row < MP ? base_p + (size_t)row * DM : base_s + (size_t)(row - MP) * DM) : X + (size_t)row * DM;
#pragma unroll
                for (int q = 0; q < 4; ++q) bv[mm][q] = *(const pg8::f32x4*)(br + col0 + (q >> 1) * 128 + (q & 1) * 16);
            }
#pragma unroll
            for (int mm = 0; mm < 2; ++mm) {
                const int m = m0 + mm, row = u.pm * 256 + ai * 128 + wr * 64 + m * 16 + fr;
                if (!uni) { const float* gr = gate + (size_t)batch_of(row) * NMOD;
#pragma unroll
                    for (int q = 0; q < 4; ++q) gv[q] = *(const pg8::f32x4*)(gr + col0 + (q >> 1) * 128 + (q & 1) * 16); }
                float* xr = X + (size_t)row * DM;
#pragma unroll
                for (int q = 0; q < 4; ++q) { const int bj = q >> 1, n = q & 1;
                    *(pg8::f32x4*)(xr + col0 + bj * 128 + n * 16) = bv[mm][q] + gv[q] * acc[ai][bj][m][n]; }
            }
            asm volatile("" ::: "memory");
        }
    }
};
struct EpiSwiGLU {
    static constexpr bool PERM = true, AFTER_DRAIN = false;
    bf16_t* ACT;
    __device__ __forceinline__ void operator()(const pg8::f32x4 (&acc)[2][2][4][2], const pg8::Unit& u, int wr, int wc, int fr, int fq) const {
        const int col0 = u.pn * 128 + wc * 32 + 8 * fq;
#pragma unroll
        for (int ai = 0; ai < 2; ++ai)
#pragma unroll
            for (int m = 0; m < 4; ++m) {
                const int row = u.pm * 256 + ai * 128 + wr * 64 + m * 16 + fr;
                const pg8::f32x4 g0 = acc[ai][0][m][0], g1 = acc[ai][0][m][1], u0 = acc[ai][1][m][0], u1 = acc[ai][1][m][1];
                float r[8];
#pragma unroll
                for (int j = 0; j < 4; ++j) { r[j] = silu_f(g0[j]) * u0[j]; r[4 + j] = silu_f(g1[j]) * u1[j]; }
                u32x4 w; w.x = pg8::cvt_pk_bf16(r[0], r[1]); w.y = pg8::cvt_pk_bf16(r[2], r[3]); w.z = pg8::cvt_pk_bf16(r[4], r[5]); w.w = pg8::cvt_pk_bf16(r[6], r[7]);
                *(u32x4*)(ACT + (size_t)row * DFF + col0) = w;
                asm volatile("" ::: "memory");
            }
    }
};


template <int NKS  , int UNR, class Epi>
__device__ __forceinline__ void sgemm_phase(LAS unsigned char* lds, const bf16_t* A  , int lda, const bf16_t* Bt, int K, int ncb,
                                            int tid, int lane, int wave, const Epi& E) {
    const int l32 = lane & 31, hf = lane >> 5;
    LAS float* red = (LAS float*)lds;
    const int kw0 = wave * NKS * 16 + hf * 8;
    for (int it = blockIdx.x; it < 16 * ncb; it += gridDim.x) {
        const int rb = it & 15, cb = it >> 4;
        int n0, n1; E.cols(cb, n0, n1);
        const bf16_t* ap = A + (size_t)(rb * 32 + l32) * lda + kw0;
        const bf16_t* b0p = Bt + (size_t)(n0 + l32) * K + kw0;
        const bf16_t* b1p = Bt + (size_t)(n1 + l32) * K + kw0;
        f32x16 c0, c1;
#pragma unroll
        for (int r = 0; r < 16; ++r) { c0[r] = 0.f; c1[r] = 0.f; }
#pragma unroll 1
        for (int kb = 0; kb < NKS; kb += UNR) {
            bf16x8 a[UNR], b0[UNR], b1[UNR];
#pragma unroll
            for (int j = 0; j < UNR; ++j) { a[j] = *(const bf16x8*)(ap + (kb + j) * 16); b0[j] = *(const bf16x8*)(b0p + (kb + j) * 16); b1[j] = *(const bf16x8*)(b1p + (kb + j) * 16); }
#pragma unroll
            for (int j = 0; j < UNR; ++j) { c0 = MFMA32(a[j], b0[j], c0); c1 = MFMA32(a[j], b1[j], c1); }
        }
        LAS float* rw = red + wave * 2176;
#pragma unroll
        for (int r = 0; r < 16; ++r) { const int row = (r >> 2) * 8 + hf * 4 + (r & 3); rw[row * 34 + l32] = c0[r]; rw[1088 + row * 34 + l32] = c1[r]; }
        __syncthreads();
        {
            const int row = tid >> 4, cc = (tid & 15) * 2;
            f32x2 g = {0.f, 0.f}, u = {0.f, 0.f};
#pragma unroll
            for (int w = 0; w < 8; ++w) { g += *(const LAS f32x2*)(red + w * 2176 + row * 34 + cc); u += *(const LAS f32x2*)(red + w * 2176 + 1088 + row * 34 + cc); }
            E(rb * 32 + row, n0 + cc, n1 + cc, g, u);
        }
        __syncthreads();
    }
}
struct SEpiQKV {
    bf16_t* QKV; float* out; int layer;
    __device__ __forceinline__ void cols(int cb, int& n0, int& n1) const { n0 = cb * 64; n1 = n0 + 32; }
    __device__ __forceinline__ void emit(int r, int c, f32x2 v) const {
        *(unsigned*)(QKV + (size_t)(MP + r) * INW + c) = pk2(v.x, v.y);
        if (c >= 512 && c < 1536) { const size_t off = (c < 1024 ? OFF_KS : OFF_VS) + ((size_t)layer * MS + r) * 512 + (c & 511); *(f32x2*)(out + off) = v; }
    }
    __device__ __forceinline__ void operator()(int r, int c0, int c1, f32x2 g, f32x2 u) const { emit(r, c0, g); emit(r, c1, u); }
};
struct SEpiResid {
    const float* base; float* Xs; const float* gate;
    __device__ __forceinline__ void cols(int cb, int& n0, int& n1) const { n0 = cb * 64; n1 = n0 + 32; }
    __device__ __forceinline__ void operator()(int r, int c0, int c1, f32x2 g, f32x2 u) const {
        const float* gp = gate + (size_t)(2 + (r >> 5)) * NMOD; const float* bp = base + (size_t)r * DM; float* xp = Xs + (size_t)r * DM;
        const f32x2 x0 = *(const f32x2*)(bp + c0) + *(const f32x2*)(gp + c0) * g, x1 = *(const f32x2*)(bp + c1) + *(const f32x2*)(gp + c1) * u;
        *(f32x2*)(xp + c0) = x0; *(f32x2*)(xp + c1) = x1;
    }
};
struct SEpiSwiGLU {
    bf16_t* ACT;
    __device__ __forceinline__ void cols(int cb, int& n0, int& n1) const { n0 = (cb >> 2) * 256 + (cb & 3) * 32; n1 = n0 + 128; }
    __device__ __forceinline__ void operator()(int r, int c0, int c1, f32x2 g, f32x2 u) const {
        const int col = (c0 >> 8) * 128 + (c0 & 127);
        *(unsigned*)(ACT + (size_t)(MP + r) * DFF + col) = pk2(silu_f(g.x) * u.x, silu_f(g.y) * u.y);
    }
};

__device__ __forceinline__ void transpose_item(const float* W, int K, int N, bf16_t* WT, LAS float* scr, int item, int lane, bool perm) {
    const int nblk = N / 32, kb = item / nblk, nb = item % nblk, k0 = 64 * kb, n0 = 32 * nb;
    int p0 = n0;
    if (perm) { if (n0 < DFF) p0 = (n0 >> 7) * 256 + (n0 & 127); else { const int n1 = n0 - DFF; p0 = (n1 >> 7) * 256 + 128 + (n1 & 127); } }
#pragma unroll 8
    for (int i = 0; i < 32; ++i) { const int kk = 2 * i + (lane >> 5); scr[kk * 33 + (lane & 31)] = W[(size_t)(k0 + kk) * N + n0 + (lane & 31)]; }
    asm volatile("s_waitcnt lgkmcnt(0)" ::: "memory"); __builtin_amdgcn_wave_barrier();
    const int c = lane & 7;
#pragma unroll
    for (int j = 0; j < 4; ++j) { const int n = (lane >> 3) + 8 * j; const LAS float* s = scr + (8 * c) * 33 + n;
        u32x4 o; o.x = pk2(s[0 * 33], s[1 * 33]); o.y = pk2(s[2 * 33], s[3 * 33]); o.z = pk2(s[4 * 33], s[5 * 33]); o.w = pk2(s[6 * 33], s[7 * 33]);
        *(u32x4*)(WT + (size_t)(p0 + n) * K + k0 + 8 * c) = o; }
    asm volatile("s_waitcnt lgkmcnt(0)" ::: "memory"); __builtin_amdgcn_wave_barrier();
}

__device__ __forceinline__ void p0_phase(const Params& P, LAS unsigned char* lds, int tid, int lane, int wave) {
    LAS float* sc = (LAS float*)lds;
    for (int i = tid; i < NBI * DM; i += 512) { const int b = i >> 10, k = i & 1023; const float c = b < 2 ? P.in[5][b * DM + k] : P.in[6][(b - 2) * DM + k]; sc[i] = silu_f(c); }
    __syncthreads();
    const int gw = blockIdx.x * 8 + wave, NGW = gridDim.x * 8;
    float* MOD = (float*)(P.ws + WS_MOD);
    for (int it = gw; it < 768; it += NGW) {
        const int l = it / 192, r = it % 192, cb = r >> 3, kc = r & 7;
        f32x4 acc[NBI];
#pragma unroll
        for (int b = 0; b < NBI; ++b) acc[b] = (f32x4){0.f, 0.f, 0.f, 0.f};
        const float* wp = P.in[9] + ((size_t)l * DM + kc * 128) * NMOD + cb * 256 + lane * 4;
        const LAS float* scp = sc + kc * 128;
#pragma unroll 4
        for (int k = 0; k < 128; ++k) { const f32x4 w = *(const f32x4*)(wp + (size_t)k * NMOD);
#pragma unroll
            for (int b = 0; b < NBI; ++b) acc[b] += scp[b * DM + k] * w; }
        if (kc == 0) { const f32x4 bv = *(const f32x4*)(P.in[10] + (size_t)l * NMOD + cb * 256 + lane * 4);
#pragma unroll
            for (int b = 0; b < NBI; ++b) acc[b] += bv; }
        float* mp = MOD + (size_t)l * NBI * NMOD + cb * 256 + lane * 4;
#pragma unroll
        for (int b = 0; b < NBI; ++b) { atomicAdd(mp + b * NMOD + 0, acc[b].x); atomicAdd(mp + b * NMOD + 1, acc[b].y); atomicAdd(mp + b * NMOD + 2, acc[b].z); atomicAdd(mp + b * NMOD + 3, acc[b].w); }
    }
    LAS float* scr = (LAS float*)(lds + 73728 + wave * 8448);
    constexpr int I_IN = 16 * 112, I_OUT = 16 * 32, I_FI = 16 * 176, I_FO = 44 * 32, I_L = I_IN + I_OUT + I_FI + I_FO;
    for (int it = gw; it < DEPTH * I_L; it += NGW) {
        const int l = it / I_L; int r = it % I_L;
        if (r < I_IN) { transpose_item(P.in[11] + (size_t)l * DM * INW, DM, INW, (bf16_t*)(P.ws + WS_WIN) + (size_t)l * INW * DM, scr, r, lane, false); continue; } r -= I_IN;
        if (r < I_OUT) { transpose_item(P.in[14] + (size_t)l * DM * DM, DM, DM, (bf16_t*)(P.ws + WS_WOUT) + (size_t)l * DM * DM, scr, r, lane, false); continue; } r -= I_OUT;
        if (r < I_FI) { transpose_item(P.in[15] + (size_t)l * DM * 2 * DFF, DM, 2 * DFF, (bf16_t*)(P.ws + WS_WFI) + (size_t)l * 2 * DFF * DM, scr, r, lane, true); continue; } r -= I_FI;
        transpose_item(P.in[16] + (size_t)l * DFF * DM, DFF, DM, (bf16_t*)(P.ws + WS_WFO) + (size_t)l * DM * DFF, scr, r, lane, false);
    }
    f32x2* ROPE = (f32x2*)(P.ws + WS_ROPE);
    for (int idx = blockIdx.x * 512 + tid; idx < SEQ * 64; idx += gridDim.x * 512) {
        const int pos = idx >> 6, i = idx & 63;
        const float inv = exp2f(-(float)i * (13.287712379549449f / 64.f));
        const float ang = (float)pos * inv;
        double rev = (double)ang * 0.15915494309189535; rev -= floor(rev);
        const float rf = (float)rev;
        ROPE[idx] = (f32x2){__builtin_amdgcn_cosf(rf), __builtin_amdgcn_sinf(rf)};
    }
}

template <bool FINAL>
__device__ __forceinline__ void norm_phase(const Params& P, int l, bool from_input, const float* gain, int sh_off, int sc_off, int lane, int wave) {
    const int gw = blockIdx.x * 8 + wave, NGW = gridDim.x * 8;
    const float* MOD = (const float*)(P.ws + WS_MOD) + (size_t)l * NBI * NMOD;
    const float* X = (const float*)(P.ws + WS_X); bf16_t* H = (bf16_t*)(P.ws + WS_H);
    f32x4 g[4];
#pragma unroll
    for (int j = 0; j < 4; ++j) g[j] = *(const f32x4*)(gain + 4 * lane + 256 * j);
    auto xrow = [&](int m) -> const float* { return (!FINAL && from_input) ? (m < MP ? P.in[0] + (size_t)m * DM : P.in[1] + (size_t)(m - MP) * DM) : X + (size_t)m * DM; };
    f32x4 vn[4];
    if (gw < MT) { const float* xr = xrow(gw);
#pragma unroll
        for (int j = 0; j < 4; ++j) vn[j] = *(const f32x4*)(xr + 4 * lane + 256 * j); }
    for (int m = gw; m < MT; m += NGW) {
        f32x4 v[4]; float ss = 0.f;
#pragma unroll
        for (int j = 0; j < 4; ++j) v[j] = vn[j];
        if (m + NGW < MT) { const float* xr = xrow(m + NGW);
#pragma unroll
            for (int j = 0; j < 4; ++j) vn[j] = *(const f32x4*)(xr + 4 * lane + 256 * j); }
        f32x4 sc[4], sh[4];
        if (!FINAL) { const float* mr = MOD + (size_t)batch_of(m) * NMOD;
#pragma unroll
            for (int j = 0; j < 4; ++j) { const int c = 4 * lane + 256 * j; sc[j] = *(const f32x4*)(mr + sc_off + c); sh[j] = *(const f32x4*)(mr + sh_off + c); } }
#pragma unroll
        for (int j = 0; j < 4; ++j) ss += (v[j].x * v[j].x + v[j].y * v[j].y) + (v[j].z * v[j].z + v[j].w * v[j].w);
        const float rstd = rsqrtf(wave_sum(ss) * (1.f / DM) + EPS);
        if (FINAL) {
            float* o = P.out + (size_t)m * DM;
#pragma unroll
            for (int j = 0; j < 4; ++j) *(f32x4*)(o + 4 * lane + 256 * j) = v[j] * rstd * g[j];
        } else {
#pragma unroll
            for (int j = 0; j < 4; ++j) { const int c = 4 * lane + 256 * j;
                const f32x4 hh = v[j] * rstd * g[j] * (1.f + sc[j]) + sh[j];
                u32x2 w; w.x = pk2(hh.x, hh.y); w.y = pk2(hh.z, hh.w);
                *(u32x2*)(H + (size_t)m * DM + c) = w; }
        }
    }
}

__device__ __forceinline__ void sb_unit(const Params& P, int l, int u, LAS unsigned char* lds, int tid, int lane, int wave) {
    const bf16_t* QKV = (const bf16_t*)(P.ws + WS_QKV);
    const int h = wave, l32 = lane & 31, hf = lane >> 5;
    const bool samp = u >= 1024;
    int qrow0, nsteps; const float* ck = nullptr; const float* cv = nullptr;
    if (!samp) { const int b = u >> 9, qb = u & 511; qrow0 = b * SEQ + qb * 32; nsteps = qb + 1; }
    else { const int bs = u - 1024; qrow0 = MP + bs * 32; nsteps = 65; ck = P.in[2] + (size_t)(l * DB + bs) * PAST * 512; cv = P.in[3] + (size_t)(l * DB + bs) * PAST * 512; }
    bf16x8 qf[4];
#pragma unroll
    for (int ks = 0; ks < 4; ++ks) qf[ks] = *(const bf16x8*)(QKV + (size_t)(qrow0 + l32) * INW + h * 64 + ks * 16 + hf * 8);
    f32x16 O0, O1;
#pragma unroll
    for (int r = 0; r < 16; ++r) { O0[r] = 0.f; O1[r] = 0.f; }
    float cum = 0.f;
    LAS unsigned char* vt = lds + 66048 + wave * 4608;
    auto issue = [&](int s, bf16x8 (&k)[4], bf16x8 (&v)[4]) {
        if (!samp || s == 0) {
            const int krow0 = samp ? qrow0 : qrow0 - s * 32;
#pragma unroll
            for (int ks = 0; ks < 4; ++ks) k[ks] = *(const bf16x8*)(QKV + (size_t)(krow0 + l32) * INW + 512 + h * 64 + ks * 16 + hf * 8);
#pragma unroll
            for (int it = 0; it < 4; ++it) { const int id = it * 64 + lane, key = id >> 3, ch = id & 7;
                v[it] = *(const bf16x8*)(QKV + (size_t)(krow0 + key) * INW + 1024 + h * 64 + ch * 8); }
        } else {
            const int kpos0 = (64 - s) * 32;
#pragma unroll
            for (int ks = 0; ks < 4; ++ks) { const float* p = ck + (size_t)(kpos0 + l32) * 512 + h * 64 + ks * 16 + hf * 8; k[ks] = pack8(*(const f32x4*)p, *(const f32x4*)(p + 4)); }
#pragma unroll
            for (int it = 0; it < 4; ++it) { const int id = it * 64 + lane, key = id >> 3, ch = id & 7;
                const float* p = cv + (size_t)(kpos0 + key) * 512 + h * 64 + ch * 8;
                v[it] = pack8(*(const f32x4*)p, *(const f32x4*)(p + 4)); }
        }
    };
    bf16x8 kf[4], vr[4];
    issue(0, kf, vr);
    for (int s = 0; s < nsteps; ++s) {
#pragma unroll
        for (int it = 0; it < 4; ++it) { const int id = it * 64 + lane, key = id >> 3, ch = id & 7; *(LAS bf16x8*)(vt + key * 144 + ch * 16) = vr[it]; }
        bf16x8 kn[4];
#pragma unroll
        for (int ks = 0; ks < 4; ++ks) kn[ks] = kf[ks];
        if (s + 1 < nsteps) issue(s + 1, kn, vr);
        asm volatile("s_waitcnt lgkmcnt(0)" ::: "memory"); __builtin_amdgcn_wave_barrier();
        f32x16 S;
#pragma unroll
        for (int r = 0; r < 16; ++r) S[r] = 0.f;
#pragma unroll
        for (int ks = 0; ks < 4; ++ks) S = MFMA32(kf[ks], qf[ks], S);
        float L[16], lb[16]; bool valid[16];
#pragma unroll
        for (int r = 0; r < 16; ++r) {
            const float z = S[r] * 0.125f;
            const float sp = fmaxf(z, 0.f) + __logf(1.f + __expf(-fabsf(z)));
            const int key = (r >> 2) * 8 + hf * 4 + (r & 3);
            valid[r] = (s != 0) || (key < l32);
            L[r] = valid[r] ? -sp : 0.f; lb[r] = z - sp;
        }
        float T[4], Pp[4];
#pragma unroll
        for (int g = 0; g < 4; ++g) { T[g] = (L[4 * g] + L[4 * g + 1]) + (L[4 * g + 2] + L[4 * g + 3]); Pp[g] = __shfl_xor(T[g], 32); }
        float later[4]; float tot = 0.f;
#pragma unroll
        for (int g = 3; g >= 0; --g) { later[g] = tot; tot += T[g] + Pp[g]; }
        float w[16];
#pragma unroll
        for (int g = 0; g < 4; ++g) {
            const float s3 = cum + later[g] + (hf == 0 ? Pp[g] : 0.f);
            const float s2 = s3 + L[4 * g + 3], s1 = s2 + L[4 * g + 2], s0 = s1 + L[4 * g + 1];
            w[4 * g + 3] = valid[4 * g + 3] ? __expf(lb[4 * g + 3] + s3) : 0.f;
            w[4 * g + 2] = valid[4 * g + 2] ? __expf(lb[4 * g + 2] + s2) : 0.f;
            w[4 * g + 1] = valid[4 * g + 1] ? __expf(lb[4 * g + 1] + s1) : 0.f;
            w[4 * g + 0] = valid[4 * g + 0] ? __expf(lb[4 * g + 0] + s0) : 0.f;
        }
        cum += tot;
#pragma unroll
        for (int c = 0; c < 2; ++c) {
            u32x4 pw; pw.x = pk2(w[8 * c], w[8 * c + 1]); pw.y = pk2(w[8 * c + 2], w[8 * c + 3]); pw.z = pk2(w[8 * c + 4], w[8 * c + 5]); pw.w = pk2(w[8 * c + 6], w[8 * c + 7]);
            const bf16x8 pa = __builtin_bit_cast(bf16x8, pw);
#pragma unroll
            for (int dt = 0; dt < 2; ++dt) {
                bf16x8 vb;
#pragma unroll
                for (int i = 0; i < 8; ++i) { const int key = 16 * c + 8 * (i >> 2) + 4 * hf + (i & 3); vb[i] = *(const LAS short*)(vt + key * 144 + (l32 + 32 * dt) * 2); }
                if (dt == 0) O0 = MFMA32(pa, vb, O0); else O1 = MFMA32(pa, vb, O1);
            }
        }
        asm volatile("" ::: "memory");
        if (__all(cum < -110.f)) break;
#pragma unroll
        for (int ks = 0; ks < 4; ++ks) kf[ks] = kn[ks];
    }
    LAS float* oa = (LAS float*)lds;
#pragma unroll
    for (int r = 0; r < 16; ++r) { const int q = (r >> 2) * 8 + hf * 4 + (r & 3); oa[q * 516 + h * 64 + l32] = O0[r]; oa[q * 516 + h * 64 + 32 + l32] = O1[r]; }
    __syncthreads();
    bf16_t* Ob = (bf16_t*)(P.ws + WS_O);
    const float* gsb = P.in[12] + (size_t)l * 512;
    {
        f32x4 ra[4], rb[4]; float sq[4];
#pragma unroll
        for (int rr = 0; rr < 4; ++rr) { const int q = wave * 4 + rr;
            ra[rr] = *(const LAS f32x4*)(oa + q * 516 + 4 * lane); rb[rr] = *(const LAS f32x4*)(oa + q * 516 + 256 + 4 * lane);
            const f32x4 a = ra[rr], b = rb[rr];
            sq[rr] = (a.x * a.x + a.y * a.y) + (a.z * a.z + a.w * a.w) + (b.x * b.x + b.y * b.y) + (b.z * b.z + b.w * b.w); }
#pragma unroll
        for (int o = 1; o < 64; o <<= 1) {
#pragma unroll
            for (int rr = 0; rr < 4; ++rr) sq[rr] += __shfl_xor(sq[rr], o);
        }
        const f32x4 ga = *(const f32x4*)(gsb + 4 * lane), gb = *(const f32x4*)(gsb + 256 + 4 * lane);
#pragma unroll
        for (int rr = 0; rr < 4; ++rr) { const int q = wave * 4 + rr;
            const float rstd = rsqrtf(sq[rr] * (1.f / 512.f) + EPS);
            const f32x4 ya = ra[rr] * rstd * ga, yb = rb[rr] * rstd * gb;
            u32x2 wa, wb; wa.x = pk2(ya.x, ya.y); wa.y = pk2(ya.z, ya.w); wb.x = pk2(yb.x, yb.y); wb.y = pk2(yb.z, yb.w);
            *(u32x2*)(Ob + (size_t)(qrow0 + q) * DM + 4 * lane) = wa; *(u32x2*)(Ob + (size_t)(qrow0 + q) * DM + 256 + 4 * lane) = wb; }
    }
    __syncthreads();
}

__device__ __forceinline__ void ret_unit(const Params& P, int l, LAS unsigned char* lds, int tid, int lane, int wave,
                                         int row0, int pos0, int nchunks, int L, int h, const float* init, float* outst, bool state_only) {
    const bf16_t* QKV = (const bf16_t*)(P.ws + WS_QKV); bf16_t* Ob = (bf16_t*)(P.ws + WS_O);
    const f32x2* ROPE = (const f32x2*)(P.ws + WS_ROPE);
    const float lg2 = log2f(1.f - exp2f(-5.f - (float)h));
    LAS unsigned char *Qn = lds, *Kn = lds + 17408, *KdT = lds + 34816, *VT = lds + 53248, *SbT = lds + 71680, *Pm = lds + 106496;
    LAS float* of = (LAS float*)lds;
    const int l32 = lane & 31, hf = lane >> 5;
    const int sdt = wave >> 1, set0 = (wave & 1) * 2;
    f32x16 S0, S1;
#pragma unroll
    for (int r = 0; r < 16; ++r) { S0[r] = 0.f; S1[r] = 0.f; }
    if (init) {
        const float* ip = init + (sdt * 32 + hf * 4) * 128 + set0 * 32 + l32;
#pragma unroll
        for (int r = 0; r < 16; ++r) { S0[r] = ip[((r >> 2) * 8 + (r & 3)) * 128]; S1[r] = ip[((r >> 2) * 8 + (r & 3)) * 128 + 32]; if ((r & 3) == 3) asm volatile("" ::: "memory"); }
    }
    if (!state_only) {
#pragma unroll
        for (int g = 0; g < 4; ++g) { const int d0 = sdt * 32 + g * 8 + hf * 4;
            u32x2 a, b; a.x = pk2(S0[4 * g], S0[4 * g + 1]); a.y = pk2(S0[4 * g + 2], S0[4 * g + 3]); b.x = pk2(S1[4 * g], S1[4 * g + 1]); b.y = pk2(S1[4 * g + 2], S1[4 * g + 3]);
            *(LAS u32x2*)(SbT + (set0 * 32 + l32) * 272 + d0 * 2) = a; *(LAS u32x2*)(SbT + ((set0 + 1) * 32 + l32) * 272 + d0 * 2) = b; }
    }
    const float gL = exp2f((float)L * lg2);
    const int lt = wave >> 2, et = wave & 3;
    bf16x8 rk1, rk2, rq1, rq2, rv0, rv1; f32x4 rcs[4];
    const bf16x8 z8 = {0, 0, 0, 0, 0, 0, 0, 0};
    auto issue = [&](int c) {
        const int t = tid >> 3, i0 = (tid & 7) * 8; const bool ok = t < L;
        const size_t row = (size_t)(row0 + c * 64 + t);
        rk1 = z8; rk2 = z8; rq1 = z8; rq2 = z8;
#pragma unroll
        for (int i = 0; i < 4; ++i) rcs[i] = (f32x4){0.f, 0.f, 0.f, 0.f};
        if (ok) {
            rk1 = *(const bf16x8*)(QKV + row * INW + 2048 + h * 128 + i0); rk2 = *(const bf16x8*)(QKV + row * INW + 2048 + h * 128 + 64 + i0);
            if (!state_only) { rq1 = *(const bf16x8*)(QKV + row * INW + 1536 + h * 128 + i0); rq2 = *(const bf16x8*)(QKV + row * INW + 1536 + h * 128 + 64 + i0); }
            const f32x4* rp = (const f32x4*)(ROPE + (size_t)(pos0 + c * 64 + t) * 64 + i0);
#pragma unroll
            for (int i = 0; i < 4; ++i) rcs[i] = rp[i];
        }
        const int t0 = tid >> 4, ch = tid & 15;
        rv0 = z8; rv1 = z8;
        if (t0 < L) rv0 = *(const bf16x8*)(QKV + (size_t)(row0 + c * 64 + t0) * INW + 2560 + h * 128 + ch * 8);
        if (t0 + 32 < L) rv1 = *(const bf16x8*)(QKV + (size_t)(row0 + c * 64 + t0 + 32) * INW + 2560 + h * 128 + ch * 8);
    };
    issue(0);
    const int l32_0 = l32, hf_0 = hf, tid_0 = tid; const float lg2_0 = lg2;
#pragma unroll 1
    for (int c = 0; c < nchunks; ++c) {
        int l32 = l32_0, hf = hf_0, tid = tid_0; float lg2 = lg2_0;
        asm volatile("" : "+v"(l32), "+v"(hf), "+v"(tid), "+v"(lg2));
        {
            const int t = tid >> 3, pc = tid & 7, i0 = pc * 8; const bool ok = t < L;
            const float kd = ok ? __builtin_amdgcn_exp2f((float)(L - 1 - t) * lg2) : 0.f;
            const int tsw = (((t >> 3) ^ pc) << 4) + (t & 7) * 2;
            float cs_c[8], cs_s[8];
#pragma unroll
            for (int i = 0; i < 4; ++i) { cs_c[2 * i] = rcs[i].x; cs_s[2 * i] = rcs[i].y; cs_c[2 * i + 1] = rcs[i].z; cs_s[2 * i + 1] = rcs[i].w; }
            {
                float o1[8], o2[8];
#pragma unroll
                for (int i = 0; i < 8; ++i) { const float x1 = bf2f((unsigned short)rk1[i]), x2 = bf2f((unsigned short)rk2[i]);
                    o1[i] = (x1 * cs_c[i] - x2 * cs_s[i]) * 0.08838834764831845f; o2[i] = (x1 * cs_s[i] + x2 * cs_c[i]) * 0.08838834764831845f; }
                if (!state_only) {
                    u32x4 a, b; a.x = pk2(o1[0], o1[1]); a.y = pk2(o1[2], o1[3]); a.z = pk2(o1[4], o1[5]); a.w = pk2(o1[6], o1[7]);
                    b.x = pk2(o2[0], o2[1]); b.y = pk2(o2[2], o2[3]); b.z = pk2(o2[4], o2[5]); b.w = pk2(o2[6], o2[7]);
                    *(LAS u32x4*)(Kn + t * 272 + i0 * 2) = a; *(LAS u32x4*)(Kn + t * 272 + (64 + i0) * 2) = b;
                }
#pragma unroll
                for (int i = 0; i < 8; ++i) { *(LAS unsigned short*)(KdT + (i0 + i) * 144 + tsw) = (unsigned short)f2bf(o1[i] * kd); *(LAS unsigned short*)(KdT + (64 + i0 + i) * 144 + tsw) = (unsigned short)f2bf(o2[i] * kd); }
            }
            if (!state_only) {
                float o1[8], o2[8];
#pragma unroll
                for (int i = 0; i < 8; ++i) { const float x1 = bf2f((unsigned short)rq1[i]), x2 = bf2f((unsigned short)rq2[i]);
                    o1[i] = x1 * cs_c[i] - x2 * cs_s[i]; o2[i] = x1 * cs_s[i] + x2 * cs_c[i]; }
                u32x4 a, b; a.x = pk2(o1[0], o1[1]); a.y = pk2(o1[2], o1[3]); a.z = pk2(o1[4], o1[5]); a.w = pk2(o1[6], o1[7]);
                b.x = pk2(o2[0], o2[1]); b.y = pk2(o2[2], o2[3]); b.z = pk2(o2[4], o2[5]); b.w = pk2(o2[6], o2[7]);
                *(LAS u32x4*)(Qn + t * 272 + i0 * 2) = a; *(LAS u32x4*)(Qn + t * 272 + (64 + i0) * 2) = b;
            }
            {
                const int t0 = tid >> 4, ch = tid & 15, sw = ch & 7;
                const int o0 = (((t0 >> 3) ^ sw) << 4) + (t0 & 7) * 2, o1b = ((((t0 + 32) >> 3) ^ sw) << 4) + (t0 & 7) * 2;
#pragma unroll
                for (int i = 0; i < 8; ++i) { *(LAS short*)(VT + (ch * 8 + i) * 144 + o0) = rv0[i]; *(LAS short*)(VT + (ch * 8 + i) * 144 + o1b) = rv1[i]; }
            }
        }
        if (c + 1 < nchunks) issue(c + 1);
        unsigned gpre[8];
#pragma unroll
        for (int rr = 0; rr < 8; ++rr) { const int t = wave * 8 + rr; gpre[rr] = (!state_only && t < L) ? *(const unsigned*)(QKV + (size_t)(row0 + c * 64 + t) * INW + 3072 + h * 128 + lane * 2) : 0u; }
        __syncthreads();
        f32x16 acc;
        if (!state_only) {
#pragma unroll
            for (int r = 0; r < 16; ++r) acc[r] = 0.f;
#pragma unroll
            for (int ks = 0; ks < 8; ++ks) { const bf16x8 a = *(const LAS bf16x8*)(Qn + (lt * 32 + l32) * 272 + (ks * 16 + hf * 8) * 2), b = *(const LAS bf16x8*)(SbT + (et * 32 + l32) * 272 + (ks * 16 + hf * 8) * 2); acc = MFMA32(a, b, acc); }
#pragma unroll
            for (int r = 0; r < 16; ++r) { const int tl = lt * 32 + (r >> 2) * 8 + hf * 4 + (r & 3); acc[r] *= __builtin_amdgcn_exp2f((float)(tl + 1) * lg2); }
            if (wave < 4) {
                const int slt = wave >> 1, smt = wave & 1;
                f32x16 sc;
#pragma unroll
                for (int r = 0; r < 16; ++r) sc[r] = 0.f;
                if (slt >= smt) {
#pragma unroll
                    for (int ks = 0; ks < 8; ++ks) { const bf16x8 a = *(const LAS bf16x8*)(Qn + (slt * 32 + l32) * 272 + (ks * 16 + hf * 8) * 2), b = *(const LAS bf16x8*)(Kn + (smt * 32 + l32) * 272 + (ks * 16 + hf * 8) * 2); sc = MFMA32(a, b, sc); }
                }
                const int tm = smt * 32 + l32;
#pragma unroll
                for (int r = 0; r < 16; ++r) { const int tl = slt * 32 + (r >> 2) * 8 + hf * 4 + (r & 3);
                    const float p = tl >= tm ? sc[r] * __builtin_amdgcn_exp2f((float)(tl - tm) * lg2) : 0.f;
                    *(LAS unsigned short*)(Pm + tl * 144 + tm * 2) = (unsigned short)f2bf(p); }
            }
            __syncthreads();
#pragma unroll
            for (int ms = 0; ms < 4; ++ms) { const bf16x8 a = *(const LAS bf16x8*)(Pm + (lt * 32 + l32) * 144 + (ms * 16 + hf * 8) * 2), b = *(const LAS bf16x8*)(VT + (et * 32 + l32) * 144 + (((ms * 2 + hf) ^ ((et * 4 + (l32 >> 3)) & 7)) << 4)); acc = MFMA32(a, b, acc); }
#pragma unroll
            for (int r = 0; r < 16; ++r) { const int tl = lt * 32 + (r >> 2) * 8 + hf * 4 + (r & 3); of[tl * 132 + et * 32 + l32] = acc[r]; }
        }
#pragma unroll
        for (int r = 0; r < 16; ++r) { S0[r] *= gL; S1[r] *= gL; }
#pragma unroll
        for (int ts = 0; ts < 4; ++ts) {
            const int cc = ts * 2 + hf, rs = l32 >> 3;
            const bf16x8 a = *(const LAS bf16x8*)(KdT + (sdt * 32 + l32) * 144 + ((cc ^ ((sdt * 4 + rs) & 7)) << 4));
            const bf16x8 b0 = *(const LAS bf16x8*)(VT + (set0 * 32 + l32) * 144 + ((cc ^ ((set0 * 4 + rs) & 7)) << 4)), b1 = *(const LAS bf16x8*)(VT + ((set0 + 1) * 32 + l32) * 144 + ((cc ^ (((set0 + 1) * 4 + rs) & 7)) << 4));
            S0 = MFMA32(a, b0, S0); S1 = MFMA32(a, b1, S1);
        }
        if (!state_only) {
#pragma unroll
            for (int g = 0; g < 4; ++g) { const int d0 = sdt * 32 + g * 8 + hf * 4;
                u32x2 a, b; a.x = pk2(S0[4 * g], S0[4 * g + 1]); a.y = pk2(S0[4 * g + 2], S0[4 * g + 3]); b.x = pk2(S1[4 * g], S1[4 * g + 1]); b.y = pk2(S1[4 * g + 2], S1[4 * g + 3]);
                *(LAS u32x2*)(SbT + (set0 * 32 + l32) * 272 + d0 * 2) = a; *(LAS u32x2*)(SbT + ((set0 + 1) * 32 + l32) * 272 + d0 * 2) = b; }
            __syncthreads();
            const f32x2 gr = *(const f32x2*)(P.in[13] + (size_t)(l * 4 + h) * 128 + lane * 2);
            f32x2 ov[8]; float sq[8];
#pragma unroll
            for (int rr = 0; rr < 8; ++rr) { ov[rr] = *(const LAS f32x2*)(of + (wave * 8 + rr) * 132 + lane * 2); sq[rr] = ov[rr].x * ov[rr].x + ov[rr].y * ov[rr].y; }
#pragma unroll
            for (int o = 1; o < 64; o <<= 1) {
#pragma unroll
                for (int rr = 0; rr < 8; ++rr) sq[rr] += __shfl_xor(sq[rr], o);
            }
#pragma unroll
            for (int rr = 0; rr < 8; ++rr) {
                const int t = wave * 8 + rr;
                if (t < L) {
                    const float rstd = rsqrtf(sq[rr] * (1.f / 128.f) + EPS);
                    const size_t row = (size_t)(row0 + c * 64 + t);
                    const unsigned gg = gpre[rr];
                    const float y0 = ov[rr].x * rstd * gr.x * silu_f(bf2f(gg & 0xffffu)), y1 = ov[rr].y * rstd * gr.y * silu_f(bf2f(gg >> 16));
                    *(unsigned*)(Ob + row * DM + 512 + h * 128 + lane * 2) = pk2(y0, y1);
                }
            }
        }
        __syncthreads();
    }
    if (outst) {
        float* op = outst + (sdt * 32 + hf * 4) * 128 + set0 * 32 + l32;
#pragma unroll
        for (int r = 0; r < 16; ++r) { op[((r >> 2) * 8 + (r & 3)) * 128] = S0[r]; op[((r >> 2) * 8 + (r & 3)) * 128 + 32] = S1[r]; if ((r & 3) == 3) asm volatile("" ::: "memory"); }
    }
}


#define XB_TMO      128
#define XB_XCNT(j)  (256  + 64 * (j))
#define XB_XSUB(j)  (1280 + 64 * (j))
#define XB_XGEN(j)  (2304 + 64 * (j))
#define XB_TOP      3328
#define XB_TOPGEN   3392
#define XCD_BAR_WORDS 3456
#define XB_SPIN_CAP (1u << 18)

__device__ __forceinline__ unsigned xb_ld(unsigned* p)              { return __hip_atomic_load(p, __ATOMIC_RELAXED, __HIP_MEMORY_SCOPE_AGENT); }
__device__ __forceinline__ unsigned xb_add(unsigned* p, unsigned v) { return __hip_atomic_fetch_add(p, v, __ATOMIC_RELAXED, __HIP_MEMORY_SCOPE_AGENT); }
__device__ __forceinline__ unsigned xb_xcc_id() { return (unsigned)__builtin_amdgcn_s_getreg((3 << 11) | 20) & 0xFu; }
#define XB_SPIN(cond, bar) do { unsigned _sp = 0; while (cond) { __builtin_amdgcn_s_sleep(1); \
    if ((++_sp & 255u) == 0u) { if (xb_ld(&(bar)[XB_TMO])) break; if (_sp > XB_SPIN_CAP) { atomicAdd(&(bar)[XB_TMO], 1u); break; } } } } while (0)

struct XcdBarrier {
    unsigned* bar; unsigned x;
    volatile LAS unsigned* st;
};

__device__ __forceinline__ XcdBarrier xcd_barrier_post(unsigned* bar, volatile LAS unsigned* st) {
    XcdBarrier b; b.bar = bar; b.x = xb_xcc_id(); b.st = st;
    if (threadIdx.x == 0) (void)xb_add(&bar[XB_XCNT(b.x)], 1u);
    return b;
}
__device__ __forceinline__ void xcd_barrier_complete(unsigned* bar, unsigned x, unsigned& nloc, unsigned& nx) {
    const unsigned G = gridDim.x * gridDim.y * gridDim.z;
    unsigned sum, cnt, mine, sp = 0u;
    for (;;) {
        sum = 0u; cnt = 0u; mine = 0u;
#pragma unroll
        for (unsigned j = 0; j < 16; ++j) { const unsigned c = xb_ld(&bar[XB_XCNT(j)]); sum += c; cnt += (c > 0u) ? 1u : 0u; mine = (j == x) ? c : mine; }
        if (sum == G) break;
        __builtin_amdgcn_s_sleep(1);
        if ((++sp & 255u) == 0u) { if (xb_ld(&bar[XB_TMO])) break; if (sp > XB_SPIN_CAP) { atomicAdd(&bar[XB_TMO], 1u); break; } }
    }
    nloc = mine > 0u ? mine : 1u; nx = cnt > 0u ? cnt : 1u;
}

__device__ __forceinline__ void xcd_barrier(const XcdBarrier& b) {
    asm volatile("s_waitcnt vmcnt(0)" ::: "memory");
    __syncthreads();
    if (threadIdx.x == 0) {
        unsigned* bar = b.bar;
        __builtin_amdgcn_s_waitcnt(0);
        unsigned nloc = b.st[0], nx = b.st[1];
        if (nloc == 0u) { xcd_barrier_complete(bar, b.x, nloc, nx); b.st[0] = nloc; b.st[1] = nx; }
        const unsigned old = xb_add(&bar[XB_XSUB(b.x)], 1u);
        const unsigned gen = old / nloc;
        if (old + 1u == (gen + 1u) * nloc) {
            __builtin_amdgcn_fence(__ATOMIC_RELEASE, "agent");
            asm volatile("s_waitcnt vmcnt(0)" ::: "memory");
            const unsigned og = xb_add(&bar[XB_TOP], 1u);
            const unsigned tg = og / nx;
            if (og + 1u == (tg + 1u) * nx) xb_add(&bar[XB_TOPGEN], 1u);
            else XB_SPIN(xb_ld(&bar[XB_TOPGEN]) == tg, bar);
            __builtin_amdgcn_fence(__ATOMIC_ACQUIRE, "agent");
            xb_add(&bar[XB_XGEN(b.x)], 1u);
            asm volatile("s_waitcnt vmcnt(0)" ::: "memory");
        } else {
            XB_SPIN(xb_ld(&bar[XB_XGEN(b.x)]) == gen, bar);
            __builtin_amdgcn_fence(__ATOMIC_ACQUIRE, "agent");
            asm volatile("s_waitcnt vmcnt(0)" ::: "memory");
        }
    }
    __syncthreads();
}
__global__ void __launch_bounds__(512, 2) fwd_megakernel(Params P) {
    extern __shared__ __attribute__((aligned(16))) unsigned char lds_raw[];
    LAS unsigned char* lds = (LAS unsigned char*)lds_raw;
    cg::grid_group grid = cg::this_grid();
    int tid = threadIdx.x, lane = tid & 63, wave = __builtin_amdgcn_readfirstlane(tid >> 6);
#define REFRESH() do { tid = threadIdx.x; asm volatile("" : "+v"(tid)); lane = tid & 63; wave = __builtin_amdgcn_readfirstlane(tid >> 6); } while (0)
    const int G = gridDim.x, bx = blockIdx.x;
    bf16_t* H = (bf16_t*)(P.ws + WS_H); bf16_t* Ob = (bf16_t*)(P.ws + WS_O); bf16_t* QKV = (bf16_t*)(P.ws + WS_QKV); bf16_t* ACT = QKV;
    float* X = (float*)(P.ws + WS_X); float* U = (float*)(P.ws + WS_U);
    const float* MOD = (const float*)(P.ws + WS_MOD);

    volatile LAS unsigned* bst = (volatile LAS unsigned*)(lds + LDS_BYTES - 64);
    if (tid == 0) { bst[0] = 0u; bst[1] = 0u; }
    __syncthreads();
    const XcdBarrier xbar = xcd_barrier_post((unsigned*)(P.ws + WS_BAR), bst);
#ifndef SK_P0
    p0_phase(P, lds, tid, lane, wave);
#endif
    grid.sync(); REFRESH();
#pragma unroll 1
    for (int l = 0; l < DEPTH; ++l) {
        norm_phase<false>(P, l, l == 0, P.in[7] + (size_t)l * DM, 0, 1024, lane, wave);
        xcd_barrier(xbar); REFRESH();
#ifndef SK_G1
        {
            pg8::Gemm g{H, (const bf16_t*)(P.ws + WS_WIN) + (size_t)l * INW * DM, MP, INW, DM}; pg8::StaticOrder S; S.init(MP, INW, G, bx);
            EpiQKV E{QKV, P.out, l};
            pg8::gemm_phase<EpiQKV, pg8::StaticOrder, true, true>(lds, g, S, E);
            SEpiQKV SE{QKV, P.out, l};
            sgemm_phase<8, 8, SEpiQKV>(lds, H + (size_t)MP * DM, DM, g.Bt, DM, INW / 64, tid, lane, wave, SE);
        }
#endif
        xcd_barrier(xbar); REFRESH();
        {
            unsigned* qhead = (unsigned*)(P.ws + WS_CTR) + l * 64;
            volatile LAS unsigned* qslot = (volatile LAS unsigned*)(lds + LDS_BYTES - 128);
            for (;;) {
                if (tid == 0) *qslot = __hip_atomic_fetch_add(qhead, 1u, __ATOMIC_RELAXED, __HIP_MEMORY_SCOPE_AGENT);
                __syncthreads();
                const int u = (int)*qslot;
                __syncthreads();
                if (u >= 1360) break;
                if (u < 256) { const int bh = u >> 5, seg = u & 31, b = bh >> 2, h = bh & 3;
                    ret_unit(P, l, lds, tid, lane, wave, b * SEQ + seg * 512, seg * 512, 8, 64, h, nullptr, U + (size_t)(bh * 32 + seg) * 16384, true); }
                else if (u < 272) sb_unit(P, l, 1024 + (u - 256), lds, tid, lane, wave);
                else if (u < 1296) { const int v = u - 272; sb_unit(P, l, (v & 1) * 512 + (511 - (v >> 1)), lds, tid, lane, wave); }
                else { const int idx = u - 1296, bs = idx >> 2, h = idx & 3; const size_t so = ((size_t)(l * DB + bs) * 4 + h) * 16384;
                    ret_unit(P, l, lds, tid, lane, wave, MP + bs * 32, PAST, 1, 32, h, P.in[4] + so, P.out + OFF_RS + so, false); }
            }
        }
        xcd_barrier(xbar); REFRESH();
        for (int idx = bx * 512 + tid; idx < 8 * 16384; idx += G * 512) {
            const int bh = idx >> 14, within = idx & 16383, h = bh & 3;
            const float g512 = exp2f(512.f * log2f(1.f - exp2f(-5.f - (float)h)));
            float* up = U + (size_t)bh * 32 * 16384 + within; float s = 0.f;
            float uv[32];
#pragma unroll
            for (int seg = 0; seg < 32; ++seg) uv[seg] = up[(size_t)seg * 16384];
#pragma unroll
            for (int seg = 0; seg < 32; ++seg) { up[(size_t)seg * 16384] = s; s = g512 * s + uv[seg]; }
            P.out[OFF_RP + ((size_t)l * 8 + bh) * 16384 + within] = s;
        }
        xcd_barrier(xbar); REFRESH();
#ifndef SK_R3
        for (int u = bx; u < 256; u += G) { const int bh = u >> 5, seg = u & 31, b = bh >> 2, h = bh & 3;
            ret_unit(P, l, lds, tid, lane, wave, b * SEQ + seg * 512, seg * 512, 8, 64, h, U + (size_t)(bh * 32 + seg) * 16384, nullptr, false); }
#endif
        xcd_barrier(xbar); REFRESH();
#ifndef SK_G2
        {
            pg8::Gemm g{Ob, (const bf16_t*)(P.ws + WS_WOUT) + (size_t)l * DM * DM, MP, DM, DM}; pg8::StaticOrder S; S.init(MP, DM, G, bx);
            EpiResid E{l == 0 ? P.in[0] : nullptr, l == 0 ? P.in[1] : nullptr, X, MOD + (size_t)l * NBI * NMOD + 2048};
            pg8::gemm_phase<EpiResid, pg8::StaticOrder, true, true>(lds, g, S, E);
            SEpiResid SE{l == 0 ? P.in[1] : X + (size_t)MP * DM, X + (size_t)MP * DM, MOD + (size_t)l * NBI * NMOD + 2048};
            sgemm_phase<8, 8, SEpiResid>(lds, Ob + (size_t)MP * DM, DM, g.Bt, DM, DM / 64, tid, lane, wave, SE);
        }
#endif
        xcd_barrier(xbar); REFRESH();
        norm_phase<false>(P, l, false, P.in[8] + (size_t)l * DM, 3072, 4096, lane, wave);
        xcd_barrier(xbar); REFRESH();
#ifndef SK_G3
        {
            pg8::Gemm g{H, (const bf16_t*)(P.ws + WS_WFI) + (size_t)l * 2 * DFF * DM, MP, 2 * DFF, DM}; pg8::StaticOrder S; S.init(MP, 2 * DFF, G, bx);
            EpiSwiGLU E{ACT};
            pg8::gemm_phase<EpiSwiGLU, pg8::StaticOrder, true, true>(lds, g, S, E);
            SEpiSwiGLU SE{ACT};
            sgemm_phase<8, 8, SEpiSwiGLU>(lds, H + (size_t)MP * DM, DM, g.Bt, DM, (2 * DFF / 256) * 4, tid, lane, wave, SE);
        }
#endif
        xcd_barrier(xbar); REFRESH();
#ifndef SK_G4
        {
            pg8::Gemm g{ACT, (const bf16_t*)(P.ws + WS_WFO) + (size_t)l * DM * DFF, MP, DM, DFF}; pg8::StaticOrder S; S.init(MP, DM, G, bx);
            EpiResid E{nullptr, nullptr, X, MOD + (size_t)l * NBI * NMOD + 5120};
            pg8::gemm_phase<EpiResid, pg8::StaticOrder, true, true>(lds, g, S, E);
            SEpiResid SE{X + (size_t)MP * DM, X + (size_t)MP * DM, MOD + (size_t)l * NBI * NMOD + 5120};
            sgemm_phase<22, 11, SEpiResid>(lds, ACT + (size_t)MP * DFF, DFF, g.Bt, DFF, DM / 64, tid, lane, wave, SE);
        }
#endif
        xcd_barrier(xbar); REFRESH();
    }
    norm_phase<true>(P, 0, false, P.in[17], 0, 0, lane, wave);
}

extern "C" void kernel_launch(void* const* d_in, const int* in_sizes, int n_in, void* d_out, int out_size, void* d_ws, size_t ws_size, hipStream_t stream) {
    static int grid = 0;
    if (grid == 0) {
        if (n_in != 18 || ws_size < WS_END) { fprintf(stderr, "kernel_launch: unexpected n_in %d / ws_size %zu\n", n_in, ws_size); grid = -1; return; }
        int dev = 0, cus = 0, per_cu = 0;
        (void)hipGetDevice(&dev); (void)hipDeviceGetAttribute(&cus, hipDeviceAttributeMultiprocessorCount, dev);
        if (hipFuncSetAttribute((const void*)fwd_megakernel, hipFuncAttributeMaxDynamicSharedMemorySize, LDS_BYTES) != hipSuccess) { fprintf(stderr, "kernel_launch: hipFuncSetAttribute failed\n"); grid = -1; return; }
        (void)hipOccupancyMaxActiveBlocksPerMultiprocessor(&per_cu, (const void*)fwd_megakernel, 512, LDS_BYTES);
        (void)hipGetLastError();
        if (per_cu < 1) { fprintf(stderr, "kernel_launch: occupancy query says %d blocks per CU\n", per_cu); per_cu = 1; }
        grid = cus;
    }
    if (grid < 0) return;
    (void)hipMemsetAsync((char*)d_ws + WS_MOD, 0, MOD_BYTES, stream);
    Params p{};
    for (int i = 0; i < 18; ++i) p.in[i] = (const float*)d_in[i];
    p.out = (float*)d_out; p.ws = (unsigned char*)d_ws;
    void* args[] = {&p};
    hipError_t e = hipLaunchCooperativeKernel((const void*)fwd_megakernel, dim3(grid), dim3(512), args, LDS_BYTES, stream);
    if (e != hipSuccess) fprintf(stderr, "cooperative launch failed: %s (grid %d)\n", hipGetErrorString(e), grid);
}
```

```cpp
#include <hip/hip_runtime.h>
#include <hip/hip_cooperative_groups.h>
#include <cstdio>
#include <cstdint>
namespace cg = cooperative_groups;
namespace pg8 {
#define PG8_LAS __attribute__((address_space(3)))
typedef unsigned short bf16_t;
typedef short bf16x8 __attribute__((ext_vector_type(8)));
typedef float f32x4 __attribute__((ext_vector_type(4)));
typedef unsigned u32x4 __attribute__((ext_vector_type(4)));
constexpr int BM = 256, BK = 64, HALF = 128, HTB = HALF * BK * 2  , STAGE_BYTES = 8 * HTB, NXCD = 8, WGM = 8;

__host__ __device__ __forceinline__ int lds_byte(int r, int c) { const int st = (r >> 4) * 2 + (c >> 5), rr = r & 15, cc = c & 31, ob = rr * 64 + cc * 2; return st * 1024 + (ob ^ (((ob >> 9) & 1) << 5)); }
__host__ __device__ __forceinline__ void stage_rc(int b, int& R, int& C) { const int st = b / 1024, sb = b % 1024, swz = sb ^ (((sb >> 9) & 1) << 5); R = (st >> 1) * 16 + swz / 64; C = (st & 1) * 32 + (swz % 64) / 2; }
__host__ __device__ __forceinline__ int perm32(int rho) { const int n = rho >> 4, i = rho & 15; return 8 * (i >> 2) + 4 * n + (i & 3); }

struct Unit { int pm, pn; };
struct Gemm { const bf16_t* A; const bf16_t* Bt; int M, N, K; };

struct StaticOrder {
    int nM, nN, nwg, G, c;
    __host__ __device__ void init(int M, int N, int G_, int c_) { nM = M / BM; nN = N / BM; nwg = nM * nN; G = G_; c = c_; }
    __host__ __device__ bool next(int i, Unit& u) const {
        const long L = (long)i * G + c; if (L >= nwg) return false;
        int wgid = (int)L; { const int q = nwg / NXCD, r = nwg % NXCD, xcd = wgid % NXCD, off = wgid / NXCD; wgid = (xcd < r ? xcd * (q + 1) : r * (q + 1) + (xcd - r) * q) + off; }
        const int nig = WGM * nN, gid = wgid / nig, fm = gid * WGM, gsz = (nM - fm) < WGM ? (nM - fm) : WGM;
        u.pm = fm + ((wgid % nig) % gsz); u.pn = (wgid % nig) / gsz; return true;
    }
    __device__ __forceinline__ void a_ready(const Unit&) const {}
    __device__ __forceinline__ void done(const Unit&) const {}
};

__device__ __forceinline__ unsigned cvt_pk_bf16(float lo, float hi) { unsigned r; asm volatile("v_cvt_pk_bf16_f32 %0, %1, %2" : "=v"(r) : "v"(lo), "v"(hi)); return r; }
typedef float f32x2 __attribute__((ext_vector_type(2)));
__device__ __forceinline__ f32x2 gelu_pk(f32x2 v) {
    const f32x2 av = __builtin_elementwise_abs(v), d = av * 0.2316418882f + 1.0f;
    f32x2 t; t.x = __builtin_amdgcn_rcpf(d.x); t.y = __builtin_amdgcn_rcpf(d.y);
    f32x2 q = t * 0.5307027145f + (-0.7265760135f); q = q * t + 0.7107068705f; q = q * t + (-0.142248368f); q = q * t + 0.127414796f; q = q * t;
    const f32x2 s = (v * v) * (-0.72134752044f);
    f32x2 e; e.x = __builtin_amdgcn_exp2f(s.x); e.y = __builtin_amdgcn_exp2f(s.y);
    const f32x2 m = v * (q * e), r = v - m;
    f32x2 o; o.x = v.x < 0.f ? m.x : r.x; o.y = v.y < 0.f ? m.y : r.y; return o;
}

template <int ACT  > struct EpiBf16 {
    static constexpr bool PERM = true, AFTER_DRAIN = false; static_assert(ACT == 0 || ACT == 1, "EpiBf16: ACT is 0 (none) or 1 (gelu_pk)");
    bf16_t* O; int ldc; const float* bias; int split_cols; size_t split_stride; float scale0;
    __device__ __forceinline__ void operator()(const f32x4 (&acc)[2][2][4][2], const Unit& u, int wr, int wc, int fr, int fq) const {
        const int row0 = u.pm * BM + wr * 64 + fr; int colt = u.pn * BM; bf16_t* base = O;
        float sc = 1.f; if (split_cols) { const int t = colt / split_cols; base += (size_t)t * split_stride; colt -= t * split_cols; if (t == 0) sc = scale0; }
        const int col0 = colt + wc * 32 + 8 * fq, bcol0 = u.pn * BM + wc * 32 + 8 * fq;
        f32x4 bv[2][2];
#pragma unroll
        for (int bj = 0; bj < 2; ++bj)
#pragma unroll
            for (int n = 0; n < 2; ++n) bv[bj][n] = bias ? *(const f32x4*)(bias + bcol0 + bj * HALF + 4 * n) : (f32x4){0.f, 0.f, 0.f, 0.f};
#pragma unroll
        for (int ai = 0; ai < 2; ++ai)
#pragma unroll
            for (int m = 0; m < 4; ++m) { bf16_t* rowp = base + (size_t)(row0 + ai * HALF + m * 16) * ldc + col0;
#pragma unroll
                for (int bj = 0; bj < 2; ++bj) { f32x4 v0 = acc[ai][bj][m][0] + bv[bj][0], v1 = acc[ai][bj][m][1] + bv[bj][1];
                    if (ACT == 1) { f32x2 a = gelu_pk((f32x2){v0[0], v0[1]}), b = gelu_pk((f32x2){v0[2], v0[3]}), c = gelu_pk((f32x2){v1[0], v1[1]}), d = gelu_pk((f32x2){v1[2], v1[3]});
                        v0 = (f32x4){a.x, a.y, b.x, b.y}; v1 = (f32x4){c.x, c.y, d.x, d.y}; }
                    v0 = v0 * sc; v1 = v1 * sc; u32x4 w; w.x = cvt_pk_bf16(v0[0], v0[1]); w.y = cvt_pk_bf16(v0[2], v0[3]); w.z = cvt_pk_bf16(v1[0], v1[1]); w.w = cvt_pk_bf16(v1[2], v1[3]);
                    *(u32x4*)(rowp + bj * HALF) = w; } }
    }
};
template <class Epi, class Sched, bool ALIGN_EPI = false, bool SP2 = false>
__device__ __forceinline__ void gemm_phase(PG8_LAS unsigned char* lds, const Gemm g, const Sched& S, const Epi& E) {
    int tid_o = threadIdx.x; asm volatile("" : "+v"(tid_o));
    const int tid = tid_o, wid = __builtin_amdgcn_readfirstlane(tid >> 6), lane = tid & 63, wr = wid >> 2, wc = wid & 3, fr = lane & 15, fq = lane >> 4;
    const int K = g.K, nt = K / BK;
    unsigned voffA[2], voffB[2];
#pragma unroll
    for (int i = 0; i < 2; ++i) { int R, C; stage_rc(tid * 16 + i * 8192, R, C); const int Rb = Epi::PERM ? ((R & ~31) + perm32(R & 31)) : R;
        voffA[i] = (unsigned)(R * K + C) * 2u; voffB[i] = (unsigned)(Rb * K + C) * 2u; }
    const size_t kstep = (size_t)(BK * 2);
    const size_t hstep = (size_t)HALF * K * 2;
    const size_t tstep = 2 * hstep;
    const unsigned ldsw = (unsigned)wid * 1024u;
    const int aoff = lds_byte(wr * 64 + fr, fq * 8), boff = lds_byte(wc * 32 + fr, fq * 8);
#define PG8_SA(b, h) (((b) * 2 + (h)) * HTB)
#define PG8_SB(b, h) ((4 + (b) * 2 + (h)) * HTB)
#define PG8_STAGE(bufoff, gbase, voff) do { _Pragma("unroll") for (int _i = 0; _i < 2; ++_i) \
        __builtin_amdgcn_global_load_lds((const unsigned*)((const char*)(gbase) + (voff)[_i]), (PG8_LAS unsigned*)(lds + (bufoff) + ldsw + _i * 8192), 16, 0, 0); } while (0)
#define PG8_LDA(dst, b, h) do { _Pragma("unroll") for (int m = 0; m < 4; ++m) _Pragma("unroll") for (int k = 0; k < 2; ++k) dst[m][k] = *(const PG8_LAS bf16x8*)(lds + PG8_SA(b, h) + aoff + m * 2048 + k * 1024); } while (0)
#define PG8_LDB(dst, b, h) do { _Pragma("unroll") for (int n = 0; n < 2; ++n) _Pragma("unroll") for (int k = 0; k < 2; ++k) dst[n][k] = *(const PG8_LAS bf16x8*)(lds + PG8_SB(b, h) + boff + n * 2048 + k * 1024); } while (0)
#define PG8_MMA(ai, bj, At, Bt) do { __builtin_amdgcn_s_setprio(1); _Pragma("unroll") for (int m = 0; m < 4; ++m) _Pragma("unroll") for (int n = 0; n < 2; ++n) _Pragma("unroll") for (int k = 0; k < 2; ++k) \
        acc[ai][bj][m][n] = __builtin_amdgcn_mfma_f32_16x16x32_bf16(Bt[n][k], At[m][k], acc[ai][bj][m][n], 0, 0, 0); __builtin_amdgcn_s_setprio(0); } while (0)
#define PG8_WAIT_V(n) asm volatile("s_waitcnt vmcnt(" #n ")" ::: "memory")
#define PG8_WAIT_L(n) asm volatile("s_waitcnt lgkmcnt(" #n ")" ::: "memory")
#define PG8_BAR __builtin_amdgcn_s_barrier()
#define PG8_SCHED __builtin_amdgcn_sched_barrier(0)
    Unit cur, nxt; int ui = 0;
    if (!S.next(0, cur)) return;
    f32x4 acc[2][2][4][2];
#pragma unroll
    for (int a = 0; a < 2; ++a)
#pragma unroll
        for (int b = 0; b < 2; ++b)
#pragma unroll
            for (int m = 0; m < 4; ++m)
#pragma unroll
                for (int n = 0; n < 2; ++n) acc[a][b][m][n] = (f32x4){0.f, 0.f, 0.f, 0.f};
    bf16x8 At[4][2], B0[2][2], B1[2][2];
    const char* cA = (const char*)g.A + (size_t)cur.pm * tstep; const char* cB = (const char*)g.Bt + (size_t)cur.pn * tstep;
    S.a_ready(cur);
    if constexpr (SP2) {
        PG8_STAGE(PG8_SB(0, 0), cB, voffB); PG8_STAGE(PG8_SB(0, 1), cB + hstep, voffB); PG8_STAGE(PG8_SA(0, 0), cA, voffA); PG8_STAGE(PG8_SA(0, 1), cA + hstep, voffA);
        if (wr == 1) PG8_BAR;
        PG8_WAIT_V(2); PG8_BAR;
        PG8_STAGE(PG8_SB(1, 0), cB + kstep, voffB); PG8_STAGE(PG8_SA(1, 0), cA + kstep, voffA); PG8_STAGE(PG8_SB(1, 1), cB + hstep + kstep, voffB);
        PG8_WAIT_V(6); PG8_BAR;
    } else {
        PG8_STAGE(PG8_SB(0, 0), cB, voffB); PG8_STAGE(PG8_SA(0, 0), cA, voffA); PG8_STAGE(PG8_SB(0, 1), cB + hstep, voffB); PG8_STAGE(PG8_SA(0, 1), cA + hstep, voffA);
        if (wr == 1) PG8_BAR;
        PG8_WAIT_V(4); PG8_BAR;
        PG8_STAGE(PG8_SB(1, 0), cB + kstep, voffB); PG8_STAGE(PG8_SA(1, 0), cA + kstep, voffA); PG8_STAGE(PG8_SB(1, 1), cB + hstep + kstep, voffB);
        PG8_WAIT_V(6); PG8_BAR;
    }
    for (;;) {
        const bool has_next = S.next(ui + 1, nxt);
        const char* nA = has_next ? (const char*)g.A + (size_t)nxt.pm * tstep : cA; const char* nB = has_next ? (const char*)g.Bt + (size_t)nxt.pn * tstep : cB;
        for (int t = 0; t < nt; t += 2) {
            const bool last = (t == nt - 2);
            const char* a1 = cA + (size_t)(t + 1) * kstep;
            const char* a2 = last ? nA : cA + (size_t)(t + 2) * kstep; const char* b2 = last ? nB : cB + (size_t)(t + 2) * kstep;
            const char* a3 = a2 + kstep; const char* b3 = b2 + kstep;
            if (last && has_next) S.a_ready(nxt);
            if constexpr (SP2) {
            PG8_LDB(B0, 0, 0); PG8_LDB(B1, 0, 1); PG8_SCHED; PG8_LDA(At, 0, 0); PG8_STAGE(PG8_SA(1, 1), a1 + hstep, voffA);
            PG8_WAIT_V(8); PG8_WAIT_L(0); PG8_BAR; PG8_MMA(0, 0, At, B0); PG8_MMA(0, 1, At, B1); PG8_BAR; PG8_SCHED;
            PG8_LDA(At, 0, 1); PG8_STAGE(PG8_SB(0, 0), b2, voffB); PG8_STAGE(PG8_SB(0, 1), b2 + hstep, voffB); PG8_STAGE(PG8_SA(0, 0), a2, voffA);
            PG8_WAIT_V(8); PG8_WAIT_L(0); PG8_BAR; PG8_MMA(1, 0, At, B0); PG8_MMA(1, 1, At, B1); PG8_BAR; PG8_SCHED;
            PG8_LDB(B0, 1, 0); PG8_LDB(B1, 1, 1); PG8_SCHED; PG8_LDA(At, 1, 0); PG8_STAGE(PG8_SA(0, 1), a2 + hstep, voffA);
            PG8_WAIT_V(8); PG8_WAIT_L(0); PG8_BAR; PG8_MMA(0, 0, At, B0); PG8_MMA(0, 1, At, B1); PG8_BAR; PG8_SCHED;
            PG8_LDA(At, 1, 1); PG8_STAGE(PG8_SB(1, 0), b3, voffB); PG8_STAGE(PG8_SB(1, 1), b3 + hstep, voffB); PG8_STAGE(PG8_SA(1, 0), a3, voffA);
            PG8_WAIT_V(8); PG8_WAIT_L(0); PG8_BAR; PG8_MMA(1, 0, At, B0); PG8_MMA(1, 1, At, B1); PG8_BAR; PG8_SCHED;
            } else {
            PG8_LDB(B0, 0, 0); PG8_SCHED; PG8_LDA(At, 0, 0); PG8_STAGE(PG8_SA(1, 1), a1 + hstep, voffA);
            PG8_WAIT_L(8); PG8_BAR; PG8_WAIT_L(0); PG8_MMA(0, 0, At, B0); PG8_BAR; PG8_SCHED;
            PG8_LDB(B1, 0, 1); PG8_STAGE(PG8_SB(0, 0), b2, voffB);
            PG8_BAR; PG8_WAIT_L(0); PG8_MMA(0, 1, At, B1); PG8_BAR;
            PG8_LDA(At, 0, 1); PG8_STAGE(PG8_SA(0, 0), a2, voffA);
            PG8_BAR; PG8_WAIT_L(0); PG8_MMA(1, 0, At, B0); PG8_BAR; PG8_SCHED;
            PG8_STAGE(PG8_SB(0, 1), b2 + hstep, voffB);
            PG8_WAIT_V(6); PG8_BAR; PG8_MMA(1, 1, At, B1); PG8_BAR;
            PG8_LDB(B0, 1, 0); PG8_SCHED; PG8_LDA(At, 1, 0); PG8_STAGE(PG8_SA(0, 1), a2 + hstep, voffA);
            PG8_WAIT_L(8); PG8_BAR; PG8_WAIT_L(0); PG8_MMA(0, 0, At, B0); PG8_BAR; PG8_SCHED;
            PG8_LDB(B1, 1, 1); PG8_STAGE(PG8_SB(1, 0), b3, voffB);
            PG8_BAR; PG8_WAIT_L(0); PG8_MMA(0, 1, At, B1); PG8_BAR;
            PG8_LDA(At, 1, 1); PG8_STAGE(PG8_SA(1, 0), a3, voffA);
            PG8_BAR; PG8_WAIT_L(0); PG8_MMA(1, 0, At, B0); PG8_BAR; PG8_SCHED;
            PG8_STAGE(PG8_SB(1, 1), b3 + hstep, voffB);
            PG8_WAIT_V(6); PG8_BAR; PG8_MMA(1, 1, At, B1); PG8_BAR;
            }
        }
        if constexpr (ALIGN_EPI) { if (wr == 0) PG8_BAR; }
        if constexpr (!Epi::AFTER_DRAIN) { E(acc, cur, wr, wc, fr, fq); S.done(cur); }
        if (!has_next) break;
#pragma unroll
        for (int a = 0; a < 2; ++a)
#pragma unroll
            for (int b = 0; b < 2; ++b)
#pragma unroll
                for (int m = 0; m < 4; ++m)
#pragma unroll
                    for (int n = 0; n < 2; ++n) acc[a][b][m][n] = (f32x4){0.f, 0.f, 0.f, 0.f};
        cur = nxt; cA = nA; cB = nB; ++ui;
        if constexpr (ALIGN_EPI) { if (wr == 1) PG8_BAR; }
    }
    PG8_WAIT_V(0);
    if constexpr (!ALIGN_EPI) { if (wr == 0) PG8_BAR; }
    PG8_BAR;
    if constexpr (Epi::AFTER_DRAIN) { E.fused(acc, cur, wr, wc, fr, fq, lds, wid, lane); S.done(cur); }
#undef PG8_SA
#undef PG8_SB
#undef PG8_STAGE
#undef PG8_LDA
#undef PG8_LDB
#undef PG8_MMA
#undef PG8_WAIT_V
#undef PG8_WAIT_L
#undef PG8_BAR
#undef PG8_SCHED
}
}

#define LAS __attribute__((address_space(3)))
typedef unsigned short bf16_t;
typedef short bf16x8 __attribute__((ext_vector_type(8)));
typedef float f32x4 __attribute__((ext_vector_type(4)));
typedef float f32x2 __attribute__((ext_vector_type(2)));
typedef float f32x16 __attribute__((ext_vector_type(16)));
typedef unsigned u32x4 __attribute__((ext_vector_type(4)));
typedef unsigned u32x2 __attribute__((ext_vector_type(2)));
#define MFMA32(a, b, c) __builtin_amdgcn_mfma_f32_32x32x16_bf16((a), (b), (c), 0, 0, 0)

constexpr int DM = 1024, SEQ = 16384, NBP = 2, DEPTH = 4, DB = 16, DS = 32, PAST = 2048;
constexpr int MP = NBP * SEQ, MS = DB * DS, MT = MP + MS;
constexpr int INW = 3584, DFF = 2816, NMOD = 6144, NBI = 18;
constexpr float EPS = 1e-6f;
constexpr size_t OFF_YP = 0, OFF_YS = 33554432, OFF_KP = 34078720, OFF_VP = 101187584, OFF_RP = 168296448,
                 OFF_KS = 168820736, OFF_VS = 169869312, OFF_RS = 170917888;
constexpr size_t MiB = 1u << 20;
constexpr size_t WS_MOD = 0, MOD_BYTES = 2 * MiB; constexpr size_t WS_CTR = 1820160;
constexpr size_t WS_BAR = 1802240;
constexpr size_t WS_ROPE = 2 * MiB;
constexpr size_t WS_WIN = 10 * MiB, WS_WOUT = 38 * MiB, WS_WFI = 46 * MiB, WS_WFO = 90 * MiB;
constexpr size_t WS_X = 112 * MiB;
constexpr size_t WS_H = 242 * MiB;
constexpr size_t WS_O = 307 * MiB;
constexpr size_t WS_QKV = 372 * MiB;
constexpr size_t WS_U = 600 * MiB;
constexpr size_t WS_END = 616 * MiB;
constexpr int LDS_BYTES = 147456;

struct Params { const float* in[18]; float* out; unsigned char* ws; };

typedef __bf16 bf16x2_t __attribute__((ext_vector_type(2)));
__device__ __forceinline__ unsigned pk2(float lo, float hi) { const f32x2 v = {lo, hi}; return __builtin_bit_cast(unsigned, __builtin_convertvector(v, bf16x2_t)); }
__device__ __forceinline__ unsigned f2bf(float f) { return pk2(f, 0.f) & 0xffffu; }
__device__ __forceinline__ float bf2f(unsigned h) { return __builtin_bit_cast(float, h << 16); }
__device__ __forceinline__ bf16x8 pack8(f32x4 a, f32x4 b) { u32x4 p; p.x = pk2(a.x, a.y); p.y = pk2(a.z, a.w); p.z = pk2(b.x, b.y); p.w = pk2(b.z, b.w); return __builtin_bit_cast(bf16x8, p); }
__device__ __forceinline__ float wave_sum(float v) {
#pragma unroll
    for (int o = 1; o < 64; o <<= 1) v += __shfl_xor(v, o);
    return v;
}
__device__ __forceinline__ float silu_f(float x) { return x * __builtin_amdgcn_rcpf(1.f + __expf(-x)); }
__device__ __forceinline__ int batch_of(int row) { return row < MP ? (row >> 14) : 2 + ((row - MP) >> 5); }

struct EpiQKV {
    static constexpr bool PERM = true, AFTER_DRAIN = false;
    bf16_t* QKV; float* out; int layer;
    __device__ __forceinline__ void operator()(const pg8::f32x4 (&acc)[2][2][4][2], const pg8::Unit& u, int wr, int wc, int fr, int fq) const {
        const int row0 = u.pm * 256 + wr * 64 + fr, col0 = u.pn * 256 + wc * 32 + 8 * fq;
        const bool kv = (u.pn >= 2 && u.pn < 6);
        const size_t vsel = (u.pn >= 4) ? 1 : 0;
        const size_t obase = (u.pm < 128) ? OFF_KP + vsel * (OFF_VP - OFF_KP) + (size_t)layer * MP * 512 + (size_t)row0 * 512
                                          : OFF_KS + vsel * (OFF_VS - OFF_KS) + (size_t)layer * MS * 512 + (size_t)(row0 - MP) * 512;
#pragma unroll
        for (int ai = 0; ai < 2; ++ai)
#pragma unroll
            for (int m = 0; m < 4; ++m) {
                const int row = row0 + ai * 128 + m * 16;
#pragma unroll
                for (int bj = 0; bj < 2; ++bj) {
                    const int col = col0 + bj * 128;
                    const pg8::f32x4 v0 = acc[ai][bj][m][0], v1 = acc[ai][bj][m][1];
                    u32x4 w; w.x = pg8::cvt_pk_bf16(v0[0], v0[1]); w.y = pg8::cvt_pk_bf16(v0[2], v0[3]); w.z = pg8::cvt_pk_bf16(v1[0], v1[1]); w.w = pg8::cvt_pk_bf16(v1[2], v1[3]);
                    *(u32x4*)(QKV + (size_t)row * INW + col) = w;
                    if (kv) {
                        const int c = col & 511;
                        float* dst = out + obase + (size_t)(ai * 128 + m * 16) * 512 + c;
                        *(pg8::f32x4*)dst = v0; *(pg8::f32x4*)(dst + 4) = v1;
                    }
                }
                asm volatile("" ::: "memory");
            }
    }
};
struct EpiResid {
    static constexpr bool PERM = false, AFTER_DRAIN = false;
    const float* base_p; const float* base_s;
    float* X; const float* gate;
    __device__ __forceinline__ void operator()(const pg8::f32x4 (&acc)[2][2][4][2], const pg8::Unit& u, int wr, int wc, int fr, int fq) const {
        const int col0 = u.pn * 256 + wc * 32 + 4 * fq;
        const bool uni = u.pm < 128;
        pg8::f32x4 gv[4];
        { const float* gr = gate + (size_t)batch_of(u.pm * 256 + wr * 64 + fr) * NMOD;
#pragma unroll
          for (int q = 0; q < 4; ++q) gv[q] = *(const pg8::f32x4*)(gr + col0 + (q >> 1) * 128 + (q & 1) * 16); }
#pragma unroll
        for (int grp = 0; grp < 4; ++grp) {
            const int ai = grp >> 1, m0 = (grp & 1) * 2;
            pg8::f32x4 bv[2][4];
#pragma unroll
            for (int mm = 0; mm < 2; ++mm) {
                const int row = u.pm * 256 + ai * 128 + wr * 64 + (m0 + mm) * 16 + fr;
                const float* br = base_p ? (row < MP ? base_p + (size_t)row * DM : base_s + (size_t)(row - MP) * DM) : X + (size_t)row * DM;
#pragma unroll
                for (int q = 0; q < 4; ++q) bv[mm][q] = *(const pg8::f32x4*)(br + col0 + (q >> 1) * 128 + (q & 1) * 16);
            }
#pragma unroll
            for (int mm = 0; mm < 2; ++mm) {
                const int m = m0 + mm, row = u.pm * 256 + ai * 128 + wr * 64 + m * 16 + fr;
                if (!uni) { const float* gr = gate + (size_t)batch_of(row) * NMOD;
#pragma unroll
                    for (int q = 0; q < 4; ++q) gv[q] = *(const pg8::f32x4*)(gr + col0 + (q >> 1) * 128 + (q & 1) * 16); }
                float* xr = X + (size_t)row * DM;
#pragma unroll
                for (int q = 0; q < 4; ++q) { const int bj = q >> 1, n = q & 1;
                    *(pg8::f32x4*)(xr + col0 + bj * 128 + n * 16) = bv[mm][q] + gv[q] * acc[ai][bj][m][n]; }
            }
            asm volatile("" ::: "memory");
        }
    }
};
struct EpiSwiGLU {
    static constexpr bool PERM = true, AFTER_DRAIN = false;
    bf16_t* ACT;
    __device__ __forceinline__ void operator()(const pg8::f32x4 (&acc)[2][2][4][2], const pg8::Unit& u, int wr, int wc, int fr, int fq) const {
        const int col0 = u.pn * 128 + wc * 32 + 8 * fq;
#pragma unroll
        for (int ai = 0; ai < 2; ++ai)
#pragma unroll
            for (int m = 0; m < 4; ++m) {
                const int row = u.pm * 256 + ai * 128 + wr * 64 + m * 16 + fr;
                const pg8::f32x4 g0 = acc[ai][0][m][0], g1 = acc[ai][0][m][1], u0 = acc[ai][1][m][0], u1 = acc[ai][1][m][1];
                float r[8];
#pragma unroll
                for (int j = 0; j < 4; ++j) { r[j] = silu_f(g0[j]) * u0[j]; r[4 + j] = silu_f(g1[j]) * u1[j]; }
                u32x4 w; w.x = pg8::cvt_pk_bf16(r[0], r[1]); w.y = pg8::cvt_pk_bf16(r[2], r[3]); w.z = pg8::cvt_pk_bf16(r[4], r[5]); w.w = pg8::cvt_pk_bf16(r[6], r[7]);
                *(u32x4*)(ACT + (size_t)row * DFF + col0) = w;
                asm volatile("" ::: "memory");
            }
    }
};


template <int NKS  , int UNR, class Epi>
__device__ __forceinline__ void sgemm_phase(LAS unsigned char* lds, const bf16_t* A  , int lda, const bf16_t* Bt, int K, int ncb,
                                            int tid, int lane, int wave, const Epi& E) {
    const int l32 = lane & 31, hf = lane >> 5;
    LAS float* red = (LAS float*)lds;
    const int kw0 = wave * NKS * 16 + hf * 8;
    for (int it = blockIdx.x; it < 16 * ncb; it += gridDim.x) {
        const int rb = it & 15, cb = it >> 4;
        int n0, n1; E.cols(cb, n0, n1);
        const bf16_t* ap = A + (size_t)(rb * 32 + l32) * lda + kw0;
        const bf16_t* b0p = Bt + (size_t)(n0 + l32) * K + kw0;
        const bf16_t* b1p = Bt + (size_t)(n1 + l32) * K + kw0;
        f32x16 c0, c1;
#pragma unroll
        for (int r = 0; r < 16; ++r) { c0[r] = 0.f; c1[r] = 0.f; }
#pragma unroll 1
        for (int kb = 0; kb < NKS; kb += UNR) {
            bf16x8 a[UNR], b0[UNR], b1[UNR];
#pragma unroll
            for (int j = 0; j < UNR; ++j) { a[j] = *(const bf16x8*)(ap + (kb + j) * 16); b0[j] = *(const bf16x8*)(b0p + (kb + j) * 16); b1[j] = *(const bf16x8*)(b1p + (kb + j) * 16); }
#pragma unroll
            for (int j = 0; j < UNR; ++j) { c0 = MFMA32(a[j], b0[j], c0); c1 = MFMA32(a[j], b1[j], c1); }
        }
        LAS float* rw = red + wave * 2176;
#pragma unroll
        for (int r = 0; r < 16; ++r) { const int row = (r >> 2) * 8 + hf * 4 + (r & 3); rw[row * 34 + l32] = c0[r]; rw[1088 + row * 34 + l32] = c1[r]; }
        __syncthreads();
        {
            const int row = tid >> 4, cc = (tid & 15) * 2;
            f32x2 g = {0.f, 0.f}, u = {0.f, 0.f};
#pragma unroll
            for (int w = 0; w < 8; ++w) { g += *(const LAS f32x2*)(red + w * 2176 + row * 34 + cc); u += *(const LAS f32x2*)(red + w * 2176 + 1088 + row * 34 + cc); }
            E(rb * 32 + row, n0 + cc, n1 + cc, g, u);
        }
        __syncthreads();
    }
}
struct SEpiQKV {
    bf16_t* QKV; float* out; int layer;
    __device__ __forceinline__ void cols(int cb, int& n0, int& n1) const { n0 = cb * 64; n1 = n0 + 32; }
    __device__ __forceinline__ void emit(int r, int c, f32x2 v) const {
        *(unsigned*)(QKV + (size_t)(MP + r) * INW + c) = pk2(v.x, v.y);
        if (c >= 512 && c < 1536) { const size_t off = (c < 1024 ? OFF_KS : OFF_VS) + ((size_t)layer * MS + r) * 512 + (c & 511); *(f32x2*)(out + off) = v; }
    }
    __device__ __forceinline__ void operator()(int r, int c0, int c1, f32x2 g, f32x2 u) const { emit(r, c0, g); emit(r, c1, u); }
};
struct SEpiResid {
    const float* base; float* Xs; const float* gate;
    __device__ __forceinline__ void cols(int cb, int& n0, int& n1) const { n0 = cb * 64; n1 = n0 + 32; }
    __device__ __forceinline__ void operator()(int r, int c0, int c1, f32x2 g, f32x2 u) const {
        const float* gp = gate + (size_t)(2 + (r >> 5)) * NMOD; const float* bp = base + (size_t)r * DM; float* xp = Xs + (size_t)r * DM;
        const f32x2 x0 = *(const f32x2*)(bp + c0) + *(const f32x2*)(gp + c0) * g, x1 = *(const f32x2*)(bp + c1) + *(const f32x2*)(gp + c1) * u;
        *(f32x2*)(xp + c0) = x0; *(f32x2*)(xp + c1) = x1;
    }
};
struct SEpiSwiGLU {
    bf16_t* ACT;
    __device__ __forceinline__ void cols(int cb, int& n0, int& n1) const { n0 = (cb >> 2) * 256 + (cb & 3) * 32; n1 = n0 + 128; }
    __device__ __forceinline__ void operator()(int r, int c0, int c1, f32x2 g, f32x2 u) const {
        const int col = (c0 >> 8) * 128 + (c0 & 127);
        *(unsigned*)(ACT + (size_t)(MP + r) * DFF + col) = pk2(silu_f(g.x) * u.x, silu_f(g.y) * u.y);
    }
};

__device__ __forceinline__ void transpose_item(const float* W, int K, int N, bf16_t* WT, LAS float* scr, int item, int lane, bool perm) {
    const int nblk = N / 32, kb = item / nblk, nb = item % nblk, k0 = 64 * kb, n0 = 32 * nb;
    int p0 = n0;
    if (perm) { if (n0 < DFF) p0 = (n0 >> 7) * 256 + (n0 & 127); else { const int n1 = n0 - DFF; p0 = (n1 >> 7) * 256 + 128 + (n1 & 127); } }
#pragma unroll 8
    for (int i = 0; i < 32; ++i) { const int kk = 2 * i + (lane >> 5); scr[kk * 33 + (lane & 31)] = W[(size_t)(k0 + kk) * N + n0 + (lane & 31)]; }
    asm volatile("s_waitcnt lgkmcnt(0)" ::: "memory"); __builtin_amdgcn_wave_barrier();
    const int c = lane & 7;
#pragma unroll
    for (int j = 0; j < 4; ++j) { const int n = (lane >> 3) + 8 * j; const LAS float* s = scr + (8 * c) * 33 + n;
        u32x4 o; o.x = pk2(s[0 * 33], s[1 * 33]); o.y = pk2(s[2 * 33], s[3 * 33]); o.z = pk2(s[4 * 33], s[5 * 33]); o.w = pk2(s[6 * 33], s[7 * 33]);
        *(u32x4*)(WT + (size_t)(p0 + n) * K + k0 + 8 * c) = o; }
    asm volatile("s_waitcnt lgkmcnt(0)" ::: "memory"); __builtin_amdgcn_wave_barrier();
}

__device__ __forceinline__ void p0_phase(const Params& P, LAS unsigned char* lds, int tid, int lane, int wave) {
    LAS float* sc = (LAS float*)lds;
    for (int i = tid; i < NBI * DM; i += 512) { const int b = i >> 10, k = i & 1023; const float c = b < 2 ? P.in[5][b * DM + k] : P.in[6][(b - 2) * DM + k]; sc[i] = silu_f(c); }
    __syncthreads();
    const int gw = blockIdx.x * 8 + wave, NGW = gridDim.x * 8;
    float* MOD = (float*)(P.ws + WS_MOD);
    for (int it = gw; it < 768; it += NGW) {
        const int l = it / 192, r = it % 192, cb = r >> 3, kc = r & 7;
        f32x4 acc[NBI];
#pragma unroll
        for (int b = 0; b < NBI; ++b) acc[b] = (f32x4){0.f, 0.f, 0.f, 0.f};
        const float* wp = P.in[9] + ((size_t)l * DM + kc * 128) * NMOD + cb * 256 + lane * 4;
        const LAS float* scp = sc + kc * 128;
#pragma unroll 16
        for (int k = 0; k < 128; ++k) { const f32x4 w = *(const f32x4*)(wp + (size_t)k * NMOD);
#pragma unroll
            for (int b = 0; b < NBI; ++b) acc[b] += scp[b * DM + k] * w; }
        if (kc == 0) { const f32x4 bv = *(const f32x4*)(P.in[10] + (size_t)l * NMOD + cb * 256 + lane * 4);
#pragma unroll
            for (int b = 0; b < NBI; ++b) acc[b] += bv; }
        float* mp = MOD + (size_t)l * NBI * NMOD + cb * 256 + lane * 4;
#pragma unroll
        for (int b = 0; b < NBI; ++b) { atomicAdd(mp + b * NMOD + 0, acc[b].x); atomicAdd(mp + b * NMOD + 1, acc[b].y); atomicAdd(mp + b * NMOD + 2, acc[b].z); atomicAdd(mp + b * NMOD + 3, acc[b].w); }
    }
    LAS float* scr = (LAS float*)(lds + 73728 + wave * 8448);
    constexpr int I_IN = 16 * 112, I_OUT = 16 * 32, I_FI = 16 * 176, I_FO = 44 * 32, I_L = I_IN + I_OUT + I_FI + I_FO;
    for (int it = gw; it < DEPTH * I_L; it += NGW) {
        const int l = it / I_L; int r = it % I_L;
        if (r < I_IN) { transpose_item(P.in[11] + (size_t)l * DM * INW, DM, INW, (bf16_t*)(P.ws + WS_WIN) + (size_t)l * INW * DM, scr, r, lane, false); continue; } r -= I_IN;
        if (r < I_OUT) { transpose_item(P.in[14] + (size_t)l * DM * DM, DM, DM, (bf16_t*)(P.ws + WS_WOUT) + (size_t)l * DM * DM, scr, r, lane, false); continue; } r -= I_OUT;
        if (r < I_FI) { transpose_item(P.in[15] + (size_t)l * DM * 2 * DFF, DM, 2 * DFF, (bf16_t*)(P.ws + WS_WFI) + (size_t)l * 2 * DFF * DM, scr, r, lane, true); continue; } r -= I_FI;
        transpose_item(P.in[16] + (size_t)l * DFF * DM, DFF, DM, (bf16_t*)(P.ws + WS_WFO) + (size_t)l * DM * DFF, scr, r, lane, false);
    }
    f32x2* ROPE = (f32x2*)(P.ws + WS_ROPE);
    for (int idx = blockIdx.x * 512 + tid; idx < SEQ * 64; idx += gridDim.x * 512) {
        const int pos = idx >> 6, i = idx & 63;
        const float inv = exp2f(-(float)i * (13.287712379549449f / 64.f));
        const float ang = (float)pos * inv;
        double rev = (double)ang * 0.15915494309189535; rev -= floor(rev);
        const float rf = (float)rev;
        ROPE[idx] = (f32x2){__builtin_amdgcn_cosf(rf), __builtin_amdgcn_sinf(rf)};
    }
}

template <bool FINAL>
__device__ __forceinline__ void norm_phase(const Params& P, int l, bool from_input, const float* gain, int sh_off, int sc_off, int lane, int wave) {
    const int gw = blockIdx.x * 8 + wave, NGW = gridDim.x * 8;
    const float* MOD = (const float*)(P.ws + WS_MOD) + (size_t)l * NBI * NMOD;
    const float* X = (const float*)(P.ws + WS_X); bf16_t* H = (bf16_t*)(P.ws + WS_H);
    f32x4 g[4];
#pragma unroll
    for (int j = 0; j < 4; ++j) g[j] = *(const f32x4*)(gain + 4 * lane + 256 * j);
    auto xrow = [&](int m) -> const float* { return (!FINAL && from_input) ? (m < MP ? P.in[0] + (size_t)m * DM : P.in[1] + (size_t)(m - MP) * DM) : X + (size_t)m * DM; };
    f32x4 vn[4];
    if (gw < MT) { const float* xr = xrow(gw);
#pragma unroll
        for (int j = 0; j < 4; ++j) vn[j] = *(const f32x4*)(xr + 4 * lane + 256 * j); }
    for (int m = gw; m < MT; m += NGW) {
        f32x4 v[4]; float ss = 0.f;
#pragma unroll
        for (int j = 0; j < 4; ++j) v[j] = vn[j];
        if (m + NGW < MT) { const float* xr = xrow(m + NGW);
#pragma unroll
            for (int j = 0; j < 4; ++j) vn[j] = *(const f32x4*)(xr + 4 * lane + 256 * j); }
        f32x4 sc[4], sh[4];
        if (!FINAL) { const float* mr = MOD + (size_t)batch_of(m) * NMOD;
#pragma unroll
            for (int j = 0; j < 4; ++j) { const int c = 4 * lane + 256 * j; sc[j] = *(const f32x4*)(mr + sc_off + c); sh[j] = *(const f32x4*)(mr + sh_off + c); } }
#pragma unroll
        for (int j = 0; j < 4; ++j) ss += (v[j].x * v[j].x + v[j].y * v[j].y) + (v[j].z * v[j].z + v[j].w * v[j].w);
        const float rstd = rsqrtf(wave_sum(ss) * (1.f / DM) + EPS);
        if (FINAL) {
            float* o = P.out + (size_t)m * DM;
#pragma unroll
            for (int j = 0; j < 4; ++j) *(f32x4*)(o + 4 * lane + 256 * j) = v[j] * rstd * g[j];
        } else {
#pragma unroll
            for (int j = 0; j < 4; ++j) { const int c = 4 * lane + 256 * j;
                const f32x4 hh = v[j] * rstd * g[j] * (1.f + sc[j]) + sh[j];
                u32x2 w; w.x = pk2(hh.x, hh.y); w.y = pk2(hh.z, hh.w);
                *(u32x2*)(H + (size_t)m * DM + c) = w; }
        }
    }
}

__device__ __forceinline__ void sb_unit(const Params& P, int l, int u, LAS unsigned char* lds, int tid, int lane, int wave) {
    const bf16_t* QKV = (const bf16_t*)(P.ws + WS_QKV);
    const int h = wave, l32 = lane & 31, hf = lane >> 5;
    const bool samp = u >= 1024;
    int qrow0, nsteps; const float* ck = nullptr; const float* cv = nullptr;
    if (!samp) { const int b = u >> 9, qb = u & 511; qrow0 = b * SEQ + qb * 32; nsteps = qb + 1; }
    else { const int bs = u - 1024; qrow0 = MP + bs * 32; nsteps = 65; ck = P.in[2] + (size_t)(l * DB + bs) * PAST * 512; cv = P.in[3] + (size_t)(l * DB + bs) * PAST * 512; }
    bf16x8 qf[4];
#pragma unroll
    for (int ks = 0; ks < 4; ++ks) qf[ks] = *(const bf16x8*)(QKV + (size_t)(qrow0 + l32) * INW + h * 64 + ks * 16 + hf * 8);
    f32x16 O0, O1;
#pragma unroll
    for (int r = 0; r < 16; ++r) { O0[r] = 0.f; O1[r] = 0.f; }
    float cum = 0.f;
    LAS unsigned char* vt = lds + 66048 + wave * 4608;
    auto issue = [&](int s, bf16x8 (&k)[4], bf16x8 (&v)[4]) {
        if (!samp || s == 0) {
            const int krow0 = samp ? qrow0 : qrow0 - s * 32;
#pragma unroll
            for (int ks = 0; ks < 4; ++ks) k[ks] = *(const bf16x8*)(QKV + (size_t)(krow0 + l32) * INW + 512 + h * 64 + ks * 16 + hf * 8);
#pragma unroll
            for (int it = 0; it < 4; ++it) { const int id = it * 64 + lane, key = id >> 3, ch = id & 7;
                v[it] = *(const bf16x8*)(QKV + (size_t)(krow0 + key) * INW + 1024 + h * 64 + ch * 8); }
        } else {
            const int kpos0 = (64 - s) * 32;
#pragma unroll
            for (int ks = 0; ks < 4; ++ks) { const float* p = ck + (size_t)(kpos0 + l32) * 512 + h * 64 + ks * 16 + hf * 8; k[ks] = pack8(*(const f32x4*)p, *(const f32x4*)(p + 4)); }
#pragma unroll
            for (int it = 0; it < 4; ++it) { const int id = it * 64 + lane, key = id >> 3, ch = id & 7;
                const float* p = cv + (size_t)(kpos0 + key) * 512 + h * 64 + ch * 8;
                v[it] = pack8(*(const f32x4*)p, *(const f32x4*)(p + 4)); }
        }
    };
    bf16x8 kf[4], vr[4];
    issue(0, kf, vr);
    for (int s = 0; s < nsteps; ++s) {
#pragma unroll
        for (int it = 0; it < 4; ++it) { const int id = it * 64 + lane, key = id >> 3, ch = id & 7; *(LAS bf16x8*)(vt + key * 144 + ch * 16) = vr[it]; }
        bf16x8 kn[4];
#pragma unroll
        for (int ks = 0; ks < 4; ++ks) kn[ks] = kf[ks];
        if (s + 1 < nsteps) issue(s + 1, kn, vr);
        asm volatile("s_waitcnt lgkmcnt(0)" ::: "memory"); __builtin_amdgcn_wave_barrier();
        f32x16 S;
#pragma unroll
        for (int r = 0; r < 16; ++r) S[r] = 0.f;
#pragma unroll
        for (int ks = 0; ks < 4; ++ks) S = MFMA32(kf[ks], qf[ks], S);
        float L[16], lb[16]; bool valid[16];
#pragma unroll
        for (int r = 0; r < 16; ++r) {
            const float z = S[r] * 0.18033688011112042f;
            const float sp = fmaxf(z, 0.f) + __builtin_amdgcn_logf(1.f + __builtin_amdgcn_exp2f(-fabsf(z)));
            const int key = (r >> 2) * 8 + hf * 4 + (r & 3);
            valid[r] = (s != 0) || (key < l32);
            L[r] = valid[r] ? -sp : 0.f; lb[r] = z - sp;
        }
        float T[4], Pp[4];
#pragma unroll
        for (int g = 0; g < 4; ++g) { T[g] = (L[4 * g] + L[4 * g + 1]) + (L[4 * g + 2] + L[4 * g + 3]); Pp[g] = __shfl_xor(T[g], 32); }
        float later[4]; float tot = 0.f;
#pragma unroll
        for (int g = 3; g >= 0; --g) { later[g] = tot; tot += T[g] + Pp[g]; }
        float w[16];
#pragma unroll
        for (int g = 0; g < 4; ++g) {
            const float s3 = cum + later[g] + (hf == 0 ? Pp[g] : 0.f);
            const float s2 = s3 + L[4 * g + 3], s1 = s2 + L[4 * g + 2], s0 = s1 + L[4 * g + 1];
            w[4 * g + 3] = valid[4 * g + 3] ? __builtin_amdgcn_exp2f(lb[4 * g + 3] + s3) : 0.f;
            w[4 * g + 2] = valid[4 * g + 2] ? __builtin_amdgcn_exp2f(lb[4 * g + 2] + s2) : 0.f;
            w[4 * g + 1] = valid[4 * g + 1] ? __builtin_amdgcn_exp2f(lb[4 * g + 1] + s1) : 0.f;
            w[4 * g + 0] = valid[4 * g + 0] ? __builtin_amdgcn_exp2f(lb[4 * g + 0] + s0) : 0.f;
        }
        cum += tot;
#pragma unroll
        for (int c = 0; c < 2; ++c) {
            u32x4 pw; pw.x = pk2(w[8 * c], w[8 * c + 1]); pw.y = pk2(w[8 * c + 2], w[8 * c + 3]); pw.z = pk2(w[8 * c + 4], w[8 * c + 5]); pw.w = pk2(w[8 * c + 6], w[8 * c + 7]);
            const bf16x8 pa = __builtin_bit_cast(bf16x8, pw);
#pragma unroll
            for (int dt = 0; dt < 2; ++dt) {
                bf16x8 vb;
#pragma unroll
                for (int i = 0; i < 8; ++i) { const int key = 16 * c + 8 * (i >> 2) + 4 * hf + (i & 3); vb[i] = *(const LAS short*)(vt + key * 144 + (l32 + 32 * dt) * 2); }
                if (dt == 0) O0 = MFMA32(pa, vb, O0); else O1 = MFMA32(pa, vb, O1);
            }
        }
        asm volatile("" ::: "memory");
        if (__all(cum < -158.7f)) break;
#pragma unroll
        for (int ks = 0; ks < 4; ++ks) kf[ks] = kn[ks];
    }
    LAS float* oa = (LAS float*)lds;
#pragma unroll
    for (int r = 0; r < 16; ++r) { const int q = (r >> 2) * 8 + hf * 4 + (r & 3); oa[q * 516 + h * 64 + l32] = O0[r]; oa[q * 516 + h * 64 + 32 + l32] = O1[r]; }
    __syncthreads();
    bf16_t* Ob = (bf16_t*)(P.ws + WS_O);
    const float* gsb = P.in[12] + (size_t)l * 512;
    {
        f32x4 ra[4], rb[4]; float sq[4];
#pragma unroll
        for (int rr = 0; rr < 4; ++rr) { const int q = wave * 4 + rr;
            ra[rr] = *(const LAS f32x4*)(oa + q * 516 + 4 * lane); rb[rr] = *(const LAS f32x4*)(oa + q * 516 + 256 + 4 * lane);
            const f32x4 a = ra[rr], b = rb[rr];
            sq[rr] = (a.x * a.x + a.y * a.y) + (a.z * a.z + a.w * a.w) + (b.x * b.x + b.y * b.y) + (b.z * b.z + b.w * b.w); }
#pragma unroll
        for (int o = 1; o < 64; o <<= 1) {
#pragma unroll
            for (int rr = 0; rr < 4; ++rr) sq[rr] += __shfl_xor(sq[rr], o);
        }
        const f32x4 ga = *(const f32x4*)(gsb + 4 * lane), gb = *(const f32x4*)(gsb + 256 + 4 * lane);
#pragma unroll
        for (int rr = 0; rr < 4; ++rr) { const int q = wave * 4 + rr;
            const float rstd = rsqrtf(sq[rr] * (1.f / 512.f) + EPS);
            const f32x4 ya = ra[rr] * rstd * ga, yb = rb[rr] * rstd * gb;
            u32x2 wa, wb; wa.x = pk2(ya.x, ya.y); wa.y = pk2(ya.z, ya.w); wb.x = pk2(yb.x, yb.y); wb.y = pk2(yb.z, yb.w);
            *(u32x2*)(Ob + (size_t)(qrow0 + q) * DM + 4 * lane) = wa; *(u32x2*)(Ob + (size_t)(qrow0 + q) * DM + 256 + 4 * lane) = wb; }
    }
    __syncthreads();
}

__device__ __forceinline__ void ret_unit(const Params& P, int l, LAS unsigned char* lds, int tid, int lane, int wave,
                                         int row0, int pos0, int nchunks, int L, int h, const float* init, float* outst, bool state_only) {
    const bf16_t* QKV = (const bf16_t*)(P.ws + WS_QKV); bf16_t* Ob = (bf16_t*)(P.ws + WS_O);
    const f32x2* ROPE = (const f32x2*)(P.ws + WS_ROPE);
    const float lg2 = log2f(1.f - exp2f(-5.f - (float)h));
    LAS unsigned char *Qn = lds, *Kn = lds + 17408, *KdT = lds + 34816, *VT = lds + 53248, *SbT = lds + 71680, *Pm = lds + 106496;
    LAS float* of = (LAS float*)lds;
    const int l32 = lane & 31, hf = lane >> 5;
    const int sdt = wave >> 1, set0 = (wave & 1) * 2;
    f32x16 S0, S1;
#pragma unroll
    for (int r = 0; r < 16; ++r) { S0[r] = 0.f; S1[r] = 0.f; }
    if (init) {
        const float* ip = init + (sdt * 32 + hf * 4) * 128 + set0 * 32 + l32;
#pragma unroll
        for (int r = 0; r < 16; ++r) { S0[r] = ip[((r >> 2) * 8 + (r & 3)) * 128]; S1[r] = ip[((r >> 2) * 8 + (r & 3)) * 128 + 32]; if ((r & 3) == 3) asm volatile("" ::: "memory"); }
    }
    if (!state_only) {
#pragma unroll
        for (int g = 0; g < 4; ++g) { const int d0 = sdt * 32 + g * 8 + hf * 4;
            u32x2 a, b; a.x = pk2(S0[4 * g], S0[4 * g + 1]); a.y = pk2(S0[4 * g + 2], S0[4 * g + 3]); b.x = pk2(S1[4 * g], S1[4 * g + 1]); b.y = pk2(S1[4 * g + 2], S1[4 * g + 3]);
            *(LAS u32x2*)(SbT + (set0 * 32 + l32) * 272 + d0 * 2) = a; *(LAS u32x2*)(SbT + ((set0 + 1) * 32 + l32) * 272 + d0 * 2) = b; }
    }
    const float gL = exp2f((float)L * lg2);
    const int lt = wave >> 2, et = wave & 3;
    bf16x8 rk1, rk2, rq1, rq2, rv0, rv1; f32x4 rcs[4];
    const bf16x8 z8 = {0, 0, 0, 0, 0, 0, 0, 0};
    auto issue = [&](int c) {
        const int t = tid >> 3, i0 = (tid & 7) * 8; const bool ok = t < L;
        const size_t row = (size_t)(row0 + c * 64 + t);
        rk1 = z8; rk2 = z8; rq1 = z8; rq2 = z8;
#pragma unroll
        for (int i = 0; i < 4; ++i) rcs[i] = (f32x4){0.f, 0.f, 0.f, 0.f};
        if (ok) {
            rk1 = *(const bf16x8*)(QKV + row * INW + 2048 + h * 128 + i0); rk2 = *(const bf16x8*)(QKV + row * INW + 2048 + h * 128 + 64 + i0);
            if (!state_only) { rq1 = *(const bf16x8*)(QKV + row * INW + 1536 + h * 128 + i0); rq2 = *(const bf16x8*)(QKV + row * INW + 1536 + h * 128 + 64 + i0); }
            const f32x4* rp = (const f32x4*)(ROPE + (size_t)(pos0 + c * 64 + t) * 64 + i0);
#pragma unroll
            for (int i = 0; i < 4; ++i) rcs[i] = rp[i];
        }
        const int t0 = tid >> 4, ch = tid & 15;
        rv0 = z8; rv1 = z8;
        if (t0 < L) rv0 = *(const bf16x8*)(QKV + (size_t)(row0 + c * 64 + t0) * INW + 2560 + h * 128 + ch * 8);
        if (t0 + 32 < L) rv1 = *(const bf16x8*)(QKV + (size_t)(row0 + c * 64 + t0 + 32) * INW + 2560 + h * 128 + ch * 8);
    };
    issue(0);
    const int l32_0 = l32, hf_0 = hf, tid_0 = tid; const float lg2_0 = lg2;
#pragma unroll 1
    for (int c = 0; c < nchunks; ++c) {
        int l32 = l32_0, hf = hf_0, tid = tid_0; float lg2 = lg2_0;
        asm volatile("" : "+v"(l32), "+v"(hf), "+v"(tid), "+v"(lg2));
        {
            const int t = tid >> 3, pc = tid & 7, i0 = pc * 8; const bool ok = t < L;
            const float kd = ok ? __builtin_amdgcn_exp2f((float)(L - 1 - t) * lg2) : 0.f;
            const int tsw = (((t >> 3) ^ pc) << 4) + (t & 7) * 2;
            float cs_c[8], cs_s[8];
#pragma unroll
            for (int i = 0; i < 4; ++i) { cs_c[2 * i] = rcs[i].x; cs_s[2 * i] = rcs[i].y; cs_c[2 * i + 1] = rcs[i].z; cs_s[2 * i + 1] = rcs[i].w; }
            {
                float o1[8], o2[8];
#pragma unroll
                for (int i = 0; i < 8; ++i) { const float x1 = bf2f((unsigned short)rk1[i]), x2 = bf2f((unsigned short)rk2[i]);
                    o1[i] = (x1 * cs_c[i] - x2 * cs_s[i]) * 0.08838834764831845f; o2[i] = (x1 * cs_s[i] + x2 * cs_c[i]) * 0.08838834764831845f; }
                if (!state_only) {
                    u32x4 a, b; a.x = pk2(o1[0], o1[1]); a.y = pk2(o1[2], o1[3]); a.z = pk2(o1[4], o1[5]); a.w = pk2(o1[6], o1[7]);
                    b.x = pk2(o2[0], o2[1]); b.y = pk2(o2[2], o2[3]); b.z = pk2(o2[4], o2[5]); b.w = pk2(o2[6], o2[7]);
                    *(LAS u32x4*)(Kn + t * 272 + i0 * 2) = a; *(LAS u32x4*)(Kn + t * 272 + (64 + i0) * 2) = b;
                }
#pragma unroll
                for (int i = 0; i < 8; ++i) { *(LAS unsigned short*)(KdT + (i0 + i) * 144 + tsw) = (unsigned short)f2bf(o1[i] * kd); *(LAS unsigned short*)(KdT + (64 + i0 + i) * 144 + tsw) = (unsigned short)f2bf(o2[i] * kd); }
            }
            if (!state_only) {
                float o1[8], o2[8];
#pragma unroll
                for (int i = 0; i < 8; ++i) { const float x1 = bf2f((unsigned short)rq1[i]), x2 = bf2f((unsigned short)rq2[i]);
                    o1[i] = x1 * cs_c[i] - x2 * cs_s[i]; o2[i] = x1 * cs_s[i] + x2 * cs_c[i]; }
                u32x4 a, b; a.x = pk2(o1[0], o1[1]); a.y = pk2(o1[2], o1[3]); a.z = pk2(o1[4], o1[5]); a.w = pk2(o1[6], o1[7]);
                b.x = pk2(o2[0], o2[1]); b.y = pk2(o2[2], o2[3]); b.z = pk2(o2[4], o2[5]); b.w = pk2(o2[6], o2[7]);
                *(LAS u32x4*)(Qn + t * 272 + i0 * 2) = a; *(LAS u32x4*)(Qn + t * 272 + (64 + i0) * 2) = b;
            }
            {
                const int t0 = tid >> 4, ch = tid & 15, sw = ch & 7;
                const int o0 = (((t0 >> 3) ^ sw) << 4) + (t0 & 7) * 2, o1b = ((((t0 + 32) >> 3) ^ sw) << 4) + (t0 & 7) * 2;
#pragma unroll
                for (int i = 0; i < 8; ++i) { *(LAS short*)(VT + (ch * 8 + i) * 144 + o0) = rv0[i]; *(LAS short*)(VT + (ch * 8 + i) * 144 + o1b) = rv1[i]; }
            }
        }
        if (c + 1 < nchunks) issue(c + 1);
        unsigned gpre[8];
#pragma unroll
        for (int rr = 0; rr < 8; ++rr) { const int t = wave * 8 + rr; gpre[rr] = (!state_only && t < L) ? *(const unsigned*)(QKV + (size_t)(row0 + c * 64 + t) * INW + 3072 + h * 128 + lane * 2) : 0u; }
        __syncthreads();
        f32x16 acc;
        if (!state_only) {
#pragma unroll
            for (int r = 0; r < 16; ++r) acc[r] = 0.f;
#pragma unroll
            for (int ks = 0; ks < 8; ++ks) { const bf16x8 a = *(const LAS bf16x8*)(Qn + (lt * 32 + l32) * 272 + (ks * 16 + hf * 8) * 2), b = *(const LAS bf16x8*)(SbT + (et * 32 + l32) * 272 + (ks * 16 + hf * 8) * 2); acc = MFMA32(a, b, acc); }
#pragma unroll
            for (int r = 0; r < 16; ++r) { const int tl = lt * 32 + (r >> 2) * 8 + hf * 4 + (r & 3); acc[r] *= __builtin_amdgcn_exp2f((float)(tl + 1) * lg2); }
            if (wave < 4) {
                const int slt = wave >> 1, smt = wave & 1;
                f32x16 sc;
#pragma unroll
                for (int r = 0; r < 16; ++r) sc[r] = 0.f;
                if (slt >= smt) {
#pragma unroll
                    for (int ks = 0; ks < 8; ++ks) { const bf16x8 a = *(const LAS bf16x8*)(Qn + (slt * 32 + l32) * 272 + (ks * 16 + hf * 8) * 2), b = *(const LAS bf16x8*)(Kn + (smt * 32 + l32) * 272 + (ks * 16 + hf * 8) * 2); sc = MFMA32(a, b, sc); }
                }
                const int tm = smt * 32 + l32;
#pragma unroll
                for (int r = 0; r < 16; ++r) { const int tl = slt * 32 + (r >> 2) * 8 + hf * 4 + (r & 3);
                    const float p = tl >= tm ? sc[r] * __builtin_amdgcn_exp2f((float)(tl - tm) * lg2) : 0.f;
                    *(LAS unsigned short*)(Pm + tl * 144 + tm * 2) = (unsigned short)f2bf(p); }
            }
            __syncthreads();
#pragma unroll
            for (int ms = 0; ms < 4; ++ms) { const bf16x8 a = *(const LAS bf16x8*)(Pm + (lt * 32 + l32) * 144 + (ms * 16 + hf * 8) * 2), b = *(const LAS bf16x8*)(VT + (et * 32 + l32) * 144 + (((ms * 2 + hf) ^ ((et * 4 + (l32 >> 3)) & 7)) << 4)); acc = MFMA32(a, b, acc); }
#pragma unroll
            for (int r = 0; r < 16; ++r) { const int tl = lt * 32 + (r >> 2) * 8 + hf * 4 + (r & 3); of[tl * 132 + et * 32 + l32] = acc[r]; }
        }
#pragma unroll
        for (int r = 0; r < 16; ++r) { S0[r] *= gL; S1[r] *= gL; }
#pragma unroll
        for (int ts = 0; ts < 4; ++ts) {
            const int cc = ts * 2 + hf, rs = l32 >> 3;
            const bf16x8 a = *(const LAS bf16x8*)(KdT + (sdt * 32 + l32) * 144 + ((cc ^ ((sdt * 4 + rs) & 7)) << 4));
            const bf16x8 b0 = *(const LAS bf16x8*)(VT + (set0 * 32 + l32) * 144 + ((cc ^ ((set0 * 4 + rs) & 7)) << 4)), b1 = *(const LAS bf16x8*)(VT + ((set0 + 1) * 32 + l32) * 144 + ((cc ^ (((set0 + 1) * 4 + rs) & 7)) << 4));
            S0 = MFMA32(a, b0, S0); S1 = MFMA32(a, b1, S1);
        }
        if (!state_only) {
#pragma unroll
            for (int g = 0; g < 4; ++g) { const int d0 = sdt * 32 + g * 8 + hf * 4;
                u32x2 a, b; a.x = pk2(S0[4 * g], S0[4 * g + 1]); a.y = pk2(S0[4 * g + 2], S0[4 * g + 3]); b.x = pk2(S1[4 * g], S1[4 * g + 1]); b.y = pk2(S1[4 * g + 2], S1[4 * g + 3]);
                *(LAS u32x2*)(SbT + (set0 * 32 + l32) * 272 + d0 * 2) = a; *(LAS u32x2*)(SbT + ((set0 + 1) * 32 + l32) * 272 + d0 * 2) = b; }
            __syncthreads();
            const f32x2 gr = *(const f32x2*)(P.in[13] + (size_t)(l * 4 + h) * 128 + lane * 2);
            f32x2 ov[8]; float sq[8];
#pragma unroll
            for (int rr = 0; rr < 8; ++rr) { ov[rr] = *(const LAS f32x2*)(of + (wave * 8 + rr) * 132 + lane * 2); sq[rr] = ov[rr].x * ov[rr].x + ov[rr].y * ov[rr].y; }
#pragma unroll
            for (int o = 1; o < 64; o <<= 1) {
#pragma unroll
                for (int rr = 0; rr < 8; ++rr) sq[rr] += __shfl_xor(sq[rr], o);
            }
#pragma unroll
            for (int rr = 0; rr < 8; ++rr) {
                const int t = wave * 8 + rr;
                if (t < L) {
                    const float rstd = rsqrtf(sq[rr] * (1.f / 128.f) + EPS);
                    const size_t row = (size_t)(row0 + c * 64 + t);
                    const unsigned gg = gpre[rr];
                    const float y0 = ov[rr].x * rstd * gr.x * silu_f(bf2f(gg & 0xffffu)), y1 = ov[rr].y * rstd * gr.y * silu_f(bf2f(gg >> 16));
                    *(unsigned*)(Ob + row * DM + 512 + h * 128 + lane * 2) = pk2(y0, y1);
                }
            }
        }
        __syncthreads();
    }
    if (outst) {
        float* op = outst + (sdt * 32 + hf * 4) * 128 + set0 * 32 + l32;
#pragma unroll
        for (int r = 0; r < 16; ++r) { op[((r >> 2) * 8 + (r & 3)) * 128] = S0[r]; op[((r >> 2) * 8 + (r & 3)) * 128 + 32] = S1[r]; if ((r & 3) == 3) asm volatile("" ::: "memory"); }
    }
}


#define XB_TMO      128
#define XB_XCNT(j)  (256  + 64 * (j))
#define XB_XSUB(j)  (1280 + 64 * (j))
#define XB_XGEN(j)  (2304 + 64 * (j))
#define XB_TOP      3328
#define XB_TOPGEN   3392
#define XCD_BAR_WORDS 3456
#define XB_SPIN_CAP (1u << 18)

__device__ __forceinline__ unsigned xb_ld(unsigned* p)              { return __hip_atomic_load(p, __ATOMIC_RELAXED, __HIP_MEMORY_SCOPE_AGENT); }
__device__ __forceinline__ unsigned xb_add(unsigned* p, unsigned v) { return __hip_atomic_fetch_add(p, v, __ATOMIC_RELAXED, __HIP_MEMORY_SCOPE_AGENT); }
__device__ __forceinline__ unsigned xb_xcc_id() { return (unsigned)__builtin_amdgcn_s_getreg((3 << 11) | 20) & 0xFu; }
#define XB_SPIN(cond, bar) do { unsigned _sp = 0; while (cond) { __builtin_amdgcn_s_sleep(1); \
    if ((++_sp & 255u) == 0u) { if (xb_ld(&(bar)[XB_TMO])) break; if (_sp > XB_SPIN_CAP) { atomicAdd(&(bar)[XB_TMO], 1u); break; } } } } while (0)

struct XcdBarrier {
    unsigned* bar; unsigned x;
    volatile LAS unsigned* st;
};

__device__ __forceinline__ XcdBarrier xcd_barrier_post(unsigned* bar, volatile LAS unsigned* st) {
    XcdBarrier b; b.bar = bar; b.x = xb_xcc_id(); b.st = st;
    if (threadIdx.x == 0) (void)xb_add(&bar[XB_XCNT(b.x)], 1u);
    return b;
}
__device__ __forceinline__ void xcd_barrier_complete(unsigned* bar, unsigned x, unsigned& nloc, unsigned& nx) {
    const unsigned G = gridDim.x * gridDim.y * gridDim.z;
    unsigned sum, cnt, mine, sp = 0u;
    for (;;) {
        sum = 0u; cnt = 0u; mine = 0u;
#pragma unroll
        for (unsigned j = 0; j < 16; ++j) { const unsigned c = xb_ld(&bar[XB_XCNT(j)]); sum += c; cnt += (c > 0u) ? 1u : 0u; mine = (j == x) ? c : mine; }
        if (sum == G) break;
        __builtin_amdgcn_s_sleep(1);
        if ((++sp & 255u) == 0u) { if (xb_ld(&bar[XB_TMO])) break; if (sp > XB_SPIN_CAP) { atomicAdd(&bar[XB_TMO], 1u); break; } }
    }
    nloc = mine > 0u ? mine : 1u; nx = cnt > 0u ? cnt : 1u;
}

__device__ __forceinline__ void xcd_barrier(const XcdBarrier& b) {
    asm volatile("s_waitcnt vmcnt(0)" ::: "memory");
    __syncthreads();
    if (threadIdx.x == 0) {
        unsigned* bar = b.bar;
        __builtin_amdgcn_s_waitcnt(0);
        unsigned nloc = b.st[0], nx = b.st[1];
        if (nloc == 0u) { xcd_barrier_complete(bar, b.x, nloc, nx); b.st[0] = nloc; b.st[1] = nx; }
        const unsigned old = xb_add(&bar[XB_XSUB(b.x)], 1u);
        const unsigned gen = old / nloc;
        if (old + 1u == (gen + 1u) * nloc) {
            __builtin_amdgcn_fence(__ATOMIC_RELEASE, "agent");
            asm volatile("s_waitcnt vmcnt(0)" ::: "memory");
            const unsigned og = xb_add(&bar[XB_TOP], 1u);
            const unsigned tg = og / nx;
            if (og + 1u == (tg + 1u) * nx) xb_add(&bar[XB_TOPGEN], 1u);
            else XB_SPIN(xb_ld(&bar[XB_TOPGEN]) == tg, bar);
            __builtin_amdgcn_fence(__ATOMIC_ACQUIRE, "agent");
            xb_add(&bar[XB_XGEN(b.x)], 1u);
            asm volatile("s_waitcnt vmcnt(0)" ::: "memory");
        } else {
            XB_SPIN(xb_ld(&bar[XB_XGEN(b.x)]) == gen, bar);
            __builtin_amdgcn_fence(__ATOMIC_ACQUIRE, "agent");
            asm volatile("s_waitcnt vmcnt(0)" ::: "memory");
        }
    }
    __syncthreads();
}
__global__ void __launch_bounds__(512, 2) fwd_megakernel(Params P) {
    extern __shared__ __attribute__((aligned(16))) unsigned char lds_raw[];
    LAS unsigned char* lds = (LAS unsigned char*)lds_raw;
    cg::grid_group grid = cg::this_grid();
    int tid = threadIdx.x, lane = tid & 63, wave = __builtin_amdgcn_readfirstlane(tid >> 6);
#define REFRESH() do { tid = threadIdx.x; asm volatile("" : "+v"(tid)); lane = tid & 63; wave = __builtin_amdgcn_readfirstlane(tid >> 6); } while (0)
    const int G = gridDim.x, bx = blockIdx.x;
    bf16_t* H = (bf16_t*)(P.ws + WS_H); bf16_t* Ob = (bf16_t*)(P.ws + WS_O); bf16_t* QKV = (bf16_t*)(P.ws + WS_QKV); bf16_t* ACT = QKV;
    float* X = (float*)(P.ws + WS_X); float* U = (float*)(P.ws + WS_U);
    const float* MOD = (const float*)(P.ws + WS_MOD);

    volatile LAS unsigned* bst = (volatile LAS unsigned*)(lds + LDS_BYTES - 64);
    if (tid == 0) { bst[0] = 0u; bst[1] = 0u; }
    __syncthreads();
    const XcdBarrier xbar = xcd_barrier_post((unsigned*)(P.ws + WS_BAR), bst);
#ifndef SK_P0
    p0_phase(P, lds, tid, lane, wave);
#endif
    grid.sync(); REFRESH();
#pragma unroll 1
    for (int l = 0; l < DEPTH; ++l) {
        norm_phase<false>(P, l, l == 0, P.in[7] + (size_t)l * DM, 0, 1024, lane, wave);
        xcd_barrier(xbar); REFRESH();
#ifndef SK_G1
        {
            pg8::Gemm g{H, (const bf16_t*)(P.ws + WS_WIN) + (size_t)l * INW * DM, MP, INW, DM}; pg8::StaticOrder S; S.init(MP, INW, G, bx);
            EpiQKV E{QKV, P.out, l};
            pg8::gemm_phase<EpiQKV, pg8::StaticOrder, true, true>(lds, g, S, E);
            SEpiQKV SE{QKV, P.out, l};
            sgemm_phase<8, 8, SEpiQKV>(lds, H + (size_t)MP * DM, DM, g.Bt, DM, INW / 64, tid, lane, wave, SE);
        }
#endif
        xcd_barrier(xbar); REFRESH();
        {
            unsigned* qhead = (unsigned*)(P.ws + WS_CTR) + l * 64;
            volatile LAS unsigned* qslot = (volatile LAS unsigned*)(lds + LDS_BYTES - 128);
            for (;;) {
                if (tid == 0) *qslot = __hip_atomic_fetch_add(qhead, 1u, __ATOMIC_RELAXED, __HIP_MEMORY_SCOPE_AGENT);
                __syncthreads();
                const int u = (int)*qslot;
                __syncthreads();
                if (u >= 1360) break;
                if (u < 256) { const int bh = u >> 5, seg = u & 31, b = bh >> 2, h = bh & 3;
                    ret_unit(P, l, lds, tid, lane, wave, b * SEQ + seg * 512, seg * 512, 8, 64, h, nullptr, U + (size_t)(bh * 32 + seg) * 16384, true); }
                else if (u < 272) sb_unit(P, l, 1024 + (u - 256), lds, tid, lane, wave);
                else if (u < 1296) { const int v = u - 272; sb_unit(P, l, (v & 1) * 512 + (511 - (v >> 1)), lds, tid, lane, wave); }
                else { const int idx = u - 1296, bs = idx >> 2, h = idx & 3; const size_t so = ((size_t)(l * DB + bs) * 4 + h) * 16384;
                    ret_unit(P, l, lds, tid, lane, wave, MP + bs * 32, PAST, 1, 32, h, P.in[4] + so, P.out + OFF_RS + so, false); }
            }
        }
        xcd_barrier(xbar); REFRESH();
        for (int idx = bx * 512 + tid; idx < 8 * 16384; idx += G * 512) {
            const int bh = idx >> 14, within = idx & 16383, h = bh & 3;
            const float g512 = exp2f(512.f * log2f(1.f - exp2f(-5.f - (float)h)));
            float* up = U + (size_t)bh * 32 * 16384 + within; float s = 0.f;
            float uv[32];
#pragma unroll
            for (int seg = 0; seg < 32; ++seg) uv[seg] = up[(size_t)seg * 16384];
#pragma unroll
            for (int seg = 0; seg < 32; ++seg) { up[(size_t)seg * 16384] = s; s = g512 * s + uv[seg]; }
            P.out[OFF_RP + ((size_t)l * 8 + bh) * 16384 + within] = s;
        }
        xcd_barrier(xbar); REFRESH();
#ifndef SK_R3
        for (int u = bx; u < 256; u += G) { const int bh = u >> 5, seg = u & 31, b = bh >> 2, h = bh & 3;
            ret_unit(P, l, lds, tid, lane, wave, b * SEQ + seg * 512, seg * 512, 8, 64, h, U + (size_t)(bh * 32 + seg) * 16384, nullptr, false); }
#endif
        xcd_barrier(xbar); REFRESH();
#ifndef SK_G2
        {
            pg8::Gemm g{Ob, (const bf16_t*)(P.ws + WS_WOUT) + (size_t)l * DM * DM, MP, DM, DM}; pg8::StaticOrder S; S.init(MP, DM, G, bx);
            EpiResid E{l == 0 ? P.in[0] : nullptr, l == 0 ? P.in[1] : nullptr, X, MOD + (size_t)l * NBI * NMOD + 2048};
            pg8::gemm_phase<EpiResid, pg8::StaticOrder, true, true>(lds, g, S, E);
            SEpiResid SE{l == 0 ? P.in[1] : X + (size_t)MP * DM, X + (size_t)MP * DM, MOD + (size_t)l * NBI * NMOD + 2048};
            sgemm_phase<8, 8, SEpiResid>(lds, Ob + (size_t)MP * DM, DM, g.Bt, DM, DM / 64, tid, lane, wave, SE);
        }
#endif
        xcd_barrier(xbar); REFRESH();
        norm_phase<false>(P, l, false, P.in[8] + (size_t)l * DM, 3072, 4096, lane, wave);
        xcd_barrier(xbar); REFRESH();
#ifndef SK_G3
        {
            pg8::Gemm g{H, (const bf16_t*)(P.ws + WS_WFI) + (size_t)l * 2 * DFF * DM, MP, 2 * DFF, DM}; pg8::StaticOrder S; S.init(MP, 2 * DFF, G, bx);
            EpiSwiGLU E{ACT};
            pg8::gemm_phase<EpiSwiGLU, pg8::StaticOrder, true, true>(lds, g, S, E);
            SEpiSwiGLU SE{ACT};
            sgemm_phase<8, 8, SEpiSwiGLU>(lds, H + (size_t)MP * DM, DM, g.Bt, DM, (2 * DFF / 256) * 4, tid, lane, wave, SE);
        }
#endif
        xcd_barrier(xbar); REFRESH();
#ifndef SK_G4
        {
            pg8::Gemm g{ACT, (const bf16_t*)(P.ws + WS_WFO) + (size_t)l * DM * DFF, MP, DM, DFF}; pg8::StaticOrder S; S.init(MP, DM, G, bx);
            EpiResid E{nullptr, nullptr, X, MOD + (size_t)l * NBI * NMOD + 5120};
            pg8::gemm_phase<EpiResid, pg8::StaticOrder, true, true>(lds, g, S, E);
            SEpiResid SE{X + (size_t)MP * DM, X + (size_t)MP * DM, MOD + (size_t)l * NBI * NMOD + 5120};
            sgemm_phase<22, 11, SEpiResid>(lds, ACT + (size_t)MP * DFF, DFF, g.Bt, DFF, DM / 64, tid, lane, wave, SE);
        }
#endif
        xcd_barrier(xbar); REFRESH();
    }
    norm_phase<true>(P, 0, false, P.in[17], 0, 0, lane, wave);
}

extern "C" void kernel_launch(void* const* d_in, const int* in_sizes, int n_in, void* d_out, int out_size, void* d_ws, size_t ws_size, hipStream_t stream) {
    static int grid = 0;
    if (grid == 0) {
        if (n_in != 18 || ws_size < WS_END) { fprintf(stderr, "kernel_launch: unexpected n_in %d / ws_size %zu\n", n_in, ws_size); grid = -1; return; }
        int dev = 0, cus = 0, per_cu = 0;
        (void)hipGetDevice(&dev); (void)hipDeviceGetAttribute(&cus, hipDeviceAttributeMultiprocessorCount, dev);
        if (hipFuncSetAttribute((const void*)fwd_megakernel, hipFuncAttributeMaxDynamicSharedMemorySize, LDS_BYTES) != hipSuccess) { fprintf(stderr, "kernel_launch: hipFuncSetAttribute failed\n"); grid = -1; return; }
        (void)hipOccupancyMaxActiveBlocksPerMultiprocessor(&per_cu, (const void*)fwd_megakernel, 512, LDS_BYTES);
        (void)hipGetLastError();
        if (per_cu < 1) { fprintf(stderr, "kernel_launch: occupancy query says %d blocks per CU\n", per_cu); per_cu = 1; }
        grid = cus;
    }
    if (grid < 0) return;
    (void)hipMemsetAsync((char*)d_ws + WS_MOD, 0, MOD_BYTES, stream);
    Params p{};
    for (int i = 0; i < 18; ++i) p.in[i] = (const float*)d_in[i];
    p.out = (float*)d_out; p.ws = (unsigned char*)d_ws;
    void* args[] = {&p};
    hipError_t e = hipLaunchCooperativeKernel((const void*)fwd_megakernel, dim3(grid), dim3(512), args, LDS_BYTES, stream);
    if (e != hipSuccess) fprintf(stderr, "cooperative launch failed: %s (grid %d)\n", hipGetErrorString(e), grid);
}
```

```cpp
#include <hip/hip_runtime.h>
#include <hip/hip_cooperative_groups.h>
#include <cstdio>
#include <cstdint>
namespace cg = cooperative_groups;
namespace pg8 {
#define PG8_LAS __attribute__((address_space(3)))
typedef unsigned short bf16_t;
typedef short bf16x8 __attribute__((ext_vector_type(8)));
typedef float f32x4 __attribute__((ext_vector_type(4)));
typedef unsigned u32x4 __attribute__((ext_vector_type(4)));
constexpr int BM = 256, BK = 64, HALF = 128, HTB = HALF * BK * 2  , STAGE_BYTES = 8 * HTB, NXCD = 8, WGM = 8;

__host__ __device__ __forceinline__ int lds_byte(int r, int c) { const int st = (r >> 4) * 2 + (c >> 5), rr = r & 15, cc = c & 31, ob = rr * 64 + cc * 2; return st * 1024 + (ob ^ (((ob >> 9) & 1) << 5)); }
__host__ __device__ __forceinline__ void stage_rc(int b, int& R, int& C) { const int st = b / 1024, sb = b % 1024, swz = sb ^ (((sb >> 9) & 1) << 5); R = (st >> 1) * 16 + swz / 64; C = (st & 1) * 32 + (swz % 64) / 2; }
__host__ __device__ __forceinline__ int perm32(int rho) { const int n = rho >> 4, i = rho & 15; return 8 * (i >> 2) + 4 * n + (i & 3); }

struct Unit { int pm, pn; };
struct Gemm { const bf16_t* A; const bf16_t* Bt; int M, N, K; };

struct StaticOrder {
    int nM, nN, nwg, G, c;
    __host__ __device__ void init(int M, int N, int G_, int c_) { nM = M / BM; nN = N / BM; nwg = nM * nN; G = G_; c = c_; }
    __host__ __device__ bool next(int i, Unit& u) const {
        const long L = (long)i * G + c; if (L >= nwg) return false;
        int wgid = (int)L; { const int q = nwg / NXCD, r = nwg % NXCD, xcd = wgid % NXCD, off = wgid / NXCD; wgid = (xcd < r ? xcd * (q + 1) : r * (q + 1) + (xcd - r) * q) + off; }
        const int nig = WGM * nN, gid = wgid / nig, fm = gid * WGM, gsz = (nM - fm) < WGM ? (nM - fm) : WGM;
        u.pm = fm + ((wgid % nig) % gsz); u.pn = (wgid % nig) / gsz; return true;
    }
    __device__ __forceinline__ void a_ready(const Unit&) const {}
    __device__ __forceinline__ void done(const Unit&) const {}
};

__device__ __forceinline__ unsigned cvt_pk_bf16(float lo, float hi) { unsigned r; asm volatile("v_cvt_pk_bf16_f32 %0, %1, %2" : "=v"(r) : "v"(lo), "v"(hi)); return r; }
typedef float f32x2 __attribute__((ext_vector_type(2)));
__device__ __forceinline__ f32x2 gelu_pk(f32x2 v) {
    const f32x2 av = __builtin_elementwise_abs(v), d = av * 0.2316418882f + 1.0f;
    f32x2 t; t.x = __builtin_amdgcn_rcpf(d.x); t.y = __builtin_amdgcn_rcpf(d.y);
    f32x2 q = t * 0.5307027145f + (-0.7265760135f); q = q * t + 0.7107068705f; q = q * t + (-0.142248368f); q = q * t + 0.127414796f; q = q * t;
    const f32x2 s = (v * v) * (-0.72134752044f);
    f32x2 e; e.x = __builtin_amdgcn_exp2f(s.x); e.y = __builtin_amdgcn_exp2f(s.y);
    const f32x2 m = v * (q * e), r = v - m;
    f32x2 o; o.x = v.x < 0.f ? m.x : r.x; o.y = v.y < 0.f ? m.y : r.y; return o;
}

template <int ACT  > struct EpiBf16 {
    static constexpr bool PERM = true, AFTER_DRAIN = false; static_assert(ACT == 0 || ACT == 1, "EpiBf16: ACT is 0 (none) or 1 (gelu_pk)");
    bf16_t* O; int ldc; const float* bias; int split_cols; size_t split_stride; float scale0;
    __device__ __forceinline__ void operator()(const f32x4 (&acc)[2][2][4][2], const Unit& u, int wr, int wc, int fr, int fq) const {
        const int row0 = u.pm * BM + wr * 64 + fr; int colt = u.pn * BM; bf16_t* base = O;
        float sc = 1.f; if (split_cols) { const int t = colt / split_cols; base += (size_t)t * split_stride; colt -= t * split_cols; if (t == 0) sc = scale0; }
        const int col0 = colt + wc * 32 + 8 * fq, bcol0 = u.pn * BM + wc * 32 + 8 * fq;
        f32x4 bv[2][2];
#pragma unroll
        for (int bj = 0; bj < 2; ++bj)
#pragma unroll
            for (int n = 0; n < 2; ++n) bv[bj][n] = bias ? *(const f32x4*)(bias + bcol0 + bj * HALF + 4 * n) : (f32x4){0.f, 0.f, 0.f, 0.f};
#pragma unroll
        for (int ai = 0; ai < 2; ++ai)
#pragma unroll
            for (int m = 0; m < 4; ++m) { bf16_t* rowp = base + (size_t)(row0 + ai * HALF + m * 16) * ldc + col0;
#pragma unroll
                for (int bj = 0; bj < 2; ++bj) { f32x4 v0 = acc[ai][bj][m][0] + bv[bj][0], v1 = acc[ai][bj][m][1] + bv[bj][1];
                    if (ACT == 1) { f32x2 a = gelu_pk((f32x2){v0[0], v0[1]}), b = gelu_pk((f32x2){v0[2], v0[3]}), c = gelu_pk((f32x2){v1[0], v1[1]}), d = gelu_pk((f32x2){v1[2], v1[3]});
                        v0 = (f32x4){a.x, a.y, b.x, b.y}; v1 = (f32x4){c.x, c.y, d.x, d.y}; }
                    v0 = v0 * sc; v1 = v1 * sc; u32x4 w; w.x = cvt_pk_bf16(v0[0], v0[1]); w.y = cvt_pk_bf16(v0[2], v0[3]); w.z = cvt_pk_bf16(v1[0], v1[1]); w.w = cvt_pk_bf16(v1[2], v1[3]);
                    *(u32x4*)(rowp + bj * HALF) = w; } }
    }
};
template <class Epi, class Sched, bool ALIGN_EPI = false, bool SP2 = false>
__device__ __forceinline__ void gemm_phase(PG8_LAS unsigned char* lds, const Gemm g, const Sched& S, const Epi& E) {
    int tid_o = threadIdx.x; asm volatile("" : "+v"(tid_o));
    const int tid = tid_o, wid = __builtin_amdgcn_readfirstlane(tid >> 6), lane = tid & 63, wr = wid >> 2, wc = wid & 3, fr = lane & 15, fq = lane >> 4;
    const int K = g.K, nt = K / BK;
    unsigned voffA[2], voffB[2];
#pragma unroll
    for (int i = 0; i < 2; ++i) { int R, C; stage_rc(tid * 16 + i * 8192, R, C); const int Rb = Epi::PERM ? ((R & ~31) + perm32(R & 31)) : R;
        voffA[i] = (unsigned)(R * K + C) * 2u; voffB[i] = (unsigned)(Rb * K + C) * 2u; }
    const size_t kstep = (size_t)(BK * 2);
    const size_t hstep = (size_t)HALF * K * 2;
    const size_t tstep = 2 * hstep;
    const unsigned ldsw = (unsigned)wid * 1024u;
    const int aoff = lds_byte(wr * 64 + fr, fq * 8), boff = lds_byte(wc * 32 + fr, fq * 8);
#define PG8_SA(b, h) (((b) * 2 + (h)) * HTB)
#define PG8_SB(b, h) ((4 + (b) * 2 + (h)) * HTB)
#define PG8_STAGE(bufoff, gbase, voff) do { _Pragma("unroll") for (int _i = 0; _i < 2; ++_i) \
        __builtin_amdgcn_global_load_lds((const unsigned*)((const char*)(gbase) + (voff)[_i]), (PG8_LAS unsigned*)(lds + (bufoff) + ldsw + _i * 8192), 16, 0, 0); } while (0)
#define PG8_LDA(dst, b, h) do { _Pragma("unroll") for (int m = 0; m < 4; ++m) _Pragma("unroll") for (int k = 0; k < 2; ++k) dst[m][k] = *(const PG8_LAS bf16x8*)(lds + PG8_SA(b, h) + aoff + m * 2048 + k * 1024); } while (0)
#define PG8_LDB(dst, b, h) do { _Pragma("unroll") for (int n = 0; n < 2; ++n) _Pragma("unroll") for (int k = 0; k < 2; ++k) dst[n][k] = *(const PG8_LAS bf16x8*)(lds + PG8_SB(b, h) + boff + n * 2048 + k * 1024); } while (0)
#define PG8_MMA(ai, bj, At, Bt) do { __builtin_amdgcn_s_setprio(1); _Pragma("unroll") for (int m = 0; m < 4; ++m) _Pragma("unroll") for (int n = 0; n < 2; ++n) _Pragma("unroll") for (int k = 0; k < 2; ++k) \
        acc[ai][bj][m][n] = __builtin_amdgcn_mfma_f32_16x16x32_bf16(Bt[n][k], At[m][k], acc[ai][bj][m][n], 0, 0, 0); __builtin_amdgcn_s_setprio(0); } while (0)
#define PG8_WAIT_V(n) asm volatile("s_waitcnt vmcnt(" #n ")" ::: "memory")
#define PG8_WAIT_L(n) asm volatile("s_waitcnt lgkmcnt(" #n ")" ::: "memory")
#define PG8_BAR __builtin_amdgcn_s_barrier()
#define PG8_SCHED __builtin_amdgcn_sched_barrier(0)
    Unit cur, nxt; int ui = 0;
    if (!S.next(0, cur)) return;
    f32x4 acc[2][2][4][2];
#pragma unroll
    for (int a = 0; a < 2; ++a)
#pragma unroll
        for (int b = 0; b < 2; ++b)
#pragma unroll
            for (int m = 0; m < 4; ++m)
#pragma unroll
                for (int n = 0; n < 2; ++n) acc[a][b][m][n] = (f32x4){0.f, 0.f, 0.f, 0.f};
    bf16x8 At[4][2], B0[2][2], B1[2][2];
    const char* cA = (const char*)g.A + (size_t)cur.pm * tstep; const char* cB = (const char*)g.Bt + (size_t)cur.pn * tstep;
    S.a_ready(cur);
    if constexpr (SP2) {
        PG8_STAGE(PG8_SB(0, 0), cB, voffB); PG8_STAGE(PG8_SB(0, 1), cB + hstep, voffB); PG8_STAGE(PG8_SA(0, 0), cA, voffA); PG8_STAGE(PG8_SA(0, 1), cA + hstep, voffA);
        if (wr == 1) PG8_BAR;
        PG8_WAIT_V(2); PG8_BAR;
        PG8_STAGE(PG8_SB(1, 0), cB + kstep, voffB); PG8_STAGE(PG8_SA(1, 0), cA + kstep, voffA); PG8_STAGE(PG8_SB(1, 1), cB + hstep + kstep, voffB);
        PG8_WAIT_V(6); PG8_BAR;
    } else {
        PG8_STAGE(PG8_SB(0, 0), cB, voffB); PG8_STAGE(PG8_SA(0, 0), cA, voffA); PG8_STAGE(PG8_SB(0, 1), cB + hstep, voffB); PG8_STAGE(PG8_SA(0, 1), cA + hstep, voffA);
        if (wr == 1) PG8_BAR;
        PG8_WAIT_V(4); PG8_BAR;
        PG8_STAGE(PG8_SB(1, 0), cB + kstep, voffB); PG8_STAGE(PG8_SA(1, 0), cA + kstep, voffA); PG8_STAGE(PG8_SB(1, 1), cB + hstep + kstep, voffB);
        PG8_WAIT_V(6); PG8_BAR;
    }
    for (;;) {
        const bool has_next = S.next(ui + 1, nxt);
        const char* nA = has_next ? (const char*)g.A + (size_t)nxt.pm * tstep : cA; const char* nB = has_next ? (const char*)g.Bt + (size_t)nxt.pn * tstep : cB;
        for (int t = 0; t < nt; t += 2) {
            const bool last = (t == nt - 2);
            const char* a1 = cA + (size_t)(t + 1) * kstep;
            const char* a2 = last ? nA : cA + (size_t)(t + 2) * kstep; const char* b2 = last ? nB : cB + (size_t)(t + 2) * kstep;
            const char* a3 = a2 + kstep; const char* b3 = b2 + kstep;
            if (last && has_next) S.a_ready(nxt);
            if constexpr (SP2) {
            PG8_LDB(B0, 0, 0); PG8_LDB(B1, 0, 1); PG8_SCHED; PG8_LDA(At, 0, 0); PG8_STAGE(PG8_SA(1, 1), a1 + hstep, voffA);
            PG8_WAIT_V(8); PG8_WAIT_L(0); PG8_BAR; PG8_MMA(0, 0, At, B0); PG8_MMA(0, 1, At, B1); PG8_BAR; PG8_SCHED;
            PG8_LDA(At, 0, 1); PG8_STAGE(PG8_SB(0, 0), b2, voffB); PG8_STAGE(PG8_SB(0, 1), b2 + hstep, voffB); PG8_STAGE(PG8_SA(0, 0), a2, voffA);
            PG8_WAIT_V(8); PG8_WAIT_L(0); PG8_BAR; PG8_MMA(1, 0, At, B0); PG8_MMA(1, 1, At, B1); PG8_BAR; PG8_SCHED;
            PG8_LDB(B0, 1, 0); PG8_LDB(B1, 1, 1); PG8_SCHED; PG8_LDA(At, 1, 0); PG8_STAGE(PG8_SA(0, 1), a2 + hstep, voffA);
            PG8_WAIT_V(8); PG8_WAIT_L(0); PG8_BAR; PG8_MMA(0, 0, At, B0); PG8_MMA(0, 1, At, B1); PG8_BAR; PG8_SCHED;
            PG8_LDA(At, 1, 1); PG8_STAGE(PG8_SB(1, 0), b3, voffB); PG8_STAGE(PG8_SB(1, 1), b3 + hstep, voffB); PG8_STAGE(PG8_SA(1, 0), a3, voffA);
            PG8_WAIT_V(8); PG8_WAIT_L(0); PG8_BAR; PG8_MMA(1, 0, At, B0); PG8_MMA(1, 1, At, B1); PG8_BAR; PG8_SCHED;
            } else {
            PG8_LDB(B0, 0, 0); PG8_SCHED; PG8_LDA(At, 0, 0); PG8_STAGE(PG8_SA(1, 1), a1 + hstep, voffA);
            PG8_WAIT_L(8); PG8_BAR; PG8_WAIT_L(0); PG8_MMA(0, 0, At, B0); PG8_BAR; PG8_SCHED;
            PG8_LDB(B1, 0, 1); PG8_STAGE(PG8_SB(0, 0), b2, voffB);
            PG8_BAR; PG8_WAIT_L(0); PG8_MMA(0, 1, At, B1); PG8_BAR;
            PG8_LDA(At, 0, 1); PG8_STAGE(PG8_SA(0, 0), a2, voffA);
            PG8_BAR; PG8_WAIT_L(0); PG8_MMA(1, 0, At, B0); PG8_BAR; PG8_SCHED;
            PG8_STAGE(PG8_SB(0, 1), b2 + hstep, voffB);
            PG8_WAIT_V(6); PG8_BAR; PG8_MMA(1, 1, At, B1); PG8_BAR;
            PG8_LDB(B0, 1, 0); PG8_SCHED; PG8_LDA(At, 1, 0); PG8_STAGE(PG8_SA(0, 1), a2 + hstep, voffA);
            PG8_WAIT_L(8); PG8_BAR; PG8_WAIT_L(0); PG8_MMA(0, 0, At, B0); PG8_BAR; PG8_SCHED;
            PG8_LDB(B1, 1, 1); PG8_STAGE(PG8_SB(1, 0), b3, voffB);
            PG8_BAR; PG8_WAIT_L(0); PG8_MMA(0, 1, At, B1); PG8_BAR;
            PG8_LDA(At, 1, 1); PG8_STAGE(PG8_SA(1, 0), a3, voffA);
            PG8_BAR; PG8_WAIT_L(0); PG8_MMA(1, 0, At, B0); PG8_BAR; PG8_SCHED;
            PG8_STAGE(PG8_SB(1, 1), b3 + hstep, voffB);
            PG8_WAIT_V(6); PG8_BAR; PG8_MMA(1, 1, At, B1); PG8_BAR;
            }
        }
        if constexpr (ALIGN_EPI) { if (wr == 0) PG8_BAR; }
        if constexpr (!Epi::AFTER_DRAIN) { E(acc, cur, wr, wc, fr, fq); S.done(cur); }
        if (!has_next) break;
#pragma unroll
        for (int a = 0; a < 2; ++a)
#pragma unroll
            for (int b = 0; b < 2; ++b)
#pragma unroll
                for (int m = 0; m < 4; ++m)
#pragma unroll
                    for (int n = 0; n < 2; ++n) acc[a][b][m][n] = (f32x4){0.f, 0.f, 0.f, 0.f};
        cur = nxt; cA = nA; cB = nB; ++ui;
        if constexpr (ALIGN_EPI) { if (wr == 1) PG8_BAR; }
    }
    PG8_WAIT_V(0);
    if constexpr (!ALIGN_EPI) { if (wr == 0) PG8_BAR; }
    PG8_BAR;
    if constexpr (Epi::AFTER_DRAIN) { E.fused(acc, cur, wr, wc, fr, fq, lds, wid, lane); S.done(cur); }
#undef PG8_SA
#undef PG8_SB
#undef PG8_STAGE
#undef PG8_LDA
#undef PG8_LDB
#undef PG8_MMA
#undef PG8_WAIT_V
#undef PG8_WAIT_L
#undef PG8_BAR
#undef PG8_SCHED
}
}

#define LAS __attribute__((address_space(3)))
typedef unsigned short bf16_t;
typedef short bf16x8 __attribute__((ext_vector_type(8)));
typedef float f32x4 __attribute__((ext_vector_type(4)));
typedef float f32x2 __attribute__((ext_vector_type(2)));
typedef float f32x16 __attribute__((ext_vector_type(16)));
typedef unsigned u32x4 __attribute__((ext_vector_type(4)));
typedef unsigned u32x2 __attribute__((ext_vector_type(2)));
#define MFMA32(a, b, c) __builtin_amdgcn_mfma_f32_32x32x16_bf16((a), (b), (c), 0, 0, 0)

constexpr int DM = 1024, SEQ = 16384, NBP = 2, DEPTH = 4, DB = 16, DS = 32, PAST = 2048;
constexpr int MP = NBP * SEQ, MS = DB * DS, MT = MP + MS;
constexpr int INW = 3584, DFF = 2816, NMOD = 6144, NBI = 18;
constexpr float EPS = 1e-6f;
constexpr size_t OFF_YP = 0, OFF_YS = 33554432, OFF_KP = 34078720, OFF_VP = 101187584, OFF_RP = 168296448,
                 OFF_KS = 168820736, OFF_VS = 169869312, OFF_RS = 170917888;
constexpr size_t MiB = 1u << 20;
constexpr size_t WS_MOD = 0, MOD_BYTES = 2 * MiB; constexpr size_t WS_CTR = 1820160;
constexpr size_t WS_BAR = 1802240;
constexpr size_t WS_ROPE = 2 * MiB;
constexpr size_t WS_WIN = 10 * MiB, WS_WOUT = 38 * MiB, WS_WFI = 46 * MiB, WS_WFO = 90 * MiB;
constexpr size_t WS_X = 112 * MiB;
constexpr size_t WS_H = 242 * MiB;
constexpr size_t WS_O = 307 * MiB;
constexpr size_t WS_QKV = 372 * MiB;
constexpr size_t WS_U = 600 * MiB;
constexpr size_t WS_PART = 616 * MiB;
constexpr size_t WS_END = 632 * MiB;
constexpr int LDS_BYTES = 147456;

struct Params { const float* in[18]; float* out; unsigned char* ws; };

typedef __bf16 bf16x2_t __attribute__((ext_vector_type(2)));
__device__ __forceinline__ unsigned pk2(float lo, float hi) { const f32x2 v = {lo, hi}; return __builtin_bit_cast(unsigned, __builtin_convertvector(v, bf16x2_t)); }
__device__ __forceinline__ unsigned f2bf(float f) { return pk2(f, 0.f) & 0xffffu; }
__device__ __forceinline__ float bf2f(unsigned h) { return __builtin_bit_cast(float, h << 16); }
__device__ __forceinline__ f32x4 ldx4(const bf16_t* p) { const u32x2 w = *(const u32x2*)p;
    return (f32x4){__builtin_bit_cast(float, w.x << 16), __builtin_bit_cast(float, w.x & 0xffff0000u), __builtin_bit_cast(float, w.y << 16), __builtin_bit_cast(float, w.y & 0xffff0000u)}; }
__device__ __forceinline__ bf16x8 pack8(f32x4 a, f32x4 b) { u32x4 p; p.x = pk2(a.x, a.y); p.y = pk2(a.z, a.w); p.z = pk2(b.x, b.y); p.w = pk2(b.z, b.w); return __builtin_bit_cast(bf16x8, p); }
__device__ __forceinline__ float wave_sum(float v) {
#pragma unroll
    for (int o = 1; o < 64; o <<= 1) v += __shfl_xor(v, o);
    return v;
}
__device__ __forceinline__ float silu_f(float x) { return x * __builtin_amdgcn_rcpf(1.f + __expf(-x)); }
__device__ __forceinline__ int batch_of(int row) { return row < MP ? (row >> 14) : 2 + ((row - MP) >> 5); }

struct EpiQKV {
    static constexpr bool PERM = true, AFTER_DRAIN = false;
    bf16_t* QKV; float* out; int layer;
    __device__ __forceinline__ void operator()(const pg8::f32x4 (&acc)[2][2][4][2], const pg8::Unit& u, int wr, int wc, int fr, int fq) const {
        const int row0 = u.pm * 256 + wr * 64 + fr, col0 = u.pn * 256 + wc * 32 + 8 * fq;
        const bool kv = (u.pn >= 2 && u.pn < 6);
        const size_t vsel = (u.pn >= 4) ? 1 : 0;
        const size_t obase = (u.pm < 128) ? OFF_KP + vsel * (OFF_VP - OFF_KP) + (size_t)layer * MP * 512 + (size_t)row0 * 512
                                          : OFF_KS + vsel * (OFF_VS - OFF_KS) + (size_t)layer * MS * 512 + (size_t)(row0 - MP) * 512;
#pragma unroll
        for (int ai = 0; ai < 2; ++ai)
#pragma unroll
            for (int m = 0; m < 4; ++m) {
                const int row = row0 + ai * 128 + m * 16;
#pragma unroll
                for (int bj = 0; bj < 2; ++bj) {
                    const int col = col0 + bj * 128;
                    const pg8::f32x4 v0 = acc[ai][bj][m][0], v1 = acc[ai][bj][m][1];
                    u32x4 w; w.x = pg8::cvt_pk_bf16(v0[0], v0[1]); w.y = pg8::cvt_pk_bf16(v0[2], v0[3]); w.z = pg8::cvt_pk_bf16(v1[0], v1[1]); w.w = pg8::cvt_pk_bf16(v1[2], v1[3]);
                    *(u32x4*)(QKV + (size_t)row * INW + col) = w;
                    if (kv) {
                        const int c = col & 511;
                        float* dst = out + obase + (size_t)(ai * 128 + m * 16) * 512 + c;
                        *(pg8::f32x4*)dst = v0; *(pg8::f32x4*)(dst + 4) = v1;
                    }
                }
                asm volatile("" ::: "memory");
            }
    }
};
struct EpiResid {
    static constexpr bool PERM = false, AFTER_DRAIN = false;
    const float* base_p; const float* base_s;
    bf16_t* X; const float* gate;
    __device__ __forceinline__ void operator()(const pg8::f32x4 (&acc)[2][2][4][2], const pg8::Unit& u, int wr, int wc, int fr, int fq) const {
        const int col0 = u.pn * 256 + wc * 32 + 4 * fq;
        const bool uni = u.pm < 128;
        pg8::f32x4 gv[4];
        { const float* gr = gate + (size_t)batch_of(u.pm * 256 + wr * 64 + fr) * NMOD;
#pragma unroll
          for (int q = 0; q < 4; ++q) gv[q] = *(const pg8::f32x4*)(gr + col0 + (q >> 1) * 128 + (q & 1) * 16); }
#pragma unroll
        for (int grp = 0; grp < 4; ++grp) {
            const int ai = grp >> 1, m0 = (grp & 1) * 2;
            pg8::f32x4 bv[2][4];
#pragma unroll
            for (int mm = 0; mm < 2; ++mm) {
                const int row = u.pm * 256 + ai * 128 + wr * 64 + (m0 + mm) * 16 + fr;
                if (base_p) { const float* br = row < MP ? base_p + (size_t)row * DM : base_s + (size_t)(row - MP) * DM;
#pragma unroll
                    for (int q = 0; q < 4; ++q) bv[mm][q] = *(const pg8::f32x4*)(br + col0 + (q >> 1) * 128 + (q & 1) * 16);
                } else { const bf16_t* br = X + (size_t)row * DM;
#pragma unroll
                    for (int q = 0; q < 4; ++q) bv[mm][q] = ldx4(br + col0 + (q >> 1) * 128 + (q & 1) * 16); }
            }
#pragma unroll
            for (int mm = 0; mm < 2; ++mm) {
                const int m = m0 + mm, row = u.pm * 256 + ai * 128 + wr * 64 + m * 16 + fr;
                if (!uni) { const float* gr = gate + (size_t)batch_of(row) * NMOD;
#pragma unroll
                    for (int q = 0; q < 4; ++q) gv[q] = *(const pg8::f32x4*)(gr + col0 + (q >> 1) * 128 + (q & 1) * 16); }
                bf16_t* xr = X + (size_t)row * DM;
#pragma unroll
                for (int q = 0; q < 4; ++q) { const int bj = q >> 1, n = q & 1;
                    const pg8::f32x4 xv = bv[mm][q] + gv[q] * acc[ai][bj][m][n];
                    u32x2 w; w.x = pk2(xv[0], xv[1]); w.y = pk2(xv[2], xv[3]); *(u32x2*)(xr + col0 + bj * 128 + n * 16) = w; }
            }
            asm volatile("" ::: "memory");
        }
    }
};
struct EpiSwiGLU {
    static constexpr bool PERM = true, AFTER_DRAIN = false;
    bf16_t* ACT;
    __device__ __forceinline__ void operator()(const pg8::f32x4 (&acc)[2][2][4][2], const pg8::Unit& u, int wr, int wc, int fr, int fq) const {
        const int col0 = u.pn * 128 + wc * 32 + 8 * fq;
#pragma unroll
        for (int ai = 0; ai < 2; ++ai)
#pragma unroll
            for (int m = 0; m < 4; ++m) {
                const int row = u.pm * 256 + ai * 128 + wr * 64 + m * 16 + fr;
                const pg8::f32x4 g0 = acc[ai][0][m][0], g1 = acc[ai][0][m][1], u0 = acc[ai][1][m][0], u1 = acc[ai][1][m][1];
                float r[8];
#pragma unroll
                for (int j = 0; j < 4; ++j) { r[j] = silu_f(g0[j]) * u0[j]; r[4 + j] = silu_f(g1[j]) * u1[j]; }
                u32x4 w; w.x = pg8::cvt_pk_bf16(r[0], r[1]); w.y = pg8::cvt_pk_bf16(r[2], r[3]); w.z = pg8::cvt_pk_bf16(r[4], r[5]); w.w = pg8::cvt_pk_bf16(r[6], r[7]);
                *(u32x4*)(ACT + (size_t)row * DFF + col0) = w;
                asm volatile("" ::: "memory");
            }
    }
};


template <int NKS  , int UNR, class Epi>
__device__ __forceinline__ void sgemm_phase(LAS unsigned char* lds, const bf16_t* A  , int lda, const bf16_t* Bt, int K, int ncb,
                                            int tid, int lane, int wave, const Epi& E) {
    const int l32 = lane & 31, hf = lane >> 5;
    LAS float* red = (LAS float*)lds;
    const int kw0 = wave * NKS * 16 + hf * 8;
    for (int it = blockIdx.x; it < 16 * ncb; it += gridDim.x) {
        const int rb = it & 15, cb = it >> 4;
        int n0, n1; E.cols(cb, n0, n1);
        const bf16_t* ap = A + (size_t)(rb * 32 + l32) * lda + kw0;
        const bf16_t* b0p = Bt + (size_t)(n0 + l32) * K + kw0;
        const bf16_t* b1p = Bt + (size_t)(n1 + l32) * K + kw0;
        f32x16 c0, c1;
#pragma unroll
        for (int r = 0; r < 16; ++r) { c0[r] = 0.f; c1[r] = 0.f; }
#pragma unroll 1
        for (int kb = 0; kb < NKS; kb += UNR) {
            bf16x8 a[UNR], b0[UNR], b1[UNR];
#pragma unroll
            for (int j = 0; j < UNR; ++j) { a[j] = *(const bf16x8*)(ap + (kb + j) * 16); b0[j] = *(const bf16x8*)(b0p + (kb + j) * 16); b1[j] = *(const bf16x8*)(b1p + (kb + j) * 16); }
#pragma unroll
            for (int j = 0; j < UNR; ++j) { c0 = MFMA32(a[j], b0[j], c0); c1 = MFMA32(a[j], b1[j], c1); }
        }
        LAS float* rw = red + wave * 2176;
#pragma unroll
        for (int r = 0; r < 16; ++r) { const int row = (r >> 2) * 8 + hf * 4 + (r & 3); rw[row * 34 + l32] = c0[r]; rw[1088 + row * 34 + l32] = c1[r]; }
        __syncthreads();
        {
            const int row = tid >> 4, cc = (tid & 15) * 2;
            f32x2 g = {0.f, 0.f}, u = {0.f, 0.f};
#pragma unroll
            for (int w = 0; w < 8; ++w) { g += *(const LAS f32x2*)(red + w * 2176 + row * 34 + cc); u += *(const LAS f32x2*)(red + w * 2176 + 1088 + row * 34 + cc); }
            E(rb * 32 + row, n0 + cc, n1 + cc, g, u);
        }
        __syncthreads();
    }
}
struct SEpiQKV {
    bf16_t* QKV; float* out; int layer;
    __device__ __forceinline__ void cols(int cb, int& n0, int& n1) const { n0 = cb * 64; n1 = n0 + 32; }
    __device__ __forceinline__ void emit(int r, int c, f32x2 v) const {
        *(unsigned*)(QKV + (size_t)(MP + r) * INW + c) = pk2(v.x, v.y);
        if (c >= 512 && c < 1536) { const size_t off = (c < 1024 ? OFF_KS : OFF_VS) + ((size_t)layer * MS + r) * 512 + (c & 511); *(f32x2*)(out + off) = v; }
    }
    __device__ __forceinline__ void operator()(int r, int c0, int c1, f32x2 g, f32x2 u) const { emit(r, c0, g); emit(r, c1, u); }
};
struct SEpiResid {
    const float* basef; bf16_t* Xs; const float* gate;
    __device__ __forceinline__ void cols(int cb, int& n0, int& n1) const { n0 = cb * 64; n1 = n0 + 32; }
    __device__ __forceinline__ void operator()(int r, int c0, int c1, f32x2 g, f32x2 u) const {
        const float* gp = gate + (size_t)(2 + (r >> 5)) * NMOD; bf16_t* xp = Xs + (size_t)r * DM;
        f32x2 b0, b1;
        if (basef) { b0 = *(const f32x2*)(basef + (size_t)r * DM + c0); b1 = *(const f32x2*)(basef + (size_t)r * DM + c1); }
        else { const unsigned w0 = *(const unsigned*)(xp + c0), w1 = *(const unsigned*)(xp + c1);
            b0 = (f32x2){__builtin_bit_cast(float, w0 << 16), __builtin_bit_cast(float, w0 & 0xffff0000u)}; b1 = (f32x2){__builtin_bit_cast(float, w1 << 16), __builtin_bit_cast(float, w1 & 0xffff0000u)}; }
        const f32x2 x0 = b0 + *(const f32x2*)(gp + c0) * g, x1 = b1 + *(const f32x2*)(gp + c1) * u;
        *(unsigned*)(xp + c0) = pk2(x0.x, x0.y); *(unsigned*)(xp + c1) = pk2(x1.x, x1.y);
    }
};
struct SEpiSwiGLU {
    bf16_t* ACT;
    __device__ __forceinline__ void cols(int cb, int& n0, int& n1) const { n0 = (cb >> 2) * 256 + (cb & 3) * 32; n1 = n0 + 128; }
    __device__ __forceinline__ void operator()(int r, int c0, int c1, f32x2 g, f32x2 u) const {
        const int col = (c0 >> 8) * 128 + (c0 & 127);
        *(unsigned*)(ACT + (size_t)(MP + r) * DFF + col) = pk2(silu_f(g.x) * u.x, silu_f(g.y) * u.y);
    }
};

__device__ __forceinline__ void transpose_item(const float* W, int K, int N, bf16_t* WT, LAS float* scr, int item, int lane, bool perm) {
    const int nblk = N / 32, kb = item / nblk, nb = item % nblk, k0 = 64 * kb, n0 = 32 * nb;
    int p0 = n0;
    if (perm) { if (n0 < DFF) p0 = (n0 >> 7) * 256 + (n0 & 127); else { const int n1 = n0 - DFF; p0 = (n1 >> 7) * 256 + 128 + (n1 & 127); } }
#pragma unroll 8
    for (int i = 0; i < 32; ++i) { const int kk = 2 * i + (lane >> 5); scr[kk * 33 + (lane & 31)] = W[(size_t)(k0 + kk) * N + n0 + (lane & 31)]; }
    asm volatile("s_waitcnt lgkmcnt(0)" ::: "memory"); __builtin_amdgcn_wave_barrier();
    const int c = lane & 7;
#pragma unroll
    for (int j = 0; j < 4; ++j) { const int n = (lane >> 3) + 8 * j; const LAS float* s = scr + (8 * c) * 33 + n;
        u32x4 o; o.x = pk2(s[0 * 33], s[1 * 33]); o.y = pk2(s[2 * 33], s[3 * 33]); o.z = pk2(s[4 * 33], s[5 * 33]); o.w = pk2(s[6 * 33], s[7 * 33]);
        *(u32x4*)(WT + (size_t)(p0 + n) * K + k0 + 8 * c) = o; }
    asm volatile("s_waitcnt lgkmcnt(0)" ::: "memory"); __builtin_amdgcn_wave_barrier();
}

__device__ __forceinline__ void p0_phase(const Params& P, LAS unsigned char* lds, int tid, int lane, int wave) {
    LAS float* sc = (LAS float*)lds;
    for (int i = tid; i < NBI * DM; i += 512) { const int b = i >> 10, k = i & 1023; const float c = b < 2 ? P.in[5][b * DM + k] : P.in[6][(b - 2) * DM + k]; sc[i] = silu_f(c); }
    __syncthreads();
    const int gw = blockIdx.x * 8 + wave, NGW = gridDim.x * 8;
    float* MOD = (float*)(P.ws + WS_MOD);
    for (int it = gw; it < 768; it += NGW) {
        const int l = it / 192, r = it % 192, cb = r >> 3, kc = r & 7;
        f32x4 acc[NBI];
#pragma unroll
        for (int b = 0; b < NBI; ++b) acc[b] = (f32x4){0.f, 0.f, 0.f, 0.f};
        const float* wp = P.in[9] + ((size_t)l * DM + kc * 128) * NMOD + cb * 256 + lane * 4;
        const LAS float* scp = sc + kc * 128;
#pragma unroll 16
        for (int k = 0; k < 128; ++k) { const f32x4 w = *(const f32x4*)(wp + (size_t)k * NMOD);
#pragma unroll
            for (int b = 0; b < NBI; ++b) acc[b] += scp[b * DM + k] * w; }
        if (kc == 0) { const f32x4 bv = *(const f32x4*)(P.in[10] + (size_t)l * NMOD + cb * 256 + lane * 4);
#pragma unroll
            for (int b = 0; b < NBI; ++b) acc[b] += bv; }
        float* mp = (float*)(P.ws + WS_PART) + ((size_t)kc * DEPTH + l) * NBI * NMOD + cb * 256 + lane * 4;
#pragma unroll
        for (int b = 0; b < NBI; ++b) *(f32x4*)(mp + b * NMOD) = acc[b];
    }
    LAS float* scr = (LAS float*)(lds + 73728 + wave * 8448);
    constexpr int I_IN = 16 * 112, I_OUT = 16 * 32, I_FI = 16 * 176, I_FO = 44 * 32, I_L = I_IN + I_OUT + I_FI + I_FO;
    for (int it = gw; it < DEPTH * I_L; it += NGW) {
        const int l = it / I_L; int r = it % I_L;
        if (r < I_IN) { transpose_item(P.in[11] + (size_t)l * DM * INW, DM, INW, (bf16_t*)(P.ws + WS_WIN) + (size_t)l * INW * DM, scr, r, lane, false); continue; } r -= I_IN;
        if (r < I_OUT) { transpose_item(P.in[14] + (size_t)l * DM * DM, DM, DM, (bf16_t*)(P.ws + WS_WOUT) + (size_t)l * DM * DM, scr, r, lane, false); continue; } r -= I_OUT;
        if (r < I_FI) { transpose_item(P.in[15] + (size_t)l * DM * 2 * DFF, DM, 2 * DFF, (bf16_t*)(P.ws + WS_WFI) + (size_t)l * 2 * DFF * DM, scr, r, lane, true); continue; } r -= I_FI;
        transpose_item(P.in[16] + (size_t)l * DFF * DM, DFF, DM, (bf16_t*)(P.ws + WS_WFO) + (size_t)l * DM * DFF, scr, r, lane, false);
    }
    f32x2* ROPE = (f32x2*)(P.ws + WS_ROPE);
    for (int idx = blockIdx.x * 512 + tid; idx < SEQ * 64; idx += gridDim.x * 512) {
        const int pos = idx >> 6, i = idx & 63;
        const float inv = exp2f(-(float)i * (13.287712379549449f / 64.f));
        const float ang = (float)pos * inv;
        double rev = (double)ang * 0.15915494309189535; rev -= floor(rev);
        const float rf = (float)rev;
        ROPE[idx] = (f32x2){__builtin_amdgcn_cosf(rf), __builtin_amdgcn_sinf(rf)};
    }
}

template <bool FINAL>
__device__ __forceinline__ void norm_phase(const Params& P, int l, bool from_input, const float* gain, int sh_off, int sc_off, int lane, int wave) {
    const int gw = blockIdx.x * 8 + wave, NGW = gridDim.x * 8;
    const float* MOD = (const float*)(P.ws + WS_MOD) + (size_t)l * NBI * NMOD;
    const bf16_t* X = (const bf16_t*)(P.ws + WS_X); bf16_t* H = (bf16_t*)(P.ws + WS_H);
    f32x4 g[4];
#pragma unroll
    for (int j = 0; j < 4; ++j) g[j] = *(const f32x4*)(gain + 4 * lane + 256 * j);
    auto loadrow = [&](int m, f32x4 (&v)[4]) {
        if (!FINAL && from_input) { const float* xr = m < MP ? P.in[0] + (size_t)m * DM : P.in[1] + (size_t)(m - MP) * DM;
#pragma unroll
            for (int j = 0; j < 4; ++j) v[j] = *(const f32x4*)(xr + 4 * lane + 256 * j);
        } else { const bf16_t* xr = X + (size_t)m * DM;
#pragma unroll
            for (int j = 0; j < 4; ++j) v[j] = ldx4(xr + 4 * lane + 256 * j); }
    };
    f32x4 vn[4];
    if (gw < MT) loadrow(gw, vn);
    for (int m = gw; m < MT; m += NGW) {
        f32x4 v[4]; float ss = 0.f;
#pragma unroll
        for (int j = 0; j < 4; ++j) v[j] = vn[j];
        if (m + NGW < MT) loadrow(m + NGW, vn);
        f32x4 sc[4], sh[4];
        if (!FINAL) { const float* mr = MOD + (size_t)batch_of(m) * NMOD;
#pragma unroll
            for (int j = 0; j < 4; ++j) { const int c = 4 * lane + 256 * j; sc[j] = *(const f32x4*)(mr + sc_off + c); sh[j] = *(const f32x4*)(mr + sh_off + c); } }
#pragma unroll
        for (int j = 0; j < 4; ++j) ss += (v[j].x * v[j].x + v[j].y * v[j].y) + (v[j].z * v[j].z + v[j].w * v[j].w);
        const float rstd = rsqrtf(wave_sum(ss) * (1.f / DM) + EPS);
        if (FINAL) {
            float* o = P.out + (size_t)m * DM;
#pragma unroll
            for (int j = 0; j < 4; ++j) *(f32x4*)(o + 4 * lane + 256 * j) = v[j] * rstd * g[j];
        } else {
#pragma unroll
            for (int j = 0; j < 4; ++j) { const int c = 4 * lane + 256 * j;
                const f32x4 hh = v[j] * rstd * g[j] * (1.f + sc[j]) + sh[j];
                u32x2 w; w.x = pk2(hh.x, hh.y); w.y = pk2(hh.z, hh.w);
                *(u32x2*)(H + (size_t)m * DM + c) = w; }
        }
    }
}

__device__ __forceinline__ void sb_unit(const Params& P, int l, int u, LAS unsigned char* lds, int tid, int lane, int wave) {
    const bf16_t* QKV = (const bf16_t*)(P.ws + WS_QKV);
    const int h = wave, l32 = lane & 31, hf = lane >> 5;
    const bool samp = u >= 1024;
    int qrow0, nsteps; const float* ck = nullptr; const float* cv = nullptr;
    if (!samp) { const int b = u >> 9, qb = u & 511; qrow0 = b * SEQ + qb * 32; nsteps = qb + 1; }
    else { const int bs = u - 1024; qrow0 = MP + bs * 32; nsteps = 65; ck = P.in[2] + (size_t)(l * DB + bs) * PAST * 512; cv = P.in[3] + (size_t)(l * DB + bs) * PAST * 512; }
    bf16x8 qf[4];
#pragma unroll
    for (int ks = 0; ks < 4; ++ks) qf[ks] = *(const bf16x8*)(QKV + (size_t)(qrow0 + l32) * INW + h * 64 + ks * 16 + hf * 8);
    f32x16 O0, O1;
#pragma unroll
    for (int r = 0; r < 16; ++r) { O0[r] = 0.f; O1[r] = 0.f; }
    float cum = 0.f;
    LAS unsigned char* vt = lds + 66048 + wave * 4608;
    auto issue = [&](int s, bf16x8 (&k)[4], bf16x8 (&v)[4]) {
        if (!samp || s == 0) {
            const int krow0 = samp ? qrow0 : qrow0 - s * 32;
#pragma unroll
            for (int ks = 0; ks < 4; ++ks) k[ks] = *(const bf16x8*)(QKV + (size_t)(krow0 + l32) * INW + 512 + h * 64 + ks * 16 + hf * 8);
#pragma unroll
            for (int it = 0; it < 4; ++it) { const int id = it * 64 + lane, key = id >> 3, ch = id & 7;
                v[it] = *(const bf16x8*)(QKV + (size_t)(krow0 + key) * INW + 1024 + h * 64 + ch * 8); }
        } else {
            const int kpos0 = (64 - s) * 32;
#pragma unroll
            for (int ks = 0; ks < 4; ++ks) { const float* p = ck + (size_t)(kpos0 + l32) * 512 + h * 64 + ks * 16 + hf * 8; k[ks] = pack8(*(const f32x4*)p, *(const f32x4*)(p + 4)); }
#pragma unroll
            for (int it = 0; it < 4; ++it) { const int id = it * 64 + lane, key = id >> 3, ch = id & 7;
                const float* p = cv + (size_t)(kpos0 + key) * 512 + h * 64 + ch * 8;
                v[it] = pack8(*(const f32x4*)p, *(const f32x4*)(p + 4)); }
        }
    };
    bf16x8 kf[4], vr[4];
    issue(0, kf, vr);
    for (int s = 0; s < nsteps; ++s) {
#pragma unroll
        for (int it = 0; it < 4; ++it) { const int id = it * 64 + lane, key = id >> 3, ch = id & 7; *(LAS bf16x8*)(vt + key * 144 + ch * 16) = vr[it]; }
        bf16x8 kn[4];
#pragma unroll
        for (int ks = 0; ks < 4; ++ks) kn[ks] = kf[ks];
        if (s + 1 < nsteps) issue(s + 1, kn, vr);
        asm volatile("s_waitcnt lgkmcnt(0)" ::: "memory"); __builtin_amdgcn_wave_barrier();
        f32x16 S;
#pragma unroll
        for (int r = 0; r < 16; ++r) S[r] = 0.f;
#pragma unroll
        for (int ks = 0; ks < 4; ++ks) S = MFMA32(kf[ks], qf[ks], S);
        float L[16], lb[16]; bool valid[16];
#pragma unroll
        for (int r = 0; r < 16; ++r) {
            const float z = S[r] * 0.18033688011112042f;
            const float sp = fmaxf(z, 0.f) + __builtin_amdgcn_logf(1.f + __builtin_amdgcn_exp2f(-fabsf(z)));
            const int key = (r >> 2) * 8 + hf * 4 + (r & 3);
            valid[r] = (s != 0) || (key < l32);
            L[r] = valid[r] ? -sp : 0.f; lb[r] = z - sp;
        }
        float T[4], Pp[4];
#pragma unroll
        for (int g = 0; g < 4; ++g) { T[g] = (L[4 * g] + L[4 * g + 1]) + (L[4 * g + 2] + L[4 * g + 3]); Pp[g] = __shfl_xor(T[g], 32); }
        float later[4]; float tot = 0.f;
#pragma unroll
        for (int g = 3; g >= 0; --g) { later[g] = tot; tot += T[g] + Pp[g]; }
        float w[16];
#pragma unroll
        for (int g = 0; g < 4; ++g) {
            const float s3 = cum + later[g] + (hf == 0 ? Pp[g] : 0.f);
            const float s2 = s3 + L[4 * g + 3], s1 = s2 + L[4 * g + 2], s0 = s1 + L[4 * g + 1];
            w[4 * g + 3] = valid[4 * g + 3] ? __builtin_amdgcn_exp2f(lb[4 * g + 3] + s3) : 0.f;
            w[4 * g + 2] = valid[4 * g + 2] ? __builtin_amdgcn_exp2f(lb[4 * g + 2] + s2) : 0.f;
            w[4 * g + 1] = valid[4 * g + 1] ? __builtin_amdgcn_exp2f(lb[4 * g + 1] + s1) : 0.f;
            w[4 * g + 0] = valid[4 * g + 0] ? __builtin_amdgcn_exp2f(lb[4 * g + 0] + s0) : 0.f;
        }
        cum += tot;
#pragma unroll
        for (int c = 0; c < 2; ++c) {
            u32x4 pw; pw.x = pk2(w[8 * c], w[8 * c + 1]); pw.y = pk2(w[8 * c + 2], w[8 * c + 3]); pw.z = pk2(w[8 * c + 4], w[8 * c + 5]); pw.w = pk2(w[8 * c + 6], w[8 * c + 7]);
            const bf16x8 pa = __builtin_bit_cast(bf16x8, pw);
#pragma unroll
            for (int dt = 0; dt < 2; ++dt) {
                bf16x8 vb;
#pragma unroll
                for (int i = 0; i < 8; ++i) { const int key = 16 * c + 8 * (i >> 2) + 4 * hf + (i & 3); vb[i] = *(const LAS short*)(vt + key * 144 + (l32 + 32 * dt) * 2); }
                if (dt == 0) O0 = MFMA32(pa, vb, O0); else O1 = MFMA32(pa, vb, O1);
            }
        }
        asm volatile("" ::: "memory");
        if (__all(cum < -158.7f)) break;
#pragma unroll
        for (int ks = 0; ks < 4; ++ks) kf[ks] = kn[ks];
    }
    LAS float* oa = (LAS float*)lds;
#pragma unroll
    for (int r = 0; r < 16; ++r) { const int q = (r >> 2) * 8 + hf * 4 + (r & 3); oa[q * 516 + h * 64 + l32] = O0[r]; oa[q * 516 + h * 64 + 32 + l32] = O1[r]; }
    __syncthreads();
    bf16_t* Ob = (bf16_t*)(P.ws + WS_O);
    const float* gsb = P.in[12] + (size_t)l * 512;
    {
        f32x4 ra[4], rb[4]; float sq[4];
#pragma unroll
        for (int rr = 0; rr < 4; ++rr) { const int q = wave * 4 + rr;
            ra[rr] = *(const LAS f32x4*)(oa + q * 516 + 4 * lane); rb[rr] = *(const LAS f32x4*)(oa + q * 516 + 256 + 4 * lane);
            const f32x4 a = ra[rr], b = rb[rr];
            sq[rr] = (a.x * a.x + a.y * a.y) + (a.z * a.z + a.w * a.w) + (b.x * b.x + b.y * b.y) + (b.z * b.z + b.w * b.w); }
#pragma unroll
        for (int o = 1; o < 64; o <<= 1) {
#pragma unroll
            for (int rr = 0; rr < 4; ++rr) sq[rr] += __shfl_xor(sq[rr], o);
        }
        const f32x4 ga = *(const f32x4*)(gsb + 4 * lane), gb = *(const f32x4*)(gsb + 256 + 4 * lane);
#pragma unroll
        for (int rr = 0; rr < 4; ++rr) { const int q = wave * 4 + rr;
            const float rstd = rsqrtf(sq[rr] * (1.f / 512.f) + EPS);
            const f32x4 ya = ra[rr] * rstd * ga, yb = rb[rr] * rstd * gb;
            u32x2 wa, wb; wa.x = pk2(ya.x, ya.y); wa.y = pk2(ya.z, ya.w); wb.x = pk2(yb.x, yb.y); wb.y = pk2(yb.z, yb.w);
            *(u32x2*)(Ob + (size_t)(qrow0 + q) * DM + 4 * lane) = wa; *(u32x2*)(Ob + (size_t)(qrow0 + q) * DM + 256 + 4 * lane) = wb; }
    }
    __syncthreads();
}

__device__ __forceinline__ void ret_unit(const Params& P, int l, LAS unsigned char* lds, int tid, int lane, int wave,
                                         int row0, int pos0, int nchunks, int L, int h, const float* init, float* outst, bool state_only) {
    const bf16_t* QKV = (const bf16_t*)(P.ws + WS_QKV); bf16_t* Ob = (bf16_t*)(P.ws + WS_O);
    const f32x2* ROPE = (const f32x2*)(P.ws + WS_ROPE);
    const float lg2 = log2f(1.f - exp2f(-5.f - (float)h));
    LAS unsigned char *Qn = lds, *Kn = lds + 17408, *KdT = lds + 34816, *VT = lds + 53248, *SbT = lds + 71680, *Pm = lds + 106496;
    LAS float* of = (LAS float*)lds;
    const int l32 = lane & 31, hf = lane >> 5;
    const int sdt = wave >> 1, set0 = (wave & 1) * 2;
    f32x16 S0, S1;
#pragma unroll
    for (int r = 0; r < 16; ++r) { S0[r] = 0.f; S1[r] = 0.f; }
    if (init) {
        const float* ip = init + (sdt * 32 + hf * 4) * 128 + set0 * 32 + l32;
#pragma unroll
        for (int r = 0; r < 16; ++r) { S0[r] = ip[((r >> 2) * 8 + (r & 3)) * 128]; S1[r] = ip[((r >> 2) * 8 + (r & 3)) * 128 + 32]; if ((r & 3) == 3) asm volatile("" ::: "memory"); }
    }
    if (!state_only) {
#pragma unroll
        for (int g = 0; g < 4; ++g) { const int d0 = sdt * 32 + g * 8 + hf * 4;
            u32x2 a, b; a.x = pk2(S0[4 * g], S0[4 * g + 1]); a.y = pk2(S0[4 * g + 2], S0[4 * g + 3]); b.x = pk2(S1[4 * g], S1[4 * g + 1]); b.y = pk2(S1[4 * g + 2], S1[4 * g + 3]);
            *(LAS u32x2*)(SbT + (set0 * 32 + l32) * 272 + d0 * 2) = a; *(LAS u32x2*)(SbT + ((set0 + 1) * 32 + l32) * 272 + d0 * 2) = b; }
    }
    const float gL = exp2f((float)L * lg2);
    const int lt = wave >> 2, et = wave & 3;
    bf16x8 rk1, rk2, rq1, rq2, rv0, rv1; f32x4 rcs[4];
    const bf16x8 z8 = {0, 0, 0, 0, 0, 0, 0, 0};
    auto issue = [&](int c) {
        const int t = tid >> 3, i0 = (tid & 7) * 8; const bool ok = t < L;
        const size_t row = (size_t)(row0 + c * 64 + t);
        rk1 = z8; rk2 = z8; rq1 = z8; rq2 = z8;
#pragma unroll
        for (int i = 0; i < 4; ++i) rcs[i] = (f32x4){0.f, 0.f, 0.f, 0.f};
        if (ok) {
            rk1 = *(const bf16x8*)(QKV + row * INW + 2048 + h * 128 + i0); rk2 = *(const bf16x8*)(QKV + row * INW + 2048 + h * 128 + 64 + i0);
            if (!state_only) { rq1 = *(const bf16x8*)(QKV + row * INW + 1536 + h * 128 + i0); rq2 = *(const bf16x8*)(QKV + row * INW + 1536 + h * 128 + 64 + i0); }
            const f32x4* rp = (const f32x4*)(ROPE + (size_t)(pos0 + c * 64 + t) * 64 + i0);
#pragma unroll
            for (int i = 0; i < 4; ++i) rcs[i] = rp[i];
        }
        const int t0 = tid >> 4, ch = tid & 15;
        rv0 = z8; rv1 = z8;
        if (t0 < L) rv0 = *(const bf16x8*)(QKV + (size_t)(row0 + c * 64 + t0) * INW + 2560 + h * 128 + ch * 8);
        if (t0 + 32 < L) rv1 = *(const bf16x8*)(QKV + (size_t)(row0 + c * 64 + t0 + 32) * INW + 2560 + h * 128 + ch * 8);
    };
    issue(0);
    const int l32_0 = l32, hf_0 = hf, tid_0 = tid; const float lg2_0 = lg2;
#pragma unroll 1
    for (int c = 0; c < nchunks; ++c) {
        int l32 = l32_0, hf = hf_0, tid = tid_0; float lg2 = lg2_0;
        asm volatile("" : "+v"(l32), "+v"(hf), "+v"(tid), "+v"(lg2));
        {
            const int t = tid >> 3, pc = tid & 7, i0 = pc * 8; const bool ok = t < L;
            const float kd = ok ? __builtin_amdgcn_exp2f((float)(L - 1 - t) * lg2) : 0.f;
            const int tsw = (((t >> 3) ^ pc) << 4) + (t & 7) * 2;
            float cs_c[8], cs_s[8];
#pragma unroll
            for (int i = 0; i < 4; ++i) { cs_c[2 * i] = rcs[i].x; cs_s[2 * i] = rcs[i].y; cs_c[2 * i + 1] = rcs[i].z; cs_s[2 * i + 1] = rcs[i].w; }
            {
                float o1[8], o2[8];
#pragma unroll
                for (int i = 0; i < 8; ++i) { const float x1 = bf2f((unsigned short)rk1[i]), x2 = bf2f((unsigned short)rk2[i]);
                    o1[i] = (x1 * cs_c[i] - x2 * cs_s[i]) * 0.08838834764831845f; o2[i] = (x1 * cs_s[i] + x2 * cs_c[i]) * 0.08838834764831845f; }
                if (!state_only) {
                    u32x4 a, b; a.x = pk2(o1[0], o1[1]); a.y = pk2(o1[2], o1[3]); a.z = pk2(o1[4], o1[5]); a.w = pk2(o1[6], o1[7]);
                    b.x = pk2(o2[0], o2[1]); b.y = pk2(o2[2], o2[3]); b.z = pk2(o2[4], o2[5]); b.w = pk2(o2[6], o2[7]);
                    *(LAS u32x4*)(Kn + t * 272 + i0 * 2) = a; *(LAS u32x4*)(Kn + t * 272 + (64 + i0) * 2) = b;
                }
#pragma unroll
                for (int i = 0; i < 8; ++i) { *(LAS unsigned short*)(KdT + (i0 + i) * 144 + tsw) = (unsigned short)f2bf(o1[i] * kd); *(LAS unsigned short*)(KdT + (64 + i0 + i) * 144 + tsw) = (unsigned short)f2bf(o2[i] * kd); }
            }
            if (!state_only) {
                float o1[8], o2[8];
#pragma unroll
                for (int i = 0; i < 8; ++i) { const float x1 = bf2f((unsigned short)rq1[i]), x2 = bf2f((unsigned short)rq2[i]);
                    o1[i] = x1 * cs_c[i] - x2 * cs_s[i]; o2[i] = x1 * cs_s[i] + x2 * cs_c[i]; }
                u32x4 a, b; a.x = pk2(o1[0], o1[1]); a.y = pk2(o1[2], o1[3]); a.z = pk2(o1[4], o1[5]); a.w = pk2(o1[6], o1[7]);
                b.x = pk2(o2[0], o2[1]); b.y = pk2(o2[2], o2[3]); b.z = pk2(o2[4], o2[5]); b.w = pk2(o2[6], o2[7]);
                *(LAS u32x4*)(Qn + t * 272 + i0 * 2) = a; *(LAS u32x4*)(Qn + t * 272 + (64 + i0) * 2) = b;
            }
            {
                const int t0 = tid >> 4, ch = tid & 15, sw = ch & 7;
                const int o0 = (((t0 >> 3) ^ sw) << 4) + (t0 & 7) * 2, o1b = ((((t0 + 32) >> 3) ^ sw) << 4) + (t0 & 7) * 2;
#pragma unroll
                for (int i = 0; i < 8; ++i) { *(LAS short*)(VT + (ch * 8 + i) * 144 + o0) = rv0[i]; *(LAS short*)(VT + (ch * 8 + i) * 144 + o1b) = rv1[i]; }
            }
        }
        if (c + 1 < nchunks) issue(c + 1);
        unsigned gpre[8];
#pragma unroll
        for (int rr = 0; rr < 8; ++rr) { const int t = wave * 8 + rr; gpre[rr] = (!state_only && t < L) ? *(const unsigned*)(QKV + (size_t)(row0 + c * 64 + t) * INW + 3072 + h * 128 + lane * 2) : 0u; }
        __syncthreads();
        f32x16 acc;
        if (!state_only) {
#pragma unroll
            for (int r = 0; r < 16; ++r) acc[r] = 0.f;
#pragma unroll
            for (int ks = 0; ks < 8; ++ks) { const bf16x8 a = *(const LAS bf16x8*)(Qn + (lt * 32 + l32) * 272 + (ks * 16 + hf * 8) * 2), b = *(const LAS bf16x8*)(SbT + (et * 32 + l32) * 272 + (ks * 16 + hf * 8) * 2); acc = MFMA32(a, b, acc); }
#pragma unroll
            for (int r = 0; r < 16; ++r) { const int tl = lt * 32 + (r >> 2) * 8 + hf * 4 + (r & 3); acc[r] *= __builtin_amdgcn_exp2f((float)(tl + 1) * lg2); }
            if (wave < 4) {
                const int slt = wave >> 1, smt = wave & 1;
                f32x16 sc;
#pragma unroll
                for (int r = 0; r < 16; ++r) sc[r] = 0.f;
                if (slt >= smt) {
#pragma unroll
                    for (int ks = 0; ks < 8; ++ks) { const bf16x8 a = *(const LAS bf16x8*)(Qn + (slt * 32 + l32) * 272 + (ks * 16 + hf * 8) * 2), b = *(const LAS bf16x8*)(Kn + (smt * 32 + l32) * 272 + (ks * 16 + hf * 8) * 2); sc = MFMA32(a, b, sc); }
                }
                const int tm = smt * 32 + l32;
#pragma unroll
                for (int r = 0; r < 16; ++r) { const int tl = slt * 32 + (r >> 2) * 8 + hf * 4 + (r & 3);
                    const float p = tl >= tm ? sc[r] * __builtin_amdgcn_exp2f((float)(tl - tm) * lg2) : 0.f;
                    *(LAS unsigned short*)(Pm + tl * 144 + tm * 2) = (unsigned short)f2bf(p); }
            }
            __syncthreads();
#pragma unroll
            for (int ms = 0; ms < 4; ++ms) { const bf16x8 a = *(const LAS bf16x8*)(Pm + (lt * 32 + l32) * 144 + (ms * 16 + hf * 8) * 2), b = *(const LAS bf16x8*)(VT + (et * 32 + l32) * 144 + (((ms * 2 + hf) ^ ((et * 4 + (l32 >> 3)) & 7)) << 4)); acc = MFMA32(a, b, acc); }
#pragma unroll
            for (int r = 0; r < 16; ++r) { const int tl = lt * 32 + (r >> 2) * 8 + hf * 4 + (r & 3); of[tl * 132 + et * 32 + l32] = acc[r]; }
        }
#pragma unroll
        for (int r = 0; r < 16; ++r) { S0[r] *= gL; S1[r] *= gL; }
#pragma unroll
        for (int ts = 0; ts < 4; ++ts) {
            const int cc = ts * 2 + hf, rs = l32 >> 3;
            const bf16x8 a = *(const LAS bf16x8*)(KdT + (sdt * 32 + l32) * 144 + ((cc ^ ((sdt * 4 + rs) & 7)) << 4));
            const bf16x8 b0 = *(const LAS bf16x8*)(VT + (set0 * 32 + l32) * 144 + ((cc ^ ((set0 * 4 + rs) & 7)) << 4)), b1 = *(const LAS bf16x8*)(VT + ((set0 + 1) * 32 + l32) * 144 + ((cc ^ (((set0 + 1) * 4 + rs) & 7)) << 4));
            S0 = MFMA32(a, b0, S0); S1 = MFMA32(a, b1, S1);
        }
        if (!state_only) {
#pragma unroll
            for (int g = 0; g < 4; ++g) { const int d0 = sdt * 32 + g * 8 + hf * 4;
                u32x2 a, b; a.x = pk2(S0[4 * g], S0[4 * g + 1]); a.y = pk2(S0[4 * g + 2], S0[4 * g + 3]); b.x = pk2(S1[4 * g], S1[4 * g + 1]); b.y = pk2(S1[4 * g + 2], S1[4 * g + 3]);
                *(LAS u32x2*)(SbT + (set0 * 32 + l32) * 272 + d0 * 2) = a; *(LAS u32x2*)(SbT + ((set0 + 1) * 32 + l32) * 272 + d0 * 2) = b; }
            __syncthreads();
            const f32x2 gr = *(const f32x2*)(P.in[13] + (size_t)(l * 4 + h) * 128 + lane * 2);
            f32x2 ov[8]; float sq[8];
#pragma unroll
            for (int rr = 0; rr < 8; ++rr) { ov[rr] = *(const LAS f32x2*)(of + (wave * 8 + rr) * 132 + lane * 2); sq[rr] = ov[rr].x * ov[rr].x + ov[rr].y * ov[rr].y; }
#pragma unroll
            for (int o = 1; o < 64; o <<= 1) {
#pragma unroll
                for (int rr = 0; rr < 8; ++rr) sq[rr] += __shfl_xor(sq[rr], o);
            }
#pragma unroll
            for (int rr = 0; rr < 8; ++rr) {
                const int t = wave * 8 + rr;
                if (t < L) {
                    const float rstd = rsqrtf(sq[rr] * (1.f / 128.f) + EPS);
                    const size_t row = (size_t)(row0 + c * 64 + t);
                    const unsigned gg = gpre[rr];
                    const float y0 = ov[rr].x * rstd * gr.x * silu_f(bf2f(gg & 0xffffu)), y1 = ov[rr].y * rstd * gr.y * silu_f(bf2f(gg >> 16));
                    *(unsigned*)(Ob + row * DM + 512 + h * 128 + lane * 2) = pk2(y0, y1);
                }
            }
        }
        __syncthreads();
    }
    if (outst) {
        float* op = outst + (sdt * 32 + hf * 4) * 128 + set0 * 32 + l32;
#pragma unroll
        for (int r = 0; r < 16; ++r) { op[((r >> 2) * 8 + (r & 3)) * 128] = S0[r]; op[((r >> 2) * 8 + (r & 3)) * 128 + 32] = S1[r]; if ((r & 3) == 3) asm volatile("" ::: "memory"); }
    }
}


#define XB_TMO      128
#define XB_XCNT(j)  (256  + 64 * (j))
#define XB_XSUB(j)  (1280 + 64 * (j))
#define XB_XGEN(j)  (2304 + 64 * (j))
#define XB_TOP      3328
#define XB_TOPGEN   3392
#define XCD_BAR_WORDS 3456
#define XB_SPIN_CAP (1u << 18)

__device__ __forceinline__ unsigned xb_ld(unsigned* p)              { return __hip_atomic_load(p, __ATOMIC_RELAXED, __HIP_MEMORY_SCOPE_AGENT); }
__device__ __forceinline__ unsigned xb_add(unsigned* p, unsigned v) { return __hip_atomic_fetch_add(p, v, __ATOMIC_RELAXED, __HIP_MEMORY_SCOPE_AGENT); }
__device__ __forceinline__ unsigned xb_xcc_id() { return (unsigned)__builtin_amdgcn_s_getreg((3 << 11) | 20) & 0xFu; }
#define XB_SPIN(cond, bar) do { unsigned _sp = 0; while (cond) { __builtin_amdgcn_s_sleep(1); \
    if ((++_sp & 255u) == 0u) { if (xb_ld(&(bar)[XB_TMO])) break; if (_sp > XB_SPIN_CAP) { atomicAdd(&(bar)[XB_TMO], 1u); break; } } } } while (0)

struct XcdBarrier {
    unsigned* bar; unsigned x;
    volatile LAS unsigned* st;
};

__device__ __forceinline__ XcdBarrier xcd_barrier_post(unsigned* bar, volatile LAS unsigned* st) {
    XcdBarrier b; b.bar = bar; b.x = xb_xcc_id(); b.st = st;
    if (threadIdx.x == 0) (void)xb_add(&bar[XB_XCNT(b.x)], 1u);
    return b;
}
__device__ __forceinline__ void xcd_barrier_complete(unsigned* bar, unsigned x, unsigned& nloc, unsigned& nx) {
    const unsigned G = gridDim.x * gridDim.y * gridDim.z;
    unsigned sum, cnt, mine, sp = 0u;
    for (;;) {
        sum = 0u; cnt = 0u; mine = 0u;
#pragma unroll
        for (unsigned j = 0; j < 16; ++j) { const unsigned c = xb_ld(&bar[XB_XCNT(j)]); sum += c; cnt += (c > 0u) ? 1u : 0u; mine = (j == x) ? c : mine; }
        if (sum == G) break;
        __builtin_amdgcn_s_sleep(1);
        if ((++sp & 255u) == 0u) { if (xb_ld(&bar[XB_TMO])) break; if (sp > XB_SPIN_CAP) { atomicAdd(&bar[XB_TMO], 1u); break; } }
    }
    nloc = mine > 0u ? mine : 1u; nx = cnt > 0u ? cnt : 1u;
}

__device__ __forceinline__ void xcd_barrier(const XcdBarrier& b) {
    asm volatile("s_waitcnt vmcnt(0)" ::: "memory");
    __syncthreads();
    if (threadIdx.x == 0) {
        unsigned* bar = b.bar;
        __builtin_amdgcn_s_waitcnt(0);
        unsigned nloc = b.st[0], nx = b.st[1];
        if (nloc == 0u) { xcd_barrier_complete(bar, b.x, nloc, nx); b.st[0] = nloc; b.st[1] = nx; }
        const unsigned old = xb_add(&bar[XB_XSUB(b.x)], 1u);
        const unsigned gen = old / nloc;
        if (old + 1u == (gen + 1u) * nloc) {
            __builtin_amdgcn_fence(__ATOMIC_RELEASE, "agent");
            asm volatile("s_waitcnt vmcnt(0)" ::: "memory");
            const unsigned og = xb_add(&bar[XB_TOP], 1u);
            const unsigned tg = og / nx;
            if (og + 1u == (tg + 1u) * nx) xb_add(&bar[XB_TOPGEN], 1u);
            else XB_SPIN(xb_ld(&bar[XB_TOPGEN]) == tg, bar);
            __builtin_amdgcn_fence(__ATOMIC_ACQUIRE, "agent");
            xb_add(&bar[XB_XGEN(b.x)], 1u);
            asm volatile("s_waitcnt vmcnt(0)" ::: "memory");
        } else {
            XB_SPIN(xb_ld(&bar[XB_XGEN(b.x)]) == gen, bar);
            __builtin_amdgcn_fence(__ATOMIC_ACQUIRE, "agent");
            asm volatile("s_waitcnt vmcnt(0)" ::: "memory");
        }
    }
    __syncthreads();
}
__global__ void __launch_bounds__(512, 2) fwd_megakernel(Params P) {
    extern __shared__ __attribute__((aligned(16))) unsigned char lds_raw[];
    LAS unsigned char* lds = (LAS unsigned char*)lds_raw;
    cg::grid_group grid = cg::this_grid();
    int tid = threadIdx.x, lane = tid & 63, wave = __builtin_amdgcn_readfirstlane(tid >> 6);
#define REFRESH() do { tid = threadIdx.x; asm volatile("" : "+v"(tid)); lane = tid & 63; wave = __builtin_amdgcn_readfirstlane(tid >> 6); } while (0)
    const int G = gridDim.x, bx = blockIdx.x;
    bf16_t* H = (bf16_t*)(P.ws + WS_H); bf16_t* Ob = (bf16_t*)(P.ws + WS_O); bf16_t* QKV = (bf16_t*)(P.ws + WS_QKV); bf16_t* ACT = QKV;
    bf16_t* X = (bf16_t*)(P.ws + WS_X); float* U = (float*)(P.ws + WS_U);
    const float* MOD = (const float*)(P.ws + WS_MOD);

    volatile LAS unsigned* bst = (volatile LAS unsigned*)(lds + LDS_BYTES - 64);
    if (tid == 0) { bst[0] = 0u; bst[1] = 0u; }
    __syncthreads();
    const XcdBarrier xbar = xcd_barrier_post((unsigned*)(P.ws + WS_BAR), bst);
#ifndef SK_P0
    p0_phase(P, lds, tid, lane, wave);
#endif
    xcd_barrier(xbar); REFRESH();
    {
        const f32x4* part = (const f32x4*)(P.ws + WS_PART); f32x4* mod4 = (f32x4*)(P.ws + WS_MOD);
        constexpr int NV = DEPTH * NBI * NMOD / 4;
        for (int i = bx * 512 + tid; i < NV; i += G * 512) {
            f32x4 a = part[i];
#pragma unroll
            for (int kc = 1; kc < 8; ++kc) a += part[(size_t)kc * NV + i];
            mod4[i] = a;
        }
    }
    if (P.ws == nullptr) grid.sync();
    xcd_barrier(xbar); REFRESH();
#pragma unroll 1
    for (int l = 0; l < DEPTH; ++l) {
        norm_phase<false>(P, l, l == 0, P.in[7] + (size_t)l * DM, 0, 1024, lane, wave);
        xcd_barrier(xbar); REFRESH();
#ifndef SK_G1
        {
            pg8::Gemm g{H, (const bf16_t*)(P.ws + WS_WIN) + (size_t)l * INW * DM, MP, INW, DM}; pg8::StaticOrder S; S.init(MP, INW, G, bx);
            EpiQKV E{QKV, P.out, l};
            pg8::gemm_phase<EpiQKV, pg8::StaticOrder, true, true>(lds, g, S, E);
            SEpiQKV SE{QKV, P.out, l};
            sgemm_phase<8, 8, SEpiQKV>(lds, H + (size_t)MP * DM, DM, g.Bt, DM, INW / 64, tid, lane, wave, SE);
        }
#endif
        xcd_barrier(xbar); REFRESH();
        {
            unsigned* qhead = (unsigned*)(P.ws + WS_CTR) + l * 64;
            volatile LAS unsigned* qslot = (volatile LAS unsigned*)(lds + LDS_BYTES - 128);
            for (;;) {
                if (tid == 0) *qslot = __hip_atomic_fetch_add(qhead, 1u, __ATOMIC_RELAXED, __HIP_MEMORY_SCOPE_AGENT);
                __syncthreads();
                const int u = (int)*qslot;
                __syncthreads();
                if (u >= 1360) break;
                if (u < 256) { const int bh = u >> 5, seg = u & 31, b = bh >> 2, h = bh & 3;
                    ret_unit(P, l, lds, tid, lane, wave, b * SEQ + seg * 512, seg * 512, 8, 64, h, nullptr, U + (size_t)(bh * 32 + seg) * 16384, true); }
                else if (u < 272) sb_unit(P, l, 1024 + (u - 256), lds, tid, lane, wave);
                else if (u < 1296) { const int v = u - 272; sb_unit(P, l, (v & 1) * 512 + (511 - (v >> 1)), lds, tid, lane, wave); }
                else { const int idx = u - 1296, bs = idx >> 2, h = idx & 3; const size_t so = ((size_t)(l * DB + bs) * 4 + h) * 16384;
                    ret_unit(P, l, lds, tid, lane, wave, MP + bs * 32, PAST, 1, 32, h, P.in[4] + so, P.out + OFF_RS + so, false); }
            }
        }
        xcd_barrier(xbar); REFRESH();
        for (int idx = bx * 512 + tid; idx < 8 * 16384; idx += G * 512) {
            const int bh = idx >> 14, within = idx & 16383, h = bh & 3;
            const float g512 = exp2f(512.f * log2f(1.f - exp2f(-5.f - (float)h)));
            float* up = U + (size_t)bh * 32 * 16384 + within; float s = 0.f;
            float uv[32];
#pragma unroll
            for (int seg = 0; seg < 32; ++seg) uv[seg] = up[(size_t)seg * 16384];
#pragma unroll
            for (int seg = 0; seg < 32; ++seg) { up[(size_t)seg * 16384] = s; s = g512 * s + uv[seg]; }
            P.out[OFF_RP + ((size_t)l * 8 + bh) * 16384 + within] = s;
        }
        xcd_barrier(xbar); REFRESH();
#ifndef SK_R3
        for (int u = bx; u < 256; u += G) { const int bh = u >> 5, seg = u & 31, b = bh >> 2, h = bh & 3;
            ret_unit(P, l, lds, tid, lane, wave, b * SEQ + seg * 512, seg * 512, 8, 64, h, U + (size_t)(bh * 32 + seg) * 16384, nullptr, false); }
#endif
        xcd_barrier(xbar); REFRESH();
#ifndef SK_G2
        {
            pg8::Gemm g{Ob, (const bf16_t*)(P.ws + WS_WOUT) + (size_t)l * DM * DM, MP, DM, DM}; pg8::StaticOrder S; S.init(MP, DM, G, bx);
            EpiResid E{l == 0 ? P.in[0] : nullptr, l == 0 ? P.in[1] : nullptr, X, MOD + (size_t)l * NBI * NMOD + 2048};
            pg8::gemm_phase<EpiResid, pg8::StaticOrder, true, true>(lds, g, S, E);
            SEpiResid SE{l == 0 ? P.in[1] : nullptr, X + (size_t)MP * DM, MOD + (size_t)l * NBI * NMOD + 2048};
            sgemm_phase<8, 8, SEpiResid>(lds, Ob + (size_t)MP * DM, DM, g.Bt, DM, DM / 64, tid, lane, wave, SE);
        }
#endif
        xcd_barrier(xbar); REFRESH();
        norm_phase<false>(P, l, false, P.in[8] + (size_t)l * DM, 3072, 4096, lane, wave);
        xcd_barrier(xbar); REFRESH();
#ifndef SK_G3
        {
            pg8::Gemm g{H, (const bf16_t*)(P.ws + WS_WFI) + (size_t)l * 2 * DFF * DM, MP, 2 * DFF, DM}; pg8::StaticOrder S; S.init(MP, 2 * DFF, G, bx);
            EpiSwiGLU E{ACT};
            pg8::gemm_phase<EpiSwiGLU, pg8::StaticOrder, true, true>(lds, g, S, E);
            SEpiSwiGLU SE{ACT};
            sgemm_phase<8, 8, SEpiSwiGLU>(lds, H + (size_t)MP * DM, DM, g.Bt, DM, (2 * DFF / 256) * 4, tid, lane, wave, SE);
        }
#endif
        xcd_barrier(xbar); REFRESH();
#ifndef SK_G4
        {
            pg8::Gemm g{ACT, (const bf16_t*)(P.ws + WS_WFO) + (size_t)l * DM * DFF, MP, DM, DFF}; pg8::StaticOrder S; S.init(MP, DM, G, bx);
            EpiResid E{nullptr, nullptr, X, MOD + (size_t)l * NBI * NMOD + 5120};
            pg8::gemm_phase<EpiResid, pg8::StaticOrder, true, true>(lds, g, S, E);
            SEpiResid SE{nullptr, X + (size_t)MP * DM, MOD + (size_t)l * NBI * NMOD + 5120};
            sgemm_phase<22, 11, SEpiResid>(lds, ACT + (size_t)MP * DFF, DFF, g.Bt, DFF, DM / 64, tid, lane, wave, SE);
        }
#endif
        xcd_barrier(xbar); REFRESH();
    }
    norm_phase<true>(P, 0, false, P.in[17], 0, 0, lane, wave);
}

extern "C" void kernel_launch(void* const* d_in, const int* in_sizes, int n_in, void* d_out, int out_size, void* d_ws, size_t ws_size, hipStream_t stream) {
    static int grid = 0;
    if (grid == 0) {
        if (n_in != 18 || ws_size < WS_END) { fprintf(stderr, "kernel_launch: unexpected n_in %d / ws_size %zu\n", n_in, ws_size); grid = -1; return; }
        int dev = 0, cus = 0, per_cu = 0;
        (void)hipGetDevice(&dev); (void)hipDeviceGetAttribute(&cus, hipDeviceAttributeMultiprocessorCount, dev);
        if (hipFuncSetAttribute((const void*)fwd_megakernel, hipFuncAttributeMaxDynamicSharedMemorySize, LDS_BYTES) != hipSuccess) { fprintf(stderr, "kernel_launch: hipFuncSetAttribute failed\n"); grid = -1; return; }
        (void)hipOccupancyMaxActiveBlocksPerMultiprocessor(&per_cu, (const void*)fwd_megakernel, 512, LDS_BYTES);
        (void)hipGetLastError();
        if (per_cu < 1) { fprintf(stderr, "kernel_launch: occupancy query says %d blocks per CU\n", per_cu); per_cu = 1; }
        grid = cus;
    }
    if (grid < 0) return;
    (void)hipMemsetAsync((char*)d_ws + WS_BAR, 0, 20480, stream);
    Params p{};
    for (int i = 0; i < 18; ++i) p.in[i] = (const float*)d_in[i];
    p.out = (float*)d_out; p.ws = (unsigned char*)d_ws;
    void* args[] = {&p};
    hipError_t e = hipLaunchCooperativeKernel((const void*)fwd_megakernel, dim3(grid), dim3(512), args, LDS_BYTES, stream);
    if (e != hipSuccess) fprintf(stderr, "cooperative launch failed: %s (grid %d)\n", hipGetErrorString(e), grid);
}
```

```cpp
#include <hip/hip_runtime.h>
#include <hip/hip_cooperative_groups.h>
#include <cstdio>
#include <cstdint>
namespace cg = cooperative_groups;
namespace pg8 {
#define PG8_LAS __attribute__((address_space(3)))
typedef unsigned short bf16_t;
typedef short bf16x8 __attribute__((ext_vector_type(8)));
typedef float f32x4 __attribute__((ext_vector_type(4)));
typedef unsigned u32x4 __attribute__((ext_vector_type(4)));
constexpr int BM = 256, BK = 64, HALF = 128, HTB = HALF * BK * 2  , STAGE_BYTES = 8 * HTB, NXCD = 8, WGM = 8;

__host__ __device__ __forceinline__ int lds_byte(int r, int c) { const int st = (r >> 4) * 2 + (c >> 5), rr = r & 15, cc = c & 31, ob = rr * 64 + cc * 2; return st * 1024 + (ob ^ (((ob >> 9) & 1) << 5)); }
__host__ __device__ __forceinline__ void stage_rc(int b, int& R, int& C) { const int st = b / 1024, sb = b % 1024, swz = sb ^ (((sb >> 9) & 1) << 5); R = (st >> 1) * 16 + swz / 64; C = (st & 1) * 32 + (swz % 64) / 2; }
__host__ __device__ __forceinline__ int perm32(int rho) { const int n = rho >> 4, i = rho & 15; return 8 * (i >> 2) + 4 * n + (i & 3); }

struct Unit { int pm, pn; };
struct Gemm { const bf16_t* A; const bf16_t* Bt; int M, N, K; };

struct StaticOrder {
    int nM, nN, nwg, G, c;
    __host__ __device__ void init(int M, int N, int G_, int c_) { nM = M / BM; nN = N / BM; nwg = nM * nN; G = G_; c = c_; }
    __host__ __device__ bool next(int i, Unit& u) const {
        const long L = (long)i * G + c; if (L >= nwg) return false;
        int wgid = (int)L; { const int q = nwg / NXCD, r = nwg % NXCD, xcd = wgid % NXCD, off = wgid / NXCD; wgid = (xcd < r ? xcd * (q + 1) : r * (q + 1) + (xcd - r) * q) + off; }
        const int nig = WGM * nN, gid = wgid / nig, fm = gid * WGM, gsz = (nM - fm) < WGM ? (nM - fm) : WGM;
        u.pm = fm + ((wgid % nig) % gsz); u.pn = (wgid % nig) / gsz; return true;
    }
    __device__ __forceinline__ void a_ready(const Unit&) const {}
    __device__ __forceinline__ void done(const Unit&) const {}
};

__device__ __forceinline__ unsigned cvt_pk_bf16(float lo, float hi) { unsigned r; asm volatile("v_cvt_pk_bf16_f32 %0, %1, %2" : "=v"(r) : "v"(lo), "v"(hi)); return r; }
typedef float f32x2 __attribute__((ext_vector_type(2)));
__device__ __forceinline__ f32x2 gelu_pk(f32x2 v) {
    const f32x2 av = __builtin_elementwise_abs(v), d = av * 0.2316418882f + 1.0f;
    f32x2 t; t.x = __builtin_amdgcn_rcpf(d.x); t.y = __builtin_amdgcn_rcpf(d.y);
    f32x2 q = t * 0.5307027145f + (-0.7265760135f); q = q * t + 0.7107068705f; q = q * t + (-0.142248368f); q = q * t + 0.127414796f; q = q * t;
    const f32x2 s = (v * v) * (-0.72134752044f);
    f32x2 e; e.x = __builtin_amdgcn_exp2f(s.x); e.y = __builtin_amdgcn_exp2f(s.y);
    const f32x2 m = v * (q * e), r = v - m;
    f32x2 o; o.x = v.x < 0.f ? m.x : r.x; o.y = v.y < 0.f ? m.y : r.y; return o;
}

template <int ACT  > struct EpiBf16 {
    static constexpr bool PERM = true, AFTER_DRAIN = false; static_assert(ACT == 0 || ACT == 1, "EpiBf16: ACT is 0 (none) or 1 (gelu_pk)");
    bf16_t* O; int ldc; const float* bias; int split_cols; size_t split_stride; float scale0;
    __device__ __forceinline__ void operator()(const f32x4 (&acc)[2][2][4][2], const Unit& u, int wr, int wc, int fr, int fq) const {
        const int row0 = u.pm * BM + wr * 64 + fr; int colt = u.pn * BM; bf16_t* base = O;
        float sc = 1.f; if (split_cols) { const int t = colt / split_cols; base += (size_t)t * split_stride; colt -= t * split_cols; if (t == 0) sc = scale0; }
        const int col0 = colt + wc * 32 + 8 * fq, bcol0 = u.pn * BM + wc * 32 + 8 * fq;
        f32x4 bv[2][2];
#pragma unroll
        for (int bj = 0; bj < 2; ++bj)
#pragma unroll
            for (int n = 0; n < 2; ++n) bv[bj][n] = bias ? *(const f32x4*)(bias + bcol0 + bj * HALF + 4 * n) : (f32x4){0.f, 0.f, 0.f, 0.f};
#pragma unroll
        for (int ai = 0; ai < 2; ++ai)
#pragma unroll
            for (int m = 0; m < 4; ++m) { bf16_t* rowp = base + (size_t)(row0 + ai * HALF + m * 16) * ldc + col0;
#pragma unroll
                for (int bj = 0; bj < 2; ++bj) { f32x4 v0 = acc[ai][bj][m][0] + bv[bj][0], v1 = acc[ai][bj][m][1] + bv[bj][1];
                    if (ACT == 1) { f32x2 a = gelu_pk((f32x2){v0[0], v0[1]}), b = gelu_pk((f32x2){v0[2], v0[3]}), c = gelu_pk((f32x2){v1[0], v1[1]}), d = gelu_pk((f32x2){v1[2], v1[3]});
                        v0 = (f32x4){a.x, a.y, b.x, b.y}; v1 = (f32x4){c.x, c.y, d.x, d.y}; }
                    v0 = v0 * sc; v1 = v1 * sc; u32x4 w; w.x = cvt_pk_bf16(v0[0], v0[1]); w.y = cvt_pk_bf16(v0[2], v0[3]); w.z = cvt_pk_bf16(v1[0], v1[1]); w.w = cvt_pk_bf16(v1[2], v1[3]);
                    *(u32x4*)(rowp + bj * HALF) = w; } }
    }
};
template <class Epi, class Sched, bool ALIGN_EPI = false, bool SP2 = false>
__device__ __forceinline__ void gemm_phase(PG8_LAS unsigned char* lds, const Gemm g, const Sched& S, const Epi& E) {
    int tid_o = threadIdx.x; asm volatile("" : "+v"(tid_o));
    const int tid = tid_o, wid = __builtin_amdgcn_readfirstlane(tid >> 6), lane = tid & 63, wr = wid >> 2, wc = wid & 3, fr = lane & 15, fq = lane >> 4;
    const int K = g.K, nt = K / BK;
    unsigned voffA[2], voffB[2];
#pragma unroll
    for (int i = 0; i < 2; ++i) { int R, C; stage_rc(tid * 16 + i * 8192, R, C); const int Rb = Epi::PERM ? ((R & ~31) + perm32(R & 31)) : R;
        voffA[i] = (unsigned)(R * K + C) * 2u; voffB[i] = (unsigned)(Rb * K + C) * 2u; }
    const size_t kstep = (size_t)(BK * 2);
    const size_t hstep = (size_t)HALF * K * 2;
    const size_t tstep = 2 * hstep;
    const unsigned ldsw = (unsigned)wid * 1024u;
    const int aoff = lds_byte(wr * 64 + fr, fq * 8), boff = lds_byte(wc * 32 + fr, fq * 8);
#define PG8_SA(b, h) (((b) * 2 + (h)) * HTB)
#define PG8_SB(b, h) ((4 + (b) * 2 + (h)) * HTB)
#define PG8_STAGE(bufoff, gbase, voff) do { _Pragma("unroll") for (int _i = 0; _i < 2; ++_i) \
        __builtin_amdgcn_global_load_lds((const unsigned*)((const char*)(gbase) + (voff)[_i]), (PG8_LAS unsigned*)(lds + (bufoff) + ldsw + _i * 8192), 16, 0, 0); } while (0)
#define PG8_LDA(dst, b, h) do { _Pragma("unroll") for (int m = 0; m < 4; ++m) _Pragma("unroll") for (int k = 0; k < 2; ++k) dst[m][k] = *(const PG8_LAS bf16x8*)(lds + PG8_SA(b, h) + aoff + m * 2048 + k * 1024); } while (0)
#define PG8_LDB(dst, b, h) do { _Pragma("unroll") for (int n = 0; n < 2; ++n) _Pragma("unroll") for (int k = 0; k < 2; ++k) dst[n][k] = *(const PG8_LAS bf16x8*)(lds + PG8_SB(b, h) + boff + n * 2048 + k * 1024); } while (0)
#define PG8_MMA(ai, bj, At, Bt) do { __builtin_amdgcn_s_setprio(1); _Pragma("unroll") for (int m = 0; m < 4; ++m) _Pragma("unroll") for (int n = 0; n < 2; ++n) _Pragma("unroll") for (int k = 0; k < 2; ++k) \
        acc[ai][bj][m][n] = __builtin_amdgcn_mfma_f32_16x16x32_bf16(Bt[n][k], At[m][k], acc[ai][bj][m][n], 0, 0, 0); __builtin_amdgcn_s_setprio(0); } while (0)
#define PG8_WAIT_V(n) asm volatile("s_waitcnt vmcnt(" #n ")" ::: "memory")
#define PG8_WAIT_L(n) asm volatile("s_waitcnt lgkmcnt(" #n ")" ::: "memory")
#define PG8_BAR __builtin_amdgcn_s_barrier()
#define PG8_SCHED __builtin_amdgcn_sched_barrier(0)
    Unit cur, nxt; int ui = 0;
    if (!S.next(0, cur)) return;
    f32x4 acc[2][2][4][2];
#pragma unroll
    for (int a = 0; a < 2; ++a)
#pragma unroll
        for (int b = 0; b < 2; ++b)
#pragma unroll
            for (int m = 0; m < 4; ++m)
#pragma unroll
                for (int n = 0; n < 2; ++n) acc[a][b][m][n] = (f32x4){0.f, 0.f, 0.f, 0.f};
    bf16x8 At[4][2], B0[2][2], B1[2][2];
    const char* cA = (const char*)g.A + (size_t)cur.pm * tstep; const char* cB = (const char*)g.Bt + (size_t)cur.pn * tstep;
    S.a_ready(cur);
    if constexpr (SP2) {
        PG8_STAGE(PG8_SB(0, 0), cB, voffB); PG8_STAGE(PG8_SB(0, 1), cB + hstep, voffB); PG8_STAGE(PG8_SA(0, 0), cA, voffA); PG8_STAGE(PG8_SA(0, 1), cA + hstep, voffA);
        if (wr == 1) PG8_BAR;
        PG8_WAIT_V(2); PG8_BAR;
        PG8_STAGE(PG8_SB(1, 0), cB + kstep, voffB); PG8_STAGE(PG8_SA(1, 0), cA + kstep, voffA); PG8_STAGE(PG8_SB(1, 1), cB + hstep + kstep, voffB);
        PG8_WAIT_V(6); PG8_BAR;
    } else {
        PG8_STAGE(PG8_SB(0, 0), cB, voffB); PG8_STAGE(PG8_SA(0, 0), cA, voffA); PG8_STAGE(PG8_SB(0, 1), cB + hstep, voffB); PG8_STAGE(PG8_SA(0, 1), cA + hstep, voffA);
        if (wr == 1) PG8_BAR;
        PG8_WAIT_V(4); PG8_BAR;
        PG8_STAGE(PG8_SB(1, 0), cB + kstep, voffB); PG8_STAGE(PG8_SA(1, 0), cA + kstep, voffA); PG8_STAGE(PG8_SB(1, 1), cB + hstep + kstep, voffB);
        PG8_WAIT_V(6); PG8_BAR;
    }
    for (;;) {
        const bool has_next = S.next(ui + 1, nxt);
        const char* nA = has_next ? (const char*)g.A + (size_t)nxt.pm * tstep : cA; const char* nB = has_next ? (const char*)g.Bt + (size_t)nxt.pn * tstep : cB;
        for (int t = 0; t < nt; t += 2) {
            const bool last = (t == nt - 2);
            const char* a1 = cA + (size_t)(t + 1) * kstep;
            const char* a2 = last ? nA : cA + (size_t)(t + 2) * kstep; const char* b2 = last ? nB : cB + (size_t)(t + 2) * kstep;
            const char* a3 = a2 + kstep; const char* b3 = b2 + kstep;
            if (last && has_next) S.a_ready(nxt);
            if constexpr (SP2) {
            PG8_LDB(B0, 0, 0); PG8_LDB(B1, 0, 1); PG8_SCHED; PG8_LDA(At, 0, 0); PG8_STAGE(PG8_SA(1, 1), a1 + hstep, voffA);
            PG8_WAIT_V(8); PG8_WAIT_L(0); PG8_BAR; PG8_MMA(0, 0, At, B0); PG8_MMA(0, 1, At, B1); PG8_BAR; PG8_SCHED;
            PG8_LDA(At, 0, 1); PG8_STAGE(PG8_SB(0, 0), b2, voffB); PG8_STAGE(PG8_SB(0, 1), b2 + hstep, voffB); PG8_STAGE(PG8_SA(0, 0), a2, voffA);
            PG8_WAIT_V(8); PG8_WAIT_L(0); PG8_BAR; PG8_MMA(1, 0, At, B0); PG8_MMA(1, 1, At, B1); PG8_BAR; PG8_SCHED;
            PG8_LDB(B0, 1, 0); PG8_LDB(B1, 1, 1); PG8_SCHED; PG8_LDA(At, 1, 0); PG8_STAGE(PG8_SA(0, 1), a2 + hstep, voffA);
            PG8_WAIT_V(8); PG8_WAIT_L(0); PG8_BAR; PG8_MMA(0, 0, At, B0); PG8_MMA(0, 1, At, B1); PG8_BAR; PG8_SCHED;
            PG8_LDA(At, 1, 1); PG8_STAGE(PG8_SB(1, 0), b3, voffB); PG8_STAGE(PG8_SB(1, 1), b3 + hstep, voffB); PG8_STAGE(PG8_SA(1, 0), a3, voffA);
            PG8_WAIT_V(8); PG8_WAIT_L(0); PG8_BAR; PG8_MMA(1, 0, At, B0); PG8_MMA(1, 1, At, B1); PG8_BAR; PG8_SCHED;
            } else {
            PG8_LDB(B0, 0, 0); PG8_SCHED; PG8_LDA(At, 0, 0); PG8_STAGE(PG8_SA(1, 1), a1 + hstep, voffA);
            PG8_WAIT_L(8); PG8_BAR; PG8_WAIT_L(0); PG8_MMA(0, 0, At, B0); PG8_BAR; PG8_SCHED;
            PG8_LDB(B1, 0, 1); PG8_STAGE(PG8_SB(0, 0), b2, voffB);
            PG8_BAR; PG8_WAIT_L(0); PG8_MMA(0, 1, At, B1); PG8_BAR;
            PG8_LDA(At, 0, 1); PG8_STAGE(PG8_SA(0, 0), a2, voffA);
            PG8_BAR; PG8_WAIT_L(0); PG8_MMA(1, 0, At, B0); PG8_BAR; PG8_SCHED;
            PG8_STAGE(PG8_SB(0, 1), b2 + hstep, voffB);
            PG8_WAIT_V(6); PG8_BAR; PG8_MMA(1, 1, At, B1); PG8_BAR;
            PG8_LDB(B0, 1, 0); PG8_SCHED; PG8_LDA(At, 1, 0); PG8_STAGE(PG8_SA(0, 1), a2 + hstep, voffA);
            PG8_WAIT_L(8); PG8_BAR; PG8_WAIT_L(0); PG8_MMA(0, 0, At, B0); PG8_BAR; PG8_SCHED;
            PG8_LDB(B1, 1, 1); PG8_STAGE(PG8_SB(1, 0), b3, voffB);
            PG8_BAR; PG8_WAIT_L(0); PG8_MMA(0, 1, At, B1); PG8_BAR;
            PG8_LDA(At, 1, 1); PG8_STAGE(PG8_SA(1, 0), a3, voffA);
            PG8_BAR; PG8_WAIT_L(0); PG8_MMA(1, 0, At, B0); PG8_BAR; PG8_SCHED;
            PG8_STAGE(PG8_SB(1, 1), b3 + hstep, voffB);
            PG8_WAIT_V(6); PG8_BAR; PG8_MMA(1, 1, At, B1); PG8_BAR;
            }
        }
        if constexpr (ALIGN_EPI) { if (wr == 0) PG8_BAR; }
        if constexpr (!Epi::AFTER_DRAIN) { E(acc, cur, wr, wc, fr, fq); S.done(cur); }
        if (!has_next) break;
#pragma unroll
        for (int a = 0; a < 2; ++a)
#pragma unroll
            for (int b = 0; b < 2; ++b)
#pragma unroll
                for (int m = 0; m < 4; ++m)
#pragma unroll
                    for (int n = 0; n < 2; ++n) acc[a][b][m][n] = (f32x4){0.f, 0.f, 0.f, 0.f};
        cur = nxt; cA = nA; cB = nB; ++ui;
        if constexpr (ALIGN_EPI) { if (wr == 1) PG8_BAR; }
    }
    PG8_WAIT_V(0);
    if constexpr (!ALIGN_EPI) { if (wr == 0) PG8_BAR; }
    PG8_BAR;
    if constexpr (Epi::AFTER_DRAIN) { E.fused(acc, cur, wr, wc, fr, fq, lds, wid, lane); S.done(cur); }
#undef PG8_SA
#undef PG8_SB
#undef PG8_STAGE
#undef PG8_LDA
#undef PG8_LDB
#undef PG8_MMA
#undef PG8_WAIT_V
#undef PG8_WAIT_L
#undef PG8_BAR
#undef PG8_SCHED
}
}

#define LAS __attribute__((address_space(3)))
typedef unsigned short bf16_t;
typedef short bf16x8 __attribute__((ext_vector_type(8)));
typedef float f32x4 __attribute__((ext_vector_type(4)));
typedef float f32x2 __attribute__((ext_vector_type(2)));
typedef float f32x16 __attribute__((ext_vector_type(16)));
typedef unsigned u32x4 __attribute__((ext_vector_type(4)));
typedef unsigned u32x2 __attribute__((ext_vector_type(2)));
#define MFMA32(a, b, c) __builtin_amdgcn_mfma_f32_32x32x16_bf16((a), (b), (c), 0, 0, 0)

constexpr int DM = 1024, SEQ = 16384, NBP = 2, DEPTH = 4, DB = 16, DS = 32, PAST = 2048;
constexpr int MP = NBP * SEQ, MS = DB * DS, MT = MP + MS;
constexpr int INW = 3584, DFF = 2816, NMOD = 6144, NBI = 18;
constexpr float EPS = 1e-6f;
constexpr size_t OFF_YP = 0, OFF_YS = 33554432, OFF_KP = 34078720, OFF_VP = 101187584, OFF_RP = 168296448,
                 OFF_KS = 168820736, OFF_VS = 169869312, OFF_RS = 170917888;
constexpr size_t MiB = 1u << 20;
constexpr size_t WS_MOD = 0, MOD_BYTES = 2 * MiB; constexpr size_t WS_CTR = 1820160;
constexpr size_t WS_BAR = 1802240;
constexpr size_t WS_ROPE = 2 * MiB;
constexpr size_t WS_WIN = 10 * MiB, WS_WOUT = 38 * MiB, WS_WFI = 46 * MiB, WS_WFO = 90 * MiB;
constexpr size_t WS_X = 112 * MiB;
constexpr size_t WS_H = 242 * MiB;
constexpr size_t WS_O = 307 * MiB;
constexpr size_t WS_QKV = 372 * MiB;
constexpr size_t WS_U = 600 * MiB;
constexpr size_t WS_PART = 616 * MiB;
constexpr size_t WS_END = 632 * MiB;
constexpr int LDS_BYTES = 147456;

struct Params { const float* in[18]; float* out; unsigned char* ws; };

typedef __bf16 bf16x2_t __attribute__((ext_vector_type(2)));
__device__ __forceinline__ unsigned pk2(float lo, float hi) { const f32x2 v = {lo, hi}; return __builtin_bit_cast(unsigned, __builtin_convertvector(v, bf16x2_t)); }
__device__ __forceinline__ unsigned f2bf(float f) { return pk2(f, 0.f) & 0xffffu; }
__device__ __forceinline__ float bf2f(unsigned h) { return __builtin_bit_cast(float, h << 16); }
__device__ __forceinline__ f32x4 ldx4(const bf16_t* p) { const u32x2 w = *(const u32x2*)p;
    return (f32x4){__builtin_bit_cast(float, w.x << 16), __builtin_bit_cast(float, w.x & 0xffff0000u), __builtin_bit_cast(float, w.y << 16), __builtin_bit_cast(float, w.y & 0xffff0000u)}; }
__device__ __forceinline__ bf16x8 pack8(f32x4 a, f32x4 b) { u32x4 p; p.x = pk2(a.x, a.y); p.y = pk2(a.z, a.w); p.z = pk2(b.x, b.y); p.w = pk2(b.z, b.w); return __builtin_bit_cast(bf16x8, p); }
__device__ __forceinline__ float wave_sum(float v) {
#pragma unroll
    for (int o = 1; o < 64; o <<= 1) v += __shfl_xor(v, o);
    return v;
}
__device__ __forceinline__ float silu_f(float x) { return x * __builtin_amdgcn_rcpf(1.f + __expf(-x)); }
__device__ __forceinline__ int batch_of(int row) { return row < MP ? (row >> 14) : 2 + ((row - MP) >> 5); }

struct EpiQKV {
    static constexpr bool PERM = true, AFTER_DRAIN = false;
    bf16_t* QKV; float* out; int layer;
    __device__ __forceinline__ void operator()(const pg8::f32x4 (&acc)[2][2][4][2], const pg8::Unit& u, int wr, int wc, int fr, int fq) const {
        const int row0 = u.pm * 256 + wr * 64 + fr, col0 = u.pn * 256 + wc * 32 + 8 * fq;
        const bool kv = (u.pn >= 2 && u.pn < 6);
        const size_t vsel = (u.pn >= 4) ? 1 : 0;
        const size_t obase = (u.pm < 128) ? OFF_KP + vsel * (OFF_VP - OFF_KP) + (size_t)layer * MP * 512 + (size_t)row0 * 512
                                          : OFF_KS + vsel * (OFF_VS - OFF_KS) + (size_t)layer * MS * 512 + (size_t)(row0 - MP) * 512;
#pragma unroll
        for (int ai = 0; ai < 2; ++ai)
#pragma unroll
            for (int m = 0; m < 4; ++m) {
                const int row = row0 + ai * 128 + m * 16;
#pragma unroll
                for (int bj = 0; bj < 2; ++bj) {
                    const int col = col0 + bj * 128;
                    const pg8::f32x4 v0 = acc[ai][bj][m][0], v1 = acc[ai][bj][m][1];
                    u32x4 w; w.x = pg8::cvt_pk_bf16(v0[0], v0[1]); w.y = pg8::cvt_pk_bf16(v0[2], v0[3]); w.z = pg8::cvt_pk_bf16(v1[0], v1[1]); w.w = pg8::cvt_pk_bf16(v1[2], v1[3]);
                    *(u32x4*)(QKV + (size_t)row * INW + col) = w;
                    if (kv) {
                        const int c = col & 511;
                        float* dst = out + obase + (size_t)(ai * 128 + m * 16) * 512 + c;
                        *(pg8::f32x4*)dst = v0; *(pg8::f32x4*)(dst + 4) = v1;
                    }
                }
                asm volatile("" ::: "memory");
            }
    }
};
struct EpiResid {
    static constexpr bool PERM = false, AFTER_DRAIN = false;
    const float* base_p; const float* base_s;
    bf16_t* X; const float* gate;
    __device__ __forceinline__ void operator()(const pg8::f32x4 (&acc)[2][2][4][2], const pg8::Unit& u, int wr, int wc, int fr, int fq) const {
        const int col0 = u.pn * 256 + wc * 32 + 4 * fq;
        const bool uni = u.pm < 128;
        pg8::f32x4 gv[4];
        { const float* gr = gate + (size_t)batch_of(u.pm * 256 + wr * 64 + fr) * NMOD;
#pragma unroll
          for (int q = 0; q < 4; ++q) gv[q] = *(const pg8::f32x4*)(gr + col0 + (q >> 1) * 128 + (q & 1) * 16); }
#pragma unroll
        for (int grp = 0; grp < 4; ++grp) {
            const int ai = grp >> 1, m0 = (grp & 1) * 2;
            pg8::f32x4 bv[2][4];
#pragma unroll
            for (int mm = 0; mm < 2; ++mm) {
                const int row = u.pm * 256 + ai * 128 + wr * 64 + (m0 + mm) * 16 + fr;
                if (base_p) { const float* br = row < MP ? base_p + (size_t)row * DM : base_s + (size_t)(row - MP) * DM;
#pragma unroll
                    for (int q = 0; q < 4; ++q) bv[mm][q] = *(const pg8::f32x4*)(br + col0 + (q >> 1) * 128 + (q & 1) * 16);
                } else { const bf16_t* br = X + (size_t)row * DM;
#pragma unroll
                    for (int q = 0; q < 4; ++q) bv[mm][q] = ldx4(br + col0 + (q >> 1) * 128 + (q & 1) * 16); }
            }
#pragma unroll
            for (int mm = 0; mm < 2; ++mm) {
                const int m = m0 + mm, row = u.pm * 256 + ai * 128 + wr * 64 + m * 16 + fr;
                if (!uni) { const float* gr = gate + (size_t)batch_of(row) * NMOD;
#pragma unroll
                    for (int q = 0; q < 4; ++q) gv[q] = *(const pg8::f32x4*)(gr + col0 + (q >> 1) * 128 + (q & 1) * 16); }
                bf16_t* xr = X + (size_t)row * DM;
#pragma unroll
                for (int q = 0; q < 4; ++q) { const int bj = q >> 1, n = q & 1;
                    const pg8::f32x4 xv = bv[mm][q] + gv[q] * acc[ai][bj][m][n];
                    u32x2 w; w.x = pk2(xv[0], xv[1]); w.y = pk2(xv[2], xv[3]); *(u32x2*)(xr + col0 + bj * 128 + n * 16) = w; }
            }
            asm volatile("" ::: "memory");
        }
    }
};
struct EpiSwiGLU {
    static constexpr bool PERM = true, AFTER_DRAIN = false;
    bf16_t* ACT;
    __device__ __forceinline__ void operator()(const pg8::f32x4 (&acc)[2][2][4][2], const pg8::Unit& u, int wr, int wc, int fr, int fq) const {
        const int col0 = u.pn * 128 + wc * 32 + 8 * fq;
#pragma unroll
        for (int ai = 0; ai < 2; ++ai)
#pragma unroll
            for (int m = 0; m < 4; ++m) {
                const int row = u.pm * 256 + ai * 128 + wr * 64 + m * 16 + fr;
                const pg8::f32x4 g0 = acc[ai][0][m][0], g1 = acc[ai][0][m][1], u0 = acc[ai][1][m][0], u1 = acc[ai][1][m][1];
                float r[8];
#pragma unroll
                for (int j = 0; j < 4; ++j) { r[j] = silu_f(g0[j]) * u0[j]; r[4 + j] = silu_f(g1[j]) * u1[j]; }
                u32x4 w; w.x = pg8::cvt_pk_bf16(r[0], r[1]); w.y = pg8::cvt_pk_bf16(r[2], r[3]); w.z = pg8::cvt_pk_bf16(r[4], r[5]); w.w = pg8::cvt_pk_bf16(r[6], r[7]);
                *(u32x4*)(ACT + (size_t)row * DFF + col0) = w;
                asm volatile("" ::: "memory");
            }
    }
};


template <int NKS  , int UNR, class Epi>
__device__ __forceinline__ void sgemm_phase(LAS unsigned char* lds, const bf16_t* A  , int lda, const bf16_t* Bt, int K, int ncb,
                                            int tid, int lane, int wave, const Epi& E) {
    const int l32 = lane & 31, hf = lane >> 5;
    LAS float* red = (LAS float*)lds;
    const int kw0 = wave * NKS * 16 + hf * 8;
    for (int it = blockIdx.x; it < 16 * ncb; it += gridDim.x) {
        const int rb = it & 15, cb = it >> 4;
        int n0, n1; E.cols(cb, n0, n1);
        const bf16_t* ap = A + (size_t)(rb * 32 + l32) * lda + kw0;
        const bf16_t* b0p = Bt + (size_t)(n0 + l32) * K + kw0;
        const bf16_t* b1p = Bt + (size_t)(n1 + l32) * K + kw0;
        f32x16 c0, c1;
#pragma unroll
        for (int r = 0; r < 16; ++r) { c0[r] = 0.f; c1[r] = 0.f; }
#pragma unroll 1
        for (int kb = 0; kb < NKS; kb += UNR) {
            bf16x8 a[UNR], b0[UNR], b1[UNR];
#pragma unroll
            for (int j = 0; j < UNR; ++j) { a[j] = *(const bf16x8*)(ap + (kb + j) * 16); b0[j] = *(const bf16x8*)(b0p + (kb + j) * 16); b1[j] = *(const bf16x8*)(b1p + (kb + j) * 16); }
#pragma unroll
            for (int j = 0; j < UNR; ++j) { c0 = MFMA32(a[j], b0[j], c0); c1 = MFMA32(a[j], b1[j], c1); }
        }
        LAS float* rw = red + wave * 2176;
#pragma unroll
        for (int r = 0; r < 16; ++r) { const int row = (r >> 2) * 8 + hf * 4 + (r & 3); rw[row * 34 + l32] = c0[r]; rw[1088 + row * 34 + l32] = c1[r]; }
        __syncthreads();
        {
            const int row = tid >> 4, cc = (tid & 15) * 2;
            f32x2 g = {0.f, 0.f}, u = {0.f, 0.f};
#pragma unroll
            for (int w = 0; w < 8; ++w) { g += *(const LAS f32x2*)(red + w * 2176 + row * 34 + cc); u += *(const LAS f32x2*)(red + w * 2176 + 1088 + row * 34 + cc); }
            E(rb * 32 + row, n0 + cc, n1 + cc, g, u);
        }
        __syncthreads();
    }
}

template <class Epi>
__device__ __forceinline__ void sgemm_st_phase(LAS unsigned char* lds, const bf16_t* A, int lda, const bf16_t* Bt, int K, int ncb, int tid, int lane, int wave, const Epi& E) {
    const int l32 = lane & 31, hf = lane >> 5, rg = lane >> 3, seg = lane & 7;
    LAS unsigned char* img = lds + wave * 13824;
    const int kw0 = wave * 128;
    for (int it = blockIdx.x; it < 16 * ncb; it += gridDim.x) {
        const int rb = it & 15, cb = it >> 4;
        int n0, n1; E.cols(cb, n0, n1);
        bf16x8 ld[2][12];
#pragma unroll
        for (int h = 0; h < 2; ++h)
#pragma unroll
            for (int q = 0; q < 12; ++q) {
                const int r = (q & 3) * 8 + rg;
                const bf16_t* p = (q < 4) ? A + (size_t)(rb * 32 + r) * lda : Bt + (size_t)((q < 8 ? n0 : n1) + r) * K;
                ld[h][q] = *(const bf16x8*)(p + kw0 + h * 64 + seg * 8);
            }
        f32x16 c0, c1;
#pragma unroll
        for (int r = 0; r < 16; ++r) { c0[r] = 0.f; c1[r] = 0.f; }
#pragma unroll
        for (int h = 0; h < 2; ++h) {
#pragma unroll
            for (int q = 0; q < 12; ++q) *(LAS bf16x8*)(img + (q * 8 + rg) * 144 + seg * 16) = ld[h][q];
            asm volatile("s_waitcnt lgkmcnt(0)" ::: "memory"); __builtin_amdgcn_wave_barrier();
#pragma unroll
            for (int ks = 0; ks < 4; ++ks) {
                const bf16x8 a = *(const LAS bf16x8*)(img + l32 * 144 + ks * 32 + hf * 16), b0 = *(const LAS bf16x8*)(img + (32 + l32) * 144 + ks * 32 + hf * 16), b1 = *(const LAS bf16x8*)(img + (64 + l32) * 144 + ks * 32 + hf * 16);
                c0 = MFMA32(a, b0, c0); c1 = MFMA32(a, b1, c1);
            }
            asm volatile("s_waitcnt lgkmcnt(0)" ::: "memory"); __builtin_amdgcn_wave_barrier();
        }
        LAS float* rw = (LAS float*)img;
#pragma unroll
        for (int r = 0; r < 16; ++r) { const int row = (r >> 2) * 8 + hf * 4 + (r & 3); rw[row * 34 + l32] = c0[r]; rw[1088 + row * 34 + l32] = c1[r]; }
        __syncthreads();
        {
            const int row = tid >> 4, cc = (tid & 15) * 2;
            f32x2 g = {0.f, 0.f}, u = {0.f, 0.f};
#pragma unroll
            for (int w = 0; w < 8; ++w) { const LAS float* p = (const LAS float*)(lds + w * 13824) + row * 34 + cc; g += *(const LAS f32x2*)(p); u += *(const LAS f32x2*)(p + 1088); }
            E(rb * 32 + row, n0 + cc, n1 + cc, g, u);
        }
        __syncthreads();
    }
}
struct SEpiQKV {
    bf16_t* QKV; float* out; int layer;
    __device__ __forceinline__ void cols(int cb, int& n0, int& n1) const { n0 = cb * 64; n1 = n0 + 32; }
    __device__ __forceinline__ void emit(int r, int c, f32x2 v) const {
        *(unsigned*)(QKV + (size_t)(MP + r) * INW + c) = pk2(v.x, v.y);
        if (c >= 512 && c < 1536) { const size_t off = (c < 1024 ? OFF_KS : OFF_VS) + ((size_t)layer * MS + r) * 512 + (c & 511); *(f32x2*)(out + off) = v; }
    }
    __device__ __forceinline__ void operator()(int r, int c0, int c1, f32x2 g, f32x2 u) const { emit(r, c0, g); emit(r, c1, u); }
};
struct SEpiResid {
    const float* basef; bf16_t* Xs; const float* gate;
    __device__ __forceinline__ void cols(int cb, int& n0, int& n1) const { n0 = cb * 64; n1 = n0 + 32; }
    __device__ __forceinline__ void operator()(int r, int c0, int c1, f32x2 g, f32x2 u) const {
        const float* gp = gate + (size_t)(2 + (r >> 5)) * NMOD; bf16_t* xp = Xs + (size_t)r * DM;
        f32x2 b0, b1;
        if (basef) { b0 = *(const f32x2*)(basef + (size_t)r * DM + c0); b1 = *(const f32x2*)(basef + (size_t)r * DM + c1); }
        else { const unsigned w0 = *(const unsigned*)(xp + c0), w1 = *(const unsigned*)(xp + c1);
            b0 = (f32x2){__builtin_bit_cast(float, w0 << 16), __builtin_bit_cast(float, w0 & 0xffff0000u)}; b1 = (f32x2){__builtin_bit_cast(float, w1 << 16), __builtin_bit_cast(float, w1 & 0xffff0000u)}; }
        const f32x2 x0 = b0 + *(const f32x2*)(gp + c0) * g, x1 = b1 + *(const f32x2*)(gp + c1) * u;
        *(unsigned*)(xp + c0) = pk2(x0.x, x0.y); *(unsigned*)(xp + c1) = pk2(x1.x, x1.y);
    }
};
struct SEpiSwiGLU {
    bf16_t* ACT;
    __device__ __forceinline__ void cols(int cb, int& n0, int& n1) const { n0 = (cb >> 2) * 256 + (cb & 3) * 32; n1 = n0 + 128; }
    __device__ __forceinline__ void operator()(int r, int c0, int c1, f32x2 g, f32x2 u) const {
        const int col = (c0 >> 8) * 128 + (c0 & 127);
        *(unsigned*)(ACT + (size_t)(MP + r) * DFF + col) = pk2(silu_f(g.x) * u.x, silu_f(g.y) * u.y);
    }
};

__device__ __forceinline__ void transpose_item(const float* W, int K, int N, bf16_t* WT, LAS float* scr, int item, int lane, bool perm) {
    const int nblk = N / 32, kb = item / nblk, nb = item % nblk, k0 = 64 * kb, n0 = 32 * nb;
    int p0 = n0;
    if (perm) { if (n0 < DFF) p0 = (n0 >> 7) * 256 + (n0 & 127); else { const int n1 = n0 - DFF; p0 = (n1 >> 7) * 256 + 128 + (n1 & 127); } }
#pragma unroll 8
    for (int i = 0; i < 32; ++i) { const int kk = 2 * i + (lane >> 5); scr[kk * 33 + (lane & 31)] = W[(size_t)(k0 + kk) * N + n0 + (lane & 31)]; }
    asm volatile("s_waitcnt lgkmcnt(0)" ::: "memory"); __builtin_amdgcn_wave_barrier();
    const int c = lane & 7;
#pragma unroll
    for (int j = 0; j < 4; ++j) { const int n = (lane >> 3) + 8 * j; const LAS float* s = scr + (8 * c) * 33 + n;
        u32x4 o; o.x = pk2(s[0 * 33], s[1 * 33]); o.y = pk2(s[2 * 33], s[3 * 33]); o.z = pk2(s[4 * 33], s[5 * 33]); o.w = pk2(s[6 * 33], s[7 * 33]);
        *(u32x4*)(WT + (size_t)(p0 + n) * K + k0 + 8 * c) = o; }
    asm volatile("s_waitcnt lgkmcnt(0)" ::: "memory"); __builtin_amdgcn_wave_barrier();
}

__device__ __forceinline__ void p0_phase(const Params& P, LAS unsigned char* lds, int tid, int lane, int wave) {
    LAS float* sc = (LAS float*)lds;
    for (int i = tid; i < NBI * DM; i += 512) { const int b = i >> 10, k = i & 1023; const float c = b < 2 ? P.in[5][b * DM + k] : P.in[6][(b - 2) * DM + k]; sc[i] = silu_f(c); }
    __syncthreads();
    const int gw = blockIdx.x * 8 + wave, NGW = gridDim.x * 8;
    float* MOD = (float*)(P.ws + WS_MOD);
    for (int it = gw; it < 768; it += NGW) {
        const int l = it / 192, r = it % 192, cb = r >> 3, kc = r & 7;
        f32x4 acc[NBI];
#pragma unroll
        for (int b = 0; b < NBI; ++b) acc[b] = (f32x4){0.f, 0.f, 0.f, 0.f};
        const float* wp = P.in[9] + ((size_t)l * DM + kc * 128) * NMOD + cb * 256 + lane * 4;
        const LAS float* scp = sc + kc * 128;
#pragma unroll 16
        for (int k = 0; k < 128; ++k) { const f32x4 w = *(const f32x4*)(wp + (size_t)k * NMOD);
#pragma unroll
            for (int b = 0; b < NBI; ++b) acc[b] += scp[b * DM + k] * w; }
        if (kc == 0) { const f32x4 bv = *(const f32x4*)(P.in[10] + (size_t)l * NMOD + cb * 256 + lane * 4);
#pragma unroll
            for (int b = 0; b < NBI; ++b) acc[b] += bv; }
        float* mp = (float*)(P.ws + WS_PART) + ((size_t)kc * DEPTH + l) * NBI * NMOD + cb * 256 + lane * 4;
#pragma unroll
        for (int b = 0; b < NBI; ++b) *(f32x4*)(mp + b * NMOD) = acc[b];
    }
    LAS float* scr = (LAS float*)(lds + 73728 + wave * 8448);
    constexpr int I_IN = 16 * 112, I_OUT = 16 * 32, I_FI = 16 * 176, I_FO = 44 * 32, I_L = I_IN + I_OUT + I_FI + I_FO;
    for (int it = gw; it < DEPTH * I_L; it += NGW) {
        const int l = it / I_L; int r = it % I_L;
        if (r < I_IN) { transpose_item(P.in[11] + (size_t)l * DM * INW, DM, INW, (bf16_t*)(P.ws + WS_WIN) + (size_t)l * INW * DM, scr, r, lane, false); continue; } r -= I_IN;
        if (r < I_OUT) { transpose_item(P.in[14] + (size_t)l * DM * DM, DM, DM, (bf16_t*)(P.ws + WS_WOUT) + (size_t)l * DM * DM, scr, r, lane, false); continue; } r -= I_OUT;
        if (r < I_FI) { transpose_item(P.in[15] + (size_t)l * DM * 2 * DFF, DM, 2 * DFF, (bf16_t*)(P.ws + WS_WFI) + (size_t)l * 2 * DFF * DM, scr, r, lane, true); continue; } r -= I_FI;
        transpose_item(P.in[16] + (size_t)l * DFF * DM, DFF, DM, (bf16_t*)(P.ws + WS_WFO) + (size_t)l * DM * DFF, scr, r, lane, false);
    }
    f32x2* ROPE = (f32x2*)(P.ws + WS_ROPE);
    for (int idx = blockIdx.x * 512 + tid; idx < SEQ * 64; idx += gridDim.x * 512) {
        const int pos = idx >> 6, i = idx & 63;
        const float inv = exp2f(-(float)i * (13.287712379549449f / 64.f));
        const float ang = (float)pos * inv;
        double rev = (double)ang * 0.15915494309189535; rev -= floor(rev);
        const float rf = (float)rev;
        ROPE[idx] = (f32x2){__builtin_amdgcn_cosf(rf), __builtin_amdgcn_sinf(rf)};
    }
}

template <bool FINAL>
__device__ __forceinline__ void norm_phase(const Params& P, int l, bool from_input, const float* gain, int sh_off, int sc_off, int lane, int wave) {
    const int gw = blockIdx.x * 8 + wave, NGW = gridDim.x * 8;
    const float* MOD = (const float*)(P.ws + WS_MOD) + (size_t)l * NBI * NMOD;
    const bf16_t* X = (const bf16_t*)(P.ws + WS_X); bf16_t* H = (bf16_t*)(P.ws + WS_H);
    f32x4 g[4];
#pragma unroll
    for (int j = 0; j < 4; ++j) g[j] = *(const f32x4*)(gain + 4 * lane + 256 * j);
    auto loadrow = [&](int m, f32x4 (&v)[4]) {
        if (!FINAL && from_input) { const float* xr = m < MP ? P.in[0] + (size_t)m * DM : P.in[1] + (size_t)(m - MP) * DM;
#pragma unroll
            for (int j = 0; j < 4; ++j) v[j] = *(const f32x4*)(xr + 4 * lane + 256 * j);
        } else { const bf16_t* xr = X + (size_t)m * DM;
#pragma unroll
            for (int j = 0; j < 4; ++j) v[j] = ldx4(xr + 4 * lane + 256 * j); }
    };
    f32x4 vn[4];
    if (gw < MT) loadrow(gw, vn);
    for (int m = gw; m < MT; m += NGW) {
        f32x4 v[4]; float ss = 0.f;
#pragma unroll
        for (int j = 0; j < 4; ++j) v[j] = vn[j];
        if (m + NGW < MT) loadrow(m + NGW, vn);
        f32x4 sc[4], sh[4];
        if (!FINAL) { const float* mr = MOD + (size_t)batch_of(m) * NMOD;
#pragma unroll
            for (int j = 0; j < 4; ++j) { const int c = 4 * lane + 256 * j; sc[j] = *(const f32x4*)(mr + sc_off + c); sh[j] = *(const f32x4*)(mr + sh_off + c); } }
#pragma unroll
        for (int j = 0; j < 4; ++j) ss += (v[j].x * v[j].x + v[j].y * v[j].y) + (v[j].z * v[j].z + v[j].w * v[j].w);
        const float rstd = rsqrtf(wave_sum(ss) * (1.f / DM) + EPS);
        if (FINAL) {
            float* o = P.out + (size_t)m * DM;
#pragma unroll
            for (int j = 0; j < 4; ++j) *(f32x4*)(o + 4 * lane + 256 * j) = v[j] * rstd * g[j];
        } else {
#pragma unroll
            for (int j = 0; j < 4; ++j) { const int c = 4 * lane + 256 * j;
                const f32x4 hh = v[j] * rstd * g[j] * (1.f + sc[j]) + sh[j];
                u32x2 w; w.x = pk2(hh.x, hh.y); w.y = pk2(hh.z, hh.w);
                *(u32x2*)(H + (size_t)m * DM + c) = w; }
        }
    }
}

__device__ __forceinline__ void sb_unit(const Params& P, int l, int u, LAS unsigned char* lds, int tid, int lane, int wave) {
    const bf16_t* QKV = (const bf16_t*)(P.ws + WS_QKV);
    const int h = wave, l32 = lane & 31, hf = lane >> 5;
    const bool samp = u >= 1024;
    int qrow0, nsteps; const float* ck = nullptr; const float* cv = nullptr;
    if (!samp) { const int b = u >> 9, qb = u & 511; qrow0 = b * SEQ + qb * 32; nsteps = qb + 1; }
    else { const int bs = u - 1024; qrow0 = MP + bs * 32; nsteps = 65; ck = P.in[2] + (size_t)(l * DB + bs) * PAST * 512; cv = P.in[3] + (size_t)(l * DB + bs) * PAST * 512; }
    bf16x8 qf[4];
#pragma unroll
    for (int ks = 0; ks < 4; ++ks) qf[ks] = *(const bf16x8*)(QKV + (size_t)(qrow0 + l32) * INW + h * 64 + ks * 16 + hf * 8);
    f32x16 O0, O1;
#pragma unroll
    for (int r = 0; r < 16; ++r) { O0[r] = 0.f; O1[r] = 0.f; }
    float cum = 0.f;
    LAS unsigned char* vt = lds + 66048 + wave * 4608;
    auto issue = [&](int s, bf16x8 (&k)[4], bf16x8 (&v)[4]) {
        if (!samp || s == 0) {
            const int krow0 = samp ? qrow0 : qrow0 - s * 32;
#pragma unroll
            for (int ks = 0; ks < 4; ++ks) k[ks] = *(const bf16x8*)(QKV + (size_t)(krow0 + l32) * INW + 512 + h * 64 + ks * 16 + hf * 8);
#pragma unroll
            for (int it = 0; it < 4; ++it) { const int id = it * 64 + lane, key = id >> 3, ch = id & 7;
                v[it] = *(const bf16x8*)(QKV + (size_t)(krow0 + key) * INW + 1024 + h * 64 + ch * 8); }
        } else {
            const int kpos0 = (64 - s) * 32;
#pragma unroll
            for (int ks = 0; ks < 4; ++ks) { const float* p = ck + (size_t)(kpos0 + l32) * 512 + h * 64 + ks * 16 + hf * 8; k[ks] = pack8(*(const f32x4*)p, *(const f32x4*)(p + 4)); }
#pragma unroll
            for (int it = 0; it < 4; ++it) { const int id = it * 64 + lane, key = id >> 3, ch = id & 7;
                const float* p = cv + (size_t)(kpos0 + key) * 512 + h * 64 + ch * 8;
                v[it] = pack8(*(const f32x4*)p, *(const f32x4*)(p + 4)); }
        }
    };
    bf16x8 kf[4], vr[4];
    issue(0, kf, vr);
    for (int s = 0; s < nsteps; ++s) {
#pragma unroll
        for (int it = 0; it < 4; ++it) { const int id = it * 64 + lane, key = id >> 3, ch = id & 7; *(LAS bf16x8*)(vt + key * 144 + ch * 16) = vr[it]; }
        bf16x8 kn[4];
#pragma unroll
        for (int ks = 0; ks < 4; ++ks) kn[ks] = kf[ks];
        if (s + 1 < nsteps) issue(s + 1, kn, vr);
        asm volatile("s_waitcnt lgkmcnt(0)" ::: "memory"); __builtin_amdgcn_wave_barrier();
        f32x16 S;
#pragma unroll
        for (int r = 0; r < 16; ++r) S[r] = 0.f;
#pragma unroll
        for (int ks = 0; ks < 4; ++ks) S = MFMA32(kf[ks], qf[ks], S);
        float L[16], lb[16]; bool valid[16];
#pragma unroll
        for (int r = 0; r < 16; ++r) {
            const float z = S[r] * 0.18033688011112042f;
            const float sp = fmaxf(z, 0.f) + __builtin_amdgcn_logf(1.f + __builtin_amdgcn_exp2f(-fabsf(z)));
            const int key = (r >> 2) * 8 + hf * 4 + (r & 3);
            valid[r] = (s != 0) || (key < l32);
            L[r] = valid[r] ? -sp : 0.f; lb[r] = z - sp;
        }
        float T[4], Pp[4];
#pragma unroll
        for (int g = 0; g < 4; ++g) { T[g] = (L[4 * g] + L[4 * g + 1]) + (L[4 * g + 2] + L[4 * g + 3]); Pp[g] = __shfl_xor(T[g], 32); }
        float later[4]; float tot = 0.f;
#pragma unroll
        for (int g = 3; g >= 0; --g) { later[g] = tot; tot += T[g] + Pp[g]; }
        float w[16];
#pragma unroll
        for (int g = 0; g < 4; ++g) {
            const float s3 = cum + later[g] + (hf == 0 ? Pp[g] : 0.f);
            const float s2 = s3 + L[4 * g + 3], s1 = s2 + L[4 * g + 2], s0 = s1 + L[4 * g + 1];
            w[4 * g + 3] = valid[4 * g + 3] ? __builtin_amdgcn_exp2f(lb[4 * g + 3] + s3) : 0.f;
            w[4 * g + 2] = valid[4 * g + 2] ? __builtin_amdgcn_exp2f(lb[4 * g + 2] + s2) : 0.f;
            w[4 * g + 1] = valid[4 * g + 1] ? __builtin_amdgcn_exp2f(lb[4 * g + 1] + s1) : 0.f;
            w[4 * g + 0] = valid[4 * g + 0] ? __builtin_amdgcn_exp2f(lb[4 * g + 0] + s0) : 0.f;
        }
        cum += tot;
#pragma unroll
        for (int c = 0; c < 2; ++c) {
            u32x4 pw; pw.x = pk2(w[8 * c], w[8 * c + 1]); pw.y = pk2(w[8 * c + 2], w[8 * c + 3]); pw.z = pk2(w[8 * c + 4], w[8 * c + 5]); pw.w = pk2(w[8 * c + 6], w[8 * c + 7]);
            const bf16x8 pa = __builtin_bit_cast(bf16x8, pw);
#pragma unroll
            for (int dt = 0; dt < 2; ++dt) {
                bf16x8 vb;
#pragma unroll
                for (int i = 0; i < 8; ++i) { const int key = 16 * c + 8 * (i >> 2) + 4 * hf + (i & 3); vb[i] = *(const LAS short*)(vt + key * 144 + (l32 + 32 * dt) * 2); }
                if (dt == 0) O0 = MFMA32(pa, vb, O0); else O1 = MFMA32(pa, vb, O1);
            }
        }
        asm volatile("" ::: "memory");
        if (__all(cum < -158.7f)) break;
#pragma unroll
        for (int ks = 0; ks < 4; ++ks) kf[ks] = kn[ks];
    }
    LAS float* oa = (LAS float*)lds;
#pragma unroll
    for (int r = 0; r < 16; ++r) { const int q = (r >> 2) * 8 + hf * 4 + (r & 3); oa[q * 516 + h * 64 + l32] = O0[r]; oa[q * 516 + h * 64 + 32 + l32] = O1[r]; }
    __syncthreads();
    bf16_t* Ob = (bf16_t*)(P.ws + WS_O);
    const float* gsb = P.in[12] + (size_t)l * 512;
    {
        f32x4 ra[4], rb[4]; float sq[4];
#pragma unroll
        for (int rr = 0; rr < 4; ++rr) { const int q = wave * 4 + rr;
            ra[rr] = *(const LAS f32x4*)(oa + q * 516 + 4 * lane); rb[rr] = *(const LAS f32x4*)(oa + q * 516 + 256 + 4 * lane);
            const f32x4 a = ra[rr], b = rb[rr];
            sq[rr] = (a.x * a.x + a.y * a.y) + (a.z * a.z + a.w * a.w) + (b.x * b.x + b.y * b.y) + (b.z * b.z + b.w * b.w); }
#pragma unroll
        for (int o = 1; o < 64; o <<= 1) {
#pragma unroll
            for (int rr = 0; rr < 4; ++rr) sq[rr] += __shfl_xor(sq[rr], o);
        }
        const f32x4 ga = *(const f32x4*)(gsb + 4 * lane), gb = *(const f32x4*)(gsb + 256 + 4 * lane);
#pragma unroll
        for (int rr = 0; rr < 4; ++rr) { const int q = wave * 4 + rr;
            const float rstd = rsqrtf(sq[rr] * (1.f / 512.f) + EPS);
            const f32x4 ya = ra[rr] * rstd * ga, yb = rb[rr] * rstd * gb;
            u32x2 wa, wb; wa.x = pk2(ya.x, ya.y); wa.y = pk2(ya.z, ya.w); wb.x = pk2(yb.x, yb.y); wb.y = pk2(yb.z, yb.w);
            *(u32x2*)(Ob + (size_t)(qrow0 + q) * DM + 4 * lane) = wa; *(u32x2*)(Ob + (size_t)(qrow0 + q) * DM + 256 + 4 * lane) = wb; }
    }
    __syncthreads();
}

__device__ __forceinline__ void ret_unit(const Params& P, int l, LAS unsigned char* lds, int tid, int lane, int wave,
                                         int row0, int pos0, int nchunks, int L, int h, const float* init, float* outst, bool state_only) {
    const bf16_t* QKV = (const bf16_t*)(P.ws + WS_QKV); bf16_t* Ob = (bf16_t*)(P.ws + WS_O);
    const f32x2* ROPE = (const f32x2*)(P.ws + WS_ROPE);
    const float lg2 = log2f(1.f - exp2f(-5.f - (float)h));
    LAS unsigned char *Qn = lds, *Kn = lds + 17408, *KdT = lds + 34816, *VT = lds + 53248, *SbT = lds + 71680, *Pm = lds + 106496;
    LAS float* of = (LAS float*)lds;
    const int l32 = lane & 31, hf = lane >> 5;
    const int sdt = wave >> 1, set0 = (wave & 1) * 2;
    f32x16 S0, S1;
#pragma unroll
    for (int r = 0; r < 16; ++r) { S0[r] = 0.f; S1[r] = 0.f; }
    if (init) {
        const float* ip = init + (sdt * 32 + hf * 4) * 128 + set0 * 32 + l32;
#pragma unroll
        for (int r = 0; r < 16; ++r) { S0[r] = ip[((r >> 2) * 8 + (r & 3)) * 128]; S1[r] = ip[((r >> 2) * 8 + (r & 3)) * 128 + 32]; if ((r & 3) == 3) asm volatile("" ::: "memory"); }
    }
    if (!state_only) {
#pragma unroll
        for (int g = 0; g < 4; ++g) { const int d0 = sdt * 32 + g * 8 + hf * 4;
            u32x2 a, b; a.x = pk2(S0[4 * g], S0[4 * g + 1]); a.y = pk2(S0[4 * g + 2], S0[4 * g + 3]); b.x = pk2(S1[4 * g], S1[4 * g + 1]); b.y = pk2(S1[4 * g + 2], S1[4 * g + 3]);
            *(LAS u32x2*)(SbT + (set0 * 32 + l32) * 272 + d0 * 2) = a; *(LAS u32x2*)(SbT + ((set0 + 1) * 32 + l32) * 272 + d0 * 2) = b; }
    }
    const float gL = exp2f((float)L * lg2);
    const int lt = wave >> 2, et = wave & 3;
    bf16x8 rk1, rk2, rq1, rq2, rv0, rv1; f32x4 rcs[4];
    const bf16x8 z8 = {0, 0, 0, 0, 0, 0, 0, 0};
    auto issue = [&](int c) {
        const int t = tid >> 3, i0 = (tid & 7) * 8; const bool ok = t < L;
        const size_t row = (size_t)(row0 + c * 64 + t);
        rk1 = z8; rk2 = z8; rq1 = z8; rq2 = z8;
#pragma unroll
        for (int i = 0; i < 4; ++i) rcs[i] = (f32x4){0.f, 0.f, 0.f, 0.f};
        if (ok) {
            rk1 = *(const bf16x8*)(QKV + row * INW + 2048 + h * 128 + i0); rk2 = *(const bf16x8*)(QKV + row * INW + 2048 + h * 128 + 64 + i0);
            if (!state_only) { rq1 = *(const bf16x8*)(QKV + row * INW + 1536 + h * 128 + i0); rq2 = *(const bf16x8*)(QKV + row * INW + 1536 + h * 128 + 64 + i0); }
            const f32x4* rp = (const f32x4*)(ROPE + (size_t)(pos0 + c * 64 + t) * 64 + i0);
#pragma unroll
            for (int i = 0; i < 4; ++i) rcs[i] = rp[i];
        }
        const int t0 = tid >> 4, ch = tid & 15;
        rv0 = z8; rv1 = z8;
        if (t0 < L) rv0 = *(const bf16x8*)(QKV + (size_t)(row0 + c * 64 + t0) * INW + 2560 + h * 128 + ch * 8);
        if (t0 + 32 < L) rv1 = *(const bf16x8*)(QKV + (size_t)(row0 + c * 64 + t0 + 32) * INW + 2560 + h * 128 + ch * 8);
    };
    issue(0);
    const int l32_0 = l32, hf_0 = hf, tid_0 = tid; const float lg2_0 = lg2;
#pragma unroll 1
    for (int c = 0; c < nchunks; ++c) {
        int l32 = l32_0, hf = hf_0, tid = tid_0; float lg2 = lg2_0;
        asm volatile("" : "+v"(l32), "+v"(hf), "+v"(tid), "+v"(lg2));
        {
            const int t = tid >> 3, pc = tid & 7, i0 = pc * 8; const bool ok = t < L;
            const float kd = ok ? __builtin_amdgcn_exp2f((float)(L - 1 - t) * lg2) : 0.f;
            const int tsw = (((t >> 3) ^ pc) << 4) + (t & 7) * 2;
            float cs_c[8], cs_s[8];
#pragma unroll
            for (int i = 0; i < 4; ++i) { cs_c[2 * i] = rcs[i].x; cs_s[2 * i] = rcs[i].y; cs_c[2 * i + 1] = rcs[i].z; cs_s[2 * i + 1] = rcs[i].w; }
            {
                float o1[8], o2[8];
#pragma unroll
                for (int i = 0; i < 8; ++i) { const float x1 = bf2f((unsigned short)rk1[i]), x2 = bf2f((unsigned short)rk2[i]);
                    o1[i] = (x1 * cs_c[i] - x2 * cs_s[i]) * 0.08838834764831845f; o2[i] = (x1 * cs_s[i] + x2 * cs_c[i]) * 0.08838834764831845f; }
                if (!state_only) {
                    u32x4 a, b; a.x = pk2(o1[0], o1[1]); a.y = pk2(o1[2], o1[3]); a.z = pk2(o1[4], o1[5]); a.w = pk2(o1[6], o1[7]);
                    b.x = pk2(o2[0], o2[1]); b.y = pk2(o2[2], o2[3]); b.z = pk2(o2[4], o2[5]); b.w = pk2(o2[6], o2[7]);
                    *(LAS u32x4*)(Kn + t * 272 + i0 * 2) = a; *(LAS u32x4*)(Kn + t * 272 + (64 + i0) * 2) = b;
                }
#pragma unroll
                for (int i = 0; i < 8; ++i) { *(LAS unsigned short*)(KdT + (i0 + i) * 144 + tsw) = (unsigned short)f2bf(o1[i] * kd); *(LAS unsigned short*)(KdT + (64 + i0 + i) * 144 + tsw) = (unsigned short)f2bf(o2[i] * kd); }
            }
            if (!state_only) {
                float o1[8], o2[8];
#pragma unroll
                for (int i = 0; i < 8; ++i) { const float x1 = bf2f((unsigned short)rq1[i]), x2 = bf2f((unsigned short)rq2[i]);
                    o1[i] = x1 * cs_c[i] - x2 * cs_s[i]; o2[i] = x1 * cs_s[i] + x2 * cs_c[i]; }
                u32x4 a, b; a.x = pk2(o1[0], o1[1]); a.y = pk2(o1[2], o1[3]); a.z = pk2(o1[4], o1[5]); a.w = pk2(o1[6], o1[7]);
                b.x = pk2(o2[0], o2[1]); b.y = pk2(o2[2], o2[3]); b.z = pk2(o2[4], o2[5]); b.w = pk2(o2[6], o2[7]);
                *(LAS u32x4*)(Qn + t * 272 + i0 * 2) = a; *(LAS u32x4*)(Qn + t * 272 + (64 + i0) * 2) = b;
            }
            {
                const int t0 = tid >> 4, ch = tid & 15, sw = ch & 7;
                const int o0 = (((t0 >> 3) ^ sw) << 4) + (t0 & 7) * 2, o1b = ((((t0 + 32) >> 3) ^ sw) << 4) + (t0 & 7) * 2;
#pragma unroll
                for (int i = 0; i < 8; ++i) { *(LAS short*)(VT + (ch * 8 + i) * 144 + o0) = rv0[i]; *(LAS short*)(VT + (ch * 8 + i) * 144 + o1b) = rv1[i]; }
            }
        }
        if (c + 1 < nchunks) issue(c + 1);
        unsigned gpre[8];
#pragma unroll
        for (int rr = 0; rr < 8; ++rr) { const int t = wave * 8 + rr; gpre[rr] = (!state_only && t < L) ? *(const unsigned*)(QKV + (size_t)(row0 + c * 64 + t) * INW + 3072 + h * 128 + lane * 2) : 0u; }
        __syncthreads();
        f32x16 acc;
        if (!state_only) {
#pragma unroll
            for (int r = 0; r < 16; ++r) acc[r] = 0.f;
#pragma unroll
            for (int ks = 0; ks < 8; ++ks) { const bf16x8 a = *(const LAS bf16x8*)(Qn + (lt * 32 + l32) * 272 + (ks * 16 + hf * 8) * 2), b = *(const LAS bf16x8*)(SbT + (et * 32 + l32) * 272 + (ks * 16 + hf * 8) * 2); acc = MFMA32(a, b, acc); }
#pragma unroll
            for (int r = 0; r < 16; ++r) { const int tl = lt * 32 + (r >> 2) * 8 + hf * 4 + (r & 3); acc[r] *= __builtin_amdgcn_exp2f((float)(tl + 1) * lg2); }
            if (wave < 4) {
                const int slt = wave >> 1, smt = wave & 1;
                f32x16 sc;
#pragma unroll
                for (int r = 0; r < 16; ++r) sc[r] = 0.f;
                if (slt >= smt) {
#pragma unroll
                    for (int ks = 0; ks < 8; ++ks) { const bf16x8 a = *(const LAS bf16x8*)(Qn + (slt * 32 + l32) * 272 + (ks * 16 + hf * 8) * 2), b = *(const LAS bf16x8*)(Kn + (smt * 32 + l32) * 272 + (ks * 16 + hf * 8) * 2); sc = MFMA32(a, b, sc); }
                }
                const int tm = smt * 32 + l32;
#pragma unroll
                for (int r = 0; r < 16; ++r) { const int tl = slt * 32 + (r >> 2) * 8 + hf * 4 + (r & 3);
                    const float p = tl >= tm ? sc[r] * __builtin_amdgcn_exp2f((float)(tl - tm) * lg2) : 0.f;
                    *(LAS unsigned short*)(Pm + tl * 144 + tm * 2) = (unsigned short)f2bf(p); }
            }
            __syncthreads();
#pragma unroll
            for (int ms = 0; ms < 4; ++ms) { const bf16x8 a = *(const LAS bf16x8*)(Pm + (lt * 32 + l32) * 144 + (ms * 16 + hf * 8) * 2), b = *(const LAS bf16x8*)(VT + (et * 32 + l32) * 144 + (((ms * 2 + hf) ^ ((et * 4 + (l32 >> 3)) & 7)) << 4)); acc = MFMA32(a, b, acc); }
#pragma unroll
            for (int r = 0; r < 16; ++r) { const int tl = lt * 32 + (r >> 2) * 8 + hf * 4 + (r & 3); of[tl * 132 + et * 32 + l32] = acc[r]; }
        }
#pragma unroll
        for (int r = 0; r < 16; ++r) { S0[r] *= gL; S1[r] *= gL; }
#pragma unroll
        for (int ts = 0; ts < 4; ++ts) {
            const int cc = ts * 2 + hf, rs = l32 >> 3;
            const bf16x8 a = *(const LAS bf16x8*)(KdT + (sdt * 32 + l32) * 144 + ((cc ^ ((sdt * 4 + rs) & 7)) << 4));
            const bf16x8 b0 = *(const LAS bf16x8*)(VT + (set0 * 32 + l32) * 144 + ((cc ^ ((set0 * 4 + rs) & 7)) << 4)), b1 = *(const LAS bf16x8*)(VT + ((set0 + 1) * 32 + l32) * 144 + ((cc ^ (((set0 + 1) * 4 + rs) & 7)) << 4));
            S0 = MFMA32(a, b0, S0); S1 = MFMA32(a, b1, S1);
        }
        if (!state_only) {
#pragma unroll
            for (int g = 0; g < 4; ++g) { const int d0 = sdt * 32 + g * 8 + hf * 4;
                u32x2 a, b; a.x = pk2(S0[4 * g], S0[4 * g + 1]); a.y = pk2(S0[4 * g + 2], S0[4 * g + 3]); b.x = pk2(S1[4 * g], S1[4 * g + 1]); b.y = pk2(S1[4 * g + 2], S1[4 * g + 3]);
                *(LAS u32x2*)(SbT + (set0 * 32 + l32) * 272 + d0 * 2) = a; *(LAS u32x2*)(SbT + ((set0 + 1) * 32 + l32) * 272 + d0 * 2) = b; }
            __syncthreads();
            const f32x2 gr = *(const f32x2*)(P.in[13] + (size_t)(l * 4 + h) * 128 + lane * 2);
            f32x2 ov[8]; float sq[8];
#pragma unroll
            for (int rr = 0; rr < 8; ++rr) { ov[rr] = *(const LAS f32x2*)(of + (wave * 8 + rr) * 132 + lane * 2); sq[rr] = ov[rr].x * ov[rr].x + ov[rr].y * ov[rr].y; }
#pragma unroll
            for (int o = 1; o < 64; o <<= 1) {
#pragma unroll
                for (int rr = 0; rr < 8; ++rr) sq[rr] += __shfl_xor(sq[rr], o);
            }
#pragma unroll
            for (int rr = 0; rr < 8; ++rr) {
                const int t = wave * 8 + rr;
                if (t < L) {
                    const float rstd = rsqrtf(sq[rr] * (1.f / 128.f) + EPS);
                    const size_t row = (size_t)(row0 + c * 64 + t);
                    const unsigned gg = gpre[rr];
                    const float y0 = ov[rr].x * rstd * gr.x * silu_f(bf2f(gg & 0xffffu)), y1 = ov[rr].y * rstd * gr.y * silu_f(bf2f(gg >> 16));
                    *(unsigned*)(Ob + row * DM + 512 + h * 128 + lane * 2) = pk2(y0, y1);
                }
            }
        }
        __syncthreads();
    }
    if (outst) {
        float* op = outst + (sdt * 32 + hf * 4) * 128 + set0 * 32 + l32;
#pragma unroll
        for (int r = 0; r < 16; ++r) { op[((r >> 2) * 8 + (r & 3)) * 128] = S0[r]; op[((r >> 2) * 8 + (r & 3)) * 128 + 32] = S1[r]; if ((r & 3) == 3) asm volatile("" ::: "memory"); }
    }
}


#define XB_TMO      128
#define XB_XCNT(j)  (256  + 64 * (j))
#define XB_XSUB(j)  (1280 + 64 * (j))
#define XB_XGEN(j)  (2304 + 64 * (j))
#define XB_TOP      3328
#define XB_TOPGEN   3392
#define XCD_BAR_WORDS 3456
#define XB_SPIN_CAP (1u << 18)

__device__ __forceinline__ unsigned xb_ld(unsigned* p)              { return __hip_atomic_load(p, __ATOMIC_RELAXED, __HIP_MEMORY_SCOPE_AGENT); }
__device__ __forceinline__ unsigned xb_add(unsigned* p, unsigned v) { return __hip_atomic_fetch_add(p, v, __ATOMIC_RELAXED, __HIP_MEMORY_SCOPE_AGENT); }
__device__ __forceinline__ unsigned xb_xcc_id() { return (unsigned)__builtin_amdgcn_s_getreg((3 << 11) | 20) & 0xFu; }
#define XB_SPIN(cond, bar) do { unsigned _sp = 0; while (cond) { __builtin_amdgcn_s_sleep(1); \
    if ((++_sp & 255u) == 0u) { if (xb_ld(&(bar)[XB_TMO])) break; if (_sp > XB_SPIN_CAP) { atomicAdd(&(bar)[XB_TMO], 1u); break; } } } } while (0)

struct XcdBarrier {
    unsigned* bar; unsigned x;
    volatile LAS unsigned* st;
};

__device__ __forceinline__ XcdBarrier xcd_barrier_post(unsigned* bar, volatile LAS unsigned* st) {
    XcdBarrier b; b.bar = bar; b.x = xb_xcc_id(); b.st = st;
    if (threadIdx.x == 0) (void)xb_add(&bar[XB_XCNT(b.x)], 1u);
    return b;
}
__device__ __forceinline__ void xcd_barrier_complete(unsigned* bar, unsigned x, unsigned& nloc, unsigned& nx) {
    const unsigned G = gridDim.x * gridDim.y * gridDim.z;
    unsigned sum, cnt, mine, sp = 0u;
    for (;;) {
        sum = 0u; cnt = 0u; mine = 0u;
#pragma unroll
        for (unsigned j = 0; j < 16; ++j) { const unsigned c = xb_ld(&bar[XB_XCNT(j)]); sum += c; cnt += (c > 0u) ? 1u : 0u; mine = (j == x) ? c : mine; }
        if (sum == G) break;
        __builtin_amdgcn_s_sleep(1);
        if ((++sp & 255u) == 0u) { if (xb_ld(&bar[XB_TMO])) break; if (sp > XB_SPIN_CAP) { atomicAdd(&bar[XB_TMO], 1u); break; } }
    }
    nloc = mine > 0u ? mine : 1u; nx = cnt > 0u ? cnt : 1u;
}

__device__ __forceinline__ void xcd_barrier(const XcdBarrier& b) {
    asm volatile("s_waitcnt vmcnt(0)" ::: "memory");
    __syncthreads();
    if (threadIdx.x == 0) {
        unsigned* bar = b.bar;
        __builtin_amdgcn_s_waitcnt(0);
        unsigned nloc = b.st[0], nx = b.st[1];
        if (nloc == 0u) { xcd_barrier_complete(bar, b.x, nloc, nx); b.st[0] = nloc; b.st[1] = nx; }
        const unsigned old = xb_add(&bar[XB_XSUB(b.x)], 1u);
        const unsigned gen = old / nloc;
        if (old + 1u == (gen + 1u) * nloc) {
            __builtin_amdgcn_fence(__ATOMIC_RELEASE, "agent");
            asm volatile("s_waitcnt vmcnt(0)" ::: "memory");
            const unsigned og = xb_add(&bar[XB_TOP], 1u);
            const unsigned tg = og / nx;
            if (og + 1u == (tg + 1u) * nx) xb_add(&bar[XB_TOPGEN], 1u);
            else XB_SPIN(xb_ld(&bar[XB_TOPGEN]) == tg, bar);
            __builtin_amdgcn_fence(__ATOMIC_ACQUIRE, "agent");
            xb_add(&bar[XB_XGEN(b.x)], 1u);
            asm volatile("s_waitcnt vmcnt(0)" ::: "memory");
        } else {
            XB_SPIN(xb_ld(&bar[XB_XGEN(b.x)]) == gen, bar);
            __builtin_amdgcn_fence(__ATOMIC_ACQUIRE, "agent");
            asm volatile("s_waitcnt vmcnt(0)" ::: "memory");
        }
    }
    __syncthreads();
}
__global__ void __launch_bounds__(512, 2) fwd_megakernel(Params P) {
    extern __shared__ __attribute__((aligned(16))) unsigned char lds_raw[];
    LAS unsigned char* lds = (LAS unsigned char*)lds_raw;
    cg::grid_group grid = cg::this_grid();
    int tid = threadIdx.x, lane = tid & 63, wave = __builtin_amdgcn_readfirstlane(tid >> 6);
#define REFRESH() do { tid = threadIdx.x; asm volatile("" : "+v"(tid)); lane = tid & 63; wave = __builtin_amdgcn_readfirstlane(tid >> 6); } while (0)
    const int G = gridDim.x, bx = blockIdx.x;
    bf16_t* H = (bf16_t*)(P.ws + WS_H); bf16_t* Ob = (bf16_t*)(P.ws + WS_O); bf16_t* QKV = (bf16_t*)(P.ws + WS_QKV); bf16_t* ACT = QKV;
    bf16_t* X = (bf16_t*)(P.ws + WS_X); float* U = (float*)(P.ws + WS_U);
    const float* MOD = (const float*)(P.ws + WS_MOD);

    volatile LAS unsigned* bst = (volatile LAS unsigned*)(lds + LDS_BYTES - 64);
    if (tid == 0) { bst[0] = 0u; bst[1] = 0u; }
    __syncthreads();
    const XcdBarrier xbar = xcd_barrier_post((unsigned*)(P.ws + WS_BAR), bst);
#ifndef SK_P0
    p0_phase(P, lds, tid, lane, wave);
#endif
    xcd_barrier(xbar); REFRESH();
    {
        const f32x4* part = (const f32x4*)(P.ws + WS_PART); f32x4* mod4 = (f32x4*)(P.ws + WS_MOD);
        constexpr int NV = DEPTH * NBI * NMOD / 4;
        for (int i = bx * 512 + tid; i < NV; i += G * 512) {
            f32x4 a = part[i];
#pragma unroll
            for (int kc = 1; kc < 8; ++kc) a += part[(size_t)kc * NV + i];
            mod4[i] = a;
        }
    }
    if (P.ws == nullptr) grid.sync();
    xcd_barrier(xbar); REFRESH();
#pragma unroll 1
    for (int l = 0; l < DEPTH; ++l) {
        norm_phase<false>(P, l, l == 0, P.in[7] + (size_t)l * DM, 0, 1024, lane, wave);
        xcd_barrier(xbar); REFRESH();
#ifndef SK_G1
        {
            pg8::Gemm g{H, (const bf16_t*)(P.ws + WS_WIN) + (size_t)l * INW * DM, MP, INW, DM}; pg8::StaticOrder S; S.init(MP, INW, G, bx);
            EpiQKV E{QKV, P.out, l};
            pg8::gemm_phase<EpiQKV, pg8::StaticOrder, true, true>(lds, g, S, E);
            SEpiQKV SE{QKV, P.out, l};
            sgemm_st_phase<SEpiQKV>(lds, H + (size_t)MP * DM, DM, g.Bt, DM, INW / 64, tid, lane, wave, SE);
        }
#endif
        xcd_barrier(xbar); REFRESH();
        {
            unsigned* qhead = (unsigned*)(P.ws + WS_CTR) + l * 64;
            volatile LAS unsigned* qslot = (volatile LAS unsigned*)(lds + LDS_BYTES - 128);
            for (;;) {
                if (tid == 0) *qslot = __hip_atomic_fetch_add(qhead, 1u, __ATOMIC_RELAXED, __HIP_MEMORY_SCOPE_AGENT);
                __syncthreads();
                const int u = (int)*qslot;
                __syncthreads();
                if (u >= 1360) break;
                if (u < 256) { const int bh = u >> 5, seg = u & 31, b = bh >> 2, h = bh & 3;
                    ret_unit(P, l, lds, tid, lane, wave, b * SEQ + seg * 512, seg * 512, 8, 64, h, nullptr, U + (size_t)(bh * 32 + seg) * 16384, true); }
                else if (u < 272) sb_unit(P, l, 1024 + (u - 256), lds, tid, lane, wave);
                else if (u < 1296) { const int v = u - 272; sb_unit(P, l, (v & 1) * 512 + (511 - (v >> 1)), lds, tid, lane, wave); }
                else { const int idx = u - 1296, bs = idx >> 2, h = idx & 3; const size_t so = ((size_t)(l * DB + bs) * 4 + h) * 16384;
                    ret_unit(P, l, lds, tid, lane, wave, MP + bs * 32, PAST, 1, 32, h, P.in[4] + so, P.out + OFF_RS + so, false); }
            }
        }
        xcd_barrier(xbar); REFRESH();
        for (int idx = bx * 512 + tid; idx < 8 * 16384; idx += G * 512) {
            const int bh = idx >> 14, within = idx & 16383, h = bh & 3;
            const float g512 = exp2f(512.f * log2f(1.f - exp2f(-5.f - (float)h)));
            float* up = U + (size_t)bh * 32 * 16384 + within; float s = 0.f;
            float uv[32];
#pragma unroll
            for (int seg = 0; seg < 32; ++seg) uv[seg] = up[(size_t)seg * 16384];
#pragma unroll
            for (int seg = 0; seg < 32; ++seg) { up[(size_t)seg * 16384] = s; s = g512 * s + uv[seg]; }
            P.out[OFF_RP + ((size_t)l * 8 + bh) * 16384 + within] = s;
        }
        xcd_barrier(xbar); REFRESH();
#ifndef SK_R3
        for (int u = bx; u < 256; u += G) { const int bh = u >> 5, seg = u & 31, b = bh >> 2, h = bh & 3;
            ret_unit(P, l, lds, tid, lane, wave, b * SEQ + seg * 512, seg * 512, 8, 64, h, U + (size_t)(bh * 32 + seg) * 16384, nullptr, false); }
#endif
        xcd_barrier(xbar); REFRESH();
#ifndef SK_G2
        {
            pg8::Gemm g{Ob, (const bf16_t*)(P.ws + WS_WOUT) + (size_t)l * DM * DM, MP, DM, DM}; pg8::StaticOrder S; S.init(MP, DM, G, bx);
            EpiResid E{l == 0 ? P.in[0] : nullptr, l == 0 ? P.in[1] : nullptr, X, MOD + (size_t)l * NBI * NMOD + 2048};
            pg8::gemm_phase<EpiResid, pg8::StaticOrder, true, true>(lds, g, S, E);
            SEpiResid SE{l == 0 ? P.in[1] : nullptr, X + (size_t)MP * DM, MOD + (size_t)l * NBI * NMOD + 2048};
            sgemm_phase<8, 8, SEpiResid>(lds, Ob + (size_t)MP * DM, DM, g.Bt, DM, DM / 64, tid, lane, wave, SE);
        }
#endif
        xcd_barrier(xbar); REFRESH();
        norm_phase<false>(P, l, false, P.in[8] + (size_t)l * DM, 3072, 4096, lane, wave);
        xcd_barrier(xbar); REFRESH();
#ifndef SK_G3
        {
            pg8::Gemm g{H, (const bf16_t*)(P.ws + WS_WFI) + (size_t)l * 2 * DFF * DM, MP, 2 * DFF, DM}; pg8::StaticOrder S; S.init(MP, 2 * DFF, G, bx);
            EpiSwiGLU E{ACT};
            pg8::gemm_phase<EpiSwiGLU, pg8::StaticOrder, true, true>(lds, g, S, E);
            SEpiSwiGLU SE{ACT};
            sgemm_st_phase<SEpiSwiGLU>(lds, H + (size_t)MP * DM, DM, g.Bt, DM, (2 * DFF / 256) * 4, tid, lane, wave, SE);
        }
#endif
        xcd_barrier(xbar); REFRESH();
#ifndef SK_G4
        {
            pg8::Gemm g{ACT, (const bf16_t*)(P.ws + WS_WFO) + (size_t)l * DM * DFF, MP, DM, DFF}; pg8::StaticOrder S; S.init(MP, DM, G, bx);
            EpiResid E{nullptr, nullptr, X, MOD + (size_t)l * NBI * NMOD + 5120};
            pg8::gemm_phase<EpiResid, pg8::StaticOrder, true, true>(lds, g, S, E);
            SEpiResid SE{nullptr, X + (size_t)MP * DM, MOD + (size_t)l * NBI * NMOD + 5120};
            sgemm_phase<22, 11, SEpiResid>(lds, ACT + (size_t)MP * DFF, DFF, g.Bt, DFF, DM / 64, tid, lane, wave, SE);
        }
#endif
        xcd_barrier(xbar); REFRESH();
    }
    norm_phase<true>(P, 0, false, P.in[17], 0, 0, lane, wave);
}

extern "C" void kernel_launch(void* const* d_in, const int* in_sizes, int n_in, void* d_out, int out_size, void* d_ws, size_t ws_size, hipStream_t stream) {
    static int grid = 0;
    if (grid == 0) {
        if (n_in != 18 || ws_size < WS_END) { fprintf(stderr, "kernel_launch: unexpected n_in %d / ws_size %zu\n", n_in, ws_size); grid = -1; return; }
        int dev = 0, cus = 0, per_cu = 0;
        (void)hipGetDevice(&dev); (void)hipDeviceGetAttribute(&cus, hipDeviceAttributeMultiprocessorCount, dev);
        if (hipFuncSetAttribute((const void*)fwd_megakernel, hipFuncAttributeMaxDynamicSharedMemorySize, LDS_BYTES) != hipSuccess) { fprintf(stderr, "kernel_launch: hipFuncSetAttribute failed\n"); grid = -1; return; }
        (void)hipOccupancyMaxActiveBlocksPerMultiprocessor(&per_cu, (const void*)fwd_megakernel, 512, LDS_BYTES);
        (void)hipGetLastError();
        if (per_cu < 1) { fprintf(stderr, "kernel_launch: occupancy query says %d blocks per CU\n", per_cu); per_cu = 1; }
        grid = cus;
    }
    if (grid < 0) return;
    (void)hipMemsetAsync((char*)d_ws + WS_BAR, 0, 20480, stream);
    Params p{};
    for (int i = 0; i < 18; ++i) p.in[i] = (const float*)d_in[i];
    p.out = (float*)d_out; p.ws = (unsigned char*)d_ws;
    void* args[] = {&p};
    hipError_t e = hipLaunchCooperativeKernel((const void*)fwd_megakernel, dim3(grid), dim3(512), args, LDS_BYTES, stream);
    if (e != hipSuccess) fprintf(stderr, "cooperative launch failed: %s (grid %d)\n", hipGetErrorString(e), grid);
}
```

```cpp
#include <hip/hip_runtime.h>
#include <hip/hip_cooperative_groups.h>
#include <cstdio>
#include <cstdint>
namespace cg = cooperative_groups;
namespace pg8 {
#define PG8_LAS __attribute__((address_space(3)))
typedef unsigned short bf16_t;
typedef short bf16x8 __attribute__((ext_vector_type(8)));
typedef float f32x4 __attribute__((ext_vector_type(4)));
typedef unsigned u32x4 __attribute__((ext_vector_type(4)));
constexpr int BM = 256, BK = 64, HALF = 128, HTB = HALF * BK * 2  , STAGE_BYTES = 8 * HTB, NXCD = 8, WGM = 8;

__host__ __device__ __forceinline__ int lds_byte(int r, int c) { const int st = (r >> 4) * 2 + (c >> 5), rr = r & 15, cc = c & 31, ob = rr * 64 + cc * 2; return st * 1024 + (ob ^ (((ob >> 9) & 1) << 5)); }
__host__ __device__ __forceinline__ void stage_rc(int b, int& R, int& C) { const int st = b / 1024, sb = b % 1024, swz = sb ^ (((sb >> 9) & 1) << 5); R = (st >> 1) * 16 + swz / 64; C = (st & 1) * 32 + (swz % 64) / 2; }
__host__ __device__ __forceinline__ int perm32(int rho) { const int n = rho >> 4, i = rho & 15; return 8 * (i >> 2) + 4 * n + (i & 3); }

struct Unit { int pm, pn; };
struct Gemm { const bf16_t* A; const bf16_t* Bt; int M, N, K; };

struct StaticOrder {
    int nM, nN, nwg, G, c;
    __host__ __device__ void init(int M, int N, int G_, int c_) { nM = M / BM; nN = N / BM; nwg = nM * nN; G = G_; c = c_; }
    __host__ __device__ bool next(int i, Unit& u) const {
        const long L = (long)i * G + c; if (L >= nwg) return false;
        int wgid = (int)L; { const int q = nwg / NXCD, r = nwg % NXCD, xcd = wgid % NXCD, off = wgid / NXCD; wgid = (xcd < r ? xcd * (q + 1) : r * (q + 1) + (xcd - r) * q) + off; }
        const int nig = WGM * nN, gid = wgid / nig, fm = gid * WGM, gsz = (nM - fm) < WGM ? (nM - fm) : WGM;
        u.pm = fm + ((wgid % nig) % gsz); u.pn = (wgid % nig) / gsz; return true;
    }
    __device__ __forceinline__ void a_ready(const Unit&) const {}
    __device__ __forceinline__ void done(const Unit&) const {}
};

__device__ __forceinline__ unsigned cvt_pk_bf16(float lo, float hi) { unsigned r; asm volatile("v_cvt_pk_bf16_f32 %0, %1, %2" : "=v"(r) : "v"(lo), "v"(hi)); return r; }
typedef float f32x2 __attribute__((ext_vector_type(2)));
__device__ __forceinline__ f32x2 gelu_pk(f32x2 v) {
    const f32x2 av = __builtin_elementwise_abs(v), d = av * 0.2316418882f + 1.0f;
    f32x2 t; t.x = __builtin_amdgcn_rcpf(d.x); t.y = __builtin_amdgcn_rcpf(d.y);
    f32x2 q = t * 0.5307027145f + (-0.7265760135f); q = q * t + 0.7107068705f; q = q * t + (-0.142248368f); q = q * t + 0.127414796f; q = q * t;
    const f32x2 s = (v * v) * (-0.72134752044f);
    f32x2 e; e.x = __builtin_amdgcn_exp2f(s.x); e.y = __builtin_amdgcn_exp2f(s.y);
    const f32x2 m = v * (q * e), r = v - m;
    f32x2 o; o.x = v.x < 0.f ? m.x : r.x; o.y = v.y < 0.f ? m.y : r.y; return o;
}

template <int ACT  > struct EpiBf16 {
    static constexpr bool PERM = true, AFTER_DRAIN = false; static_assert(ACT == 0 || ACT == 1, "EpiBf16: ACT is 0 (none) or 1 (gelu_pk)");
    bf16_t* O; int ldc; const float* bias; int split_cols; size_t split_stride; float scale0;
    __device__ __forceinline__ void operator()(const f32x4 (&acc)[2][2][4][2], const Unit& u, int wr, int wc, int fr, int fq) const {
        const int row0 = u.pm * BM + wr * 64 + fr; int colt = u.pn * BM; bf16_t* base = O;
        float sc = 1.f; if (split_cols) { const int t = colt / split_cols; base += (size_t)t * split_stride; colt -= t * split_cols; if (t == 0) sc = scale0; }
        const int col0 = colt + wc * 32 + 8 * fq, bcol0 = u.pn * BM + wc * 32 + 8 * fq;
        f32x4 bv[2][2];
#pragma unroll
        for (int bj = 0; bj < 2; ++bj)
#pragma unroll
            for (int n = 0; n < 2; ++n) bv[bj][n] = bias ? *(const f32x4*)(bias + bcol0 + bj * HALF + 4 * n) : (f32x4){0.f, 0.f, 0.f, 0.f};
#pragma unroll
        for (int ai = 0; ai < 2; ++ai)
#pragma unroll
            for (int m = 0; m < 4; ++m) { bf16_t* rowp = base + (size_t)(row0 + ai * HALF + m * 16) * ldc + col0;
#pragma unroll
                for (int bj = 0; bj < 2; ++bj) { f32x4 v0 = acc[ai][bj][m][0] + bv[bj][0], v1 = acc[ai][bj][m][1] + bv[bj][1];
                    if (ACT == 1) { f32x2 a = gelu_pk((f32x2){v0[0], v0[1]}), b = gelu_pk((f32x2){v0[2], v0[3]}), c = gelu_pk((f32x2){v1[0], v1[1]}), d = gelu_pk((f32x2){v1[2], v1[3]});
                        v0 = (f32x4){a.x, a.y, b.x, b.y}; v1 = (f32x4){c.x, c.y, d.x, d.y}; }
                    v0 = v0 * sc; v1 = v1 * sc; u32x4 w; w.x = cvt_pk_bf16(v0[0], v0[1]); w.y = cvt_pk_bf16(v0[2], v0[3]); w.z = cvt_pk_bf16(v1[0], v1[1]); w.w = cvt_pk_bf16(v1[2], v1[3]);
                    *(u32x4*)(rowp + bj * HALF) = w; } }
    }
};
template <class Epi, class Sched, bool ALIGN_EPI = false, bool SP2 = false>
__device__ __forceinline__ void gemm_phase(PG8_LAS unsigned char* lds, const Gemm g, const Sched& S, const Epi& E) {
    int tid_o = threadIdx.x; asm volatile("" : "+v"(tid_o));
    const int tid = tid_o, wid = __builtin_amdgcn_readfirstlane(tid >> 6), lane = tid & 63, wr = wid >> 2, wc = wid & 3, fr = lane & 15, fq = lane >> 4;
    const int K = g.K, nt = K / BK;
    unsigned voffA[2], voffB[2];
#pragma unroll
    for (int i = 0; i < 2; ++i) { int R, C; stage_rc(tid * 16 + i * 8192, R, C); const int Rb = Epi::PERM ? ((R & ~31) + perm32(R & 31)) : R;
        voffA[i] = (unsigned)(R * K + C) * 2u; voffB[i] = (unsigned)(Rb * K + C) * 2u; }
    const size_t kstep = (size_t)(BK * 2);
    const size_t hstep = (size_t)HALF * K * 2;
    const size_t tstep = 2 * hstep;
    const unsigned ldsw = (unsigned)wid * 1024u;
    const int aoff = lds_byte(wr * 64 + fr, fq * 8), boff = lds_byte(wc * 32 + fr, fq * 8);
#define PG8_SA(b, h) (((b) * 2 + (h)) * HTB)
#define PG8_SB(b, h) ((4 + (b) * 2 + (h)) * HTB)
#define PG8_STAGE(bufoff, gbase, voff) do { _Pragma("unroll") for (int _i = 0; _i < 2; ++_i) \
        __builtin_amdgcn_global_load_lds((const unsigned*)((const char*)(gbase) + (voff)[_i]), (PG8_LAS unsigned*)(lds + (bufoff) + ldsw + _i * 8192), 16, 0, 0); } while (0)
#define PG8_LDA(dst, b, h) do { _Pragma("unroll") for (int m = 0; m < 4; ++m) _Pragma("unroll") for (int k = 0; k < 2; ++k) dst[m][k] = *(const PG8_LAS bf16x8*)(lds + PG8_SA(b, h) + aoff + m * 2048 + k * 1024); } while (0)
#define PG8_LDB(dst, b, h) do { _Pragma("unroll") for (int n = 0; n < 2; ++n) _Pragma("unroll") for (int k = 0; k < 2; ++k) dst[n][k] = *(const PG8_LAS bf16x8*)(lds + PG8_SB(b, h) + boff + n * 2048 + k * 1024); } while (0)
#define PG8_MMA(ai, bj, At, Bt) do { __builtin_amdgcn_s_setprio(1); _Pragma("unroll") for (int m = 0; m < 4; ++m) _Pragma("unroll") for (int n = 0; n < 2; ++n) _Pragma("unroll") for (int k = 0; k < 2; ++k) \
        acc[ai][bj][m][n] = __builtin_amdgcn_mfma_f32_16x16x32_bf16(Bt[n][k], At[m][k], acc[ai][bj][m][n], 0, 0, 0); __builtin_amdgcn_s_setprio(0); } while (0)
#define PG8_WAIT_V(n) asm volatile("s_waitcnt vmcnt(" #n ")" ::: "memory")
#define PG8_WAIT_L(n) asm volatile("s_waitcnt lgkmcnt(" #n ")" ::: "memory")
#define PG8_BAR __builtin_amdgcn_s_barrier()
#define PG8_SCHED __builtin_amdgcn_sched_barrier(0)
    Unit cur, nxt; int ui = 0;
    if (!S.next(0, cur)) return;
    f32x4 acc[2][2][4][2];
#pragma unroll
    for (int a = 0; a < 2; ++a)
#pragma unroll
        for (int b = 0; b < 2; ++b)
#pragma unroll
            for (int m = 0; m < 4; ++m)
#pragma unroll
                for (int n = 0; n < 2; ++n) acc[a][b][m][n] = (f32x4){0.f, 0.f, 0.f, 0.f};
    bf16x8 At[4][2], B0[2][2], B1[2][2];
    const char* cA = (const char*)g.A + (size_t)cur.pm * tstep; const char* cB = (const char*)g.Bt + (size_t)cur.pn * tstep;
    S.a_ready(cur);
    if constexpr (SP2) {
        PG8_STAGE(PG8_SB(0, 0), cB, voffB); PG8_STAGE(PG8_SB(0, 1), cB + hstep, voffB); PG8_STAGE(PG8_SA(0, 0), cA, voffA); PG8_STAGE(PG8_SA(0, 1), cA + hstep, voffA);
        if (wr == 1) PG8_BAR;
        PG8_WAIT_V(2); PG8_BAR;
        PG8_STAGE(PG8_SB(1, 0), cB + kstep, voffB); PG8_STAGE(PG8_SA(1, 0), cA + kstep, voffA); PG8_STAGE(PG8_SB(1, 1), cB + hstep + kstep, voffB);
        PG8_WAIT_V(6); PG8_BAR;
    } else {
        PG8_STAGE(PG8_SB(0, 0), cB, voffB); PG8_STAGE(PG8_SA(0, 0), cA, voffA); PG8_STAGE(PG8_SB(0, 1), cB + hstep, voffB); PG8_STAGE(PG8_SA(0, 1), cA + hstep, voffA);
        if (wr == 1) PG8_BAR;
        PG8_WAIT_V(4); PG8_BAR;
        PG8_STAGE(PG8_SB(1, 0), cB + kstep, voffB); PG8_STAGE(PG8_SA(1, 0), cA + kstep, voffA); PG8_STAGE(PG8_SB(1, 1), cB + hstep + kstep, voffB);
        PG8_WAIT_V(6); PG8_BAR;
    }
    for (;;) {
        const bool has_next = S.next(ui + 1, nxt);
        const char* nA = has_next ? (const char*)g.A + (size_t)nxt.pm * tstep : cA; const char* nB = has_next ? (const char*)g.Bt + (size_t)nxt.pn * tstep : cB;
        for (int t = 0; t < nt; t += 2) {
            const bool last = (t == nt - 2);
            const char* a1 = cA + (size_t)(t + 1) * kstep;
            const char* a2 = last ? nA : cA + (size_t)(t + 2) * kstep; const char* b2 = last ? nB : cB + (size_t)(t + 2) * kstep;
            const char* a3 = a2 + kstep; const char* b3 = b2 + kstep;
            if (last && has_next) S.a_ready(nxt);
            if constexpr (SP2) {
            PG8_LDB(B0, 0, 0); PG8_LDB(B1, 0, 1); PG8_SCHED; PG8_LDA(At, 0, 0); PG8_STAGE(PG8_SA(1, 1), a1 + hstep, voffA);
            PG8_WAIT_V(8); PG8_WAIT_L(0); PG8_BAR; PG8_MMA(0, 0, At, B0); PG8_MMA(0, 1, At, B1); PG8_BAR; PG8_SCHED;
            PG8_LDA(At, 0, 1); PG8_STAGE(PG8_SB(0, 0), b2, voffB); PG8_STAGE(PG8_SB(0, 1), b2 + hstep, voffB); PG8_STAGE(PG8_SA(0, 0), a2, voffA);
            PG8_WAIT_V(8); PG8_WAIT_L(0); PG8_BAR; PG8_MMA(1, 0, At, B0); PG8_MMA(1, 1, At, B1); PG8_BAR; PG8_SCHED;
            PG8_LDB(B0, 1, 0); PG8_LDB(B1, 1, 1); PG8_SCHED; PG8_LDA(At, 1, 0); PG8_STAGE(PG8_SA(0, 1), a2 + hstep, voffA);
            PG8_WAIT_V(8); PG8_WAIT_L(0); PG8_BAR; PG8_MMA(0, 0, At, B0); PG8_MMA(0, 1, At, B1); PG8_BAR; PG8_SCHED;
            PG8_LDA(At, 1, 1); PG8_STAGE(PG8_SB(1, 0), b3, voffB); PG8_STAGE(PG8_SB(1, 1), b3 + hstep, voffB); PG8_STAGE(PG8_SA(1, 0), a3, voffA);
            PG8_WAIT_V(8); PG8_WAIT_L(0); PG8_BAR; PG8_MMA(1, 0, At, B0); PG8_MMA(1, 1, At, B1); PG8_BAR; PG8_SCHED;
            } else {
            PG8_LDB(B0, 0, 0); PG8_SCHED; PG8_LDA(At, 0, 0); PG8_STAGE(PG8_SA(1, 1), a1 + hstep, voffA);
            PG8_WAIT_L(8); PG8_BAR; PG8_WAIT_L(0); PG8_MMA(0, 0, At, B0); PG8_BAR; PG8_SCHED;
            PG8_LDB(B1, 0, 1); PG8_STAGE(PG8_SB(0, 0), b2, voffB);
            PG8_BAR; PG8_WAIT_L(0); PG8_MMA(0, 1, At, B1); PG8_BAR;
            PG8_LDA(At, 0, 1); PG8_STAGE(PG8_SA(0, 0), a2, voffA);
            PG8_BAR; PG8_WAIT_L(0); PG8_MMA(1, 0, At, B0); PG8_BAR; PG8_SCHED;
            PG8_STAGE(PG8_SB(0, 1), b2 + hstep, voffB);
            PG8_WAIT_V(6); PG8_BAR; PG8_MMA(1, 1, At, B1); PG8_BAR;
            PG8_LDB(B0, 1, 0); PG8_SCHED; PG8_LDA(At, 1, 0); PG8_STAGE(PG8_SA(0, 1), a2 + hstep, voffA);
            PG8_WAIT_L(8); PG8_BAR; PG8_WAIT_L(0); PG8_MMA(0, 0, At, B0); PG8_BAR; PG8_SCHED;
            PG8_LDB(B1, 1, 1); PG8_STAGE(PG8_SB(1, 0), b3, voffB);
            PG8_BAR; PG8_WAIT_L(0); PG8_MMA(0, 1, At, B1); PG8_BAR;
            PG8_LDA(At, 1, 1); PG8_STAGE(PG8_SA(1, 0), a3, voffA);
            PG8_BAR; PG8_WAIT_L(0); PG8_MMA(1, 0, At, B0); PG8_BAR; PG8_SCHED;
            PG8_STAGE(PG8_SB(1, 1), b3 + hstep, voffB);
            PG8_WAIT_V(6); PG8_BAR; PG8_MMA(1, 1, At, B1); PG8_BAR;
            }
        }
        if constexpr (ALIGN_EPI) { if (wr == 0) PG8_BAR; }
        if constexpr (!Epi::AFTER_DRAIN) { E(acc, cur, wr, wc, fr, fq); S.done(cur); }
        if (!has_next) break;
#pragma unroll
        for (int a = 0; a < 2; ++a)
#pragma unroll
            for (int b = 0; b < 2; ++b)
#pragma unroll
                for (int m = 0; m < 4; ++m)
#pragma unroll
                    for (int n = 0; n < 2; ++n) acc[a][b][m][n] = (f32x4){0.f, 0.f, 0.f, 0.f};
        cur = nxt; cA = nA; cB = nB; ++ui;
        if constexpr (ALIGN_EPI) { if (wr == 1) PG8_BAR; }
    }
    PG8_WAIT_V(0);
    if constexpr (!ALIGN_EPI) { if (wr == 0) PG8_BAR; }
    PG8_BAR;
    if constexpr (Epi::AFTER_DRAIN) { E.fused(acc, cur, wr, wc, fr, fq, lds, wid, lane); S.done(cur); }
#undef PG8_SA
#undef PG8_SB
#undef PG8_STAGE
#undef PG8_LDA
#undef PG8_LDB
#undef PG8_MMA
#undef PG8_WAIT_V
#undef PG8_WAIT_L
#undef PG8_BAR
#undef PG8_SCHED
}
}

#define LAS __attribute__((address_space(3)))
typedef unsigned short bf16_t;
typedef short bf16x8 __attribute__((ext_vector_type(8)));
typedef float f32x4 __attribute__((ext_vector_type(4)));
typedef float f32x2 __attribute__((ext_vector_type(2)));
typedef float f32x16 __attribute__((ext_vector_type(16)));
typedef unsigned u32x4 __attribute__((ext_vector_type(4)));
typedef unsigned u32x2 __attribute__((ext_vector_type(2)));
#define MFMA32(a, b, c) __builtin_amdgcn_mfma_f32_32x32x16_bf16((a), (b), (c), 0, 0, 0)

constexpr int DM = 1024, SEQ = 16384, NBP = 2, DEPTH = 4, DB = 16, DS = 32, PAST = 2048;
constexpr int MP = NBP * SEQ, MS = DB * DS, MT = MP + MS;
constexpr int INW = 3584, DFF = 2816, NMOD = 6144, NBI = 18;
constexpr float EPS = 1e-6f;
constexpr size_t OFF_YP = 0, OFF_YS = 33554432, OFF_KP = 34078720, OFF_VP = 101187584, OFF_RP = 168296448,
                 OFF_KS = 168820736, OFF_VS = 169869312, OFF_RS = 170917888;
constexpr size_t MiB = 1u << 20;
constexpr size_t WS_MOD = 0, MOD_BYTES = 2 * MiB; constexpr size_t WS_CTR = 1820160;
constexpr size_t WS_BAR = 1802240;
constexpr size_t WS_ROPE = 2 * MiB;
constexpr size_t WS_WIN = 10 * MiB, WS_WOUT = 38 * MiB, WS_WFI = 46 * MiB, WS_WFO = 90 * MiB;
constexpr size_t WS_X = 112 * MiB;
constexpr size_t WS_H = 242 * MiB;
constexpr size_t WS_O = 307 * MiB;
constexpr size_t WS_QKV = 372 * MiB;
constexpr size_t WS_U = 600 * MiB;
constexpr size_t WS_PART = 616 * MiB;
constexpr size_t WS_END = 632 * MiB;
constexpr int LDS_BYTES = 147456;

struct Params { const float* in[18]; float* out; unsigned char* ws; };

typedef __bf16 bf16x2_t __attribute__((ext_vector_type(2)));
__device__ __forceinline__ unsigned pk2(float lo, float hi) { const f32x2 v = {lo, hi}; return __builtin_bit_cast(unsigned, __builtin_convertvector(v, bf16x2_t)); }
__device__ __forceinline__ unsigned f2bf(float f) { return pk2(f, 0.f) & 0xffffu; }
__device__ __forceinline__ float bf2f(unsigned h) { return __builtin_bit_cast(float, h << 16); }
__device__ __forceinline__ f32x4 ldx4(const bf16_t* p) { const u32x2 w = *(const u32x2*)p;
    return (f32x4){__builtin_bit_cast(float, w.x << 16), __builtin_bit_cast(float, w.x & 0xffff0000u), __builtin_bit_cast(float, w.y << 16), __builtin_bit_cast(float, w.y & 0xffff0000u)}; }
__device__ __forceinline__ bf16x8 pack8(f32x4 a, f32x4 b) { u32x4 p; p.x = pk2(a.x, a.y); p.y = pk2(a.z, a.w); p.z = pk2(b.x, b.y); p.w = pk2(b.z, b.w); return __builtin_bit_cast(bf16x8, p); }
__device__ __forceinline__ float wave_sum(float v) {
#pragma unroll
    for (int o = 1; o < 64; o <<= 1) v += __shfl_xor(v, o);
    return v;
}
__device__ __forceinline__ float silu_f(float x) { return x * __builtin_amdgcn_rcpf(1.f + __expf(-x)); }
__device__ __forceinline__ int batch_of(int row) { return row < MP ? (row >> 14) : 2 + ((row - MP) >> 5); }

struct EpiQKV {
    static constexpr bool PERM = true, AFTER_DRAIN = false;
    bf16_t* QKV; float* out; int layer;
    __device__ __forceinline__ void operator()(const pg8::f32x4 (&acc)[2][2][4][2], const pg8::Unit& u, int wr, int wc, int fr, int fq) const {
        const int row0 = u.pm * 256 + wr * 64 + fr, col0 = u.pn * 256 + wc * 32 + 8 * fq;
        const bool kv = (u.pn >= 2 && u.pn < 6);
        const size_t vsel = (u.pn >= 4) ? 1 : 0;
        const size_t obase = (u.pm < 128) ? OFF_KP + vsel * (OFF_VP - OFF_KP) + (size_t)layer * MP * 512 + (size_t)row0 * 512
                                          : OFF_KS + vsel * (OFF_VS - OFF_KS) + (size_t)layer * MS * 512 + (size_t)(row0 - MP) * 512;
#pragma unroll
        for (int ai = 0; ai < 2; ++ai)
#pragma unroll
            for (int m = 0; m < 4; ++m) {
                const int row = row0 + ai * 128 + m * 16;
#pragma unroll
                for (int bj = 0; bj < 2; ++bj) {
                    const int col = col0 + bj * 128;
                    const pg8::f32x4 v0 = acc[ai][bj][m][0], v1 = acc[ai][bj][m][1];
                    u32x4 w; w.x = pg8::cvt_pk_bf16(v0[0], v0[1]); w.y = pg8::cvt_pk_bf16(v0[2], v0[3]); w.z = pg8::cvt_pk_bf16(v1[0], v1[1]); w.w = pg8::cvt_pk_bf16(v1[2], v1[3]);
                    *(u32x4*)(QKV + (size_t)row * INW + col) = w;
                    if (kv) {
                        const int c = col & 511;
                        float* dst = out + obase + (size_t)(ai * 128 + m * 16) * 512 + c;
                        *(pg8::f32x4*)dst = v0; *(pg8::f32x4*)(dst + 4) = v1;
                    }
                }
                asm volatile("" ::: "memory");
            }
    }
};
struct EpiResid {
    static constexpr bool PERM = false, AFTER_DRAIN = false;
    const float* base_p; const float* base_s;
    bf16_t* X; const float* gate;
    __device__ __forceinline__ void operator()(const pg8::f32x4 (&acc)[2][2][4][2], const pg8::Unit& u, int wr, int wc, int fr, int fq) const {
        const int col0 = u.pn * 256 + wc * 32 + 4 * fq;
        const bool uni = u.pm < 128;
        pg8::f32x4 gv[4];
        { const float* gr = gate + (size_t)batch_of(u.pm * 256 + wr * 64 + fr) * NMOD;
#pragma unroll
          for (int q = 0; q < 4; ++q) gv[q] = *(const pg8::f32x4*)(gr + col0 + (q >> 1) * 128 + (q & 1) * 16); }
#pragma unroll
        for (int grp = 0; grp < 4; ++grp) {
            const int ai = grp >> 1, m0 = (grp & 1) * 2;
            pg8::f32x4 bv[2][4];
#pragma unroll
            for (int mm = 0; mm < 2; ++mm) {
                const int row = u.pm * 256 + ai * 128 + wr * 64 + (m0 + mm) * 16 + fr;
                if (base_p) { const float* br = row < MP ? base_p + (size_t)row * DM : base_s + (size_t)(row - MP) * DM;
#pragma unroll
                    for (int q = 0; q < 4; ++q) bv[mm][q] = *(const pg8::f32x4*)(br + col0 + (q >> 1) * 128 + (q & 1) * 16);
                } else { const bf16_t* br = X + (size_t)row * DM;
#pragma unroll
                    for (int q = 0; q < 4; ++q) bv[mm][q] = ldx4(br + col0 + (q >> 1) * 128 + (q & 1) * 16); }
            }
#pragma unroll
            for (int mm = 0; mm < 2; ++mm) {
                const int m = m0 + mm, row = u.pm * 256 + ai * 128 + wr * 64 + m * 16 + fr;
                if (!uni) { const float* gr = gate + (size_t)batch_of(row) * NMOD;
#pragma unroll
                    for (int q = 0; q < 4; ++q) gv[q] = *(const pg8::f32x4*)(gr + col0 + (q >> 1) * 128 + (q & 1) * 16); }
                bf16_t* xr = X + (size_t)row * DM;
#pragma unroll
                for (int q = 0; q < 4; ++q) { const int bj = q >> 1, n = q & 1;
                    const pg8::f32x4 xv = bv[mm][q] + gv[q] * acc[ai][bj][m][n];
                    u32x2 w; w.x = pk2(xv[0], xv[1]); w.y = pk2(xv[2], xv[3]); *(u32x2*)(xr + col0 + bj * 128 + n * 16) = w; }
            }
            asm volatile("" ::: "memory");
        }
    }
};
struct EpiSwiGLU {
    static constexpr bool PERM = true, AFTER_DRAIN = false;
    bf16_t* ACT;
    __device__ __forceinline__ void operator()(const pg8::f32x4 (&acc)[2][2][4][2], const pg8::Unit& u, int wr, int wc, int fr, int fq) const {
        const int col0 = u.pn * 128 + wc * 32 + 8 * fq;
#pragma unroll
        for (int ai = 0; ai < 2; ++ai)
#pragma unroll
            for (int m = 0; m < 4; ++m) {
                const int row = u.pm * 256 + ai * 128 + wr * 64 + m * 16 + fr;
                const pg8::f32x4 g0 = acc[ai][0][m][0], g1 = acc[ai][0][m][1], u0 = acc[ai][1][m][0], u1 = acc[ai][1][m][1];
                float r[8];
#pragma unroll
                for (int j = 0; j < 4; ++j) { r[j] = silu_f(g0[j]) * u0[j]; r[4 + j] = silu_f(g1[j]) * u1[j]; }
                u32x4 w; w.x = pg8::cvt_pk_bf16(r[0], r[1]); w.y = pg8::cvt_pk_bf16(r[2], r[3]); w.z = pg8::cvt_pk_bf16(r[4], r[5]); w.w = pg8::cvt_pk_bf16(r[6], r[7]);
                *(u32x4*)(ACT + (size_t)row * DFF + col0) = w;
                asm volatile("" ::: "memory");
            }
    }
};


template <int NKS  , int UNR, class Epi>
__device__ __forceinline__ void sgemm_phase(LAS unsigned char* lds, const bf16_t* A  , int lda, const bf16_t* Bt, int K, int ncb,
                                            int tid, int lane, int wave, const Epi& E) {
    const int l32 = lane & 31, hf = lane >> 5;
    LAS float* red = (LAS float*)lds;
    const int kw0 = wave * NKS * 16 + hf * 8;
    for (int it = blockIdx.x; it < 16 * ncb; it += gridDim.x) {
        const int rb = it & 15, cb = it >> 4;
        int n0, n1; E.cols(cb, n0, n1);
        const bf16_t* ap = A + (size_t)(rb * 32 + l32) * lda + kw0;
        const bf16_t* b0p = Bt + (size_t)(n0 + l32) * K + kw0;
        const bf16_t* b1p = Bt + (size_t)(n1 + l32) * K + kw0;
        f32x16 c0, c1;
#pragma unroll
        for (int r = 0; r < 16; ++r) { c0[r] = 0.f; c1[r] = 0.f; }
#pragma unroll 1
        for (int kb = 0; kb < NKS; kb += UNR) {
            bf16x8 a[UNR], b0[UNR], b1[UNR];
#pragma unroll
            for (int j = 0; j < UNR; ++j) { a[j] = *(const bf16x8*)(ap + (kb + j) * 16); b0[j] = *(const bf16x8*)(b0p + (kb + j) * 16); b1[j] = *(const bf16x8*)(b1p + (kb + j) * 16); }
#pragma unroll
            for (int j = 0; j < UNR; ++j) { c0 = MFMA32(a[j], b0[j], c0); c1 = MFMA32(a[j], b1[j], c1); }
        }
        LAS float* rw = red + wave * 2176;
#pragma unroll
        for (int r = 0; r < 16; ++r) { const int row = (r >> 2) * 8 + hf * 4 + (r & 3); rw[row * 34 + l32] = c0[r]; rw[1088 + row * 34 + l32] = c1[r]; }
        __syncthreads();
        {
            const int row = tid >> 4, cc = (tid & 15) * 2;
            f32x2 g = {0.f, 0.f}, u = {0.f, 0.f};
#pragma unroll
            for (int w = 0; w < 8; ++w) { g += *(const LAS f32x2*)(red + w * 2176 + row * 34 + cc); u += *(const LAS f32x2*)(red + w * 2176 + 1088 + row * 34 + cc); }
            E(rb * 32 + row, n0 + cc, n1 + cc, g, u);
        }
        __syncthreads();
    }
}

template <class Epi>
__device__ __forceinline__ void sgemm_st_phase(LAS unsigned char* lds, const bf16_t* A, int lda, const bf16_t* Bt, int K, int ncb, int tid, int lane, int wave, const Epi& E) {
    const int l32 = lane & 31, hf = lane >> 5, rg = lane >> 3, seg = lane & 7;
    LAS unsigned char* img = lds + wave * 13824;
    const int kw0 = wave * 128;
    for (int it = blockIdx.x; it < 16 * ncb; it += gridDim.x) {
        const int rb = it & 15, cb = it >> 4;
        int n0, n1; E.cols(cb, n0, n1);
        bf16x8 ld[2][12];
#pragma unroll
        for (int h = 0; h < 2; ++h)
#pragma unroll
            for (int q = 0; q < 12; ++q) {
                const int r = (q & 3) * 8 + rg;
                const bf16_t* p = (q < 4) ? A + (size_t)(rb * 32 + r) * lda : Bt + (size_t)((q < 8 ? n0 : n1) + r) * K;
                ld[h][q] = *(const bf16x8*)(p + kw0 + h * 64 + seg * 8);
            }
        f32x16 c0, c1;
#pragma unroll
        for (int r = 0; r < 16; ++r) { c0[r] = 0.f; c1[r] = 0.f; }
#pragma unroll
        for (int h = 0; h < 2; ++h) {
#pragma unroll
            for (int q = 0; q < 12; ++q) *(LAS bf16x8*)(img + (q * 8 + rg) * 144 + seg * 16) = ld[h][q];
            asm volatile("s_waitcnt lgkmcnt(0)" ::: "memory"); __builtin_amdgcn_wave_barrier();
#pragma unroll
            for (int ks = 0; ks < 4; ++ks) {
                const bf16x8 a = *(const LAS bf16x8*)(img + l32 * 144 + ks * 32 + hf * 16), b0 = *(const LAS bf16x8*)(img + (32 + l32) * 144 + ks * 32 + hf * 16), b1 = *(const LAS bf16x8*)(img + (64 + l32) * 144 + ks * 32 + hf * 16);
                c0 = MFMA32(a, b0, c0); c1 = MFMA32(a, b1, c1);
            }
            asm volatile("s_waitcnt lgkmcnt(0)" ::: "memory"); __builtin_amdgcn_wave_barrier();
        }
        LAS float* rw = (LAS float*)img;
#pragma unroll
        for (int r = 0; r < 16; ++r) { const int row = (r >> 2) * 8 + hf * 4 + (r & 3); rw[row * 34 + l32] = c0[r]; rw[1088 + row * 34 + l32] = c1[r]; }
        __syncthreads();
        {
            const int row = tid >> 4, cc = (tid & 15) * 2;
            f32x2 g = {0.f, 0.f}, u = {0.f, 0.f};
#pragma unroll
            for (int w = 0; w < 8; ++w) { const LAS float* p = (const LAS float*)(lds + w * 13824) + row * 34 + cc; g += *(const LAS f32x2*)(p); u += *(const LAS f32x2*)(p + 1088); }
            E(rb * 32 + row, n0 + cc, n1 + cc, g, u);
        }
        __syncthreads();
    }
}
struct SEpiQKV {
    bf16_t* QKV; float* out; int layer;
    __device__ __forceinline__ void cols(int cb, int& n0, int& n1) const { n0 = cb * 64; n1 = n0 + 32; }
    __device__ __forceinline__ void emit(int r, int c, f32x2 v) const {
        *(unsigned*)(QKV + (size_t)(MP + r) * INW + c) = pk2(v.x, v.y);
        if (c >= 512 && c < 1536) { const size_t off = (c < 1024 ? OFF_KS : OFF_VS) + ((size_t)layer * MS + r) * 512 + (c & 511); *(f32x2*)(out + off) = v; }
    }
    __device__ __forceinline__ void operator()(int r, int c0, int c1, f32x2 g, f32x2 u) const { emit(r, c0, g); emit(r, c1, u); }
};
struct SEpiResid {
    const float* basef; bf16_t* Xs; const float* gate;
    __device__ __forceinline__ void cols(int cb, int& n0, int& n1) const { n0 = cb * 64; n1 = n0 + 32; }
    __device__ __forceinline__ void operator()(int r, int c0, int c1, f32x2 g, f32x2 u) const {
        const float* gp = gate + (size_t)(2 + (r >> 5)) * NMOD; bf16_t* xp = Xs + (size_t)r * DM;
        f32x2 b0, b1;
        if (basef) { b0 = *(const f32x2*)(basef + (size_t)r * DM + c0); b1 = *(const f32x2*)(basef + (size_t)r * DM + c1); }
        else { const unsigned w0 = *(const unsigned*)(xp + c0), w1 = *(const unsigned*)(xp + c1);
            b0 = (f32x2){__builtin_bit_cast(float, w0 << 16), __builtin_bit_cast(float, w0 & 0xffff0000u)}; b1 = (f32x2){__builtin_bit_cast(float, w1 << 16), __builtin_bit_cast(float, w1 & 0xffff0000u)}; }
        const f32x2 x0 = b0 + *(const f32x2*)(gp + c0) * g, x1 = b1 + *(const f32x2*)(gp + c1) * u;
        *(unsigned*)(xp + c0) = pk2(x0.x, x0.y); *(unsigned*)(xp + c1) = pk2(x1.x, x1.y);
    }
};
struct SEpiSwiGLU {
    bf16_t* ACT;
    __device__ __forceinline__ void cols(int cb, int& n0, int& n1) const { n0 = (cb >> 2) * 256 + (cb & 3) * 32; n1 = n0 + 128; }
    __device__ __forceinline__ void operator()(int r, int c0, int c1, f32x2 g, f32x2 u) const {
        const int col = (c0 >> 8) * 128 + (c0 & 127);
        *(unsigned*)(ACT + (size_t)(MP + r) * DFF + col) = pk2(silu_f(g.x) * u.x, silu_f(g.y) * u.y);
    }
};

__device__ __forceinline__ void transpose_item(const float* W, int K, int N, bf16_t* WT, LAS float* scr, int item, int lane, bool perm) {
    const int nblk = N / 32, kb = item / nblk, nb = item % nblk, k0 = 64 * kb, n0 = 32 * nb;
    int p0 = n0;
    if (perm) { if (n0 < DFF) p0 = (n0 >> 7) * 256 + (n0 & 127); else { const int n1 = n0 - DFF; p0 = (n1 >> 7) * 256 + 128 + (n1 & 127); } }
#pragma unroll 8
    for (int i = 0; i < 32; ++i) { const int kk = 2 * i + (lane >> 5); scr[kk * 33 + (lane & 31)] = W[(size_t)(k0 + kk) * N + n0 + (lane & 31)]; }
    asm volatile("s_waitcnt lgkmcnt(0)" ::: "memory"); __builtin_amdgcn_wave_barrier();
    const int c = lane & 7;
#pragma unroll
    for (int j = 0; j < 4; ++j) { const int n = (lane >> 3) + 8 * j; const LAS float* s = scr + (8 * c) * 33 + n;
        u32x4 o; o.x = pk2(s[0 * 33], s[1 * 33]); o.y = pk2(s[2 * 33], s[3 * 33]); o.z = pk2(s[4 * 33], s[5 * 33]); o.w = pk2(s[6 * 33], s[7 * 33]);
        *(u32x4*)(WT + (size_t)(p0 + n) * K + k0 + 8 * c) = o; }
    asm volatile("s_waitcnt lgkmcnt(0)" ::: "memory"); __builtin_amdgcn_wave_barrier();
}

__device__ __forceinline__ void p0_phase(const Params& P, LAS unsigned char* lds, int tid, int lane, int wave) {
    LAS float* sc = (LAS float*)lds;
    for (int i = tid; i < NBI * DM; i += 512) { const int b = i >> 10, k = i & 1023; const float c = b < 2 ? P.in[5][b * DM + k] : P.in[6][(b - 2) * DM + k]; sc[i] = silu_f(c); }
    __syncthreads();
    const int gw = blockIdx.x * 8 + wave, NGW = gridDim.x * 8;
    float* MOD = (float*)(P.ws + WS_MOD);
    for (int it = gw; it < 768; it += NGW) {
        const int l = it / 192, r = it % 192, cb = r >> 3, kc = r & 7;
        f32x4 acc[NBI];
#pragma unroll
        for (int b = 0; b < NBI; ++b) acc[b] = (f32x4){0.f, 0.f, 0.f, 0.f};
        const float* wp = P.in[9] + ((size_t)l * DM + kc * 128) * NMOD + cb * 256 + lane * 4;
        const LAS float* scp = sc + kc * 128;
#pragma unroll 16
        for (int k = 0; k < 128; ++k) { const f32x4 w = *(const f32x4*)(wp + (size_t)k * NMOD);
#pragma unroll
            for (int b = 0; b < NBI; ++b) acc[b] += scp[b * DM + k] * w; }
        if (kc == 0) { const f32x4 bv = *(const f32x4*)(P.in[10] + (size_t)l * NMOD + cb * 256 + lane * 4);
#pragma unroll
            for (int b = 0; b < NBI; ++b) acc[b] += bv; }
        float* mp = (float*)(P.ws + WS_PART) + ((size_t)kc * DEPTH + l) * NBI * NMOD + cb * 256 + lane * 4;
#pragma unroll
        for (int b = 0; b < NBI; ++b) *(f32x4*)(mp + b * NMOD) = acc[b];
    }
    LAS float* scr = (LAS float*)(lds + 73728 + wave * 8448);
    constexpr int I_IN = 16 * 112, I_OUT = 16 * 32, I_FI = 16 * 176, I_FO = 44 * 32, I_L = I_IN + I_OUT + I_FI + I_FO;
    for (int it = gw; it < DEPTH * I_L; it += NGW) {
        const int l = it / I_L; int r = it % I_L;
        if (r < I_IN) { transpose_item(P.in[11] + (size_t)l * DM * INW, DM, INW, (bf16_t*)(P.ws + WS_WIN) + (size_t)l * INW * DM, scr, r, lane, false); continue; } r -= I_IN;
        if (r < I_OUT) { transpose_item(P.in[14] + (size_t)l * DM * DM, DM, DM, (bf16_t*)(P.ws + WS_WOUT) + (size_t)l * DM * DM, scr, r, lane, false); continue; } r -= I_OUT;
        if (r < I_FI) { transpose_item(P.in[15] + (size_t)l * DM * 2 * DFF, DM, 2 * DFF, (bf16_t*)(P.ws + WS_WFI) + (size_t)l * 2 * DFF * DM, scr, r, lane, true); continue; } r -= I_FI;
        transpose_item(P.in[16] + (size_t)l * DFF * DM, DFF, DM, (bf16_t*)(P.ws + WS_WFO) + (size_t)l * DM * DFF, scr, r, lane, false);
    }
    f32x2* ROPE = (f32x2*)(P.ws + WS_ROPE);
    for (int idx = blockIdx.x * 512 + tid; idx < SEQ * 64; idx += gridDim.x * 512) {
        const int pos = idx >> 6, i = idx & 63;
        const float inv = exp2f(-(float)i * (13.287712379549449f / 64.f));
        const float ang = (float)pos * inv;
        double rev = (double)ang * 0.15915494309189535; rev -= floor(rev);
        const float rf = (float)rev;
        ROPE[idx] = (f32x2){__builtin_amdgcn_cosf(rf), __builtin_amdgcn_sinf(rf)};
    }
}

template <bool FINAL>
__device__ __forceinline__ void norm_phase(const Params& P, int l, bool from_input, const float* gain, int sh_off, int sc_off, int lane, int wave) {
    const int gw = blockIdx.x * 8 + wave, NGW = gridDim.x * 8;
    const float* MOD = (const float*)(P.ws + WS_MOD) + (size_t)l * NBI * NMOD;
    const bf16_t* X = (const bf16_t*)(P.ws + WS_X); bf16_t* H = (bf16_t*)(P.ws + WS_H);
    f32x4 g[4];
#pragma unroll
    for (int j = 0; j < 4; ++j) g[j] = *(const f32x4*)(gain + 4 * lane + 256 * j);
    auto loadrow = [&](int m, f32x4 (&v)[4]) {
        if (!FINAL && from_input) { const float* xr = m < MP ? P.in[0] + (size_t)m * DM : P.in[1] + (size_t)(m - MP) * DM;
#pragma unroll
            for (int j = 0; j < 4; ++j) v[j] = *(const f32x4*)(xr + 4 * lane + 256 * j);
        } else { const bf16_t* xr = X + (size_t)m * DM;
#pragma unroll
            for (int j = 0; j < 4; ++j) v[j] = ldx4(xr + 4 * lane + 256 * j); }
    };
    f32x4 vn[4];
    if (gw < MT) loadrow(gw, vn);
    for (int m = gw; m < MT; m += NGW) {
        f32x4 v[4]; float ss = 0.f;
#pragma unroll
        for (int j = 0; j < 4; ++j) v[j] = vn[j];
        if (m + NGW < MT) loadrow(m + NGW, vn);
        f32x4 sc[4], sh[4];
        if (!FINAL) { const float* mr = MOD + (size_t)batch_of(m) * NMOD;
#pragma unroll
            for (int j = 0; j < 4; ++j) { const int c = 4 * lane + 256 * j; sc[j] = *(const f32x4*)(mr + sc_off + c); sh[j] = *(const f32x4*)(mr + sh_off + c); } }
#pragma unroll
        for (int j = 0; j < 4; ++j) ss += (v[j].x * v[j].x + v[j].y * v[j].y) + (v[j].z * v[j].z + v[j].w * v[j].w);
        const float rstd = rsqrtf(wave_sum(ss) * (1.f / DM) + EPS);
        if (FINAL) {
            float* o = P.out + (size_t)m * DM;
#pragma unroll
            for (int j = 0; j < 4; ++j) *(f32x4*)(o + 4 * lane + 256 * j) = v[j] * rstd * g[j];
        } else {
#pragma unroll
            for (int j = 0; j < 4; ++j) { const int c = 4 * lane + 256 * j;
                const f32x4 hh = v[j] * rstd * g[j] * (1.f + sc[j]) + sh[j];
                u32x2 w; w.x = pk2(hh.x, hh.y); w.y = pk2(hh.z, hh.w);
                *(u32x2*)(H + (size_t)m * DM + c) = w; }
        }
    }
}

__device__ __forceinline__ void sb_unit(const Params& P, int l, int u, LAS unsigned char* lds, int tid, int lane, int wave) {
    const bf16_t* QKV = (const bf16_t*)(P.ws + WS_QKV);
    const int h = wave, l32 = lane & 31, hf = lane >> 5;
    const bool samp = u >= 1024;
    int qrow0, nsteps; const float* ck = nullptr; const float* cv = nullptr;
    if (!samp) { const int b = u >> 9, qb = u & 511; qrow0 = b * SEQ + qb * 32; nsteps = qb + 1; }
    else { const int bs = u - 1024; qrow0 = MP + bs * 32; nsteps = 65; ck = P.in[2] + (size_t)(l * DB + bs) * PAST * 512; cv = P.in[3] + (size_t)(l * DB + bs) * PAST * 512; }
    bf16x8 qf[4];
#pragma unroll
    for (int ks = 0; ks < 4; ++ks) qf[ks] = *(const bf16x8*)(QKV + (size_t)(qrow0 + l32) * INW + h * 64 + ks * 16 + hf * 8);
    f32x16 O0, O1;
#pragma unroll
    for (int r = 0; r < 16; ++r) { O0[r] = 0.f; O1[r] = 0.f; }
    float cum = 0.f;
    LAS unsigned char* vt = lds + 66048 + wave * 4608;
    auto issue = [&](int s, bf16x8 (&k)[4], bf16x8 (&v)[4]) {
        if (!samp || s == 0) {
            const int krow0 = samp ? qrow0 : qrow0 - s * 32;
#pragma unroll
            for (int ks = 0; ks < 4; ++ks) k[ks] = *(const bf16x8*)(QKV + (size_t)(krow0 + l32) * INW + 512 + h * 64 + ks * 16 + hf * 8);
#pragma unroll
            for (int it = 0; it < 4; ++it) { const int id = it * 64 + lane, key = id >> 3, ch = id & 7;
                v[it] = *(const bf16x8*)(QKV + (size_t)(krow0 + key) * INW + 1024 + h * 64 + ch * 8); }
        } else {
            const int kpos0 = (64 - s) * 32;
#pragma unroll
            for (int ks = 0; ks < 4; ++ks) { const float* p = ck + (size_t)(kpos0 + l32) * 512 + h * 64 + ks * 16 + hf * 8; k[ks] = pack8(*(const f32x4*)p, *(const f32x4*)(p + 4)); }
#pragma unroll
            for (int it = 0; it < 4; ++it) { const int id = it * 64 + lane, key = id >> 3, ch = id & 7;
                const float* p = cv + (size_t)(kpos0 + key) * 512 + h * 64 + ch * 8;
                v[it] = pack8(*(const f32x4*)p, *(const f32x4*)(p + 4)); }
        }
    };
    bf16x8 kf[4], vr[4];
    issue(0, kf, vr);
    for (int s = 0; s < nsteps; ++s) {
#pragma unroll
        for (int it = 0; it < 4; ++it) { const int id = it * 64 + lane, key = id >> 3, ch = id & 7; *(LAS bf16x8*)(vt + key * 144 + ch * 16) = vr[it]; }
        bf16x8 kn[4];
#pragma unroll
        for (int ks = 0; ks < 4; ++ks) kn[ks] = kf[ks];
        if (s + 1 < nsteps) issue(s + 1, kn, vr);
        asm volatile("s_waitcnt lgkmcnt(0)" ::: "memory"); __builtin_amdgcn_wave_barrier();
        f32x16 S;
#pragma unroll
        for (int r = 0; r < 16; ++r) S[r] = 0.f;
#pragma unroll
        for (int ks = 0; ks < 4; ++ks) S = MFMA32(kf[ks], qf[ks], S);
        float L[16], lb[16]; bool valid[16];
#pragma unroll
        for (int r = 0; r < 16; ++r) {
            const float z = S[r] * 0.18033688011112042f;
            const float sp = fmaxf(z, 0.f) + __builtin_amdgcn_logf(1.f + __builtin_amdgcn_exp2f(-fabsf(z)));
            const int key = (r >> 2) * 8 + hf * 4 + (r & 3);
            valid[r] = (s != 0) || (key < l32);
            L[r] = valid[r] ? -sp : 0.f; lb[r] = z - sp;
        }
        float T[4], Pp[4];
#pragma unroll
        for (int g = 0; g < 4; ++g) { T[g] = (L[4 * g] + L[4 * g + 1]) + (L[4 * g + 2] + L[4 * g + 3]); Pp[g] = __shfl_xor(T[g], 32); }
        float later[4]; float tot = 0.f;
#pragma unroll
        for (int g = 3; g >= 0; --g) { later[g] = tot; tot += T[g] + Pp[g]; }
        float w[16];
#pragma unroll
        for (int g = 0; g < 4; ++g) {
            const float s3 = cum + later[g] + (hf == 0 ? Pp[g] : 0.f);
            const float s2 = s3 + L[4 * g + 3], s1 = s2 + L[4 * g + 2], s0 = s1 + L[4 * g + 1];
            w[4 * g + 3] = valid[4 * g + 3] ? __builtin_amdgcn_exp2f(lb[4 * g + 3] + s3) : 0.f;
            w[4 * g + 2] = valid[4 * g + 2] ? __builtin_amdgcn_exp2f(lb[4 * g + 2] + s2) : 0.f;
            w[4 * g + 1] = valid[4 * g + 1] ? __builtin_amdgcn_exp2f(lb[4 * g + 1] + s1) : 0.f;
            w[4 * g + 0] = valid[4 * g + 0] ? __builtin_amdgcn_exp2f(lb[4 * g + 0] + s0) : 0.f;
        }
        cum += tot;
#pragma unroll
        for (int c = 0; c < 2; ++c) {
            u32x4 pw; pw.x = pk2(w[8 * c], w[8 * c + 1]); pw.y = pk2(w[8 * c + 2], w[8 * c + 3]); pw.z = pk2(w[8 * c + 4], w[8 * c + 5]); pw.w = pk2(w[8 * c + 6], w[8 * c + 7]);
            const bf16x8 pa = __builtin_bit_cast(bf16x8, pw);
#pragma unroll
            for (int dt = 0; dt < 2; ++dt) {
                bf16x8 vb;
#pragma unroll
                for (int i = 0; i < 8; ++i) { const int key = 16 * c + 8 * (i >> 2) + 4 * hf + (i & 3); vb[i] = *(const LAS short*)(vt + key * 144 + (l32 + 32 * dt) * 2); }
                if (dt == 0) O0 = MFMA32(pa, vb, O0); else O1 = MFMA32(pa, vb, O1);
            }
        }
        asm volatile("" ::: "memory");
        if (__all(cum < -150.f)) break;
#pragma unroll
        for (int ks = 0; ks < 4; ++ks) kf[ks] = kn[ks];
    }
    LAS float* oa = (LAS float*)lds;
#pragma unroll
    for (int r = 0; r < 16; ++r) { const int q = (r >> 2) * 8 + hf * 4 + (r & 3); oa[q * 516 + h * 64 + l32] = O0[r]; oa[q * 516 + h * 64 + 32 + l32] = O1[r]; }
    __syncthreads();
    bf16_t* Ob = (bf16_t*)(P.ws + WS_O);
    const float* gsb = P.in[12] + (size_t)l * 512;
    {
        f32x4 ra[4], rb[4]; float sq[4];
#pragma unroll
        for (int rr = 0; rr < 4; ++rr) { const int q = wave * 4 + rr;
            ra[rr] = *(const LAS f32x4*)(oa + q * 516 + 4 * lane); rb[rr] = *(const LAS f32x4*)(oa + q * 516 + 256 + 4 * lane);
            const f32x4 a = ra[rr], b = rb[rr];
            sq[rr] = (a.x * a.x + a.y * a.y) + (a.z * a.z + a.w * a.w) + (b.x * b.x + b.y * b.y) + (b.z * b.z + b.w * b.w); }
#pragma unroll
        for (int o = 1; o < 64; o <<= 1) {
#pragma unroll
            for (int rr = 0; rr < 4; ++rr) sq[rr] += __shfl_xor(sq[rr], o);
        }
        const f32x4 ga = *(const f32x4*)(gsb + 4 * lane), gb = *(const f32x4*)(gsb + 256 + 4 * lane);
#pragma unroll
        for (int rr = 0; rr < 4; ++rr) { const int q = wave * 4 + rr;
            const float rstd = rsqrtf(sq[rr] * (1.f / 512.f) + EPS);
            const f32x4 ya = ra[rr] * rstd * ga, yb = rb[rr] * rstd * gb;
            u32x2 wa, wb; wa.x = pk2(ya.x, ya.y); wa.y = pk2(ya.z, ya.w); wb.x = pk2(yb.x, yb.y); wb.y = pk2(yb.z, yb.w);
            *(u32x2*)(Ob + (size_t)(qrow0 + q) * DM + 4 * lane) = wa; *(u32x2*)(Ob + (size_t)(qrow0 + q) * DM + 256 + 4 * lane) = wb; }
    }
    __syncthreads();
}

__device__ __forceinline__ void ret_unit(const Params& P, int l, LAS unsigned char* lds, int tid, int lane, int wave,
                                         int row0, int pos0, int nchunks, int L, int h, const float* init, float* outst, bool state_only) {
    const bf16_t* QKV = (const bf16_t*)(P.ws + WS_QKV); bf16_t* Ob = (bf16_t*)(P.ws + WS_O);
    const f32x2* ROPE = (const f32x2*)(P.ws + WS_ROPE);
    const float lg2 = log2f(1.f - exp2f(-5.f - (float)h));
    LAS unsigned char *Qn = lds, *Kn = lds + 17408, *KdT = lds + 34816, *VT = lds + 53248, *SbT = lds + 71680, *Pm = lds + 106496;
    LAS float* of = (LAS float*)lds;
    const int l32 = lane & 31, hf = lane >> 5;
    const int sdt = wave >> 1, set0 = (wave & 1) * 2;
    f32x16 S0, S1;
#pragma unroll
    for (int r = 0; r < 16; ++r) { S0[r] = 0.f; S1[r] = 0.f; }
    if (init) {
        const float* ip = init + (sdt * 32 + hf * 4) * 128 + set0 * 32 + l32;
#pragma unroll
        for (int r = 0; r < 16; ++r) { S0[r] = ip[((r >> 2) * 8 + (r & 3)) * 128]; S1[r] = ip[((r >> 2) * 8 + (r & 3)) * 128 + 32]; if ((r & 3) == 3) asm volatile("" ::: "memory"); }
    }
    if (!state_only) {
#pragma unroll
        for (int g = 0; g < 4; ++g) { const int d0 = sdt * 32 + g * 8 + hf * 4;
            u32x2 a, b; a.x = pk2(S0[4 * g], S0[4 * g + 1]); a.y = pk2(S0[4 * g + 2], S0[4 * g + 3]); b.x = pk2(S1[4 * g], S1[4 * g + 1]); b.y = pk2(S1[4 * g + 2], S1[4 * g + 3]);
            *(LAS u32x2*)(SbT + (set0 * 32 + l32) * 272 + d0 * 2) = a; *(LAS u32x2*)(SbT + ((set0 + 1) * 32 + l32) * 272 + d0 * 2) = b; }
    }
    const float gL = exp2f((float)L * lg2);
    const int lt = wave >> 2, et = wave & 3;
    bf16x8 rk1, rk2, rq1, rq2, rv0, rv1; f32x4 rcs[4];
    const bf16x8 z8 = {0, 0, 0, 0, 0, 0, 0, 0};
    auto issue = [&](int c) {
        const int t = tid >> 3, i0 = (tid & 7) * 8; const bool ok = t < L;
        const size_t row = (size_t)(row0 + c * 64 + t);
        rk1 = z8; rk2 = z8; rq1 = z8; rq2 = z8;
#pragma unroll
        for (int i = 0; i < 4; ++i) rcs[i] = (f32x4){0.f, 0.f, 0.f, 0.f};
        if (ok) {
            rk1 = *(const bf16x8*)(QKV + row * INW + 2048 + h * 128 + i0); rk2 = *(const bf16x8*)(QKV + row * INW + 2048 + h * 128 + 64 + i0);
            if (!state_only) { rq1 = *(const bf16x8*)(QKV + row * INW + 1536 + h * 128 + i0); rq2 = *(const bf16x8*)(QKV + row * INW + 1536 + h * 128 + 64 + i0); }
            const f32x4* rp = (const f32x4*)(ROPE + (size_t)(pos0 + c * 64 + t) * 64 + i0);
#pragma unroll
            for (int i = 0; i < 4; ++i) rcs[i] = rp[i];
        }
        const int t0 = tid >> 4, ch = tid & 15;
        rv0 = z8; rv1 = z8;
        if (t0 < L) rv0 = *(const bf16x8*)(QKV + (size_t)(row0 + c * 64 + t0) * INW + 2560 + h * 128 + ch * 8);
        if (t0 + 32 < L) rv1 = *(const bf16x8*)(QKV + (size_t)(row0 + c * 64 + t0 + 32) * INW + 2560 + h * 128 + ch * 8);
    };
    issue(0);
    const int l32_0 = l32, hf_0 = hf, tid_0 = tid; const float lg2_0 = lg2;
#pragma unroll 1
    for (int c = 0; c < nchunks; ++c) {
        int l32 = l32_0, hf = hf_0, tid = tid_0; float lg2 = lg2_0;
        asm volatile("" : "+v"(l32), "+v"(hf), "+v"(tid), "+v"(lg2));
        {
            const int t = tid >> 3, pc = tid & 7, i0 = pc * 8; const bool ok = t < L;
            const float kd = ok ? __builtin_amdgcn_exp2f((float)(L - 1 - t) * lg2) : 0.f;
            const int tsw = (((t >> 3) ^ pc) << 4) + (t & 7) * 2;
            float cs_c[8], cs_s[8];
#pragma unroll
            for (int i = 0; i < 4; ++i) { cs_c[2 * i] = rcs[i].x; cs_s[2 * i] = rcs[i].y; cs_c[2 * i + 1] = rcs[i].z; cs_s[2 * i + 1] = rcs[i].w; }
            {
                float o1[8], o2[8];
#pragma unroll
                for (int i = 0; i < 8; ++i) { const float x1 = bf2f((unsigned short)rk1[i]), x2 = bf2f((unsigned short)rk2[i]);
                    o1[i] = (x1 * cs_c[i] - x2 * cs_s[i]) * 0.08838834764831845f; o2[i] = (x1 * cs_s[i] + x2 * cs_c[i]) * 0.08838834764831845f; }
                if (!state_only) {
                    u32x4 a, b; a.x = pk2(o1[0], o1[1]); a.y = pk2(o1[2], o1[3]); a.z = pk2(o1[4], o1[5]); a.w = pk2(o1[6], o1[7]);
                    b.x = pk2(o2[0], o2[1]); b.y = pk2(o2[2], o2[3]); b.z = pk2(o2[4], o2[5]); b.w = pk2(o2[6], o2[7]);
                    *(LAS u32x4*)(Kn + t * 272 + i0 * 2) = a; *(LAS u32x4*)(Kn + t * 272 + (64 + i0) * 2) = b;
                }
#pragma unroll
                for (int i = 0; i < 8; ++i) { *(LAS unsigned short*)(KdT + (i0 + i) * 144 + tsw) = (unsigned short)f2bf(o1[i] * kd); *(LAS unsigned short*)(KdT + (64 + i0 + i) * 144 + tsw) = (unsigned short)f2bf(o2[i] * kd); }
            }
            if (!state_only) {
                float o1[8], o2[8];
#pragma unroll
                for (int i = 0; i < 8; ++i) { const float x1 = bf2f((unsigned short)rq1[i]), x2 = bf2f((unsigned short)rq2[i]);
                    o1[i] = x1 * cs_c[i] - x2 * cs_s[i]; o2[i] = x1 * cs_s[i] + x2 * cs_c[i]; }
                u32x4 a, b; a.x = pk2(o1[0], o1[1]); a.y = pk2(o1[2], o1[3]); a.z = pk2(o1[4], o1[5]); a.w = pk2(o1[6], o1[7]);
                b.x = pk2(o2[0], o2[1]); b.y = pk2(o2[2], o2[3]); b.z = pk2(o2[4], o2[5]); b.w = pk2(o2[6], o2[7]);
                *(LAS u32x4*)(Qn + t * 272 + i0 * 2) = a; *(LAS u32x4*)(Qn + t * 272 + (64 + i0) * 2) = b;
            }
            {
                const int t0 = tid >> 4, ch = tid & 15, sw = ch & 7;
                const int o0 = (((t0 >> 3) ^ sw) << 4) + (t0 & 7) * 2, o1b = ((((t0 + 32) >> 3) ^ sw) << 4) + (t0 & 7) * 2;
#pragma unroll
                for (int i = 0; i < 8; ++i) { *(LAS short*)(VT + (ch * 8 + i) * 144 + o0) = rv0[i]; *(LAS short*)(VT + (ch * 8 + i) * 144 + o1b) = rv1[i]; }
            }
        }
        if (c + 1 < nchunks) issue(c + 1);
        unsigned gpre[8];
#pragma unroll
        for (int rr = 0; rr < 8; ++rr) { const int t = wave * 8 + rr; gpre[rr] = (!state_only && t < L) ? *(const unsigned*)(QKV + (size_t)(row0 + c * 64 + t) * INW + 3072 + h * 128 + lane * 2) : 0u; }
        __syncthreads();
        f32x16 acc;
        if (!state_only) {
#pragma unroll
            for (int r = 0; r < 16; ++r) acc[r] = 0.f;
#pragma unroll
            for (int ks = 0; ks < 8; ++ks) { const bf16x8 a = *(const LAS bf16x8*)(Qn + (lt * 32 + l32) * 272 + (ks * 16 + hf * 8) * 2), b = *(const LAS bf16x8*)(SbT + (et * 32 + l32) * 272 + (ks * 16 + hf * 8) * 2); acc = MFMA32(a, b, acc); }
#pragma unroll
            for (int r = 0; r < 16; ++r) { const int tl = lt * 32 + (r >> 2) * 8 + hf * 4 + (r & 3); acc[r] *= __builtin_amdgcn_exp2f((float)(tl + 1) * lg2); }
            if (wave < 4) {
                const int slt = wave >> 1, smt = wave & 1;
                f32x16 sc;
#pragma unroll
                for (int r = 0; r < 16; ++r) sc[r] = 0.f;
                if (slt >= smt) {
#pragma unroll
                    for (int ks = 0; ks < 8; ++ks) { const bf16x8 a = *(const LAS bf16x8*)(Qn + (slt * 32 + l32) * 272 + (ks * 16 + hf * 8) * 2), b = *(const LAS bf16x8*)(Kn + (smt * 32 + l32) * 272 + (ks * 16 + hf * 8) * 2); sc = MFMA32(a, b, sc); }
                }
                const int tm = smt * 32 + l32;
#pragma unroll
                for (int r = 0; r < 16; ++r) { const int tl = slt * 32 + (r >> 2) * 8 + hf * 4 + (r & 3);
                    const float p = tl >= tm ? sc[r] * __builtin_amdgcn_exp2f((float)(tl - tm) * lg2) : 0.f;
                    *(LAS unsigned short*)(Pm + tl * 144 + tm * 2) = (unsigned short)f2bf(p); }
            }
            __syncthreads();
#pragma unroll
            for (int ms = 0; ms < 4; ++ms) { const bf16x8 a = *(const LAS bf16x8*)(Pm + (lt * 32 + l32) * 144 + (ms * 16 + hf * 8) * 2), b = *(const LAS bf16x8*)(VT + (et * 32 + l32) * 144 + (((ms * 2 + hf) ^ ((et * 4 + (l32 >> 3)) & 7)) << 4)); acc = MFMA32(a, b, acc); }
#pragma unroll
            for (int r = 0; r < 16; ++r) { const int tl = lt * 32 + (r >> 2) * 8 + hf * 4 + (r & 3); of[tl * 132 + et * 32 + l32] = acc[r]; }
        }
#pragma unroll
        for (int r = 0; r < 16; ++r) { S0[r] *= gL; S1[r] *= gL; }
#pragma unroll
        for (int ts = 0; ts < 4; ++ts) {
            const int cc = ts * 2 + hf, rs = l32 >> 3;
            const bf16x8 a = *(const LAS bf16x8*)(KdT + (sdt * 32 + l32) * 144 + ((cc ^ ((sdt * 4 + rs) & 7)) << 4));
            const bf16x8 b0 = *(const LAS bf16x8*)(VT + (set0 * 32 + l32) * 144 + ((cc ^ ((set0 * 4 + rs) & 7)) << 4)), b1 = *(const LAS bf16x8*)(VT + ((set0 + 1) * 32 + l32) * 144 + ((cc ^ (((set0 + 1) * 4 + rs) & 7)) << 4));
            S0 = MFMA32(a, b0, S0); S1 = MFMA32(a, b1, S1);
        }
        if (!state_only) {
#pragma unroll
            for (int g = 0; g < 4; ++g) { const int d0 = sdt * 32 + g * 8 + hf * 4;
                u32x2 a, b; a.x = pk2(S0[4 * g], S0[4 * g + 1]); a.y = pk2(S0[4 * g + 2], S0[4 * g + 3]); b.x = pk2(S1[4 * g], S1[4 * g + 1]); b.y = pk2(S1[4 * g + 2], S1[4 * g + 3]);
                *(LAS u32x2*)(SbT + (set0 * 32 + l32) * 272 + d0 * 2) = a; *(LAS u32x2*)(SbT + ((set0 + 1) * 32 + l32) * 272 + d0 * 2) = b; }
            __syncthreads();
            const f32x2 gr = *(const f32x2*)(P.in[13] + (size_t)(l * 4 + h) * 128 + lane * 2);
            f32x2 ov[8]; float sq[8];
#pragma unroll
            for (int rr = 0; rr < 8; ++rr) { ov[rr] = *(const LAS f32x2*)(of + (wave * 8 + rr) * 132 + lane * 2); sq[rr] = ov[rr].x * ov[rr].x + ov[rr].y * ov[rr].y; }
#pragma unroll
            for (int o = 1; o < 64; o <<= 1) {
#pragma unroll
                for (int rr = 0; rr < 8; ++rr) sq[rr] += __shfl_xor(sq[rr], o);
            }
#pragma unroll
            for (int rr = 0; rr < 8; ++rr) {
                const int t = wave * 8 + rr;
                if (t < L) {
                    const float rstd = rsqrtf(sq[rr] * (1.f / 128.f) + EPS);
                    const size_t row = (size_t)(row0 + c * 64 + t);
                    const unsigned gg = gpre[rr];
                    const float y0 = ov[rr].x * rstd * gr.x * silu_f(bf2f(gg & 0xffffu)), y1 = ov[rr].y * rstd * gr.y * silu_f(bf2f(gg >> 16));
                    *(unsigned*)(Ob + row * DM + 512 + h * 128 + lane * 2) = pk2(y0, y1);
                }
            }
        }
        __syncthreads();
    }
    if (outst) {
        float* op = outst + (sdt * 32 + hf * 4) * 128 + set0 * 32 + l32;
#pragma unroll
        for (int r = 0; r < 16; ++r) { op[((r >> 2) * 8 + (r & 3)) * 128] = S0[r]; op[((r >> 2) * 8 + (r & 3)) * 128 + 32] = S1[r]; if ((r & 3) == 3) asm volatile("" ::: "memory"); }
    }
}


#define XB_TMO      128
#define XB_XCNT(j)  (256  + 64 * (j))
#define XB_XSUB(j)  (1280 + 64 * (j))
#define XB_XGEN(j)  (2304 + 64 * (j))
#define XB_TOP      3328
#define XB_TOPGEN   3392
#define XCD_BAR_WORDS 3456
#define XB_SPIN_CAP (1u << 18)

__device__ __forceinline__ unsigned xb_ld(unsigned* p)              { return __hip_atomic_load(p, __ATOMIC_RELAXED, __HIP_MEMORY_SCOPE_AGENT); }
__device__ __forceinline__ unsigned xb_add(unsigned* p, unsigned v) { return __hip_atomic_fetch_add(p, v, __ATOMIC_RELAXED, __HIP_MEMORY_SCOPE_AGENT); }
__device__ __forceinline__ unsigned xb_xcc_id() { return (unsigned)__builtin_amdgcn_s_getreg((3 << 11) | 20) & 0xFu; }
#define XB_SPIN(cond, bar) do { unsigned _sp = 0; while (cond) { __builtin_amdgcn_s_sleep(1); \
    if ((++_sp & 255u) == 0u) { if (xb_ld(&(bar)[XB_TMO])) break; if (_sp > XB_SPIN_CAP) { atomicAdd(&(bar)[XB_TMO], 1u); break; } } } } while (0)

struct XcdBarrier {
    unsigned* bar; unsigned x;
    volatile LAS unsigned* st;
};

__device__ __forceinline__ XcdBarrier xcd_barrier_post(unsigned* bar, volatile LAS unsigned* st) {
    XcdBarrier b; b.bar = bar; b.x = xb_xcc_id(); b.st = st;
    if (threadIdx.x == 0) (void)xb_add(&bar[XB_XCNT(b.x)], 1u);
    return b;
}
__device__ __forceinline__ void xcd_barrier_complete(unsigned* bar, unsigned x, unsigned& nloc, unsigned& nx) {
    const unsigned G = gridDim.x * gridDim.y * gridDim.z;
    unsigned sum, cnt, mine, sp = 0u;
    for (;;) {
        sum = 0u; cnt = 0u; mine = 0u;
#pragma unroll
        for (unsigned j = 0; j < 16; ++j) { const unsigned c = xb_ld(&bar[XB_XCNT(j)]); sum += c; cnt += (c > 0u) ? 1u : 0u; mine = (j == x) ? c : mine; }
        if (sum == G) break;
        __builtin_amdgcn_s_sleep(1);
        if ((++sp & 255u) == 0u) { if (xb_ld(&bar[XB_TMO])) break; if (sp > XB_SPIN_CAP) { atomicAdd(&bar[XB_TMO], 1u); break; } }
    }
    nloc = mine > 0u ? mine : 1u; nx = cnt > 0u ? cnt : 1u;
}

__device__ __forceinline__ void xcd_barrier(const XcdBarrier& b) {
    asm volatile("s_waitcnt vmcnt(0)" ::: "memory");
    __syncthreads();
    if (threadIdx.x == 0) {
        unsigned* bar = b.bar;
        __builtin_amdgcn_s_waitcnt(0);
        unsigned nloc = b.st[0], nx = b.st[1];
        if (nloc == 0u) { xcd_barrier_complete(bar, b.x, nloc, nx); b.st[0] = nloc; b.st[1] = nx; }
        const unsigned old = xb_add(&bar[XB_XSUB(b.x)], 1u);
        const unsigned gen = old / nloc;
        if (old + 1u == (gen + 1u) * nloc) {
            __builtin_amdgcn_fence(__ATOMIC_RELEASE, "agent");
            asm volatile("s_waitcnt vmcnt(0)" ::: "memory");
            const unsigned og = xb_add(&bar[XB_TOP], 1u);
            const unsigned tg = og / nx;
            if (og + 1u == (tg + 1u) * nx) xb_add(&bar[XB_TOPGEN], 1u);
            else XB_SPIN(xb_ld(&bar[XB_TOPGEN]) == tg, bar);
            __builtin_amdgcn_fence(__ATOMIC_ACQUIRE, "agent");
            xb_add(&bar[XB_XGEN(b.x)], 1u);
            asm volatile("s_waitcnt vmcnt(0)" ::: "memory");
        } else {
            XB_SPIN(xb_ld(&bar[XB_XGEN(b.x)]) == gen, bar);
            __builtin_amdgcn_fence(__ATOMIC_ACQUIRE, "agent");
            asm volatile("s_waitcnt vmcnt(0)" ::: "memory");
        }
    }
    __syncthreads();
}
__global__ void __launch_bounds__(512, 2) fwd_megakernel(Params P) {
    extern __shared__ __attribute__((aligned(16))) unsigned char lds_raw[];
    LAS unsigned char* lds = (LAS unsigned char*)lds_raw;
    cg::grid_group grid = cg::this_grid();
    int tid = threadIdx.x, lane = tid & 63, wave = __builtin_amdgcn_readfirstlane(tid >> 6);
#define REFRESH() do { tid = threadIdx.x; asm volatile("" : "+v"(tid)); lane = tid & 63; wave = __builtin_amdgcn_readfirstlane(tid >> 6); } while (0)
    const int G = gridDim.x, bx = blockIdx.x;
    bf16_t* H = (bf16_t*)(P.ws + WS_H); bf16_t* Ob = (bf16_t*)(P.ws + WS_O); bf16_t* QKV = (bf16_t*)(P.ws + WS_QKV); bf16_t* ACT = QKV;
    bf16_t* X = (bf16_t*)(P.ws + WS_X); float* U = (float*)(P.ws + WS_U);
    const float* MOD = (const float*)(P.ws + WS_MOD);

    volatile LAS unsigned* bst = (volatile LAS unsigned*)(lds + LDS_BYTES - 64);
    if (tid == 0) { bst[0] = 0u; bst[1] = 0u; }
    __syncthreads();
    const XcdBarrier xbar = xcd_barrier_post((unsigned*)(P.ws + WS_BAR), bst);
#ifndef SK_P0
    p0_phase(P, lds, tid, lane, wave);
#endif
    xcd_barrier(xbar); REFRESH();
    {
        const f32x4* part = (const f32x4*)(P.ws + WS_PART); f32x4* mod4 = (f32x4*)(P.ws + WS_MOD);
        constexpr int NV = DEPTH * NBI * NMOD / 4;
        for (int i = bx * 512 + tid; i < NV; i += G * 512) {
            f32x4 a = part[i];
#pragma unroll
            for (int kc = 1; kc < 8; ++kc) a += part[(size_t)kc * NV + i];
            mod4[i] = a;
        }
    }
    if (P.ws == nullptr) grid.sync();
    xcd_barrier(xbar); REFRESH();
#pragma unroll 1
    for (int l = 0; l < DEPTH; ++l) {
        norm_phase<false>(P, l, l == 0, P.in[7] + (size_t)l * DM, 0, 1024, lane, wave);
        xcd_barrier(xbar); REFRESH();
#ifndef SK_G1
        {
            pg8::Gemm g{H, (const bf16_t*)(P.ws + WS_WIN) + (size_t)l * INW * DM, MP, INW, DM}; pg8::StaticOrder S; S.init(MP, INW, G, bx);
            EpiQKV E{QKV, P.out, l};
            pg8::gemm_phase<EpiQKV, pg8::StaticOrder, true, true>(lds, g, S, E);
            SEpiQKV SE{QKV, P.out, l};
            sgemm_st_phase<SEpiQKV>(lds, H + (size_t)MP * DM, DM, g.Bt, DM, INW / 64, tid, lane, wave, SE);
        }
#endif
        xcd_barrier(xbar); REFRESH();
        {
            unsigned* qhead = (unsigned*)(P.ws + WS_CTR) + l * 64;
            volatile LAS unsigned* qslot = (volatile LAS unsigned*)(lds + LDS_BYTES - 128);
            for (;;) {
                if (tid == 0) *qslot = __hip_atomic_fetch_add(qhead, 1u, __ATOMIC_RELAXED, __HIP_MEMORY_SCOPE_AGENT);
                __syncthreads();
                const int u = (int)*qslot;
                __syncthreads();
                if (u >= 1360) break;
                if (u < 256) { const int bh = u >> 5, seg = u & 31, b = bh >> 2, h = bh & 3;
                    ret_unit(P, l, lds, tid, lane, wave, b * SEQ + seg * 512, seg * 512, 8, 64, h, nullptr, U + (size_t)(bh * 32 + seg) * 16384, true); }
                else if (u < 272) sb_unit(P, l, 1024 + (u - 256), lds, tid, lane, wave);
                else if (u < 1296) { const int v = u - 272; sb_unit(P, l, (v & 1) * 512 + (511 - (v >> 1)), lds, tid, lane, wave); }
                else { const int idx = u - 1296, bs = idx >> 2, h = idx & 3; const size_t so = ((size_t)(l * DB + bs) * 4 + h) * 16384;
                    ret_unit(P, l, lds, tid, lane, wave, MP + bs * 32, PAST, 1, 32, h, P.in[4] + so, P.out + OFF_RS + so, false); }
            }
        }
        xcd_barrier(xbar); REFRESH();
        for (int idx = bx * 512 + tid; idx < 8 * 16384; idx += G * 512) {
            const int bh = idx >> 14, within = idx & 16383, h = bh & 3;
            const float g512 = exp2f(512.f * log2f(1.f - exp2f(-5.f - (float)h)));
            float* up = U + (size_t)bh * 32 * 16384 + within; float s = 0.f;
            float uv[32];
#pragma unroll
            for (int seg = 0; seg < 32; ++seg) uv[seg] = up[(size_t)seg * 16384];
#pragma unroll
            for (int seg = 0; seg < 32; ++seg) { up[(size_t)seg * 16384] = s; s = g512 * s + uv[seg]; }
            P.out[OFF_RP + ((size_t)l * 8 + bh) * 16384 + within] = s;
        }
        xcd_barrier(xbar); REFRESH();
#ifndef SK_R3
        for (int u = bx; u < 256; u += G) { const int bh = u >> 5, seg = u & 31, b = bh >> 2, h = bh & 3;
            ret_unit(P, l, lds, tid, lane, wave, b * SEQ + seg * 512, seg * 512, 8, 64, h, U + (size_t)(bh * 32 + seg) * 16384, nullptr, false); }
#endif
        xcd_barrier(xbar); REFRESH();
#ifndef SK_G2
        {
            pg8::Gemm g{Ob, (const bf16_t*)(P.ws + WS_WOUT) + (size_t)l * DM * DM, MP, DM, DM}; pg8::StaticOrder S; S.init(MP, DM, G, bx);
            EpiResid E{l == 0 ? P.in[0] : nullptr, l == 0 ? P.in[1] : nullptr, X, MOD + (size_t)l * NBI * NMOD + 2048};
            pg8::gemm_phase<EpiResid, pg8::StaticOrder, true, true>(lds, g, S, E);
            SEpiResid SE{l == 0 ? P.in[1] : nullptr, X + (size_t)MP * DM, MOD + (size_t)l * NBI * NMOD + 2048};
            sgemm_phase<8, 8, SEpiResid>(lds, Ob + (size_t)MP * DM, DM, g.Bt, DM, DM / 64, tid, lane, wave, SE);
        }
#endif
        xcd_barrier(xbar); REFRESH();
        norm_phase<false>(P, l, false, P.in[8] + (size_t)l * DM, 3072, 4096, lane, wave);
        xcd_barrier(xbar); REFRESH();
#ifndef SK_G3
        {
            pg8::Gemm g{H, (const bf16_t*)(P.ws + WS_WFI) + (size_t)l * 2 * DFF * DM, MP, 2 * DFF, DM}; pg8::StaticOrder S; S.init(MP, 2 * DFF, G, bx);
            EpiSwiGLU E{ACT};
            pg8::gemm_phase<EpiSwiGLU, pg8::StaticOrder, true, true>(lds, g, S, E);
            SEpiSwiGLU SE{ACT};
            sgemm_st_phase<SEpiSwiGLU>(lds, H + (size_t)MP * DM, DM, g.Bt, DM, (2 * DFF / 256) * 4, tid, lane, wave, SE);
        }
#endif
        xcd_barrier(xbar); REFRESH();
#ifndef SK_G4
        {
            pg8::Gemm g{ACT, (const bf16_t*)(P.ws + WS_WFO) + (size_t)l * DM * DFF, MP, DM, DFF}; pg8::StaticOrder S; S.init(MP, DM, G, bx);
            EpiResid E{nullptr, nullptr, X, MOD + (size_t)l * NBI * NMOD + 5120};
            pg8::gemm_phase<EpiResid, pg8::StaticOrder, true, true>(lds, g, S, E);
            SEpiResid SE{nullptr, X + (size_t)MP * DM, MOD + (size_t)l * NBI * NMOD + 5120};
            sgemm_phase<22, 11, SEpiResid>(lds, ACT + (size_t)MP * DFF, DFF, g.Bt, DFF, DM / 64, tid, lane, wave, SE);
        }
#endif
        xcd_barrier(xbar); REFRESH();
    }
    norm_phase<true>(P, 0, false, P.in[17], 0, 0, lane, wave);
}

extern "C" void kernel_launch(void* const* d_in, const int* in_sizes, int n_in, void* d_out, int out_size, void* d_ws, size_t ws_size, hipStream_t stream) {
    static int grid = 0;
    if (grid == 0) {
        if (n_in != 18 || ws_size < WS_END) { fprintf(stderr, "kernel_launch: unexpected n_in %d / ws_size %zu\n", n_in, ws_size); grid = -1; return; }
        int dev = 0, cus = 0, per_cu = 0;
        (void)hipGetDevice(&dev); (void)hipDeviceGetAttribute(&cus, hipDeviceAttributeMultiprocessorCount, dev);
        if (hipFuncSetAttribute((const void*)fwd_megakernel, hipFuncAttributeMaxDynamicSharedMemorySize, LDS_BYTES) != hipSuccess) { fprintf(stderr, "kernel_launch: hipFuncSetAttribute failed\n"); grid = -1; return; }
        (void)hipOccupancyMaxActiveBlocksPerMultiprocessor(&per_cu, (const void*)fwd_megakernel, 512, LDS_BYTES);
        (void)hipGetLastError();
        if (per_cu < 1) { fprintf(stderr, "kernel_launch: occupancy query says %d blocks per CU\n", per_cu); per_cu = 1; }
        grid = cus;
    }
    if (grid < 0) return;
    (void)hipMemsetAsync((char*)d_ws + WS_BAR, 0, 20480, stream);
    Params p{};
    for (int i = 0; i < 18; ++i) p.in[i] = (const float*)d_in[i];
    p.out = (float*)d_out; p.ws = (unsigned char*)d_ws;
    void* args[] = {&p};
    hipError_t e = hipLaunchCooperativeKernel((const void*)fwd_megakernel, dim3(grid), dim3(512), args, LDS_BYTES, stream);
    if (e != hipSuccess) fprintf(stderr, "cooperative launch failed: %s (grid %d)\n", hipGetErrorString(e), grid);
}
```

```cpp
#include <hip/hip_runtime.h>
#include <hip/hip_cooperative_groups.h>
#include <cstdio>
#include <cstdint>
namespace cg = cooperative_groups;
namespace pg8 {
#define PG8_LAS __attribute__((address_space(3)))
typedef unsigned short bf16_t;
typedef short bf16x8 __attribute__((ext_vector_type(8)));
typedef float f32x4 __attribute__((ext_vector_type(4)));
typedef unsigned u32x4 __attribute__((ext_vector_type(4)));
constexpr int BM = 256, BK = 64, HALF = 128, HTB = HALF * BK * 2  , STAGE_BYTES = 8 * HTB, NXCD = 8, WGM = 8;

__host__ __device__ __forceinline__ int lds_byte(int r, int c) { const int st = (r >> 4) * 2 + (c >> 5), rr = r & 15, cc = c & 31, ob = rr * 64 + cc * 2; return st * 1024 + (ob ^ (((ob >> 9) & 1) << 5)); }
__host__ __device__ __forceinline__ void stage_rc(int b, int& R, int& C) { const int st = b / 1024, sb = b % 1024, swz = sb ^ (((sb >> 9) & 1) << 5); R = (st >> 1) * 16 + swz / 64; C = (st & 1) * 32 + (swz % 64) / 2; }
__host__ __device__ __forceinline__ int perm32(int rho) { const int n = rho >> 4, i = rho & 15; return 8 * (i >> 2) + 4 * n + (i & 3); }

struct Unit { int pm, pn; };
struct Gemm { const bf16_t* A; const bf16_t* Bt; int M, N, K; };

struct StaticOrder {
    int nM, nN, nwg, G, c;
    __host__ __device__ void init(int M, int N, int G_, int c_) { nM = M / BM; nN = N / BM; nwg = nM * nN; G = G_; c = c_; }
    __host__ __device__ bool next(int i, Unit& u) const {
        const long L = (long)i * G + c; if (L >= nwg) return false;
        int wgid = (int)L; { const int q = nwg / NXCD, r = nwg % NXCD, xcd = wgid % NXCD, off = wgid / NXCD; wgid = (xcd < r ? xcd * (q + 1) : r * (q + 1) + (xcd - r) * q) + off; }
        const int nig = WGM * nN, gid = wgid / nig, fm = gid * WGM, gsz = (nM - fm) < WGM ? (nM - fm) : WGM;
        u.pm = fm + ((wgid % nig) % gsz); u.pn = (wgid % nig) / gsz; return true;
    }
    __device__ __forceinline__ void a_ready(const Unit&) const {}
    __device__ __forceinline__ void done(const Unit&) const {}
};

__device__ __forceinline__ unsigned cvt_pk_bf16(float lo, float hi) { unsigned r; asm volatile("v_cvt_pk_bf16_f32 %0, %1, %2" : "=v"(r) : "v"(lo), "v"(hi)); return r; }
typedef float f32x2 __attribute__((ext_vector_type(2)));
__device__ __forceinline__ f32x2 gelu_pk(f32x2 v) {
    const f32x2 av = __builtin_elementwise_abs(v), d = av * 0.2316418882f + 1.0f;
    f32x2 t; t.x = __builtin_amdgcn_rcpf(d.x); t.y = __builtin_amdgcn_rcpf(d.y);
    f32x2 q = t * 0.5307027145f + (-0.7265760135f); q = q * t + 0.7107068705f; q = q * t + (-0.142248368f); q = q * t + 0.127414796f; q = q * t;
    const f32x2 s = (v * v) * (-0.72134752044f);
    f32x2 e; e.x = __builtin_amdgcn_exp2f(s.x); e.y = __builtin_amdgcn_exp2f(s.y);
    const f32x2 m = v * (q * e), r = v - m;
    f32x2 o; o.x = v.x < 0.f ? m.x : r.x; o.y = v.y < 0.f ? m.y : r.y; return o;
}

template <int ACT  > struct EpiBf16 {
    static constexpr bool PERM = true, AFTER_DRAIN = false; static_assert(ACT == 0 || ACT == 1, "EpiBf16: ACT is 0 (none) or 1 (gelu_pk)");
    bf16_t* O; int ldc; const float* bias; int split_cols; size_t split_stride; float scale0;
    __device__ __forceinline__ void operator()(const f32x4 (&acc)[2][2][4][2], const Unit& u, int wr, int wc, int fr, int fq) const {
        const int row0 = u.pm * BM + wr * 64 + fr; int colt = u.pn * BM; bf16_t* base = O;
        float sc = 1.f; if (split_cols) { const int t = colt / split_cols; base += (size_t)t * split_stride; colt -= t * split_cols; if (t == 0) sc = scale0; }
        const int col0 = colt + wc * 32 + 8 * fq, bcol0 = u.pn * BM + wc * 32 + 8 * fq;
        f32x4 bv[2][2];
#pragma unroll
        for (int bj = 0; bj < 2; ++bj)
#pragma unroll
            for (int n = 0; n < 2; ++n) bv[bj][n] = bias ? *(const f32x4*)(bias + bcol0 + bj * HALF + 4 * n) : (f32x4){0.f, 0.f, 0.f, 0.f};
#pragma unroll
        for (int ai = 0; ai < 2; ++ai)
#pragma unroll
            for (int m = 0; m < 4; ++m) { bf16_t* rowp = base + (size_t)(row0 + ai * HALF + m * 16) * ldc + col0;
#pragma unroll
                for (int bj = 0; bj < 2; ++bj) { f32x4 v0 = acc[ai][bj][m][0] + bv[bj][0], v1 = acc[ai][bj][m][1] + bv[bj][1];
                    if (ACT == 1) { f32x2 a = gelu_pk((f32x2){v0[0], v0[1]}), b = gelu_pk((f32x2){v0[2], v0[3]}), c = gelu_pk((f32x2){v1[0], v1[1]}), d = gelu_pk((f32x2){v1[2], v1[3]});
                        v0 = (f32x4){a.x, a.y, b.x, b.y}; v1 = (f32x4){c.x, c.y, d.x, d.y}; }
                    v0 = v0 * sc; v1 = v1 * sc; u32x4 w; w.x = cvt_pk_bf16(v0[0], v0[1]); w.y = cvt_pk_bf16(v0[2], v0[3]); w.z = cvt_pk_bf16(v1[0], v1[1]); w.w = cvt_pk_bf16(v1[2], v1[3]);
                    *(u32x4*)(rowp + bj * HALF) = w; } }
    }
};
template <class Epi, class Sched, bool ALIGN_EPI = false, bool SP2 = false>
__device__ __forceinline__ void gemm_phase(PG8_LAS unsigned char* lds, const Gemm g, const Sched& S, const Epi& E) {
    int tid_o = threadIdx.x; asm volatile("" : "+v"(tid_o));
    const int tid = tid_o, wid = __builtin_amdgcn_readfirstlane(tid >> 6), lane = tid & 63, wr = wid >> 2, wc = wid & 3, fr = lane & 15, fq = lane >> 4;
    const int K = g.K, nt = K / BK;
    unsigned voffA[2], voffB[2];
#pragma unroll
    for (int i = 0; i < 2; ++i) { int R, C; stage_rc(tid * 16 + i * 8192, R, C); const int Rb = Epi::PERM ? ((R & ~31) + perm32(R & 31)) : R;
        voffA[i] = (unsigned)(R * K + C) * 2u; voffB[i] = (unsigned)(Rb * K + C) * 2u; }
    const size_t kstep = (size_t)(BK * 2);
    const size_t hstep = (size_t)HALF * K * 2;
    const size_t tstep = 2 * hstep;
    const unsigned ldsw = (unsigned)wid * 1024u;
    const int aoff = lds_byte(wr * 64 + fr, fq * 8), boff = lds_byte(wc * 32 + fr, fq * 8);
#define PG8_SA(b, h) (((b) * 2 + (h)) * HTB)
#define PG8_SB(b, h) ((4 + (b) * 2 + (h)) * HTB)
#define PG8_STAGE(bufoff, gbase, voff) do { _Pragma("unroll") for (int _i = 0; _i < 2; ++_i) \
        __builtin_amdgcn_global_load_lds((const unsigned*)((const char*)(gbase) + (voff)[_i]), (PG8_LAS unsigned*)(lds + (bufoff) + ldsw + _i * 8192), 16, 0, 0); } while (0)
#define PG8_LDA(dst, b, h) do { _Pragma("unroll") for (int m = 0; m < 4; ++m) _Pragma("unroll") for (int k = 0; k < 2; ++k) dst[m][k] = *(const PG8_LAS bf16x8*)(lds + PG8_SA(b, h) + aoff + m * 2048 + k * 1024); } while (0)
#define PG8_LDB(dst, b, h) do { _Pragma("unroll") for (int n = 0; n < 2; ++n) _Pragma("unroll") for (int k = 0; k < 2; ++k) dst[n][k] = *(const PG8_LAS bf16x8*)(lds + PG8_SB(b, h) + boff + n * 2048 + k * 1024); } while (0)
#define PG8_MMA(ai, bj, At, Bt) do { __builtin_amdgcn_s_setprio(1); _Pragma("unroll") for (int m = 0; m < 4; ++m) _Pragma("unroll") for (int n = 0; n < 2; ++n) _Pragma("unroll") for (int k = 0; k < 2; ++k) \
        acc[ai][bj][m][n] = __builtin_amdgcn_mfma_f32_16x16x32_bf16(Bt[n][k], At[m][k], acc[ai][bj][m][n], 0, 0, 0); __builtin_amdgcn_s_setprio(0); } while (0)
#define PG8_WAIT_V(n) asm volatile("s_waitcnt vmcnt(" #n ")" ::: "memory")
#define PG8_WAIT_L(n) asm volatile("s_waitcnt lgkmcnt(" #n ")" ::: "memory")
#define PG8_BAR __builtin_amdgcn_s_barrier()
#define PG8_SCHED __builtin_amdgcn_sched_barrier(0)
    Unit cur, nxt; int ui = 0;
    if (!S.next(0, cur)) return;
    f32x4 acc[2][2][4][2];
#pragma unroll
    for (int a = 0; a < 2; ++a)
#pragma unroll
        for (int b = 0; b < 2; ++b)
#pragma unroll
            for (int m = 0; m < 4; ++m)
#pragma unroll
                for (int n = 0; n < 2; ++n) acc[a][b][m][n] = (f32x4){0.f, 0.f, 0.f, 0.f};
    bf16x8 At[4][2], B0[2][2], B1[2][2];
    const char* cA = (const char*)g.A + (size_t)cur.pm * tstep; const char* cB = (const char*)g.Bt + (size_t)cur.pn * tstep;
    S.a_ready(cur);
    if constexpr (SP2) {
        PG8_STAGE(PG8_SB(0, 0), cB, voffB); PG8_STAGE(PG8_SB(0, 1), cB + hstep, voffB); PG8_STAGE(PG8_SA(0, 0), cA, voffA); PG8_STAGE(PG8_SA(0, 1), cA + hstep, voffA);
        if (wr == 1) PG8_BAR;
        PG8_WAIT_V(2); PG8_BAR;
        PG8_STAGE(PG8_SB(1, 0), cB + kstep, voffB); PG8_STAGE(PG8_SA(1, 0), cA + kstep, voffA); PG8_STAGE(PG8_SB(1, 1), cB + hstep + kstep, voffB);
        PG8_WAIT_V(6); PG8_BAR;
    } else {
        PG8_STAGE(PG8_SB(0, 0), cB, voffB); PG8_STAGE(PG8_SA(0, 0), cA, voffA); PG8_STAGE(PG8_SB(0, 1), cB + hstep, voffB); PG8_STAGE(PG8_SA(0, 1), cA + hstep, voffA);
        if (wr == 1) PG8_BAR;
        PG8_WAIT_V(4); PG8_BAR;
        PG8_STAGE(PG8_SB(1, 0), cB + kstep, voffB); PG8_STAGE(PG8_SA(1, 0), cA + kstep, voffA); PG8_STAGE(PG8_SB(1, 1), cB + hstep + kstep, voffB);
        PG8_WAIT_V(6); PG8_BAR;
    }
    for (;;) {
        const bool has_next = S.next(ui + 1, nxt);
        const char* nA = has_next ? (const char*)g.A + (size_t)nxt.pm * tstep : cA; const char* nB = has_next ? (const char*)g.Bt + (size_t)nxt.pn * tstep : cB;
        for (int t = 0; t < nt; t += 2) {
            const bool last = (t == nt - 2);
            const char* a1 = cA + (size_t)(t + 1) * kstep;
            const char* a2 = last ? nA : cA + (size_t)(t + 2) * kstep; const char* b2 = last ? nB : cB + (size_t)(t + 2) * kstep;
            const char* a3 = a2 + kstep; const char* b3 = b2 + kstep;
            if (last && has_next) S.a_ready(nxt);
            if constexpr (SP2) {
            PG8_LDB(B0, 0, 0); PG8_LDB(B1, 0, 1); PG8_SCHED; PG8_LDA(At, 0, 0); PG8_STAGE(PG8_SA(1, 1), a1 + hstep, voffA);
            PG8_WAIT_V(8); PG8_WAIT_L(0); PG8_BAR; PG8_MMA(0, 0, At, B0); PG8_MMA(0, 1, At, B1); PG8_BAR; PG8_SCHED;
            PG8_LDA(At, 0, 1); PG8_STAGE(PG8_SB(0, 0), b2, voffB); PG8_STAGE(PG8_SB(0, 1), b2 + hstep, voffB); PG8_STAGE(PG8_SA(0, 0), a2, voffA);
            PG8_WAIT_V(8); PG8_WAIT_L(0); PG8_BAR; PG8_MMA(1, 0, At, B0); PG8_MMA(1, 1, At, B1); PG8_BAR; PG8_SCHED;
            PG8_LDB(B0, 1, 0); PG8_LDB(B1, 1, 1); PG8_SCHED; PG8_LDA(At, 1, 0); PG8_STAGE(PG8_SA(0, 1), a2 + hstep, voffA);
            PG8_WAIT_V(8); PG8_WAIT_L(0); PG8_BAR; PG8_MMA(0, 0, At, B0); PG8_MMA(0, 1, At, B1); PG8_BAR; PG8_SCHED;
            PG8_LDA(At, 1, 1); PG8_STAGE(PG8_SB(1, 0), b3, voffB); PG8_STAGE(PG8_SB(1, 1), b3 + hstep, voffB); PG8_STAGE(PG8_SA(1, 0), a3, voffA);
            PG8_WAIT_V(8); PG8_WAIT_L(0); PG8_BAR; PG8_MMA(1, 0, At, B0); PG8_MMA(1, 1, At, B1); PG8_BAR; PG8_SCHED;
            } else {
            PG8_LDB(B0, 0, 0); PG8_SCHED; PG8_LDA(At, 0, 0); PG8_STAGE(PG8_SA(1, 1), a1 + hstep, voffA);
            PG8_WAIT_L(8); PG8_BAR; PG8_WAIT_L(0); PG8_MMA(0, 0, At, B0); PG8_BAR; PG8_SCHED;
            PG8_LDB(B1, 0, 1); PG8_STAGE(PG8_SB(0, 0), b2, voffB);
            PG8_BAR; PG8_WAIT_L(0); PG8_MMA(0, 1, At, B1); PG8_BAR;
            PG8_LDA(At, 0, 1); PG8_STAGE(PG8_SA(0, 0), a2, voffA);
            PG8_BAR; PG8_WAIT_L(0); PG8_MMA(1, 0, At, B0); PG8_BAR; PG8_SCHED;
            PG8_STAGE(PG8_SB(0, 1), b2 + hstep, voffB);
            PG8_WAIT_V(6); PG8_BAR; PG8_MMA(1, 1, At, B1); PG8_BAR;
            PG8_LDB(B0, 1, 0); PG8_SCHED; PG8_LDA(At, 1, 0); PG8_STAGE(PG8_SA(0, 1), a2 + hstep, voffA);
            PG8_WAIT_L(8); PG8_BAR; PG8_WAIT_L(0); PG8_MMA(0, 0, At, B0); PG8_BAR; PG8_SCHED;
            PG8_LDB(B1, 1, 1); PG8_STAGE(PG8_SB(1, 0), b3, voffB);
            PG8_BAR; PG8_WAIT_L(0); PG8_MMA(0, 1, At, B1); PG8_BAR;
            PG8_LDA(At, 1, 1); PG8_STAGE(PG8_SA(1, 0), a3, voffA);
            PG8_BAR; PG8_WAIT_L(0); PG8_MMA(1, 0, At, B0); PG8_BAR; PG8_SCHED;
            PG8_STAGE(PG8_SB(1, 1), b3 + hstep, voffB);
            PG8_WAIT_V(6); PG8_BAR; PG8_MMA(1, 1, At, B1); PG8_BAR;
            }
        }
        if constexpr (ALIGN_EPI) { if (wr == 0) PG8_BAR; }
        if constexpr (!Epi::AFTER_DRAIN) { E(acc, cur, wr, wc, fr, fq); S.done(cur); }
        if (!has_next) break;
#pragma unroll
        for (int a = 0; a < 2; ++a)
#pragma unroll
            for (int b = 0; b < 2; ++b)
#pragma unroll
                for (int m = 0; m < 4; ++m)
#pragma unroll
                    for (int n = 0; n < 2; ++n) acc[a][b][m][n] = (f32x4){0.f, 0.f, 0.f, 0.f};
        cur = nxt; cA = nA; cB = nB; ++ui;
        if constexpr (ALIGN_EPI) { if (wr == 1) PG8_BAR; }
    }
    PG8_WAIT_V(0);
    if constexpr (!ALIGN_EPI) { if (wr == 0) PG8_BAR; }
    PG8_BAR;
    if constexpr (Epi::AFTER_DRAIN) { E.fused(acc, cur, wr, wc, fr, fq, lds, wid, lane); S.done(cur); }
#undef PG8_SA
#undef PG8_SB
#undef PG8_STAGE
#undef PG8_LDA
#undef PG8_LDB
#undef PG8_MMA
#undef PG8_WAIT_V
#undef PG8_WAIT_L
#undef PG8_BAR
#undef PG8_SCHED
}
}

#define LAS __attribute__((address_space(3)))
typedef unsigned short bf16_t;
typedef short bf16x8 __attribute__((ext_vector_type(8)));
typedef float f32x4 __attribute__((ext_vector_type(4)));
typedef float f32x2 __attribute__((ext_vector_type(2)));
typedef float f32x16 __attribute__((ext_vector_type(16)));
typedef unsigned u32x4 __attribute__((ext_vector_type(4)));
typedef unsigned u32x2 __attribute__((ext_vector_type(2)));
#define MFMA32(a, b, c) __builtin_amdgcn_mfma_f32_32x32x16_bf16((a), (b), (c), 0, 0, 0)

constexpr int DM = 1024, SEQ = 16384, NBP = 2, DEPTH = 4, DB = 16, DS = 32, PAST = 2048;
constexpr int MP = NBP * SEQ, MS = DB * DS, MT = MP + MS;
constexpr int INW = 3584, DFF = 2816, NMOD = 6144, NBI = 18;
constexpr float EPS = 1e-6f;
constexpr size_t OFF_YP = 0, OFF_YS = 33554432, OFF_KP = 34078720, OFF_VP = 101187584, OFF_RP = 168296448,
                 OFF_KS = 168820736, OFF_VS = 169869312, OFF_RS = 170917888;
constexpr size_t MiB = 1u << 20;
constexpr size_t WS_MOD = 0, MOD_BYTES = 2 * MiB; constexpr size_t WS_CTR = 1820160;
constexpr size_t WS_BAR = 1802240;
constexpr size_t WS_ROPE = 2 * MiB;
constexpr size_t WS_WIN = 10 * MiB, WS_WOUT = 38 * MiB, WS_WFI = 46 * MiB, WS_WFO = 90 * MiB;
constexpr size_t WS_X = 112 * MiB;
constexpr size_t WS_H = 242 * MiB;
constexpr size_t WS_O = 307 * MiB;
constexpr size_t WS_QKV = 372 * MiB;
constexpr size_t WS_U = 600 * MiB;
constexpr size_t WS_PART = 616 * MiB;
constexpr size_t WS_END = 632 * MiB;
constexpr int LDS_BYTES = 147456;

struct Params { const float* in[18]; float* out; unsigned char* ws; };

typedef __bf16 bf16x2_t __attribute__((ext_vector_type(2)));
__device__ __forceinline__ unsigned pk2(float lo, float hi) { const f32x2 v = {lo, hi}; return __builtin_bit_cast(unsigned, __builtin_convertvector(v, bf16x2_t)); }
__device__ __forceinline__ unsigned f2bf(float f) { return pk2(f, 0.f) & 0xffffu; }
__device__ __forceinline__ float bf2f(unsigned h) { return __builtin_bit_cast(float, h << 16); }
__device__ __forceinline__ f32x4 ldx4(const bf16_t* p) { const u32x2 w = *(const u32x2*)p;
    return (f32x4){__builtin_bit_cast(float, w.x << 16), __builtin_bit_cast(float, w.x & 0xffff0000u), __builtin_bit_cast(float, w.y << 16), __builtin_bit_cast(float, w.y & 0xffff0000u)}; }
__device__ __forceinline__ bf16x8 pack8(f32x4 a, f32x4 b) { u32x4 p; p.x = pk2(a.x, a.y); p.y = pk2(a.z, a.w); p.z = pk2(b.x, b.y); p.w = pk2(b.z, b.w); return __builtin_bit_cast(bf16x8, p); }
__device__ __forceinline__ float wave_sum(float v) {
#pragma unroll
    for (int o = 1; o < 64; o <<= 1) v += __shfl_xor(v, o);
    return v;
}
__device__ __forceinline__ float silu_f(float x) { return x * __builtin_amdgcn_rcpf(1.f + __expf(-x)); }
__device__ __forceinline__ int batch_of(int row) { return row < MP ? (row >> 14) : 2 + ((row - MP) >> 5); }

struct EpiQKV {
    static constexpr bool PERM = true, AFTER_DRAIN = false;
    bf16_t* QKV; float* out; int layer;
    __device__ __forceinline__ void operator()(const pg8::f32x4 (&acc)[2][2][4][2], const pg8::Unit& u, int wr, int wc, int fr, int fq) const {
        const int row0 = u.pm * 256 + wr * 64 + fr, col0 = u.pn * 256 + wc * 32 + 8 * fq;
        const bool kv = (u.pn >= 2 && u.pn < 6);
        const size_t vsel = (u.pn >= 4) ? 1 : 0;
        const size_t obase = (u.pm < 128) ? OFF_KP + vsel * (OFF_VP - OFF_KP) + (size_t)layer * MP * 512 + (size_t)row0 * 512
                                          : OFF_KS + vsel * (OFF_VS - OFF_KS) + (size_t)layer * MS * 512 + (size_t)(row0 - MP) * 512;
#pragma unroll
        for (int ai = 0; ai < 2; ++ai)
#pragma unroll
            for (int m = 0; m < 4; ++m) {
                const int row = row0 + ai * 128 + m * 16;
#pragma unroll
                for (int bj = 0; bj < 2; ++bj) {
                    const int col = col0 + bj * 128;
                    const pg8::f32x4 v0 = acc[ai][bj][m][0], v1 = acc[ai][bj][m][1];
                    u32x4 w; w.x = pg8::cvt_pk_bf16(v0[0], v0[1]); w.y = pg8::cvt_pk_bf16(v0[2], v0[3]); w.z = pg8::cvt_pk_bf16(v1[0], v1[1]); w.w = pg8::cvt_pk_bf16(v1[2], v1[3]);
                    *(u32x4*)(QKV + (size_t)row * INW + col) = w;
                    if (kv) {
                        const int c = col & 511;
                        float* dst = out + obase + (size_t)(ai * 128 + m * 16) * 512 + c;
                        *(pg8::f32x4*)dst = v0; *(pg8::f32x4*)(dst + 4) = v1;
                    }
                }
                asm volatile("" ::: "memory");
            }
    }
};
struct EpiResid {
    static constexpr bool PERM = false, AFTER_DRAIN = false;
    const float* base_p; const float* base_s;
    bf16_t* X; const float* gate;
    __device__ __forceinline__ void operator()(const pg8::f32x4 (&acc)[2][2][4][2], const pg8::Unit& u, int wr, int wc, int fr, int fq) const {
        const int col0 = u.pn * 256 + wc * 32 + 4 * fq;
        const bool uni = u.pm < 128;
        pg8::f32x4 gv[4];
        { const float* gr = gate + (size_t)batch_of(u.pm * 256 + wr * 64 + fr) * NMOD;
#pragma unroll
          for (int q = 0; q < 4; ++q) gv[q] = *(const pg8::f32x4*)(gr + col0 + (q >> 1) * 128 + (q & 1) * 16); }
#pragma unroll
        for (int grp = 0; grp < 4; ++grp) {
            const int ai = grp >> 1, m0 = (grp & 1) * 2;
            pg8::f32x4 bv[2][4];
#pragma unroll
            for (int mm = 0; mm < 2; ++mm) {
                const int row = u.pm * 256 + ai * 128 + wr * 64 + (m0 + mm) * 16 + fr;
                if (base_p) { const float* br = row < MP ? base_p + (size_t)row * DM : base_s + (size_t)(row - MP) * DM;
#pragma unroll
                    for (int q = 0; q < 4; ++q) bv[mm][q] = *(const pg8::f32x4*)(br + col0 + (q >> 1) * 128 + (q & 1) * 16);
                } else { const bf16_t* br = X + (size_t)row * DM;
#pragma unroll
                    for (int q = 0; q < 4; ++q) bv[mm][q] = ldx4(br + col0 + (q >> 1) * 128 + (q & 1) * 16); }
            }
#pragma unroll
            for (int mm = 0; mm < 2; ++mm) {
                const int m = m0 + mm, row = u.pm * 256 + ai * 128 + wr * 64 + m * 16 + fr;
                if (!uni) { const float* gr = gate + (size_t)batch_of(row) * NMOD;
#pragma unroll
                    for (int q = 0; q < 4; ++q) gv[q] = *(const pg8::f32x4*)(gr + col0 + (q >> 1) * 128 + (q & 1) * 16); }
                bf16_t* xr = X + (size_t)row * DM;
#pragma unroll
                for (int q = 0; q < 4; ++q) { const int bj = q >> 1, n = q & 1;
                    const pg8::f32x4 xv = bv[mm][q] + gv[q] * acc[ai][bj][m][n];
                    u32x2 w; w.x = pk2(xv[0], xv[1]); w.y = pk2(xv[2], xv[3]); *(u32x2*)(xr + col0 + bj * 128 + n * 16) = w; }
            }
            asm volatile("" ::: "memory");
        }
    }
};
struct EpiSwiGLU {
    static constexpr bool PERM = true, AFTER_DRAIN = false;
    bf16_t* ACT;
    __device__ __forceinline__ void operator()(const pg8::f32x4 (&acc)[2][2][4][2], const pg8::Unit& u, int wr, int wc, int fr, int fq) const {
        const int col0 = u.pn * 128 + wc * 32 + 8 * fq;
#pragma unroll
        for (int ai = 0; ai < 2; ++ai)
#pragma unroll
            for (int m = 0; m < 4; ++m) {
                const int row = u.pm * 256 + ai * 128 + wr * 64 + m * 16 + fr;
                const pg8::f32x4 g0 = acc[ai][0][m][0], g1 = acc[ai][0][m][1], u0 = acc[ai][1][m][0], u1 = acc[ai][1][m][1];
                float r[8];
#pragma unroll
                for (int j = 0; j < 4; ++j) { r[j] = silu_f(g0[j]) * u0[j]; r[4 + j] = silu_f(g1[j]) * u1[j]; }
                u32x4 w; w.x = pg8::cvt_pk_bf16(r[0], r[1]); w.y = pg8::cvt_pk_bf16(r[2], r[3]); w.z = pg8::cvt_pk_bf16(r[4], r[5]); w.w = pg8::cvt_pk_bf16(r[6], r[7]);
                *(u32x4*)(ACT + (size_t)row * DFF + col0) = w;
                asm volatile("" ::: "memory");
            }
    }
};


template <int NKS  , int UNR, class Epi>
__device__ __forceinline__ void sgemm_phase(LAS unsigned char* lds, const bf16_t* A  , int lda, const bf16_t* Bt, int K, int ncb,
                                            int tid, int lane, int wave, const Epi& E) {
    const int l32 = lane & 31, hf = lane >> 5;
    LAS float* red = (LAS float*)lds;
    const int kw0 = wave * NKS * 16 + hf * 8;
    for (int it = blockIdx.x; it < 16 * ncb; it += gridDim.x) {
        const int rb = it & 15, cb = it >> 4;
        int n0, n1; E.cols(cb, n0, n1);
        const bf16_t* ap = A + (size_t)(rb * 32 + l32) * lda + kw0;
        const bf16_t* b0p = Bt + (size_t)(n0 + l32) * K + kw0;
        const bf16_t* b1p = Bt + (size_t)(n1 + l32) * K + kw0;
        f32x16 c0, c1;
#pragma unroll
        for (int r = 0; r < 16; ++r) { c0[r] = 0.f; c1[r] = 0.f; }
#pragma unroll 1
        for (int kb = 0; kb < NKS; kb += UNR) {
            bf16x8 a[UNR], b0[UNR], b1[UNR];
#pragma unroll
            for (int j = 0; j < UNR; ++j) { a[j] = *(const bf16x8*)(ap + (kb + j) * 16); b0[j] = *(const bf16x8*)(b0p + (kb + j) * 16); b1[j] = *(const bf16x8*)(b1p + (kb + j) * 16); }
#pragma unroll
            for (int j = 0; j < UNR; ++j) { c0 = MFMA32(a[j], b0[j], c0); c1 = MFMA32(a[j], b1[j], c1); }
        }
        LAS float* rw = red + wave * 2176;
#pragma unroll
        for (int r = 0; r < 16; ++r) { const int row = (r >> 2) * 8 + hf * 4 + (r & 3); rw[row * 34 + l32] = c0[r]; rw[1088 + row * 34 + l32] = c1[r]; }
        __syncthreads();
        {
            const int row = tid >> 4, cc = (tid & 15) * 2;
            f32x2 g = {0.f, 0.f}, u = {0.f, 0.f};
#pragma unroll
            for (int w = 0; w < 8; ++w) { g += *(const LAS f32x2*)(red + w * 2176 + row * 34 + cc); u += *(const LAS f32x2*)(red + w * 2176 + 1088 + row * 34 + cc); }
            E(rb * 32 + row, n0 + cc, n1 + cc, g, u);
        }
        __syncthreads();
    }
}

template <class Epi>
__device__ __forceinline__ void sgemm_st_phase(LAS unsigned char* lds, const bf16_t* A, int lda, const bf16_t* Bt, int K, int ncb, int tid, int lane, int wave, const Epi& E) {
    const int l32 = lane & 31, hf = lane >> 5, rg = lane >> 3, seg = lane & 7;
    LAS unsigned char* img = lds + wave * 13824;
    const int kw0 = wave * 128;
    for (int it = blockIdx.x; it < 16 * ncb; it += gridDim.x) {
        const int rb = it & 15, cb = it >> 4;
        int n0, n1; E.cols(cb, n0, n1);
        bf16x8 ld[2][12];
#pragma unroll
        for (int h = 0; h < 2; ++h)
#pragma unroll
            for (int q = 0; q < 12; ++q) {
                const int r = (q & 3) * 8 + rg;
                const bf16_t* p = (q < 4) ? A + (size_t)(rb * 32 + r) * lda : Bt + (size_t)((q < 8 ? n0 : n1) + r) * K;
                ld[h][q] = *(const bf16x8*)(p + kw0 + h * 64 + seg * 8);
            }
        f32x16 c0, c1;
#pragma unroll
        for (int r = 0; r < 16; ++r) { c0[r] = 0.f; c1[r] = 0.f; }
#pragma unroll
        for (int h = 0; h < 2; ++h) {
#pragma unroll
            for (int q = 0; q < 12; ++q) *(LAS bf16x8*)(img + (q * 8 + rg) * 144 + seg * 16) = ld[h][q];
            asm volatile("s_waitcnt lgkmcnt(0)" ::: "memory"); __builtin_amdgcn_wave_barrier();
#pragma unroll
            for (int ks = 0; ks < 4; ++ks) {
                const bf16x8 a = *(const LAS bf16x8*)(img + l32 * 144 + ks * 32 + hf * 16), b0 = *(const LAS bf16x8*)(img + (32 + l32) * 144 + ks * 32 + hf * 16), b1 = *(const LAS bf16x8*)(img + (64 + l32) * 144 + ks * 32 + hf * 16);
                c0 = MFMA32(a, b0, c0); c1 = MFMA32(a, b1, c1);
            }
            asm volatile("s_waitcnt lgkmcnt(0)" ::: "memory"); __builtin_amdgcn_wave_barrier();
        }
        LAS float* rw = (LAS float*)img;
#pragma unroll
        for (int r = 0; r < 16; ++r) { const int row = (r >> 2) * 8 + hf * 4 + (r & 3); rw[row * 34 + l32] = c0[r]; rw[1088 + row * 34 + l32] = c1[r]; }
        __syncthreads();
        {
            const int row = tid >> 4, cc = (tid & 15) * 2;
            f32x2 g = {0.f, 0.f}, u = {0.f, 0.f};
#pragma unroll
            for (int w = 0; w < 8; ++w) { const LAS float* p = (const LAS float*)(lds + w * 13824) + row * 34 + cc; g += *(const LAS f32x2*)(p); u += *(const LAS f32x2*)(p + 1088); }
            E(rb * 32 + row, n0 + cc, n1 + cc, g, u);
        }
        __syncthreads();
    }
}
struct SEpiQKV {
    bf16_t* QKV; float* out; int layer;
    __device__ __forceinline__ void cols(int cb, int& n0, int& n1) const { n0 = cb * 64; n1 = n0 + 32; }
    __device__ __forceinline__ void emit(int r, int c, f32x2 v) const {
        *(unsigned*)(QKV + (size_t)(MP + r) * INW + c) = pk2(v.x, v.y);
        if (c >= 512 && c < 1536) { const size_t off = (c < 1024 ? OFF_KS : OFF_VS) + ((size_t)layer * MS + r) * 512 + (c & 511); *(f32x2*)(out + off) = v; }
    }
    __device__ __forceinline__ void operator()(int r, int c0, int c1, f32x2 g, f32x2 u) const { emit(r, c0, g); emit(r, c1, u); }
};
struct SEpiResid {
    const float* basef; bf16_t* Xs; const float* gate;
    __device__ __forceinline__ void cols(int cb, int& n0, int& n1) const { n0 = cb * 64; n1 = n0 + 32; }
    __device__ __forceinline__ void operator()(int r, int c0, int c1, f32x2 g, f32x2 u) const {
        const float* gp = gate + (size_t)(2 + (r >> 5)) * NMOD; bf16_t* xp = Xs + (size_t)r * DM;
        f32x2 b0, b1;
        if (basef) { b0 = *(const f32x2*)(basef + (size_t)r * DM + c0); b1 = *(const f32x2*)(basef + (size_t)r * DM + c1); }
        else { const unsigned w0 = *(const unsigned*)(xp + c0), w1 = *(const unsigned*)(xp + c1);
            b0 = (f32x2){__builtin_bit_cast(float, w0 << 16), __builtin_bit_cast(float, w0 & 0xffff0000u)}; b1 = (f32x2){__builtin_bit_cast(float, w1 << 16), __builtin_bit_cast(float, w1 & 0xffff0000u)}; }
        const f32x2 x0 = b0 + *(const f32x2*)(gp + c0) * g, x1 = b1 + *(const f32x2*)(gp + c1) * u;
        *(unsigned*)(xp + c0) = pk2(x0.x, x0.y); *(unsigned*)(xp + c1) = pk2(x1.x, x1.y);
    }
};
struct SEpiSwiGLU {
    bf16_t* ACT;
    __device__ __forceinline__ void cols(int cb, int& n0, int& n1) const { n0 = (cb >> 2) * 256 + (cb & 3) * 32; n1 = n0 + 128; }
    __device__ __forceinline__ void operator()(int r, int c0, int c1, f32x2 g, f32x2 u) const {
        const int col = (c0 >> 8) * 128 + (c0 & 127);
        *(unsigned*)(ACT + (size_t)(MP + r) * DFF + col) = pk2(silu_f(g.x) * u.x, silu_f(g.y) * u.y);
    }
};

__device__ __forceinline__ void transpose_item(const float* W, int K, int N, bf16_t* WT, LAS float* scr, int item, int lane, bool perm) {
    const int nblk = N / 32, kb = item / nblk, nb = item % nblk, k0 = 64 * kb, n0 = 32 * nb;
    int p0 = n0;
    if (perm) { if (n0 < DFF) p0 = (n0 >> 7) * 256 + (n0 & 127); else { const int n1 = n0 - DFF; p0 = (n1 >> 7) * 256 + 128 + (n1 & 127); } }
#pragma unroll 8
    for (int i = 0; i < 32; ++i) { const int kk = 2 * i + (lane >> 5); scr[kk * 33 + (lane & 31)] = W[(size_t)(k0 + kk) * N + n0 + (lane & 31)]; }
    asm volatile("s_waitcnt lgkmcnt(0)" ::: "memory"); __builtin_amdgcn_wave_barrier();
    const int c = lane & 7;
#pragma unroll
    for (int j = 0; j < 4; ++j) { const int n = (lane >> 3) + 8 * j; const LAS float* s = scr + (8 * c) * 33 + n;
        u32x4 o; o.x = pk2(s[0 * 33], s[1 * 33]); o.y = pk2(s[2 * 33], s[3 * 33]); o.z = pk2(s[4 * 33], s[5 * 33]); o.w = pk2(s[6 * 33], s[7 * 33]);
        *(u32x4*)(WT + (size_t)(p0 + n) * K + k0 + 8 * c) = o; }
    asm volatile("s_waitcnt lgkmcnt(0)" ::: "memory"); __builtin_amdgcn_wave_barrier();
}

__device__ __forceinline__ void p0_phase(const Params& P, LAS unsigned char* lds, int tid, int lane, int wave) {
    LAS float* sc = (LAS float*)lds;
    for (int i = tid; i < NBI * DM; i += 512) { const int b = i >> 10, k = i & 1023; const float c = b < 2 ? P.in[5][b * DM + k] : P.in[6][(b - 2) * DM + k]; sc[i] = silu_f(c); }
    __syncthreads();
    const int gw = blockIdx.x * 8 + wave, NGW = gridDim.x * 8;
    float* MOD = (float*)(P.ws + WS_MOD);
    for (int it = gw; it < 768; it += NGW) {
        const int l = it / 192, r = it % 192, cb = r >> 3, kc = r & 7;
        f32x4 acc[NBI];
#pragma unroll
        for (int b = 0; b < NBI; ++b) acc[b] = (f32x4){0.f, 0.f, 0.f, 0.f};
        const float* wp = P.in[9] + ((size_t)l * DM + kc * 128) * NMOD + cb * 256 + lane * 4;
        const LAS float* scp = sc + kc * 128;
#pragma unroll 16
        for (int k = 0; k < 128; ++k) { const f32x4 w = *(const f32x4*)(wp + (size_t)k * NMOD);
#pragma unroll
            for (int b = 0; b < NBI; ++b) acc[b] += scp[b * DM + k] * w; }
        if (kc == 0) { const f32x4 bv = *(const f32x4*)(P.in[10] + (size_t)l * NMOD + cb * 256 + lane * 4);
#pragma unroll
            for (int b = 0; b < NBI; ++b) acc[b] += bv; }
        float* mp = (float*)(P.ws + WS_PART) + ((size_t)kc * DEPTH + l) * NBI * NMOD + cb * 256 + lane * 4;
#pragma unroll
        for (int b = 0; b < NBI; ++b) *(f32x4*)(mp + b * NMOD) = acc[b];
    }
    LAS float* scr = (LAS float*)(lds + 73728 + wave * 8448);
    constexpr int I_IN = 16 * 112, I_OUT = 16 * 32, I_FI = 16 * 176, I_FO = 44 * 32, I_L = I_IN + I_OUT + I_FI + I_FO;
    for (int it = gw; it < DEPTH * I_L; it += NGW) {
        const int l = it / I_L; int r = it % I_L;
        if (r < I_IN) { transpose_item(P.in[11] + (size_t)l * DM * INW, DM, INW, (bf16_t*)(P.ws + WS_WIN) + (size_t)l * INW * DM, scr, r, lane, false); continue; } r -= I_IN;
        if (r < I_OUT) { transpose_item(P.in[14] + (size_t)l * DM * DM, DM, DM, (bf16_t*)(P.ws + WS_WOUT) + (size_t)l * DM * DM, scr, r, lane, false); continue; } r -= I_OUT;
        if (r < I_FI) { transpose_item(P.in[15] + (size_t)l * DM * 2 * DFF, DM, 2 * DFF, (bf16_t*)(P.ws + WS_WFI) + (size_t)l * 2 * DFF * DM, scr, r, lane, true); continue; } r -= I_FI;
        transpose_item(P.in[16] + (size_t)l * DFF * DM, DFF, DM, (bf16_t*)(P.ws + WS_WFO) + (size_t)l * DM * DFF, scr, r, lane, false);
    }
    f32x2* ROPE = (f32x2*)(P.ws + WS_ROPE);
    for (int idx = blockIdx.x * 512 + tid; idx < SEQ * 64; idx += gridDim.x * 512) {
        const int pos = idx >> 6, i = idx & 63;
        const float inv = exp2f(-(float)i * (13.287712379549449f / 64.f));
        const float ang = (float)pos * inv;
        double rev = (double)ang * 0.15915494309189535; rev -= floor(rev);
        const float rf = (float)rev;
        ROPE[idx] = (f32x2){__builtin_amdgcn_cosf(rf), __builtin_amdgcn_sinf(rf)};
    }
}

template <bool FINAL>
__device__ __forceinline__ void norm_phase(const Params& P, int l, bool from_input, const float* gain, int sh_off, int sc_off, int lane, int wave) {
    const int gw = blockIdx.x * 8 + wave, NGW = gridDim.x * 8;
    const float* MOD = (const float*)(P.ws + WS_MOD) + (size_t)l * NBI * NMOD;
    const bf16_t* X = (const bf16_t*)(P.ws + WS_X); bf16_t* H = (bf16_t*)(P.ws + WS_H);
    f32x4 g[4];
#pragma unroll
    for (int j = 0; j < 4; ++j) g[j] = *(const f32x4*)(gain + 4 * lane + 256 * j);
    auto loadrow = [&](int m, f32x4 (&v)[4]) {
        if (!FINAL && from_input) { const float* xr = m < MP ? P.in[0] + (size_t)m * DM : P.in[1] + (size_t)(m - MP) * DM;
#pragma unroll
            for (int j = 0; j < 4; ++j) v[j] = *(const f32x4*)(xr + 4 * lane + 256 * j);
        } else { const bf16_t* xr = X + (size_t)m * DM;
#pragma unroll
            for (int j = 0; j < 4; ++j) v[j] = ldx4(xr + 4 * lane + 256 * j); }
    };
    f32x4 vn[4];
    if (gw < MT) loadrow(gw, vn);
    for (int m = gw; m < MT; m += NGW) {
        f32x4 v[4]; float ss = 0.f;
#pragma unroll
        for (int j = 0; j < 4; ++j) v[j] = vn[j];
        if (m + NGW < MT) loadrow(m + NGW, vn);
        f32x4 sc[4], sh[4];
        if (!FINAL) { const float* mr = MOD + (size_t)batch_of(m) * NMOD;
#pragma unroll
            for (int j = 0; j < 4; ++j) { const int c = 4 * lane + 256 * j; sc[j] = *(const f32x4*)(mr + sc_off + c); sh[j] = *(const f32x4*)(mr + sh_off + c); } }
#pragma unroll
        for (int j = 0; j < 4; ++j) ss += (v[j].x * v[j].x + v[j].y * v[j].y) + (v[j].z * v[j].z + v[j].w * v[j].w);
        const float rstd = rsqrtf(wave_sum(ss) * (1.f / DM) + EPS);
        if (FINAL) {
            float* o = P.out + (size_t)m * DM;
#pragma unroll
            for (int j = 0; j < 4; ++j) *(f32x4*)(o + 4 * lane + 256 * j) = v[j] * rstd * g[j];
        } else {
#pragma unroll
            for (int j = 0; j < 4; ++j) { const int c = 4 * lane + 256 * j;
                const f32x4 hh = v[j] * rstd * g[j] * (1.f + sc[j]) + sh[j];
                u32x2 w; w.x = pk2(hh.x, hh.y); w.y = pk2(hh.z, hh.w);
                *(u32x2*)(H + (size_t)m * DM + c) = w; }
        }
    }
}

__device__ __forceinline__ void sb_unit(const Params& P, int l, int u, LAS unsigned char* lds, int tid, int lane, int wave) {
    const bf16_t* QKV = (const bf16_t*)(P.ws + WS_QKV);
    const int h = wave, l32 = lane & 31, hf = lane >> 5;
    const bool samp = u >= 1024;
    int qrow0, nsteps; const float* ck = nullptr; const float* cv = nullptr;
    if (!samp) { const int b = u >> 9, qb = u & 511; qrow0 = b * SEQ + qb * 32; nsteps = qb + 1; }
    else { const int bs = u - 1024; qrow0 = MP + bs * 32; nsteps = 65; ck = P.in[2] + (size_t)(l * DB + bs) * PAST * 512; cv = P.in[3] + (size_t)(l * DB + bs) * PAST * 512; }
    bf16x8 qf[4];
#pragma unroll
    for (int ks = 0; ks < 4; ++ks) qf[ks] = *(const bf16x8*)(QKV + (size_t)(qrow0 + l32) * INW + h * 64 + ks * 16 + hf * 8);
    f32x16 O0, O1;
#pragma unroll
    for (int r = 0; r < 16; ++r) { O0[r] = 0.f; O1[r] = 0.f; }
    float cum = 0.f;
    LAS unsigned char* vt = lds + 66048 + wave * 4608;
    auto issue = [&](int s, bf16x8 (&k)[4], bf16x8 (&v)[4]) {
        if (!samp || s == 0) {
            const int krow0 = samp ? qrow0 : qrow0 - s * 32;
#pragma unroll
            for (int ks = 0; ks < 4; ++ks) k[ks] = *(const bf16x8*)(QKV + (size_t)(krow0 + l32) * INW + 512 + h * 64 + ks * 16 + hf * 8);
#pragma unroll
            for (int it = 0; it < 4; ++it) { const int id = it * 64 + lane, key = id >> 3, ch = id & 7;
                v[it] = *(const bf16x8*)(QKV + (size_t)(krow0 + key) * INW + 1024 + h * 64 + ch * 8); }
        } else {
            const int kpos0 = (64 - s) * 32;
#pragma unroll
            for (int ks = 0; ks < 4; ++ks) { const float* p = ck + (size_t)(kpos0 + l32) * 512 + h * 64 + ks * 16 + hf * 8; k[ks] = pack8(*(const f32x4*)p, *(const f32x4*)(p + 4)); }
#pragma unroll
            for (int it = 0; it < 4; ++it) { const int id = it * 64 + lane, key = id >> 3, ch = id & 7;
                const float* p = cv + (size_t)(kpos0 + key) * 512 + h * 64 + ch * 8;
                v[it] = pack8(*(const f32x4*)p, *(const f32x4*)(p + 4)); }
        }
    };
    bf16x8 kf[4], vr[4];
    issue(0, kf, vr);
    for (int s = 0; s < nsteps; ++s) {
#pragma unroll
        for (int it = 0; it < 4; ++it) { const int id = it * 64 + lane, key = id >> 3, ch = id & 7; *(LAS bf16x8*)(vt + key * 144 + ch * 16) = vr[it]; }
        bf16x8 kn[4];
#pragma unroll
        for (int ks = 0; ks < 4; ++ks) kn[ks] = kf[ks];
        if (s + 1 < nsteps) issue(s + 1, kn, vr);
        asm volatile("s_waitcnt lgkmcnt(0)" ::: "memory"); __builtin_amdgcn_wave_barrier();
        f32x16 S;
#pragma unroll
        for (int r = 0; r < 16; ++r) S[r] = 0.f;
#pragma unroll
        for (int ks = 0; ks < 4; ++ks) S = MFMA32(kf[ks], qf[ks], S);
        float L[16], lb[16]; bool valid[16];
#pragma unroll
        for (int r = 0; r < 16; ++r) {
            const float z = S[r] * 0.18033688011112042f;
            const float sp = fmaxf(z, 0.f) + __builtin_amdgcn_logf(1.f + __builtin_amdgcn_exp2f(-fabsf(z)));
            const int key = (r >> 2) * 8 + hf * 4 + (r & 3);
            valid[r] = (s != 0) || (key < l32);
            L[r] = valid[r] ? -sp : 0.f; lb[r] = z - sp;
        }
        float T[4], Pp[4];
#pragma unroll
        for (int g = 0; g < 4; ++g) { T[g] = (L[4 * g] + L[4 * g + 1]) + (L[4 * g + 2] + L[4 * g + 3]); Pp[g] = __shfl_xor(T[g], 32); }
        float later[4]; float tot = 0.f;
#pragma unroll
        for (int g = 3; g >= 0; --g) { later[g] = tot; tot += T[g] + Pp[g]; }
        float w[16];
#pragma unroll
        for (int g = 0; g < 4; ++g) {
            const float s3 = cum + later[g] + (hf == 0 ? Pp[g] : 0.f);
            const float s2 = s3 + L[4 * g + 3], s1 = s2 + L[4 * g + 2], s0 = s1 + L[4 * g + 1];
            w[4 * g + 3] = valid[4 * g + 3] ? __builtin_amdgcn_exp2f(lb[4 * g + 3] + s3) : 0.f;
            w[4 * g + 2] = valid[4 * g + 2] ? __builtin_amdgcn_exp2f(lb[4 * g + 2] + s2) : 0.f;
            w[4 * g + 1] = valid[4 * g + 1] ? __builtin_amdgcn_exp2f(lb[4 * g + 1] + s1) : 0.f;
            w[4 * g + 0] = valid[4 * g + 0] ? __builtin_amdgcn_exp2f(lb[4 * g + 0] + s0) : 0.f;
        }
        cum += tot;
#pragma unroll
        for (int c = 0; c < 2; ++c) {
            u32x4 pw; pw.x = pk2(w[8 * c], w[8 * c + 1]); pw.y = pk2(w[8 * c + 2], w[8 * c + 3]); pw.z = pk2(w[8 * c + 4], w[8 * c + 5]); pw.w = pk2(w[8 * c + 6], w[8 * c + 7]);
            const bf16x8 pa = __builtin_bit_cast(bf16x8, pw);
#pragma unroll
            for (int dt = 0; dt < 2; ++dt) {
                bf16x8 vb;
#pragma unroll
                for (int i = 0; i < 8; ++i) { const int key = 16 * c + 8 * (i >> 2) + 4 * hf + (i & 3); vb[i] = *(const LAS short*)(vt + key * 144 + (l32 + 32 * dt) * 2); }
                if (dt == 0) O0 = MFMA32(pa, vb, O0); else O1 = MFMA32(pa, vb, O1);
            }
        }
        asm volatile("" ::: "memory");
        if (__all(cum < -150.f)) break;
#pragma unroll
        for (int ks = 0; ks < 4; ++ks) kf[ks] = kn[ks];
    }
    LAS float* oa = (LAS float*)lds;
#pragma unroll
    for (int r = 0; r < 16; ++r) { const int q = (r >> 2) * 8 + hf * 4 + (r & 3); oa[q * 516 + h * 64 + l32] = O0[r]; oa[q * 516 + h * 64 + 32 + l32] = O1[r]; }
    __syncthreads();
    bf16_t* Ob = (bf16_t*)(P.ws + WS_O);
    const float* gsb = P.in[12] + (size_t)l * 512;
    {
        f32x4 ra[4], rb[4]; float sq[4];
#pragma unroll
        for (int rr = 0; rr < 4; ++rr) { const int q = wave * 4 + rr;
            ra[rr] = *(const LAS f32x4*)(oa + q * 516 + 4 * lane); rb[rr] = *(const LAS f32x4*)(oa + q * 516 + 256 + 4 * lane);
            const f32x4 a = ra[rr], b = rb[rr];
            sq[rr] = (a.x * a.x + a.y * a.y) + (a.z * a.z + a.w * a.w) + (b.x * b.x + b.y * b.y) + (b.z * b.z + b.w * b.w); }
#pragma unroll
        for (int o = 1; o < 64; o <<= 1) {
#pragma unroll
            for (int rr = 0; rr < 4; ++rr) sq[rr] += __shfl_xor(sq[rr], o);
        }
        const f32x4 ga = *(const f32x4*)(gsb + 4 * lane), gb = *(const f32x4*)(gsb + 256 + 4 * lane);
#pragma unroll
        for (int rr = 0; rr < 4; ++rr) { const int q = wave * 4 + rr;
            const float rstd = rsqrtf(sq[rr] * (1.f / 512.f) + EPS);
            const f32x4 ya = ra[rr] * rstd * ga, yb = rb[rr] * rstd * gb;
            u32x2 wa, wb; wa.x = pk2(ya.x, ya.y); wa.y = pk2(ya.z, ya.w); wb.x = pk2(yb.x, yb.y); wb.y = pk2(yb.z, yb.w);
            *(u32x2*)(Ob + (size_t)(qrow0 + q) * DM + 4 * lane) = wa; *(u32x2*)(Ob + (size_t)(qrow0 + q) * DM + 256 + 4 * lane) = wb; }
    }
    __syncthreads();
}

__device__ __forceinline__ void ret_unit(const Params& P, int l, LAS unsigned char* lds, int tid, int lane, int wave,
                                         int row0, int pos0, int nchunks, int L, int h, const float* init, float* outst, bool state_only) {
    const bf16_t* QKV = (const bf16_t*)(P.ws + WS_QKV); bf16_t* Ob = (bf16_t*)(P.ws + WS_O);
    const f32x2* ROPE = (const f32x2*)(P.ws + WS_ROPE);
    const float lg2 = log2f(1.f - exp2f(-5.f - (float)h));
    LAS unsigned char *Qn = lds, *Kn = lds + 17408, *KdT = lds + 34816, *VT = lds + 53248, *SbT = lds + 71680, *Pm = lds + 106496;
    LAS float* of = (LAS float*)lds;
    const int l32 = lane & 31, hf = lane >> 5;
    const int sdt = wave >> 1, set0 = (wave & 1) * 2;
    f32x16 S0, S1;
#pragma unroll
    for (int r = 0; r < 16; ++r) { S0[r] = 0.f; S1[r] = 0.f; }
    if (init) {
        const float* ip = init + (sdt * 32 + hf * 4) * 128 + set0 * 32 + l32;
#pragma unroll
        for (int r = 0; r < 16; ++r) { S0[r] = ip[((r >> 2) * 8 + (r & 3)) * 128]; S1[r] = ip[((r >> 2) * 8 + (r & 3)) * 128 + 32]; if ((r & 3) == 3) asm volatile("" ::: "memory"); }
    }
    if (!state_only) {
#pragma unroll
        for (int g = 0; g < 4; ++g) { const int d0 = sdt * 32 + g * 8 + hf * 4;
            u32x2 a, b; a.x = pk2(S0[4 * g], S0[4 * g + 1]); a.y = pk2(S0[4 * g + 2], S0[4 * g + 3]); b.x = pk2(S1[4 * g], S1[4 * g + 1]); b.y = pk2(S1[4 * g + 2], S1[4 * g + 3]);
            *(LAS u32x2*)(SbT + (set0 * 32 + l32) * 272 + d0 * 2) = a; *(LAS u32x2*)(SbT + ((set0 + 1) * 32 + l32) * 272 + d0 * 2) = b; }
    }
    const float gL = exp2f((float)L * lg2);
    const int lt = wave >> 2, et = wave & 3;
    bf16x8 rk1, rk2, rq1, rq2, rv0, rv1; f32x4 rcs[4];
    const bf16x8 z8 = {0, 0, 0, 0, 0, 0, 0, 0};
    auto issue = [&](int c) {
        const int t = tid >> 3, i0 = (tid & 7) * 8; const bool ok = t < L;
        const size_t row = (size_t)(row0 + c * 64 + t);
        rk1 = z8; rk2 = z8; rq1 = z8; rq2 = z8;
#pragma unroll
        for (int i = 0; i < 4; ++i) rcs[i] = (f32x4){0.f, 0.f, 0.f, 0.f};
        if (ok) {
            rk1 = *(const bf16x8*)(QKV + row * INW + 2048 + h * 128 + i0); rk2 = *(const bf16x8*)(QKV + row * INW + 2048 + h * 128 + 64 + i0);
            if (!state_only) { rq1 = *(const bf16x8*)(QKV + row * INW + 1536 + h * 128 + i0); rq2 = *(const bf16x8*)(QKV + row * INW + 1536 + h * 128 + 64 + i0); }
            const f32x4* rp = (const f32x4*)(ROPE + (size_t)(pos0 + c * 64 + t) * 64 + i0);
#pragma unroll
            for (int i = 0; i < 4; ++i) rcs[i] = rp[i];
        }
        const int t0 = tid >> 4, ch = tid & 15;
        rv0 = z8; rv1 = z8;
        if (t0 < L) rv0 = *(const bf16x8*)(QKV + (size_t)(row0 + c * 64 + t0) * INW + 2560 + h * 128 + ch * 8);
        if (t0 + 32 < L) rv1 = *(const bf16x8*)(QKV + (size_t)(row0 + c * 64 + t0 + 32) * INW + 2560 + h * 128 + ch * 8);
    };
    issue(0);
    const int l32_0 = l32, hf_0 = hf, tid_0 = tid; const float lg2_0 = lg2;
#pragma unroll 1
    for (int c = 0; c < nchunks; ++c) {
        int l32 = l32_0, hf = hf_0, tid = tid_0; float lg2 = lg2_0;
        asm volatile("" : "+v"(l32), "+v"(hf), "+v"(tid), "+v"(lg2));
        {
            const int t = tid >> 3, pc = tid & 7, i0 = pc * 8; const bool ok = t < L;
            const float kd = ok ? __builtin_amdgcn_exp2f((float)(L - 1 - t) * lg2) : 0.f;
            const int tsw = (((t >> 3) ^ pc) << 4) + (t & 7) * 2;
            float cs_c[8], cs_s[8];
#pragma unroll
            for (int i = 0; i < 4; ++i) { cs_c[2 * i] = rcs[i].x; cs_s[2 * i] = rcs[i].y; cs_c[2 * i + 1] = rcs[i].z; cs_s[2 * i + 1] = rcs[i].w; }
            {
                float o1[8], o2[8];
#pragma unroll
                for (int i = 0; i < 8; ++i) { const float x1 = bf2f((unsigned short)rk1[i]), x2 = bf2f((unsigned short)rk2[i]);
                    o1[i] = (x1 * cs_c[i] - x2 * cs_s[i]) * 0.08838834764831845f; o2[i] = (x1 * cs_s[i] + x2 * cs_c[i]) * 0.08838834764831845f; }
                if (!state_only) {
                    u32x4 a, b; a.x = pk2(o1[0], o1[1]); a.y = pk2(o1[2], o1[3]); a.z = pk2(o1[4], o1[5]); a.w = pk2(o1[6], o1[7]);
                    b.x = pk2(o2[0], o2[1]); b.y = pk2(o2[2], o2[3]); b.z = pk2(o2[4], o2[5]); b.w = pk2(o2[6], o2[7]);
                    *(LAS u32x4*)(Kn + t * 272 + i0 * 2) = a; *(LAS u32x4*)(Kn + t * 272 + (64 + i0) * 2) = b;
                }
#pragma unroll
                for (int i = 0; i < 8; ++i) { *(LAS unsigned short*)(KdT + (i0 + i) * 144 + tsw) = (unsigned short)f2bf(o1[i] * kd); *(LAS unsigned short*)(KdT + (64 + i0 + i) * 144 + tsw) = (unsigned short)f2bf(o2[i] * kd); }
            }
            if (!state_only) {
                float o1[8], o2[8];
#pragma unroll
                for (int i = 0; i < 8; ++i) { const float x1 = bf2f((unsigned short)rq1[i]), x2 = bf2f((unsigned short)rq2[i]);
                    o1[i] = x1 * cs_c[i] - x2 * cs_s[i]; o2[i] = x1 * cs_s[i] + x2 * cs_c[i]; }
                u32x4 a, b; a.x = pk2(o1[0], o1[1]); a.y = pk2(o1[2], o1[3]); a.z = pk2(o1[4], o1[5]); a.w = pk2(o1[6], o1[7]);
                b.x = pk2(o2[0], o2[1]); b.y = pk2(o2[2], o2[3]); b.z = pk2(o2[4], o2[5]); b.w = pk2(o2[6], o2[7]);
                *(LAS u32x4*)(Qn + t * 272 + i0 * 2) = a; *(LAS u32x4*)(Qn + t * 272 + (64 + i0) * 2) = b;
            }
            {
                const int t0 = tid >> 4, ch = tid & 15, sw = ch & 7;
                const int o0 = (((t0 >> 3) ^ sw) << 4) + (t0 & 7) * 2, o1b = ((((t0 + 32) >> 3) ^ sw) << 4) + (t0 & 7) * 2;
#pragma unroll
                for (int i = 0; i < 8; ++i) { *(LAS short*)(VT + (ch * 8 + i) * 144 + o0) = rv0[i]; *(LAS short*)(VT + (ch * 8 + i) * 144 + o1b) = rv1[i]; }
            }
        }
        if (c + 1 < nchunks) issue(c + 1);
        unsigned gpre[8];
#pragma unroll
        for (int rr = 0; rr < 8; ++rr) { const int t = wave * 8 + rr; gpre[rr] = (!state_only && t < L) ? *(const unsigned*)(QKV + (size_t)(row0 + c * 64 + t) * INW + 3072 + h * 128 + lane * 2) : 0u; }
        __syncthreads();
        f32x16 acc;
        if (!state_only) {
#pragma unroll
            for (int r = 0; r < 16; ++r) acc[r] = 0.f;
#pragma unroll
            for (int ks = 0; ks < 8; ++ks) { const bf16x8 a = *(const LAS bf16x8*)(Qn + (lt * 32 + l32) * 272 + (ks * 16 + hf * 8) * 2), b = *(const LAS bf16x8*)(SbT + (et * 32 + l32) * 272 + (ks * 16 + hf * 8) * 2); acc = MFMA32(a, b, acc); }
#pragma unroll
            for (int r = 0; r < 16; ++r) { const int tl = lt * 32 + (r >> 2) * 8 + hf * 4 + (r & 3); acc[r] *= __builtin_amdgcn_exp2f((float)(tl + 1) * lg2); }
            if (wave < 4) {
                const int slt = wave >> 1, smt = wave & 1;
                f32x16 sc;
#pragma unroll
                for (int r = 0; r < 16; ++r) sc[r] = 0.f;
                if (slt >= smt) {
#pragma unroll
                    for (int ks = 0; ks < 8; ++ks) { const bf16x8 a = *(const LAS bf16x8*)(Qn + (slt * 32 + l32) * 272 + (ks * 16 + hf * 8) * 2), b = *(const LAS bf16x8*)(Kn + (smt * 32 + l32) * 272 + (ks * 16 + hf * 8) * 2); sc = MFMA32(a, b, sc); }
                }
                const int tm = smt * 32 + l32;
#pragma unroll
                for (int r = 0; r < 16; ++r) { const int tl = slt * 32 + (r >> 2) * 8 + hf * 4 + (r & 3);
                    const float p = tl >= tm ? sc[r] * __builtin_amdgcn_exp2f((float)(tl - tm) * lg2) : 0.f;
                    *(LAS unsigned short*)(Pm + tl * 144 + tm * 2) = (unsigned short)f2bf(p); }
            }
            __syncthreads();
#pragma unroll
            for (int ms = 0; ms < 4; ++ms) { const bf16x8 a = *(const LAS bf16x8*)(Pm + (lt * 32 + l32) * 144 + (ms * 16 + hf * 8) * 2), b = *(const LAS bf16x8*)(VT + (et * 32 + l32) * 144 + (((ms * 2 + hf) ^ ((et * 4 + (l32 >> 3)) & 7)) << 4)); acc = MFMA32(a, b, acc); }
#pragma unroll
            for (int r = 0; r < 16; ++r) { const int tl = lt * 32 + (r >> 2) * 8 + hf * 4 + (r & 3); of[tl * 132 + et * 32 + l32] = acc[r]; }
        }
#pragma unroll
        for (int r = 0; r < 16; ++r) { S0[r] *= gL; S1[r] *= gL; }
#pragma unroll
        for (int ts = 0; ts < 4; ++ts) {
            const int cc = ts * 2 + hf, rs = l32 >> 3;
            const bf16x8 a = *(const LAS bf16x8*)(KdT + (sdt * 32 + l32) * 144 + ((cc ^ ((sdt * 4 + rs) & 7)) << 4));
            const bf16x8 b0 = *(const LAS bf16x8*)(VT + (set0 * 32 + l32) * 144 + ((cc ^ ((set0 * 4 + rs) & 7)) << 4)), b1 = *(const LAS bf16x8*)(VT + ((set0 + 1) * 32 + l32) * 144 + ((cc ^ (((set0 + 1) * 4 + rs) & 7)) << 4));
            S0 = MFMA32(a, b0, S0); S1 = MFMA32(a, b1, S1);
        }
        if (!state_only) {
#pragma unroll
            for (int g = 0; g < 4; ++g) { const int d0 = sdt * 32 + g * 8 + hf * 4;
                u32x2 a, b; a.x = pk2(S0[4 * g], S0[4 * g + 1]); a.y = pk2(S0[4 * g + 2], S0[4 * g + 3]); b.x = pk2(S1[4 * g], S1[4 * g + 1]); b.y = pk2(S1[4 * g + 2], S1[4 * g + 3]);
                *(LAS u32x2*)(SbT + (set0 * 32 + l32) * 272 + d0 * 2) = a; *(LAS u32x2*)(SbT + ((set0 + 1) * 32 + l32) * 272 + d0 * 2) = b; }
            __syncthreads();
            const f32x2 gr = *(const f32x2*)(P.in[13] + (size_t)(l * 4 + h) * 128 + lane * 2);
            f32x2 ov[8]; float sq[8];
#pragma unroll
            for (int rr = 0; rr < 8; ++rr) { ov[rr] = *(const LAS f32x2*)(of + (wave * 8 + rr) * 132 + lane * 2); sq[rr] = ov[rr].x * ov[rr].x + ov[rr].y * ov[rr].y; }
#pragma unroll
            for (int o = 1; o < 64; o <<= 1) {
#pragma unroll
                for (int rr = 0; rr < 8; ++rr) sq[rr] += __shfl_xor(sq[rr], o);
            }
#pragma unroll
            for (int rr = 0; rr < 8; ++rr) {
                const int t = wave * 8 + rr;
                if (t < L) {
                    const float rstd = rsqrtf(sq[rr] * (1.f / 128.f) + EPS);
                    const size_t row = (size_t)(row0 + c * 64 + t);
                    const unsigned gg = gpre[rr];
                    const float y0 = ov[rr].x * rstd * gr.x * silu_f(bf2f(gg & 0xffffu)), y1 = ov[rr].y * rstd * gr.y * silu_f(bf2f(gg >> 16));
                    *(unsigned*)(Ob + row * DM + 512 + h * 128 + lane * 2) = pk2(y0, y1);
                }
            }
        }
        __syncthreads();
    }
    if (outst) {
        float* op = outst + (sdt * 32 + hf * 4) * 128 + set0 * 32 + l32;
#pragma unroll
        for (int r = 0; r < 16; ++r) { op[((r >> 2) * 8 + (r & 3)) * 128] = S0[r]; op[((r >> 2) * 8 + (r & 3)) * 128 + 32] = S1[r]; if ((r & 3) == 3) asm volatile("" ::: "memory"); }
    }
}


#define XB_TMO      128
#define XB_XCNT(j)  (256  + 64 * (j))
#define XB_XSUB(j)  (1280 + 64 * (j))
#define XB_XGEN(j)  (2304 + 64 * (j))
#define XB_TOP      3328
#define XB_TOPGEN   3392
#define XCD_BAR_WORDS 3456
#define XB_SPIN_CAP (1u << 18)

__device__ __forceinline__ unsigned xb_ld(unsigned* p)              { return __hip_atomic_load(p, __ATOMIC_RELAXED, __HIP_MEMORY_SCOPE_AGENT); }
__device__ __forceinline__ unsigned xb_add(unsigned* p, unsigned v) { return __hip_atomic_fetch_add(p, v, __ATOMIC_RELAXED, __HIP_MEMORY_SCOPE_AGENT); }
__device__ __forceinline__ unsigned xb_xcc_id() { return (unsigned)__builtin_amdgcn_s_getreg((3 << 11) | 20) & 0xFu; }
#define XB_SPIN(cond, bar) do { unsigned _sp = 0; while (cond) { __builtin_amdgcn_s_sleep(1); \
    if ((++_sp & 255u) == 0u) { if (xb_ld(&(bar)[XB_TMO])) break; if (_sp > XB_SPIN_CAP) { atomicAdd(&(bar)[XB_TMO], 1u); break; } } } } while (0)

struct XcdBarrier {
    unsigned* bar; unsigned x;
    volatile LAS unsigned* st;
};

__device__ __forceinline__ XcdBarrier xcd_barrier_post(unsigned* bar, volatile LAS unsigned* st) {
    XcdBarrier b; b.bar = bar; b.x = xb_xcc_id(); b.st = st;
    if (threadIdx.x == 0) (void)xb_add(&bar[XB_XCNT(b.x)], 1u);
    return b;
}
__device__ __forceinline__ void xcd_barrier_complete(unsigned* bar, unsigned x, unsigned& nloc, unsigned& nx) {
    const unsigned G = gridDim.x * gridDim.y * gridDim.z;
    unsigned sum, cnt, mine, sp = 0u;
    for (;;) {
        sum = 0u; cnt = 0u; mine = 0u;
#pragma unroll
        for (unsigned j = 0; j < 16; ++j) { const unsigned c = xb_ld(&bar[XB_XCNT(j)]); sum += c; cnt += (c > 0u) ? 1u : 0u; mine = (j == x) ? c : mine; }
        if (sum == G) break;
        __builtin_amdgcn_s_sleep(1);
        if ((++sp & 255u) == 0u) { if (xb_ld(&bar[XB_TMO])) break; if (sp > XB_SPIN_CAP) { atomicAdd(&bar[XB_TMO], 1u); break; } }
    }
    nloc = mine > 0u ? mine : 1u; nx = cnt > 0u ? cnt : 1u;
}

__device__ __forceinline__ void xcd_barrier(const XcdBarrier& b) {
    asm volatile("s_waitcnt vmcnt(0)" ::: "memory");
    __syncthreads();
    if (threadIdx.x == 0) {
        unsigned* bar = b.bar;
        __builtin_amdgcn_s_waitcnt(0);
        unsigned nloc = b.st[0], nx = b.st[1];
        if (nloc == 0u) { xcd_barrier_complete(bar, b.x, nloc, nx); b.st[0] = nloc; b.st[1] = nx; }
        const unsigned old = xb_add(&bar[XB_XSUB(b.x)], 1u);
        const unsigned gen = old / nloc;
        if (old + 1u == (gen + 1u) * nloc) {
            __builtin_amdgcn_fence(__ATOMIC_RELEASE, "agent");
            asm volatile("s_waitcnt vmcnt(0)" ::: "memory");
            const unsigned og = xb_add(&bar[XB_TOP], 1u);
            const unsigned tg = og / nx;
            if (og + 1u == (tg + 1u) * nx) xb_add(&bar[XB_TOPGEN], 1u);
            else XB_SPIN(xb_ld(&bar[XB_TOPGEN]) == tg, bar);
            __builtin_amdgcn_fence(__ATOMIC_ACQUIRE, "agent");
            xb_add(&bar[XB_XGEN(b.x)], 1u);
            asm volatile("s_waitcnt vmcnt(0)" ::: "memory");
        } else {
            XB_SPIN(xb_ld(&bar[XB_XGEN(b.x)]) == gen, bar);
            __builtin_amdgcn_fence(__ATOMIC_ACQUIRE, "agent");
            asm volatile("s_waitcnt vmcnt(0)" ::: "memory");
        }
    }
    __syncthreads();
}
__global__ void __launch_bounds__(512, 2) fwd_megakernel(Params P) {
    extern __shared__ __attribute__((aligned(16))) unsigned char lds_raw[];
    LAS unsigned char* lds = (LAS unsigned char*)lds_raw;
    cg::grid_group grid = cg::this_grid();
    int tid = threadIdx.x, lane = tid & 63, wave = __builtin_amdgcn_readfirstlane(tid >> 6);
#define REFRESH() do { tid = threadIdx.x; asm volatile("" : "+v"(tid)); lane = tid & 63; wave = __builtin_amdgcn_readfirstlane(tid >> 6); } while (0)
    const int G = gridDim.x, bx = blockIdx.x;
    bf16_t* H = (bf16_t*)(P.ws + WS_H); bf16_t* Ob = (bf16_t*)(P.ws + WS_O); bf16_t* QKV = (bf16_t*)(P.ws + WS_QKV); bf16_t* ACT = QKV;
    bf16_t* X = (bf16_t*)(P.ws + WS_X); float* U = (float*)(P.ws + WS_U);
    const float* MOD = (const float*)(P.ws + WS_MOD);

    volatile LAS unsigned* bst = (volatile LAS unsigned*)(lds + LDS_BYTES - 64);
    if (tid == 0) { bst[0] = 0u; bst[1] = 0u; }
    __syncthreads();
    const XcdBarrier xbar = xcd_barrier_post((unsigned*)(P.ws + WS_BAR), bst);
#ifndef SK_P0
    p0_phase(P, lds, tid, lane, wave);
#endif
    xcd_barrier(xbar); REFRESH();
    {
        const f32x4* part = (const f32x4*)(P.ws + WS_PART); f32x4* mod4 = (f32x4*)(P.ws + WS_MOD);
        constexpr int NV = DEPTH * NBI * NMOD / 4;
        for (int i = bx * 512 + tid; i < NV; i += G * 512) {
            f32x4 a = part[i];
#pragma unroll
            for (int kc = 1; kc < 8; ++kc) a += part[(size_t)kc * NV + i];
            mod4[i] = a;
        }
    }
    if (P.ws == nullptr) grid.sync();
    xcd_barrier(xbar); REFRESH();
#pragma unroll 1
    for (int l = 0; l < DEPTH; ++l) {
        norm_phase<false>(P, l, l == 0, P.in[7] + (size_t)l * DM, 0, 1024, lane, wave);
        xcd_barrier(xbar); REFRESH();
#ifndef SK_G1
        {
            pg8::Gemm g{H, (const bf16_t*)(P.ws + WS_WIN) + (size_t)l * INW * DM, MP, INW, DM}; pg8::StaticOrder S; S.init(MP, INW, G, bx);
            EpiQKV E{QKV, P.out, l};
            pg8::gemm_phase<EpiQKV, pg8::StaticOrder, true, true>(lds, g, S, E);
            SEpiQKV SE{QKV, P.out, l};
            sgemm_st_phase<SEpiQKV>(lds, H + (size_t)MP * DM, DM, g.Bt, DM, INW / 64, tid, lane, wave, SE);
        }
#endif
        xcd_barrier(xbar); REFRESH();
        {
            unsigned* qhead = (unsigned*)(P.ws + WS_CTR) + l * 64;
            volatile LAS unsigned* qslot = (volatile LAS unsigned*)(lds + LDS_BYTES - 128);
            for (;;) {
                if (tid == 0) *qslot = __hip_atomic_fetch_add(qhead, 1u, __ATOMIC_RELAXED, __HIP_MEMORY_SCOPE_AGENT);
                __syncthreads();
                const int u = (int)*qslot;
                __syncthreads();
                if (u >= 1360) break;
                if (u < 256) { const int bh = u >> 5, seg = u & 31, b = bh >> 2, h = bh & 3;
                    ret_unit(P, l, lds, tid, lane, wave, b * SEQ + seg * 512, seg * 512, 8, 64, h, nullptr, U + (size_t)(bh * 32 + seg) * 16384, true);
                    asm volatile("s_waitcnt vmcnt(0)" ::: "memory");
                    __syncthreads();
                    if (tid == 0) {
                        __builtin_amdgcn_fence(__ATOMIC_RELEASE, "agent");
                        asm volatile("s_waitcnt vmcnt(0)" ::: "memory");
                        const unsigned old = __hip_atomic_fetch_add((unsigned*)(P.ws + WS_CTR + 1024) + l * 8 + bh, 1u, __ATOMIC_RELAXED, __HIP_MEMORY_SCOPE_AGENT);
                        const unsigned last = (old == 31u) ? 1u : 0u;
                        if (last) { __builtin_amdgcn_fence(__ATOMIC_ACQUIRE, "agent"); asm volatile("s_waitcnt vmcnt(0)" ::: "memory"); }
                        qslot[1] = last;
                    }
                    __syncthreads();
                    if (qslot[1]) {
                        const float g512 = exp2f(512.f * log2f(1.f - exp2f(-5.f - (float)h)));
#pragma unroll 1
                        for (int j = 0; j < 32; ++j) {
                            const int within = j * 512 + tid;
                            float* up = U + (size_t)bh * 32 * 16384 + within; float sst = 0.f;
                            float uv[32];
#pragma unroll
                            for (int sg = 0; sg < 32; ++sg) uv[sg] = up[(size_t)sg * 16384];
#pragma unroll
                            for (int sg = 0; sg < 32; ++sg) { up[(size_t)sg * 16384] = sst; sst = g512 * sst + uv[sg]; }
                            P.out[OFF_RP + ((size_t)l * 8 + bh) * 16384 + within] = sst;
                        }
                    }
                }
                else if (u < 272) sb_unit(P, l, 1024 + (u - 256), lds, tid, lane, wave);
                else if (u < 1296) { const int v = u - 272; sb_unit(P, l, (v & 1) * 512 + (511 - (v >> 1)), lds, tid, lane, wave); }
                else { const int idx = u - 1296, bs = idx >> 2, h = idx & 3; const size_t so = ((size_t)(l * DB + bs) * 4 + h) * 16384;
                    ret_unit(P, l, lds, tid, lane, wave, MP + bs * 32, PAST, 1, 32, h, P.in[4] + so, P.out + OFF_RS + so, false); }
            }
        }
        xcd_barrier(xbar); REFRESH();
#ifndef SK_R3
        for (int u = bx; u < 256; u += G) { const int bh = u >> 5, seg = u & 31, b = bh >> 2, h = bh & 3;
            ret_unit(P, l, lds, tid, lane, wave, b * SEQ + seg * 512, seg * 512, 8, 64, h, U + (size_t)(bh * 32 + seg) * 16384, nullptr, false); }
#endif
        xcd_barrier(xbar); REFRESH();
#ifndef SK_G2
        {
            pg8::Gemm g{Ob, (const bf16_t*)(P.ws + WS_WOUT) + (size_t)l * DM * DM, MP, DM, DM}; pg8::StaticOrder S; S.init(MP, DM, G, bx);
            EpiResid E{l == 0 ? P.in[0] : nullptr, l == 0 ? P.in[1] : nullptr, X, MOD + (size_t)l * NBI * NMOD + 2048};
            pg8::gemm_phase<EpiResid, pg8::StaticOrder, true, true>(lds, g, S, E);
            SEpiResid SE{l == 0 ? P.in[1] : nullptr, X + (size_t)MP * DM, MOD + (size_t)l * NBI * NMOD + 2048};
            sgemm_phase<8, 8, SEpiResid>(lds, Ob + (size_t)MP * DM, DM, g.Bt, DM, DM / 64, tid, lane, wave, SE);
        }
#endif
        xcd_barrier(xbar); REFRESH();
        norm_phase<false>(P, l, false, P.in[8] + (size_t)l * DM, 3072, 4096, lane, wave);
        xcd_barrier(xbar); REFRESH();
#ifndef SK_G3
        {
            pg8::Gemm g{H, (const bf16_t*)(P.ws + WS_WFI) + (size_t)l * 2 * DFF * DM, MP, 2 * DFF, DM}; pg8::StaticOrder S; S.init(MP, 2 * DFF, G, bx);
            EpiSwiGLU E{ACT};
            pg8::gemm_phase<EpiSwiGLU, pg8::StaticOrder, true, true>(lds, g, S, E);
            SEpiSwiGLU SE{ACT};
            sgemm_st_phase<SEpiSwiGLU>(lds, H + (size_t)MP * DM, DM, g.Bt, DM, (2 * DFF / 256) * 4, tid, lane, wave, SE);
        }
#endif
        xcd_barrier(xbar); REFRESH();
#ifndef SK_G4
        {
            pg8::Gemm g{ACT, (const bf16_t*)(P.ws + WS_WFO) + (size_t)l * DM * DFF, MP, DM, DFF}; pg8::StaticOrder S; S.init(MP, DM, G, bx);
            EpiResid E{nullptr, nullptr, X, MOD + (size_t)l * NBI * NMOD + 5120};
            pg8::gemm_phase<EpiResid, pg8::StaticOrder, true, true>(lds, g, S, E);
            SEpiResid SE{nullptr, X + (size_t)MP * DM, MOD + (size_t)l * NBI * NMOD + 5120};
            sgemm_phase<22, 11, SEpiResid>(lds, ACT + (size_t)MP * DFF, DFF, g.Bt, DFF, DM / 64, tid, lane, wave, SE);
        }
#endif
        xcd_barrier(xbar); REFRESH();
    }
    norm_phase<true>(P, 0, false, P.in[17], 0, 0, lane, wave);
}

extern "C" void kernel_launch(void* const* d_in, const int* in_sizes, int n_in, void* d_out, int out_size, void* d_ws, size_t ws_size, hipStream_t stream) {
    static int grid = 0;
    if (grid == 0) {
        if (n_in != 18 || ws_size < WS_END) { fprintf(stderr, "kernel_launch: unexpected n_in %d / ws_size %zu\n", n_in, ws_size); grid = -1; return; }
        int dev = 0, cus = 0, per_cu = 0;
        (void)hipGetDevice(&dev); (void)hipDeviceGetAttribute(&cus, hipDeviceAttributeMultiprocessorCount, dev);
        if (hipFuncSetAttribute((const void*)fwd_megakernel, hipFuncAttributeMaxDynamicSharedMemorySize, LDS_BYTES) != hipSuccess) { fprintf(stderr, "kernel_launch: hipFuncSetAttribute failed\n"); grid = -1; return; }
        (void)hipOccupancyMaxActiveBlocksPerMultiprocessor(&per_cu, (const void*)fwd_megakernel, 512, LDS_BYTES);
        (void)hipGetLastError();
        if (per_cu < 1) { fprintf(stderr, "kernel_launch: occupancy query says %d blocks per CU\n", per_cu); per_cu = 1; }
        grid = cus;
    }
    if (grid < 0) return;
    (void)hipMemsetAsync((char*)d_ws + WS_BAR, 0, 20480, stream);
    Params p{};
    for (int i = 0; i < 18; ++i) p.in[i] = (const float*)d_in[i];
    p.out = (float*)d_out; p.ws = (unsigned char*)d_ws;
    void* args[] = {&p};
    hipError_t e = hipLaunchCooperativeKernel((const void*)fwd_megakernel, dim3(grid), dim3(512), args, LDS_BYTES, stream);
    if (e != hipSuccess) fprintf(stderr, "cooperative launch failed: %s (grid %d)\n", hipGetErrorString(e), grid);
}
```

```cpp
#include <hip/hip_runtime.h>
#include <hip/hip_cooperative_groups.h>
#include <cstdio>
#include <cstdint>
namespace cg = cooperative_groups;
namespace pg8 {
#define PG8_LAS __attribute__((address_space(3)))
typedef unsigned short bf16_t;
typedef short bf16x8 __attribute__((ext_vector_type(8)));
typedef float f32x4 __attribute__((ext_vector_type(4)));
typedef unsigned u32x4 __attribute__((ext_vector_type(4)));
constexpr int BM = 256, BK = 64, HALF = 128, HTB = HALF * BK * 2  , STAGE_BYTES = 8 * HTB, NXCD = 8, WGM = 8;

__host__ __device__ __forceinline__ int lds_byte(int r, int c) { const int st = (r >> 4) * 2 + (c >> 5), rr = r & 15, cc = c & 31, ob = rr * 64 + cc * 2; return st * 1024 + (ob ^ (((ob >> 9) & 1) << 5)); }
__host__ __device__ __forceinline__ void stage_rc(int b, int& R, int& C) { const int st = b / 1024, sb = b % 1024, swz = sb ^ (((sb >> 9) & 1) << 5); R = (st >> 1) * 16 + swz / 64; C = (st & 1) * 32 + (swz % 64) / 2; }
__host__ __device__ __forceinline__ int perm32(int rho) { const int n = rho >> 4, i = rho & 15; return 8 * (i >> 2) + 4 * n + (i & 3); }

struct Unit { int pm, pn; };
struct Gemm { const bf16_t* A; const bf16_t* Bt; int M, N, K; };

struct StaticOrder {
    int nM, nN, nwg, G, c;
    __host__ __device__ void init(int M, int N, int G_, int c_) { nM = M / BM; nN = N / BM; nwg = nM * nN; G = G_; c = c_; }
    __host__ __device__ bool next(int i, Unit& u) const {
        const long L = (long)i * G + c; if (L >= nwg) return false;
        int wgid = (int)L; { const int q = nwg / NXCD, r = nwg % NXCD, xcd = wgid % NXCD, off = wgid / NXCD; wgid = (xcd < r ? xcd * (q + 1) : r * (q + 1) + (xcd - r) * q) + off; }
        const int nig = WGM * nN, gid = wgid / nig, fm = gid * WGM, gsz = (nM - fm) < WGM ? (nM - fm) : WGM;
        u.pm = fm + ((wgid % nig) % gsz); u.pn = (wgid % nig) / gsz; return true;
    }
    __device__ __forceinline__ void a_ready(const Unit&) const {}
    __device__ __forceinline__ void done(const Unit&) const {}
};

__device__ __forceinline__ unsigned cvt_pk_bf16(float lo, float hi) { unsigned r; asm volatile("v_cvt_pk_bf16_f32 %0, %1, %2" : "=v"(r) : "v"(lo), "v"(hi)); return r; }
typedef float f32x2 __attribute__((ext_vector_type(2)));
__device__ __forceinline__ f32x2 gelu_pk(f32x2 v) {
    const f32x2 av = __builtin_elementwise_abs(v), d = av * 0.2316418882f + 1.0f;
    f32x2 t; t.x = __builtin_amdgcn_rcpf(d.x); t.y = __builtin_amdgcn_rcpf(d.y);
    f32x2 q = t * 0.5307027145f + (-0.7265760135f); q = q * t + 0.7107068705f; q = q * t + (-0.142248368f); q = q * t + 0.127414796f; q = q * t;
    const f32x2 s = (v * v) * (-0.72134752044f);
    f32x2 e; e.x = __builtin_amdgcn_exp2f(s.x); e.y = __builtin_amdgcn_exp2f(s.y);
    const f32x2 m = v * (q * e), r = v - m;
    f32x2 o; o.x = v.x < 0.f ? m.x : r.x; o.y = v.y < 0.f ? m.y : r.y; return o;
}

template <int ACT  > struct EpiBf16 {
    static constexpr bool PERM = true, AFTER_DRAIN = false; static_assert(ACT == 0 || ACT == 1, "EpiBf16: ACT is 0 (none) or 1 (gelu_pk)");
    bf16_t* O; int ldc; const float* bias; int split_cols; size_t split_stride; float scale0;
    __device__ __forceinline__ void operator()(const f32x4 (&acc)[2][2][4][2], const Unit& u, int wr, int wc, int fr, int fq) const {
        const int row0 = u.pm * BM + wr * 64 + fr; int colt = u.pn * BM; bf16_t* base = O;
        float sc = 1.f; if (split_cols) { const int t = colt / split_cols; base += (size_t)t * split_stride; colt -= t * split_cols; if (t == 0) sc = scale0; }
        const int col0 = colt + wc * 32 + 8 * fq, bcol0 = u.pn * BM + wc * 32 + 8 * fq;
        f32x4 bv[2][2];
#pragma unroll
        for (int bj = 0; bj < 2; ++bj)
#pragma unroll
            for (int n = 0; n < 2; ++n) bv[bj][n] = bias ? *(const f32x4*)(bias + bcol0 + bj * HALF + 4 * n) : (f32x4){0.f, 0.f, 0.f, 0.f};
#pragma unroll
        for (int ai = 0; ai < 2; ++ai)
#pragma unroll
            for (int m = 0; m < 4; ++m) { bf16_t* rowp = base + (size_t)(row0 + ai * HALF + m * 16) * ldc + col0;
#pragma unroll
                for (int bj = 0; bj < 2; ++bj) { f32x4 v0 = acc[ai][bj][m][0] + bv[bj][0], v1 = acc[ai][bj][m][1] + bv[bj][1];
                    if (ACT == 1) { f32x2 a = gelu_pk((f32x2){v0[0], v0[1]}), b = gelu_pk((f32x2){v0[2], v0[3]}), c = gelu_pk((f32x2){v1[0], v1[1]}), d = gelu_pk((f32x2){v1[2], v1[3]});
                        v0 = (f32x4){a.x, a.y, b.x, b.y}; v1 = (f32x4){c.x, c.y, d.x, d.y}; }
                    v0 = v0 * sc; v1 = v1 * sc; u32x4 w; w.x = cvt_pk_bf16(v0[0], v0[1]); w.y = cvt_pk_bf16(v0[2], v0[3]); w.z = cvt_pk_bf16(v1[0], v1[1]); w.w = cvt_pk_bf16(v1[2], v1[3]);
                    *(u32x4*)(rowp + bj * HALF) = w; } }
    }
};
template <class Epi, class Sched, bool ALIGN_EPI = false, bool SP2 = false>
__device__ __forceinline__ void gemm_phase(PG8_LAS unsigned char* lds, const Gemm g, const Sched& S, const Epi& E) {
    int tid_o = threadIdx.x; asm volatile("" : "+v"(tid_o));
    const int tid = tid_o, wid = __builtin_amdgcn_readfirstlane(tid >> 6), lane = tid & 63, wr = wid >> 2, wc = wid & 3, fr = lane & 15, fq = lane >> 4;
    const int K = g.K, nt = K / BK;
    unsigned voffA[2], voffB[2];
#pragma unroll
    for (int i = 0; i < 2; ++i) { int R, C; stage_rc(tid * 16 + i * 8192, R, C); const int Rb = Epi::PERM ? ((R & ~31) + perm32(R & 31)) : R;
        voffA[i] = (unsigned)(R * K + C) * 2u; voffB[i] = (unsigned)(Rb * K + C) * 2u; }
    const size_t kstep = (size_t)(BK * 2);
    const size_t hstep = (size_t)HALF * K * 2;
    const size_t tstep = 2 * hstep;
    const unsigned ldsw = (unsigned)wid * 1024u;
    const int aoff = lds_byte(wr * 64 + fr, fq * 8), boff = lds_byte(wc * 32 + fr, fq * 8);
#define PG8_SA(b, h) (((b) * 2 + (h)) * HTB)
#define PG8_SB(b, h) ((4 + (b) * 2 + (h)) * HTB)
#define PG8_STAGE(bufoff, gbase, voff) do { _Pragma("unroll") for (int _i = 0; _i < 2; ++_i) \
        __builtin_amdgcn_global_load_lds((const unsigned*)((const char*)(gbase) + (voff)[_i]), (PG8_LAS unsigned*)(lds + (bufoff) + ldsw + _i * 8192), 16, 0, 0); } while (0)
#define PG8_LDA(dst, b, h) do { _Pragma("unroll") for (int m = 0; m < 4; ++m) _Pragma("unroll") for (int k = 0; k < 2; ++k) dst[m][k] = *(const PG8_LAS bf16x8*)(lds + PG8_SA(b, h) + aoff + m * 2048 + k * 1024); } while (0)
#define PG8_LDB(dst, b, h) do { _Pragma("unroll") for (int n = 0; n < 2; ++n) _Pragma("unroll") for (int k = 0; k < 2; ++k) dst[n][k] = *(const PG8_LAS bf16x8*)(lds + PG8_SB(b, h) + boff + n * 2048 + k * 1024); } while (0)
#define PG8_MMA(ai, bj, At, Bt) do { __builtin_amdgcn_s_setprio(1); _Pragma("unroll") for (int m = 0; m < 4; ++m) _Pragma("unroll") for (int n = 0; n < 2; ++n) _Pragma("unroll") for (int k = 0; k < 2; ++k) \
        acc[ai][bj][m][n] = __builtin_amdgcn_mfma_f32_16x16x32_bf16(Bt[n][k], At[m][k], acc[ai][bj][m][n], 0, 0, 0); __builtin_amdgcn_s_setprio(0); } while (0)
#define PG8_WAIT_V(n) asm volatile("s_waitcnt vmcnt(" #n ")" ::: "memory")
#define PG8_WAIT_L(n) asm volatile("s_waitcnt lgkmcnt(" #n ")" ::: "memory")
#define PG8_BAR __builtin_amdgcn_s_barrier()
#define PG8_SCHED __builtin_amdgcn_sched_barrier(0)
    Unit cur, nxt; int ui = 0;
    if (!S.next(0, cur)) return;
    f32x4 acc[2][2][4][2];
#pragma unroll
    for (int a = 0; a < 2; ++a)
#pragma unroll
        for (int b = 0; b < 2; ++b)
#pragma unroll
            for (int m = 0; m < 4; ++m)
#pragma unroll
                for (int n = 0; n < 2; ++n) acc[a][b][m][n] = (f32x4){0.f, 0.f, 0.f, 0.f};
    bf16x8 At[4][2], B0[2][2], B1[2][2];
    const char* cA = (const char*)g.A + (size_t)cur.pm * tstep; const char* cB = (const char*)g.Bt + (size_t)cur.pn * tstep;
    S.a_ready(cur);
    if constexpr (SP2) {
        PG8_STAGE(PG8_SB(0, 0), cB, voffB); PG8_STAGE(PG8_SB(0, 1), cB + hstep, voffB); PG8_STAGE(PG8_SA(0, 0), cA, voffA); PG8_STAGE(PG8_SA(0, 1), cA + hstep, voffA);
        if (wr == 1) PG8_BAR;
        PG8_WAIT_V(2); PG8_BAR;
        PG8_STAGE(PG8_SB(1, 0), cB + kstep, voffB); PG8_STAGE(PG8_SA(1, 0), cA + kstep, voffA); PG8_STAGE(PG8_SB(1, 1), cB + hstep + kstep, voffB);
        PG8_WAIT_V(6); PG8_BAR;
    } else {
        PG8_STAGE(PG8_SB(0, 0), cB, voffB); PG8_STAGE(PG8_SA(0, 0), cA, voffA); PG8_STAGE(PG8_SB(0, 1), cB + hstep, voffB); PG8_STAGE(PG8_SA(0, 1), cA + hstep, voffA);
        if (wr == 1) PG8_BAR;
        PG8_WAIT_V(4); PG8_BAR;
        PG8_STAGE(PG8_SB(1, 0), cB + kstep, voffB); PG8_STAGE(PG8_SA(1, 0), cA + kstep, voffA); PG8_STAGE(PG8_SB(1, 1), cB + hstep + kstep, voffB);
        PG8_WAIT_V(6); PG8_BAR;
    }
    for (;;) {
        const bool has_next = S.next(ui + 1, nxt);
        const char* nA = has_next ? (const char*)g.A + (size_t)nxt.pm * tstep : cA; const char* nB = has_next ? (const char*)g.Bt + (size_t)nxt.pn * tstep : cB;
        for (int t = 0; t < nt; t += 2) {
            const bool last = (t == nt - 2);
            const char* a1 = cA + (size_t)(t + 1) * kstep;
            const char* a2 = last ? nA : cA + (size_t)(t + 2) * kstep; const char* b2 = last ? nB : cB + (size_t)(t + 2) * kstep;
            const char* a3 = a2 + kstep; const char* b3 = b2 + kstep;
            if (last && has_next) S.a_ready(nxt);
            if constexpr (SP2) {
            PG8_LDB(B0, 0, 0); PG8_LDB(B1, 0, 1); PG8_SCHED; PG8_LDA(At, 0, 0); PG8_STAGE(PG8_SA(1, 1), a1 + hstep, voffA);
            PG8_WAIT_V(8); PG8_WAIT_L(0); PG8_BAR; PG8_MMA(0, 0, At, B0); PG8_MMA(0, 1, At, B1); PG8_BAR; PG8_SCHED;
            PG8_LDA(At, 0, 1); PG8_STAGE(PG8_SB(0, 0), b2, voffB); PG8_STAGE(PG8_SB(0, 1), b2 + hstep, voffB); PG8_STAGE(PG8_SA(0, 0), a2, voffA);
            PG8_WAIT_V(8); PG8_WAIT_L(0); PG8_BAR; PG8_MMA(1, 0, At, B0); PG8_MMA(1, 1, At, B1); PG8_BAR; PG8_SCHED;
            PG8_LDB(B0, 1, 0); PG8_LDB(B1, 1, 1); PG8_SCHED; PG8_LDA(At, 1, 0); PG8_STAGE(PG8_SA(0, 1), a2 + hstep, voffA);
            PG8_WAIT_V(8); PG8_WAIT_L(0); PG8_BAR; PG8_MMA(0, 0, At, B0); PG8_MMA(0, 1, At, B1); PG8_BAR; PG8_SCHED;
            PG8_LDA(At, 1, 1); PG8_STAGE(PG8_SB(1, 0), b3, voffB); PG8_STAGE(PG8_SB(1, 1), b3 + hstep, voffB); PG8_STAGE(PG8_SA(1, 0), a3, voffA);
            PG8_WAIT_V(8); PG8_WAIT_L(0); PG8_BAR; PG8_MMA(1, 0, At, B0); PG8_MMA(1, 1, At, B1); PG8_BAR; PG8_SCHED;
            } else {
            PG8_LDB(B0, 0, 0); PG8_SCHED; PG8_LDA(At, 0, 0); PG8_STAGE(PG8_SA(1, 1), a1 + hstep, voffA);
            PG8_WAIT_L(8); PG8_BAR; PG8_WAIT_L(0); PG8_MMA(0, 0, At, B0); PG8_BAR; PG8_SCHED;
            PG8_LDB(B1, 0, 1); PG8_STAGE(PG8_SB(0, 0), b2, voffB);
            PG8_BAR; PG8_WAIT_L(0); PG8_MMA(0, 1, At, B1); PG8_BAR;
            PG8_LDA(At, 0, 1); PG8_STAGE(PG8_SA(0, 0), a2, voffA);
            PG8_BAR; PG8_WAIT_L(0); PG8_MMA(1, 0, At, B0); PG8_BAR; PG8_SCHED;
            PG8_STAGE(PG8_SB(0, 1), b2 + hstep, voffB);
            PG8_WAIT_V(6); PG8_BAR; PG8_MMA(1, 1, At, B1); PG8_BAR;
            PG8_LDB(B0, 1, 0); PG8_SCHED; PG8_LDA(At, 1, 0); PG8_STAGE(PG8_SA(0, 1), a2 + hstep, voffA);
            PG8_WAIT_L(8); PG8_BAR; PG8_WAIT_L(0); PG8_MMA(0, 0, At, B0); PG8_BAR; PG8_SCHED;
            PG8_LDB(B1, 1, 1); PG8_STAGE(PG8_SB(1, 0), b3, voffB);
            PG8_BAR; PG8_WAIT_L(0); PG8_MMA(0, 1, At, B1); PG8_BAR;
            PG8_LDA(At, 1, 1); PG8_STAGE(PG8_SA(1, 0), a3, voffA);
            PG8_BAR; PG8_WAIT_L(0); PG8_MMA(1, 0, At, B0); PG8_BAR; PG8_SCHED;
            PG8_STAGE(PG8_SB(1, 1), b3 + hstep, voffB);
            PG8_WAIT_V(6); PG8_BAR; PG8_MMA(1, 1, At, B1); PG8_BAR;
            }
        }
        if constexpr (ALIGN_EPI) { if (wr == 0) PG8_BAR; }
        if constexpr (!Epi::AFTER_DRAIN) { E(acc, cur, wr, wc, fr, fq); S.done(cur); }
        if (!has_next) break;
#pragma unroll
        for (int a = 0; a < 2; ++a)
#pragma unroll
            for (int b = 0; b < 2; ++b)
#pragma unroll
                for (int m = 0; m < 4; ++m)
#pragma unroll
                    for (int n = 0; n < 2; ++n) acc[a][b][m][n] = (f32x4){0.f, 0.f, 0.f, 0.f};
        cur = nxt; cA = nA; cB = nB; ++ui;
        if constexpr (ALIGN_EPI) { if (wr == 1) PG8_BAR; }
    }
    PG8_WAIT_V(0);
    if constexpr (!ALIGN_EPI) { if (wr == 0) PG8_BAR; }
    PG8_BAR;
    if constexpr (Epi::AFTER_DRAIN) { E.fused(acc, cur, wr, wc, fr, fq, lds, wid, lane); S.done(cur); }
#undef PG8_SA
#undef PG8_SB
#undef PG8_STAGE
#undef PG8_LDA
#undef PG8_LDB
#undef PG8_MMA
#undef PG8_WAIT_V
#undef PG8_WAIT_L
#undef PG8_BAR
#undef PG8_SCHED
}
}

#define LAS __attribute__((address_space(3)))
typedef unsigned short bf16_t;
typedef short bf16x8 __attribute__((ext_vector_type(8)));
typedef float f32x4 __attribute__((ext_vector_type(4)));
typedef float f32x2 __attribute__((ext_vector_type(2)));
typedef float f32x16 __attribute__((ext_vector_type(16)));
typedef unsigned u32x4 __attribute__((ext_vector_type(4)));
typedef unsigned u32x2 __attribute__((ext_vector_type(2)));
#define MFMA32(a, b, c) __builtin_amdgcn_mfma_f32_32x32x16_bf16((a), (b), (c), 0, 0, 0)

constexpr int DM = 1024, SEQ = 16384, NBP = 2, DEPTH = 4, DB = 16, DS = 32, PAST = 2048;
constexpr int MP = NBP * SEQ, MS = DB * DS, MT = MP + MS;
constexpr int INW = 3584, DFF = 2816, NMOD = 6144, NBI = 18;
constexpr float EPS = 1e-6f;
constexpr size_t OFF_YP = 0, OFF_YS = 33554432, OFF_KP = 34078720, OFF_VP = 101187584, OFF_RP = 168296448,
                 OFF_KS = 168820736, OFF_VS = 169869312, OFF_RS = 170917888;
constexpr size_t MiB = 1u << 20;
constexpr size_t WS_MOD = 0, MOD_BYTES = 2 * MiB; constexpr size_t WS_CTR = 1820160;
constexpr size_t WS_BAR = 1802240;
constexpr size_t WS_ROPE = 2 * MiB;
constexpr size_t WS_WIN = 10 * MiB, WS_WOUT = 38 * MiB, WS_WFI = 46 * MiB, WS_WFO = 90 * MiB;
constexpr size_t WS_X = 112 * MiB;
constexpr size_t WS_H = 242 * MiB;
constexpr size_t WS_O = 307 * MiB;
constexpr size_t WS_QKV = 372 * MiB;
constexpr size_t WS_U = 600 * MiB;
constexpr size_t WS_PART = 616 * MiB;
constexpr size_t WS_END = 632 * MiB;
constexpr int LDS_BYTES = 147456;

struct Params { const float* in[18]; float* out; unsigned char* ws; };

typedef __bf16 bf16x2_t __attribute__((ext_vector_type(2)));
__device__ __forceinline__ unsigned pk2(float lo, float hi) { const f32x2 v = {lo, hi}; return __builtin_bit_cast(unsigned, __builtin_convertvector(v, bf16x2_t)); }
__device__ __forceinline__ unsigned f2bf(float f) { return pk2(f, 0.f) & 0xffffu; }
__device__ __forceinline__ float bf2f(unsigned h) { return __builtin_bit_cast(float, h << 16); }
__device__ __forceinline__ f32x4 ldx4(const bf16_t* p) { const u32x2 w = *(const u32x2*)p;
    return (f32x4){__builtin_bit_cast(float, w.x << 16), __builtin_bit_cast(float, w.x & 0xffff0000u), __builtin_bit_cast(float, w.y << 16), __builtin_bit_cast(float, w.y & 0xffff0000u)}; }
__device__ __forceinline__ bf16x8 pack8(f32x4 a, f32x4 b) { u32x4 p; p.x = pk2(a.x, a.y); p.y = pk2(a.z, a.w); p.z = pk2(b.x, b.y); p.w = pk2(b.z, b.w); return __builtin_bit_cast(bf16x8, p); }
__device__ __forceinline__ float wave_sum(float v) {
#pragma unroll
    for (int o = 1; o < 64; o <<= 1) v += __shfl_xor(v, o);
    return v;
}
__device__ __forceinline__ float silu_f(float x) { return x * __builtin_amdgcn_rcpf(1.f + __expf(-x)); }
__device__ __forceinline__ int batch_of(int row) { return row < MP ? (row >> 14) : 2 + ((row - MP) >> 5); }

struct EpiQKV {
    static constexpr bool PERM = true, AFTER_DRAIN = false;
    bf16_t* QKV; float* out; int layer;
    __device__ __forceinline__ void operator()(const pg8::f32x4 (&acc)[2][2][4][2], const pg8::Unit& u, int wr, int wc, int fr, int fq) const {
        const int row0 = u.pm * 256 + wr * 64 + fr, col0 = u.pn * 256 + wc * 32 + 8 * fq;
        const bool kv = (u.pn >= 2 && u.pn < 6);
        const size_t vsel = (u.pn >= 4) ? 1 : 0;
        const size_t obase = (u.pm < 128) ? OFF_KP + vsel * (OFF_VP - OFF_KP) + (size_t)layer * MP * 512 + (size_t)row0 * 512
                                          : OFF_KS + vsel * (OFF_VS - OFF_KS) + (size_t)layer * MS * 512 + (size_t)(row0 - MP) * 512;
#pragma unroll
        for (int ai = 0; ai < 2; ++ai)
#pragma unroll
            for (int m = 0; m < 4; ++m) {
                const int row = row0 + ai * 128 + m * 16;
#pragma unroll
                for (int bj = 0; bj < 2; ++bj) {
                    const int col = col0 + bj * 128;
                    const pg8::f32x4 v0 = acc[ai][bj][m][0], v1 = acc[ai][bj][m][1];
                    u32x4 w; w.x = pg8::cvt_pk_bf16(v0[0], v0[1]); w.y = pg8::cvt_pk_bf16(v0[2], v0[3]); w.z = pg8::cvt_pk_bf16(v1[0], v1[1]); w.w = pg8::cvt_pk_bf16(v1[2], v1[3]);
                    *(u32x4*)(QKV + (size_t)row * INW + col) = w;
                    if (kv) {
                        const int c = col & 511;
                        float* dst = out + obase + (size_t)(ai * 128 + m * 16) * 512 + c;
                        *(pg8::f32x4*)dst = v0; *(pg8::f32x4*)(dst + 4) = v1;
                    }
                }
                asm volatile("" ::: "memory");
            }
    }
};
struct EpiResid {
    static constexpr bool PERM = false, AFTER_DRAIN = false;
    const float* base_p; const float* base_s;
    bf16_t* X; const float* gate;
    __device__ __forceinline__ void operator()(const pg8::f32x4 (&acc)[2][2][4][2], const pg8::Unit& u, int wr, int wc, int fr, int fq) const {
        const int col0 = u.pn * 256 + wc * 32 + 4 * fq;
        const bool uni = u.pm < 128;
        pg8::f32x4 gv[4];
        { const float* gr = gate + (size_t)batch_of(u.pm * 256 + wr * 64 + fr) * NMOD;
#pragma unroll
          for (int q = 0; q < 4; ++q) gv[q] = *(const pg8::f32x4*)(gr + col0 + (q >> 1) * 128 + (q & 1) * 16); }
#pragma unroll
        for (int grp = 0; grp < 4; ++grp) {
            const int ai = grp >> 1, m0 = (grp & 1) * 2;
            pg8::f32x4 bv[2][4];
#pragma unroll
            for (int mm = 0; mm < 2; ++mm) {
                const int row = u.pm * 256 + ai * 128 + wr * 64 + (m0 + mm) * 16 + fr;
                if (base_p) { const float* br = row < MP ? base_p + (size_t)row * DM : base_s + (size_t)(row - MP) * DM;
#pragma unroll
                    for (int q = 0; q < 4; ++q) bv[mm][q] = *(const pg8::f32x4*)(br + col0 + (q >> 1) * 128 + (q & 1) * 16);
                } else { const bf16_t* br = X + (size_t)row * DM;
#pragma unroll
                    for (int q = 0; q < 4; ++q) bv[mm][q] = ldx4(br + col0 + (q >> 1) * 128 + (q & 1) * 16); }
            }
#pragma unroll
            for (int mm = 0; mm < 2; ++mm) {
                const int m = m0 + mm, row = u.pm * 256 + ai * 128 + wr * 64 + m * 16 + fr;
                if (!uni) { const float* gr = gate + (size_t)batch_of(row) * NMOD;
#pragma unroll
                    for (int q = 0; q < 4; ++q) gv[q] = *(const pg8::f32x4*)(gr + col0 + (q >> 1) * 128 + (q & 1) * 16); }
                bf16_t* xr = X + (size_t)row * DM;
#pragma unroll
                for (int q = 0; q < 4; ++q) { const int bj = q >> 1, n = q & 1;
                    const pg8::f32x4 xv = bv[mm][q] + gv[q] * acc[ai][bj][m][n];
                    u32x2 w; w.x = pk2(xv[0], xv[1]); w.y = pk2(xv[2], xv[3]); *(u32x2*)(xr + col0 + bj * 128 + n * 16) = w; }
            }
            asm volatile("" ::: "memory");
        }
    }
};
struct EpiSwiGLU {
    static constexpr bool PERM = true, AFTER_DRAIN = false;
    bf16_t* ACT;
    __device__ __forceinline__ void operator()(const pg8::f32x4 (&acc)[2][2][4][2], const pg8::Unit& u, int wr, int wc, int fr, int fq) const {
        const int col0 = u.pn * 128 + wc * 32 + 8 * fq;
#pragma unroll
        for (int ai = 0; ai < 2; ++ai)
#pragma unroll
            for (int m = 0; m < 4; ++m) {
                const int row = u.pm * 256 + ai * 128 + wr * 64 + m * 16 + fr;
                const pg8::f32x4 g0 = acc[ai][0][m][0], g1 = acc[ai][0][m][1], u0 = acc[ai][1][m][0], u1 = acc[ai][1][m][1];
                float r[8];
#pragma unroll
                for (int j = 0; j < 4; ++j) { r[j] = silu_f(g0[j]) * u0[j]; r[4 + j] = silu_f(g1[j]) * u1[j]; }
                u32x4 w; w.x = pg8::cvt_pk_bf16(r[0], r[1]); w.y = pg8::cvt_pk_bf16(r[2], r[3]); w.z = pg8::cvt_pk_bf16(r[4], r[5]); w.w = pg8::cvt_pk_bf16(r[6], r[7]);
                *(u32x4*)(ACT + (size_t)row * DFF + col0) = w;
                asm volatile("" ::: "memory");
            }
    }
};


template <int NKS  , int UNR, class Epi>
__device__ __forceinline__ void sgemm_phase(LAS unsigned char* lds, const bf16_t* A  , int lda, const bf16_t* Bt, int K, int ncb,
                                            int tid, int lane, int wave, const Epi& E) {
    const int l32 = lane & 31, hf = lane >> 5;
    LAS float* red = (LAS float*)lds;
    const int kw0 = wave * NKS * 16 + hf * 8;
    for (int it = blockIdx.x; it < 16 * ncb; it += gridDim.x) {
        const int rb = it & 15, cb = it >> 4;
        int n0, n1; E.cols(cb, n0, n1);
        const bf16_t* ap = A + (size_t)(rb * 32 + l32) * lda + kw0;
        const bf16_t* b0p = Bt + (size_t)(n0 + l32) * K + kw0;
        const bf16_t* b1p = Bt + (size_t)(n1 + l32) * K + kw0;
        f32x16 c0, c1;
#pragma unroll
        for (int r = 0; r < 16; ++r) { c0[r] = 0.f; c1[r] = 0.f; }
#pragma unroll 1
        for (int kb = 0; kb < NKS; kb += UNR) {
            bf16x8 a[UNR], b0[UNR], b1[UNR];
#pragma unroll
            for (int j = 0; j < UNR; ++j) { a[j] = *(const bf16x8*)(ap + (kb + j) * 16); b0[j] = *(const bf16x8*)(b0p + (kb + j) * 16); b1[j] = *(const bf16x8*)(b1p + (kb + j) * 16); }
#pragma unroll
            for (int j = 0; j < UNR; ++j) { c0 = MFMA32(a[j], b0[j], c0); c1 = MFMA32(a[j], b1[j], c1); }
        }
        LAS float* rw = red + wave * 2176;
#pragma unroll
        for (int r = 0; r < 16; ++r) { const int row = (r >> 2) * 8 + hf * 4 + (r & 3); rw[row * 34 + l32] = c0[r]; rw[1088 + row * 34 + l32] = c1[r]; }
        __syncthreads();
        {
            const int row = tid >> 4, cc = (tid & 15) * 2;
            f32x2 g = {0.f, 0.f}, u = {0.f, 0.f};
#pragma unroll
            for (int w = 0; w < 8; ++w) { g += *(const LAS f32x2*)(red + w * 2176 + row * 34 + cc); u += *(const LAS f32x2*)(red + w * 2176 + 1088 + row * 34 + cc); }
            E(rb * 32 + row, n0 + cc, n1 + cc, g, u);
        }
        __syncthreads();
    }
}

template <class Epi>
__device__ __forceinline__ void sgemm_st_phase(LAS unsigned char* lds, const bf16_t* A, int lda, const bf16_t* Bt, int K, int ncb, int tid, int lane, int wave, const Epi& E) {
    const int l32 = lane & 31, hf = lane >> 5, rg = lane >> 3, seg = lane & 7;
    LAS unsigned char* img = lds + wave * 13824;
    const int kw0 = wave * 128;
    for (int it = blockIdx.x; it < 16 * ncb; it += gridDim.x) {
        const int rb = it & 15, cb = it >> 4;
        int n0, n1; E.cols(cb, n0, n1);
        bf16x8 ld[2][12];
#pragma unroll
        for (int h = 0; h < 2; ++h)
#pragma unroll
            for (int q = 0; q < 12; ++q) {
                const int r = (q & 3) * 8 + rg;
                const bf16_t* p = (q < 4) ? A + (size_t)(rb * 32 + r) * lda : Bt + (size_t)((q < 8 ? n0 : n1) + r) * K;
                ld[h][q] = *(const bf16x8*)(p + kw0 + h * 64 + seg * 8);
            }
        f32x16 c0, c1;
#pragma unroll
        for (int r = 0; r < 16; ++r) { c0[r] = 0.f; c1[r] = 0.f; }
#pragma unroll
        for (int h = 0; h < 2; ++h) {
#pragma unroll
            for (int q = 0; q < 12; ++q) *(LAS bf16x8*)(img + (q * 8 + rg) * 144 + seg * 16) = ld[h][q];
            asm volatile("s_waitcnt lgkmcnt(0)" ::: "memory"); __builtin_amdgcn_wave_barrier();
#pragma unroll
            for (int ks = 0; ks < 4; ++ks) {
                const bf16x8 a = *(const LAS bf16x8*)(img + l32 * 144 + ks * 32 + hf * 16), b0 = *(const LAS bf16x8*)(img + (32 + l32) * 144 + ks * 32 + hf * 16), b1 = *(const LAS bf16x8*)(img + (64 + l32) * 144 + ks * 32 + hf * 16);
                c0 = MFMA32(a, b0, c0); c1 = MFMA32(a, b1, c1);
            }
            asm volatile("s_waitcnt lgkmcnt(0)" ::: "memory"); __builtin_amdgcn_wave_barrier();
        }
        LAS float* rw = (LAS float*)img;
#pragma unroll
        for (int r = 0; r < 16; ++r) { const int row = (r >> 2) * 8 + hf * 4 + (r & 3); rw[row * 34 + l32] = c0[r]; rw[1088 + row * 34 + l32] = c1[r]; }
        __syncthreads();
        {
            const int row = tid >> 4, cc = (tid & 15) * 2;
            f32x2 g = {0.f, 0.f}, u = {0.f, 0.f};
#pragma unroll
            for (int w = 0; w < 8; ++w) { const LAS float* p = (const LAS float*)(lds + w * 13824) + row * 34 + cc; g += *(const LAS f32x2*)(p); u += *(const LAS f32x2*)(p + 1088); }
            E(rb * 32 + row, n0 + cc, n1 + cc, g, u);
        }
        __syncthreads();
    }
}
struct SEpiQKV {
    bf16_t* QKV; float* out; int layer;
    __device__ __forceinline__ void cols(int cb, int& n0, int& n1) const { n0 = cb * 64; n1 = n0 + 32; }
    __device__ __forceinline__ void emit(int r, int c, f32x2 v) const {
        *(unsigned*)(QKV + (size_t)(MP + r) * INW + c) = pk2(v.x, v.y);
        if (c >= 512 && c < 1536) { const size_t off = (c < 1024 ? OFF_KS : OFF_VS) + ((size_t)layer * MS + r) * 512 + (c & 511); *(f32x2*)(out + off) = v; }
    }
    __device__ __forceinline__ void operator()(int r, int c0, int c1, f32x2 g, f32x2 u) const { emit(r, c0, g); emit(r, c1, u); }
};
struct SEpiResid {
    const float* basef; bf16_t* Xs; const float* gate;
    __device__ __forceinline__ void cols(int cb, int& n0, int& n1) const { n0 = cb * 64; n1 = n0 + 32; }
    __device__ __forceinline__ void operator()(int r, int c0, int c1, f32x2 g, f32x2 u) const {
        const float* gp = gate + (size_t)(2 + (r >> 5)) * NMOD; bf16_t* xp = Xs + (size_t)r * DM;
        f32x2 b0, b1;
        if (basef) { b0 = *(const f32x2*)(basef + (size_t)r * DM + c0); b1 = *(const f32x2*)(basef + (size_t)r * DM + c1); }
        else { const unsigned w0 = *(const unsigned*)(xp + c0), w1 = *(const unsigned*)(xp + c1);
            b0 = (f32x2){__builtin_bit_cast(float, w0 << 16), __builtin_bit_cast(float, w0 & 0xffff0000u)}; b1 = (f32x2){__builtin_bit_cast(float, w1 << 16), __builtin_bit_cast(float, w1 & 0xffff0000u)}; }
        const f32x2 x0 = b0 + *(const f32x2*)(gp + c0) * g, x1 = b1 + *(const f32x2*)(gp + c1) * u;
        *(unsigned*)(xp + c0) = pk2(x0.x, x0.y); *(unsigned*)(xp + c1) = pk2(x1.x, x1.y);
    }
};
struct SEpiSwiGLU {
    bf16_t* ACT;
    __device__ __forceinline__ void cols(int cb, int& n0, int& n1) const { n0 = (cb >> 2) * 256 + (cb & 3) * 32; n1 = n0 + 128; }
    __device__ __forceinline__ void operator()(int r, int c0, int c1, f32x2 g, f32x2 u) const {
        const int col = (c0 >> 8) * 128 + (c0 & 127);
        *(unsigned*)(ACT + (size_t)(MP + r) * DFF + col) = pk2(silu_f(g.x) * u.x, silu_f(g.y) * u.y);
    }
};

__device__ __forceinline__ void transpose_item(const float* W, int K, int N, bf16_t* WT, LAS float* scr, int item, int lane, bool perm) {
    const int nblk = N / 32, kb = item / nblk, nb = item % nblk, k0 = 64 * kb, n0 = 32 * nb;
    int p0 = n0;
    if (perm) { if (n0 < DFF) p0 = (n0 >> 7) * 256 + (n0 & 127); else { const int n1 = n0 - DFF; p0 = (n1 >> 7) * 256 + 128 + (n1 & 127); } }
#pragma unroll 8
    for (int i = 0; i < 32; ++i) { const int kk = 2 * i + (lane >> 5); scr[kk * 33 + (lane & 31)] = W[(size_t)(k0 + kk) * N + n0 + (lane & 31)]; }
    asm volatile("s_waitcnt lgkmcnt(0)" ::: "memory"); __builtin_amdgcn_wave_barrier();
    const int c = lane & 7;
#pragma unroll
    for (int j = 0; j < 4; ++j) { const int n = (lane >> 3) + 8 * j; const LAS float* s = scr + (8 * c) * 33 + n;
        u32x4 o; o.x = pk2(s[0 * 33], s[1 * 33]); o.y = pk2(s[2 * 33], s[3 * 33]); o.z = pk2(s[4 * 33], s[5 * 33]); o.w = pk2(s[6 * 33], s[7 * 33]);
        *(u32x4*)(WT + (size_t)(p0 + n) * K + k0 + 8 * c) = o; }
    asm volatile("s_waitcnt lgkmcnt(0)" ::: "memory"); __builtin_amdgcn_wave_barrier();
}

__device__ __forceinline__ void p0_phase(const Params& P, LAS unsigned char* lds, int tid, int lane, int wave) {
    LAS float* sc = (LAS float*)lds;
    for (int i = tid; i < NBI * DM; i += 512) { const int b = i >> 10, k = i & 1023; const float c = b < 2 ? P.in[5][b * DM + k] : P.in[6][(b - 2) * DM + k]; sc[i] = silu_f(c); }
    __syncthreads();
    const int gw = blockIdx.x * 8 + wave, NGW = gridDim.x * 8;
    float* MOD = (float*)(P.ws + WS_MOD);
    for (int it = gw; it < 768; it += NGW) {
        const int l = it / 192, r = it % 192, cb = r >> 3, kc = r & 7;
        f32x4 acc[NBI];
#pragma unroll
        for (int b = 0; b < NBI; ++b) acc[b] = (f32x4){0.f, 0.f, 0.f, 0.f};
        const float* wp = P.in[9] + ((size_t)l * DM + kc * 128) * NMOD + cb * 256 + lane * 4;
        const LAS float* scp = sc + kc * 128;
#pragma unroll 16
        for (int k = 0; k < 128; ++k) { const f32x4 w = *(const f32x4*)(wp + (size_t)k * NMOD);
#pragma unroll
            for (int b = 0; b < NBI; ++b) acc[b] += scp[b * DM + k] * w; }
        if (kc == 0) { const f32x4 bv = *(const f32x4*)(P.in[10] + (size_t)l * NMOD + cb * 256 + lane * 4);
#pragma unroll
            for (int b = 0; b < NBI; ++b) acc[b] += bv; }
        float* mp = (float*)(P.ws + WS_PART) + ((size_t)kc * DEPTH + l) * NBI * NMOD + cb * 256 + lane * 4;
#pragma unroll
        for (int b = 0; b < NBI; ++b) *(f32x4*)(mp + b * NMOD) = acc[b];
    }
    LAS float* scr = (LAS float*)(lds + 73728 + wave * 8448);
    constexpr int I_IN = 16 * 112, I_OUT = 16 * 32, I_FI = 16 * 176, I_FO = 44 * 32, I_L = I_IN + I_OUT + I_FI + I_FO;
    for (int it = gw; it < DEPTH * I_L; it += NGW) {
        const int l = it / I_L; int r = it % I_L;
        if (r < I_IN) { transpose_item(P.in[11] + (size_t)l * DM * INW, DM, INW, (bf16_t*)(P.ws + WS_WIN) + (size_t)l * INW * DM, scr, r, lane, false); continue; } r -= I_IN;
        if (r < I_OUT) { transpose_item(P.in[14] + (size_t)l * DM * DM, DM, DM, (bf16_t*)(P.ws + WS_WOUT) + (size_t)l * DM * DM, scr, r, lane, false); continue; } r -= I_OUT;
        if (r < I_FI) { transpose_item(P.in[15] + (size_t)l * DM * 2 * DFF, DM, 2 * DFF, (bf16_t*)(P.ws + WS_WFI) + (size_t)l * 2 * DFF * DM, scr, r, lane, true); continue; } r -= I_FI;
        transpose_item(P.in[16] + (size_t)l * DFF * DM, DFF, DM, (bf16_t*)(P.ws + WS_WFO) + (size_t)l * DM * DFF, scr, r, lane, false);
    }
    f32x2* ROPE = (f32x2*)(P.ws + WS_ROPE);
    for (int idx = blockIdx.x * 512 + tid; idx < SEQ * 64; idx += gridDim.x * 512) {
        const int pos = idx >> 6, i = idx & 63;
        const float inv = exp2f(-(float)i * (13.287712379549449f / 64.f));
        const float ang = (float)pos * inv;
        double rev = (double)ang * 0.15915494309189535; rev -= floor(rev);
        const float rf = (float)rev;
        ROPE[idx] = (f32x2){__builtin_amdgcn_cosf(rf), __builtin_amdgcn_sinf(rf)};
    }
}

template <bool FINAL>
__device__ __forceinline__ void norm_phase(const Params& P, int l, bool from_input, const float* gain, int sh_off, int sc_off, int lane, int wave) {
    const int gw = blockIdx.x * 8 + wave, NGW = gridDim.x * 8;
    const float* MOD = (const float*)(P.ws + WS_MOD) + (size_t)l * NBI * NMOD;
    const bf16_t* X = (const bf16_t*)(P.ws + WS_X); bf16_t* H = (bf16_t*)(P.ws + WS_H);
    f32x4 g[4];
#pragma unroll
    for (int j = 0; j < 4; ++j) g[j] = *(const f32x4*)(gain + 4 * lane + 256 * j);
    auto loadrow = [&](int m, f32x4 (&v)[4]) {
        if (!FINAL && from_input) { const float* xr = m < MP ? P.in[0] + (size_t)m * DM : P.in[1] + (size_t)(m - MP) * DM;
#pragma unroll
            for (int j = 0; j < 4; ++j) v[j] = *(const f32x4*)(xr + 4 * lane + 256 * j);
        } else { const bf16_t* xr = X + (size_t)m * DM;
#pragma unroll
            for (int j = 0; j < 4; ++j) v[j] = ldx4(xr + 4 * lane + 256 * j); }
    };
    f32x4 vn[4];
    if (gw < MT) loadrow(gw, vn);
    for (int m = gw; m < MT; m += NGW) {
        f32x4 v[4]; float ss = 0.f;
#pragma unroll
        for (int j = 0; j < 4; ++j) v[j] = vn[j];
        if (m + NGW < MT) loadrow(m + NGW, vn);
        f32x4 sc[4], sh[4];
        if (!FINAL) { const float* mr = MOD + (size_t)batch_of(m) * NMOD;
#pragma unroll
            for (int j = 0; j < 4; ++j) { const int c = 4 * lane + 256 * j; sc[j] = *(const f32x4*)(mr + sc_off + c); sh[j] = *(const f32x4*)(mr + sh_off + c); } }
#pragma unroll
        for (int j = 0; j < 4; ++j) ss += (v[j].x * v[j].x + v[j].y * v[j].y) + (v[j].z * v[j].z + v[j].w * v[j].w);
        const float rstd = rsqrtf(wave_sum(ss) * (1.f / DM) + EPS);
        if (FINAL) {
            float* o = P.out + (size_t)m * DM;
#pragma unroll
            for (int j = 0; j < 4; ++j) *(f32x4*)(o + 4 * lane + 256 * j) = v[j] * rstd * g[j];
        } else {
#pragma unroll
            for (int j = 0; j < 4; ++j) { const int c = 4 * lane + 256 * j;
                const f32x4 hh = v[j] * rstd * g[j] * (1.f + sc[j]) + sh[j];
                u32x2 w; w.x = pk2(hh.x, hh.y); w.y = pk2(hh.z, hh.w);
                *(u32x2*)(H + (size_t)m * DM + c) = w; }
        }
    }
}

__device__ __forceinline__ void sb_unit(const Params& P, int l, int u, LAS unsigned char* lds, int tid, int lane, int wave) {
    const bf16_t* QKV = (const bf16_t*)(P.ws + WS_QKV);
    const int h = wave, l32 = lane & 31, hf = lane >> 5;
    const bool samp = u >= 1024;
    int qrow0, nsteps; const float* ck = nullptr; const float* cv = nullptr;
    if (!samp) { const int b = u >> 9, qb = u & 511; qrow0 = b * SEQ + qb * 32; nsteps = qb + 1; }
    else { const int bs = u - 1024; qrow0 = MP + bs * 32; nsteps = 65; ck = P.in[2] + (size_t)(l * DB + bs) * PAST * 512; cv = P.in[3] + (size_t)(l * DB + bs) * PAST * 512; }
    bf16x8 qf[4];
#pragma unroll
    for (int ks = 0; ks < 4; ++ks) qf[ks] = *(const bf16x8*)(QKV + (size_t)(qrow0 + l32) * INW + h * 64 + ks * 16 + hf * 8);
    f32x16 O0, O1;
#pragma unroll
    for (int r = 0; r < 16; ++r) { O0[r] = 0.f; O1[r] = 0.f; }
    float cum = 0.f;
    LAS unsigned char* vt = lds + 66048 + wave * 4608;
    auto issue = [&](int s, bf16x8 (&k)[4], bf16x8 (&v)[4]) {
        if (!samp || s == 0) {
            const int krow0 = samp ? qrow0 : qrow0 - s * 32;
#pragma unroll
            for (int ks = 0; ks < 4; ++ks) k[ks] = *(const bf16x8*)(QKV + (size_t)(krow0 + l32) * INW + 512 + h * 64 + ks * 16 + hf * 8);
#pragma unroll
            for (int it = 0; it < 4; ++it) { const int id = it * 64 + lane, key = id >> 3, ch = id & 7;
                v[it] = *(const bf16x8*)(QKV + (size_t)(krow0 + key) * INW + 1024 + h * 64 + ch * 8); }
        } else {
            const int kpos0 = (64 - s) * 32;
#pragma unroll
            for (int ks = 0; ks < 4; ++ks) { const float* p = ck + (size_t)(kpos0 + l32) * 512 + h * 64 + ks * 16 + hf * 8; k[ks] = pack8(*(const f32x4*)p, *(const f32x4*)(p + 4)); }
#pragma unroll
            for (int it = 0; it < 4; ++it) { const int id = it * 64 + lane, key = id >> 3, ch = id & 7;
                const float* p = cv + (size_t)(kpos0 + key) * 512 + h * 64 + ch * 8;
                v[it] = pack8(*(const f32x4*)p, *(const f32x4*)(p + 4)); }
        }
    };
    bf16x8 kf[4], vr[4];
    issue(0, kf, vr);
    for (int s = 0; s < nsteps; ++s) {
#pragma unroll
        for (int it = 0; it < 4; ++it) { const int id = it * 64 + lane, key = id >> 3, ch = id & 7; *(LAS bf16x8*)(vt + key * 144 + ch * 16) = vr[it]; }
        bf16x8 kn[4];
#pragma unroll
        for (int ks = 0; ks < 4; ++ks) kn[ks] = kf[ks];
        if (s + 1 < nsteps) issue(s + 1, kn, vr);
        asm volatile("s_waitcnt lgkmcnt(0)" ::: "memory"); __builtin_amdgcn_wave_barrier();
        f32x16 S;
#pragma unroll
        for (int r = 0; r < 16; ++r) S[r] = 0.f;
#pragma unroll
        for (int ks = 0; ks < 4; ++ks) S = MFMA32(kf[ks], qf[ks], S);
        float L[16], lb[16]; bool valid[16];
#pragma unroll
        for (int r = 0; r < 16; ++r) {
            const float z = S[r] * 0.18033688011112042f;
            const float sp = fmaxf(z, 0.f) + __builtin_amdgcn_logf(1.f + __builtin_amdgcn_exp2f(-fabsf(z)));
            const int key = (r >> 2) * 8 + hf * 4 + (r & 3);
            valid[r] = (s != 0) || (key < l32);
            L[r] = valid[r] ? -sp : 0.f; lb[r] = z - sp;
        }
        float T[4], Pp[4];
#pragma unroll
        for (int g = 0; g < 4; ++g) { T[g] = (L[4 * g] + L[4 * g + 1]) + (L[4 * g + 2] + L[4 * g + 3]); Pp[g] = __shfl_xor(T[g], 32); }
        float later[4]; float tot = 0.f;
#pragma unroll
        for (int g = 3; g >= 0; --g) { later[g] = tot; tot += T[g] + Pp[g]; }
        float w[16];
#pragma unroll
        for (int g = 0; g < 4; ++g) {
            const float s3 = cum + later[g] + (hf == 0 ? Pp[g] : 0.f);
            const float s2 = s3 + L[4 * g + 3], s1 = s2 + L[4 * g + 2], s0 = s1 + L[4 * g + 1];
            w[4 * g + 3] = valid[4 * g + 3] ? __builtin_amdgcn_exp2f(lb[4 * g + 3] + s3) : 0.f;
            w[4 * g + 2] = valid[4 * g + 2] ? __builtin_amdgcn_exp2f(lb[4 * g + 2] + s2) : 0.f;
            w[4 * g + 1] = valid[4 * g + 1] ? __builtin_amdgcn_exp2f(lb[4 * g + 1] + s1) : 0.f;
            w[4 * g + 0] = valid[4 * g + 0] ? __builtin_amdgcn_exp2f(lb[4 * g + 0] + s0) : 0.f;
        }
        cum += tot;
#pragma unroll
        for (int c = 0; c < 2; ++c) {
            u32x4 pw; pw.x = pk2(w[8 * c], w[8 * c + 1]); pw.y = pk2(w[8 * c + 2], w[8 * c + 3]); pw.z = pk2(w[8 * c + 4], w[8 * c + 5]); pw.w = pk2(w[8 * c + 6], w[8 * c + 7]);
            const bf16x8 pa = __builtin_bit_cast(bf16x8, pw);
#pragma unroll
            for (int dt = 0; dt < 2; ++dt) {
                bf16x8 vb;
#pragma unroll
                for (int i = 0; i < 8; ++i) { const int key = 16 * c + 8 * (i >> 2) + 4 * hf + (i & 3); vb[i] = *(const LAS short*)(vt + key * 144 + (l32 + 32 * dt) * 2); }
                if (dt == 0) O0 = MFMA32(pa, vb, O0); else O1 = MFMA32(pa, vb, O1);
            }
        }
        asm volatile("" ::: "memory");
        if (__all(cum < -150.f)) break;
#pragma unroll
        for (int ks = 0; ks < 4; ++ks) kf[ks] = kn[ks];
    }
    LAS float* oa = (LAS float*)lds;
#pragma unroll
    for (int r = 0; r < 16; ++r) { const int q = (r >> 2) * 8 + hf * 4 + (r & 3); oa[q * 516 + h * 64 + l32] = O0[r]; oa[q * 516 + h * 64 + 32 + l32] = O1[r]; }
    __syncthreads();
    bf16_t* Ob = (bf16_t*)(P.ws + WS_O);
    const float* gsb = P.in[12] + (size_t)l * 512;
    {
        f32x4 ra[4], rb[4]; float sq[4];
#pragma unroll
        for (int rr = 0; rr < 4; ++rr) { const int q = wave * 4 + rr;
            ra[rr] = *(const LAS f32x4*)(oa + q * 516 + 4 * lane); rb[rr] = *(const LAS f32x4*)(oa + q * 516 + 256 + 4 * lane);
            const f32x4 a = ra[rr], b = rb[rr];
            sq[rr] = (a.x * a.x + a.y * a.y) + (a.z * a.z + a.w * a.w) + (b.x * b.x + b.y * b.y) + (b.z * b.z + b.w * b.w); }
#pragma unroll
        for (int o = 1; o < 64; o <<= 1) {
#pragma unroll
            for (int rr = 0; rr < 4; ++rr) sq[rr] += __shfl_xor(sq[rr], o);
        }
        const f32x4 ga = *(const f32x4*)(gsb + 4 * lane), gb = *(const f32x4*)(gsb + 256 + 4 * lane);
#pragma unroll
        for (int rr = 0; rr < 4; ++rr) { const int q = wave * 4 + rr;
            const float rstd = rsqrtf(sq[rr] * (1.f / 512.f) + EPS);
            const f32x4 ya = ra[rr] * rstd * ga, yb = rb[rr] * rstd * gb;
            u32x2 wa, wb; wa.x = pk2(ya.x, ya.y); wa.y = pk2(ya.z, ya.w); wb.x = pk2(yb.x, yb.y); wb.y = pk2(yb.z, yb.w);
            *(u32x2*)(Ob + (size_t)(qrow0 + q) * DM + 4 * lane) = wa; *(u32x2*)(Ob + (size_t)(qrow0 + q) * DM + 256 + 4 * lane) = wb; }
    }
    __syncthreads();
}

__device__ __forceinline__ void ret_unit(const Params& P, int l, LAS unsigned char* lds, int tid, int lane, int wave,
                                         int row0, int pos0, int nchunks, int L, int h, const float* init, float* outst, bool state_only) {
    const bf16_t* QKV = (const bf16_t*)(P.ws + WS_QKV); bf16_t* Ob = (bf16_t*)(P.ws + WS_O);
    const f32x2* ROPE = (const f32x2*)(P.ws + WS_ROPE);
    const float lg2 = log2f(1.f - exp2f(-5.f - (float)h));
    LAS unsigned char *Qn = lds, *Kn = lds + 17408, *KdT = lds + 34816, *VT = lds + 53248, *SbT = lds + 71680, *Pm = lds + 106496;
    LAS float* of = (LAS float*)lds;
    const int l32 = lane & 31, hf = lane >> 5;
    const int sdt = wave >> 1, set0 = (wave & 1) * 2;
    f32x16 S0, S1;
#pragma unroll
    for (int r = 0; r < 16; ++r) { S0[r] = 0.f; S1[r] = 0.f; }
    if (init) {
        int ipo = (sdt * 32 + hf * 4) * 128 + set0 * 32 + l32; asm volatile("" : "+v"(ipo));
        const float* ip = init + ipo;
#pragma unroll
        for (int r = 0; r < 16; ++r) { S0[r] = ip[((r >> 2) * 8 + (r & 3)) * 128]; S1[r] = ip[((r >> 2) * 8 + (r & 3)) * 128 + 32]; if ((r & 3) == 3) asm volatile("" ::: "memory"); }
    }
    if (!state_only) {
#pragma unroll
        for (int g = 0; g < 4; ++g) { const int d0 = sdt * 32 + g * 8 + hf * 4;
            u32x2 a, b; a.x = pk2(S0[4 * g], S0[4 * g + 1]); a.y = pk2(S0[4 * g + 2], S0[4 * g + 3]); b.x = pk2(S1[4 * g], S1[4 * g + 1]); b.y = pk2(S1[4 * g + 2], S1[4 * g + 3]);
            *(LAS u32x2*)(SbT + (set0 * 32 + l32) * 272 + d0 * 2) = a; *(LAS u32x2*)(SbT + ((set0 + 1) * 32 + l32) * 272 + d0 * 2) = b; }
    }
    const float gL = exp2f((float)L * lg2);
    const int lt = wave >> 2, et = wave & 3;
    bf16x8 rk1, rk2, rq1, rq2, rv0, rv1; f32x4 rcs[4];
    const bf16x8 z8 = {0, 0, 0, 0, 0, 0, 0, 0};
    auto issue = [&](int c) {
        const int t = tid >> 3, i0 = (tid & 7) * 8; const bool ok = t < L;
        const size_t row = (size_t)(row0 + c * 64 + t);
        rk1 = z8; rk2 = z8; rq1 = z8; rq2 = z8;
#pragma unroll
        for (int i = 0; i < 4; ++i) rcs[i] = (f32x4){0.f, 0.f, 0.f, 0.f};
        if (ok) {
            rk1 = *(const bf16x8*)(QKV + row * INW + 2048 + h * 128 + i0); rk2 = *(const bf16x8*)(QKV + row * INW + 2048 + h * 128 + 64 + i0);
            if (!state_only) { rq1 = *(const bf16x8*)(QKV + row * INW + 1536 + h * 128 + i0); rq2 = *(const bf16x8*)(QKV + row * INW + 1536 + h * 128 + 64 + i0); }
            const f32x4* rp = (const f32x4*)(ROPE + (size_t)(pos0 + c * 64 + t) * 64 + i0);
#pragma unroll
            for (int i = 0; i < 4; ++i) rcs[i] = rp[i];
        }
        const int t0 = tid >> 4, ch = tid & 15;
        rv0 = z8; rv1 = z8;
        if (t0 < L) rv0 = *(const bf16x8*)(QKV + (size_t)(row0 + c * 64 + t0) * INW + 2560 + h * 128 + ch * 8);
        if (t0 + 32 < L) rv1 = *(const bf16x8*)(QKV + (size_t)(row0 + c * 64 + t0 + 32) * INW + 2560 + h * 128 + ch * 8);
    };
    issue(0);
    const int l32_0 = l32, hf_0 = hf, tid_0 = tid; const float lg2_0 = lg2;
#pragma unroll 1
    for (int c = 0; c < nchunks; ++c) {
        int l32 = l32_0, hf = hf_0, tid = tid_0; float lg2 = lg2_0;
        asm volatile("" : "+v"(l32), "+v"(hf), "+v"(tid), "+v"(lg2));
        {
            const int t = tid >> 3, pc = tid & 7, i0 = pc * 8; const bool ok = t < L;
            const float kd = ok ? __builtin_amdgcn_exp2f((float)(L - 1 - t) * lg2) : 0.f;
            const int tsw = (((t >> 3) ^ pc) << 4) + (t & 7) * 2;
            float cs_c[8], cs_s[8];
#pragma unroll
            for (int i = 0; i < 4; ++i) { cs_c[2 * i] = rcs[i].x; cs_s[2 * i] = rcs[i].y; cs_c[2 * i + 1] = rcs[i].z; cs_s[2 * i + 1] = rcs[i].w; }
            {
                float o1[8], o2[8];
#pragma unroll
                for (int i = 0; i < 8; ++i) { const float x1 = bf2f((unsigned short)rk1[i]), x2 = bf2f((unsigned short)rk2[i]);
                    o1[i] = (x1 * cs_c[i] - x2 * cs_s[i]) * 0.08838834764831845f; o2[i] = (x1 * cs_s[i] + x2 * cs_c[i]) * 0.08838834764831845f; }
                if (!state_only) {
                    u32x4 a, b; a.x = pk2(o1[0], o1[1]); a.y = pk2(o1[2], o1[3]); a.z = pk2(o1[4], o1[5]); a.w = pk2(o1[6], o1[7]);
                    b.x = pk2(o2[0], o2[1]); b.y = pk2(o2[2], o2[3]); b.z = pk2(o2[4], o2[5]); b.w = pk2(o2[6], o2[7]);
                    *(LAS u32x4*)(Kn + t * 272 + i0 * 2) = a; *(LAS u32x4*)(Kn + t * 272 + (64 + i0) * 2) = b;
                }
#pragma unroll
                for (int i = 0; i < 8; ++i) { *(LAS unsigned short*)(KdT + (i0 + i) * 144 + tsw) = (unsigned short)f2bf(o1[i] * kd); *(LAS unsigned short*)(KdT + (64 + i0 + i) * 144 + tsw) = (unsigned short)f2bf(o2[i] * kd); }
            }
            if (!state_only) {
                float o1[8], o2[8];
#pragma unroll
                for (int i = 0; i < 8; ++i) { const float x1 = bf2f((unsigned short)rq1[i]), x2 = bf2f((unsigned short)rq2[i]);
                    o1[i] = x1 * cs_c[i] - x2 * cs_s[i]; o2[i] = x1 * cs_s[i] + x2 * cs_c[i]; }
                u32x4 a, b; a.x = pk2(o1[0], o1[1]); a.y = pk2(o1[2], o1[3]); a.z = pk2(o1[4], o1[5]); a.w = pk2(o1[6], o1[7]);
                b.x = pk2(o2[0], o2[1]); b.y = pk2(o2[2], o2[3]); b.z = pk2(o2[4], o2[5]); b.w = pk2(o2[6], o2[7]);
                *(LAS u32x4*)(Qn + t * 272 + i0 * 2) = a; *(LAS u32x4*)(Qn + t * 272 + (64 + i0) * 2) = b;
            }
            {
                const int t0 = tid >> 4, ch = tid & 15, sw = ch & 7;
                const int o0 = (((t0 >> 3) ^ sw) << 4) + (t0 & 7) * 2, o1b = ((((t0 + 32) >> 3) ^ sw) << 4) + (t0 & 7) * 2;
#pragma unroll
                for (int i = 0; i < 8; ++i) { *(LAS short*)(VT + (ch * 8 + i) * 144 + o0) = rv0[i]; *(LAS short*)(VT + (ch * 8 + i) * 144 + o1b) = rv1[i]; }
            }
        }
        if (c + 1 < nchunks) issue(c + 1);
        unsigned gpre[8];
#pragma unroll
        for (int rr = 0; rr < 8; ++rr) { const int t = wave * 8 + rr; gpre[rr] = (!state_only && t < L) ? *(const unsigned*)(QKV + (size_t)(row0 + c * 64 + t) * INW + 3072 + h * 128 + lane * 2) : 0u; }
        __syncthreads();
        f32x16 acc;
        if (!state_only) {
#pragma unroll
            for (int r = 0; r < 16; ++r) acc[r] = 0.f;
#pragma unroll
            for (int ks = 0; ks < 8; ++ks) { const bf16x8 a = *(const LAS bf16x8*)(Qn + (lt * 32 + l32) * 272 + (ks * 16 + hf * 8) * 2), b = *(const LAS bf16x8*)(SbT + (et * 32 + l32) * 272 + (ks * 16 + hf * 8) * 2); acc = MFMA32(a, b, acc); }
#pragma unroll
            for (int r = 0; r < 16; ++r) { const int tl = lt * 32 + (r >> 2) * 8 + hf * 4 + (r & 3); acc[r] *= __builtin_amdgcn_exp2f((float)(tl + 1) * lg2); }
            if (wave < 4) {
                const int slt = wave >> 1, smt = wave & 1;
                f32x16 sc;
#pragma unroll
                for (int r = 0; r < 16; ++r) sc[r] = 0.f;
                if (slt >= smt) {
#pragma unroll
                    for (int ks = 0; ks < 8; ++ks) { const bf16x8 a = *(const LAS bf16x8*)(Qn + (slt * 32 + l32) * 272 + (ks * 16 + hf * 8) * 2), b = *(const LAS bf16x8*)(Kn + (smt * 32 + l32) * 272 + (ks * 16 + hf * 8) * 2); sc = MFMA32(a, b, sc); }
                }
                const int tm = smt * 32 + l32;
#pragma unroll
                for (int r = 0; r < 16; ++r) { const int tl = slt * 32 + (r >> 2) * 8 + hf * 4 + (r & 3);
                    const float p = tl >= tm ? sc[r] * __builtin_amdgcn_exp2f((float)(tl - tm) * lg2) : 0.f;
                    *(LAS unsigned short*)(Pm + tl * 144 + tm * 2) = (unsigned short)f2bf(p); }
            }
            __syncthreads();
#pragma unroll
            for (int ms = 0; ms < 4; ++ms) { const bf16x8 a = *(const LAS bf16x8*)(Pm + (lt * 32 + l32) * 144 + (ms * 16 + hf * 8) * 2), b = *(const LAS bf16x8*)(VT + (et * 32 + l32) * 144 + (((ms * 2 + hf) ^ ((et * 4 + (l32 >> 3)) & 7)) << 4)); acc = MFMA32(a, b, acc); }
#pragma unroll
            for (int r = 0; r < 16; ++r) { const int tl = lt * 32 + (r >> 2) * 8 + hf * 4 + (r & 3); of[tl * 132 + et * 32 + l32] = acc[r]; }
        }
#pragma unroll
        for (int r = 0; r < 16; ++r) { S0[r] *= gL; S1[r] *= gL; }
#pragma unroll
        for (int ts = 0; ts < 4; ++ts) {
            const int cc = ts * 2 + hf, rs = l32 >> 3;
            const bf16x8 a = *(const LAS bf16x8*)(KdT + (sdt * 32 + l32) * 144 + ((cc ^ ((sdt * 4 + rs) & 7)) << 4));
            const bf16x8 b0 = *(const LAS bf16x8*)(VT + (set0 * 32 + l32) * 144 + ((cc ^ ((set0 * 4 + rs) & 7)) << 4)), b1 = *(const LAS bf16x8*)(VT + ((set0 + 1) * 32 + l32) * 144 + ((cc ^ (((set0 + 1) * 4 + rs) & 7)) << 4));
            S0 = MFMA32(a, b0, S0); S1 = MFMA32(a, b1, S1);
        }
        if (!state_only) {
#pragma unroll
            for (int g = 0; g < 4; ++g) { const int d0 = sdt * 32 + g * 8 + hf * 4;
                u32x2 a, b; a.x = pk2(S0[4 * g], S0[4 * g + 1]); a.y = pk2(S0[4 * g + 2], S0[4 * g + 3]); b.x = pk2(S1[4 * g], S1[4 * g + 1]); b.y = pk2(S1[4 * g + 2], S1[4 * g + 3]);
                *(LAS u32x2*)(SbT + (set0 * 32 + l32) * 272 + d0 * 2) = a; *(LAS u32x2*)(SbT + ((set0 + 1) * 32 + l32) * 272 + d0 * 2) = b; }
            __syncthreads();
            const f32x2 gr = *(const f32x2*)(P.in[13] + (size_t)(l * 4 + h) * 128 + lane * 2);
            f32x2 ov[8]; float sq[8];
#pragma unroll
            for (int rr = 0; rr < 8; ++rr) { ov[rr] = *(const LAS f32x2*)(of + (wave * 8 + rr) * 132 + lane * 2); sq[rr] = ov[rr].x * ov[rr].x + ov[rr].y * ov[rr].y; }
#pragma unroll
            for (int o = 1; o < 64; o <<= 1) {
#pragma unroll
                for (int rr = 0; rr < 8; ++rr) sq[rr] += __shfl_xor(sq[rr], o);
            }
#pragma unroll
            for (int rr = 0; rr < 8; ++rr) {
                const int t = wave * 8 + rr;
                if (t < L) {
                    const float rstd = rsqrtf(sq[rr] * (1.f / 128.f) + EPS);
                    const size_t row = (size_t)(row0 + c * 64 + t);
                    const unsigned gg = gpre[rr];
                    const float y0 = ov[rr].x * rstd * gr.x * silu_f(bf2f(gg & 0xffffu)), y1 = ov[rr].y * rstd * gr.y * silu_f(bf2f(gg >> 16));
                    *(unsigned*)(Ob + row * DM + 512 + h * 128 + lane * 2) = pk2(y0, y1);
                }
            }
        }
        __syncthreads();
    }
    if (outst) {
        float* op = outst + (sdt * 32 + hf * 4) * 128 + set0 * 32 + l32;
#pragma unroll
        for (int r = 0; r < 16; ++r) { op[((r >> 2) * 8 + (r & 3)) * 128] = S0[r]; op[((r >> 2) * 8 + (r & 3)) * 128 + 32] = S1[r]; if ((r & 3) == 3) asm volatile("" ::: "memory"); }
    }
}


#define XB_TMO      128
#define XB_XCNT(j)  (256  + 64 * (j))
#define XB_XSUB(j)  (1280 + 64 * (j))
#define XB_XGEN(j)  (2304 + 64 * (j))
#define XB_TOP      3328
#define XB_TOPGEN   3392
#define XCD_BAR_WORDS 3456
#define XB_SPIN_CAP (1u << 18)

__device__ __forceinline__ unsigned xb_ld(unsigned* p)              { return __hip_atomic_load(p, __ATOMIC_RELAXED, __HIP_MEMORY_SCOPE_AGENT); }
__device__ __forceinline__ unsigned xb_add(unsigned* p, unsigned v) { return __hip_atomic_fetch_add(p, v, __ATOMIC_RELAXED, __HIP_MEMORY_SCOPE_AGENT); }
__device__ __forceinline__ unsigned xb_xcc_id() { return (unsigned)__builtin_amdgcn_s_getreg((3 << 11) | 20) & 0xFu; }
#define XB_SPIN(cond, bar) do { unsigned _sp = 0; while (cond) { __builtin_amdgcn_s_sleep(1); \
    if ((++_sp & 255u) == 0u) { if (xb_ld(&(bar)[XB_TMO])) break; if (_sp > XB_SPIN_CAP) { atomicAdd(&(bar)[XB_TMO], 1u); break; } } } } while (0)

struct XcdBarrier {
    unsigned* bar; unsigned x;
    volatile LAS unsigned* st;
};

__device__ __forceinline__ XcdBarrier xcd_barrier_post(unsigned* bar, volatile LAS unsigned* st) {
    XcdBarrier b; b.bar = bar; b.x = xb_xcc_id(); b.st = st;
    if (threadIdx.x == 0) (void)xb_add(&bar[XB_XCNT(b.x)], 1u);
    return b;
}
__device__ __forceinline__ void xcd_barrier_complete(unsigned* bar, unsigned x, unsigned& nloc, unsigned& nx) {
    const unsigned G = gridDim.x * gridDim.y * gridDim.z;
    unsigned sum, cnt, mine, sp = 0u;
    for (;;) {
        sum = 0u; cnt = 0u; mine = 0u;
#pragma unroll
        for (unsigned j = 0; j < 16; ++j) { const unsigned c = xb_ld(&bar[XB_XCNT(j)]); sum += c; cnt += (c > 0u) ? 1u : 0u; mine = (j == x) ? c : mine; }
        if (sum == G) break;
        __builtin_amdgcn_s_sleep(1);
        if ((++sp & 255u) == 0u) { if (xb_ld(&bar[XB_TMO])) break; if (sp > XB_SPIN_CAP) { atomicAdd(&bar[XB_TMO], 1u); break; } }
    }
    nloc = mine > 0u ? mine : 1u; nx = cnt > 0u ? cnt : 1u;
}

__device__ __forceinline__ void xcd_barrier(const XcdBarrier& b) {
    asm volatile("s_waitcnt vmcnt(0)" ::: "memory");
    __syncthreads();
    if (threadIdx.x == 0) {
        unsigned* bar = b.bar;
        __builtin_amdgcn_s_waitcnt(0);
        unsigned nloc = b.st[0], nx = b.st[1];
        if (nloc == 0u) { xcd_barrier_complete(bar, b.x, nloc, nx); b.st[0] = nloc; b.st[1] = nx; }
        const unsigned old = xb_add(&bar[XB_XSUB(b.x)], 1u);
        const unsigned gen = old / nloc;
        if (old + 1u == (gen + 1u) * nloc) {
            __builtin_amdgcn_fence(__ATOMIC_RELEASE, "agent");
            asm volatile("s_waitcnt vmcnt(0)" ::: "memory");
            const unsigned og = xb_add(&bar[XB_TOP], 1u);
            const unsigned tg = og / nx;
            if (og + 1u == (tg + 1u) * nx) xb_add(&bar[XB_TOPGEN], 1u);
            else XB_SPIN(xb_ld(&bar[XB_TOPGEN]) == tg, bar);
            __builtin_amdgcn_fence(__ATOMIC_ACQUIRE, "agent");
            xb_add(&bar[XB_XGEN(b.x)], 1u);
            asm volatile("s_waitcnt vmcnt(0)" ::: "memory");
        } else {
            XB_SPIN(xb_ld(&bar[XB_XGEN(b.x)]) == gen, bar);
            __builtin_amdgcn_fence(__ATOMIC_ACQUIRE, "agent");
            asm volatile("s_waitcnt vmcnt(0)" ::: "memory");
        }
    }
    __syncthreads();
}
__global__ void __launch_bounds__(512, 2) fwd_megakernel(Params P) {
    extern __shared__ __attribute__((aligned(16))) unsigned char lds_raw[];
    LAS unsigned char* lds = (LAS unsigned char*)lds_raw;
    cg::grid_group grid = cg::this_grid();
    int tid = threadIdx.x, lane = tid & 63, wave = __builtin_amdgcn_readfirstlane(tid >> 6);
#define REFRESH() do { tid = threadIdx.x; asm volatile("" : "+v"(tid)); lane = tid & 63; wave = __builtin_amdgcn_readfirstlane(tid >> 6); } while (0)
    const int G = gridDim.x, bx = blockIdx.x;
#define H ((bf16_t*)(P.ws + WS_H))
#define Ob ((bf16_t*)(P.ws + WS_O))
#define QKV ((bf16_t*)(P.ws + WS_QKV))
#define ACT ((bf16_t*)(P.ws + WS_QKV))
#define X ((bf16_t*)(P.ws + WS_X))
#define U ((float*)(P.ws + WS_U))
#define MOD ((const float*)(P.ws + WS_MOD))

    volatile LAS unsigned* bst = (volatile LAS unsigned*)(lds + LDS_BYTES - 64);
    if (tid == 0) { bst[0] = 0u; bst[1] = 0u; }
    __syncthreads();
    (void)xcd_barrier_post((unsigned*)(P.ws + WS_BAR), bst);
#define XBAR() do { XcdBarrier xb_; xb_.bar = (unsigned*)(P.ws + WS_BAR); xb_.x = xb_xcc_id(); xb_.st = (volatile LAS unsigned*)(lds + LDS_BYTES - 64); xcd_barrier(xb_); } while (0)
#ifndef SK_P0
    p0_phase(P, lds, tid, lane, wave);
#endif
    XBAR(); REFRESH();
    {
        const f32x4* part = (const f32x4*)(P.ws + WS_PART); f32x4* mod4 = (f32x4*)(P.ws + WS_MOD);
        constexpr int NV = DEPTH * NBI * NMOD / 4;
        for (int i = bx * 512 + tid; i < NV; i += G * 512) {
            f32x4 a = part[i];
#pragma unroll
            for (int kc = 1; kc < 8; ++kc) a += part[(size_t)kc * NV + i];
            mod4[i] = a;
        }
    }
    if (P.ws == nullptr) grid.sync();
    XBAR(); REFRESH();
#pragma unroll 1
    for (int l = 0; l < DEPTH; ++l) {
        norm_phase<false>(P, l, l == 0, P.in[7] + (size_t)l * DM, 0, 1024, lane, wave);
        XBAR(); REFRESH();
#ifndef SK_G1
        {
            pg8::Gemm g{H, (const bf16_t*)(P.ws + WS_WIN) + (size_t)l * INW * DM, MP, INW, DM}; pg8::StaticOrder S; S.init(MP, INW, G, bx);
            EpiQKV E{QKV, P.out, l};
            pg8::gemm_phase<EpiQKV, pg8::StaticOrder, true, true>(lds, g, S, E);
            SEpiQKV SE{QKV, P.out, l};
            sgemm_st_phase<SEpiQKV>(lds, H + (size_t)MP * DM, DM, g.Bt, DM, INW / 64, tid, lane, wave, SE);
        }
#endif
        XBAR(); REFRESH();
        {
            unsigned* qhead = (unsigned*)(P.ws + WS_CTR) + l * 64;
            volatile LAS unsigned* qslot = (volatile LAS unsigned*)(lds + LDS_BYTES - 128);
            for (;;) {
                if (tid == 0) *qslot = __hip_atomic_fetch_add(qhead, 1u, __ATOMIC_RELAXED, __HIP_MEMORY_SCOPE_AGENT);
                __syncthreads();
                const int u = (int)*qslot;
                __syncthreads();
                if (u >= 1616) break;
                REFRESH();
                if (u < 256) { const int bh = u >> 5, seg = u & 31, b = bh >> 2, h = bh & 3;
                    ret_unit(P, l, lds, tid, lane, wave, b * SEQ + seg * 512, seg * 512, 8, 64, h, nullptr, U + (size_t)(bh * 32 + seg) * 16384, true);
                    asm volatile("s_waitcnt vmcnt(0)" ::: "memory");
                    __syncthreads();
                    if (tid == 0) {
                        __builtin_amdgcn_fence(__ATOMIC_RELEASE, "agent");
                        asm volatile("s_waitcnt vmcnt(0)" ::: "memory");
                        const unsigned old = __hip_atomic_fetch_add((unsigned*)(P.ws + WS_CTR + 1024) + l * 8 + bh, 1u, __ATOMIC_RELAXED, __HIP_MEMORY_SCOPE_AGENT);
                        const unsigned last = (old == 31u) ? 1u : 0u;
                        if (last) { __builtin_amdgcn_fence(__ATOMIC_ACQUIRE, "agent"); asm volatile("s_waitcnt vmcnt(0)" ::: "memory"); }
                        qslot[1] = last;
                    }
                    __syncthreads();
                    if (qslot[1]) {
                        const float g512 = exp2f(512.f * log2f(1.f - exp2f(-5.f - (float)h)));
#pragma unroll 1
                        for (int j = 0; j < 32; ++j) {
                            const int within = j * 512 + tid;
                            float* up = U + (size_t)bh * 32 * 16384 + within; float sst = 0.f;
                            float uv[32];
#pragma unroll
                            for (int sg = 0; sg < 32; ++sg) uv[sg] = up[(size_t)sg * 16384];
#pragma unroll
                            for (int sg = 0; sg < 32; ++sg) { up[(size_t)sg * 16384] = sst; sst = g512 * sst + uv[sg]; }
                            P.out[OFF_RP + ((size_t)l * 8 + bh) * 16384 + within] = sst;
                        }
                        asm volatile("s_waitcnt vmcnt(0)" ::: "memory");
                        __syncthreads();
                        if (tid == 0) { __builtin_amdgcn_fence(__ATOMIC_RELEASE, "agent"); asm volatile("s_waitcnt vmcnt(0)" ::: "memory");
                            __hip_atomic_store((unsigned*)(P.ws + WS_CTR + 1152) + l * 8 + bh, 1u, __ATOMIC_RELAXED, __HIP_MEMORY_SCOPE_AGENT); }
                    }
                }
                else if (u < 272) sb_unit(P, l, 1024 + (u - 256), lds, tid, lane, wave);
                else if (u < 1296) { const int v = u - 272; sb_unit(P, l, (v & 1) * 512 + (511 - (v >> 1)), lds, tid, lane, wave); }
                else if (u < 1360) { const int idx = u - 1296, bs = idx >> 2, h = idx & 3; const size_t so = ((size_t)(l * DB + bs) * 4 + h) * 16384;
                    ret_unit(P, l, lds, tid, lane, wave, MP + bs * 32, PAST, 1, 32, h, P.in[4] + so, P.out + OFF_RS + so, false); }
                else {
                    const int v = u - 1360, bh = v >> 5, seg = v & 31, b = bh >> 2, h = bh & 3;
                    if (tid == 0) {
                        unsigned* fl = (unsigned*)(P.ws + WS_CTR + 1152) + l * 8 + bh; unsigned sp = 0u;
                        while (__hip_atomic_load(fl, __ATOMIC_RELAXED, __HIP_MEMORY_SCOPE_AGENT) == 0u && ++sp < (1u << 22)) __builtin_amdgcn_s_sleep(2);
                        __builtin_amdgcn_fence(__ATOMIC_ACQUIRE, "agent"); asm volatile("s_waitcnt vmcnt(0)" ::: "memory");
                    }
                    __syncthreads();
                    ret_unit(P, l, lds, tid, lane, wave, b * SEQ + seg * 512, seg * 512, 8, 64, h, (const float*)(P.ws + WS_U) + (size_t)(bh * 32 + seg) * 16384, nullptr, false);
                }
            }
        }
        XBAR(); REFRESH();
#ifndef SK_G2
        {
            pg8::Gemm g{Ob, (const bf16_t*)(P.ws + WS_WOUT) + (size_t)l * DM * DM, MP, DM, DM}; pg8::StaticOrder S; S.init(MP, DM, G, bx);
            EpiResid E{l == 0 ? P.in[0] : nullptr, l == 0 ? P.in[1] : nullptr, X, MOD + (size_t)l * NBI * NMOD + 2048};
            pg8::gemm_phase<EpiResid, pg8::StaticOrder, true, true>(lds, g, S, E);
            SEpiResid SE{l == 0 ? P.in[1] : nullptr, X + (size_t)MP * DM, MOD + (size_t)l * NBI * NMOD + 2048};
            sgemm_phase<8, 8, SEpiResid>(lds, Ob + (size_t)MP * DM, DM, g.Bt, DM, DM / 64, tid, lane, wave, SE);
        }
#endif
        XBAR(); REFRESH();
        norm_phase<false>(P, l, false, P.in[8] + (size_t)l * DM, 3072, 4096, lane, wave);
        XBAR(); REFRESH();
#ifndef SK_G3
        {
            pg8::Gemm g{H, (const bf16_t*)(P.ws + WS_WFI) + (size_t)l * 2 * DFF * DM, MP, 2 * DFF, DM}; pg8::StaticOrder S; S.init(MP, 2 * DFF, G, bx);
            EpiSwiGLU E{ACT};
            pg8::gemm_phase<EpiSwiGLU, pg8::StaticOrder, true, true>(lds, g, S, E);
            SEpiSwiGLU SE{ACT};
            sgemm_st_phase<SEpiSwiGLU>(lds, H + (size_t)MP * DM, DM, g.Bt, DM, (2 * DFF / 256) * 4, tid, lane, wave, SE);
        }
#endif
        XBAR(); REFRESH();
#ifndef SK_G4
        {
            pg8::Gemm g{ACT, (const bf16_t*)(P.ws + WS_WFO) + (size_t)l * DM * DFF, MP, DM, DFF}; pg8::StaticOrder S; S.init(MP, DM, G, bx);
            EpiResid E{nullptr, nullptr, X, MOD + (size_t)l * NBI * NMOD + 5120};
            pg8::gemm_phase<EpiResid, pg8::StaticOrder, true, true>(lds, g, S, E);
            SEpiResid SE{nullptr, X + (size_t)MP * DM, MOD + (size_t)l * NBI * NMOD + 5120};
            sgemm_phase<22, 11, SEpiResid>(lds, ACT + (size_t)MP * DFF, DFF, g.Bt, DFF, DM / 64, tid, lane, wave, SE);
        }
#endif
        XBAR(); REFRESH();
    }
    norm_phase<true>(P, 0, false, P.in[17], 0, 0, lane, wave);
}

#undef H
#undef Ob
#undef QKV
#undef ACT
#undef X
#undef U
#undef MOD
extern "C" void kernel_launch(void* const* d_in, const int* in_sizes, int n_in, void* d_out, int out_size, void* d_ws, size_t ws_size, hipStream_t stream) {
    static int grid = 0;
    if (grid == 0) {
        if (n_in != 18 || ws_size < WS_END) { fprintf(stderr, "kernel_launch: unexpected n_in %d / ws_size %zu\n", n_in, ws_size); grid = -1; return; }
        int dev = 0, cus = 0, per_cu = 0;
        (void)hipGetDevice(&dev); (void)hipDeviceGetAttribute(&cus, hipDeviceAttributeMultiprocessorCount, dev);
        if (hipFuncSetAttribute((const void*)fwd_megakernel, hipFuncAttributeMaxDynamicSharedMemorySize, LDS_BYTES) != hipSuccess) { fprintf(stderr, "kernel_launch: hipFuncSetAttribute failed\n"); grid = -1; return; }
        (void)hipOccupancyMaxActiveBlocksPerMultiprocessor(&per_cu, (const void*)fwd_megakernel, 512, LDS_BYTES);
        (void)hipGetLastError();
        if (per_cu < 1) { fprintf(stderr, "kernel_launch: occupancy query says %d blocks per CU\n", per_cu); per_cu = 1; }
        grid = cus;
    }
    if (grid < 0) return;
    (void)hipMemsetAsync((char*)d_ws + WS_BAR, 0, 20480, stream);
    Params p{};
    for (int i = 0; i < 18; ++i) p.in[i] = (const float*)d_in[i];
    p.out = (float*)d_out; p.ws = (unsigned char*)d_ws;
    void* args[] = {&p};
    hipError_t e = hipLaunchCooperativeKernel((const void*)fwd_megakernel, dim3(grid), dim3(512), args, LDS_BYTES, stream);
    if (e != hipSuccess) fprintf(stderr, "cooperative launch failed: %s (grid %d)\n", hipGetErrorString(e), grid);
}
```

```cpp
#include <hip/hip_runtime.h>
#include <hip/hip_cooperative_groups.h>
#include <cstdio>
#include <cstdint>
namespace cg = cooperative_groups;
namespace pg8 {
#define PG8_LAS __attribute__((address_space(3)))
typedef unsigned short bf16_t;
typedef short bf16x8 __attribute__((ext_vector_type(8)));
typedef float f32x4 __attribute__((ext_vector_type(4)));
typedef unsigned u32x4 __attribute__((ext_vector_type(4)));
constexpr int BM = 256, BK = 64, HALF = 128, HTB = HALF * BK * 2  , STAGE_BYTES = 8 * HTB, NXCD = 8, WGM = 4;

__host__ __device__ __forceinline__ int lds_byte(int r, int c) { const int st = (r >> 4) * 2 + (c >> 5), rr = r & 15, cc = c & 31, ob = rr * 64 + cc * 2; return st * 1024 + (ob ^ (((ob >> 9) & 1) << 5)); }
__host__ __device__ __forceinline__ void stage_rc(int b, int& R, int& C) { const int st = b / 1024, sb = b % 1024, swz = sb ^ (((sb >> 9) & 1) << 5); R = (st >> 1) * 16 + swz / 64; C = (st & 1) * 32 + (swz % 64) / 2; }
__host__ __device__ __forceinline__ int perm32(int rho) { const int n = rho >> 4, i = rho & 15; return 8 * (i >> 2) + 4 * n + (i & 3); }

struct Unit { int pm, pn; };
struct Gemm { const bf16_t* A; const bf16_t* Bt; int M, N, K; };

struct StaticOrder {
    int nM, nN, nwg, G, c;
    __host__ __device__ void init(int M, int N, int G_, int c_) { nM = M / BM; nN = N / BM; nwg = nM * nN; G = G_; c = c_; }
    __host__ __device__ bool next(int i, Unit& u) const {
        const long L = (long)i * G + c; if (L >= nwg) return false;
        int wgid = (int)L; { const int q = nwg / NXCD, r = nwg % NXCD, xcd = wgid % NXCD, off = wgid / NXCD; wgid = (xcd < r ? xcd * (q + 1) : r * (q + 1) + (xcd - r) * q) + off; }
        const int nig = WGM * nN, gid = wgid / nig, fm = gid * WGM, gsz = (nM - fm) < WGM ? (nM - fm) : WGM;
        u.pm = fm + ((wgid % nig) % gsz); u.pn = (wgid % nig) / gsz; return true;
    }
    __device__ __forceinline__ void a_ready(const Unit&) const {}
    __device__ __forceinline__ void done(const Unit&) const {}
};

__device__ __forceinline__ unsigned cvt_pk_bf16(float lo, float hi) { unsigned r; asm volatile("v_cvt_pk_bf16_f32 %0, %1, %2" : "=v"(r) : "v"(lo), "v"(hi)); return r; }
typedef float f32x2 __attribute__((ext_vector_type(2)));
__device__ __forceinline__ f32x2 gelu_pk(f32x2 v) {
    const f32x2 av = __builtin_elementwise_abs(v), d = av * 0.2316418882f + 1.0f;
    f32x2 t; t.x = __builtin_amdgcn_rcpf(d.x); t.y = __builtin_amdgcn_rcpf(d.y);
    f32x2 q = t * 0.5307027145f + (-0.7265760135f); q = q * t + 0.7107068705f; q = q * t + (-0.142248368f); q = q * t + 0.127414796f; q = q * t;
    const f32x2 s = (v * v) * (-0.72134752044f);
    f32x2 e; e.x = __builtin_amdgcn_exp2f(s.x); e.y = __builtin_amdgcn_exp2f(s.y);
    const f32x2 m = v * (q * e), r = v - m;
    f32x2 o; o.x = v.x < 0.f ? m.x : r.x; o.y = v.y < 0.f ? m.y : r.y; return o;
}

template <int ACT  > struct EpiBf16 {
    static constexpr bool PERM = true, AFTER_DRAIN = false; static_assert(ACT == 0 || ACT == 1, "EpiBf16: ACT is 0 (none) or 1 (gelu_pk)");
    bf16_t* O; int ldc; const float* bias; int split_cols; size_t split_stride; float scale0;
    __device__ __forceinline__ void operator()(const f32x4 (&acc)[2][2][4][2], const Unit& u, int wr, int wc, int fr, int fq) const {
        const int row0 = u.pm * BM + wr * 64 + fr; int colt = u.pn * BM; bf16_t* base = O;
        float sc = 1.f; if (split_cols) { const int t = colt / split_cols; base += (size_t)t * split_stride; colt -= t * split_cols; if (t == 0) sc = scale0; }
        const int col0 = colt + wc * 32 + 8 * fq, bcol0 = u.pn * BM + wc * 32 + 8 * fq;
        f32x4 bv[2][2];
#pragma unroll
        for (int bj = 0; bj < 2; ++bj)
#pragma unroll
            for (int n = 0; n < 2; ++n) bv[bj][n] = bias ? *(const f32x4*)(bias + bcol0 + bj * HALF + 4 * n) : (f32x4){0.f, 0.f, 0.f, 0.f};
#pragma unroll
        for (int ai = 0; ai < 2; ++ai)
#pragma unroll
            for (int m = 0; m < 4; ++m) { bf16_t* rowp = base + (size_t)(row0 + ai * HALF + m * 16) * ldc + col0;
#pragma unroll
                for (int bj = 0; bj < 2; ++bj) { f32x4 v0 = acc[ai][bj][m][0] + bv[bj][0], v1 = acc[ai][bj][m][1] + bv[bj][1];
                    if (ACT == 1) { f32x2 a = gelu_pk((f32x2){v0[0], v0[1]}), b = gelu_pk((f32x2){v0[2], v0[3]}), c = gelu_pk((f32x2){v1[0], v1[1]}), d = gelu_pk((f32x2){v1[2], v1[3]});
                        v0 = (f32x4){a.x, a.y, b.x, b.y}; v1 = (f32x4){c.x, c.y, d.x, d.y}; }
                    v0 = v0 * sc; v1 = v1 * sc; u32x4 w; w.x = cvt_pk_bf16(v0[0], v0[1]); w.y = cvt_pk_bf16(v0[2], v0[3]); w.z = cvt_pk_bf16(v1[0], v1[1]); w.w = cvt_pk_bf16(v1[2], v1[3]);
                    *(u32x4*)(rowp + bj * HALF) = w; } }
    }
};
template <class Epi, class Sched, bool ALIGN_EPI = false, bool SP2 = false>
__device__ __forceinline__ void gemm_phase(PG8_LAS unsigned char* lds, const Gemm g, const Sched& S, const Epi& E) {
    int tid_o = threadIdx.x; asm volatile("" : "+v"(tid_o));
    const int tid = tid_o, wid = __builtin_amdgcn_readfirstlane(tid >> 6), lane = tid & 63, wr = wid >> 2, wc = wid & 3, fr = lane & 15, fq = lane >> 4;
    const int K = g.K, nt = K / BK;
    unsigned voffA[2], voffB[2];
#pragma unroll
    for (int i = 0; i < 2; ++i) { int R, C; stage_rc(tid * 16 + i * 8192, R, C); const int Rb = Epi::PERM ? ((R & ~31) + perm32(R & 31)) : R;
        voffA[i] = (unsigned)(R * K + C) * 2u; voffB[i] = (unsigned)(Rb * K + C) * 2u; }
    const size_t kstep = (size_t)(BK * 2);
    const size_t hstep = (size_t)HALF * K * 2;
    const size_t tstep = 2 * hstep;
    const unsigned ldsw = (unsigned)wid * 1024u;
    const int aoff = lds_byte(wr * 64 + fr, fq * 8), boff = lds_byte(wc * 32 + fr, fq * 8);
#define PG8_SA(b, h) (((b) * 2 + (h)) * HTB)
#define PG8_SB(b, h) ((4 + (b) * 2 + (h)) * HTB)
#define PG8_STAGE(bufoff, gbase, voff) do { _Pragma("unroll") for (int _i = 0; _i < 2; ++_i) \
        __builtin_amdgcn_global_load_lds((const unsigned*)((const char*)(gbase) + (voff)[_i]), (PG8_LAS unsigned*)(lds + (bufoff) + ldsw + _i * 8192), 16, 0, 0); } while (0)
#define PG8_LDA(dst, b, h) do { _Pragma("unroll") for (int m = 0; m < 4; ++m) _Pragma("unroll") for (int k = 0; k < 2; ++k) dst[m][k] = *(const PG8_LAS bf16x8*)(lds + PG8_SA(b, h) + aoff + m * 2048 + k * 1024); } while (0)
#define PG8_LDB(dst, b, h) do { _Pragma("unroll") for (int n = 0; n < 2; ++n) _Pragma("unroll") for (int k = 0; k < 2; ++k) dst[n][k] = *(const PG8_LAS bf16x8*)(lds + PG8_SB(b, h) + boff + n * 2048 + k * 1024); } while (0)
#define PG8_MMA(ai, bj, At, Bt) do { __builtin_amdgcn_s_setprio(1); _Pragma("unroll") for (int m = 0; m < 4; ++m) _Pragma("unroll") for (int n = 0; n < 2; ++n) _Pragma("unroll") for (int k = 0; k < 2; ++k) \
        acc[ai][bj][m][n] = __builtin_amdgcn_mfma_f32_16x16x32_bf16(Bt[n][k], At[m][k], acc[ai][bj][m][n], 0, 0, 0); __builtin_amdgcn_s_setprio(0); } while (0)
#define PG8_WAIT_V(n) asm volatile("s_waitcnt vmcnt(" #n ")" ::: "memory")
#define PG8_WAIT_L(n) asm volatile("s_waitcnt lgkmcnt(" #n ")" ::: "memory")
#define PG8_BAR __builtin_amdgcn_s_barrier()
#define PG8_SCHED __builtin_amdgcn_sched_barrier(0)
    Unit cur, nxt; int ui = 0;
    if (!S.next(0, cur)) return;
    f32x4 acc[2][2][4][2];
#pragma unroll
    for (int a = 0; a < 2; ++a)
#pragma unroll
        for (int b = 0; b < 2; ++b)
#pragma unroll
            for (int m = 0; m < 4; ++m)
#pragma unroll
                for (int n = 0; n < 2; ++n) acc[a][b][m][n] = (f32x4){0.f, 0.f, 0.f, 0.f};
    bf16x8 At[4][2], B0[2][2], B1[2][2];
    const char* cA = (const char*)g.A + (size_t)cur.pm * tstep; const char* cB = (const char*)g.Bt + (size_t)cur.pn * tstep;
    S.a_ready(cur);
    if constexpr (SP2) {
        PG8_STAGE(PG8_SB(0, 0), cB, voffB); PG8_STAGE(PG8_SB(0, 1), cB + hstep, voffB); PG8_STAGE(PG8_SA(0, 0), cA, voffA); PG8_STAGE(PG8_SA(0, 1), cA + hstep, voffA);
        if (wr == 1) PG8_BAR;
        PG8_WAIT_V(2); PG8_BAR;
        PG8_STAGE(PG8_SB(1, 0), cB + kstep, voffB); PG8_STAGE(PG8_SA(1, 0), cA + kstep, voffA); PG8_STAGE(PG8_SB(1, 1), cB + hstep + kstep, voffB);
        PG8_WAIT_V(6); PG8_BAR;
    } else {
        PG8_STAGE(PG8_SB(0, 0), cB, voffB); PG8_STAGE(PG8_SA(0, 0), cA, voffA); PG8_STAGE(PG8_SB(0, 1), cB + hstep, voffB); PG8_STAGE(PG8_SA(0, 1), cA + hstep, voffA);
        if (wr == 1) PG8_BAR;
        PG8_WAIT_V(4); PG8_BAR;
        PG8_STAGE(PG8_SB(1, 0), cB + kstep, voffB); PG8_STAGE(PG8_SA(1, 0), cA + kstep, voffA); PG8_STAGE(PG8_SB(1, 1), cB + hstep + kstep, voffB);
        PG8_WAIT_V(6); PG8_BAR;
    }
    for (;;) {
        const bool has_next = S.next(ui + 1, nxt);
        const char* nA = has_next ? (const char*)g.A + (size_t)nxt.pm * tstep : cA; const char* nB = has_next ? (const char*)g.Bt + (size_t)nxt.pn * tstep : cB;
        for (int t = 0; t < nt; t += 2) {
            const bool last = (t == nt - 2);
            const char* a1 = cA + (size_t)(t + 1) * kstep;
            const char* a2 = last ? nA : cA + (size_t)(t + 2) * kstep; const char* b2 = last ? nB : cB + (size_t)(t + 2) * kstep;
            const char* a3 = a2 + kstep; const char* b3 = b2 + kstep;
            if (last && has_next) S.a_ready(nxt);
            if constexpr (SP2) {
            PG8_LDB(B0, 0, 0); PG8_LDB(B1, 0, 1); PG8_SCHED; PG8_LDA(At, 0, 0); PG8_STAGE(PG8_SA(1, 1), a1 + hstep, voffA);
            PG8_WAIT_V(8); PG8_WAIT_L(0); PG8_BAR; PG8_MMA(0, 0, At, B0); PG8_MMA(0, 1, At, B1); PG8_BAR; PG8_SCHED;
            PG8_LDA(At, 0, 1); PG8_STAGE(PG8_SB(0, 0), b2, voffB); PG8_STAGE(PG8_SB(0, 1), b2 + hstep, voffB); PG8_STAGE(PG8_SA(0, 0), a2, voffA);
            PG8_WAIT_V(8); PG8_WAIT_L(0); PG8_BAR; PG8_MMA(1, 0, At, B0); PG8_MMA(1, 1, At, B1); PG8_BAR; PG8_SCHED;
            PG8_LDB(B0, 1, 0); PG8_LDB(B1, 1, 1); PG8_SCHED; PG8_LDA(At, 1, 0); PG8_STAGE(PG8_SA(0, 1), a2 + hstep, voffA);
            PG8_WAIT_V(8); PG8_WAIT_L(0); PG8_BAR; PG8_MMA(0, 0, At, B0); PG8_MMA(0, 1, At, B1); PG8_BAR; PG8_SCHED;
            PG8_LDA(At, 1, 1); PG8_STAGE(PG8_SB(1, 0), b3, voffB); PG8_STAGE(PG8_SB(1, 1), b3 + hstep, voffB); PG8_STAGE(PG8_SA(1, 0), a3, voffA);
            PG8_WAIT_V(8); PG8_WAIT_L(0); PG8_BAR; PG8_MMA(1, 0, At, B0); PG8_MMA(1, 1, At, B1); PG8_BAR; PG8_SCHED;
            } else {
            PG8_LDB(B0, 0, 0); PG8_SCHED; PG8_LDA(At, 0, 0); PG8_STAGE(PG8_SA(1, 1), a1 + hstep, voffA);
            PG8_WAIT_L(8); PG8_BAR; PG8_WAIT_L(0); PG8_MMA(0, 0, At, B0); PG8_BAR; PG8_SCHED;
            PG8_LDB(B1, 0, 1); PG8_STAGE(PG8_SB(0, 0), b2, voffB);
            PG8_BAR; PG8_WAIT_L(0); PG8_MMA(0, 1, At, B1); PG8_BAR;
            PG8_LDA(At, 0, 1); PG8_STAGE(PG8_SA(0, 0), a2, voffA);
            PG8_BAR; PG8_WAIT_L(0); PG8_MMA(1, 0, At, B0); PG8_BAR; PG8_SCHED;
            PG8_STAGE(PG8_SB(0, 1), b2 + hstep, voffB);
            PG8_WAIT_V(6); PG8_BAR; PG8_MMA(1, 1, At, B1); PG8_BAR;
            PG8_LDB(B0, 1, 0); PG8_SCHED; PG8_LDA(At, 1, 0); PG8_STAGE(PG8_SA(0, 1), a2 + hstep, voffA);
            PG8_WAIT_L(8); PG8_BAR; PG8_WAIT_L(0); PG8_MMA(0, 0, At, B0); PG8_BAR; PG8_SCHED;
            PG8_LDB(B1, 1, 1); PG8_STAGE(PG8_SB(1, 0), b3, voffB);
            PG8_BAR; PG8_WAIT_L(0); PG8_MMA(0, 1, At, B1); PG8_BAR;
            PG8_LDA(At, 1, 1); PG8_STAGE(PG8_SA(1, 0), a3, voffA);
            PG8_BAR; PG8_WAIT_L(0); PG8_MMA(1, 0, At, B0); PG8_BAR; PG8_SCHED;
            PG8_STAGE(PG8_SB(1, 1), b3 + hstep, voffB);
            PG8_WAIT_V(6); PG8_BAR; PG8_MMA(1, 1, At, B1); PG8_BAR;
            }
        }
        if constexpr (ALIGN_EPI) { if (wr == 0) PG8_BAR; }
        if constexpr (!Epi::AFTER_DRAIN) { E(acc, cur, wr, wc, fr, fq); S.done(cur); }
        if (!has_next) break;
#pragma unroll
        for (int a = 0; a < 2; ++a)
#pragma unroll
            for (int b = 0; b < 2; ++b)
#pragma unroll
                for (int m = 0; m < 4; ++m)
#pragma unroll
                    for (int n = 0; n < 2; ++n) acc[a][b][m][n] = (f32x4){0.f, 0.f, 0.f, 0.f};
        cur = nxt; cA = nA; cB = nB; ++ui;
        if constexpr (ALIGN_EPI) { if (wr == 1) PG8_BAR; }
    }
    PG8_WAIT_V(0);
    if constexpr (!ALIGN_EPI) { if (wr == 0) PG8_BAR; }
    PG8_BAR;
    if constexpr (Epi::AFTER_DRAIN) { E.fused(acc, cur, wr, wc, fr, fq, lds, wid, lane); S.done(cur); }
#undef PG8_SA
#undef PG8_SB
#undef PG8_STAGE
#undef PG8_LDA
#undef PG8_LDB
#undef PG8_MMA
#undef PG8_WAIT_V
#undef PG8_WAIT_L
#undef PG8_BAR
#undef PG8_SCHED
}
}

#define LAS __attribute__((address_space(3)))
typedef unsigned short bf16_t;
typedef short bf16x8 __attribute__((ext_vector_type(8)));
typedef float f32x4 __attribute__((ext_vector_type(4)));
typedef float f32x2 __attribute__((ext_vector_type(2)));
typedef float f32x16 __attribute__((ext_vector_type(16)));
typedef unsigned u32x4 __attribute__((ext_vector_type(4)));
typedef unsigned u32x2 __attribute__((ext_vector_type(2)));
#define MFMA32(a, b, c) __builtin_amdgcn_mfma_f32_32x32x16_bf16((a), (b), (c), 0, 0, 0)

constexpr int DM = 1024, SEQ = 16384, NBP = 2, DEPTH = 4, DB = 16, DS = 32, PAST = 2048;
constexpr int MP = NBP * SEQ, MS = DB * DS, MT = MP + MS;
constexpr int INW = 3584, DFF = 2816, NMOD = 6144, NBI = 18;
constexpr float EPS = 1e-6f;
constexpr size_t OFF_YP = 0, OFF_YS = 33554432, OFF_KP = 34078720, OFF_VP = 101187584, OFF_RP = 168296448,
                 OFF_KS = 168820736, OFF_VS = 169869312, OFF_RS = 170917888;
constexpr size_t MiB = 1u << 20;
constexpr size_t WS_MOD = 0, MOD_BYTES = 2 * MiB; constexpr size_t WS_CTR = 1820160;
constexpr size_t WS_BAR = 1802240;
constexpr size_t WS_ROPE = 2 * MiB;
constexpr size_t WS_WIN = 10 * MiB, WS_WOUT = 38 * MiB, WS_WFI = 46 * MiB, WS_WFO = 90 * MiB;
constexpr size_t WS_X = 112 * MiB;
constexpr size_t WS_H = 242 * MiB;
constexpr size_t WS_O = 307 * MiB;
constexpr size_t WS_QKV = 372 * MiB;
constexpr size_t WS_U = 600 * MiB;
constexpr size_t WS_PART = 616 * MiB;
constexpr size_t WS_END = 632 * MiB;
constexpr int LDS_BYTES = 147456;

struct Params { const float* in[18]; float* out; unsigned char* ws; };

typedef __bf16 bf16x2_t __attribute__((ext_vector_type(2)));
__device__ __forceinline__ unsigned pk2(float lo, float hi) { const f32x2 v = {lo, hi}; return __builtin_bit_cast(unsigned, __builtin_convertvector(v, bf16x2_t)); }
__device__ __forceinline__ unsigned f2bf(float f) { return pk2(f, 0.f) & 0xffffu; }
__device__ __forceinline__ float bf2f(unsigned h) { return __builtin_bit_cast(float, h << 16); }
__device__ __forceinline__ f32x4 ldx4(const bf16_t* p) { const u32x2 w = *(const u32x2*)p;
    return (f32x4){__builtin_bit_cast(float, w.x << 16), __builtin_bit_cast(float, w.x & 0xffff0000u), __builtin_bit_cast(float, w.y << 16), __builtin_bit_cast(float, w.y & 0xffff0000u)}; }
__device__ __forceinline__ bf16x8 pack8(f32x4 a, f32x4 b) { u32x4 p; p.x = pk2(a.x, a.y); p.y = pk2(a.z, a.w); p.z = pk2(b.x, b.y); p.w = pk2(b.z, b.w); return __builtin_bit_cast(bf16x8, p); }
__device__ __forceinline__ float wave_sum(float v) {
#pragma unroll
    for (int o = 1; o < 64; o <<= 1) v += __shfl_xor(v, o);
    return v;
}
__device__ __forceinline__ float silu_f(float x) { return x * __builtin_amdgcn_rcpf(1.f + __expf(-x)); }
__device__ __forceinline__ int batch_of(int row) { return row < MP ? (row >> 14) : 2 + ((row - MP) >> 5); }

struct EpiQKV {
    static constexpr bool PERM = true, AFTER_DRAIN = false;
    bf16_t* QKV; float* out; int layer;
    __device__ __forceinline__ void operator()(const pg8::f32x4 (&acc)[2][2][4][2], const pg8::Unit& u, int wr, int wc, int fr, int fq) const {
        const int row0 = u.pm * 256 + wr * 64 + fr, col0 = u.pn * 256 + wc * 32 + 8 * fq;
        const bool kv = (u.pn >= 2 && u.pn < 6);
        const size_t vsel = (u.pn >= 4) ? 1 : 0;
        const size_t obase = (u.pm < 128) ? OFF_KP + vsel * (OFF_VP - OFF_KP) + (size_t)layer * MP * 512 + (size_t)row0 * 512
                                          : OFF_KS + vsel * (OFF_VS - OFF_KS) + (size_t)layer * MS * 512 + (size_t)(row0 - MP) * 512;
#pragma unroll
        for (int ai = 0; ai < 2; ++ai)
#pragma unroll
            for (int m = 0; m < 4; ++m) {
                const int row = row0 + ai * 128 + m * 16;
#pragma unroll
                for (int bj = 0; bj < 2; ++bj) {
                    const int col = col0 + bj * 128;
                    const pg8::f32x4 v0 = acc[ai][bj][m][0], v1 = acc[ai][bj][m][1];
                    u32x4 w; w.x = pg8::cvt_pk_bf16(v0[0], v0[1]); w.y = pg8::cvt_pk_bf16(v0[2], v0[3]); w.z = pg8::cvt_pk_bf16(v1[0], v1[1]); w.w = pg8::cvt_pk_bf16(v1[2], v1[3]);
                    *(u32x4*)(QKV + (size_t)row * INW + col) = w;
                    if (kv) {
                        const int c = col & 511;
                        float* dst = out + obase + (size_t)(ai * 128 + m * 16) * 512 + c;
                        *(pg8::f32x4*)dst = v0; *(pg8::f32x4*)(dst + 4) = v1;
                    }
                }
                asm volatile("" ::: "memory");
            }
    }
};
struct EpiResid {
    static constexpr bool PERM = false, AFTER_DRAIN = false;
    const float* base_p; const float* base_s;
    bf16_t* X; const float* gate;
    __device__ __forceinline__ void operator()(const pg8::f32x4 (&acc)[2][2][4][2], const pg8::Unit& u, int wr, int wc, int fr, int fq) const {
        const int col0 = u.pn * 256 + wc * 32 + 4 * fq;
        const bool uni = u.pm < 128;
        pg8::f32x4 gv[4];
        { const float* gr = gate + (size_t)batch_of(u.pm * 256 + wr * 64 + fr) * NMOD;
#pragma unroll
          for (int q = 0; q < 4; ++q) gv[q] = *(const pg8::f32x4*)(gr + col0 + (q >> 1) * 128 + (q & 1) * 16); }
#pragma unroll
        for (int grp = 0; grp < 4; ++grp) {
            const int ai = grp >> 1, m0 = (grp & 1) * 2;
            pg8::f32x4 bv[2][4];
#pragma unroll
            for (int mm = 0; mm < 2; ++mm) {
                const int row = u.pm * 256 + ai * 128 + wr * 64 + (m0 + mm) * 16 + fr;
                if (base_p) { const float* br = row < MP ? base_p + (size_t)row * DM : base_s + (size_t)(row - MP) * DM;
#pragma unroll
                    for (int q = 0; q < 4; ++q) bv[mm][q] = *(const pg8::f32x4*)(br + col0 + (q >> 1) * 128 + (q & 1) * 16);
                } else { const bf16_t* br = X + (size_t)row * DM;
#pragma unroll
                    for (int q = 0; q < 4; ++q) bv[mm][q] = ldx4(br + col0 + (q >> 1) * 128 + (q & 1) * 16); }
            }
#pragma unroll
            for (int mm = 0; mm < 2; ++mm) {
                const int m = m0 + mm, row = u.pm * 256 + ai * 128 + wr * 64 + m * 16 + fr;
                if (!uni) { const float* gr = gate + (size_t)batch_of(row) * NMOD;
#pragma unroll
                    for (int q = 0; q < 4; ++q) gv[q] = *(const pg8::f32x4*)(gr + col0 + (q >> 1) * 128 + (q & 1) * 16); }
                bf16_t* xr = X + (size_t)row * DM;
#pragma unroll
                for (int q = 0; q < 4; ++q) { const int bj = q >> 1, n = q & 1;
                    const pg8::f32x4 xv = bv[mm][q] + gv[q] * acc[ai][bj][m][n];
                    u32x2 w; w.x = pk2(xv[0], xv[1]); w.y = pk2(xv[2], xv[3]); *(u32x2*)(xr + col0 + bj * 128 + n * 16) = w; }
            }
            asm volatile("" ::: "memory");
        }
    }
};
struct EpiSwiGLU {
    static constexpr bool PERM = true, AFTER_DRAIN = false;
    bf16_t* ACT;
    __device__ __forceinline__ void operator()(const pg8::f32x4 (&acc)[2][2][4][2], const pg8::Unit& u, int wr, int wc, int fr, int fq) const {
        const int col0 = u.pn * 128 + wc * 32 + 8 * fq;
#pragma unroll
        for (int ai = 0; ai < 2; ++ai)
#pragma unroll
            for (int m = 0; m < 4; ++m) {
                const int row = u.pm * 256 + ai * 128 + wr * 64 + m * 16 + fr;
                const pg8::f32x4 g0 = acc[ai][0][m][0], g1 = acc[ai][0][m][1], u0 = acc[ai][1][m][0], u1 = acc[ai][1][m][1];
                float r[8];
#pragma unroll
                for (int j = 0; j < 4; ++j) { r[j] = silu_f(g0[j]) * u0[j]; r[4 + j] = silu_f(g1[j]) * u1[j]; }
                u32x4 w; w.x = pg8::cvt_pk_bf16(r[0], r[1]); w.y = pg8::cvt_pk_bf16(r[2], r[3]); w.z = pg8::cvt_pk_bf16(r[4], r[5]); w.w = pg8::cvt_pk_bf16(r[6], r[7]);
                *(u32x4*)(ACT + (size_t)row * DFF + col0) = w;
                asm volatile("" ::: "memory");
            }
    }
};


template <int NKS  , int UNR, class Epi>
__device__ __forceinline__ void sgemm_phase(LAS unsigned char* lds, const bf16_t* A  , int lda, const bf16_t* Bt, int K, int ncb,
                                            int tid, int lane, int wave, const Epi& E) {
    const int l32 = lane & 31, hf = lane >> 5;
    LAS float* red = (LAS float*)lds;
    const int kw0 = wave * NKS * 16 + hf * 8;
    for (int it = blockIdx.x; it < 16 * ncb; it += gridDim.x) {
        const int rb = it & 15, cb = it >> 4;
        int n0, n1; E.cols(cb, n0, n1);
        const bf16_t* ap = A + (size_t)(rb * 32 + l32) * lda + kw0;
        const bf16_t* b0p = Bt + (size_t)(n0 + l32) * K + kw0;
        const bf16_t* b1p = Bt + (size_t)(n1 + l32) * K + kw0;
        f32x16 c0, c1;
#pragma unroll
        for (int r = 0; r < 16; ++r) { c0[r] = 0.f; c1[r] = 0.f; }
#pragma unroll 1
        for (int kb = 0; kb < NKS; kb += UNR) {
            bf16x8 a[UNR], b0[UNR], b1[UNR];
#pragma unroll
            for (int j = 0; j < UNR; ++j) { a[j] = *(const bf16x8*)(ap + (kb + j) * 16); b0[j] = *(const bf16x8*)(b0p + (kb + j) * 16); b1[j] = *(const bf16x8*)(b1p + (kb + j) * 16); }
#pragma unroll
            for (int j = 0; j < UNR; ++j) { c0 = MFMA32(a[j], b0[j], c0); c1 = MFMA32(a[j], b1[j], c1); }
        }
        LAS float* rw = red + wave * 2176;
#pragma unroll
        for (int r = 0; r < 16; ++r) { const int row = (r >> 2) * 8 + hf * 4 + (r & 3); rw[row * 34 + l32] = c0[r]; rw[1088 + row * 34 + l32] = c1[r]; }
        __syncthreads();
        {
            const int row = tid >> 4, cc = (tid & 15) * 2;
            f32x2 g = {0.f, 0.f}, u = {0.f, 0.f};
#pragma unroll
            for (int w = 0; w < 8; ++w) { g += *(const LAS f32x2*)(red + w * 2176 + row * 34 + cc); u += *(const LAS f32x2*)(red + w * 2176 + 1088 + row * 34 + cc); }
            E(rb * 32 + row, n0 + cc, n1 + cc, g, u);
        }
        __syncthreads();
    }
}

template <class Epi>
__device__ __forceinline__ void sgemm_st_phase(LAS unsigned char* lds, const bf16_t* A, int lda, const bf16_t* Bt, int K, int ncb, int tid, int lane, int wave, const Epi& E) {
    const int l32 = lane & 31, hf = lane >> 5, rg = lane >> 3, seg = lane & 7;
    LAS unsigned char* img = lds + wave * 13824;
    const int kw0 = wave * 128;
    for (int it = blockIdx.x; it < 16 * ncb; it += gridDim.x) {
        const int rb = it & 15, cb = it >> 4;
        int n0, n1; E.cols(cb, n0, n1);
        bf16x8 ld[2][12];
#pragma unroll
        for (int h = 0; h < 2; ++h)
#pragma unroll
            for (int q = 0; q < 12; ++q) {
                const int r = (q & 3) * 8 + rg;
                const bf16_t* p = (q < 4) ? A + (size_t)(rb * 32 + r) * lda : Bt + (size_t)((q < 8 ? n0 : n1) + r) * K;
                ld[h][q] = *(const bf16x8*)(p + kw0 + h * 64 + seg * 8);
            }
        f32x16 c0, c1;
#pragma unroll
        for (int r = 0; r < 16; ++r) { c0[r] = 0.f; c1[r] = 0.f; }
#pragma unroll
        for (int h = 0; h < 2; ++h) {
#pragma unroll
            for (int q = 0; q < 12; ++q) *(LAS bf16x8*)(img + (q * 8 + rg) * 144 + seg * 16) = ld[h][q];
            asm volatile("s_waitcnt lgkmcnt(0)" ::: "memory"); __builtin_amdgcn_wave_barrier();
#pragma unroll
            for (int ks = 0; ks < 4; ++ks) {
                const bf16x8 a = *(const LAS bf16x8*)(img + l32 * 144 + ks * 32 + hf * 16), b0 = *(const LAS bf16x8*)(img + (32 + l32) * 144 + ks * 32 + hf * 16), b1 = *(const LAS bf16x8*)(img + (64 + l32) * 144 + ks * 32 + hf * 16);
                c0 = MFMA32(a, b0, c0); c1 = MFMA32(a, b1, c1);
            }
            asm volatile("s_waitcnt lgkmcnt(0)" ::: "memory"); __builtin_amdgcn_wave_barrier();
        }
        LAS float* rw = (LAS float*)img;
#pragma unroll
        for (int r = 0; r < 16; ++r) { const int row = (r >> 2) * 8 + hf * 4 + (r & 3); rw[row * 34 + l32] = c0[r]; rw[1088 + row * 34 + l32] = c1[r]; }
        __syncthreads();
        {
            const int row = tid >> 4, cc = (tid & 15) * 2;
            f32x2 g = {0.f, 0.f}, u = {0.f, 0.f};
#pragma unroll
            for (int w = 0; w < 8; ++w) { const LAS float* p = (const LAS float*)(lds + w * 13824) + row * 34 + cc; g += *(const LAS f32x2*)(p); u += *(const LAS f32x2*)(p + 1088); }
            E(rb * 32 + row, n0 + cc, n1 + cc, g, u);
        }
        __syncthreads();
    }
}
struct SEpiQKV {
    bf16_t* QKV; float* out; int layer;
    __device__ __forceinline__ void cols(int cb, int& n0, int& n1) const { n0 = cb * 64; n1 = n0 + 32; }
    __device__ __forceinline__ void emit(int r, int c, f32x2 v) const {
        *(unsigned*)(QKV + (size_t)(MP + r) * INW + c) = pk2(v.x, v.y);
        if (c >= 512 && c < 1536) { const size_t off = (c < 1024 ? OFF_KS : OFF_VS) + ((size_t)layer * MS + r) * 512 + (c & 511); *(f32x2*)(out + off) = v; }
    }
    __device__ __forceinline__ void operator()(int r, int c0, int c1, f32x2 g, f32x2 u) const { emit(r, c0, g); emit(r, c1, u); }
};
struct SEpiResid {
    const float* basef; bf16_t* Xs; const float* gate;
    __device__ __forceinline__ void cols(int cb, int& n0, int& n1) const { n0 = cb * 64; n1 = n0 + 32; }
    __device__ __forceinline__ void operator()(int r, int c0, int c1, f32x2 g, f32x2 u) const {
        const float* gp = gate + (size_t)(2 + (r >> 5)) * NMOD; bf16_t* xp = Xs + (size_t)r * DM;
        f32x2 b0, b1;
        if (basef) { b0 = *(const f32x2*)(basef + (size_t)r * DM + c0); b1 = *(const f32x2*)(basef + (size_t)r * DM + c1); }
        else { const unsigned w0 = *(const unsigned*)(xp + c0), w1 = *(const unsigned*)(xp + c1);
            b0 = (f32x2){__builtin_bit_cast(float, w0 << 16), __builtin_bit_cast(float, w0 & 0xffff0000u)}; b1 = (f32x2){__builtin_bit_cast(float, w1 << 16), __builtin_bit_cast(float, w1 & 0xffff0000u)}; }
        const f32x2 x0 = b0 + *(const f32x2*)(gp + c0) * g, x1 = b1 + *(const f32x2*)(gp + c1) * u;
        *(unsigned*)(xp + c0) = pk2(x0.x, x0.y); *(unsigned*)(xp + c1) = pk2(x1.x, x1.y);
    }
};
struct SEpiSwiGLU {
    bf16_t* ACT;
    __device__ __forceinline__ void cols(int cb, int& n0, int& n1) const { n0 = (cb >> 2) * 256 + (cb & 3) * 32; n1 = n0 + 128; }
    __device__ __forceinline__ void operator()(int r, int c0, int c1, f32x2 g, f32x2 u) const {
        const int col = (c0 >> 8) * 128 + (c0 & 127);
        *(unsigned*)(ACT + (size_t)(MP + r) * DFF + col) = pk2(silu_f(g.x) * u.x, silu_f(g.y) * u.y);
    }
};

__device__ __forceinline__ void transpose_item(const float* W, int K, int N, bf16_t* WT, LAS float* scr, int item, int lane, bool perm) {
    const int nblk = N / 32, kb = item / nblk, nb = item % nblk, k0 = 64 * kb, n0 = 32 * nb;
    int p0 = n0;
    if (perm) { if (n0 < DFF) p0 = (n0 >> 7) * 256 + (n0 & 127); else { const int n1 = n0 - DFF; p0 = (n1 >> 7) * 256 + 128 + (n1 & 127); } }
#pragma unroll 8
    for (int i = 0; i < 32; ++i) { const int kk = 2 * i + (lane >> 5); scr[kk * 33 + (lane & 31)] = W[(size_t)(k0 + kk) * N + n0 + (lane & 31)]; }
    asm volatile("s_waitcnt lgkmcnt(0)" ::: "memory"); __builtin_amdgcn_wave_barrier();
    const int c = lane & 7;
#pragma unroll
    for (int j = 0; j < 4; ++j) { const int n = (lane >> 3) + 8 * j; const LAS float* s = scr + (8 * c) * 33 + n;
        u32x4 o; o.x = pk2(s[0 * 33], s[1 * 33]); o.y = pk2(s[2 * 33], s[3 * 33]); o.z = pk2(s[4 * 33], s[5 * 33]); o.w = pk2(s[6 * 33], s[7 * 33]);
        *(u32x4*)(WT + (size_t)(p0 + n) * K + k0 + 8 * c) = o; }
    asm volatile("s_waitcnt lgkmcnt(0)" ::: "memory"); __builtin_amdgcn_wave_barrier();
}

__device__ __forceinline__ void p0_phase(const Params& P, LAS unsigned char* lds, int tid, int lane, int wave) {
    LAS float* sc = (LAS float*)lds;
    for (int i = tid; i < NBI * DM; i += 512) { const int b = i >> 10, k = i & 1023; const float c = b < 2 ? P.in[5][b * DM + k] : P.in[6][(b - 2) * DM + k]; sc[i] = silu_f(c); }
    __syncthreads();
    const int gw = blockIdx.x * 8 + wave, NGW = gridDim.x * 8;
    float* MOD = (float*)(P.ws + WS_MOD);
    for (int it = gw; it < 768; it += NGW) {
        const int l = it / 192, r = it % 192, cb = r >> 3, kc = r & 7;
        f32x4 acc[NBI];
#pragma unroll
        for (int b = 0; b < NBI; ++b) acc[b] = (f32x4){0.f, 0.f, 0.f, 0.f};
        const float* wp = P.in[9] + ((size_t)l * DM + kc * 128) * NMOD + cb * 256 + lane * 4;
        const LAS float* scp = sc + kc * 128;
#pragma unroll 16
        for (int k = 0; k < 128; ++k) { const f32x4 w = *(const f32x4*)(wp + (size_t)k * NMOD);
#pragma unroll
            for (int b = 0; b < NBI; ++b) acc[b] += scp[b * DM + k] * w; }
        if (kc == 0) { const f32x4 bv = *(const f32x4*)(P.in[10] + (size_t)l * NMOD + cb * 256 + lane * 4);
#pragma unroll
            for (int b = 0; b < NBI; ++b) acc[b] += bv; }
        float* mp = (float*)(P.ws + WS_PART) + ((size_t)kc * DEPTH + l) * NBI * NMOD + cb * 256 + lane * 4;
#pragma unroll
        for (int b = 0; b < NBI; ++b) *(f32x4*)(mp + b * NMOD) = acc[b];
    }
    LAS float* scr = (LAS float*)(lds + 73728 + wave * 8448);
    constexpr int I_IN = 16 * 112, I_OUT = 16 * 32, I_FI = 16 * 176, I_FO = 44 * 32, I_L = I_IN + I_OUT + I_FI + I_FO;
    for (int it = gw; it < DEPTH * I_L; it += NGW) {
        const int l = it / I_L; int r = it % I_L;
        if (r < I_IN) { transpose_item(P.in[11] + (size_t)l * DM * INW, DM, INW, (bf16_t*)(P.ws + WS_WIN) + (size_t)l * INW * DM, scr, r, lane, false); continue; } r -= I_IN;
        if (r < I_OUT) { transpose_item(P.in[14] + (size_t)l * DM * DM, DM, DM, (bf16_t*)(P.ws + WS_WOUT) + (size_t)l * DM * DM, scr, r, lane, false); continue; } r -= I_OUT;
        if (r < I_FI) { transpose_item(P.in[15] + (size_t)l * DM * 2 * DFF, DM, 2 * DFF, (bf16_t*)(P.ws + WS_WFI) + (size_t)l * 2 * DFF * DM, scr, r, lane, true); continue; } r -= I_FI;
        transpose_item(P.in[16] + (size_t)l * DFF * DM, DFF, DM, (bf16_t*)(P.ws + WS_WFO) + (size_t)l * DM * DFF, scr, r, lane, false);
    }
    f32x2* ROPE = (f32x2*)(P.ws + WS_ROPE);
    for (int idx = blockIdx.x * 512 + tid; idx < SEQ * 64; idx += gridDim.x * 512) {
        const int pos = idx >> 6, i = idx & 63;
        const float inv = exp2f(-(float)i * (13.287712379549449f / 64.f));
        const float ang = (float)pos * inv;
        double rev = (double)ang * 0.15915494309189535; rev -= floor(rev);
        const float rf = (float)rev;
        ROPE[idx] = (f32x2){__builtin_amdgcn_cosf(rf), __builtin_amdgcn_sinf(rf)};
    }
}

template <bool FINAL>
__device__ __forceinline__ void norm_phase(const Params& P, int l, bool from_input, const float* gain, int sh_off, int sc_off, int lane, int wave) {
    const int gw = blockIdx.x * 8 + wave, NGW = gridDim.x * 8;
    const float* MOD = (const float*)(P.ws + WS_MOD) + (size_t)l * NBI * NMOD;
    const bf16_t* X = (const bf16_t*)(P.ws + WS_X); bf16_t* H = (bf16_t*)(P.ws + WS_H);
    f32x4 g[4];
#pragma unroll
    for (int j = 0; j < 4; ++j) g[j] = *(const f32x4*)(gain + 4 * lane + 256 * j);
    auto loadrow = [&](int m, f32x4 (&v)[4]) {
        if (!FINAL && from_input) { const float* xr = m < MP ? P.in[0] + (size_t)m * DM : P.in[1] + (size_t)(m - MP) * DM;
#pragma unroll
            for (int j = 0; j < 4; ++j) v[j] = *(const f32x4*)(xr + 4 * lane + 256 * j);
        } else { const bf16_t* xr = X + (size_t)m * DM;
#pragma unroll
            for (int j = 0; j < 4; ++j) v[j] = ldx4(xr + 4 * lane + 256 * j); }
    };
    f32x4 vn[4];
    if (gw < MT) loadrow(gw, vn);
    for (int m = gw; m < MT; m += NGW) {
        f32x4 v[4]; float ss = 0.f;
#pragma unroll
        for (int j = 0; j < 4; ++j) v[j] = vn[j];
        if (m + NGW < MT) loadrow(m + NGW, vn);
        f32x4 sc[4], sh[4];
        if (!FINAL) { const float* mr = MOD + (size_t)batch_of(m) * NMOD;
#pragma unroll
            for (int j = 0; j < 4; ++j) { const int c = 4 * lane + 256 * j; sc[j] = *(const f32x4*)(mr + sc_off + c); sh[j] = *(const f32x4*)(mr + sh_off + c); } }
#pragma unroll
        for (int j = 0; j < 4; ++j) ss += (v[j].x * v[j].x + v[j].y * v[j].y) + (v[j].z * v[j].z + v[j].w * v[j].w);
        const float rstd = rsqrtf(wave_sum(ss) * (1.f / DM) + EPS);
        if (FINAL) {
            float* o = P.out + (size_t)m * DM;
#pragma unroll
            for (int j = 0; j < 4; ++j) *(f32x4*)(o + 4 * lane + 256 * j) = v[j] * rstd * g[j];
        } else {
#pragma unroll
            for (int j = 0; j < 4; ++j) { const int c = 4 * lane + 256 * j;
                const f32x4 hh = v[j] * rstd * g[j] * (1.f + sc[j]) + sh[j];
                u32x2 w; w.x = pk2(hh.x, hh.y); w.y = pk2(hh.z, hh.w);
                *(u32x2*)(H + (size_t)m * DM + c) = w; }
        }
    }
}

__device__ __forceinline__ void sb_unit(const Params& P, int l, int u, LAS unsigned char* lds, int tid, int lane, int wave) {
    const bf16_t* QKV = (const bf16_t*)(P.ws + WS_QKV);
    const int h = wave, l32 = lane & 31, hf = lane >> 5;
    const bool samp = u >= 1024;
    int qrow0, nsteps; const float* ck = nullptr; const float* cv = nullptr;
    if (!samp) { const int b = u >> 9, qb = u & 511; qrow0 = b * SEQ + qb * 32; nsteps = qb + 1; }
    else { const int bs = u - 1024; qrow0 = MP + bs * 32; nsteps = 65; ck = P.in[2] + (size_t)(l * DB + bs) * PAST * 512; cv = P.in[3] + (size_t)(l * DB + bs) * PAST * 512; }
    bf16x8 qf[4];
#pragma unroll
    for (int ks = 0; ks < 4; ++ks) qf[ks] = *(const bf16x8*)(QKV + (size_t)(qrow0 + l32) * INW + h * 64 + ks * 16 + hf * 8);
    f32x16 O0, O1;
#pragma unroll
    for (int r = 0; r < 16; ++r) { O0[r] = 0.f; O1[r] = 0.f; }
    float cum = 0.f;
    LAS unsigned char* vt = lds + 66048 + wave * 4608;
    auto issue = [&](int s, bf16x8 (&k)[4], bf16x8 (&v)[4]) {
        if (!samp || s == 0) {
            const int krow0 = samp ? qrow0 : qrow0 - s * 32;
#pragma unroll
            for (int ks = 0; ks < 4; ++ks) k[ks] = *(const bf16x8*)(QKV + (size_t)(krow0 + l32) * INW + 512 + h * 64 + ks * 16 + hf * 8);
#pragma unroll
            for (int it = 0; it < 4; ++it) { const int id = it * 64 + lane, key = id >> 3, ch = id & 7;
                v[it] = *(const bf16x8*)(QKV + (size_t)(krow0 + key) * INW + 1024 + h * 64 + ch * 8); }
        } else {
            const int kpos0 = (64 - s) * 32;
#pragma unroll
            for (int ks = 0; ks < 4; ++ks) { const float* p = ck + (size_t)(kpos0 + l32) * 512 + h * 64 + ks * 16 + hf * 8; k[ks] = pack8(*(const f32x4*)p, *(const f32x4*)(p + 4)); }
#pragma unroll
            for (int it = 0; it < 4; ++it) { const int id = it * 64 + lane, key = id >> 3, ch = id & 7;
                const float* p = cv + (size_t)(kpos0 + key) * 512 + h * 64 + ch * 8;
                v[it] = pack8(*(const f32x4*)p, *(const f32x4*)(p + 4)); }
        }
    };
    bf16x8 kf[4], vr[4];
    issue(0, kf, vr);
    for (int s = 0; s < nsteps; ++s) {
#pragma unroll
        for (int it = 0; it < 4; ++it) { const int id = it * 64 + lane, key = id >> 3, ch = id & 7; *(LAS bf16x8*)(vt + key * 144 + ch * 16) = vr[it]; }
        bf16x8 kn[4];
#pragma unroll
        for (int ks = 0; ks < 4; ++ks) kn[ks] = kf[ks];
        if (s + 1 < nsteps) issue(s + 1, kn, vr);
        asm volatile("s_waitcnt lgkmcnt(0)" ::: "memory"); __builtin_amdgcn_wave_barrier();
        f32x16 S;
#pragma unroll
        for (int r = 0; r < 16; ++r) S[r] = 0.f;
#pragma unroll
        for (int ks = 0; ks < 4; ++ks) S = MFMA32(kf[ks], qf[ks], S);
        float L[16], lb[16]; bool valid[16];
#pragma unroll
        for (int r = 0; r < 16; ++r) {
            const float z = S[r] * 0.18033688011112042f;
            const float sp = fmaxf(z, 0.f) + __builtin_amdgcn_logf(1.f + __builtin_amdgcn_exp2f(-fabsf(z)));
            const int key = (r >> 2) * 8 + hf * 4 + (r & 3);
            valid[r] = (s != 0) || (key < l32);
            L[r] = valid[r] ? -sp : 0.f; lb[r] = z - sp;
        }
        float T[4], Pp[4];
#pragma unroll
        for (int g = 0; g < 4; ++g) { T[g] = (L[4 * g] + L[4 * g + 1]) + (L[4 * g + 2] + L[4 * g + 3]); Pp[g] = __shfl_xor(T[g], 32); }
        float later[4]; float tot = 0.f;
#pragma unroll
        for (int g = 3; g >= 0; --g) { later[g] = tot; tot += T[g] + Pp[g]; }
        float w[16];
#pragma unroll
        for (int g = 0; g < 4; ++g) {
            const float s3 = cum + later[g] + (hf == 0 ? Pp[g] : 0.f);
            const float s2 = s3 + L[4 * g + 3], s1 = s2 + L[4 * g + 2], s0 = s1 + L[4 * g + 1];
            w[4 * g + 3] = valid[4 * g + 3] ? __builtin_amdgcn_exp2f(lb[4 * g + 3] + s3) : 0.f;
            w[4 * g + 2] = valid[4 * g + 2] ? __builtin_amdgcn_exp2f(lb[4 * g + 2] + s2) : 0.f;
            w[4 * g + 1] = valid[4 * g + 1] ? __builtin_amdgcn_exp2f(lb[4 * g + 1] + s1) : 0.f;
            w[4 * g + 0] = valid[4 * g + 0] ? __builtin_amdgcn_exp2f(lb[4 * g + 0] + s0) : 0.f;
        }
        cum += tot;
#pragma unroll
        for (int c = 0; c < 2; ++c) {
            u32x4 pw; pw.x = pk2(w[8 * c], w[8 * c + 1]); pw.y = pk2(w[8 * c + 2], w[8 * c + 3]); pw.z = pk2(w[8 * c + 4], w[8 * c + 5]); pw.w = pk2(w[8 * c + 6], w[8 * c + 7]);
            const bf16x8 pa = __builtin_bit_cast(bf16x8, pw);
#pragma unroll
            for (int dt = 0; dt < 2; ++dt) {
                bf16x8 vb;
#pragma unroll
                for (int i = 0; i < 8; ++i) { const int key = 16 * c + 8 * (i >> 2) + 4 * hf + (i & 3); vb[i] = *(const LAS short*)(vt + key * 144 + (l32 + 32 * dt) * 2); }
                if (dt == 0) O0 = MFMA32(pa, vb, O0); else O1 = MFMA32(pa, vb, O1);
            }
        }
        asm volatile("" ::: "memory");
        if (__all(cum < -150.f)) break;
#pragma unroll
        for (int ks = 0; ks < 4; ++ks) kf[ks] = kn[ks];
    }
    LAS float* oa = (LAS float*)lds;
#pragma unroll
    for (int r = 0; r < 16; ++r) { const int q = (r >> 2) * 8 + hf * 4 + (r & 3); oa[q * 516 + h * 64 + l32] = O0[r]; oa[q * 516 + h * 64 + 32 + l32] = O1[r]; }
    __syncthreads();
    bf16_t* Ob = (bf16_t*)(P.ws + WS_O);
    const float* gsb = P.in[12] + (size_t)l * 512;
    {
        f32x4 ra[4], rb[4]; float sq[4];
#pragma unroll
        for (int rr = 0; rr < 4; ++rr) { const int q = wave * 4 + rr;
            ra[rr] = *(const LAS f32x4*)(oa + q * 516 + 4 * lane); rb[rr] = *(const LAS f32x4*)(oa + q * 516 + 256 + 4 * lane);
            const f32x4 a = ra[rr], b = rb[rr];
            sq[rr] = (a.x * a.x + a.y * a.y) + (a.z * a.z + a.w * a.w) + (b.x * b.x + b.y * b.y) + (b.z * b.z + b.w * b.w); }
#pragma unroll
        for (int o = 1; o < 64; o <<= 1) {
#pragma unroll
            for (int rr = 0; rr < 4; ++rr) sq[rr] += __shfl_xor(sq[rr], o);
        }
        const f32x4 ga = *(const f32x4*)(gsb + 4 * lane), gb = *(const f32x4*)(gsb + 256 + 4 * lane);
#pragma unroll
        for (int rr = 0; rr < 4; ++rr) { const int q = wave * 4 + rr;
            const float rstd = rsqrtf(sq[rr] * (1.f / 512.f) + EPS);
            const f32x4 ya = ra[rr] * rstd * ga, yb = rb[rr] * rstd * gb;
            u32x2 wa, wb; wa.x = pk2(ya.x, ya.y); wa.y = pk2(ya.z, ya.w); wb.x = pk2(yb.x, yb.y); wb.y = pk2(yb.z, yb.w);
            *(u32x2*)(Ob + (size_t)(qrow0 + q) * DM + 4 * lane) = wa; *(u32x2*)(Ob + (size_t)(qrow0 + q) * DM + 256 + 4 * lane) = wb; }
    }
    __syncthreads();
}

__device__ __forceinline__ void ret_unit(const Params& P, int l, LAS unsigned char* lds, int tid, int lane, int wave,
                                         int row0, int pos0, int nchunks, int L, int h, const float* init, float* outst, bool state_only) {
    const bf16_t* QKV = (const bf16_t*)(P.ws + WS_QKV); bf16_t* Ob = (bf16_t*)(P.ws + WS_O);
    const f32x2* ROPE = (const f32x2*)(P.ws + WS_ROPE);
    const float lg2 = log2f(1.f - exp2f(-5.f - (float)h));
    LAS unsigned char *Qn = lds, *Kn = lds + 17408, *KdT = lds + 34816, *VT = lds + 53248, *SbT = lds + 71680, *Pm = lds + 106496;
    LAS float* of = (LAS float*)lds;
    const int l32 = lane & 31, hf = lane >> 5;
    const int sdt = wave >> 1, set0 = (wave & 1) * 2;
    f32x16 S0, S1;
#pragma unroll
    for (int r = 0; r < 16; ++r) { S0[r] = 0.f; S1[r] = 0.f; }
    if (init) {
        int ipo = (sdt * 32 + hf * 4) * 128 + set0 * 32 + l32; asm volatile("" : "+v"(ipo));
        const float* ip = init + ipo;
#pragma unroll
        for (int r = 0; r < 16; ++r) { S0[r] = ip[((r >> 2) * 8 + (r & 3)) * 128]; S1[r] = ip[((r >> 2) * 8 + (r & 3)) * 128 + 32]; if ((r & 3) == 3) asm volatile("" ::: "memory"); }
    }
    if (!state_only) {
#pragma unroll
        for (int g = 0; g < 4; ++g) { const int d0 = sdt * 32 + g * 8 + hf * 4;
            u32x2 a, b; a.x = pk2(S0[4 * g], S0[4 * g + 1]); a.y = pk2(S0[4 * g + 2], S0[4 * g + 3]); b.x = pk2(S1[4 * g], S1[4 * g + 1]); b.y = pk2(S1[4 * g + 2], S1[4 * g + 3]);
            *(LAS u32x2*)(SbT + (set0 * 32 + l32) * 272 + d0 * 2) = a; *(LAS u32x2*)(SbT + ((set0 + 1) * 32 + l32) * 272 + d0 * 2) = b; }
    }
    const float gL = exp2f((float)L * lg2);
    const int lt = wave >> 2, et = wave & 3;
    bf16x8 rk1, rk2, rq1, rq2, rv0, rv1; f32x4 rcs[4];
    const bf16x8 z8 = {0, 0, 0, 0, 0, 0, 0, 0};
    auto issue = [&](int c) {
        const int t = tid >> 3, i0 = (tid & 7) * 8; const bool ok = t < L;
        const size_t row = (size_t)(row0 + c * 64 + t);
        rk1 = z8; rk2 = z8; rq1 = z8; rq2 = z8;
#pragma unroll
        for (int i = 0; i < 4; ++i) rcs[i] = (f32x4){0.f, 0.f, 0.f, 0.f};
        if (ok) {
            rk1 = *(const bf16x8*)(QKV + row * INW + 2048 + h * 128 + i0); rk2 = *(const bf16x8*)(QKV + row * INW + 2048 + h * 128 + 64 + i0);
            if (!state_only) { rq1 = *(const bf16x8*)(QKV + row * INW + 1536 + h * 128 + i0); rq2 = *(const bf16x8*)(QKV + row * INW + 1536 + h * 128 + 64 + i0); }
            const f32x4* rp = (const f32x4*)(ROPE + (size_t)(pos0 + c * 64 + t) * 64 + i0);
#pragma unroll
            for (int i = 0; i < 4; ++i) rcs[i] = rp[i];
        }
        const int t0 = tid >> 4, ch = tid & 15;
        rv0 = z8; rv1 = z8;
        if (t0 < L) rv0 = *(const bf16x8*)(QKV + (size_t)(row0 + c * 64 + t0) * INW + 2560 + h * 128 + ch * 8);
        if (t0 + 32 < L) rv1 = *(const bf16x8*)(QKV + (size_t)(row0 + c * 64 + t0 + 32) * INW + 2560 + h * 128 + ch * 8);
    };
    issue(0);
    const int l32_0 = l32, hf_0 = hf, tid_0 = tid; const float lg2_0 = lg2;
#pragma unroll 1
    for (int c = 0; c < nchunks; ++c) {
        int l32 = l32_0, hf = hf_0, tid = tid_0; float lg2 = lg2_0;
        asm volatile("" : "+v"(l32), "+v"(hf), "+v"(tid), "+v"(lg2));
        {
            const int t = tid >> 3, pc = tid & 7, i0 = pc * 8; const bool ok = t < L;
            const float kd = ok ? __builtin_amdgcn_exp2f((float)(L - 1 - t) * lg2) : 0.f;
            const int tsw = (((t >> 3) ^ pc) << 4) + (t & 7) * 2;
            float cs_c[8], cs_s[8];
#pragma unroll
            for (int i = 0; i < 4; ++i) { cs_c[2 * i] = rcs[i].x; cs_s[2 * i] = rcs[i].y; cs_c[2 * i + 1] = rcs[i].z; cs_s[2 * i + 1] = rcs[i].w; }
            {
                float o1[8], o2[8];
#pragma unroll
                for (int i = 0; i < 8; ++i) { const float x1 = bf2f((unsigned short)rk1[i]), x2 = bf2f((unsigned short)rk2[i]);
                    o1[i] = (x1 * cs_c[i] - x2 * cs_s[i]) * 0.08838834764831845f; o2[i] = (x1 * cs_s[i] + x2 * cs_c[i]) * 0.08838834764831845f; }
                if (!state_only) {
                    u32x4 a, b; a.x = pk2(o1[0], o1[1]); a.y = pk2(o1[2], o1[3]); a.z = pk2(o1[4], o1[5]); a.w = pk2(o1[6], o1[7]);
                    b.x = pk2(o2[0], o2[1]); b.y = pk2(o2[2], o2[3]); b.z = pk2(o2[4], o2[5]); b.w = pk2(o2[6], o2[7]);
                    *(LAS u32x4*)(Kn + t * 272 + i0 * 2) = a; *(LAS u32x4*)(Kn + t * 272 + (64 + i0) * 2) = b;
                }
#pragma unroll
                for (int i = 0; i < 8; ++i) { *(LAS unsigned short*)(KdT + (i0 + i) * 144 + tsw) = (unsigned short)f2bf(o1[i] * kd); *(LAS unsigned short*)(KdT + (64 + i0 + i) * 144 + tsw) = (unsigned short)f2bf(o2[i] * kd); }
            }
            if (!state_only) {
                float o1[8], o2[8];
#pragma unroll
                for (int i = 0; i < 8; ++i) { const float x1 = bf2f((unsigned short)rq1[i]), x2 = bf2f((unsigned short)rq2[i]);
                    o1[i] = x1 * cs_c[i] - x2 * cs_s[i]; o2[i] = x1 * cs_s[i] + x2 * cs_c[i]; }
                u32x4 a, b; a.x = pk2(o1[0], o1[1]); a.y = pk2(o1[2], o1[3]); a.z = pk2(o1[4], o1[5]); a.w = pk2(o1[6], o1[7]);
                b.x = pk2(o2[0], o2[1]); b.y = pk2(o2[2], o2[3]); b.z = pk2(o2[4], o2[5]); b.w = pk2(o2[6], o2[7]);
                *(LAS u32x4*)(Qn + t * 272 + i0 * 2) = a; *(LAS u32x4*)(Qn + t * 272 + (64 + i0) * 2) = b;
            }
            {
                const int t0 = tid >> 4, ch = tid & 15, sw = ch & 7;
                const int o0 = (((t0 >> 3) ^ sw) << 4) + (t0 & 7) * 2, o1b = ((((t0 + 32) >> 3) ^ sw) << 4) + (t0 & 7) * 2;
#pragma unroll
                for (int i = 0; i < 8; ++i) { *(LAS short*)(VT + (ch * 8 + i) * 144 + o0) = rv0[i]; *(LAS short*)(VT + (ch * 8 + i) * 144 + o1b) = rv1[i]; }
            }
        }
        if (c + 1 < nchunks) issue(c + 1);
        unsigned gpre[8];
#pragma unroll
        for (int rr = 0; rr < 8; ++rr) { const int t = wave * 8 + rr; gpre[rr] = (!state_only && t < L) ? *(const unsigned*)(QKV + (size_t)(row0 + c * 64 + t) * INW + 3072 + h * 128 + lane * 2) : 0u; }
        __syncthreads();
        f32x16 acc;
        if (!state_only) {
#pragma unroll
            for (int r = 0; r < 16; ++r) acc[r] = 0.f;
#pragma unroll
            for (int ks = 0; ks < 8; ++ks) { const bf16x8 a = *(const LAS bf16x8*)(Qn + (lt * 32 + l32) * 272 + (ks * 16 + hf * 8) * 2), b = *(const LAS bf16x8*)(SbT + (et * 32 + l32) * 272 + (ks * 16 + hf * 8) * 2); acc = MFMA32(a, b, acc); }
#pragma unroll
            for (int r = 0; r < 16; ++r) { const int tl = lt * 32 + (r >> 2) * 8 + hf * 4 + (r & 3); acc[r] *= __builtin_amdgcn_exp2f((float)(tl + 1) * lg2); }
            if (wave < 4) {
                const int slt = wave >> 1, smt = wave & 1;
                f32x16 sc;
#pragma unroll
                for (int r = 0; r < 16; ++r) sc[r] = 0.f;
                if (slt >= smt) {
#pragma unroll
                    for (int ks = 0; ks < 8; ++ks) { const bf16x8 a = *(const LAS bf16x8*)(Qn + (slt * 32 + l32) * 272 + (ks * 16 + hf * 8) * 2), b = *(const LAS bf16x8*)(Kn + (smt * 32 + l32) * 272 + (ks * 16 + hf * 8) * 2); sc = MFMA32(a, b, sc); }
                }
                const int tm = smt * 32 + l32;
#pragma unroll
                for (int r = 0; r < 16; ++r) { const int tl = slt * 32 + (r >> 2) * 8 + hf * 4 + (r & 3);
                    const float p = tl >= tm ? sc[r] * __builtin_amdgcn_exp2f((float)(tl - tm) * lg2) : 0.f;
                    *(LAS unsigned short*)(Pm + tl * 144 + tm * 2) = (unsigned short)f2bf(p); }
            }
            __syncthreads();
#pragma unroll
            for (int ms = 0; ms < 4; ++ms) { const bf16x8 a = *(const LAS bf16x8*)(Pm + (lt * 32 + l32) * 144 + (ms * 16 + hf * 8) * 2), b = *(const LAS bf16x8*)(VT + (et * 32 + l32) * 144 + (((ms * 2 + hf) ^ ((et * 4 + (l32 >> 3)) & 7)) << 4)); acc = MFMA32(a, b, acc); }
#pragma unroll
            for (int r = 0; r < 16; ++r) { const int tl = lt * 32 + (r >> 2) * 8 + hf * 4 + (r & 3); of[tl * 132 + et * 32 + l32] = acc[r]; }
        }
#pragma unroll
        for (int r = 0; r < 16; ++r) { S0[r] *= gL; S1[r] *= gL; }
#pragma unroll
        for (int ts = 0; ts < 4; ++ts) {
            const int cc = ts * 2 + hf, rs = l32 >> 3;
            const bf16x8 a = *(const LAS bf16x8*)(KdT + (sdt * 32 + l32) * 144 + ((cc ^ ((sdt * 4 + rs) & 7)) << 4));
            const bf16x8 b0 = *(const LAS bf16x8*)(VT + (set0 * 32 + l32) * 144 + ((cc ^ ((set0 * 4 + rs) & 7)) << 4)), b1 = *(const LAS bf16x8*)(VT + ((set0 + 1) * 32 + l32) * 144 + ((cc ^ (((set0 + 1) * 4 + rs) & 7)) << 4));
            S0 = MFMA32(a, b0, S0); S1 = MFMA32(a, b1, S1);
        }
        if (!state_only) {
#pragma unroll
            for (int g = 0; g < 4; ++g) { const int d0 = sdt * 32 + g * 8 + hf * 4;
                u32x2 a, b; a.x = pk2(S0[4 * g], S0[4 * g + 1]); a.y = pk2(S0[4 * g + 2], S0[4 * g + 3]); b.x = pk2(S1[4 * g], S1[4 * g + 1]); b.y = pk2(S1[4 * g + 2], S1[4 * g + 3]);
                *(LAS u32x2*)(SbT + (set0 * 32 + l32) * 272 + d0 * 2) = a; *(LAS u32x2*)(SbT + ((set0 + 1) * 32 + l32) * 272 + d0 * 2) = b; }
            __syncthreads();
            const f32x2 gr = *(const f32x2*)(P.in[13] + (size_t)(l * 4 + h) * 128 + lane * 2);
            f32x2 ov[8]; float sq[8];
#pragma unroll
            for (int rr = 0; rr < 8; ++rr) { ov[rr] = *(const LAS f32x2*)(of + (wave * 8 + rr) * 132 + lane * 2); sq[rr] = ov[rr].x * ov[rr].x + ov[rr].y * ov[rr].y; }
#pragma unroll
            for (int o = 1; o < 64; o <<= 1) {
#pragma unroll
                for (int rr = 0; rr < 8; ++rr) sq[rr] += __shfl_xor(sq[rr], o);
            }
#pragma unroll
            for (int rr = 0; rr < 8; ++rr) {
                const int t = wave * 8 + rr;
                if (t < L) {
                    const float rstd = rsqrtf(sq[rr] * (1.f / 128.f) + EPS);
                    const size_t row = (size_t)(row0 + c * 64 + t);
                    const unsigned gg = gpre[rr];
                    const float y0 = ov[rr].x * rstd * gr.x * silu_f(bf2f(gg & 0xffffu)), y1 = ov[rr].y * rstd * gr.y * silu_f(bf2f(gg >> 16));
                    *(unsigned*)(Ob + row * DM + 512 + h * 128 + lane * 2) = pk2(y0, y1);
                }
            }
        }
        __syncthreads();
    }
    if (outst) {
        float* op = outst + (sdt * 32 + hf * 4) * 128 + set0 * 32 + l32;
#pragma unroll
        for (int r = 0; r < 16; ++r) { op[((r >> 2) * 8 + (r & 3)) * 128] = S0[r]; op[((r >> 2) * 8 + (r & 3)) * 128 + 32] = S1[r]; if ((r & 3) == 3) asm volatile("" ::: "memory"); }
    }
}


#define XB_TMO      128
#define XB_XCNT(j)  (256  + 64 * (j))
#define XB_XSUB(j)  (1280 + 64 * (j))
#define XB_XGEN(j)  (2304 + 64 * (j))
#define XB_TOP      3328
#define XB_TOPGEN   3392
#define XCD_BAR_WORDS 3456
#define XB_SPIN_CAP (1u << 18)

__device__ __forceinline__ unsigned xb_ld(unsigned* p)              { return __hip_atomic_load(p, __ATOMIC_RELAXED, __HIP_MEMORY_SCOPE_AGENT); }
__device__ __forceinline__ unsigned xb_add(unsigned* p, unsigned v) { return __hip_atomic_fetch_add(p, v, __ATOMIC_RELAXED, __HIP_MEMORY_SCOPE_AGENT); }
__device__ __forceinline__ unsigned xb_xcc_id() { return (unsigned)__builtin_amdgcn_s_getreg((3 << 11) | 20) & 0xFu; }
#define XB_SPIN(cond, bar) do { unsigned _sp = 0; while (cond) { __builtin_amdgcn_s_sleep(1); \
    if ((++_sp & 255u) == 0u) { if (xb_ld(&(bar)[XB_TMO])) break; if (_sp > XB_SPIN_CAP) { atomicAdd(&(bar)[XB_TMO], 1u); break; } } } } while (0)

struct XcdBarrier {
    unsigned* bar; unsigned x;
    volatile LAS unsigned* st;
};

__device__ __forceinline__ XcdBarrier xcd_barrier_post(unsigned* bar, volatile LAS unsigned* st) {
    XcdBarrier b; b.bar = bar; b.x = xb_xcc_id(); b.st = st;
    if (threadIdx.x == 0) (void)xb_add(&bar[XB_XCNT(b.x)], 1u);
    return b;
}
__device__ __forceinline__ void xcd_barrier_complete(unsigned* bar, unsigned x, unsigned& nloc, unsigned& nx) {
    const unsigned G = gridDim.x * gridDim.y * gridDim.z;
    unsigned sum, cnt, mine, sp = 0u;
    for (;;) {
        sum = 0u; cnt = 0u; mine = 0u;
#pragma unroll
        for (unsigned j = 0; j < 16; ++j) { const unsigned c = xb_ld(&bar[XB_XCNT(j)]); sum += c; cnt += (c > 0u) ? 1u : 0u; mine = (j == x) ? c : mine; }
        if (sum == G) break;
        __builtin_amdgcn_s_sleep(1);
        if ((++sp & 255u) == 0u) { if (xb_ld(&bar[XB_TMO])) break; if (sp > XB_SPIN_CAP) { atomicAdd(&bar[XB_TMO], 1u); break; } }
    }
    nloc = mine > 0u ? mine : 1u; nx = cnt > 0u ? cnt : 1u;
}

__device__ __forceinline__ void xcd_barrier(const XcdBarrier& b) {
    asm volatile("s_waitcnt vmcnt(0)" ::: "memory");
    __syncthreads();
    if (threadIdx.x == 0) {
        unsigned* bar = b.bar;
        __builtin_amdgcn_s_waitcnt(0);
        unsigned nloc = b.st[0], nx = b.st[1];
        if (nloc == 0u) { xcd_barrier_complete(bar, b.x, nloc, nx); b.st[0] = nloc; b.st[1] = nx; }
        const unsigned old = xb_add(&bar[XB_XSUB(b.x)], 1u);
        const unsigned gen = old / nloc;
        if (old + 1u == (gen + 1u) * nloc) {
            __builtin_amdgcn_fence(__ATOMIC_RELEASE, "agent");
            asm volatile("s_waitcnt vmcnt(0)" ::: "memory");
            const unsigned og = xb_add(&bar[XB_TOP], 1u);
            const unsigned tg = og / nx;
            if (og + 1u == (tg + 1u) * nx) xb_add(&bar[XB_TOPGEN], 1u);
            else XB_SPIN(xb_ld(&bar[XB_TOPGEN]) == tg, bar);
            __builtin_amdgcn_fence(__ATOMIC_ACQUIRE, "agent");
            xb_add(&bar[XB_XGEN(b.x)], 1u);
            asm volatile("s_waitcnt vmcnt(0)" ::: "memory");
        } else {
            XB_SPIN(xb_ld(&bar[XB_XGEN(b.x)]) == gen, bar);
            __builtin_amdgcn_fence(__ATOMIC_ACQUIRE, "agent");
            asm volatile("s_waitcnt vmcnt(0)" ::: "memory");
        }
    }
    __syncthreads();
}
__global__ void __launch_bounds__(512, 2) fwd_megakernel(Params P) {
    extern __shared__ __attribute__((aligned(16))) unsigned char lds_raw[];
    LAS unsigned char* lds = (LAS unsigned char*)lds_raw;
    cg::grid_group grid = cg::this_grid();
    int tid = threadIdx.x, lane = tid & 63, wave = __builtin_amdgcn_readfirstlane(tid >> 6);
#define REFRESH() do { tid = threadIdx.x; asm volatile("" : "+v"(tid)); lane = tid & 63; wave = __builtin_amdgcn_readfirstlane(tid >> 6); } while (0)
    const int G = gridDim.x, bx = blockIdx.x;
#define H ((bf16_t*)(P.ws + WS_H))
#define Ob ((bf16_t*)(P.ws + WS_O))
#define QKV ((bf16_t*)(P.ws + WS_QKV))
#define ACT ((bf16_t*)(P.ws + WS_QKV))
#define X ((bf16_t*)(P.ws + WS_X))
#define U ((float*)(P.ws + WS_U))
#define MOD ((const float*)(P.ws + WS_MOD))

    volatile LAS unsigned* bst = (volatile LAS unsigned*)(lds + LDS_BYTES - 64);
    if (tid == 0) { bst[0] = 0u; bst[1] = 0u; }
    __syncthreads();
    (void)xcd_barrier_post((unsigned*)(P.ws + WS_BAR), bst);
#define XBAR() do { XcdBarrier xb_; xb_.bar = (unsigned*)(P.ws + WS_BAR); xb_.x = xb_xcc_id(); xb_.st = (volatile LAS unsigned*)(lds + LDS_BYTES - 64); xcd_barrier(xb_); } while (0)
#ifndef SK_P0
    p0_phase(P, lds, tid, lane, wave);
#endif
    XBAR(); REFRESH();
    {
        const f32x4* part = (const f32x4*)(P.ws + WS_PART); f32x4* mod4 = (f32x4*)(P.ws + WS_MOD);
        constexpr int NV = DEPTH * NBI * NMOD / 4;
        for (int i = bx * 512 + tid; i < NV; i += G * 512) {
            f32x4 a = part[i];
#pragma unroll
            for (int kc = 1; kc < 8; ++kc) a += part[(size_t)kc * NV + i];
            mod4[i] = a;
        }
    }
    if (P.ws == nullptr) grid.sync();
    XBAR(); REFRESH();
#pragma unroll 1
    for (int l = 0; l < DEPTH; ++l) {
        norm_phase<false>(P, l, l == 0, P.in[7] + (size_t)l * DM, 0, 1024, lane, wave);
        XBAR(); REFRESH();
#ifndef SK_G1
        {
            pg8::Gemm g{H, (const bf16_t*)(P.ws + WS_WIN) + (size_t)l * INW * DM, MP, INW, DM}; pg8::StaticOrder S; S.init(MP, INW, G, bx);
            EpiQKV E{QKV, P.out, l};
            pg8::gemm_phase<EpiQKV, pg8::StaticOrder, true, true>(lds, g, S, E);
            SEpiQKV SE{QKV, P.out, l};
            sgemm_st_phase<SEpiQKV>(lds, H + (size_t)MP * DM, DM, g.Bt, DM, INW / 64, tid, lane, wave, SE);
        }
#endif
        XBAR(); REFRESH();
        {
            unsigned* qhead = (unsigned*)(P.ws + WS_CTR) + l * 64;
            volatile LAS unsigned* qslot = (volatile LAS unsigned*)(lds + LDS_BYTES - 128);
            for (;;) {
                if (tid == 0) *qslot = __hip_atomic_fetch_add(qhead, 1u, __ATOMIC_RELAXED, __HIP_MEMORY_SCOPE_AGENT);
                __syncthreads();
                const int u = (int)*qslot;
                __syncthreads();
                if (u >= 1616) break;
                REFRESH();
                if (u < 256) { const int bh = u >> 5, seg = u & 31, b = bh >> 2, h = bh & 3;
                    ret_unit(P, l, lds, tid, lane, wave, b * SEQ + seg * 512, seg * 512, 8, 64, h, nullptr, U + (size_t)(bh * 32 + seg) * 16384, true);
                    asm volatile("s_waitcnt vmcnt(0)" ::: "memory");
                    __syncthreads();
                    if (tid == 0) {
                        __builtin_amdgcn_fence(__ATOMIC_RELEASE, "agent");
                        asm volatile("s_waitcnt vmcnt(0)" ::: "memory");
                        const unsigned old = __hip_atomic_fetch_add((unsigned*)(P.ws + WS_CTR + 1024) + l * 8 + bh, 1u, __ATOMIC_RELAXED, __HIP_MEMORY_SCOPE_AGENT);
                        const unsigned last = (old == 31u) ? 1u : 0u;
                        if (last) { __builtin_amdgcn_fence(__ATOMIC_ACQUIRE, "agent"); asm volatile("s_waitcnt vmcnt(0)" ::: "memory"); }
                        qslot[1] = last;
                    }
                    __syncthreads();
                    if (qslot[1]) {
                        const float g512 = exp2f(512.f * log2f(1.f - exp2f(-5.f - (float)h)));
#pragma unroll 1
                        for (int j = 0; j < 32; ++j) {
                            const int within = j * 512 + tid;
                            float* up = U + (size_t)bh * 32 * 16384 + within; float sst = 0.f;
                            float uv[32];
#pragma unroll
                            for (int sg = 0; sg < 32; ++sg) uv[sg] = up[(size_t)sg * 16384];
#pragma unroll
                            for (int sg = 0; sg < 32; ++sg) { up[(size_t)sg * 16384] = sst; sst = g512 * sst + uv[sg]; }
                            P.out[OFF_RP + ((size_t)l * 8 + bh) * 16384 + within] = sst;
                        }
                        asm volatile("s_waitcnt vmcnt(0)" ::: "memory");
                        __syncthreads();
                        if (tid == 0) { __builtin_amdgcn_fence(__ATOMIC_RELEASE, "agent"); asm volatile("s_waitcnt vmcnt(0)" ::: "memory");
                            __hip_atomic_store((unsigned*)(P.ws + WS_CTR + 1152) + l * 8 + bh, 1u, __ATOMIC_RELAXED, __HIP_MEMORY_SCOPE_AGENT); }
                    }
                }
                else if (u < 272) sb_unit(P, l, 1024 + (u - 256), lds, tid, lane, wave);
                else if (u < 1296) { const int v = u - 272; sb_unit(P, l, (v & 1) * 512 + (511 - (v >> 1)), lds, tid, lane, wave); }
                else if (u < 1360) { const int idx = u - 1296, bs = idx >> 2, h = idx & 3; const size_t so = ((size_t)(l * DB + bs) * 4 + h) * 16384;
                    ret_unit(P, l, lds, tid, lane, wave, MP + bs * 32, PAST, 1, 32, h, P.in[4] + so, P.out + OFF_RS + so, false); }
                else {
                    const int v = u - 1360, bh = v >> 5, seg = v & 31, b = bh >> 2, h = bh & 3;
                    if (tid == 0) {
                        unsigned* fl = (unsigned*)(P.ws + WS_CTR + 1152) + l * 8 + bh; unsigned sp = 0u;
                        while (__hip_atomic_load(fl, __ATOMIC_RELAXED, __HIP_MEMORY_SCOPE_AGENT) == 0u && ++sp < (1u << 22)) __builtin_amdgcn_s_sleep(2);
                        __builtin_amdgcn_fence(__ATOMIC_ACQUIRE, "agent"); asm volatile("s_waitcnt vmcnt(0)" ::: "memory");
                    }
                    __syncthreads();
                    ret_unit(P, l, lds, tid, lane, wave, b * SEQ + seg * 512, seg * 512, 8, 64, h, (const float*)(P.ws + WS_U) + (size_t)(bh * 32 + seg) * 16384, nullptr, false);
                }
            }
        }
        XBAR(); REFRESH();
#ifndef SK_G2
        {
            pg8::Gemm g{Ob, (const bf16_t*)(P.ws + WS_WOUT) + (size_t)l * DM * DM, MP, DM, DM}; pg8::StaticOrder S; S.init(MP, DM, G, bx);
            EpiResid E{l == 0 ? P.in[0] : nullptr, l == 0 ? P.in[1] : nullptr, X, MOD + (size_t)l * NBI * NMOD + 2048};
            pg8::gemm_phase<EpiResid, pg8::StaticOrder, true, true>(lds, g, S, E);
            SEpiResid SE{l == 0 ? P.in[1] : nullptr, X + (size_t)MP * DM, MOD + (size_t)l * NBI * NMOD + 2048};
            sgemm_phase<8, 8, SEpiResid>(lds, Ob + (size_t)MP * DM, DM, g.Bt, DM, DM / 64, tid, lane, wave, SE);
        }
#endif
        XBAR(); REFRESH();
        norm_phase<false>(P, l, false, P.in[8] + (size_t)l * DM, 3072, 4096, lane, wave);
        XBAR(); REFRESH();
#ifndef SK_G3
        {
            pg8::Gemm g{H, (const bf16_t*)(P.ws + WS_WFI) + (size_t)l * 2 * DFF * DM, MP, 2 * DFF, DM}; pg8::StaticOrder S; S.init(MP, 2 * DFF, G, bx);
            EpiSwiGLU E{ACT};
            pg8::gemm_phase<EpiSwiGLU, pg8::StaticOrder, true, true>(lds, g, S, E);
            SEpiSwiGLU SE{ACT};
            sgemm_st_phase<SEpiSwiGLU>(lds, H + (size_t)MP * DM, DM, g.Bt, DM, (2 * DFF / 256) * 4, tid, lane, wave, SE);
        }
#endif
        XBAR(); REFRESH();
#ifndef SK_G4
        {
            pg8::Gemm g{ACT, (const bf16_t*)(P.ws + WS_WFO) + (size_t)l * DM * DFF, MP, DM, DFF}; pg8::StaticOrder S; S.init(MP, DM, G, bx);
            EpiResid E{nullptr, nullptr, X, MOD + (size_t)l * NBI * NMOD + 5120};
            pg8::gemm_phase<EpiResid, pg8::StaticOrder, true, true>(lds, g, S, E);
            SEpiResid SE{nullptr, X + (size_t)MP * DM, MOD + (size_t)l * NBI * NMOD + 5120};
            sgemm_phase<22, 11, SEpiResid>(lds, ACT + (size_t)MP * DFF, DFF, g.Bt, DFF, DM / 64, tid, lane, wave, SE);
        }
#endif
        XBAR(); REFRESH();
    }
    norm_phase<true>(P, 0, false, P.in[17], 0, 0, lane, wave);
}

#undef H
#undef Ob
#undef QKV
#undef ACT
#undef X
#undef U
#undef MOD
extern "C" void kernel_launch(void* const* d_in, const int* in_sizes, int n_in, void* d_out, int out_size, void* d_ws, size_t ws_size, hipStream_t stream) {
    static int grid = 0;
    if (grid == 0) {
        if (n_in != 18 || ws_size < WS_END) { fprintf(stderr, "kernel_launch: unexpected n_in %d / ws_size %zu\n", n_in, ws_size); grid = -1; return; }
        int dev = 0, cus = 0, per_cu = 0;
        (void)hipGetDevice(&dev); (void)hipDeviceGetAttribute(&cus, hipDeviceAttributeMultiprocessorCount, dev);
        if (hipFuncSetAttribute((const void*)fwd_megakernel, hipFuncAttributeMaxDynamicSharedMemorySize, LDS_BYTES) != hipSuccess) { fprintf(stderr, "kernel_launch: hipFuncSetAttribute failed\n"); grid = -1; return; }
        (void)hipOccupancyMaxActiveBlocksPerMultiprocessor(&per_cu, (const void*)fwd_megakernel, 512, LDS_BYTES);
        (void)hipGetLastError();
        if (per_cu < 1) { fprintf(stderr, "kernel_launch: occupancy query says %d blocks per CU\n", per_cu); per_cu = 1; }
        grid = cus;
    }
    if (grid < 0) return;
    (void)hipMemsetAsync((char*)d_ws + WS_BAR, 0, 20480, stream);
    Params p{};
    for (int i = 0; i < 18; ++i) p.in[i] = (const float*)d_in[i];
    p.out = (float*)d_out; p.ws = (unsigned char*)d_ws;
    void* args[] = {&p};
    hipError_t e = hipLaunchCooperativeKernel((const void*)fwd_megakernel, dim3(grid), dim3(512), args, LDS_BYTES, stream);
    if (e != hipSuccess) fprintf(stderr, "cooperative launch failed: %s (grid %d)\n", hipGetErrorString(e), grid);
}
```
